# Optimizing an MI355X kernel written in HIP

```python
import math
import jax
import jax.numpy as jnp
from jax import lax
import numpy as np

D_MODEL = 1024
BATCH = 32
SEQ = 2048
DEPTH = 4

CHUNK = 64
Q_BLOCK = 128
HEAD_DIM = 64
N_HEADS = D_MODEL // HEAD_DIM
KV_DIM = 64
IDX_HEADS = 8
IDX_DIM = 64
INDEX_TOPK = 256
RNN_WIDTH = D_MODEL
RNN_BLOCKS = 8
RNN_BW = RNN_WIDTH // RNN_BLOCKS
CONV_W = 4
LRU_C = 8.0
REL_BUCKETS = 32
REL_MAX_DIST = 128
D_FF = 2816
N_EXPERTS = 8
TOP_K = 2
D_FF_EXPERT = 3584
PLE_DIM = 256
LN_EPS = 1e-5
DN_ALPHA = (2 * DEPTH) ** 0.25
DN_BETA = (8 * DEPTH) ** -0.25
SPLITS = (N_HEADS * HEAD_DIM, KV_DIM, KV_DIM, IDX_HEADS * IDX_DIM, IDX_DIM, IDX_HEADS, RNN_WIDTH, RNN_WIDTH, D_MODEL, D_MODEL)
D_IN = sum(SPLITS)
SPLIT_OFFSETS = tuple(int(o) for o in np.cumsum(SPLITS)[:-1])
N_DENSE = (DEPTH + 1) // 2
N_MOE = DEPTH // 2

kernel_name = 'hybrid_dsa_rglru_moe_deepnorm'


def layer_norm(x, g, b):
    xf = x.astype(jnp.float32)
    mu = jnp.mean(xf, axis=-1, keepdims=True)
    var = jnp.mean(jnp.square(xf - mu), axis=-1, keepdims=True)
    return ((xf - mu) * lax.rsqrt(var + LN_EPS)).astype(x.dtype) * g + b


def t5_bucket(rel):
    half = REL_BUCKETS // 2
    max_exact = half // 2
    ret = jnp.where(rel > 0, half, 0)
    n = jnp.abs(rel)
    nf = jnp.maximum(n, 1).astype(jnp.float32)
    large = max_exact + (jnp.log(nf / max_exact) / math.log(REL_MAX_DIST / max_exact) * (half - max_exact)).astype(jnp.int32)
    large = jnp.minimum(large, half - 1)
    return ret + jnp.where(n < max_exact, n, large)


def dsa_attention(q, k, v, q_idx, k_idx, w_idx, rel_bias):
    b, s, h, dh = q.shape
    k_top = min(INDEX_TOPK, s // 4)
    nb = s // Q_BLOCK
    key_chunk = jnp.arange(s) // CHUNK

    def to_blocks(t):
        return jnp.moveaxis(t.reshape(b, nb, Q_BLOCK, *t.shape[2:]), 1, 0)

    def block(args):
        qb, qib, wb, start = args
        qpos = start + jnp.arange(Q_BLOCK)
        qchunk = qpos // CHUNK
        admiss = key_chunk[None, :] <= qchunk[:, None]
        dots = jnp.einsum('bqhd,bsd->bqhs', qib, k_idx).astype(jnp.float32) * (IDX_DIM ** -0.5)
        score = jnp.einsum('bqhs,bqh->bqs', jax.nn.relu(dots), wb.astype(jnp.float32)) * (IDX_HEADS ** -0.5)
        score = jnp.where(admiss[None], score, -jnp.inf)
        _, idx = lax.top_k(score, k_top)
        kg = jax.vmap(lambda kk, ii: kk[ii])(k, idx)
        vg = jax.vmap(lambda vv, ii: vv[ii])(v, idx)
        logits = jnp.einsum('bqhd,bqkd->bqhk', qb, kg).astype(jnp.float32) * (dh ** -0.5)
        bias = rel_bias[t5_bucket(idx - qpos[None, :, None])]
        logits = logits + jnp.moveaxis(bias, -1, 2).astype(jnp.float32)
        valid = (idx // CHUNK) <= qchunk[None, :, None]
        logits = jnp.where(valid[:, :, None, :], logits, -1e30)
        probs = jax.nn.softmax(logits, axis=-1).astype(v.dtype)
        return jnp.einsum('bqhk,bqkd->bqhd', probs, vg)

    starts = jnp.arange(nb, dtype=jnp.int32) * Q_BLOCK
    out = lax.map(block, (to_blocks(q), to_blocks(q_idx), to_blocks(w_idx), starts))
    return jnp.moveaxis(out, 0, 1).reshape(b, s, h * dh)


def causal_conv(x, w, bias):
    s = x.shape[1]
    xp = jnp.pad(x, ((0, 0), (CONV_W - 1, 0), (0, 0)))
    out = xp[:, 0:s] * w[0]
    for j in range(1, CONV_W):
        out = out + xp[:, j:j + s] * w[j]
    return out + bias


def rg_lru(xc, wa, ba, wx, bx, lam):
    b, s, d = xc.shape
    xb = xc.reshape(b, s, RNN_BLOCKS, RNN_BW)
    r = jax.nn.sigmoid(jnp.einsum('bsnc,ncd->bsnd', xb, wa).reshape(b, s, d) + ba)
    i = jax.nn.sigmoid(jnp.einsum('bsnc,ncd->bsnd', xb, wx).reshape(b, s, d) + bx)
    log_a = -LRU_C * r.astype(jnp.float32) * jax.nn.softplus(-lam.astype(jnp.float32))
    a = jnp.exp(log_a)
    u = jnp.sqrt(-jnp.expm1(2.0 * log_a)) * (i * xc).astype(jnp.float32)

    def combine(c1, c2):
        a1, b1 = c1
        a2, b2 = c2
        return a1 * a2, a2 * b1 + b2

    _, hs = lax.associative_scan(combine, (a, u), axis=1)
    return hs.astype(xc.dtype)


def token_mixer(x, w_in, conv_w, conv_b, lru_wa, lru_ba, lru_wx, lru_bx, lru_lam, w_br_attn, w_br_rnn, w_o, rel_bias):
    b, s, _ = x.shape
    z = x @ w_in
    q, k, v, qi, ki, wi, xr, yr, ga, gr = jnp.split(z, SPLIT_OFFSETS, axis=-1)
    q = q.reshape(b, s, N_HEADS, HEAD_DIM)
    qi = qi.reshape(b, s, IDX_HEADS, IDX_DIM)
    o_attn = dsa_attention(q, k, v, qi, ki, wi, rel_bias)
    xc = causal_conv(xr, conv_w, conv_b)
    o_rnn = rg_lru(xc, lru_wa, lru_ba, lru_wx, lru_bx, lru_lam) * jax.nn.gelu(yr)
    merged = jax.nn.sigmoid(ga) * (o_attn @ w_br_attn) + jax.nn.sigmoid(gr) * (o_rnn @ w_br_rnn)
    return merged @ w_o


def swiglu(x, w_gate, w_up, w_down):
    return (jax.nn.silu(x @ w_gate) * (x @ w_up)) @ w_down


def moe_swiglu(x, router, router_b, w_gate, w_up, w_down):
    logits = (x @ router).astype(jnp.float32) + router_b.astype(jnp.float32)
    top_v, top_i = lax.top_k(logits, TOP_K)
    gates = jax.nn.softmax(top_v, axis=-1)
    combine = jnp.sum(jax.nn.one_hot(top_i, N_EXPERTS, dtype=jnp.float32) * gates[..., None], axis=-2).astype(x.dtype)
    out = jnp.zeros_like(x)
    for e in range(N_EXPERTS):
        out = out + combine[..., e:e + 1] * swiglu(x, w_gate[e], w_up[e], w_down[e])
    return out


def setup_inputs(seed: int = 0) -> dict:
    key = jax.random.key(seed)
    ks = jax.random.split(key, 28)
    f32 = jnp.float32

    def nrm(k, shape, scale):
        return jax.random.normal(k, shape, f32) * scale

    a0 = jax.random.uniform(ks[9], (DEPTH, RNN_WIDTH), f32, 0.9, 0.999)
    return {
        'x': nrm(ks[0], (BATCH, SEQ, D_MODEL), 1.0),
        'p': nrm(ks[1], (DEPTH, BATCH, SEQ, PLE_DIM), 1.0),
        'w_in': nrm(ks[2], (DEPTH, D_MODEL, D_IN), D_MODEL ** -0.5),
        'conv_w': nrm(ks[3], (DEPTH, CONV_W, RNN_WIDTH), CONV_W ** -0.5),
        'conv_b': nrm(ks[4], (DEPTH, RNN_WIDTH), 0.01),
        'lru_wa': nrm(ks[5], (DEPTH, RNN_BLOCKS, RNN_BW, RNN_BW), RNN_BW ** -0.5),
        'lru_ba': nrm(ks[6], (DEPTH, RNN_WIDTH), 0.01),
        'lru_wx': nrm(ks[7], (DEPTH, RNN_BLOCKS, RNN_BW, RNN_BW), RNN_BW ** -0.5),
        'lru_bx': nrm(ks[8], (DEPTH, RNN_WIDTH), 0.01),
        'lru_lam': jnp.log(a0) - jnp.log1p(-a0),
        'w_br_attn': nrm(ks[10], (DEPTH, N_HEADS * HEAD_DIM, D_MODEL), (N_HEADS * HEAD_DIM) ** -0.5),
        'w_br_rnn': nrm(ks[11], (DEPTH, RNN_WIDTH, D_MODEL), RNN_WIDTH ** -0.5),
        'w_o': nrm(ks[12], (DEPTH, D_MODEL, D_MODEL), DN_BETA * D_MODEL ** -0.5),
        'rel_bias': nrm(ks[13], (REL_BUCKETS, N_HEADS), 0.5),
        'ln1_g': 1.0 + nrm(ks[14], (DEPTH, D_MODEL), 0.02),
        'ln1_b': nrm(ks[15], (DEPTH, D_MODEL), 0.01),
        'ffn_w_gate': nrm(ks[16], (N_DENSE, D_MODEL, D_FF), D_MODEL ** -0.5),
        'ffn_w_up': nrm(ks[17], (N_DENSE, D_MODEL, D_FF), D_MODEL ** -0.5),
        'ffn_w_down': nrm(ks[18], (N_DENSE, D_FF, D_MODEL), DN_BETA * D_FF ** -0.5),
        'moe_router': nrm(ks[19], (N_MOE, D_MODEL, N_EXPERTS), D_MODEL ** -0.5),
        'moe_router_b': nrm(ks[20], (N_MOE, N_EXPERTS), 0.01),
        'moe_w_gate': nrm(ks[21], (N_MOE, N_EXPERTS, D_MODEL, D_FF_EXPERT), D_MODEL ** -0.5),
        'moe_w_up': nrm(ks[22], (N_MOE, N_EXPERTS, D_MODEL, D_FF_EXPERT), D_MODEL ** -0.5),
        'moe_w_down': nrm(ks[23], (N_MOE, N_EXPERTS, D_FF_EXPERT, D_MODEL), DN_BETA * D_FF_EXPERT ** -0.5),
        'ple_w_gate': nrm(ks[24], (DEPTH, D_MODEL, D_MODEL), D_MODEL ** -0.5),
        'ple_w_proj': nrm(ks[25], (DEPTH, PLE_DIM, D_MODEL), DN_BETA * PLE_DIM ** -0.5),
        'ln2_g': 1.0 + nrm(ks[26], (DEPTH, D_MODEL), 0.02),
        'ln2_b': nrm(ks[27], (DEPTH, D_MODEL), 0.01),
    }


def reference(x, p, w_in, conv_w, conv_b, lru_wa, lru_ba, lru_wx, lru_bx, lru_lam, w_br_attn, w_br_rnn, w_o, rel_bias, ln1_g, ln1_b, ffn_w_gate, ffn_w_up, ffn_w_down, moe_router, moe_router_b, moe_w_gate, moe_w_up, moe_w_down, ple_w_gate, ple_w_proj, ln2_g, ln2_b):
    for i in range(DEPTH):
        mix = token_mixer(x, w_in[i], conv_w[i], conv_b[i], lru_wa[i], lru_ba[i], lru_wx[i], lru_bx[i], lru_lam[i], w_br_attn[i], w_br_rnn[i], w_o[i], rel_bias)
        x = layer_norm(DN_ALPHA * x + mix, ln1_g[i], ln1_b[i])
        j = i // 2
        if i % 2 == 0:
            f = swiglu(x, ffn_w_gate[j], ffn_w_up[j], ffn_w_down[j])
        else:
            f = moe_swiglu(x, moe_router[j], moe_router_b[j], moe_w_gate[j], moe_w_up[j], moe_w_down[j])
        ple = jax.nn.sigmoid(x @ ple_w_gate[i]) * (p[i] @ ple_w_proj[i])
        x = layer_norm(DN_ALPHA * x + f + ple, ln2_g[i], ln2_b[i])
    return x
```

```cpp
#include <hip/hip_runtime.h>
#include <cstdio>
#include <cstdint>

constexpr int T_TOK = 65536, D = 1024, SEQ = 2048, NBATCH = 32, DEPTH = 4;
constexpr int D_IN = 5832, NIN = 5888;
constexpr int DFF = 2816, DFFE = 3584, NEXP = 8, PLE = 256;
constexpr float LN_EPS = 1e-5f;
constexpr float DN_ALPHA = 1.681792830507429f;

namespace pg8 {
#define PG8_LAS __attribute__((address_space(3)))
typedef unsigned short bf16_t;
typedef short bf16x8 __attribute__((ext_vector_type(8)));
typedef float f32x4 __attribute__((ext_vector_type(4)));
typedef unsigned u32x4 __attribute__((ext_vector_type(4)));
typedef unsigned u32x2 __attribute__((ext_vector_type(2)));
constexpr int BM = 256, BK = 64, HALF = 128, HTB = HALF * BK * 2  , STAGE_BYTES = 8 * HTB, NXCD = 8, WGM = 8;

__host__ __device__ __forceinline__ int lds_byte(int r, int c) { const int st = (r >> 4) * 2 + (c >> 5), rr = r & 15, cc = c & 31, ob = rr * 64 + cc * 2; return st * 1024 + (ob ^ (((ob >> 9) & 1) << 5)); }
__host__ __device__ __forceinline__ void stage_rc(int b, int& R, int& C) { const int st = b / 1024, sb = b % 1024, swz = sb ^ (((sb >> 9) & 1) << 5); R = (st >> 1) * 16 + swz / 64; C = (st & 1) * 32 + (swz % 64) / 2; }
__host__ __device__ __forceinline__ int perm32(int rho) { const int n = rho >> 4, i = rho & 15; return 8 * (i >> 2) + 4 * n + (i & 3); }

struct Unit { int pm, pn; };
struct Gemm { const bf16_t* A; const bf16_t* Bt; int M, N, K; };

struct StaticOrder {
    static constexpr bool GATHER = false;
    int nM, nN, nwg, G, c;
    __host__ __device__ void init(int M, int N, int G_, int c_) { nM = M / BM; nN = N / BM; nwg = nM * nN; G = G_; c = c_; }
    __host__ __device__ bool next(int i, Unit& u) const {
        const long L = (long)i * G + c; if (L >= nwg) return false;
        int wgid = (int)L; { const int q = nwg / NXCD, r = nwg % NXCD, xcd = wgid % NXCD, off = wgid / NXCD; wgid = (xcd < r ? xcd * (q + 1) : r * (q + 1) + (xcd - r) * q) + off; }
        const int nig = WGM * nN, gid = wgid / nig, fm = gid * WGM, gsz = (nM - fm) < WGM ? (nM - fm) : WGM;
        u.pm = fm + ((wgid % nig) % gsz); u.pn = (wgid % nig) / gsz; return true;
    }
    __device__ __forceinline__ const char* a_base(const Gemm& g, const Unit& u, size_t tstep) const { return (const char*)g.A + (size_t)u.pm * tstep; }
    __device__ __forceinline__ const char* b_base(const Gemm& g, const Unit& u, size_t tstep) const { return (const char*)g.Bt + (size_t)u.pn * tstep; }
    __device__ __forceinline__ void a_rows(const Unit&, int, int, int, int, int, unsigned (&)[2][2]) const {}
    __device__ __forceinline__ void a_ready(const Unit&) const {}
    __device__ __forceinline__ void done(const Unit&) const {}
};

__device__ __forceinline__ unsigned cvt_pk_bf16(float lo, float hi) { unsigned r; asm volatile("v_cvt_pk_bf16_f32 %0, %1, %2" : "=v"(r) : "v"(lo), "v"(hi)); return r; }
__device__ __forceinline__ float bf_lo(unsigned w) { return __builtin_bit_cast(float, w << 16); }
__device__ __forceinline__ float bf_hi(unsigned w) { return __builtin_bit_cast(float, w & 0xffff0000u); }
__device__ __forceinline__ float sigmoidf_fast(float x) { return __builtin_amdgcn_rcpf(1.0f + __builtin_amdgcn_exp2f(-1.4426950408889634f * x)); }
#define EPI_FENCE() asm volatile("" ::: "memory")
#define EGAS __attribute__((address_space(1)))
__device__ __forceinline__ u32x4 pack8(const f32x4 v0, const f32x4 v1) { u32x4 w; w.x = cvt_pk_bf16(v0[0], v0[1]); w.y = cvt_pk_bf16(v0[2], v0[3]); w.z = cvt_pk_bf16(v1[0], v1[1]); w.w = cvt_pk_bf16(v1[2], v1[3]); return w; }

struct EpiBf16 {
    static constexpr bool PERM = true, AFTER_DRAIN = false;
    bf16_t* O; int ldc; int row_off;
    __device__ __forceinline__ void operator()(const f32x4 (&acc)[2][2][4][2], const Unit& u, int wr, int wc, int fr, int fq) const {
        { int l_ = (int)__builtin_amdgcn_mbcnt_hi(~0u, __builtin_amdgcn_mbcnt_lo(~0u, 0u)); asm volatile("" : "+v"(l_)); fr = l_ & 15; fq = l_ >> 4; }
        const int row0 = row_off + u.pm * BM + wr * 64 + fr, col0 = u.pn * BM + wc * 32 + 8 * fq;
#pragma unroll
        for (int ai = 0; ai < 2; ++ai)
#pragma unroll
            for (int m = 0; m < 4; ++m) { bf16_t* rowp = O + (size_t)(row0 + ai * HALF + m * 16) * ldc + col0;
#pragma unroll
                for (int bj = 0; bj < 2; ++bj) *(EGAS u32x4*)(rowp + bj * HALF) = pack8(acc[ai][bj][m][0], acc[ai][bj][m][1]); }
    }
};
struct EpiZ {
    static constexpr bool PERM = true, AFTER_DRAIN = false;
    bf16_t* zbig; bf16_t* zqi; bf16_t* zsm;
    __device__ __forceinline__ void operator()(const f32x4 (&acc)[2][2][4][2], const Unit& u, int wr, int wc, int fr, int fq) const {
        { int l_ = (int)__builtin_amdgcn_mbcnt_hi(~0u, __builtin_amdgcn_mbcnt_lo(~0u, 0u)); asm volatile("" : "+v"(l_)); fr = l_ & 15; fq = l_ >> 4; }
        bf16_t* base; int ld, colt;
        if (u.pn < 20) { base = zbig + (size_t)(u.pn >> 2) * ((size_t)T_TOK * D); ld = D; colt = (u.pn & 3) * BM; }
        else if (u.pn < 22) { base = zqi; ld = 512; colt = (u.pn - 20) * BM; }
        else { base = zsm; ld = 256; colt = 0; }
        const int row0 = u.pm * BM + wr * 64 + fr, col0 = colt + wc * 32 + 8 * fq;
#pragma unroll
        for (int ai = 0; ai < 2; ++ai)
#pragma unroll
            for (int m = 0; m < 4; ++m) { bf16_t* rowp = base + (size_t)(row0 + ai * HALF + m * 16) * ld + col0;
#pragma unroll
                for (int bj = 0; bj < 2; ++bj) *(EGAS u32x4*)(rowp + bj * HALF) = pack8(acc[ai][bj][m][0], acc[ai][bj][m][1]); }
    }
};
template <int MODE> struct EpiGate {
    static constexpr bool PERM = true, AFTER_DRAIN = false;
    bf16_t* G; const bf16_t* G2;
    __device__ __forceinline__ void operator()(const f32x4 (&acc)[2][2][4][2], const Unit& u, int wr, int wc, int fr, int fq) const {
        { int l_ = (int)__builtin_amdgcn_mbcnt_hi(~0u, __builtin_amdgcn_mbcnt_lo(~0u, 0u)); asm volatile("" : "+v"(l_)); fr = l_ & 15; fq = l_ >> 4; }
        const int row0 = u.pm * BM + wr * 64 + fr, col0 = u.pn * BM + wc * 32 + 8 * fq;
#pragma unroll
        for (int ai = 0; ai < 2; ++ai)
#pragma unroll
            for (int m = 0; m < 4; ++m) { const size_t off = (size_t)(row0 + ai * HALF + m * 16) * D + col0;
#pragma unroll
                for (int bj = 0; bj < 2; ++bj) {
                    const u32x4 gw = *(const EGAS u32x4*)(G + off + bj * HALF);
                    f32x4 v0 = acc[ai][bj][m][0], v1 = acc[ai][bj][m][1];
                    if (MODE == 0) {
                        v0[0] *= sigmoidf_fast(bf_lo(gw.x)); v0[1] *= sigmoidf_fast(bf_hi(gw.x)); v0[2] *= sigmoidf_fast(bf_lo(gw.y)); v0[3] *= sigmoidf_fast(bf_hi(gw.y));
                        v1[0] *= sigmoidf_fast(bf_lo(gw.z)); v1[1] *= sigmoidf_fast(bf_hi(gw.z)); v1[2] *= sigmoidf_fast(bf_lo(gw.w)); v1[3] *= sigmoidf_fast(bf_hi(gw.w));
                    } else {
                        const u32x4 g2 = *(const EGAS u32x4*)(G2 + off + bj * HALF);
                        v0[0] = bf_lo(gw.x) + v0[0] * sigmoidf_fast(bf_lo(g2.x)); v0[1] = bf_hi(gw.x) + v0[1] * sigmoidf_fast(bf_hi(g2.x));
                        v0[2] = bf_lo(gw.y) + v0[2] * sigmoidf_fast(bf_lo(g2.y)); v0[3] = bf_hi(gw.y) + v0[3] * sigmoidf_fast(bf_hi(g2.y));
                        v1[0] = bf_lo(gw.z) + v1[0] * sigmoidf_fast(bf_lo(g2.z)); v1[1] = bf_hi(gw.z) + v1[1] * sigmoidf_fast(bf_hi(g2.z));
                        v1[2] = bf_lo(gw.w) + v1[2] * sigmoidf_fast(bf_lo(g2.w)); v1[3] = bf_hi(gw.w) + v1[3] * sigmoidf_fast(bf_hi(g2.w));
                    }
                    *(EGAS u32x4*)(G + off + bj * HALF) = pack8(v0, v1); }
                EPI_FENCE(); }
    }
};
template <int MODE> struct EpiRes {
    static constexpr bool PERM = false, AFTER_DRAIN = false;
    float* Y; const float* X; const bf16_t* U;
    __device__ __forceinline__ void operator()(const f32x4 (&acc)[2][2][4][2], const Unit& u, int wr, int wc, int fr, int fq) const {
        { int l_ = (int)__builtin_amdgcn_mbcnt_hi(~0u, __builtin_amdgcn_mbcnt_lo(~0u, 0u)); asm volatile("" : "+v"(l_)); fr = l_ & 15; fq = l_ >> 4; }
        const int row0 = u.pm * BM + wr * 64 + fr, col0 = u.pn * BM + wc * 32 + 4 * fq;
#pragma unroll
        for (int ai = 0; ai < 2; ++ai)
#pragma unroll
            for (int m = 0; m < 4; ++m) { const size_t off = (size_t)(row0 + ai * HALF + m * 16) * D + col0;
#pragma unroll
                for (int bj = 0; bj < 2; ++bj)
#pragma unroll
                    for (int n = 0; n < 2; ++n) { const size_t o = off + bj * HALF + n * 16; const f32x4 a = acc[ai][bj][m][n]; f32x4 r;
                        if (MODE == 0) { const f32x4 x = *(const EGAS f32x4*)(X + o); r = x * DN_ALPHA + a; }
                        else if (MODE == 1) { const f32x4 x = *(const EGAS f32x4*)(Y + o); const u32x2 uw = *(const EGAS u32x2*)(U + o);
                            r[0] = x[0] * DN_ALPHA + sigmoidf_fast(a[0]) * bf_lo(uw.x); r[1] = x[1] * DN_ALPHA + sigmoidf_fast(a[1]) * bf_hi(uw.x);
                            r[2] = x[2] * DN_ALPHA + sigmoidf_fast(a[2]) * bf_lo(uw.y); r[3] = x[3] * DN_ALPHA + sigmoidf_fast(a[3]) * bf_hi(uw.y); }
                        else { const f32x4 x = *(const EGAS f32x4*)(Y + o); r = x + a; }
                        *(EGAS f32x4*)(Y + o) = r; }
                EPI_FENCE(); }
    }
};
struct EpiSwiglu {
    static constexpr bool PERM = true, AFTER_DRAIN = false;
    bf16_t* H; int ldh;
    __device__ __forceinline__ void operator()(const f32x4 (&acc)[2][2][4][2], const Unit& u, int wr, int wc, int fr, int fq) const {
        { int l_ = (int)__builtin_amdgcn_mbcnt_hi(~0u, __builtin_amdgcn_mbcnt_lo(~0u, 0u)); asm volatile("" : "+v"(l_)); fr = l_ & 15; fq = l_ >> 4; }
        const int row0 = u.pm * BM + wr * 64 + fr, col0 = u.pn * HALF + wc * 32 + 8 * fq;
#pragma unroll
        for (int ai = 0; ai < 2; ++ai)
#pragma unroll
            for (int m = 0; m < 4; ++m) { bf16_t* rowp = H + (size_t)(row0 + ai * HALF + m * 16) * ldh + col0;
                f32x4 v0, v1;
#pragma unroll
                for (int j = 0; j < 4; ++j) { const float g0 = acc[ai][0][m][0][j], g1 = acc[ai][0][m][1][j];
                    v0[j] = g0 * sigmoidf_fast(g0) * acc[ai][1][m][0][j]; v1[j] = g1 * sigmoidf_fast(g1) * acc[ai][1][m][1][j]; }
                *(EGAS u32x4*)rowp = pack8(v0, v1); }
    }
};
template <class Epi, class Sched, bool ALIGN_EPI = true>
__device__ __forceinline__ void gemm_phase(PG8_LAS unsigned char* lds, const Gemm g, const Sched& S, const Epi& E, const int wave_id) {
    int lane_ = (int)__builtin_amdgcn_mbcnt_hi(~0u, __builtin_amdgcn_mbcnt_lo(~0u, 0u)); asm volatile("" : "+v"(lane_));
    const int wid = wave_id, lane = lane_, tid = wid * 64 + lane, wr = wid >> 2, wc = wid & 3, fr = lane & 15, fq = lane >> 4;
    const int K = g.K, nt = K / BK;
    unsigned voffA[2], voffB[2]; int RA[2], CA[2];
#pragma unroll
    for (int i = 0; i < 2; ++i) { int R, C; stage_rc(tid * 16 + i * 8192, R, C); const int Rb = Epi::PERM ? ((R & ~31) + perm32(R & 31)) : R; RA[i] = R; CA[i] = C;
        voffA[i] = (unsigned)(R * K + C) * 2u; voffB[i] = (unsigned)(Rb * K + C) * 2u; }
    const size_t kstep = (size_t)(BK * 2);
    const size_t hstep = (size_t)HALF * K * 2;
    const size_t tstep = 2 * hstep;
    const unsigned ldsw = (unsigned)wid * 1024u;
    const int aoff = lds_byte(wr * 64 + fr, fq * 8), boff = lds_byte(wc * 32 + fr, fq * 8);
    unsigned offC[2][2] = {{0u, 0u}, {0u, 0u}}, offN[2][2] = {{0u, 0u}, {0u, 0u}};
#define PG8_SA(b, h) (((b) * 2 + (h)) * HTB)
#define PG8_SB(b, h) ((4 + (b) * 2 + (h)) * HTB)
#define PG8_STAGE(bufoff, gbase, voff) do { _Pragma("unroll") for (int _i = 0; _i < 2; ++_i) \
        __builtin_amdgcn_global_load_lds((const unsigned*)((const char*)(gbase) + (voff)[_i]), (PG8_LAS unsigned*)(lds + (bufoff) + ldsw + _i * 8192), 16, 0, 0); } while (0)
#define PG8_STA(bufoff, ptr, h, NX) do { if constexpr (Sched::GATHER) { _Pragma("unroll") for (int _i = 0; _i < 2; ++_i) { const unsigned _o = (NX) ? offN[h][_i] : offC[h][_i]; \
        __builtin_amdgcn_global_load_lds((const unsigned*)((const char*)(ptr) + _o), (PG8_LAS unsigned*)(lds + (bufoff) + ldsw + _i * 8192), 16, 0, 0); } } \
        else { PG8_STAGE(bufoff, (ptr) + (h) * hstep, voffA); } } while (0)
#define PG8_LDA(dst, b, h) do { _Pragma("unroll") for (int m = 0; m < 4; ++m) _Pragma("unroll") for (int k = 0; k < 2; ++k) dst[m][k] = *(const PG8_LAS bf16x8*)(lds + PG8_SA(b, h) + aoff + m * 2048 + k * 1024); } while (0)
#define PG8_LDB(dst, b, h) do { _Pragma("unroll") for (int n = 0; n < 2; ++n) _Pragma("unroll") for (int k = 0; k < 2; ++k) dst[n][k] = *(const PG8_LAS bf16x8*)(lds + PG8_SB(b, h) + boff + n * 2048 + k * 1024); } while (0)
#define PG8_MMA(ai, bj, At, Bt) do { __builtin_amdgcn_s_setprio(1); _Pragma("unroll") for (int m = 0; m < 4; ++m) _Pragma("unroll") for (int n = 0; n < 2; ++n) _Pragma("unroll") for (int k = 0; k < 2; ++k) \
        acc[ai][bj][m][n] = __builtin_amdgcn_mfma_f32_16x16x32_bf16(Bt[n][k], At[m][k], acc[ai][bj][m][n], 0, 0, 0); __builtin_amdgcn_s_setprio(0); } while (0)
#define PG8_WAIT_V(n) asm volatile("s_waitcnt vmcnt(" #n ")" ::: "memory")
#define PG8_WAIT_L(n) asm volatile("s_waitcnt lgkmcnt(" #n ")" ::: "memory")
#define PG8_BAR __builtin_amdgcn_s_barrier()
#define PG8_SCHED __builtin_amdgcn_sched_barrier(0)
    Unit cur, nxt; int ui = 0;
    if (!S.next(0, cur)) return;
    f32x4 acc[2][2][4][2];
#pragma unroll
    for (int a = 0; a < 2; ++a)
#pragma unroll
        for (int b = 0; b < 2; ++b)
#pragma unroll
            for (int m = 0; m < 4; ++m)
#pragma unroll
                for (int n = 0; n < 2; ++n) acc[a][b][m][n] = (f32x4){0.f, 0.f, 0.f, 0.f};
    bf16x8 At[4][2], B0[2][2], B1[2][2];
    const char* cA = S.a_base(g, cur, tstep); const char* cB = S.b_base(g, cur, tstep);
    if constexpr (Sched::GATHER) S.a_rows(cur, RA[0], RA[1], CA[0], CA[1], K, offC);
    S.a_ready(cur);
    PG8_STAGE(PG8_SB(0, 0), cB, voffB); PG8_STAGE(PG8_SB(0, 1), cB + hstep, voffB); PG8_STA(PG8_SA(0, 0), cA, 0, false); PG8_STA(PG8_SA(0, 1), cA, 1, false);
    if (wr == 1) PG8_BAR;
    PG8_WAIT_V(2); PG8_BAR;
    PG8_STAGE(PG8_SB(1, 0), cB + kstep, voffB); PG8_STA(PG8_SA(1, 0), cA + kstep, 0, false); PG8_STAGE(PG8_SB(1, 1), cB + hstep + kstep, voffB);
    PG8_WAIT_V(6); PG8_BAR;
    for (;;) {
        const bool has_next = S.next(ui + 1, nxt);
        const char* nA = has_next ? S.a_base(g, nxt, tstep) : cA; const char* nB = has_next ? S.b_base(g, nxt, tstep) : cB;
        if constexpr (Sched::GATHER) { if (has_next) S.a_rows(nxt, RA[0], RA[1], CA[0], CA[1], K, offN); else {
#pragma unroll
            for (int h = 0; h < 2; ++h)
#pragma unroll
                for (int i = 0; i < 2; ++i) offN[h][i] = offC[h][i]; } }
        for (int t = 0; t < nt; t += 2) {
            const bool last = (t == nt - 2);
            const char* a1 = cA + (size_t)(t + 1) * kstep;
            const char* a2 = last ? nA : cA + (size_t)(t + 2) * kstep; const char* b2 = last ? nB : cB + (size_t)(t + 2) * kstep;
            const char* a3 = a2 + kstep; const char* b3 = b2 + kstep;
            if (last && has_next) S.a_ready(nxt);
            PG8_LDB(B0, 0, 0); PG8_LDB(B1, 0, 1); PG8_SCHED; PG8_LDA(At, 0, 0); PG8_STA(PG8_SA(1, 1), a1, 1, false);
            PG8_WAIT_V(8); PG8_WAIT_L(0); PG8_BAR; PG8_MMA(0, 0, At, B0); PG8_MMA(0, 1, At, B1); PG8_BAR; PG8_SCHED;
            PG8_LDA(At, 0, 1); PG8_STAGE(PG8_SB(0, 0), b2, voffB); PG8_STAGE(PG8_SB(0, 1), b2 + hstep, voffB); PG8_STA(PG8_SA(0, 0), a2, 0, last);
            PG8_WAIT_V(8); PG8_WAIT_L(0); PG8_BAR; PG8_MMA(1, 0, At, B0); PG8_MMA(1, 1, At, B1); PG8_BAR; PG8_SCHED;
            PG8_LDB(B0, 1, 0); PG8_LDB(B1, 1, 1); PG8_SCHED; PG8_LDA(At, 1, 0); PG8_STA(PG8_SA(0, 1), a2, 1, last);
            PG8_WAIT_V(8); PG8_WAIT_L(0); PG8_BAR; PG8_MMA(0, 0, At, B0); PG8_MMA(0, 1, At, B1); PG8_BAR; PG8_SCHED;
            PG8_LDA(At, 1, 1); PG8_STAGE(PG8_SB(1, 0), b3, voffB); PG8_STAGE(PG8_SB(1, 1), b3 + hstep, voffB); PG8_STA(PG8_SA(1, 0), a3, 0, last);
            PG8_WAIT_V(8); PG8_WAIT_L(0); PG8_BAR; PG8_MMA(1, 0, At, B0); PG8_MMA(1, 1, At, B1); PG8_BAR; PG8_SCHED;
        }
        if constexpr (ALIGN_EPI) { if (wr == 0) PG8_BAR; }
        E(acc, cur, wr, wc, fr, fq); S.done(cur);
        if (!has_next) break;
#pragma unroll
        for (int a = 0; a < 2; ++a)
#pragma unroll
            for (int b = 0; b < 2; ++b)
#pragma unroll
                for (int m = 0; m < 4; ++m)
#pragma unroll
                    for (int n = 0; n < 2; ++n) acc[a][b][m][n] = (f32x4){0.f, 0.f, 0.f, 0.f};
        cur = nxt; cA = nA; cB = nB; ++ui;
        if constexpr (Sched::GATHER) {
#pragma unroll
            for (int h = 0; h < 2; ++h)
#pragma unroll
                for (int i = 0; i < 2; ++i) offC[h][i] = offN[h][i]; }
        if constexpr (ALIGN_EPI) { if (wr == 1) PG8_BAR; }
    }
    PG8_WAIT_V(0);
    if constexpr (!ALIGN_EPI) { if (wr == 0) PG8_BAR; }
    PG8_BAR;
#undef PG8_SA
#undef PG8_SB
#undef PG8_STAGE
#undef PG8_STA
#undef PG8_LDA
#undef PG8_LDB
#undef PG8_MMA
#undef PG8_WAIT_V
#undef PG8_WAIT_L
#undef PG8_BAR
#undef PG8_SCHED
}
}
constexpr int NWAVES = 8;
constexpr size_t MiB = 1u << 20;
constexpr size_t WS_CTL = 0, CTL_ZERO_BYTES = 1 * MiB;
constexpr size_t WS_ROUTE = 1 * MiB;
constexpr size_t WS_LIST = 3 * MiB;
constexpr size_t WS_W = 8 * MiB;
constexpr size_t W_IN = 0, W_BRA = 12 * MiB, W_BRR = 14 * MiB, W_O = 16 * MiB, W_PG = 18 * MiB, W_PP = 20 * MiB, W_LRU = 21 * MiB, W_FF = 22 * MiB;
constexpr size_t W_FF_DN_DENSE = W_FF + 11 * MiB, W_FF_DN_MOE = W_FF + 112 * MiB;
constexpr size_t WS_XB = 208 * MiB;
constexpr size_t WS_IDX = 336 * MiB;
constexpr size_t WS_Z = 368 * MiB;
constexpr size_t Z_Q = WS_Z, Z_XR = WS_Z + 128 * MiB, Z_YR = WS_Z + 256 * MiB, Z_GA = WS_Z + 384 * MiB, Z_GR = WS_Z + 512 * MiB, Z_QI = WS_Z + 640 * MiB, Z_SM = WS_Z + 704 * MiB;
constexpr size_t WS_END = WS_Z + 736 * MiB;
constexpr size_t F_U = Z_Q;
constexpr size_t F_PB = Z_SM;
constexpr size_t F_H = Z_XR;
constexpr size_t F_H1 = WS_END;
constexpr size_t F_YE = Z_GA;
constexpr int MOE_CHUNK_TILES = 128;
constexpr size_t F_H_CHUNK_BYTES = (size_t)MOE_CHUNK_TILES * 256 * DFFE * 2;
constexpr size_t WS_NEED = F_H1 + F_H_CHUNK_BYTES;
static_assert(F_H + F_H_CHUNK_BYTES <= F_YE && F_YE + (size_t)520 * 256 * D * 2 <= Z_SM && F_H + (size_t)T_TOK * DFF * 2 <= Z_GR, "overlay map");
constexpr int CW_TMO = 0, CW_CODE = 1, CW_BAR = 4096, CW_CNT = 16384;
constexpr int RING_OFF = 0, RING_BYTES = 131072;
constexpr int LDSCTL_OFF = RING_BYTES, MISC_OFF = LDSCTL_OFF + 320;
constexpr int LDS_BYTES = 147456;

#define GAS __attribute__((address_space(1)))
#define LAS __attribute__((address_space(3)))
typedef unsigned short bf16;
typedef unsigned v4u __attribute__((ext_vector_type(4)));
typedef unsigned v2u __attribute__((ext_vector_type(2)));
typedef float f32x4 __attribute__((ext_vector_type(4)));
typedef float f32x16 __attribute__((ext_vector_type(16)));
typedef short bf16x8 __attribute__((ext_vector_type(8)));
typedef GAS unsigned gu32;
#define RLX_AGENT __ATOMIC_RELAXED, __HIP_MEMORY_SCOPE_AGENT
#define LDS_WAIT() asm volatile("s_waitcnt lgkmcnt(0)" ::: "memory")
#define VM_WAIT() asm volatile("s_waitcnt vmcnt(0)" ::: "memory")
using pg8::cvt_pk_bf16; using pg8::bf_lo; using pg8::bf_hi; using pg8::sigmoidf_fast;
#define XB_TMO      128
#define XB_XCNT(j)  (256  + 64 * (j))
#define XB_XSUB(j)  (1280 + 64 * (j))
#define XB_XGEN(j)  (2304 + 64 * (j))
#define XB_TOP      3328
#define XB_TOPGEN   3392
#define XCD_BAR_WORDS 3456
#define XB_SPIN_CAP (1u << 21)

__device__ __forceinline__ unsigned xb_ld(unsigned* p)              { return __hip_atomic_load(p, __ATOMIC_RELAXED, __HIP_MEMORY_SCOPE_AGENT); }
__device__ __forceinline__ unsigned xb_add(unsigned* p, unsigned v) { return __hip_atomic_fetch_add(p, v, __ATOMIC_RELAXED, __HIP_MEMORY_SCOPE_AGENT); }
__device__ __forceinline__ unsigned xb_xcc_id() { return (unsigned)__builtin_amdgcn_s_getreg((3 << 11) | 20) & 0xFu; }
#define XB_SPIN(cond, bar) do { unsigned _sp = 0; while (cond) { __builtin_amdgcn_s_sleep(1); \
    if ((++_sp & 255u) == 0u) { if (xb_ld(&(bar)[XB_TMO])) break; if (_sp > XB_SPIN_CAP) { atomicAdd(&(bar)[XB_TMO], 1u); break; } } } } while (0)

struct XcdBarrier {
    unsigned* bar; unsigned x;
    volatile LAS unsigned* st;
};

__device__ __forceinline__ XcdBarrier xcd_barrier_post(unsigned* bar, volatile LAS unsigned* st) {
    XcdBarrier b; b.bar = bar; b.x = xb_xcc_id(); b.st = st;
    if (threadIdx.x == 0) (void)xb_add(&bar[XB_XCNT(b.x)], 1u);
    return b;
}
__device__ __forceinline__ void xcd_barrier_complete(unsigned* bar, unsigned x, unsigned& nloc, unsigned& nx) {
    const unsigned G = gridDim.x * gridDim.y * gridDim.z;
    unsigned sum, cnt, mine, sp = 0u;
    for (;;) {
        sum = 0u; cnt = 0u; mine = 0u;
#pragma unroll
        for (unsigned j = 0; j < 16; ++j) { const unsigned c = xb_ld(&bar[XB_XCNT(j)]); sum += c; cnt += (c > 0u) ? 1u : 0u; mine = (j == x) ? c : mine; }
        if (sum == G) break;
        __builtin_amdgcn_s_sleep(1);
        if ((++sp & 255u) == 0u) { if (xb_ld(&bar[XB_TMO])) break; if (sp > XB_SPIN_CAP) { atomicAdd(&bar[XB_TMO], 1u); break; } }
    }
    nloc = mine > 0u ? mine : 1u; nx = cnt > 0u ? cnt : 1u;
}

__device__ __forceinline__ void xcd_barrier(const XcdBarrier& b) {
    asm volatile("s_waitcnt vmcnt(0)" ::: "memory");
    __syncthreads();
    if (threadIdx.x == 0) {
        unsigned* bar = b.bar;
        __builtin_amdgcn_s_waitcnt(0);
        unsigned nloc = b.st[0], nx = b.st[1];
        if (nloc == 0u) { xcd_barrier_complete(bar, b.x, nloc, nx); b.st[0] = nloc; b.st[1] = nx; }
        const unsigned old = xb_add(&bar[XB_XSUB(b.x)], 1u);
        const unsigned gen = old / nloc;
        if (old + 1u == (gen + 1u) * nloc) {
            __builtin_amdgcn_fence(__ATOMIC_RELEASE, "agent");
            asm volatile("s_waitcnt vmcnt(0)" ::: "memory");
            const unsigned og = xb_add(&bar[XB_TOP], 1u);
            const unsigned tg = og / nx;
            if (og + 1u == (tg + 1u) * nx) xb_add(&bar[XB_TOPGEN], 1u);
            else XB_SPIN(xb_ld(&bar[XB_TOPGEN]) == tg, bar);
            __builtin_amdgcn_fence(__ATOMIC_ACQUIRE, "agent");
            xb_add(&bar[XB_XGEN(b.x)], 1u);
            asm volatile("s_waitcnt vmcnt(0)" ::: "memory");
        } else {
            XB_SPIN(xb_ld(&bar[XB_XGEN(b.x)]) == gen, bar);
            __builtin_amdgcn_fence(__ATOMIC_ACQUIRE, "agent");
            asm volatile("s_waitcnt vmcnt(0)" ::: "memory");
        }
    }
    __syncthreads();
}
struct Frame {
    LAS unsigned char* lds;
    volatile LAS unsigned* MISC;
    gu32* ctl;
    int tid, lane, wave, G, bx;
    unsigned char* ws;
    float* out;
};
struct Args { const float* in[28]; float* out; unsigned char* ws; };
typedef const __attribute__((address_space(4))) Args* KArgs;
__device__ __forceinline__ KArgs kargs() { KArgs k = (KArgs)__builtin_amdgcn_kernarg_segment_ptr(); asm volatile("" : "+s"(k)); return k; }
enum { I_X = 0, I_P, I_WIN, I_CONVW, I_CONVB, I_LRUWA, I_LRUBA, I_LRUWX, I_LRUBX, I_LAM, I_WBRA, I_WBRR, I_WO, I_RELB, I_LN1G, I_LN1B, I_FFG, I_FFU, I_FFD, I_ROUTER, I_ROUTERB, I_MOEG, I_MOEU, I_MOED, I_PLEG, I_PLEP, I_LN2G, I_LN2B };

__device__ __forceinline__ Frame launder(const Frame& F0) { Frame F = F0; unsigned char* w = F0.ws; int l = (int)__builtin_amdgcn_mbcnt_hi(~0u, __builtin_amdgcn_mbcnt_lo(~0u, 0u)); asm volatile("" : "+s"(w)); asm volatile("" : "+v"(l));
    F.ws = w; F.lane = l; F.tid = F0.wave * 64 + l; F.ctl = (gu32*)(w + WS_CTL); return F; }
__device__ __forceinline__ float lane_get(float v, int src_lane) { return __builtin_bit_cast(float, __builtin_amdgcn_ds_bpermute(src_lane << 2, __builtin_bit_cast(int, v))); }
__device__ __forceinline__ float lane_xor(float v, int mask, int lane) { return lane_get(v, lane ^ mask); }
__device__ __forceinline__ float lane_up(float v, int d, int lane) { return lane_get(v, lane >= d ? lane - d : lane); }
__device__ __forceinline__ float wave_sum(float v, int lane) {
#pragma unroll
    for (int o = 1; o < 64; o <<= 1) v += lane_xor(v, o, lane);
    return v;
}
__device__ __forceinline__ unsigned pk2(float lo, float hi) { return cvt_pk_bf16(lo, hi); }

__device__ __forceinline__ void cvt_item(const float* W, int ldw, int K, bf16* WT, int d0, int sc0, int nvalid, float scale, int k0, LAS float* scr, int lane) {
    const int n = lane & 31;
#pragma unroll 8
    for (int i = 0; i < 32; ++i) { const int kk = 2 * i + (lane >> 5); float v = 0.f; if (n < nvalid) v = ((const GAS float*)W)[(size_t)(k0 + kk) * ldw + sc0 + n] * scale; scr[kk * 33 + n] = v; }
    LDS_WAIT(); asm volatile("" ::: "memory");
    const int c = lane & 7;
#pragma unroll
    for (int j = 0; j < 4; ++j) { const int nn = (lane >> 3) + 8 * j; const LAS float* s = scr + (8 * c) * 33 + nn;
        v4u o; o.x = pk2(s[0 * 33], s[1 * 33]); o.y = pk2(s[2 * 33], s[3 * 33]); o.z = pk2(s[4 * 33], s[5 * 33]); o.w = pk2(s[6 * 33], s[7 * 33]);
        *(GAS v4u*)(WT + (size_t)(d0 + nn) * K + k0 + 8 * c) = o; }
    LDS_WAIT(); asm volatile("" ::: "memory");
}
__device__ __forceinline__ void cvt_plain(const float* W, int K, int N, bf16* WT, int item, LAS float* scr, int lane) {
    const int nblk = N / 32, kb = item / nblk, nb = item % nblk;
    cvt_item(W, N, K, WT, 32 * nb, 32 * nb, 32, 1.0f, 64 * kb, scr, lane);
}
__device__ __forceinline__ void cvt_gateup(const float* Wg, const float* Wu, int dff, bf16* WT, int item, LAS float* scr, int lane) {
    const int nblk = 2 * dff / 32, kb = item / nblk, db = item % nblk, d0 = 32 * db, pn = d0 >> 8, r = d0 & 255;
    const float* W = r < 128 ? Wg : Wu; const int sc0 = 128 * pn + (r & 127);
    cvt_item(W, dff, D, WT, d0, sc0, 32, 1.0f, 64 * kb, scr, lane);
}
__device__ __forceinline__ void cvt_win(const float* W, bf16* WT, int item, LAS float* scr, int lane) {
    const int nblk = NIN / 32, kb = item / nblk, db = item % nblk, d0 = 32 * db;
    int sc0, nv = 32; float sc = 1.0f;
    if (d0 < 1024) { sc0 = d0; sc = 0.125f; }
    else if (d0 < 2048) sc0 = 1736 + (d0 - 1024);
    else if (d0 < 3072) sc0 = 2760 + (d0 - 2048);
    else if (d0 < 4096) sc0 = 3784 + (d0 - 3072);
    else if (d0 < 5120) sc0 = 4808 + (d0 - 4096);
    else if (d0 < 5632) sc0 = 1152 + (d0 - 5120);
    else if (d0 < 5696) sc0 = 1024 + (d0 - 5632);
    else if (d0 < 5760) sc0 = 1088 + (d0 - 5696);
    else if (d0 < 5824) sc0 = 1664 + (d0 - 5760);
    else if (d0 == 5824) { sc0 = 1728; nv = 8; }
    else { sc0 = 0; nv = 0; }
    cvt_item(W, D_IN, D, WT, d0, sc0, nv, sc, 64 * kb, scr, lane);
}
__device__ __forceinline__ void p0_convert(const Frame& F0, int L) {
    Frame F = launder(F0);
    const KArgs ka = kargs();
    LAS float* scr = (LAS float*)(F.lds + RING_OFF + F.wave * 16384);
    const int gw = F.bx * NWAVES + F.wave, NGW = F.G * NWAVES;
    unsigned char* wb = F.ws + WS_W;
    const int odd = L & 1, jj = L >> 1;
    constexpr int I_IN = (D / 64) * (NIN / 32), I_SQ = (D / 64) * (D / 32), I_PPJ = (PLE / 64) * (D / 32), I_LRU1 = 2 * 4;
    constexpr int I_GU_D = (D / 64) * (2 * DFF / 32), I_DN_D = (DFF / 64) * (D / 32), I_GU_E = (D / 64) * (2 * DFFE / 32), I_DN_E = (DFFE / 64) * (D / 32);
    const int n_ff = odd ? NEXP * (I_GU_E + I_DN_E) : (I_GU_D + I_DN_D);
    const int NITEMS = I_IN + 4 * I_SQ + I_PPJ + 16 * I_LRU1 + n_ff;
    for (int it = gw; it < NITEMS; it += NGW) {
        int r = it;
        if (r < I_IN) { cvt_win(ka->in[I_WIN] + (size_t)L * D * D_IN, (bf16*)(wb + W_IN), r, scr, F.lane); continue; } r -= I_IN;
        if (r < I_SQ) { cvt_plain(ka->in[I_WBRA] + (size_t)L * D * D, D, D, (bf16*)(wb + W_BRA), r, scr, F.lane); continue; } r -= I_SQ;
        if (r < I_SQ) { cvt_plain(ka->in[I_WBRR] + (size_t)L * D * D, D, D, (bf16*)(wb + W_BRR), r, scr, F.lane); continue; } r -= I_SQ;
        if (r < I_SQ) { cvt_plain(ka->in[I_WO] + (size_t)L * D * D, D, D, (bf16*)(wb + W_O), r, scr, F.lane); continue; } r -= I_SQ;
        if (r < I_SQ) { cvt_plain(ka->in[I_PLEG] + (size_t)L * D * D, D, D, (bf16*)(wb + W_PG), r, scr, F.lane); continue; } r -= I_SQ;
        if (r < I_PPJ) { cvt_plain(ka->in[I_PLEP] + (size_t)L * PLE * D, PLE, D, (bf16*)(wb + W_PP), r, scr, F.lane); continue; } r -= I_PPJ;
        if (r < 16 * I_LRU1) { const int m = r / I_LRU1, blk = m & 7, which = m >> 3;
            const float* src = ka->in[which ? I_LRUWX : I_LRUWA] + (size_t)L * 8 * 128 * 128 + (size_t)blk * 128 * 128;
            cvt_plain(src, 128, 128, (bf16*)(wb + W_LRU) + (size_t)which * 8 * 128 * 128 + (size_t)blk * 128 * 128, r % I_LRU1, scr, F.lane); continue; } r -= 16 * I_LRU1;
        if (!odd) {
            if (r < I_GU_D) { cvt_gateup(ka->in[I_FFG] + (size_t)jj * D * DFF, ka->in[I_FFU] + (size_t)jj * D * DFF, DFF, (bf16*)(wb + W_FF), r, scr, F.lane); continue; } r -= I_GU_D;
            cvt_plain(ka->in[I_FFD] + (size_t)jj * DFF * D, DFF, D, (bf16*)(wb + W_FF_DN_DENSE), r, scr, F.lane);
        } else {
            if (r < NEXP * I_GU_E) { const int e = r / I_GU_E; const size_t eo = ((size_t)jj * NEXP + e) * D * DFFE;
                cvt_gateup(ka->in[I_MOEG] + eo, ka->in[I_MOEU] + eo, DFFE, (bf16*)(wb + W_FF) + (size_t)e * 2 * DFFE * D, r % I_GU_E, scr, F.lane); continue; } r -= NEXP * I_GU_E;
            const int e = r / I_DN_E; const size_t eo = ((size_t)jj * NEXP + e) * DFFE * D;
            cvt_plain(ka->in[I_MOED] + eo, DFFE, D, (bf16*)(wb + W_FF_DN_MOE) + (size_t)e * D * DFFE, r % I_DN_E, scr, F.lane);
        }
    }
    if (L == 0) {
        const GAS f32x4* x4 = (const GAS f32x4*)ka->in[I_X]; GAS v4u* o = (GAS v4u*)(F.ws + WS_XB);
        const size_t n8 = (size_t)T_TOK * D / 8;
        for (size_t i = (size_t)F.bx * 512 + F.tid; i < n8; i += (size_t)F.G * 512) { const f32x4 a = x4[2 * i], b = x4[2 * i + 1];
            v4u w; w.x = pk2(a[0], a[1]); w.y = pk2(a[2], a[3]); w.z = pk2(b[0], b[1]); w.w = pk2(b[2], b[3]); o[i] = w; }
    }
}

template <bool LN2, bool ODD, bool DRY = false>
__device__ __forceinline__ void ln_phase(const Frame& F0, int L) {
    Frame F = launder(F0);
    const KArgs ka = kargs();
    const int jj = L >> 1;
    float* X32 = F.out; bf16* XB = (bf16*)(F.ws + WS_XB);
    const float* gam = ka->in[LN2 ? I_LN2G : I_LN1G] + (size_t)L * D; const float* bet = ka->in[LN2 ? I_LN2B : I_LN1B] + (size_t)L * D;
    f32x4 gv[4], bv[4];
#pragma unroll
    for (int j = 0; j < 4; ++j) { gv[j] = ((const GAS f32x4*)gam)[F.lane + 64 * j]; bv[j] = ((const GAS f32x4*)bet)[F.lane + 64 * j]; }
    LAS float* RT = (LAS float*)(F.lds + RING_OFF);
    LAS unsigned* TE = (LAS unsigned*)(F.lds + RING_OFF + 32768);
    volatile LAS unsigned* lcnt = F.MISC + 48; volatile LAS unsigned* gbase = F.MISC + 56;
    float rb[8];
    if (!LN2 && ODD) {
        const float* R = ka->in[I_ROUTER] + (size_t)jj * D * NEXP;
        for (int i = F.tid; i < D * NEXP; i += 512) RT[i] = R[i];
        if (F.tid < 8) lcnt[F.tid] = 0u;
#pragma unroll
        for (int e = 0; e < 8; ++e) rb[e] = ka->in[I_ROUTERB][jj * NEXP + e];
        __syncthreads();
    }
    const unsigned* route = (const unsigned*)(F.ws + WS_ROUTE);
    const bf16* YE = (const bf16*)(F.ws + F_YE);
    for (int it = 0; it < 32; ++it) {
        const int rl = F.wave + 8 * it; const size_t row = (size_t)F.bx * 256 + rl;
        GAS f32x4* xr = (GAS f32x4*)(X32 + row * D) + F.lane;
        f32x4 v[4]; float s = 0.f;
#pragma unroll
        for (int j = 0; j < 4; ++j) v[j] = xr[64 * j];
        if (LN2 && ODD) {
            const unsigned e1 = route[row * 8 + 0], e2 = route[row * 8 + 1], p1 = route[row * 8 + 2], p2 = route[row * 8 + 3];
            const float g1 = __builtin_bit_cast(float, route[row * 8 + 4]), g2 = __builtin_bit_cast(float, route[row * 8 + 5]);
            const size_t r1 = (size_t)F.MISC[16 + e1] * 256 + p1, r2 = (size_t)F.MISC[16 + e2] * 256 + p2;
            const GAS v2u* y1 = (const GAS v2u*)(YE + r1 * D) + F.lane; const GAS v2u* y2 = (const GAS v2u*)(YE + r2 * D) + F.lane;
#pragma unroll
            for (int j = 0; j < 4; ++j) { const v2u a = y1[64 * j], b = y2[64 * j];
                v[j][0] += g1 * bf_lo(a.x) + g2 * bf_lo(b.x); v[j][1] += g1 * bf_hi(a.x) + g2 * bf_hi(b.x);
                v[j][2] += g1 * bf_lo(a.y) + g2 * bf_lo(b.y); v[j][3] += g1 * bf_hi(a.y) + g2 * bf_hi(b.y); }
        }
#pragma unroll
        for (int j = 0; j < 4; ++j) s += (v[j][0] + v[j][1]) + (v[j][2] + v[j][3]);
        const float mean = wave_sum(s, F.lane) * (1.f / D); float s2 = 0.f;
#pragma unroll
        for (int j = 0; j < 4; ++j) { v[j] = v[j] - mean; s2 += (v[j][0] * v[j][0] + v[j][1] * v[j][1]) + (v[j][2] * v[j][2] + v[j][3] * v[j][3]); }
        const float rstd = 1.f / sqrtf(wave_sum(s2, F.lane) * (1.f / D) + LN_EPS);
        GAS v2u* o8 = (GAS v2u*)((DRY ? (bf16*)(F.ws + WS_NEED) : XB) + row * D) + F.lane;
        GAS f32x4* xw = DRY ? (GAS f32x4*)((float*)(F.ws + WS_NEED) + row * D) + F.lane : xr;
#pragma unroll
        for (int j = 0; j < 4; ++j) { v[j] = v[j] * rstd * gv[j] + bv[j]; xw[64 * j] = v[j]; v2u w; w.x = pk2(v[j][0], v[j][1]); w.y = pk2(v[j][2], v[j][3]); o8[64 * j] = w; }
        if (!LN2) {
            const f32x4 pv = ((const GAS f32x4*)(ka->in[I_P] + ((size_t)L * T_TOK + row) * PLE))[F.lane];
            v2u w; w.x = pk2(pv[0], pv[1]); w.y = pk2(pv[2], pv[3]); ((GAS v2u*)(F.ws + (DRY ? WS_NEED : F_PB) + row * PLE * 2))[F.lane] = w;
        }
        if (!LN2 && ODD) {
            float lg[8];
#pragma unroll
            for (int e = 0; e < 8; ++e) lg[e] = 0.f;
#pragma unroll
            for (int j = 0; j < 4; ++j)
#pragma unroll
                for (int q = 0; q < 4; ++q) { const int c = 4 * F.lane + 256 * j + q; const f32x4 ra = *(const LAS f32x4*)(RT + c * 8), rc = *(const LAS f32x4*)(RT + c * 8 + 4); const float xv = v[j][q];
                    lg[0] += xv * ra[0]; lg[1] += xv * ra[1]; lg[2] += xv * ra[2]; lg[3] += xv * ra[3]; lg[4] += xv * rc[0]; lg[5] += xv * rc[1]; lg[6] += xv * rc[2]; lg[7] += xv * rc[3]; }
#pragma unroll
            for (int e = 0; e < 8; ++e) lg[e] = wave_sum(lg[e], F.lane) + rb[e];
            int e1 = 0; float v1 = lg[0];
#pragma unroll
            for (int e = 1; e < 8; ++e) if (lg[e] > v1) { v1 = lg[e]; e1 = e; }
            int e2 = -1; float v2 = 0.f;
#pragma unroll
            for (int e = 0; e < 8; ++e) if (e != e1 && (e2 < 0 || lg[e] > v2)) { v2 = lg[e]; e2 = e; }
            const float ex = __expf(v2 - v1), g1 = 1.f / (1.f + ex), g2 = ex * g1;
            if (F.lane == 0) { const unsigned lp1 = __hip_atomic_fetch_add((LAS unsigned*)lcnt + e1, 1u, __ATOMIC_RELAXED, __HIP_MEMORY_SCOPE_WORKGROUP), lp2 = __hip_atomic_fetch_add((LAS unsigned*)lcnt + e2, 1u, __ATOMIC_RELAXED, __HIP_MEMORY_SCOPE_WORKGROUP);
                TE[rl * 4 + 0] = (unsigned)e1 | ((unsigned)e2 << 8) | (lp1 << 16); TE[rl * 4 + 1] = lp2; TE[rl * 4 + 2] = __builtin_bit_cast(unsigned, g1); TE[rl * 4 + 3] = __builtin_bit_cast(unsigned, g2); }
        }
    }
    if (!LN2 && ODD) {
        __syncthreads();
        if (F.tid < 8) gbase[F.tid] = __hip_atomic_fetch_add(F.ctl + CW_CNT + jj * 1024 + 64 * F.tid, lcnt[F.tid], RLX_AGENT);
        __syncthreads();
        if (F.tid < 256) { const unsigned w0 = TE[F.tid * 4], lp2 = TE[F.tid * 4 + 1]; const unsigned e1 = w0 & 255u, e2 = (w0 >> 8) & 255u, lp1 = w0 >> 16;
            const unsigned p1 = gbase[e1] + lp1, p2 = gbase[e2] + lp2; const unsigned tok = (unsigned)F.bx * 256 + F.tid;
            GAS int* list = (GAS int*)(F.ws + WS_LIST); list[(size_t)e1 * T_TOK + p1] = (int)tok; list[(size_t)e2 * T_TOK + p2] = (int)tok;
            GAS v4u* ro = (GAS v4u*)(F.ws + WS_ROUTE) + (size_t)tok * 2; v4u a; a.x = e1; a.y = e2; a.z = p1; a.w = p2; ro[0] = a; v4u b; b.x = TE[F.tid * 4 + 2]; b.y = TE[F.tid * 4 + 3]; b.z = 0u; b.w = 0u; ro[1] = b; }
        __syncthreads();
    }
}
template <int NJ>
__device__ __forceinline__ void select_topk_n(LAS const float* sc, int n_adm, GAS unsigned short* out, int lane) {
    const int nj = n_adm >> 6;
    unsigned u[NJ];
#pragma unroll
    for (int j = 0; j < NJ; ++j) { unsigned b = 0u;
        if (j < NJ - 8 || j < nj) { b = __builtin_bit_cast(unsigned, sc[64 * j + lane]); b = (b == 0x80000000u) ? 0u : b; b = (b & 0x80000000u) ? ~b : (b | 0x80000000u); }
        u[j] = b; }
    unsigned prefix = 0u; bool exact = false;
    for (int bit = 31; bit >= 0; --bit) {
        const unsigned cand = prefix | (1u << bit); int cnt = 0;
#pragma unroll
        for (int j = 0; j < NJ; ++j) cnt += __popcll(__ballot(u[j] >= cand));
        if (cnt >= 256) { prefix = cand; if (cnt == 256) { exact = true; break; } }
    }
    const unsigned thr = exact ? prefix - 1u : prefix;
    int ngt = 0;
#pragma unroll
    for (int j = 0; j < NJ; ++j) ngt += __popcll(__ballot(u[j] > thr));
    const int quota = 256 - ngt;
    int obase = 0, tbase = 0; const unsigned long long lt = (1ull << lane) - 1ull;
#pragma unroll
    for (int j = 0; j < NJ; ++j) {
        const bool gt = u[j] > thr, eq = u[j] == thr;
        const unsigned long long meq = __ballot(eq);
        const bool seleq = eq && (tbase + __popcll(meq & lt) < quota);
        const unsigned long long msel = __ballot(gt || seleq);
        if (gt || seleq) out[obase + __popcll(msel & lt)] = (unsigned short)(64 * j + lane);
        obase += __popcll(msel); tbase += __popcll(meq);
    }
}
__device__ __forceinline__ void select_topk(LAS const float* sc, int n_adm, GAS unsigned short* out, int lane) {
    if (n_adm <= 256) {
#pragma unroll
        for (int j = 0; j < 4; ++j) { const int p = lane + 64 * j; out[p] = (unsigned short)(p < n_adm ? p : 0); }
        return;
    }
    if (n_adm <= 512) select_topk_n<8>(sc, n_adm, out, lane);
    else if (n_adm <= 1024) select_topk_n<16>(sc, n_adm, out, lane);
    else if (n_adm <= 1536) select_topk_n<24>(sc, n_adm, out, lane);
    else select_topk_n<32>(sc, n_adm, out, lane);
}
__device__ __forceinline__ void indexer_phase(const Frame& F0) {
    Frame F = launder(F0);
    LAS float* sc = (LAS float*)(F.lds + RING_OFF);
    const bf16* QI = (const bf16*)(F.ws + Z_QI); const bf16* SM = (const bf16*)(F.ws + Z_SM);
    GAS unsigned short* IDX = (GAS unsigned short*)(F.ws + WS_IDX);
    const int lane = F.lane, h = lane >> 5, r = lane & 31;
    const int rq = 2 * ((r >> 2) & 1) + ((r >> 4) & 1), rh = (r & 3) + 4 * ((r >> 3) & 1);
    const int vcu = (F.bx & 7) * (F.G >> 3) + (F.bx >> 3);
    bf16x8 A[4][4]; v4u wq[4][2];
#define IDX_TILE(pi_, b_, tq_) const int pid_ = vcu * 8 + ((pi_) >> 1), b_ = pid_ >> 6, jp_ = pid_ & 63, tq_ = 16 * (((pi_) & 1) ? 127 - jp_ : jp_)
#define IDX_LOAD_A(t0_) do { _Pragma("unroll") for (int mt = 0; mt < 4; ++mt) { \
        _Pragma("unroll") for (int s = 0; s < 4; ++s) A[mt][s] = *(const GAS bf16x8*)(QI + (size_t)((t0_) + 4 * mt + rq) * 512 + rh * 64 + 16 * s + 8 * h); \
        _Pragma("unroll") for (int qq = 0; qq < 2; ++qq) wq[mt][qq] = *(const GAS v4u*)(SM + (size_t)((t0_) + 4 * mt + 2 * h + qq) * 256 + 192); } } while (0)
    { IDX_TILE(0, b0, tq0); if (tq0 >= 256) IDX_LOAD_A(b0 * SEQ + tq0); }
    for (int pi = 0; pi < 16; ++pi) {
        IDX_TILE(pi, b, tq);
        const int t0 = b * SEQ + tq;
        const int n_adm = ((tq >> 6) + 1) * 64, nkb = n_adm >> 5;
        if (n_adm > 256) {
            bf16x8 B[4], Bn[4];
#pragma unroll
            for (int s = 0; s < 4; ++s) B[s] = *(const GAS bf16x8*)(SM + (size_t)(b * SEQ + 32 * F.wave + r) * 256 + 128 + 16 * s + 8 * h);
            for (int kb = F.wave; kb < nkb; kb += 8) {
                const int key = 32 * kb + r;
                const int keyn = (kb + 8 < nkb) ? key + 256 : key;
#pragma unroll
                for (int s = 0; s < 4; ++s) Bn[s] = *(const GAS bf16x8*)(SM + (size_t)(b * SEQ + keyn) * 256 + 128 + 16 * s + 8 * h);
#pragma unroll
                for (int mt = 0; mt < 4; ++mt) {
                    f32x16 acc;
#pragma unroll
                    for (int i = 0; i < 16; ++i) acc[i] = 0.f;
#pragma unroll
                    for (int s = 0; s < 4; ++s) acc = __builtin_amdgcn_mfma_f32_32x32x16_bf16(A[mt][s], B[s], acc, 0, 0, 0);
                    float sA = 0.f, sB = 0.f;
#pragma unroll
                    for (int i = 0; i < 8; ++i) { const unsigned wa = wq[mt][0][i >> 1], wb = wq[mt][1][i >> 1];
                        const float fa = (i & 1) ? bf_hi(wa) : bf_lo(wa), fb = (i & 1) ? bf_hi(wb) : bf_lo(wb);
                        sA += fmaxf(acc[i], 0.f) * fa; sB += fmaxf(acc[8 + i], 0.f) * fb; }
                    sc[(4 * mt + 2 * h) * 2048 + key] = sA; sc[(4 * mt + 2 * h + 1) * 2048 + key] = sB;
                }
#pragma unroll
                for (int s = 0; s < 4; ++s) B[s] = Bn[s];
            }
        }
        __syncthreads();
        if (pi < 15) { IDX_TILE(pi + 1, bn, tqn); if (tqn >= 256) IDX_LOAD_A(bn * SEQ + tqn); }
#pragma unroll 1
        for (int qq = 0; qq < 2; ++qq) { const int q = 2 * F.wave + qq; select_topk(sc + q * 2048, n_adm, IDX + (size_t)(t0 + q) * 256, lane); }
        __syncthreads();
    }
#undef IDX_TILE
#undef IDX_LOAD_A
}

__device__ __forceinline__ unsigned vst_off(unsigned r, unsigned ch) { return r * 128u + 16u * (ch ^ ((((r >> 1) ^ (r >> 4)) & 1u) << 1) ^ (((r >> 3) & 1u) << 2)); }
__device__ __forceinline__ int t5_bucket_dev(int rel) {
    const int n = rel < 0 ? -rel : rel;
    int v = n;
    if (n >= 8) v = 8 + (n >= 12) + (n >= 16) + (n >= 23) + (n >= 32) + (n >= 46) + (n >= 64) + (n >= 91);
    return v + (rel > 0 ? 16 : 0);
}
#ifndef ATT_REPS
#define ATT_REPS 1
#endif
#ifndef ATT_FIXKEYS
#define ATT_FIXKEYS 0
#endif
template <int FIX = 0>
__device__ __forceinline__ void attention_phase(const Frame& F0) {
#pragma unroll 1
    for (int rep = 0; rep < ATT_REPS; ++rep) {
    Frame F = launder(F0);
    const bf16* SM = (const bf16*)(F.ws + Z_SM); const bf16* Q = (const bf16*)(F.ws + Z_Q); bf16* OB = (bf16*)(F.ws + Z_XR);
    const GAS unsigned short* IDX = (const GAS unsigned short*)(F.ws + WS_IDX);
    const int lane = F.lane, g = lane >> 4, m = lane & 15;
    LAS unsigned char* vst = F.lds + RING_OFF + F.wave * 4096;
    const unsigned vbase = (unsigned)(size_t)vst;
    LAS unsigned char* BK = F.lds + RING_OFF + 32768; LAS unsigned char* OH = F.lds + RING_OFF + 32768 + 2176;
    for (int i = F.tid; i < 2112; i += 512) BK[i] = (unsigned char)t5_bucket_dev(i - 2047);
    if (F.tid < 128) { const int bkt = F.tid >> 2, gg = F.tid & 3, j = bkt - 8 * gg; v4u oh; oh.x = oh.y = oh.z = oh.w = 0u;
        if (j >= 0 && j < 8) { const unsigned val = (j & 1) ? 0x3F800000u : 0x3F80u; if ((j >> 1) == 0) oh.x = val; else if ((j >> 1) == 1) oh.y = val; else if ((j >> 1) == 2) oh.z = val; else oh.w = val; }
        *(LAS v4u*)(OH + F.tid * 16) = oh; }
    __syncthreads();
    bf16x8 bb;
    { const float* rbias = kargs()->in[I_RELB]; unsigned w[4];
#pragma unroll
      for (int j = 0; j < 4; ++j) w[j] = pk2(rbias[(8 * g + 2 * j) * 16 + m], rbias[(8 * g + 2 * j + 1) * 16 + m]);
      v4u t; t.x = w[0]; t.y = w[1]; t.z = w[2]; t.w = w[3]; bb = __builtin_bit_cast(bf16x8, t); }
    unsigned tra[4][2];
    { const unsigned q = (lane & 15) >> 2, p = lane & 3;
#pragma unroll
      for (int c = 0; c < 4; ++c)
#pragma unroll
        for (int t = 0; t < 2; ++t) tra[c][t] = vst_off(8 * g + 4 * t + q, 2 * c + (p >> 1)) + 8 * (p & 1); }
    const int vcu = (F.bx & 7) * (F.G >> 3) + (F.bx >> 3);
    v4u ni0, ni1; bf16x8 nq[2]; bf16x8 ka[16][2]; unsigned koff[16];
#define ATT_KOFF(i0_, i1_) do { _Pragma("unroll") for (int k = 0; k < 4; ++k) { koff[2 * k] = ((i0_)[k] & 0xffffu) * 512u + 16u * g; koff[2 * k + 1] = ((i0_)[k] >> 16) * 512u + 16u * g; \
        koff[8 + 2 * k] = ((i1_)[k] & 0xffffu) * 512u + 16u * g; koff[8 + 2 * k + 1] = ((i1_)[k] >> 16) * 512u + 16u * g; } } while (0)
#define ATT_KLOAD(kvb_) do { const GAS char* kb_ = (kvb_); _Pragma("unroll") for (int T = 0; T < 16; ++T) { \
        asm volatile("global_load_dwordx4 %0, %2, %3\n\tglobal_load_dwordx4 %1, %2, %3 offset:64" : "=&v"(ka[T][0]), "=&v"(ka[T][1]) : "v"(koff[T]), "s"(kb_) : "memory"); } } while (0)
#define ATT_KWAIT(n_, T0_) asm volatile("s_waitcnt vmcnt(" #n_ ")" : "+v"(ka[T0_][0]), "+v"(ka[T0_][1]), "+v"(ka[T0_ + 1][0]), "+v"(ka[T0_ + 1][1]), "+v"(ka[T0_ + 2][0]), "+v"(ka[T0_ + 2][1]), "+v"(ka[T0_ + 3][0]), "+v"(ka[T0_ + 3][1]), \
        "+v"(ka[T0_ + 4][0]), "+v"(ka[T0_ + 4][1]), "+v"(ka[T0_ + 5][0]), "+v"(ka[T0_ + 5][1]), "+v"(ka[T0_ + 6][0]), "+v"(ka[T0_ + 6][1]), "+v"(ka[T0_ + 7][0]), "+v"(ka[T0_ + 7][1]) :: "memory")
    { const int tok0 = vcu * 256 + F.wave; const GAS v4u* ip = (const GAS v4u*)(IDX + (size_t)tok0 * 256 + 16 * m); ni0 = ip[0]; ni1 = ip[1];
#pragma unroll
      for (int s = 0; s < 2; ++s) nq[s] = *(const GAS bf16x8*)(Q + (size_t)tok0 * D + m * 64 + 32 * s + 8 * g);
      ATT_KOFF(ni0, ni1); ATT_KLOAD((const GAS char*)(SM + (size_t)(tok0 >> 11) * SEQ * 256)); }
    for (int it = 0; it < 32; ++it) {
        const int tok = vcu * 256 + F.wave + 8 * it, b = tok >> 11, tq = tok & (SEQ - 1);
        const int n_valid = (((tq >> 6) + 1) * 64) < 256 ? ((tq >> 6) + 1) * 64 : 256;
        bf16x8 qf[2]; qf[0] = nq[0]; qf[1] = nq[1];
        const GAS char* kvb = (const GAS char*)(SM + (size_t)b * SEQ * 256);
        f32x4 S[16];
#pragma unroll
        for (int T = 0; T < 16; ++T) {
            if (T == 0) ATT_KWAIT(16, 0);
            if (T == 8) ATT_KWAIT(0, 8);
            const unsigned bkt = BK[(koff[T] >> 9) + (2047 - tq)];
            const v4u oh = *(const LAS v4u*)(OH + bkt * 64 + g * 16);
            f32x4 a = (f32x4){0.f, 0.f, 0.f, 0.f};
            a = __builtin_amdgcn_mfma_f32_16x16x32_bf16(__builtin_bit_cast(bf16x8, oh), bb, a, 0, 0, 0);
            a = __builtin_amdgcn_mfma_f32_16x16x32_bf16(ka[T][0], qf[0], a, 0, 0, 0);
            a = __builtin_amdgcn_mfma_f32_16x16x32_bf16(ka[T][1], qf[1], a, 0, 0, 0);
            S[T] = a;
        }
        __builtin_amdgcn_sched_barrier(0);
        v4u vv[16][2];
#pragma unroll
        for (int T = 0; T < 12; ++T) { vv[T][0] = *(const GAS v4u*)(kvb + koff[T] + 128); vv[T][1] = *(const GAS v4u*)(kvb + koff[T] + 192); }
        if (n_valid < 256) {
#pragma unroll
            for (int T = 0; T < 16; ++T)
#pragma unroll
                for (int i = 0; i < 4; ++i) if (16 * (4 * g + i) + T >= n_valid) S[T][i] = -1e30f;
        }
        float mx = -3.0e38f;
#pragma unroll
        for (int T = 0; T < 16; ++T) mx = fmaxf(fmaxf(fmaxf(S[T][0], S[T][1]), fmaxf(S[T][2], S[T][3])), mx);
        mx = fmaxf(mx, lane_xor(mx, 16, lane)); mx = fmaxf(mx, lane_xor(mx, 32, lane));
        const float mneg = -mx * 1.4426950408889634f; float sum = 0.f;
#pragma unroll
        for (int T = 0; T < 16; ++T)
#pragma unroll
            for (int i = 0; i < 4; ++i) { const float p = __builtin_amdgcn_exp2f(S[T][i] * 1.4426950408889634f + mneg); S[T][i] = p; sum += p; }
        sum += lane_xor(sum, 16, lane); sum += lane_xor(sum, 32, lane);
        { const int tokn = vcu * 256 + F.wave + 8 * (it < 31 ? it + 1 : it); const GAS v4u* ip = (const GAS v4u*)(IDX + (size_t)tokn * 256 + 16 * m); ni0 = ip[0]; ni1 = ip[1];
#pragma unroll
          for (int s = 0; s < 2; ++s) nq[s] = *(const GAS bf16x8*)(Q + (size_t)tokn * D + m * 64 + 32 * s + 8 * g); }
        f32x4 O[4];
#pragma unroll
        for (int c = 0; c < 4; ++c) O[c] = (f32x4){0.f, 0.f, 0.f, 0.f};
#pragma unroll
        for (int ks = 0; ks < 8; ++ks) {
            const unsigned vb = vbase;
            if (ks == 2) {
#pragma unroll
                for (int T = 12; T < 16; ++T) { vv[T][0] = *(const GAS v4u*)(kvb + koff[T] + 128); vv[T][1] = *(const GAS v4u*)(kvb + koff[T] + 192); }
            }
#pragma unroll
            for (int tt = 0; tt < 2; ++tt) { const v4u v0 = vv[2 * ks + tt][0], v1 = vv[2 * ks + tt][1];
                const unsigned rr = 8 * (m >> 2) + 4 * tt + (m & 3);
                *(LAS v4u*)(vst + vst_off(rr, g)) = v0; *(LAS v4u*)(vst + vst_off(rr, g + 4)) = v1; }
            v4u pw; pw.x = pk2(S[2 * ks][0], S[2 * ks][1]); pw.y = pk2(S[2 * ks][2], S[2 * ks][3]); pw.z = pk2(S[2 * ks + 1][0], S[2 * ks + 1][1]); pw.w = pk2(S[2 * ks + 1][2], S[2 * ks + 1][3]);
            const bf16x8 pf = __builtin_bit_cast(bf16x8, pw);
            v2u f[4][2];
            asm volatile("s_waitcnt lgkmcnt(0)\n\t"
                         "ds_read_b64_tr_b16 %0, %8\n\tds_read_b64_tr_b16 %1, %9\n\tds_read_b64_tr_b16 %2, %10\n\tds_read_b64_tr_b16 %3, %11\n\t"
                         "ds_read_b64_tr_b16 %4, %12\n\tds_read_b64_tr_b16 %5, %13\n\tds_read_b64_tr_b16 %6, %14\n\tds_read_b64_tr_b16 %7, %15\n\t"
                         "s_waitcnt lgkmcnt(0)"
                         : "=&v"(f[0][0]), "=&v"(f[0][1]), "=&v"(f[1][0]), "=&v"(f[1][1]), "=&v"(f[2][0]), "=&v"(f[2][1]), "=&v"(f[3][0]), "=&v"(f[3][1])
                         : "v"(vb + tra[0][0]), "v"(vb + tra[0][1]), "v"(vb + tra[1][0]), "v"(vb + tra[1][1]), "v"(vb + tra[2][0]), "v"(vb + tra[2][1]), "v"(vb + tra[3][0]), "v"(vb + tra[3][1])
                         : "memory");
#pragma unroll
            for (int c = 0; c < 4; ++c) { v4u t; t.x = f[c][0].x; t.y = f[c][0].y; t.z = f[c][1].x; t.w = f[c][1].y;
                O[c] = __builtin_amdgcn_mfma_f32_16x16x32_bf16(__builtin_bit_cast(bf16x8, t), pf, O[c], 0, 0, 0); }
        }
        const float inv = 1.0f / sum;
#pragma unroll
        for (int c = 0; c < 4; ++c) { v2u w; w.x = pk2(O[c][0] * inv, O[c][1] * inv); w.y = pk2(O[c][2] * inv, O[c][3] * inv);
            *(GAS v2u*)(OB + (size_t)tok * D + m * 64 + 16 * c + 4 * g) = w; }
        { const int tokn = vcu * 256 + F.wave + 8 * (it < 31 ? it + 1 : it); ATT_KOFF(ni0, ni1); ATT_KLOAD((const GAS char*)(SM + (size_t)(tokn >> 11) * SEQ * 256)); }
    }
#undef ATT_KOFF
#undef ATT_KLOAD
#undef ATT_KWAIT
    }
}
constexpr int XCS = 136;
constexpr int HHS = 132;
__device__ __forceinline__ float gelu_tanh(float x) {
    const float z = 0.7978845608028654f * (x + 0.044715f * x * x * x);
    const float e = __builtin_amdgcn_exp2f(2.885390081777927f * z);
    const float th = 1.0f - 2.0f * __builtin_amdgcn_rcpf(e + 1.0f);
    return 0.5f * x * (1.0f + th);
}
template <bool DRY = false>
__device__ __forceinline__ void lru_phase(const Frame& F0, int L) {
    Frame F = launder(F0);
    const KArgs ka = kargs();
    const int b = F.bx >> 3, nb = F.bx & 7;
    const bf16* XR = (const bf16*)(F.ws + Z_XR); bf16* YR = (bf16*)(F.ws + Z_YR);
    const bf16* WL = (const bf16*)(F.ws + WS_W + W_LRU);
    LAS bf16* XC = (LAS bf16*)(F.lds + RING_OFF);
    LAS float* HH = (LAS float*)(F.lds + RING_OFF + 2 * 64 * XCS * 2);
    const int tid = F.tid, lane = F.lane, w = F.wave, g = lane >> 4, m = lane & 15;
    const int cc = tid & 15, tp = tid >> 4;
    const int ch0 = nb * 128 + 8 * cc;
    float cw[4][8], cbias[8];
#pragma unroll
    for (int j = 0; j < 4; ++j)
#pragma unroll
        for (int k = 0; k < 8; ++k) cw[j][k] = ka->in[I_CONVW][(size_t)L * 4 * D + j * D + ch0 + k];
#pragma unroll
    for (int k = 0; k < 8; ++k) cbias[k] = ka->in[I_CONVB][(size_t)L * D + ch0 + k];
    bf16x8 Br[4], Bi[4];
#pragma unroll
    for (int s = 0; s < 4; ++s) { Br[s] = *(const GAS bf16x8*)(WL + ((size_t)nb * 128 + 16 * w + m) * 128 + 32 * s + 8 * g);
                                  Bi[s] = *(const GAS bf16x8*)(WL + (size_t)8 * 128 * 128 + ((size_t)nb * 128 + 16 * w + m) * 128 + 32 * s + 8 * g); }
    const int chl = 16 * w + m, chg = nb * 128 + chl;
    const float ba = ka->in[I_LRUBA][(size_t)L * D + chg], bx = ka->in[I_LRUBX][(size_t)L * D + chg];
    const float lam = ka->in[I_LAM][(size_t)L * D + chg];
    const float sp8 = -8.0f * (fmaxf(-lam, 0.f) + log1pf(__expf(-fabsf(lam))));
    float carry = 0.f;
    const size_t rowb = (size_t)b * SEQ;
    v4u nxin[5], nyin[2];
#pragma unroll
    for (int k = 0; k < 5; ++k) { const int t = 2 * tp - 3 + k; v4u z; z.x = z.y = z.z = z.w = 0u; nxin[k] = (t >= 0) ? *(const GAS v4u*)(XR + (rowb + t) * D + ch0) : z; }
#pragma unroll
    for (int k = 0; k < 2; ++k) nyin[k] = *(const GAS v4u*)(YR + (rowb + 2 * tp + k) * D + ch0);
    for (int tile = 0; tile < 32; ++tile) {
        const int t0 = tile * 64, buf = tile & 1;
        LAS bf16* xc = XC + buf * 64 * XCS; LAS float* hh = HH + buf * 64 * HHS;
        v4u xin[5], yin[2];
#pragma unroll
        for (int k = 0; k < 5; ++k) xin[k] = nxin[k];
#pragma unroll
        for (int k = 0; k < 2; ++k) yin[k] = nyin[k];
        if (tile < 31) {
#pragma unroll
            for (int k = 0; k < 5; ++k) nxin[k] = *(const GAS v4u*)(XR + (rowb + t0 + 64 + 2 * tp - 3 + k) * D + ch0);
#pragma unroll
            for (int k = 0; k < 2; ++k) nyin[k] = *(const GAS v4u*)(YR + (rowb + t0 + 64 + 2 * tp + k) * D + ch0);
        }
#pragma unroll
        for (int k = 0; k < 2; ++k) { float o[8];
#pragma unroll
            for (int c = 0; c < 8; ++c) { float a = cbias[c];
#pragma unroll
                for (int j = 0; j < 4; ++j) { const unsigned wv = xin[k + j][c >> 1]; a += ((c & 1) ? bf_hi(wv) : bf_lo(wv)) * cw[j][c]; }
                o[c] = a; }
            v4u pw; pw.x = pk2(o[0], o[1]); pw.y = pk2(o[2], o[3]); pw.z = pk2(o[4], o[5]); pw.w = pk2(o[6], o[7]);
            *(LAS v4u*)(xc + (2 * tp + k) * XCS + 8 * cc) = pw; }
        __syncthreads();
#pragma unroll
        for (int mt = 0; mt < 4; ++mt) {
            f32x4 ar = (f32x4){0.f, 0.f, 0.f, 0.f}, ai = (f32x4){0.f, 0.f, 0.f, 0.f};
#pragma unroll
            for (int s = 0; s < 4; ++s) { const bf16x8 A = *(const LAS bf16x8*)(xc + (16 * mt + m) * XCS + 32 * s + 8 * g);
                ar = __builtin_amdgcn_mfma_f32_16x16x32_bf16(A, Br[s], ar, 0, 0, 0); ai = __builtin_amdgcn_mfma_f32_16x16x32_bf16(A, Bi[s], ai, 0, 0, 0); }
            float P[4], W[4];
#pragma unroll
            for (int i = 0; i < 4; ++i) {
                const float rr = sigmoidf_fast(ar[i] + ba), ig = sigmoidf_fast(ai[i] + bx);
                const float la = sp8 * rr;
                const float a = __expf(la);
                const float mult = sqrtf(-expm1f(2.0f * la));
                const float xv = __builtin_bit_cast(float, (unsigned)xc[(16 * mt + 4 * g + i) * XCS + chl] << 16);
                const float u = mult * (ig * xv);
                if (i == 0) { P[0] = a; W[0] = u; } else { P[i] = a * P[i - 1]; W[i] = a * W[i - 1] + u; }
            }
            float Ac = P[3], Uc = W[3];
            { const float A1 = lane_up(Ac, 16, lane), U1 = lane_up(Uc, 16, lane); if (g >= 1) { Uc = Ac * U1 + Uc; Ac = Ac * A1; } }
            { const float A2 = lane_up(Ac, 32, lane), U2 = lane_up(Uc, 32, lane); if (g >= 2) { Uc = Ac * U2 + Uc; Ac = Ac * A2; } }
            float Ae = lane_up(Ac, 16, lane), Ue = lane_up(Uc, 16, lane); if (g == 0) { Ae = 1.f; Ue = 0.f; }
            const float hin = Ae * carry + Ue;
            const float cnew = Ac * carry + Uc;
            carry = lane_get(cnew, 48 + m);
#pragma unroll
            for (int i = 0; i < 4; ++i) hh[(16 * mt + 4 * g + i) * HHS + chl] = P[i] * hin + W[i];
        }
        __syncthreads();
#pragma unroll
        for (int k = 0; k < 2; ++k) { const f32x4 h0 = *(const LAS f32x4*)(hh + (2 * tp + k) * HHS + 8 * cc), h1 = *(const LAS f32x4*)(hh + (2 * tp + k) * HHS + 8 * cc + 4);
            float o[8];
#pragma unroll
            for (int c = 0; c < 8; ++c) { const unsigned wv = yin[k][c >> 1]; const float y = (c & 1) ? bf_hi(wv) : bf_lo(wv); o[c] = (c < 4 ? h0[c] : h1[c - 4]) * gelu_tanh(y); }
            v4u pw; pw.x = pk2(o[0], o[1]); pw.y = pk2(o[2], o[3]); pw.z = pk2(o[4], o[5]); pw.w = pk2(o[6], o[7]);
            *(GAS v4u*)((DRY ? (bf16*)(F.ws + WS_NEED) : YR) + (rowb + t0 + 2 * tp + k) * D + ch0) = pw; }
    }
    __syncthreads();
}

struct MoeOrder : pg8::StaticOrder {
    const volatile LAS unsigned* tb; int tile0; const int* list; size_t bstride;
    __device__ __forceinline__ int expert_of(int gt) const { int e = 0;
#pragma unroll
        for (int k = 1; k < 8; ++k) e += (gt >= (int)tb[k]) ? 1 : 0;
        return e; }
    __device__ __forceinline__ const char* b_base(const pg8::Gemm& g, const pg8::Unit& u, size_t tstep) const { return (const char*)g.Bt + (size_t)expert_of(tile0 + u.pm) * bstride + (size_t)u.pn * tstep; }
};
struct MoeGatherOrder : MoeOrder {
    static constexpr bool GATHER = true;
    __device__ __forceinline__ const char* a_base(const pg8::Gemm& g, const pg8::Unit&, size_t) const { return (const char*)g.A; }
    __device__ __forceinline__ void a_rows(const pg8::Unit& u, int R0, int R1, int C0, int C1, int K, unsigned (&off)[2][2]) const {
        const int gt = tile0 + u.pm, e = expert_of(gt), j = gt - (int)tb[e], n = (int)tb[16 + e];
        const GAS int* le = (const GAS int*)list + (size_t)e * T_TOK;
#pragma unroll
        for (int h = 0; h < 2; ++h) { int p0 = 256 * j + 128 * h + R0, p1 = 256 * j + 128 * h + R1; p0 = p0 < n ? p0 : n - 1; p1 = p1 < n ? p1 : n - 1;
            off[h][0] = ((unsigned)le[p0] * (unsigned)K + (unsigned)C0) * 2u; off[h][1] = ((unsigned)le[p1] * (unsigned)K + (unsigned)C1) * 2u; }
    }
};
__global__ void __launch_bounds__(NWAVES * 64, 2) mk_fwd(Args args) {
    extern __shared__ __attribute__((aligned(16))) unsigned char lds[];
    Frame F;
    F.lds = (LAS unsigned char*)lds;
    F.MISC = (volatile LAS unsigned*)(F.lds + MISC_OFF);
    F.tid = threadIdx.x; F.lane = F.tid & 63; F.wave = __builtin_amdgcn_readfirstlane(F.tid >> 6);
    F.G = gridDim.x; F.bx = blockIdx.x;
    F.ws = args.ws; F.ctl = (gu32*)(args.ws + WS_CTL); F.out = args.out;
    for (int u = threadIdx.x; u < (LDS_BYTES - LDSCTL_OFF) / 4; u += NWAVES * 64) ((LAS unsigned*)(F.lds + LDSCTL_OFF))[u] = 0u;
    __syncthreads();
    XcdBarrier bar = xcd_barrier_post((unsigned*)(F.ctl + CW_BAR), F.MISC + 8);
#define GRID_BAR() do { XcdBarrier b_ = bar; unsigned* p_ = bar.bar; asm volatile("" : "+s"(p_)); b_.bar = p_; xcd_barrier(b_); } while (0)
    float* X32 = args.out;
#define LOCAL_HANDOFF() do { asm volatile("s_waitcnt vmcnt(0)" ::: "memory"); __syncthreads(); __builtin_amdgcn_fence(__ATOMIC_ACQUIRE, "agent"); asm volatile("s_waitcnt vmcnt(0)" ::: "memory"); __syncthreads(); } while (0)
    LAS unsigned char* ring = F.lds + RING_OFF;
    using pg8::Gemm; using pg8::StaticOrder;

    for (int L = 0; L < DEPTH; ++L) {
        const int odd = L & 1;
#ifndef SK_P0
        p0_convert(F, L);
#endif
#ifdef DUP_P0
        __syncthreads(); p0_convert(F, L);
#endif
        GRID_BAR();
        { const Frame P = launder(F); unsigned char* ws = P.ws; unsigned char* wb = ws + WS_W; bf16* XB = (bf16*)(ws + WS_XB); (void)XB; (void)wb;
          Gemm g{XB, (const bf16*)(wb + W_IN), T_TOK, NIN, D}; StaticOrder S; S.init(T_TOK, NIN, P.G, P.bx);
          pg8::EpiZ E{(bf16*)(ws + Z_Q), (bf16*)(ws + Z_QI), (bf16*)(ws + Z_SM)};
#ifndef SK_G1
          pg8::gemm_phase<pg8::EpiZ, StaticOrder>(ring, g, S, E, P.wave);
#endif
        }
        GRID_BAR();
#ifndef SK_IDX
        indexer_phase(F);
#endif
#ifdef DUP_IDX
        indexer_phase(F);
#endif
#ifdef DUP_LRU
        lru_phase<true>(F, L);
#endif
#ifndef SK_LRU
        lru_phase(F, L);
#endif
        GRID_BAR();
#ifdef DUP_ATT
        attention_phase<DUP_ATT>(F); __syncthreads();
#endif
#ifndef SK_ATT
        attention_phase(F);
#endif
        GRID_BAR();
        { const Frame P = launder(F); unsigned char* ws = P.ws; unsigned char* wb = ws + WS_W; bf16* XB = (bf16*)(ws + WS_XB); (void)XB; (void)wb;
          Gemm g{(const bf16*)(ws + Z_XR), (const bf16*)(wb + W_BRA), T_TOK, D, D}; StaticOrder S; S.init(T_TOK, D, F.G, F.bx);
          pg8::EpiGate<0> E{(bf16*)(ws + Z_GA), nullptr};
#ifndef SK_G2
          pg8::gemm_phase<pg8::EpiGate<0>, StaticOrder>(ring, g, S, E, P.wave);
#endif
        }
        LOCAL_HANDOFF();
        { const Frame P = launder(F); unsigned char* ws = P.ws; unsigned char* wb = ws + WS_W; bf16* XB = (bf16*)(ws + WS_XB); (void)XB; (void)wb;
          Gemm g{(const bf16*)(ws + Z_YR), (const bf16*)(wb + W_BRR), T_TOK, D, D}; StaticOrder S; S.init(T_TOK, D, F.G, F.bx);
          pg8::EpiGate<1> E{(bf16*)(ws + Z_GA), (const bf16*)(ws + Z_GR)};
#ifndef SK_G3
          pg8::gemm_phase<pg8::EpiGate<1>, StaticOrder>(ring, g, S, E, P.wave);
#endif
        }
        GRID_BAR();
        { const Frame P = launder(F); unsigned char* ws = P.ws; unsigned char* wb = ws + WS_W; bf16* XB = (bf16*)(ws + WS_XB); (void)XB; (void)wb;
          Gemm g{(const bf16*)(ws + Z_GA), (const bf16*)(wb + W_O), T_TOK, D, D}; StaticOrder S; S.init(T_TOK, D, F.G, F.bx);
          pg8::EpiRes<0> E{X32, L == 0 ? kargs()->in[I_X] : X32, nullptr};
#ifndef SK_G4
          pg8::gemm_phase<pg8::EpiRes<0>, StaticOrder>(ring, g, S, E, P.wave);
#endif
        }
        GRID_BAR();
#ifdef DUP_LN
        ln_phase<false, false, true>(F, L); ln_phase<false, false, true>(F, L);
#endif
#ifndef SK_LN
        if (odd) ln_phase<false, true>(F, L); else ln_phase<false, false>(F, L);
#endif
        GRID_BAR();
        if (odd) {
            if (launder(F).tid == 0) { unsigned acc = 0u; F.MISC[16] = 0u;
                for (int e = 0; e < 8; ++e) { const unsigned c = __hip_atomic_load(F.ctl + CW_CNT + (L >> 1) * 1024 + 64 * e, RLX_AGENT); F.MISC[32 + e] = c; acc += (c + 255u) >> 8; F.MISC[17 + e] = acc; } }
            __syncthreads();
        }
        { const Frame P = launder(F); unsigned char* ws = P.ws; unsigned char* wb = ws + WS_W; bf16* XB = (bf16*)(ws + WS_XB); (void)XB; (void)wb;
          Gemm g{(const bf16*)(ws + F_PB), (const bf16*)(wb + W_PP), T_TOK, D, PLE}; StaticOrder S; S.init(T_TOK, D, F.G, F.bx);
          pg8::EpiBf16 E{(bf16*)(ws + F_U), D, 0};
#ifndef SK_G5
          pg8::gemm_phase<pg8::EpiBf16, StaticOrder>(ring, g, S, E, P.wave);
#endif
        }
        LOCAL_HANDOFF();
        { const Frame P = launder(F); unsigned char* ws = P.ws; unsigned char* wb = ws + WS_W; bf16* XB = (bf16*)(ws + WS_XB); (void)XB; (void)wb;
          Gemm g{XB, (const bf16*)(wb + W_PG), T_TOK, D, D}; StaticOrder S; S.init(T_TOK, D, F.G, F.bx);
          pg8::EpiRes<1> E{X32, nullptr, (const bf16*)(ws + F_U)};
#ifndef SK_G6
          pg8::gemm_phase<pg8::EpiRes<1>, StaticOrder>(ring, g, S, E, P.wave);
#endif
        }
        if (!odd) {
            { const Frame P = launder(F); unsigned char* ws = P.ws; unsigned char* wb = ws + WS_W; bf16* XB = (bf16*)(ws + WS_XB); (void)XB; (void)wb;
          Gemm g{XB, (const bf16*)(wb + W_FF), T_TOK, 2 * DFF, D}; StaticOrder S; S.init(T_TOK, 2 * DFF, F.G, F.bx);
              pg8::EpiSwiglu E{(bf16*)(ws + F_H), DFF};
#ifndef SK_G7
              pg8::gemm_phase<pg8::EpiSwiglu, StaticOrder>(ring, g, S, E, P.wave);
#endif
        }
            GRID_BAR();
            { const Frame P = launder(F); unsigned char* ws = P.ws; unsigned char* wb = ws + WS_W; bf16* XB = (bf16*)(ws + WS_XB); (void)XB; (void)wb;
          Gemm g{(const bf16*)(ws + F_H), (const bf16*)(wb + W_FF_DN_DENSE), T_TOK, D, DFF}; StaticOrder S; S.init(T_TOK, D, F.G, F.bx);
              pg8::EpiRes<2> E{X32, nullptr, nullptr};
#ifndef SK_G8
              pg8::gemm_phase<pg8::EpiRes<2>, StaticOrder>(ring, g, S, E, P.wave);
#endif
        }
            GRID_BAR();
#ifndef SK_LN
            ln_phase<true, false>(F, L);
#endif
        } else {
            const int ntiles = (int)F.MISC[24];
            const int nchunks = (ntiles + MOE_CHUNK_TILES - 1) / MOE_CHUNK_TILES;
            for (int c = 0; c < nchunks; ++c) {
                const int tile0 = c * MOE_CHUNK_TILES, ntl = (ntiles - tile0) < MOE_CHUNK_TILES ? (ntiles - tile0) : MOE_CHUNK_TILES;
                const size_t hc_off = (c & 1) ? F_H1 : F_H;
                { const Frame P = launder(F); unsigned char* ws = P.ws; unsigned char* wb = ws + WS_W; bf16* XB = (bf16*)(ws + WS_XB); (void)XB; (void)wb;
          Gemm g{XB, (const bf16*)(wb + W_FF), ntl * 256, 2 * DFFE, D}; MoeGatherOrder S; S.init(ntl * 256, 2 * DFFE, F.G, F.bx);
                  S.tb = F.MISC + 16; S.tile0 = tile0; S.list = (const int*)(ws + WS_LIST); S.bstride = (size_t)2 * DFFE * D * 2;
                  pg8::EpiSwiglu E{(bf16*)(ws + hc_off), DFFE};
#ifndef SK_G9
                  pg8::gemm_phase<pg8::EpiSwiglu, MoeGatherOrder>(ring, g, S, E, P.wave);
#endif
        }
                GRID_BAR();
                { const Frame P = launder(F); unsigned char* ws = P.ws; unsigned char* wb = ws + WS_W; bf16* XB = (bf16*)(ws + WS_XB); (void)XB; (void)wb;
          Gemm g{(const bf16*)(ws + hc_off), (const bf16*)(wb + W_FF_DN_MOE), ntl * 256, D, DFFE}; MoeOrder S; S.init(ntl * 256, D, F.G, F.bx);
                  S.tb = F.MISC + 16; S.tile0 = tile0; S.list = nullptr; S.bstride = (size_t)D * DFFE * 2;
                  pg8::EpiBf16 E{(bf16*)(ws + F_YE), D, tile0 * 256};
#ifndef SK_G10
                  pg8::gemm_phase<pg8::EpiBf16, MoeOrder>(ring, g, S, E, P.wave);
#endif
        }
            }
            GRID_BAR();
#ifndef SK_LN
            ln_phase<true, true>(F, L);
#endif
        }
        GRID_BAR();
    }
    if (__hip_atomic_load(F.ctl + CW_BAR + XB_TMO, RLX_AGENT) != 0u) {
        const float q = __builtin_nanf("");
        for (size_t i = (size_t)F.bx * 512 + launder(F).tid; i < (size_t)T_TOK * D; i += (size_t)F.G * 512) X32[i] = q;
    }
}

#if defined(DUP_LRU) || defined(DUP_LN)
constexpr size_t WS_DRY_EXTRA = 256 * MiB;
#else
constexpr size_t WS_DRY_EXTRA = 0;
#endif
extern "C" void kernel_launch(void* const* d_in, const int* in_sizes, int n_in, void* d_out, int out_size, void* d_ws, size_t ws_size, hipStream_t stream) {
    static int grid = 0;
    if (grid == 0) {
        if (n_in != 28 || out_size != T_TOK * D || ws_size < WS_NEED + WS_DRY_EXTRA) { fprintf(stderr, "kernel_launch: unexpected shapes: n_in %d out %d ws %zu (need %zu)\n", n_in, out_size, ws_size, (size_t)WS_END); grid = -1; return; }
        int dev = 0, cus = 0, per_cu = 0;
        if (hipGetDevice(&dev) != hipSuccess || hipDeviceGetAttribute(&cus, hipDeviceAttributeMultiprocessorCount, dev) != hipSuccess) { grid = -1; return; }
        if (hipFuncSetAttribute((const void*)mk_fwd, hipFuncAttributeMaxDynamicSharedMemorySize, LDS_BYTES) != hipSuccess) { fprintf(stderr, "kernel_launch: hipFuncSetAttribute failed\n"); grid = -1; return; }
        if (hipOccupancyMaxActiveBlocksPerMultiprocessor(&per_cu, (const void*)mk_fwd, NWAVES * 64, LDS_BYTES) != hipSuccess || per_cu < 1) { fprintf(stderr, "kernel_launch: occupancy query says %d blocks per CU\n", per_cu); }
        (void)hipGetLastError();
        grid = cus;
        if (grid != 256) { fprintf(stderr, "kernel_launch: this kernel needs a 256-CU device (got %d)\n", cus); grid = -1; return; }
    }
    if (grid < 0) return;
    if (hipMemsetAsync((char*)d_ws + WS_CTL, 0, CTL_ZERO_BYTES, stream) != hipSuccess) return;
    Args a{};
    for (int i = 0; i < 28; ++i) a.in[i] = (const float*)d_in[i];
    a.out = (float*)d_out; a.ws = (unsigned char*)d_ws;
    hipLaunchKernelGGL(mk_fwd, dim3(grid), dim3(NWAVES * 64), LDS_BYTES, stream, a);
}
```

```cpp
#include <hip/hip_runtime.h>
#include <cstdio>
#include <cstdint>

constexpr int T_TOK = 65536, D = 1024, SEQ = 2048, NBATCH = 32, DEPTH = 4;
constexpr int D_IN = 5832, NIN = 5888;
constexpr int DFF = 2816, DFFE = 3584, NEXP = 8, PLE = 256;
constexpr float LN_EPS = 1e-5f;
constexpr float DN_ALPHA = 1.681792830507429f;

namespace pg8 {
#define PG8_LAS __attribute__((address_space(3)))
typedef unsigned short bf16_t;
typedef short bf16x8 __attribute__((ext_vector_type(8)));
typedef float f32x4 __attribute__((ext_vector_type(4)));
typedef unsigned u32x4 __attribute__((ext_vector_type(4)));
typedef unsigned u32x2 __attribute__((ext_vector_type(2)));
constexpr int BM = 256, BK = 64, HALF = 128, HTB = HALF * BK * 2  , STAGE_BYTES = 8 * HTB, NXCD = 8, WGM = 8;

__host__ __device__ __forceinline__ int lds_byte(int r, int c) { const int st = (r >> 4) * 2 + (c >> 5), rr = r & 15, cc = c & 31, ob = rr * 64 + cc * 2; return st * 1024 + (ob ^ (((ob >> 9) & 1) << 5)); }
__host__ __device__ __forceinline__ void stage_rc(int b, int& R, int& C) { const int st = b / 1024, sb = b % 1024, swz = sb ^ (((sb >> 9) & 1) << 5); R = (st >> 1) * 16 + swz / 64; C = (st & 1) * 32 + (swz % 64) / 2; }
__host__ __device__ __forceinline__ int perm32(int rho) { const int n = rho >> 4, i = rho & 15; return 8 * (i >> 2) + 4 * n + (i & 3); }

struct Unit { int pm, pn; };
struct Gemm { const bf16_t* A; const bf16_t* Bt; int M, N, K; };

struct StaticOrder {
    static constexpr bool GATHER = false;
    int nM, nN, nwg, G, c;
    __host__ __device__ void init(int M, int N, int G_, int c_) { nM = M / BM; nN = N / BM; nwg = nM * nN; G = G_; c = c_; }
    __host__ __device__ bool next(int i, Unit& u) const {
        const long L = (long)i * G + c; if (L >= nwg) return false;
        int wgid = (int)L; { const int q = nwg / NXCD, r = nwg % NXCD, xcd = wgid % NXCD, off = wgid / NXCD; wgid = (xcd < r ? xcd * (q + 1) : r * (q + 1) + (xcd - r) * q) + off; }
        const int nig = WGM * nN, gid = wgid / nig, fm = gid * WGM, gsz = (nM - fm) < WGM ? (nM - fm) : WGM;
        u.pm = fm + ((wgid % nig) % gsz); u.pn = (wgid % nig) / gsz; return true;
    }
    __device__ __forceinline__ const char* a_base(const Gemm& g, const Unit& u, size_t tstep) const { return (const char*)g.A + (size_t)u.pm * tstep; }
    __device__ __forceinline__ const char* b_base(const Gemm& g, const Unit& u, size_t tstep) const { return (const char*)g.Bt + (size_t)u.pn * tstep; }
    __device__ __forceinline__ void a_rows(const Unit&, int, int, int, int, int, unsigned (&)[2][2]) const {}
    __device__ __forceinline__ void a_ready(const Unit&) const {}
    __device__ __forceinline__ void done(const Unit&) const {}
};

__device__ __forceinline__ unsigned cvt_pk_bf16(float lo, float hi) { unsigned r; asm volatile("v_cvt_pk_bf16_f32 %0, %1, %2" : "=v"(r) : "v"(lo), "v"(hi)); return r; }
__device__ __forceinline__ float bf_lo(unsigned w) { return __builtin_bit_cast(float, w << 16); }
__device__ __forceinline__ float bf_hi(unsigned w) { return __builtin_bit_cast(float, w & 0xffff0000u); }
__device__ __forceinline__ float sigmoidf_fast(float x) { return __builtin_amdgcn_rcpf(1.0f + __builtin_amdgcn_exp2f(-1.4426950408889634f * x)); }
#define EPI_FENCE() asm volatile("" ::: "memory")
#define EGAS __attribute__((address_space(1)))
__device__ __forceinline__ u32x4 pack8(const f32x4 v0, const f32x4 v1) { u32x4 w; w.x = cvt_pk_bf16(v0[0], v0[1]); w.y = cvt_pk_bf16(v0[2], v0[3]); w.z = cvt_pk_bf16(v1[0], v1[1]); w.w = cvt_pk_bf16(v1[2], v1[3]); return w; }

struct EpiBf16 {
    static constexpr bool PERM = true, AFTER_DRAIN = false;
    bf16_t* O; int ldc; int row_off;
    __device__ __forceinline__ void operator()(const f32x4 (&acc)[2][2][4][2], const Unit& u, int wr, int wc, int fr, int fq) const {
        { int l_ = (int)__builtin_amdgcn_mbcnt_hi(~0u, __builtin_amdgcn_mbcnt_lo(~0u, 0u)); asm volatile("" : "+v"(l_)); fr = l_ & 15; fq = l_ >> 4; }
        const int row0 = row_off + u.pm * BM + wr * 64 + fr, col0 = u.pn * BM + wc * 32 + 8 * fq;
#pragma unroll
        for (int ai = 0; ai < 2; ++ai)
#pragma unroll
            for (int m = 0; m < 4; ++m) { bf16_t* rowp = O + (size_t)(row0 + ai * HALF + m * 16) * ldc + col0;
#pragma unroll
                for (int bj = 0; bj < 2; ++bj) *(EGAS u32x4*)(rowp + bj * HALF) = pack8(acc[ai][bj][m][0], acc[ai][bj][m][1]); }
    }
};
struct EpiZ {
    static constexpr bool PERM = true, AFTER_DRAIN = false;
    bf16_t* zbig; bf16_t* zqi; bf16_t* zsm;
    __device__ __forceinline__ void operator()(const f32x4 (&acc)[2][2][4][2], const Unit& u, int wr, int wc, int fr, int fq) const {
        { int l_ = (int)__builtin_amdgcn_mbcnt_hi(~0u, __builtin_amdgcn_mbcnt_lo(~0u, 0u)); asm volatile("" : "+v"(l_)); fr = l_ & 15; fq = l_ >> 4; }
        bf16_t* base; int ld, colt;
        if (u.pn < 20) { base = zbig + (size_t)(u.pn >> 2) * ((size_t)T_TOK * D); ld = D; colt = (u.pn & 3) * BM; }
        else if (u.pn < 22) { base = zqi; ld = 512; colt = (u.pn - 20) * BM; }
        else { base = zsm; ld = 256; colt = 0; }
        const int row0 = u.pm * BM + wr * 64 + fr, col0 = colt + wc * 32 + 8 * fq;
#pragma unroll
        for (int ai = 0; ai < 2; ++ai)
#pragma unroll
            for (int m = 0; m < 4; ++m) { bf16_t* rowp = base + (size_t)(row0 + ai * HALF + m * 16) * ld + col0;
#pragma unroll
                for (int bj = 0; bj < 2; ++bj) *(EGAS u32x4*)(rowp + bj * HALF) = pack8(acc[ai][bj][m][0], acc[ai][bj][m][1]); }
    }
};
template <int MODE> struct EpiGate {
    static constexpr bool PERM = true, AFTER_DRAIN = false;
    bf16_t* G; const bf16_t* G2;
    __device__ __forceinline__ void operator()(const f32x4 (&acc)[2][2][4][2], const Unit& u, int wr, int wc, int fr, int fq) const {
        { int l_ = (int)__builtin_amdgcn_mbcnt_hi(~0u, __builtin_amdgcn_mbcnt_lo(~0u, 0u)); asm volatile("" : "+v"(l_)); fr = l_ & 15; fq = l_ >> 4; }
        const int row0 = u.pm * BM + wr * 64 + fr, col0 = u.pn * BM + wc * 32 + 8 * fq;
#pragma unroll
        for (int ai = 0; ai < 2; ++ai)
#pragma unroll
            for (int m = 0; m < 4; ++m) { const size_t off = (size_t)(row0 + ai * HALF + m * 16) * D + col0;
#pragma unroll
                for (int bj = 0; bj < 2; ++bj) {
                    const u32x4 gw = *(const EGAS u32x4*)(G + off + bj * HALF);
                    f32x4 v0 = acc[ai][bj][m][0], v1 = acc[ai][bj][m][1];
                    if (MODE == 0) {
                        v0[0] *= sigmoidf_fast(bf_lo(gw.x)); v0[1] *= sigmoidf_fast(bf_hi(gw.x)); v0[2] *= sigmoidf_fast(bf_lo(gw.y)); v0[3] *= sigmoidf_fast(bf_hi(gw.y));
                        v1[0] *= sigmoidf_fast(bf_lo(gw.z)); v1[1] *= sigmoidf_fast(bf_hi(gw.z)); v1[2] *= sigmoidf_fast(bf_lo(gw.w)); v1[3] *= sigmoidf_fast(bf_hi(gw.w));
                    } else {
                        const u32x4 g2 = *(const EGAS u32x4*)(G2 + off + bj * HALF);
                        v0[0] = bf_lo(gw.x) + v0[0] * sigmoidf_fast(bf_lo(g2.x)); v0[1] = bf_hi(gw.x) + v0[1] * sigmoidf_fast(bf_hi(g2.x));
                        v0[2] = bf_lo(gw.y) + v0[2] * sigmoidf_fast(bf_lo(g2.y)); v0[3] = bf_hi(gw.y) + v0[3] * sigmoidf_fast(bf_hi(g2.y));
                        v1[0] = bf_lo(gw.z) + v1[0] * sigmoidf_fast(bf_lo(g2.z)); v1[1] = bf_hi(gw.z) + v1[1] * sigmoidf_fast(bf_hi(g2.z));
                        v1[2] = bf_lo(gw.w) + v1[2] * sigmoidf_fast(bf_lo(g2.w)); v1[3] = bf_hi(gw.w) + v1[3] * sigmoidf_fast(bf_hi(g2.w));
                    }
                    *(EGAS u32x4*)(G + off + bj * HALF) = pack8(v0, v1); }
                EPI_FENCE(); }
    }
};
template <int MODE> struct EpiRes {
    static constexpr bool PERM = false, AFTER_DRAIN = false;
    float* Y; const bf16_t* XB; const bf16_t* U;
    __device__ __forceinline__ void operator()(const f32x4 (&acc)[2][2][4][2], const Unit& u, int wr, int wc, int fr, int fq) const {
        { int l_ = (int)__builtin_amdgcn_mbcnt_hi(~0u, __builtin_amdgcn_mbcnt_lo(~0u, 0u)); asm volatile("" : "+v"(l_)); fr = l_ & 15; fq = l_ >> 4; }
        const int row0 = u.pm * BM + wr * 64 + fr, col0 = u.pn * BM + wc * 32 + 4 * fq;
#pragma unroll
        for (int ai = 0; ai < 2; ++ai)
#pragma unroll
            for (int m = 0; m < 4; ++m) { const size_t off = (size_t)(row0 + ai * HALF + m * 16) * D + col0;
#pragma unroll
                for (int bj = 0; bj < 2; ++bj)
#pragma unroll
                    for (int n = 0; n < 2; ++n) { const size_t o = off + bj * HALF + n * 16; const f32x4 a = acc[ai][bj][m][n]; f32x4 r;
                        if (MODE == 0) { const u32x2 xw = *(const EGAS u32x2*)(XB + o);
                            r[0] = bf_lo(xw.x) * DN_ALPHA + a[0]; r[1] = bf_hi(xw.x) * DN_ALPHA + a[1]; r[2] = bf_lo(xw.y) * DN_ALPHA + a[2]; r[3] = bf_hi(xw.y) * DN_ALPHA + a[3]; }
                        else if (MODE == 1) { const u32x2 xw = *(const EGAS u32x2*)(XB + o); const u32x2 uw = *(const EGAS u32x2*)(U + o);
                            r[0] = bf_lo(xw.x) * DN_ALPHA + sigmoidf_fast(a[0]) * bf_lo(uw.x); r[1] = bf_hi(xw.x) * DN_ALPHA + sigmoidf_fast(a[1]) * bf_hi(uw.x);
                            r[2] = bf_lo(xw.y) * DN_ALPHA + sigmoidf_fast(a[2]) * bf_lo(uw.y); r[3] = bf_hi(xw.y) * DN_ALPHA + sigmoidf_fast(a[3]) * bf_hi(uw.y); }
                        else { const f32x4 x = *(const EGAS f32x4*)(Y + o); r = x + a; }
                        *(EGAS f32x4*)(Y + o) = r; }
                EPI_FENCE(); }
    }
};
struct EpiSwiglu {
    static constexpr bool PERM = true, AFTER_DRAIN = false;
    bf16_t* H; int ldh;
    __device__ __forceinline__ void operator()(const f32x4 (&acc)[2][2][4][2], const Unit& u, int wr, int wc, int fr, int fq) const {
        { int l_ = (int)__builtin_amdgcn_mbcnt_hi(~0u, __builtin_amdgcn_mbcnt_lo(~0u, 0u)); asm volatile("" : "+v"(l_)); fr = l_ & 15; fq = l_ >> 4; }
        const int row0 = u.pm * BM + wr * 64 + fr, col0 = u.pn * HALF + wc * 32 + 8 * fq;
#pragma unroll
        for (int ai = 0; ai < 2; ++ai)
#pragma unroll
            for (int m = 0; m < 4; ++m) { bf16_t* rowp = H + (size_t)(row0 + ai * HALF + m * 16) * ldh + col0;
                f32x4 v0, v1;
#pragma unroll
                for (int j = 0; j < 4; ++j) { const float g0 = acc[ai][0][m][0][j], g1 = acc[ai][0][m][1][j];
                    v0[j] = g0 * sigmoidf_fast(g0) * acc[ai][1][m][0][j]; v1[j] = g1 * sigmoidf_fast(g1) * acc[ai][1][m][1][j]; }
                *(EGAS u32x4*)rowp = pack8(v0, v1); }
    }
};
template <class Epi, class Sched, bool ALIGN_EPI = true>
__device__ __forceinline__ void gemm_phase(PG8_LAS unsigned char* lds, const Gemm g, const Sched& S, const Epi& E, const int wave_id) {
    int lane_ = (int)__builtin_amdgcn_mbcnt_hi(~0u, __builtin_amdgcn_mbcnt_lo(~0u, 0u)); asm volatile("" : "+v"(lane_));
    const int wid = wave_id, lane = lane_, tid = wid * 64 + lane, wr = wid >> 2, wc = wid & 3, fr = lane & 15, fq = lane >> 4;
    const int K = g.K, nt = K / BK;
    unsigned voffA[2], voffB[2]; int RA[2], CA[2];
#pragma unroll
    for (int i = 0; i < 2; ++i) { int R, C; stage_rc(tid * 16 + i * 8192, R, C); const int Rb = Epi::PERM ? ((R & ~31) + perm32(R & 31)) : R; RA[i] = R; CA[i] = C;
        voffA[i] = (unsigned)(R * K + C) * 2u; voffB[i] = (unsigned)(Rb * K + C) * 2u; }
    const size_t kstep = (size_t)(BK * 2);
    const size_t hstep = (size_t)HALF * K * 2;
    const size_t tstep = 2 * hstep;
    const unsigned ldsw = (unsigned)wid * 1024u;
    const int aoff = lds_byte(wr * 64 + fr, fq * 8), boff = lds_byte(wc * 32 + fr, fq * 8);
    unsigned offC[2][2] = {{0u, 0u}, {0u, 0u}}, offN[2][2] = {{0u, 0u}, {0u, 0u}};
#define PG8_SA(b, h) (((b) * 2 + (h)) * HTB)
#define PG8_SB(b, h) ((4 + (b) * 2 + (h)) * HTB)
#define PG8_STAGE(bufoff, gbase, voff) do { _Pragma("unroll") for (int _i = 0; _i < 2; ++_i) \
        __builtin_amdgcn_global_load_lds((const unsigned*)((const char*)(gbase) + (voff)[_i]), (PG8_LAS unsigned*)(lds + (bufoff) + ldsw + _i * 8192), 16, 0, 0); } while (0)
#define PG8_STA(bufoff, ptr, h, NX) do { if constexpr (Sched::GATHER) { _Pragma("unroll") for (int _i = 0; _i < 2; ++_i) { const unsigned _o = (NX) ? offN[h][_i] : offC[h][_i]; \
        __builtin_amdgcn_global_load_lds((const unsigned*)((const char*)(ptr) + _o), (PG8_LAS unsigned*)(lds + (bufoff) + ldsw + _i * 8192), 16, 0, 0); } } \
        else { PG8_STAGE(bufoff, (ptr) + (h) * hstep, voffA); } } while (0)
#define PG8_LDA(dst, b, h) do { _Pragma("unroll") for (int m = 0; m < 4; ++m) _Pragma("unroll") for (int k = 0; k < 2; ++k) dst[m][k] = *(const PG8_LAS bf16x8*)(lds + PG8_SA(b, h) + aoff + m * 2048 + k * 1024); } while (0)
#define PG8_LDB(dst, b, h) do { _Pragma("unroll") for (int n = 0; n < 2; ++n) _Pragma("unroll") for (int k = 0; k < 2; ++k) dst[n][k] = *(const PG8_LAS bf16x8*)(lds + PG8_SB(b, h) + boff + n * 2048 + k * 1024); } while (0)
#define PG8_MMA(ai, bj, At, Bt) do { __builtin_amdgcn_s_setprio(1); _Pragma("unroll") for (int m = 0; m < 4; ++m) _Pragma("unroll") for (int n = 0; n < 2; ++n) _Pragma("unroll") for (int k = 0; k < 2; ++k) \
        acc[ai][bj][m][n] = __builtin_amdgcn_mfma_f32_16x16x32_bf16(Bt[n][k], At[m][k], acc[ai][bj][m][n], 0, 0, 0); __builtin_amdgcn_s_setprio(0); } while (0)
#define PG8_WAIT_V(n) asm volatile("s_waitcnt vmcnt(" #n ")" ::: "memory")
#define PG8_WAIT_L(n) asm volatile("s_waitcnt lgkmcnt(" #n ")" ::: "memory")
#define PG8_BAR __builtin_amdgcn_s_barrier()
#define PG8_SCHED __builtin_amdgcn_sched_barrier(0)
    Unit cur, nxt; int ui = 0;
    if (!S.next(0, cur)) return;
    f32x4 acc[2][2][4][2];
#pragma unroll
    for (int a = 0; a < 2; ++a)
#pragma unroll
        for (int b = 0; b < 2; ++b)
#pragma unroll
            for (int m = 0; m < 4; ++m)
#pragma unroll
                for (int n = 0; n < 2; ++n) acc[a][b][m][n] = (f32x4){0.f, 0.f, 0.f, 0.f};
    bf16x8 At[4][2], B0[2][2], B1[2][2];
    const char* cA = S.a_base(g, cur, tstep); const char* cB = S.b_base(g, cur, tstep);
    if constexpr (Sched::GATHER) S.a_rows(cur, RA[0], RA[1], CA[0], CA[1], K, offC);
    S.a_ready(cur);
    PG8_STAGE(PG8_SB(0, 0), cB, voffB); PG8_STAGE(PG8_SB(0, 1), cB + hstep, voffB); PG8_STA(PG8_SA(0, 0), cA, 0, false); PG8_STA(PG8_SA(0, 1), cA, 1, false);
    if (wr == 1) PG8_BAR;
    PG8_WAIT_V(2); PG8_BAR;
    PG8_STAGE(PG8_SB(1, 0), cB + kstep, voffB); PG8_STA(PG8_SA(1, 0), cA + kstep, 0, false); PG8_STAGE(PG8_SB(1, 1), cB + hstep + kstep, voffB);
    PG8_WAIT_V(6); PG8_BAR;
    for (;;) {
        const bool has_next = S.next(ui + 1, nxt);
        const char* nA = has_next ? S.a_base(g, nxt, tstep) : cA; const char* nB = has_next ? S.b_base(g, nxt, tstep) : cB;
        if constexpr (Sched::GATHER) { if (has_next) S.a_rows(nxt, RA[0], RA[1], CA[0], CA[1], K, offN); else {
#pragma unroll
            for (int h = 0; h < 2; ++h)
#pragma unroll
                for (int i = 0; i < 2; ++i) offN[h][i] = offC[h][i]; } }
        for (int t = 0; t < nt; t += 2) {
            const bool last = (t == nt - 2);
            const char* a1 = cA + (size_t)(t + 1) * kstep;
            const char* a2 = last ? nA : cA + (size_t)(t + 2) * kstep; const char* b2 = last ? nB : cB + (size_t)(t + 2) * kstep;
            const char* a3 = a2 + kstep; const char* b3 = b2 + kstep;
            if (last && has_next) S.a_ready(nxt);
            PG8_LDB(B0, 0, 0); PG8_LDB(B1, 0, 1); PG8_SCHED; PG8_LDA(At, 0, 0); PG8_STA(PG8_SA(1, 1), a1, 1, false);
            PG8_WAIT_V(8); PG8_WAIT_L(0); PG8_BAR; PG8_MMA(0, 0, At, B0); PG8_MMA(0, 1, At, B1); PG8_BAR; PG8_SCHED;
            PG8_LDA(At, 0, 1); PG8_STAGE(PG8_SB(0, 0), b2, voffB); PG8_STAGE(PG8_SB(0, 1), b2 + hstep, voffB); PG8_STA(PG8_SA(0, 0), a2, 0, last);
            PG8_WAIT_V(8); PG8_WAIT_L(0); PG8_BAR; PG8_MMA(1, 0, At, B0); PG8_MMA(1, 1, At, B1); PG8_BAR; PG8_SCHED;
            PG8_LDB(B0, 1, 0); PG8_LDB(B1, 1, 1); PG8_SCHED; PG8_LDA(At, 1, 0); PG8_STA(PG8_SA(0, 1), a2, 1, last);
            PG8_WAIT_V(8); PG8_WAIT_L(0); PG8_BAR; PG8_MMA(0, 0, At, B0); PG8_MMA(0, 1, At, B1); PG8_BAR; PG8_SCHED;
            PG8_LDA(At, 1, 1); PG8_STAGE(PG8_SB(1, 0), b3, voffB); PG8_STAGE(PG8_SB(1, 1), b3 + hstep, voffB); PG8_STA(PG8_SA(1, 0), a3, 0, last);
            PG8_WAIT_V(8); PG8_WAIT_L(0); PG8_BAR; PG8_MMA(1, 0, At, B0); PG8_MMA(1, 1, At, B1); PG8_BAR; PG8_SCHED;
        }
        if constexpr (ALIGN_EPI) { if (wr == 0) PG8_BAR; }
        E(acc, cur, wr, wc, fr, fq); S.done(cur);
        if (!has_next) break;
#pragma unroll
        for (int a = 0; a < 2; ++a)
#pragma unroll
            for (int b = 0; b < 2; ++b)
#pragma unroll
                for (int m = 0; m < 4; ++m)
#pragma unroll
                    for (int n = 0; n < 2; ++n) acc[a][b][m][n] = (f32x4){0.f, 0.f, 0.f, 0.f};
        cur = nxt; cA = nA; cB = nB; ++ui;
        if constexpr (Sched::GATHER) {
#pragma unroll
            for (int h = 0; h < 2; ++h)
#pragma unroll
                for (int i = 0; i < 2; ++i) offC[h][i] = offN[h][i]; }
        if constexpr (ALIGN_EPI) { if (wr == 1) PG8_BAR; }
    }
    PG8_WAIT_V(0);
    if constexpr (!ALIGN_EPI) { if (wr == 0) PG8_BAR; }
    PG8_BAR;
#undef PG8_SA
#undef PG8_SB
#undef PG8_STAGE
#undef PG8_STA
#undef PG8_LDA
#undef PG8_LDB
#undef PG8_MMA
#undef PG8_WAIT_V
#undef PG8_WAIT_L
#undef PG8_BAR
#undef PG8_SCHED
}
}
constexpr int NWAVES = 8;
constexpr size_t MiB = 1u << 20;
constexpr size_t WS_CTL = 0, CTL_ZERO_BYTES = 1 * MiB;
constexpr size_t WS_ROUTE = 1 * MiB;
constexpr size_t WS_LIST = 3 * MiB;
constexpr size_t WS_W = 8 * MiB;
constexpr size_t W_IN = 0, W_BRA = 12 * MiB, W_BRR = 14 * MiB, W_O = 16 * MiB, W_PG = 18 * MiB, W_PP = 20 * MiB, W_LRU = 21 * MiB, W_FF = 22 * MiB;
constexpr size_t W_FF_DN_DENSE = W_FF + 11 * MiB, W_FF_DN_MOE = W_FF + 112 * MiB;
constexpr size_t WS_XB = 208 * MiB;
constexpr size_t WS_IDX = 336 * MiB;
constexpr size_t WS_Z = 368 * MiB;
constexpr size_t Z_Q = WS_Z, Z_XR = WS_Z + 128 * MiB, Z_YR = WS_Z + 256 * MiB, Z_GA = WS_Z + 384 * MiB, Z_GR = WS_Z + 512 * MiB, Z_QI = WS_Z + 640 * MiB, Z_SM = WS_Z + 704 * MiB;
constexpr size_t WS_END = WS_Z + 736 * MiB;
constexpr size_t F_U = Z_Q;
constexpr size_t F_PB = Z_SM;
constexpr size_t F_H = Z_XR;
constexpr size_t F_H1 = WS_END;
constexpr size_t F_YE = Z_GA;
constexpr int MOE_CHUNK_TILES = 128;
constexpr size_t F_H_CHUNK_BYTES = (size_t)MOE_CHUNK_TILES * 256 * DFFE * 2;
constexpr size_t WS_NEED = F_H1 + F_H_CHUNK_BYTES;
static_assert(F_H + F_H_CHUNK_BYTES <= F_YE && F_YE + (size_t)520 * 256 * D * 2 <= Z_SM && F_H + (size_t)T_TOK * DFF * 2 <= Z_GR, "overlay map");
constexpr int CW_TMO = 0, CW_CODE = 1, CW_BAR = 4096, CW_CNT = 16384;
constexpr int RING_OFF = 0, RING_BYTES = 131072;
constexpr int LDSCTL_OFF = RING_BYTES, MISC_OFF = LDSCTL_OFF + 320;
constexpr int LDS_BYTES = 147456;

#define GAS __attribute__((address_space(1)))
#define LAS __attribute__((address_space(3)))
typedef unsigned short bf16;
typedef unsigned v4u __attribute__((ext_vector_type(4)));
typedef unsigned v2u __attribute__((ext_vector_type(2)));
typedef float f32x4 __attribute__((ext_vector_type(4)));
typedef float f32x16 __attribute__((ext_vector_type(16)));
typedef short bf16x8 __attribute__((ext_vector_type(8)));
typedef GAS unsigned gu32;
#define RLX_AGENT __ATOMIC_RELAXED, __HIP_MEMORY_SCOPE_AGENT
#define LDS_WAIT() asm volatile("s_waitcnt lgkmcnt(0)" ::: "memory")
#define VM_WAIT() asm volatile("s_waitcnt vmcnt(0)" ::: "memory")
using pg8::cvt_pk_bf16; using pg8::bf_lo; using pg8::bf_hi; using pg8::sigmoidf_fast;
#define XB_TMO      128
#define XB_XCNT(j)  (256  + 64 * (j))
#define XB_XSUB(j)  (1280 + 64 * (j))
#define XB_XGEN(j)  (2304 + 64 * (j))
#define XB_TOP      3328
#define XB_TOPGEN   3392
#define XCD_BAR_WORDS 3456
#define XB_SPIN_CAP (1u << 21)

__device__ __forceinline__ unsigned xb_ld(unsigned* p)              { return __hip_atomic_load(p, __ATOMIC_RELAXED, __HIP_MEMORY_SCOPE_AGENT); }
__device__ __forceinline__ unsigned xb_add(unsigned* p, unsigned v) { return __hip_atomic_fetch_add(p, v, __ATOMIC_RELAXED, __HIP_MEMORY_SCOPE_AGENT); }
__device__ __forceinline__ unsigned xb_xcc_id() { return (unsigned)__builtin_amdgcn_s_getreg((3 << 11) | 20) & 0xFu; }
#define XB_SPIN(cond, bar) do { unsigned _sp = 0; while (cond) { __builtin_amdgcn_s_sleep(1); \
    if ((++_sp & 255u) == 0u) { if (xb_ld(&(bar)[XB_TMO])) break; if (_sp > XB_SPIN_CAP) { atomicAdd(&(bar)[XB_TMO], 1u); break; } } } } while (0)

struct XcdBarrier {
    unsigned* bar; unsigned x;
    volatile LAS unsigned* st;
};

__device__ __forceinline__ XcdBarrier xcd_barrier_post(unsigned* bar, volatile LAS unsigned* st) {
    XcdBarrier b; b.bar = bar; b.x = xb_xcc_id(); b.st = st;
    if (threadIdx.x == 0) (void)xb_add(&bar[XB_XCNT(b.x)], 1u);
    return b;
}
__device__ __forceinline__ void xcd_barrier_complete(unsigned* bar, unsigned x, unsigned& nloc, unsigned& nx) {
    const unsigned G = gridDim.x * gridDim.y * gridDim.z;
    unsigned sum, cnt, mine, sp = 0u;
    for (;;) {
        sum = 0u; cnt = 0u; mine = 0u;
#pragma unroll
        for (unsigned j = 0; j < 16; ++j) { const unsigned c = xb_ld(&bar[XB_XCNT(j)]); sum += c; cnt += (c > 0u) ? 1u : 0u; mine = (j == x) ? c : mine; }
        if (sum == G) break;
        __builtin_amdgcn_s_sleep(1);
        if ((++sp & 255u) == 0u) { if (xb_ld(&bar[XB_TMO])) break; if (sp > XB_SPIN_CAP) { atomicAdd(&bar[XB_TMO], 1u); break; } }
    }
    nloc = mine > 0u ? mine : 1u; nx = cnt > 0u ? cnt : 1u;
}

__device__ __forceinline__ void xcd_barrier(const XcdBarrier& b) {
    asm volatile("s_waitcnt vmcnt(0)" ::: "memory");
    __syncthreads();
    if (threadIdx.x == 0) {
        unsigned* bar = b.bar;
        __builtin_amdgcn_s_waitcnt(0);
        unsigned nloc = b.st[0], nx = b.st[1];
        if (nloc == 0u) { xcd_barrier_complete(bar, b.x, nloc, nx); b.st[0] = nloc; b.st[1] = nx; }
        const unsigned old = xb_add(&bar[XB_XSUB(b.x)], 1u);
        const unsigned gen = old / nloc;
        if (old + 1u == (gen + 1u) * nloc) {
            __builtin_amdgcn_fence(__ATOMIC_RELEASE, "agent");
            asm volatile("s_waitcnt vmcnt(0)" ::: "memory");
            const unsigned og = xb_add(&bar[XB_TOP], 1u);
            const unsigned tg = og / nx;
            if (og + 1u == (tg + 1u) * nx) xb_add(&bar[XB_TOPGEN], 1u);
            else XB_SPIN(xb_ld(&bar[XB_TOPGEN]) == tg, bar);
            __builtin_amdgcn_fence(__ATOMIC_ACQUIRE, "agent");
            xb_add(&bar[XB_XGEN(b.x)], 1u);
            asm volatile("s_waitcnt vmcnt(0)" ::: "memory");
        } else {
            XB_SPIN(xb_ld(&bar[XB_XGEN(b.x)]) == gen, bar);
            __builtin_amdgcn_fence(__ATOMIC_ACQUIRE, "agent");
            asm volatile("s_waitcnt vmcnt(0)" ::: "memory");
        }
    }
    __syncthreads();
}
struct Frame {
    LAS unsigned char* lds;
    volatile LAS unsigned* MISC;
    gu32* ctl;
    int tid, lane, wave, G, bx;
    unsigned char* ws;
    float* out;
};
struct Args { const float* in[28]; float* out; unsigned char* ws; };
typedef const __attribute__((address_space(4))) Args* KArgs;
__device__ __forceinline__ KArgs kargs() { KArgs k = (KArgs)__builtin_amdgcn_kernarg_segment_ptr(); asm volatile("" : "+s"(k)); return k; }
enum { I_X = 0, I_P, I_WIN, I_CONVW, I_CONVB, I_LRUWA, I_LRUBA, I_LRUWX, I_LRUBX, I_LAM, I_WBRA, I_WBRR, I_WO, I_RELB, I_LN1G, I_LN1B, I_FFG, I_FFU, I_FFD, I_ROUTER, I_ROUTERB, I_MOEG, I_MOEU, I_MOED, I_PLEG, I_PLEP, I_LN2G, I_LN2B };

__device__ __forceinline__ Frame launder(const Frame& F0) { Frame F = F0; unsigned char* w = F0.ws; int l = (int)__builtin_amdgcn_mbcnt_hi(~0u, __builtin_amdgcn_mbcnt_lo(~0u, 0u)); asm volatile("" : "+s"(w)); asm volatile("" : "+v"(l));
    F.ws = w; F.lane = l; F.tid = F0.wave * 64 + l; F.ctl = (gu32*)(w + WS_CTL); return F; }
__device__ __forceinline__ float lane_get(float v, int src_lane) { return __builtin_bit_cast(float, __builtin_amdgcn_ds_bpermute(src_lane << 2, __builtin_bit_cast(int, v))); }
__device__ __forceinline__ float lane_xor(float v, int mask, int lane) { return lane_get(v, lane ^ mask); }
__device__ __forceinline__ float lane_up(float v, int d, int lane) { return lane_get(v, lane >= d ? lane - d : lane); }
__device__ __forceinline__ float wave_sum(float v, int lane) {
#pragma unroll
    for (int o = 1; o < 64; o <<= 1) v += lane_xor(v, o, lane);
    return v;
}
__device__ __forceinline__ unsigned pk2(float lo, float hi) { return cvt_pk_bf16(lo, hi); }

__device__ __forceinline__ void cvt_item(const float* W, int ldw, int K, bf16* WT, int d0, int sc0, int nvalid, float scale, int k0, LAS float* scr, int lane) {
    const int n = lane & 31;
#pragma unroll 8
    for (int i = 0; i < 32; ++i) { const int kk = 2 * i + (lane >> 5); float v = 0.f; if (n < nvalid) v = ((const GAS float*)W)[(size_t)(k0 + kk) * ldw + sc0 + n] * scale; scr[kk * 33 + n] = v; }
    LDS_WAIT(); asm volatile("" ::: "memory");
    const int c = lane & 7;
#pragma unroll
    for (int j = 0; j < 4; ++j) { const int nn = (lane >> 3) + 8 * j; const LAS float* s = scr + (8 * c) * 33 + nn;
        v4u o; o.x = pk2(s[0 * 33], s[1 * 33]); o.y = pk2(s[2 * 33], s[3 * 33]); o.z = pk2(s[4 * 33], s[5 * 33]); o.w = pk2(s[6 * 33], s[7 * 33]);
        *(GAS v4u*)(WT + (size_t)(d0 + nn) * K + k0 + 8 * c) = o; }
    LDS_WAIT(); asm volatile("" ::: "memory");
}
__device__ __forceinline__ void cvt_plain(const float* W, int K, int N, bf16* WT, int item, LAS float* scr, int lane) {
    const int nblk = N / 32, kb = item / nblk, nb = item % nblk;
    cvt_item(W, N, K, WT, 32 * nb, 32 * nb, 32, 1.0f, 64 * kb, scr, lane);
}
__device__ __forceinline__ void cvt_gateup(const float* Wg, const float* Wu, int dff, bf16* WT, int item, LAS float* scr, int lane) {
    const int nblk = 2 * dff / 32, kb = item / nblk, db = item % nblk, d0 = 32 * db, pn = d0 >> 8, r = d0 & 255;
    const float* W = r < 128 ? Wg : Wu; const int sc0 = 128 * pn + (r & 127);
    cvt_item(W, dff, D, WT, d0, sc0, 32, 1.0f, 64 * kb, scr, lane);
}
__device__ __forceinline__ void cvt_win(const float* W, bf16* WT, int item, LAS float* scr, int lane) {
    const int nblk = NIN / 32, kb = item / nblk, db = item % nblk, d0 = 32 * db;
    int sc0, nv = 32; float sc = 1.0f;
    if (d0 < 1024) { sc0 = d0; sc = 0.125f; }
    else if (d0 < 2048) sc0 = 1736 + (d0 - 1024);
    else if (d0 < 3072) sc0 = 2760 + (d0 - 2048);
    else if (d0 < 4096) sc0 = 3784 + (d0 - 3072);
    else if (d0 < 5120) sc0 = 4808 + (d0 - 4096);
    else if (d0 < 5632) sc0 = 1152 + (d0 - 5120);
    else if (d0 < 5696) sc0 = 1024 + (d0 - 5632);
    else if (d0 < 5760) sc0 = 1088 + (d0 - 5696);
    else if (d0 < 5824) sc0 = 1664 + (d0 - 5760);
    else if (d0 == 5824) { sc0 = 1728; nv = 8; }
    else { sc0 = 0; nv = 0; }
    cvt_item(W, D_IN, D, WT, d0, sc0, nv, sc, 64 * kb, scr, lane);
}
__device__ __forceinline__ void p0_convert(const Frame& F0, int L) {
    Frame F = launder(F0);
    const KArgs ka = kargs();
    LAS float* scr = (LAS float*)(F.lds + RING_OFF + F.wave * 16384);
    const int gw = F.bx * NWAVES + F.wave, NGW = F.G * NWAVES;
    unsigned char* wb = F.ws + WS_W;
    const int odd = L & 1, jj = L >> 1;
    constexpr int I_IN = (D / 64) * (NIN / 32), I_SQ = (D / 64) * (D / 32), I_PPJ = (PLE / 64) * (D / 32), I_LRU1 = 2 * 4;
    constexpr int I_GU_D = (D / 64) * (2 * DFF / 32), I_DN_D = (DFF / 64) * (D / 32), I_GU_E = (D / 64) * (2 * DFFE / 32), I_DN_E = (DFFE / 64) * (D / 32);
    const int n_ff = odd ? NEXP * (I_GU_E + I_DN_E) : (I_GU_D + I_DN_D);
    const int NITEMS = I_IN + 4 * I_SQ + I_PPJ + 16 * I_LRU1 + n_ff;
    for (int it = gw; it < NITEMS; it += NGW) {
        int r = it;
        if (r < I_IN) { cvt_win(ka->in[I_WIN] + (size_t)L * D * D_IN, (bf16*)(wb + W_IN), r, scr, F.lane); continue; } r -= I_IN;
        if (r < I_SQ) { cvt_plain(ka->in[I_WBRA] + (size_t)L * D * D, D, D, (bf16*)(wb + W_BRA), r, scr, F.lane); continue; } r -= I_SQ;
        if (r < I_SQ) { cvt_plain(ka->in[I_WBRR] + (size_t)L * D * D, D, D, (bf16*)(wb + W_BRR), r, scr, F.lane); continue; } r -= I_SQ;
        if (r < I_SQ) { cvt_plain(ka->in[I_WO] + (size_t)L * D * D, D, D, (bf16*)(wb + W_O), r, scr, F.lane); continue; } r -= I_SQ;
        if (r < I_SQ) { cvt_plain(ka->in[I_PLEG] + (size_t)L * D * D, D, D, (bf16*)(wb + W_PG), r, scr, F.lane); continue; } r -= I_SQ;
        if (r < I_PPJ) { cvt_plain(ka->in[I_PLEP] + (size_t)L * PLE * D, PLE, D, (bf16*)(wb + W_PP), r, scr, F.lane); continue; } r -= I_PPJ;
        if (r < 16 * I_LRU1) { const int m = r / I_LRU1, blk = m & 7, which = m >> 3;
            const float* src = ka->in[which ? I_LRUWX : I_LRUWA] + (size_t)L * 8 * 128 * 128 + (size_t)blk * 128 * 128;
            cvt_plain(src, 128, 128, (bf16*)(wb + W_LRU) + (size_t)which * 8 * 128 * 128 + (size_t)blk * 128 * 128, r % I_LRU1, scr, F.lane); continue; } r -= 16 * I_LRU1;
        if (!odd) {
            if (r < I_GU_D) { cvt_gateup(ka->in[I_FFG] + (size_t)jj * D * DFF, ka->in[I_FFU] + (size_t)jj * D * DFF, DFF, (bf16*)(wb + W_FF), r, scr, F.lane); continue; } r -= I_GU_D;
            cvt_plain(ka->in[I_FFD] + (size_t)jj * DFF * D, DFF, D, (bf16*)(wb + W_FF_DN_DENSE), r, scr, F.lane);
        } else {
            if (r < NEXP * I_GU_E) { const int e = r / I_GU_E; const size_t eo = ((size_t)jj * NEXP + e) * D * DFFE;
                cvt_gateup(ka->in[I_MOEG] + eo, ka->in[I_MOEU] + eo, DFFE, (bf16*)(wb + W_FF) + (size_t)e * 2 * DFFE * D, r % I_GU_E, scr, F.lane); continue; } r -= NEXP * I_GU_E;
            const int e = r / I_DN_E; const size_t eo = ((size_t)jj * NEXP + e) * DFFE * D;
            cvt_plain(ka->in[I_MOED] + eo, DFFE, D, (bf16*)(wb + W_FF_DN_MOE) + (size_t)e * D * DFFE, r % I_DN_E, scr, F.lane);
        }
    }
    if (L == 0) {
        const GAS f32x4* x4 = (const GAS f32x4*)ka->in[I_X]; GAS v4u* o = (GAS v4u*)(F.ws + WS_XB);
        const size_t n8 = (size_t)T_TOK * D / 8;
        for (size_t i = (size_t)F.bx * 512 + F.tid; i < n8; i += (size_t)F.G * 512) { const f32x4 a = x4[2 * i], b = x4[2 * i + 1];
            v4u w; w.x = pk2(a[0], a[1]); w.y = pk2(a[2], a[3]); w.z = pk2(b[0], b[1]); w.w = pk2(b[2], b[3]); o[i] = w; }
    }
}

template <bool LN2, bool ODD, bool DRY = false>
__device__ __forceinline__ void ln_phase(const Frame& F0, int L) {
    Frame F = launder(F0);
    const KArgs ka = kargs();
    const int jj = L >> 1;
    float* X32 = F.out; bf16* XB = (bf16*)(F.ws + WS_XB);
    const float* gam = ka->in[LN2 ? I_LN2G : I_LN1G] + (size_t)L * D; const float* bet = ka->in[LN2 ? I_LN2B : I_LN1B] + (size_t)L * D;
    f32x4 gv[4], bv[4];
#pragma unroll
    for (int j = 0; j < 4; ++j) { gv[j] = ((const GAS f32x4*)gam)[F.lane + 64 * j]; bv[j] = ((const GAS f32x4*)bet)[F.lane + 64 * j]; }
    LAS float* RT = (LAS float*)(F.lds + RING_OFF);
    LAS unsigned* TE = (LAS unsigned*)(F.lds + RING_OFF + 32768);
    volatile LAS unsigned* lcnt = F.MISC + 48; volatile LAS unsigned* gbase = F.MISC + 56;
    float rb[8];
    if (!LN2 && ODD) {
        const float* R = ka->in[I_ROUTER] + (size_t)jj * D * NEXP;
        for (int i = F.tid; i < D * NEXP; i += 512) RT[i] = R[i];
        if (F.tid < 8) lcnt[F.tid] = 0u;
#pragma unroll
        for (int e = 0; e < 8; ++e) rb[e] = ka->in[I_ROUTERB][jj * NEXP + e];
        __syncthreads();
    }
    const unsigned* route = (const unsigned*)(F.ws + WS_ROUTE);
    const bf16* YE = (const bf16*)(F.ws + F_YE);
    for (int it = 0; it < 32; ++it) {
        const int rl = F.wave + 8 * it; const size_t row = (size_t)F.bx * 256 + rl;
        GAS f32x4* xr = (GAS f32x4*)(X32 + row * D) + F.lane;
        f32x4 v[4]; float s = 0.f;
#pragma unroll
        for (int j = 0; j < 4; ++j) v[j] = xr[64 * j];
        if (LN2 && ODD) {
            const unsigned e1 = route[row * 8 + 0], e2 = route[row * 8 + 1], p1 = route[row * 8 + 2], p2 = route[row * 8 + 3];
            const float g1 = __builtin_bit_cast(float, route[row * 8 + 4]), g2 = __builtin_bit_cast(float, route[row * 8 + 5]);
            const size_t r1 = (size_t)F.MISC[16 + e1] * 256 + p1, r2 = (size_t)F.MISC[16 + e2] * 256 + p2;
            const GAS v2u* y1 = (const GAS v2u*)(YE + r1 * D) + F.lane; const GAS v2u* y2 = (const GAS v2u*)(YE + r2 * D) + F.lane;
#pragma unroll
            for (int j = 0; j < 4; ++j) { const v2u a = y1[64 * j], b = y2[64 * j];
                v[j][0] += g1 * bf_lo(a.x) + g2 * bf_lo(b.x); v[j][1] += g1 * bf_hi(a.x) + g2 * bf_hi(b.x);
                v[j][2] += g1 * bf_lo(a.y) + g2 * bf_lo(b.y); v[j][3] += g1 * bf_hi(a.y) + g2 * bf_hi(b.y); }
        }
#pragma unroll
        for (int j = 0; j < 4; ++j) s += (v[j][0] + v[j][1]) + (v[j][2] + v[j][3]);
        const float mean = wave_sum(s, F.lane) * (1.f / D); float s2 = 0.f;
#pragma unroll
        for (int j = 0; j < 4; ++j) { v[j] = v[j] - mean; s2 += (v[j][0] * v[j][0] + v[j][1] * v[j][1]) + (v[j][2] * v[j][2] + v[j][3] * v[j][3]); }
        const float rstd = 1.f / sqrtf(wave_sum(s2, F.lane) * (1.f / D) + LN_EPS);
        GAS v2u* o8 = (GAS v2u*)((DRY ? (bf16*)(F.ws + WS_NEED) : XB) + row * D) + F.lane;
        GAS f32x4* xw = DRY ? (GAS f32x4*)((float*)(F.ws + WS_NEED) + row * D) + F.lane : xr;
#pragma unroll
        for (int j = 0; j < 4; ++j) { v[j] = v[j] * rstd * gv[j] + bv[j]; if (DRY || (LN2 && L == DEPTH - 1)) xw[64 * j] = v[j];
            v2u w; w.x = pk2(v[j][0], v[j][1]); w.y = pk2(v[j][2], v[j][3]); o8[64 * j] = w; }
        if (!LN2) {
            const f32x4 pv = ((const GAS f32x4*)(ka->in[I_P] + ((size_t)L * T_TOK + row) * PLE))[F.lane];
            v2u w; w.x = pk2(pv[0], pv[1]); w.y = pk2(pv[2], pv[3]); ((GAS v2u*)(F.ws + (DRY ? WS_NEED : F_PB) + row * PLE * 2))[F.lane] = w;
        }
        if (!LN2 && ODD) {
            float lg[8];
#pragma unroll
            for (int e = 0; e < 8; ++e) lg[e] = 0.f;
#pragma unroll
            for (int j = 0; j < 4; ++j)
#pragma unroll
                for (int q = 0; q < 4; ++q) { const int c = 4 * F.lane + 256 * j + q; const f32x4 ra = *(const LAS f32x4*)(RT + c * 8), rc = *(const LAS f32x4*)(RT + c * 8 + 4); const float xv = v[j][q];
                    lg[0] += xv * ra[0]; lg[1] += xv * ra[1]; lg[2] += xv * ra[2]; lg[3] += xv * ra[3]; lg[4] += xv * rc[0]; lg[5] += xv * rc[1]; lg[6] += xv * rc[2]; lg[7] += xv * rc[3]; }
#pragma unroll
            for (int e = 0; e < 8; ++e) lg[e] = wave_sum(lg[e], F.lane) + rb[e];
            int e1 = 0; float v1 = lg[0];
#pragma unroll
            for (int e = 1; e < 8; ++e) if (lg[e] > v1) { v1 = lg[e]; e1 = e; }
            int e2 = -1; float v2 = 0.f;
#pragma unroll
            for (int e = 0; e < 8; ++e) if (e != e1 && (e2 < 0 || lg[e] > v2)) { v2 = lg[e]; e2 = e; }
            const float ex = __expf(v2 - v1), g1 = 1.f / (1.f + ex), g2 = ex * g1;
            if (F.lane == 0) { const unsigned lp1 = __hip_atomic_fetch_add((LAS unsigned*)lcnt + e1, 1u, __ATOMIC_RELAXED, __HIP_MEMORY_SCOPE_WORKGROUP), lp2 = __hip_atomic_fetch_add((LAS unsigned*)lcnt + e2, 1u, __ATOMIC_RELAXED, __HIP_MEMORY_SCOPE_WORKGROUP);
                TE[rl * 4 + 0] = (unsigned)e1 | ((unsigned)e2 << 8) | (lp1 << 16); TE[rl * 4 + 1] = lp2; TE[rl * 4 + 2] = __builtin_bit_cast(unsigned, g1); TE[rl * 4 + 3] = __builtin_bit_cast(unsigned, g2); }
        }
    }
    if (!LN2 && ODD) {
        __syncthreads();
        if (F.tid < 8) gbase[F.tid] = __hip_atomic_fetch_add(F.ctl + CW_CNT + jj * 1024 + 64 * F.tid, lcnt[F.tid], RLX_AGENT);
        __syncthreads();
        if (F.tid < 256) { const unsigned w0 = TE[F.tid * 4], lp2 = TE[F.tid * 4 + 1]; const unsigned e1 = w0 & 255u, e2 = (w0 >> 8) & 255u, lp1 = w0 >> 16;
            const unsigned p1 = gbase[e1] + lp1, p2 = gbase[e2] + lp2; const unsigned tok = (unsigned)F.bx * 256 + F.tid;
            GAS int* list = (GAS int*)(F.ws + WS_LIST); list[(size_t)e1 * T_TOK + p1] = (int)tok; list[(size_t)e2 * T_TOK + p2] = (int)tok;
            GAS v4u* ro = (GAS v4u*)(F.ws + WS_ROUTE) + (size_t)tok * 2; v4u a; a.x = e1; a.y = e2; a.z = p1; a.w = p2; ro[0] = a; v4u b; b.x = TE[F.tid * 4 + 2]; b.y = TE[F.tid * 4 + 3]; b.z = 0u; b.w = 0u; ro[1] = b; }
        __syncthreads();
    }
}
template <int NJ>
__device__ __forceinline__ void select_topk_n(LAS const float* sc, int n_adm, GAS unsigned short* out, int lane) {
    const int nj = n_adm >> 6;
    unsigned u[NJ];
#pragma unroll
    for (int j = 0; j < NJ; ++j) { unsigned b = 0u;
        if (j < NJ - 8 || j < nj) { b = __builtin_bit_cast(unsigned, sc[64 * j + lane]); b = (b == 0x80000000u) ? 0u : b; b = (b & 0x80000000u) ? ~b : (b | 0x80000000u); }
        u[j] = b; }
    unsigned prefix = 0u; bool exact = false;
    for (int bit = 31; bit >= 0; --bit) {
        const unsigned cand = prefix | (1u << bit); int cnt = 0;
#pragma unroll
        for (int j = 0; j < NJ; ++j) cnt += __popcll(__ballot(u[j] >= cand));
        if (cnt >= 256) { prefix = cand; if (cnt == 256) { exact = true; break; } }
    }
    const unsigned thr = exact ? prefix - 1u : prefix;
    int ngt = 0;
#pragma unroll
    for (int j = 0; j < NJ; ++j) ngt += __popcll(__ballot(u[j] > thr));
    const int quota = 256 - ngt;
    int obase = 0, tbase = 0; const unsigned long long lt = (1ull << lane) - 1ull;
#pragma unroll
    for (int j = 0; j < NJ; ++j) {
        const bool gt = u[j] > thr, eq = u[j] == thr;
        const unsigned long long meq = __ballot(eq);
        const bool seleq = eq && (tbase + __popcll(meq & lt) < quota);
        const unsigned long long msel = __ballot(gt || seleq);
        if (gt || seleq) out[obase + __popcll(msel & lt)] = (unsigned short)(64 * j + lane);
        obase += __popcll(msel); tbase += __popcll(meq);
    }
}
__device__ __forceinline__ void select_topk(LAS const float* sc, int n_adm, GAS unsigned short* out, int lane) {
    if (n_adm <= 256) {
#pragma unroll
        for (int j = 0; j < 4; ++j) { const int p = lane + 64 * j; out[p] = (unsigned short)(p < n_adm ? p : 0); }
        return;
    }
    if (n_adm <= 512) select_topk_n<8>(sc, n_adm, out, lane);
    else if (n_adm <= 1024) select_topk_n<16>(sc, n_adm, out, lane);
    else if (n_adm <= 1536) select_topk_n<24>(sc, n_adm, out, lane);
    else select_topk_n<32>(sc, n_adm, out, lane);
}
__device__ __forceinline__ void indexer_phase(const Frame& F0) {
    Frame F = launder(F0);
    LAS float* sc = (LAS float*)(F.lds + RING_OFF);
    const bf16* QI = (const bf16*)(F.ws + Z_QI); const bf16* SM = (const bf16*)(F.ws + Z_SM);
    GAS unsigned short* IDX = (GAS unsigned short*)(F.ws + WS_IDX);
    const int lane = F.lane, h = lane >> 5, r = lane & 31;
    const int rq = 2 * ((r >> 2) & 1) + ((r >> 4) & 1), rh = (r & 3) + 4 * ((r >> 3) & 1);
    const int vcu = (F.bx & 7) * (F.G >> 3) + (F.bx >> 3);
    bf16x8 A[4][4]; v4u wq[4][2];
#define IDX_TILE(pi_, b_, tq_) const int pid_ = vcu * 8 + ((pi_) >> 1), b_ = pid_ >> 6, jp_ = pid_ & 63, tq_ = 16 * (((pi_) & 1) ? 127 - jp_ : jp_)
#define IDX_LOAD_A(t0_) do { _Pragma("unroll") for (int mt = 0; mt < 4; ++mt) { \
        _Pragma("unroll") for (int s = 0; s < 4; ++s) A[mt][s] = *(const GAS bf16x8*)(QI + (size_t)((t0_) + 4 * mt + rq) * 512 + rh * 64 + 16 * s + 8 * h); \
        _Pragma("unroll") for (int qq = 0; qq < 2; ++qq) wq[mt][qq] = *(const GAS v4u*)(SM + (size_t)((t0_) + 4 * mt + 2 * h + qq) * 256 + 192); } } while (0)
    { IDX_TILE(0, b0, tq0); if (tq0 >= 256) IDX_LOAD_A(b0 * SEQ + tq0); }
    for (int pi = 0; pi < 16; ++pi) {
        IDX_TILE(pi, b, tq);
        const int t0 = b * SEQ + tq;
        const int n_adm = ((tq >> 6) + 1) * 64, nkb = n_adm >> 5;
        if (n_adm > 256) {
            for (int kb = F.wave; kb < nkb; kb += 8) {
                const int key = 32 * kb + r;
                bf16x8 B[4];
#pragma unroll
                for (int s = 0; s < 4; ++s) B[s] = *(const GAS bf16x8*)(SM + (size_t)(b * SEQ + key) * 256 + 128 + 16 * s + 8 * h);
#pragma unroll
                for (int mt = 0; mt < 4; ++mt) {
                    f32x16 acc;
#pragma unroll
                    for (int i = 0; i < 16; ++i) acc[i] = 0.f;
#pragma unroll
                    for (int s = 0; s < 4; ++s) acc = __builtin_amdgcn_mfma_f32_32x32x16_bf16(A[mt][s], B[s], acc, 0, 0, 0);
                    float sA = 0.f, sB = 0.f;
#pragma unroll
                    for (int i = 0; i < 8; ++i) { const unsigned wa = wq[mt][0][i >> 1], wb = wq[mt][1][i >> 1];
                        const float fa = (i & 1) ? bf_hi(wa) : bf_lo(wa), fb = (i & 1) ? bf_hi(wb) : bf_lo(wb);
                        sA += fmaxf(acc[i], 0.f) * fa; sB += fmaxf(acc[8 + i], 0.f) * fb; }
                    sc[(4 * mt + 2 * h) * 2048 + key] = sA; sc[(4 * mt + 2 * h + 1) * 2048 + key] = sB;
                }
            }
        }
        __syncthreads();
        if (pi < 15) { IDX_TILE(pi + 1, bn, tqn); if (tqn >= 256) IDX_LOAD_A(bn * SEQ + tqn); }
#pragma unroll 1
        for (int qq = 0; qq < 2; ++qq) { const int q = 2 * F.wave + qq; select_topk(sc + q * 2048, n_adm, IDX + (size_t)(t0 + q) * 256, lane); }
        __syncthreads();
    }
#undef IDX_TILE
#undef IDX_LOAD_A
}

__device__ __forceinline__ unsigned vst_off(unsigned r, unsigned ch) { return r * 128u + 16u * (ch ^ ((((r >> 1) ^ (r >> 4)) & 1u) << 1) ^ (((r >> 3) & 1u) << 2)); }
__device__ __forceinline__ int t5_bucket_dev(int rel) {
    const int n = rel < 0 ? -rel : rel;
    int v = n;
    if (n >= 8) v = 8 + (n >= 12) + (n >= 16) + (n >= 23) + (n >= 32) + (n >= 46) + (n >= 64) + (n >= 91);
    return v + (rel > 0 ? 16 : 0);
}
#ifndef ATT_REPS
#define ATT_REPS 1
#endif
#ifndef ATT_FIXKEYS
#define ATT_FIXKEYS 0
#endif
template <int FIX = 0>
__device__ __forceinline__ void attention_phase(const Frame& F0) {
#pragma unroll 1
    for (int rep = 0; rep < ATT_REPS; ++rep) {
    Frame F = launder(F0);
    const bf16* SM = (const bf16*)(F.ws + Z_SM); const bf16* Q = (const bf16*)(F.ws + Z_Q); bf16* OB = (bf16*)(F.ws + Z_XR);
    const GAS unsigned short* IDX = (const GAS unsigned short*)(F.ws + WS_IDX);
    const int lane = F.lane, g = lane >> 4, m = lane & 15;
    LAS unsigned char* vst = F.lds + RING_OFF + F.wave * 4096;
    const unsigned vbase = (unsigned)(size_t)vst;
    LAS unsigned char* BK = F.lds + RING_OFF + 32768; LAS unsigned char* OH = F.lds + RING_OFF + 32768 + 2176;
    for (int i = F.tid; i < 2112; i += 512) BK[i] = (unsigned char)t5_bucket_dev(i - 2047);
    if (F.tid < 128) { const int bkt = F.tid >> 2, gg = F.tid & 3, j = bkt - 8 * gg; v4u oh; oh.x = oh.y = oh.z = oh.w = 0u;
        if (j >= 0 && j < 8) { const unsigned val = (j & 1) ? 0x3F800000u : 0x3F80u; if ((j >> 1) == 0) oh.x = val; else if ((j >> 1) == 1) oh.y = val; else if ((j >> 1) == 2) oh.z = val; else oh.w = val; }
        *(LAS v4u*)(OH + F.tid * 16) = oh; }
    __syncthreads();
    bf16x8 bb;
    { const float* rbias = kargs()->in[I_RELB]; unsigned w[4];
#pragma unroll
      for (int j = 0; j < 4; ++j) w[j] = pk2(rbias[(8 * g + 2 * j) * 16 + m], rbias[(8 * g + 2 * j + 1) * 16 + m]);
      v4u t; t.x = w[0]; t.y = w[1]; t.z = w[2]; t.w = w[3]; bb = __builtin_bit_cast(bf16x8, t); }
    unsigned tra[4][2];
    { const unsigned q = (lane & 15) >> 2, p = lane & 3;
#pragma unroll
      for (int c = 0; c < 4; ++c)
#pragma unroll
        for (int t = 0; t < 2; ++t) tra[c][t] = vst_off(8 * g + 4 * t + q, 2 * c + (p >> 1)) + 8 * (p & 1); }
    const int vcu = (F.bx & 7) * (F.G >> 3) + (F.bx >> 3);
    v4u ni0, ni1; bf16x8 nq[2]; bf16x8 ka[16][2]; unsigned koff[16];
#define ATT_KOFF(i0_, i1_) do { _Pragma("unroll") for (int k = 0; k < 4; ++k) { koff[2 * k] = ((i0_)[k] & 0xffffu) * 512u + 16u * g; koff[2 * k + 1] = ((i0_)[k] >> 16) * 512u + 16u * g; \
        koff[8 + 2 * k] = ((i1_)[k] & 0xffffu) * 512u + 16u * g; koff[8 + 2 * k + 1] = ((i1_)[k] >> 16) * 512u + 16u * g; } } while (0)
#define ATT_KLOAD(kvb_) do { const GAS char* kb_ = (kvb_); _Pragma("unroll") for (int T = 0; T < 16; ++T) { \
        asm volatile("global_load_dwordx4 %0, %2, %3\n\tglobal_load_dwordx4 %1, %2, %3 offset:64" : "=&v"(ka[T][0]), "=&v"(ka[T][1]) : "v"(koff[T]), "s"(kb_) : "memory"); } } while (0)
#define ATT_KWAIT(n_, T0_) asm volatile("s_waitcnt vmcnt(" #n_ ")" : "+v"(ka[T0_][0]), "+v"(ka[T0_][1]), "+v"(ka[T0_ + 1][0]), "+v"(ka[T0_ + 1][1]), "+v"(ka[T0_ + 2][0]), "+v"(ka[T0_ + 2][1]), "+v"(ka[T0_ + 3][0]), "+v"(ka[T0_ + 3][1]), \
        "+v"(ka[T0_ + 4][0]), "+v"(ka[T0_ + 4][1]), "+v"(ka[T0_ + 5][0]), "+v"(ka[T0_ + 5][1]), "+v"(ka[T0_ + 6][0]), "+v"(ka[T0_ + 6][1]), "+v"(ka[T0_ + 7][0]), "+v"(ka[T0_ + 7][1]) :: "memory")
    { const int tok0 = vcu * 256 + F.wave; const GAS v4u* ip = (const GAS v4u*)(IDX + (size_t)tok0 * 256 + 16 * m); ni0 = ip[0]; ni1 = ip[1];
#pragma unroll
      for (int s = 0; s < 2; ++s) nq[s] = *(const GAS bf16x8*)(Q + (size_t)tok0 * D + m * 64 + 32 * s + 8 * g);
      ATT_KOFF(ni0, ni1); ATT_KLOAD((const GAS char*)(SM + (size_t)(tok0 >> 11) * SEQ * 256)); }
    for (int it = 0; it < 32; ++it) {
        const int tok = vcu * 256 + F.wave + 8 * it, b = tok >> 11, tq = tok & (SEQ - 1);
        const int n_valid = (((tq >> 6) + 1) * 64) < 256 ? ((tq >> 6) + 1) * 64 : 256;
        bf16x8 qf[2]; qf[0] = nq[0]; qf[1] = nq[1];
        const GAS char* kvb = (const GAS char*)(SM + (size_t)b * SEQ * 256);
        f32x4 S[16];
#pragma unroll
        for (int T = 0; T < 16; ++T) {
            if (T == 0) ATT_KWAIT(16, 0);
            if (T == 8) ATT_KWAIT(0, 8);
            const unsigned bkt = BK[(koff[T] >> 9) + (2047 - tq)];
            const v4u oh = *(const LAS v4u*)(OH + bkt * 64 + g * 16);
            f32x4 a = (f32x4){0.f, 0.f, 0.f, 0.f};
            a = __builtin_amdgcn_mfma_f32_16x16x32_bf16(__builtin_bit_cast(bf16x8, oh), bb, a, 0, 0, 0);
            a = __builtin_amdgcn_mfma_f32_16x16x32_bf16(ka[T][0], qf[0], a, 0, 0, 0);
            a = __builtin_amdgcn_mfma_f32_16x16x32_bf16(ka[T][1], qf[1], a, 0, 0, 0);
            S[T] = a;
        }
        __builtin_amdgcn_sched_barrier(0);
        v4u vv[16][2];
#pragma unroll
        for (int T = 0; T < 12; ++T) { vv[T][0] = *(const GAS v4u*)(kvb + koff[T] + 128); vv[T][1] = *(const GAS v4u*)(kvb + koff[T] + 192); }
        if (n_valid < 256) {
#pragma unroll
            for (int T = 0; T < 16; ++T)
#pragma unroll
                for (int i = 0; i < 4; ++i) if (16 * (4 * g + i) + T >= n_valid) S[T][i] = -1e30f;
        }
        float mx = -3.0e38f;
#pragma unroll
        for (int T = 0; T < 16; ++T) mx = fmaxf(fmaxf(fmaxf(S[T][0], S[T][1]), fmaxf(S[T][2], S[T][3])), mx);
        mx = fmaxf(mx, lane_xor(mx, 16, lane)); mx = fmaxf(mx, lane_xor(mx, 32, lane));
        const float mneg = -mx * 1.4426950408889634f; float sum = 0.f;
#pragma unroll
        for (int T = 0; T < 16; ++T)
#pragma unroll
            for (int i = 0; i < 4; ++i) { const float p = __builtin_amdgcn_exp2f(S[T][i] * 1.4426950408889634f + mneg); S[T][i] = p; sum += p; }
        sum += lane_xor(sum, 16, lane); sum += lane_xor(sum, 32, lane);
        { const int tokn = vcu * 256 + F.wave + 8 * (it < 31 ? it + 1 : it); const GAS v4u* ip = (const GAS v4u*)(IDX + (size_t)tokn * 256 + 16 * m); ni0 = ip[0]; ni1 = ip[1];
#pragma unroll
          for (int s = 0; s < 2; ++s) nq[s] = *(const GAS bf16x8*)(Q + (size_t)tokn * D + m * 64 + 32 * s + 8 * g); }
        f32x4 O[4];
#pragma unroll
        for (int c = 0; c < 4; ++c) O[c] = (f32x4){0.f, 0.f, 0.f, 0.f};
#pragma unroll
        for (int ks = 0; ks < 8; ++ks) {
            const unsigned vb = vbase;
            if (ks == 2) {
#pragma unroll
                for (int T = 12; T < 16; ++T) { vv[T][0] = *(const GAS v4u*)(kvb + koff[T] + 128); vv[T][1] = *(const GAS v4u*)(kvb + koff[T] + 192); }
            }
#pragma unroll
            for (int tt = 0; tt < 2; ++tt) { const v4u v0 = vv[2 * ks + tt][0], v1 = vv[2 * ks + tt][1];
                const unsigned rr = 8 * (m >> 2) + 4 * tt + (m & 3);
                *(LAS v4u*)(vst + vst_off(rr, g)) = v0; *(LAS v4u*)(vst + vst_off(rr, g + 4)) = v1; }
            v4u pw; pw.x = pk2(S[2 * ks][0], S[2 * ks][1]); pw.y = pk2(S[2 * ks][2], S[2 * ks][3]); pw.z = pk2(S[2 * ks + 1][0], S[2 * ks + 1][1]); pw.w = pk2(S[2 * ks + 1][2], S[2 * ks + 1][3]);
            const bf16x8 pf = __builtin_bit_cast(bf16x8, pw);
            v2u f[4][2];
            asm volatile("s_waitcnt lgkmcnt(0)\n\t"
                         "ds_read_b64_tr_b16 %0, %8\n\tds_read_b64_tr_b16 %1, %9\n\tds_read_b64_tr_b16 %2, %10\n\tds_read_b64_tr_b16 %3, %11\n\t"
                         "ds_read_b64_tr_b16 %4, %12\n\tds_read_b64_tr_b16 %5, %13\n\tds_read_b64_tr_b16 %6, %14\n\tds_read_b64_tr_b16 %7, %15\n\t"
                         "s_waitcnt lgkmcnt(0)"
                         : "=&v"(f[0][0]), "=&v"(f[0][1]), "=&v"(f[1][0]), "=&v"(f[1][1]), "=&v"(f[2][0]), "=&v"(f[2][1]), "=&v"(f[3][0]), "=&v"(f[3][1])
                         : "v"(vb + tra[0][0]), "v"(vb + tra[0][1]), "v"(vb + tra[1][0]), "v"(vb + tra[1][1]), "v"(vb + tra[2][0]), "v"(vb + tra[2][1]), "v"(vb + tra[3][0]), "v"(vb + tra[3][1])
                         : "memory");
#pragma unroll
            for (int c = 0; c < 4; ++c) { v4u t; t.x = f[c][0].x; t.y = f[c][0].y; t.z = f[c][1].x; t.w = f[c][1].y;
                O[c] = __builtin_amdgcn_mfma_f32_16x16x32_bf16(__builtin_bit_cast(bf16x8, t), pf, O[c], 0, 0, 0); }
        }
        const float inv = 1.0f / sum;
#pragma unroll
        for (int c = 0; c < 4; ++c) { v2u w; w.x = pk2(O[c][0] * inv, O[c][1] * inv); w.y = pk2(O[c][2] * inv, O[c][3] * inv);
            *(GAS v2u*)(OB + (size_t)tok * D + m * 64 + 16 * c + 4 * g) = w; }
        { const int tokn = vcu * 256 + F.wave + 8 * (it < 31 ? it + 1 : it); ATT_KOFF(ni0, ni1); ATT_KLOAD((const GAS char*)(SM + (size_t)(tokn >> 11) * SEQ * 256)); }
    }
#undef ATT_KOFF
#undef ATT_KLOAD
#undef ATT_KWAIT
    }
}
constexpr int XCS = 136;
constexpr int HHS = 132;
__device__ __forceinline__ float gelu_tanh(float x) {
    const float z = 0.7978845608028654f * (x + 0.044715f * x * x * x);
    const float e = __builtin_amdgcn_exp2f(2.885390081777927f * z);
    const float th = 1.0f - 2.0f * __builtin_amdgcn_rcpf(e + 1.0f);
    return 0.5f * x * (1.0f + th);
}
template <bool DRY = false>
__device__ __forceinline__ void lru_phase(const Frame& F0, int L) {
    Frame F = launder(F0);
    const KArgs ka = kargs();
    const int b = F.bx >> 3, nb = F.bx & 7;
    const bf16* XR = (const bf16*)(F.ws + Z_XR); bf16* YR = (bf16*)(F.ws + Z_YR);
    const bf16* WL = (const bf16*)(F.ws + WS_W + W_LRU);
    LAS bf16* XC = (LAS bf16*)(F.lds + RING_OFF);
    LAS float* HH = (LAS float*)(F.lds + RING_OFF + 2 * 64 * XCS * 2);
    const int tid = F.tid, lane = F.lane, w = F.wave, g = lane >> 4, m = lane & 15;
    const int cc = tid & 15, tp = tid >> 4;
    const int ch0 = nb * 128 + 8 * cc;
    float cw[4][8], cbias[8];
#pragma unroll
    for (int j = 0; j < 4; ++j)
#pragma unroll
        for (int k = 0; k < 8; ++k) cw[j][k] = ka->in[I_CONVW][(size_t)L * 4 * D + j * D + ch0 + k];
#pragma unroll
    for (int k = 0; k < 8; ++k) cbias[k] = ka->in[I_CONVB][(size_t)L * D + ch0 + k];
    bf16x8 Br[4], Bi[4];
#pragma unroll
    for (int s = 0; s < 4; ++s) { Br[s] = *(const GAS bf16x8*)(WL + ((size_t)nb * 128 + 16 * w + m) * 128 + 32 * s + 8 * g);
                                  Bi[s] = *(const GAS bf16x8*)(WL + (size_t)8 * 128 * 128 + ((size_t)nb * 128 + 16 * w + m) * 128 + 32 * s + 8 * g); }
    const int chl = 16 * w + m, chg = nb * 128 + chl;
    const float ba = ka->in[I_LRUBA][(size_t)L * D + chg], bx = ka->in[I_LRUBX][(size_t)L * D + chg];
    const float lam = ka->in[I_LAM][(size_t)L * D + chg];
    const float sp8 = -8.0f * (fmaxf(-lam, 0.f) + log1pf(__expf(-fabsf(lam))));
    float carry = 0.f;
    const size_t rowb = (size_t)b * SEQ;
    v4u nxin[5], nyin[2];
#pragma unroll
    for (int k = 0; k < 5; ++k) { const int t = 2 * tp - 3 + k; v4u z; z.x = z.y = z.z = z.w = 0u; nxin[k] = (t >= 0) ? *(const GAS v4u*)(XR + (rowb + t) * D + ch0) : z; }
#pragma unroll
    for (int k = 0; k < 2; ++k) nyin[k] = *(const GAS v4u*)(YR + (rowb + 2 * tp + k) * D + ch0);
    for (int tile = 0; tile < 32; ++tile) {
        const int t0 = tile * 64, buf = tile & 1;
        LAS bf16* xc = XC + buf * 64 * XCS; LAS float* hh = HH + buf * 64 * HHS;
        v4u xin[5], yin[2];
#pragma unroll
        for (int k = 0; k < 5; ++k) xin[k] = nxin[k];
#pragma unroll
        for (int k = 0; k < 2; ++k) yin[k] = nyin[k];
        if (tile < 31) {
#pragma unroll
            for (int k = 0; k < 5; ++k) nxin[k] = *(const GAS v4u*)(XR + (rowb + t0 + 64 + 2 * tp - 3 + k) * D + ch0);
#pragma unroll
            for (int k = 0; k < 2; ++k) nyin[k] = *(const GAS v4u*)(YR + (rowb + t0 + 64 + 2 * tp + k) * D + ch0);
        }
#pragma unroll
        for (int k = 0; k < 2; ++k) { float o[8];
#pragma unroll
            for (int c = 0; c < 8; ++c) { float a = cbias[c];
#pragma unroll
                for (int j = 0; j < 4; ++j) { const unsigned wv = xin[k + j][c >> 1]; a += ((c & 1) ? bf_hi(wv) : bf_lo(wv)) * cw[j][c]; }
                o[c] = a; }
            v4u pw; pw.x = pk2(o[0], o[1]); pw.y = pk2(o[2], o[3]); pw.z = pk2(o[4], o[5]); pw.w = pk2(o[6], o[7]);
            *(LAS v4u*)(xc + (2 * tp + k) * XCS + 8 * cc) = pw; }
        __syncthreads();
#pragma unroll
        for (int mt = 0; mt < 4; ++mt) {
            f32x4 ar = (f32x4){0.f, 0.f, 0.f, 0.f}, ai = (f32x4){0.f, 0.f, 0.f, 0.f};
#pragma unroll
            for (int s = 0; s < 4; ++s) { const bf16x8 A = *(const LAS bf16x8*)(xc + (16 * mt + m) * XCS + 32 * s + 8 * g);
                ar = __builtin_amdgcn_mfma_f32_16x16x32_bf16(A, Br[s], ar, 0, 0, 0); ai = __builtin_amdgcn_mfma_f32_16x16x32_bf16(A, Bi[s], ai, 0, 0, 0); }
            float P[4], W[4];
#pragma unroll
            for (int i = 0; i < 4; ++i) {
                const float rr = sigmoidf_fast(ar[i] + ba), ig = sigmoidf_fast(ai[i] + bx);
                const float la = sp8 * rr;
                const float a = __builtin_amdgcn_exp2f(1.4426950408889634f * la);
                const float mult = __builtin_amdgcn_sqrtf(fmaxf(__builtin_fmaf(-a, a, 1.0f), 0.f));
                const float xv = __builtin_bit_cast(float, (unsigned)xc[(16 * mt + 4 * g + i) * XCS + chl] << 16);
                const float u = mult * (ig * xv);
                if (i == 0) { P[0] = a; W[0] = u; } else { P[i] = a * P[i - 1]; W[i] = a * W[i - 1] + u; }
            }
            float Ac = P[3], Uc = W[3];
            { const float A1 = lane_up(Ac, 16, lane), U1 = lane_up(Uc, 16, lane); if (g >= 1) { Uc = Ac * U1 + Uc; Ac = Ac * A1; } }
            { const float A2 = lane_up(Ac, 32, lane), U2 = lane_up(Uc, 32, lane); if (g >= 2) { Uc = Ac * U2 + Uc; Ac = Ac * A2; } }
            float Ae = lane_up(Ac, 16, lane), Ue = lane_up(Uc, 16, lane); if (g == 0) { Ae = 1.f; Ue = 0.f; }
            const float hin = Ae * carry + Ue;
            const float cnew = Ac * carry + Uc;
            carry = lane_get(cnew, 48 + m);
#pragma unroll
            for (int i = 0; i < 4; ++i) hh[(16 * mt + 4 * g + i) * HHS + chl] = P[i] * hin + W[i];
        }
        __syncthreads();
#pragma unroll
        for (int k = 0; k < 2; ++k) { const f32x4 h0 = *(const LAS f32x4*)(hh + (2 * tp + k) * HHS + 8 * cc), h1 = *(const LAS f32x4*)(hh + (2 * tp + k) * HHS + 8 * cc + 4);
            float o[8];
#pragma unroll
            for (int c = 0; c < 8; ++c) { const unsigned wv = yin[k][c >> 1]; const float y = (c & 1) ? bf_hi(wv) : bf_lo(wv); o[c] = (c < 4 ? h0[c] : h1[c - 4]) * gelu_tanh(y); }
            v4u pw; pw.x = pk2(o[0], o[1]); pw.y = pk2(o[2], o[3]); pw.z = pk2(o[4], o[5]); pw.w = pk2(o[6], o[7]);
            *(GAS v4u*)((DRY ? (bf16*)(F.ws + WS_NEED) : YR) + (rowb + t0 + 2 * tp + k) * D + ch0) = pw; }
    }
    __syncthreads();
}

struct MoeOrder : pg8::StaticOrder {
    const volatile LAS unsigned* tb; int tile0; const int* list; size_t bstride;
    __device__ __forceinline__ int expert_of(int gt) const { int e = 0;
#pragma unroll
        for (int k = 1; k < 8; ++k) e += (gt >= (int)tb[k]) ? 1 : 0;
        return e; }
    __device__ __forceinline__ const char* b_base(const pg8::Gemm& g, const pg8::Unit& u, size_t tstep) const { return (const char*)g.Bt + (size_t)expert_of(tile0 + u.pm) * bstride + (size_t)u.pn * tstep; }
};
struct MoeGatherOrder : MoeOrder {
    static constexpr bool GATHER = true;
    __device__ __forceinline__ const char* a_base(const pg8::Gemm& g, const pg8::Unit&, size_t) const { return (const char*)g.A; }
    __device__ __forceinline__ void a_rows(const pg8::Unit& u, int R0, int R1, int C0, int C1, int K, unsigned (&off)[2][2]) const {
        const int gt = tile0 + u.pm, e = expert_of(gt), j = gt - (int)tb[e], n = (int)tb[16 + e];
        const GAS int* le = (const GAS int*)list + (size_t)e * T_TOK;
#pragma unroll
        for (int h = 0; h < 2; ++h) { int p0 = 256 * j + 128 * h + R0, p1 = 256 * j + 128 * h + R1; p0 = p0 < n ? p0 : n - 1; p1 = p1 < n ? p1 : n - 1;
            off[h][0] = ((unsigned)le[p0] * (unsigned)K + (unsigned)C0) * 2u; off[h][1] = ((unsigned)le[p1] * (unsigned)K + (unsigned)C1) * 2u; }
    }
};
__global__ void __launch_bounds__(NWAVES * 64, 2) mk_fwd(Args args) {
    extern __shared__ __attribute__((aligned(16))) unsigned char lds[];
    Frame F;
    F.lds = (LAS unsigned char*)lds;
    F.MISC = (volatile LAS unsigned*)(F.lds + MISC_OFF);
    F.tid = threadIdx.x; F.lane = F.tid & 63; F.wave = __builtin_amdgcn_readfirstlane(F.tid >> 6);
    F.G = gridDim.x; F.bx = blockIdx.x;
    F.ws = args.ws; F.ctl = (gu32*)(args.ws + WS_CTL); F.out = args.out;
    for (int u = threadIdx.x; u < (LDS_BYTES - LDSCTL_OFF) / 4; u += NWAVES * 64) ((LAS unsigned*)(F.lds + LDSCTL_OFF))[u] = 0u;
    __syncthreads();
    XcdBarrier bar = xcd_barrier_post((unsigned*)(F.ctl + CW_BAR), F.MISC + 8);
#define GRID_BAR() do { XcdBarrier b_ = bar; unsigned* p_ = bar.bar; asm volatile("" : "+s"(p_)); b_.bar = p_; xcd_barrier(b_); } while (0)
    float* X32 = args.out;
#define LOCAL_HANDOFF() do { asm volatile("s_waitcnt vmcnt(0)" ::: "memory"); __syncthreads(); __builtin_amdgcn_fence(__ATOMIC_ACQUIRE, "agent"); asm volatile("s_waitcnt vmcnt(0)" ::: "memory"); __syncthreads(); } while (0)
    LAS unsigned char* ring = F.lds + RING_OFF;
    using pg8::Gemm; using pg8::StaticOrder;

    for (int L = 0; L < DEPTH; ++L) {
        const int odd = L & 1;
#ifndef SK_P0
        p0_convert(F, L);
#endif
#ifdef DUP_P0
        __syncthreads(); p0_convert(F, L);
#endif
        GRID_BAR();
        { const Frame P = launder(F); unsigned char* ws = P.ws; unsigned char* wb = ws + WS_W; bf16* XB = (bf16*)(ws + WS_XB); (void)XB; (void)wb;
          Gemm g{XB, (const bf16*)(wb + W_IN), T_TOK, NIN, D}; StaticOrder S; S.init(T_TOK, NIN, P.G, P.bx);
          pg8::EpiZ E{(bf16*)(ws + Z_Q), (bf16*)(ws + Z_QI), (bf16*)(ws + Z_SM)};
#ifndef SK_G1
          pg8::gemm_phase<pg8::EpiZ, StaticOrder>(ring, g, S, E, P.wave);
#endif
        }
        GRID_BAR();
#ifndef SK_IDX
        indexer_phase(F);
#endif
#ifdef DUP_IDX
        indexer_phase(F);
#endif
#ifdef DUP_LRU
        lru_phase<true>(F, L);
#endif
#ifndef SK_LRU
        lru_phase(F, L);
#endif
        GRID_BAR();
#ifdef DUP_ATT
        attention_phase<DUP_ATT>(F); __syncthreads();
#endif
#ifndef SK_ATT
        attention_phase(F);
#endif
        GRID_BAR();
        { const Frame P = launder(F); unsigned char* ws = P.ws; unsigned char* wb = ws + WS_W; bf16* XB = (bf16*)(ws + WS_XB); (void)XB; (void)wb;
          Gemm g{(const bf16*)(ws + Z_XR), (const bf16*)(wb + W_BRA), T_TOK, D, D}; StaticOrder S; S.init(T_TOK, D, F.G, F.bx);
          pg8::EpiGate<0> E{(bf16*)(ws + Z_GA), nullptr};
#ifndef SK_G2
          pg8::gemm_phase<pg8::EpiGate<0>, StaticOrder>(ring, g, S, E, P.wave);
#endif
        }
        LOCAL_HANDOFF();
        { const Frame P = launder(F); unsigned char* ws = P.ws; unsigned char* wb = ws + WS_W; bf16* XB = (bf16*)(ws + WS_XB); (void)XB; (void)wb;
          Gemm g{(const bf16*)(ws + Z_YR), (const bf16*)(wb + W_BRR), T_TOK, D, D}; StaticOrder S; S.init(T_TOK, D, F.G, F.bx);
          pg8::EpiGate<1> E{(bf16*)(ws + Z_GA), (const bf16*)(ws + Z_GR)};
#ifndef SK_G3
          pg8::gemm_phase<pg8::EpiGate<1>, StaticOrder>(ring, g, S, E, P.wave);
#endif
        }
        GRID_BAR();
        { const Frame P = launder(F); unsigned char* ws = P.ws; unsigned char* wb = ws + WS_W; bf16* XB = (bf16*)(ws + WS_XB); (void)XB; (void)wb;
          Gemm g{(const bf16*)(ws + Z_GA), (const bf16*)(wb + W_O), T_TOK, D, D}; StaticOrder S; S.init(T_TOK, D, F.G, F.bx);
          pg8::EpiRes<0> E{X32, XB, nullptr};
#ifndef SK_G4
          pg8::gemm_phase<pg8::EpiRes<0>, StaticOrder>(ring, g, S, E, P.wave);
#endif
        }
        GRID_BAR();
#ifdef DUP_LN
        ln_phase<false, false, true>(F, L); ln_phase<false, false, true>(F, L);
#endif
#ifndef SK_LN
        if (odd) ln_phase<false, true>(F, L); else ln_phase<false, false>(F, L);
#endif
        GRID_BAR();
        if (odd) {
            if (launder(F).tid == 0) { unsigned acc = 0u; F.MISC[16] = 0u;
                for (int e = 0; e < 8; ++e) { const unsigned c = __hip_atomic_load(F.ctl + CW_CNT + (L >> 1) * 1024 + 64 * e, RLX_AGENT); F.MISC[32 + e] = c; acc += (c + 255u) >> 8; F.MISC[17 + e] = acc; } }
            __syncthreads();
        }
        { const Frame P = launder(F); unsigned char* ws = P.ws; unsigned char* wb = ws + WS_W; bf16* XB = (bf16*)(ws + WS_XB); (void)XB; (void)wb;
          Gemm g{(const bf16*)(ws + F_PB), (const bf16*)(wb + W_PP), T_TOK, D, PLE}; StaticOrder S; S.init(T_TOK, D, F.G, F.bx);
          pg8::EpiBf16 E{(bf16*)(ws + F_U), D, 0};
#ifndef SK_G5
          pg8::gemm_phase<pg8::EpiBf16, StaticOrder>(ring, g, S, E, P.wave);
#endif
        }
        LOCAL_HANDOFF();
        { const Frame P = launder(F); unsigned char* ws = P.ws; unsigned char* wb = ws + WS_W; bf16* XB = (bf16*)(ws + WS_XB); (void)XB; (void)wb;
          Gemm g{XB, (const bf16*)(wb + W_PG), T_TOK, D, D}; StaticOrder S; S.init(T_TOK, D, F.G, F.bx);
          pg8::EpiRes<1> E{X32, XB, (const bf16*)(ws + F_U)};
#ifndef SK_G6
          pg8::gemm_phase<pg8::EpiRes<1>, StaticOrder>(ring, g, S, E, P.wave);
#endif
        }
        if (!odd) {
            { const Frame P = launder(F); unsigned char* ws = P.ws; unsigned char* wb = ws + WS_W; bf16* XB = (bf16*)(ws + WS_XB); (void)XB; (void)wb;
          Gemm g{XB, (const bf16*)(wb + W_FF), T_TOK, 2 * DFF, D}; StaticOrder S; S.init(T_TOK, 2 * DFF, F.G, F.bx);
              pg8::EpiSwiglu E{(bf16*)(ws + F_H), DFF};
#ifndef SK_G7
              pg8::gemm_phase<pg8::EpiSwiglu, StaticOrder>(ring, g, S, E, P.wave);
#endif
        }
            GRID_BAR();
            { const Frame P = launder(F); unsigned char* ws = P.ws; unsigned char* wb = ws + WS_W; bf16* XB = (bf16*)(ws + WS_XB); (void)XB; (void)wb;
          Gemm g{(const bf16*)(ws + F_H), (const bf16*)(wb + W_FF_DN_DENSE), T_TOK, D, DFF}; StaticOrder S; S.init(T_TOK, D, F.G, F.bx);
              pg8::EpiRes<2> E{X32, nullptr, nullptr};
#ifndef SK_G8
              pg8::gemm_phase<pg8::EpiRes<2>, StaticOrder>(ring, g, S, E, P.wave);
#endif
        }
            GRID_BAR();
#ifndef SK_LN
            ln_phase<true, false>(F, L);
#endif
        } else {
            const int ntiles = (int)F.MISC[24];
            const int nchunks = (ntiles + MOE_CHUNK_TILES - 1) / MOE_CHUNK_TILES;
            for (int c = 0; c < nchunks; ++c) {
                const int tile0 = c * MOE_CHUNK_TILES, ntl = (ntiles - tile0) < MOE_CHUNK_TILES ? (ntiles - tile0) : MOE_CHUNK_TILES;
                const size_t hc_off = (c & 1) ? F_H1 : F_H;
                { const Frame P = launder(F); unsigned char* ws = P.ws; unsigned char* wb = ws + WS_W; bf16* XB = (bf16*)(ws + WS_XB); (void)XB; (void)wb;
          Gemm g{XB, (const bf16*)(wb + W_FF), ntl * 256, 2 * DFFE, D}; MoeGatherOrder S; S.init(ntl * 256, 2 * DFFE, F.G, F.bx);
                  S.tb = F.MISC + 16; S.tile0 = tile0; S.list = (const int*)(ws + WS_LIST); S.bstride = (size_t)2 * DFFE * D * 2;
                  pg8::EpiSwiglu E{(bf16*)(ws + hc_off), DFFE};
#ifndef SK_G9
                  pg8::gemm_phase<pg8::EpiSwiglu, MoeGatherOrder>(ring, g, S, E, P.wave);
#endif
        }
                GRID_BAR();
                { const Frame P = launder(F); unsigned char* ws = P.ws; unsigned char* wb = ws + WS_W; bf16* XB = (bf16*)(ws + WS_XB); (void)XB; (void)wb;
          Gemm g{(const bf16*)(ws + hc_off), (const bf16*)(wb + W_FF_DN_MOE), ntl * 256, D, DFFE}; MoeOrder S; S.init(ntl * 256, D, F.G, F.bx);
                  S.tb = F.MISC + 16; S.tile0 = tile0; S.list = nullptr; S.bstride = (size_t)D * DFFE * 2;
                  pg8::EpiBf16 E{(bf16*)(ws + F_YE), D, tile0 * 256};
#ifndef SK_G10
                  pg8::gemm_phase<pg8::EpiBf16, MoeOrder>(ring, g, S, E, P.wave);
#endif
        }
            }
            GRID_BAR();
#ifndef SK_LN
            ln_phase<true, true>(F, L);
#endif
        }
        GRID_BAR();
    }
    if (__hip_atomic_load(F.ctl + CW_BAR + XB_TMO, RLX_AGENT) != 0u) {
        const float q = __builtin_nanf("");
        for (size_t i = (size_t)F.bx * 512 + launder(F).tid; i < (size_t)T_TOK * D; i += (size_t)F.G * 512) X32[i] = q;
    }
}

#if defined(DUP_LRU) || defined(DUP_LN)
constexpr size_t WS_DRY_EXTRA = 256 * MiB;
#else
constexpr size_t WS_DRY_EXTRA = 0;
#endif
extern "C" void kernel_launch(void* const* d_in, const int* in_sizes, int n_in, void* d_out, int out_size, void* d_ws, size_t ws_size, hipStream_t stream) {
    static int grid = 0;
    if (grid == 0) {
        if (n_in != 28 || out_size != T_TOK * D || ws_size < WS_NEED + WS_DRY_EXTRA) { fprintf(stderr, "kernel_launch: unexpected shapes: n_in %d out %d ws %zu (need %zu)\n", n_in, out_size, ws_size, (size_t)WS_END); grid = -1; return; }
        int dev = 0, cus = 0, per_cu = 0;
        if (hipGetDevice(&dev) != hipSuccess || hipDeviceGetAttribute(&cus, hipDeviceAttributeMultiprocessorCount, dev) != hipSuccess) { grid = -1; return; }
        if (hipFuncSetAttribute((const void*)mk_fwd, hipFuncAttributeMaxDynamicSharedMemorySize, LDS_BYTES) != hipSuccess) { fprintf(stderr, "kernel_launch: hipFuncSetAttribute failed\n"); grid = -1; return; }
        if (hipOccupancyMaxActiveBlocksPerMultiprocessor(&per_cu, (const void*)mk_fwd, NWAVES * 64, LDS_BYTES) != hipSuccess || per_cu < 1) { fprintf(stderr, "kernel_launch: occupancy query says %d blocks per CU\n", per_cu); }
        (void)hipGetLastError();
        grid = cus;
        if (grid != 256) { fprintf(stderr, "kernel_launch: this kernel needs a 256-CU device (got %d)\n", cus); grid = -1; return; }
    }
    if (grid < 0) return;
    if (hipMemsetAsync((char*)d_ws + WS_CTL, 0, CTL_ZERO_BYTES, stream) != hipSuccess) return;
    Args a{};
    for (int i = 0; i < 28; ++i) a.in[i] = (const float*)d_in[i];
    a.out = (float*)d_out; a.ws = (unsigned char*)d_ws;
    hipLaunchKernelGGL(mk_fwd, dim3(grid), dim3(NWAVES * 64), LDS_BYTES, stream, a);
}
```

```cpp
#include <hip/hip_runtime.h>
#include <cstdio>
#include <cstdint>

constexpr int T_TOK = 65536, D = 1024, SEQ = 2048, NBATCH = 32, DEPTH = 4;
constexpr int D_IN = 5832, NIN = 5888;
constexpr int DFF = 2816, DFFE = 3584, NEXP = 8, PLE = 256;
constexpr float LN_EPS = 1e-5f;
constexpr float DN_ALPHA = 1.681792830507429f;

namespace pg8 {
#define PG8_LAS __attribute__((address_space(3)))
typedef unsigned short bf16_t;
typedef short bf16x8 __attribute__((ext_vector_type(8)));
typedef float f32x4 __attribute__((ext_vector_type(4)));
typedef unsigned u32x4 __attribute__((ext_vector_type(4)));
typedef unsigned u32x2 __attribute__((ext_vector_type(2)));
constexpr int BM = 256, BK = 64, HALF = 128, HTB = HALF * BK * 2  , STAGE_BYTES = 8 * HTB, NXCD = 8, WGM = 8;

__host__ __device__ __forceinline__ int lds_byte(int r, int c) { const int st = (r >> 4) * 2 + (c >> 5), rr = r & 15, cc = c & 31, ob = rr * 64 + cc * 2; return st * 1024 + (ob ^ (((ob >> 9) & 1) << 5)); }
__host__ __device__ __forceinline__ void stage_rc(int b, int& R, int& C) { const int st = b / 1024, sb = b % 1024, swz = sb ^ (((sb >> 9) & 1) << 5); R = (st >> 1) * 16 + swz / 64; C = (st & 1) * 32 + (swz % 64) / 2; }
__host__ __device__ __forceinline__ int perm32(int rho) { const int n = rho >> 4, i = rho & 15; return 8 * (i >> 2) + 4 * n + (i & 3); }

struct Unit { int pm, pn; };
struct Gemm { const bf16_t* A; const bf16_t* Bt; int M, N, K; };

struct StaticOrder {
    static constexpr bool GATHER = false;
    int nM, nN, nwg, G, c;
    __host__ __device__ void init(int M, int N, int G_, int c_) { nM = M / BM; nN = N / BM; nwg = nM * nN; G = G_; c = c_; }
    __host__ __device__ bool next(int i, Unit& u) const {
        const long L = (long)i * G + c; if (L >= nwg) return false;
        int wgid = (int)L; { const int q = nwg / NXCD, r = nwg % NXCD, xcd = wgid % NXCD, off = wgid / NXCD; wgid = (xcd < r ? xcd * (q + 1) : r * (q + 1) + (xcd - r) * q) + off; }
        const int nig = WGM * nN, gid = wgid / nig, fm = gid * WGM, gsz = (nM - fm) < WGM ? (nM - fm) : WGM;
        u.pm = fm + ((wgid % nig) % gsz); u.pn = (wgid % nig) / gsz; return true;
    }
    __device__ __forceinline__ const char* a_base(const Gemm& g, const Unit& u, size_t tstep) const { return (const char*)g.A + (size_t)u.pm * tstep; }
    __device__ __forceinline__ const char* b_base(const Gemm& g, const Unit& u, size_t tstep) const { return (const char*)g.Bt + (size_t)u.pn * tstep; }
    __device__ __forceinline__ void a_rows(const Unit&, int, int, int, int, int, unsigned (&)[2][2]) const {}
    __device__ __forceinline__ void a_ready(const Unit&) const {}
    __device__ __forceinline__ void done(const Unit&) const {}
};

__device__ __forceinline__ unsigned cvt_pk_bf16(float lo, float hi) { unsigned r; asm volatile("v_cvt_pk_bf16_f32 %0, %1, %2" : "=v"(r) : "v"(lo), "v"(hi)); return r; }
__device__ __forceinline__ float bf_lo(unsigned w) { return __builtin_bit_cast(float, w << 16); }
__device__ __forceinline__ float bf_hi(unsigned w) { return __builtin_bit_cast(float, w & 0xffff0000u); }
__device__ __forceinline__ float sigmoidf_fast(float x) { return __builtin_amdgcn_rcpf(1.0f + __builtin_amdgcn_exp2f(-1.4426950408889634f * x)); }
#define EPI_FENCE() asm volatile("" ::: "memory")
#define EGAS __attribute__((address_space(1)))
__device__ __forceinline__ u32x4 pack8(const f32x4 v0, const f32x4 v1) { u32x4 w; w.x = cvt_pk_bf16(v0[0], v0[1]); w.y = cvt_pk_bf16(v0[2], v0[3]); w.z = cvt_pk_bf16(v1[0], v1[1]); w.w = cvt_pk_bf16(v1[2], v1[3]); return w; }

struct EpiBf16 {
    static constexpr bool PERM = true, AFTER_DRAIN = false;
    bf16_t* O; int ldc; int row_off;
    __device__ __forceinline__ void operator()(const f32x4 (&acc)[2][2][4][2], const Unit& u, int wr, int wc, int fr, int fq) const {
        { int l_ = (int)__builtin_amdgcn_mbcnt_hi(~0u, __builtin_amdgcn_mbcnt_lo(~0u, 0u)); asm volatile("" : "+v"(l_)); fr = l_ & 15; fq = l_ >> 4; }
        const int row0 = row_off + u.pm * BM + wr * 64 + fr, col0 = u.pn * BM + wc * 32 + 8 * fq;
#pragma unroll
        for (int ai = 0; ai < 2; ++ai)
#pragma unroll
            for (int m = 0; m < 4; ++m) { bf16_t* rowp = O + (size_t)(row0 + ai * HALF + m * 16) * ldc + col0;
#pragma unroll
                for (int bj = 0; bj < 2; ++bj) *(EGAS u32x4*)(rowp + bj * HALF) = pack8(acc[ai][bj][m][0], acc[ai][bj][m][1]); }
    }
};
struct EpiZ {
    static constexpr bool PERM = true, AFTER_DRAIN = false;
    bf16_t* zbig; bf16_t* zqi; bf16_t* zsm;
    __device__ __forceinline__ void operator()(const f32x4 (&acc)[2][2][4][2], const Unit& u, int wr, int wc, int fr, int fq) const {
        { int l_ = (int)__builtin_amdgcn_mbcnt_hi(~0u, __builtin_amdgcn_mbcnt_lo(~0u, 0u)); asm volatile("" : "+v"(l_)); fr = l_ & 15; fq = l_ >> 4; }
        bf16_t* base; int ld, colt;
        if (u.pn < 20) { base = zbig + (size_t)(u.pn >> 2) * ((size_t)T_TOK * D); ld = D; colt = (u.pn & 3) * BM; }
        else if (u.pn < 22) { base = zqi; ld = 512; colt = (u.pn - 20) * BM; }
        else { base = zsm; ld = 256; colt = 0; }
        const int row0 = u.pm * BM + wr * 64 + fr, col0 = colt + wc * 32 + 8 * fq;
#pragma unroll
        for (int ai = 0; ai < 2; ++ai)
#pragma unroll
            for (int m = 0; m < 4; ++m) { bf16_t* rowp = base + (size_t)(row0 + ai * HALF + m * 16) * ld + col0;
#pragma unroll
                for (int bj = 0; bj < 2; ++bj) *(EGAS u32x4*)(rowp + bj * HALF) = pack8(acc[ai][bj][m][0], acc[ai][bj][m][1]); }
    }
};
template <int MODE> struct EpiGate {
    static constexpr bool PERM = true, AFTER_DRAIN = false;
    bf16_t* G; const bf16_t* G2;
    __device__ __forceinline__ void operator()(const f32x4 (&acc)[2][2][4][2], const Unit& u, int wr, int wc, int fr, int fq) const {
        { int l_ = (int)__builtin_amdgcn_mbcnt_hi(~0u, __builtin_amdgcn_mbcnt_lo(~0u, 0u)); asm volatile("" : "+v"(l_)); fr = l_ & 15; fq = l_ >> 4; }
        const int row0 = u.pm * BM + wr * 64 + fr, col0 = u.pn * BM + wc * 32 + 8 * fq;
#pragma unroll
        for (int ai = 0; ai < 2; ++ai) {
            u32x4 gw[4][2], g2[4][2];
#pragma unroll
            for (int m = 0; m < 4; ++m)
#pragma unroll
                for (int bj = 0; bj < 2; ++bj) { const size_t o = (size_t)(row0 + ai * HALF + m * 16) * D + col0 + bj * HALF;
                    gw[m][bj] = *(const EGAS u32x4*)(G + o); if (MODE == 1) g2[m][bj] = *(const EGAS u32x4*)(G2 + o); }
#pragma unroll
            for (int m = 0; m < 4; ++m)
#pragma unroll
                for (int bj = 0; bj < 2; ++bj) { const size_t o = (size_t)(row0 + ai * HALF + m * 16) * D + col0 + bj * HALF;
                    f32x4 v0 = acc[ai][bj][m][0], v1 = acc[ai][bj][m][1];
#pragma unroll
                    for (int j = 0; j < 4; ++j) { const unsigned wa = gw[m][bj][j >> 1], wb = gw[m][bj][2 + (j >> 1)];
                        const float ga = (j & 1) ? bf_hi(wa) : bf_lo(wa), gb = (j & 1) ? bf_hi(wb) : bf_lo(wb);
                        if (MODE == 0) { v0[j] *= sigmoidf_fast(ga); v1[j] *= sigmoidf_fast(gb); }
                        else { const unsigned xa = g2[m][bj][j >> 1], xb = g2[m][bj][2 + (j >> 1)];
                            v0[j] = ga + v0[j] * sigmoidf_fast((j & 1) ? bf_hi(xa) : bf_lo(xa)); v1[j] = gb + v1[j] * sigmoidf_fast((j & 1) ? bf_hi(xb) : bf_lo(xb)); } }
                    *(EGAS u32x4*)(G + o) = pack8(v0, v1); }
            EPI_FENCE(); }
    }
};
template <int MODE> struct EpiRes {
    static constexpr bool PERM = false, AFTER_DRAIN = false;
    float* Y; const bf16_t* XB; const bf16_t* U;
    __device__ __forceinline__ void operator()(const f32x4 (&acc)[2][2][4][2], const Unit& u, int wr, int wc, int fr, int fq) const {
        { int l_ = (int)__builtin_amdgcn_mbcnt_hi(~0u, __builtin_amdgcn_mbcnt_lo(~0u, 0u)); asm volatile("" : "+v"(l_)); fr = l_ & 15; fq = l_ >> 4; }
        const int row0 = u.pm * BM + wr * 64 + fr, col0 = u.pn * BM + wc * 32 + 4 * fq;
#pragma unroll
        for (int ai = 0; ai < 2; ++ai) {
            u32x2 xw[4][2][2], uw[4][2][2]; f32x4 yv[4][2][2];
#pragma unroll
            for (int m = 0; m < 4; ++m)
#pragma unroll
                for (int bj = 0; bj < 2; ++bj)
#pragma unroll
                    for (int n = 0; n < 2; ++n) { const size_t o = (size_t)(row0 + ai * HALF + m * 16) * D + col0 + bj * HALF + n * 16;
                        if (MODE == 0 || MODE == 1) xw[m][bj][n] = *(const EGAS u32x2*)(XB + o);
                        if (MODE == 1) uw[m][bj][n] = *(const EGAS u32x2*)(U + o);
                        if (MODE == 2) yv[m][bj][n] = *(const EGAS f32x4*)(Y + o); }
#pragma unroll
            for (int m = 0; m < 4; ++m)
#pragma unroll
                for (int bj = 0; bj < 2; ++bj)
#pragma unroll
                    for (int n = 0; n < 2; ++n) { const size_t o = (size_t)(row0 + ai * HALF + m * 16) * D + col0 + bj * HALF + n * 16; const f32x4 a = acc[ai][bj][m][n]; f32x4 r;
                        if (MODE == 0) { const u32x2 x = xw[m][bj][n];
                            r[0] = bf_lo(x.x) * DN_ALPHA + a[0]; r[1] = bf_hi(x.x) * DN_ALPHA + a[1]; r[2] = bf_lo(x.y) * DN_ALPHA + a[2]; r[3] = bf_hi(x.y) * DN_ALPHA + a[3]; }
                        else if (MODE == 1) { const u32x2 x = xw[m][bj][n], w = uw[m][bj][n];
                            r[0] = bf_lo(x.x) * DN_ALPHA + sigmoidf_fast(a[0]) * bf_lo(w.x); r[1] = bf_hi(x.x) * DN_ALPHA + sigmoidf_fast(a[1]) * bf_hi(w.x);
                            r[2] = bf_lo(x.y) * DN_ALPHA + sigmoidf_fast(a[2]) * bf_lo(w.y); r[3] = bf_hi(x.y) * DN_ALPHA + sigmoidf_fast(a[3]) * bf_hi(w.y); }
                        else r = yv[m][bj][n] + a;
                        *(EGAS f32x4*)(Y + o) = r; }
            EPI_FENCE(); }
    }
};
struct EpiSwiglu {
    static constexpr bool PERM = true, AFTER_DRAIN = false;
    bf16_t* H; int ldh;
    __device__ __forceinline__ void operator()(const f32x4 (&acc)[2][2][4][2], const Unit& u, int wr, int wc, int fr, int fq) const {
        { int l_ = (int)__builtin_amdgcn_mbcnt_hi(~0u, __builtin_amdgcn_mbcnt_lo(~0u, 0u)); asm volatile("" : "+v"(l_)); fr = l_ & 15; fq = l_ >> 4; }
        const int row0 = u.pm * BM + wr * 64 + fr, col0 = u.pn * HALF + wc * 32 + 8 * fq;
#pragma unroll
        for (int ai = 0; ai < 2; ++ai)
#pragma unroll
            for (int m = 0; m < 4; ++m) { bf16_t* rowp = H + (size_t)(row0 + ai * HALF + m * 16) * ldh + col0;
                f32x4 v0, v1;
#pragma unroll
                for (int j = 0; j < 4; ++j) { const float g0 = acc[ai][0][m][0][j], g1 = acc[ai][0][m][1][j];
                    v0[j] = g0 * sigmoidf_fast(g0) * acc[ai][1][m][0][j]; v1[j] = g1 * sigmoidf_fast(g1) * acc[ai][1][m][1][j]; }
                *(EGAS u32x4*)rowp = pack8(v0, v1); }
    }
};
template <class Epi, class Sched, bool ALIGN_EPI = true>
__device__ __forceinline__ void gemm_phase(PG8_LAS unsigned char* lds, const Gemm g, const Sched& S, const Epi& E, const int wave_id) {
    int lane_ = (int)__builtin_amdgcn_mbcnt_hi(~0u, __builtin_amdgcn_mbcnt_lo(~0u, 0u)); asm volatile("" : "+v"(lane_));
    const int wid = wave_id, lane = lane_, tid = wid * 64 + lane, wr = wid >> 2, wc = wid & 3, fr = lane & 15, fq = lane >> 4;
    const int K = g.K, nt = K / BK;
    unsigned voffA[2], voffB[2]; int RA[2], CA[2];
#pragma unroll
    for (int i = 0; i < 2; ++i) { int R, C; stage_rc(tid * 16 + i * 8192, R, C); const int Rb = Epi::PERM ? ((R & ~31) + perm32(R & 31)) : R; RA[i] = R; CA[i] = C;
        voffA[i] = (unsigned)(R * K + C) * 2u; voffB[i] = (unsigned)(Rb * K + C) * 2u; }
    const size_t kstep = (size_t)(BK * 2);
    const size_t hstep = (size_t)HALF * K * 2;
    const size_t tstep = 2 * hstep;
    const unsigned ldsw = (unsigned)wid * 1024u;
    const int aoff = lds_byte(wr * 64 + fr, fq * 8), boff = lds_byte(wc * 32 + fr, fq * 8);
    unsigned offC[2][2] = {{0u, 0u}, {0u, 0u}}, offN[2][2] = {{0u, 0u}, {0u, 0u}};
#define PG8_SA(b, h) (((b) * 2 + (h)) * HTB)
#define PG8_SB(b, h) ((4 + (b) * 2 + (h)) * HTB)
#define PG8_STAGE(bufoff, gbase, voff) do { _Pragma("unroll") for (int _i = 0; _i < 2; ++_i) \
        __builtin_amdgcn_global_load_lds((const unsigned*)((const char*)(gbase) + (voff)[_i]), (PG8_LAS unsigned*)(lds + (bufoff) + ldsw + _i * 8192), 16, 0, 0); } while (0)
#define PG8_STA(bufoff, ptr, h, NX) do { if constexpr (Sched::GATHER) { _Pragma("unroll") for (int _i = 0; _i < 2; ++_i) { const unsigned _o = (NX) ? offN[h][_i] : offC[h][_i]; \
        __builtin_amdgcn_global_load_lds((const unsigned*)((const char*)(ptr) + _o), (PG8_LAS unsigned*)(lds + (bufoff) + ldsw + _i * 8192), 16, 0, 0); } } \
        else { PG8_STAGE(bufoff, (ptr) + (h) * hstep, voffA); } } while (0)
#define PG8_LDA(dst, b, h) do { _Pragma("unroll") for (int m = 0; m < 4; ++m) _Pragma("unroll") for (int k = 0; k < 2; ++k) dst[m][k] = *(const PG8_LAS bf16x8*)(lds + PG8_SA(b, h) + aoff + m * 2048 + k * 1024); } while (0)
#define PG8_LDB(dst, b, h) do { _Pragma("unroll") for (int n = 0; n < 2; ++n) _Pragma("unroll") for (int k = 0; k < 2; ++k) dst[n][k] = *(const PG8_LAS bf16x8*)(lds + PG8_SB(b, h) + boff + n * 2048 + k * 1024); } while (0)
#define PG8_MMA(ai, bj, At, Bt) do { __builtin_amdgcn_s_setprio(1); _Pragma("unroll") for (int m = 0; m < 4; ++m) _Pragma("unroll") for (int n = 0; n < 2; ++n) _Pragma("unroll") for (int k = 0; k < 2; ++k) \
        acc[ai][bj][m][n] = __builtin_amdgcn_mfma_f32_16x16x32_bf16(Bt[n][k], At[m][k], acc[ai][bj][m][n], 0, 0, 0); __builtin_amdgcn_s_setprio(0); } while (0)
#define PG8_WAIT_V(n) asm volatile("s_waitcnt vmcnt(" #n ")" ::: "memory")
#define PG8_WAIT_L(n) asm volatile("s_waitcnt lgkmcnt(" #n ")" ::: "memory")
#define PG8_BAR __builtin_amdgcn_s_barrier()
#define PG8_SCHED __builtin_amdgcn_sched_barrier(0)
    Unit cur, nxt; int ui = 0;
    if (!S.next(0, cur)) return;
    f32x4 acc[2][2][4][2];
#pragma unroll
    for (int a = 0; a < 2; ++a)
#pragma unroll
        for (int b = 0; b < 2; ++b)
#pragma unroll
            for (int m = 0; m < 4; ++m)
#pragma unroll
                for (int n = 0; n < 2; ++n) acc[a][b][m][n] = (f32x4){0.f, 0.f, 0.f, 0.f};
    bf16x8 At[4][2], B0[2][2], B1[2][2];
    const char* cA = S.a_base(g, cur, tstep); const char* cB = S.b_base(g, cur, tstep);
    if constexpr (Sched::GATHER) S.a_rows(cur, RA[0], RA[1], CA[0], CA[1], K, offC);
    S.a_ready(cur);
    PG8_STAGE(PG8_SB(0, 0), cB, voffB); PG8_STAGE(PG8_SB(0, 1), cB + hstep, voffB); PG8_STA(PG8_SA(0, 0), cA, 0, false); PG8_STA(PG8_SA(0, 1), cA, 1, false);
    if (wr == 1) PG8_BAR;
    PG8_WAIT_V(2); PG8_BAR;
    PG8_STAGE(PG8_SB(1, 0), cB + kstep, voffB); PG8_STA(PG8_SA(1, 0), cA + kstep, 0, false); PG8_STAGE(PG8_SB(1, 1), cB + hstep + kstep, voffB);
    PG8_WAIT_V(6); PG8_BAR;
    for (;;) {
        const bool has_next = S.next(ui + 1, nxt);
        const char* nA = has_next ? S.a_base(g, nxt, tstep) : cA; const char* nB = has_next ? S.b_base(g, nxt, tstep) : cB;
        if constexpr (Sched::GATHER) { if (has_next) S.a_rows(nxt, RA[0], RA[1], CA[0], CA[1], K, offN); else {
#pragma unroll
            for (int h = 0; h < 2; ++h)
#pragma unroll
                for (int i = 0; i < 2; ++i) offN[h][i] = offC[h][i]; } }
        for (int t = 0; t < nt; t += 2) {
            const bool last = (t == nt - 2);
            const char* a1 = cA + (size_t)(t + 1) * kstep;
            const char* a2 = last ? nA : cA + (size_t)(t + 2) * kstep; const char* b2 = last ? nB : cB + (size_t)(t + 2) * kstep;
            const char* a3 = a2 + kstep; const char* b3 = b2 + kstep;
            if (last && has_next) S.a_ready(nxt);
            PG8_LDB(B0, 0, 0); PG8_LDB(B1, 0, 1); PG8_SCHED; PG8_LDA(At, 0, 0); PG8_STA(PG8_SA(1, 1), a1, 1, false);
            PG8_WAIT_V(8); PG8_WAIT_L(0); PG8_BAR; PG8_MMA(0, 0, At, B0); PG8_MMA(0, 1, At, B1); PG8_BAR; PG8_SCHED;
            PG8_LDA(At, 0, 1); PG8_STAGE(PG8_SB(0, 0), b2, voffB); PG8_STAGE(PG8_SB(0, 1), b2 + hstep, voffB); PG8_STA(PG8_SA(0, 0), a2, 0, last);
            PG8_WAIT_V(8); PG8_WAIT_L(0); PG8_BAR; PG8_MMA(1, 0, At, B0); PG8_MMA(1, 1, At, B1); PG8_BAR; PG8_SCHED;
            PG8_LDB(B0, 1, 0); PG8_LDB(B1, 1, 1); PG8_SCHED; PG8_LDA(At, 1, 0); PG8_STA(PG8_SA(0, 1), a2, 1, last);
            PG8_WAIT_V(8); PG8_WAIT_L(0); PG8_BAR; PG8_MMA(0, 0, At, B0); PG8_MMA(0, 1, At, B1); PG8_BAR; PG8_SCHED;
            PG8_LDA(At, 1, 1); PG8_STAGE(PG8_SB(1, 0), b3, voffB); PG8_STAGE(PG8_SB(1, 1), b3 + hstep, voffB); PG8_STA(PG8_SA(1, 0), a3, 0, last);
            PG8_WAIT_V(8); PG8_WAIT_L(0); PG8_BAR; PG8_MMA(1, 0, At, B0); PG8_MMA(1, 1, At, B1); PG8_BAR; PG8_SCHED;
        }
        if constexpr (ALIGN_EPI) { if (wr == 0) PG8_BAR; }
        E(acc, cur, wr, wc, fr, fq); S.done(cur);
        if (!has_next) break;
#pragma unroll
        for (int a = 0; a < 2; ++a)
#pragma unroll
            for (int b = 0; b < 2; ++b)
#pragma unroll
                for (int m = 0; m < 4; ++m)
#pragma unroll
                    for (int n = 0; n < 2; ++n) acc[a][b][m][n] = (f32x4){0.f, 0.f, 0.f, 0.f};
        cur = nxt; cA = nA; cB = nB; ++ui;
        if constexpr (Sched::GATHER) {
#pragma unroll
            for (int h = 0; h < 2; ++h)
#pragma unroll
                for (int i = 0; i < 2; ++i) offC[h][i] = offN[h][i]; }
        if constexpr (ALIGN_EPI) { if (wr == 1) PG8_BAR; }
    }
    PG8_WAIT_V(0);
    if constexpr (!ALIGN_EPI) { if (wr == 0) PG8_BAR; }
    PG8_BAR;
#undef PG8_SA
#undef PG8_SB
#undef PG8_STAGE
#undef PG8_STA
#undef PG8_LDA
#undef PG8_LDB
#undef PG8_MMA
#undef PG8_WAIT_V
#undef PG8_WAIT_L
#undef PG8_BAR
#undef PG8_SCHED
}
}
constexpr int NWAVES = 8;
constexpr size_t MiB = 1u << 20;
constexpr size_t WS_CTL = 0, CTL_ZERO_BYTES = 1 * MiB;
constexpr size_t WS_ROUTE = 1 * MiB;
constexpr size_t WS_LIST = 3 * MiB;
constexpr size_t WS_W = 8 * MiB;
constexpr size_t W_IN = 0, W_BRA = 12 * MiB, W_BRR = 14 * MiB, W_O = 16 * MiB, W_PG = 18 * MiB, W_PP = 20 * MiB, W_LRU = 21 * MiB, W_FF = 22 * MiB;
constexpr size_t W_FF_DN_DENSE = W_FF + 11 * MiB, W_FF_DN_MOE = W_FF + 112 * MiB;
constexpr size_t WS_XB = 208 * MiB;
constexpr size_t WS_IDX = 336 * MiB;
constexpr size_t WS_Z = 368 * MiB;
constexpr size_t Z_Q = WS_Z, Z_XR = WS_Z + 128 * MiB, Z_YR = WS_Z + 256 * MiB, Z_GA = WS_Z + 384 * MiB, Z_GR = WS_Z + 512 * MiB, Z_QI = WS_Z + 640 * MiB, Z_SM = WS_Z + 704 * MiB;
constexpr size_t WS_END = WS_Z + 736 * MiB;
constexpr size_t F_U = Z_Q;
constexpr size_t F_PB = Z_SM;
constexpr size_t F_H = Z_XR;
constexpr size_t F_H1 = WS_END;
constexpr size_t F_YE = Z_GA;
constexpr int MOE_CHUNK_TILES = 128;
constexpr size_t F_H_CHUNK_BYTES = (size_t)MOE_CHUNK_TILES * 256 * DFFE * 2;
constexpr size_t WS_NEED = F_H1 + F_H_CHUNK_BYTES;
static_assert(F_H + F_H_CHUNK_BYTES <= F_YE && F_YE + (size_t)520 * 256 * D * 2 <= Z_SM && F_H + (size_t)T_TOK * DFF * 2 <= Z_GR, "overlay map");
constexpr int CW_TMO = 0, CW_CODE = 1, CW_BAR = 4096, CW_CNT = 16384;
constexpr int RING_OFF = 0, RING_BYTES = 131072;
constexpr int LDSCTL_OFF = RING_BYTES, MISC_OFF = LDSCTL_OFF + 320;
constexpr int LDS_BYTES = 147456;

#define GAS __attribute__((address_space(1)))
#define LAS __attribute__((address_space(3)))
typedef unsigned short bf16;
typedef unsigned v4u __attribute__((ext_vector_type(4)));
typedef unsigned v2u __attribute__((ext_vector_type(2)));
typedef float f32x4 __attribute__((ext_vector_type(4)));
typedef float f32x16 __attribute__((ext_vector_type(16)));
typedef short bf16x8 __attribute__((ext_vector_type(8)));
typedef GAS unsigned gu32;
#define RLX_AGENT __ATOMIC_RELAXED, __HIP_MEMORY_SCOPE_AGENT
#define LDS_WAIT() asm volatile("s_waitcnt lgkmcnt(0)" ::: "memory")
#define VM_WAIT() asm volatile("s_waitcnt vmcnt(0)" ::: "memory")
using pg8::cvt_pk_bf16; using pg8::bf_lo; using pg8::bf_hi; using pg8::sigmoidf_fast;
#define XB_TMO      128
#define XB_XCNT(j)  (256  + 64 * (j))
#define XB_XSUB(j)  (1280 + 64 * (j))
#define XB_XGEN(j)  (2304 + 64 * (j))
#define XB_TOP      3328
#define XB_TOPGEN   3392
#define XCD_BAR_WORDS 3456
#define XB_SPIN_CAP (1u << 21)

__device__ __forceinline__ unsigned xb_ld(unsigned* p)              { return __hip_atomic_load(p, __ATOMIC_RELAXED, __HIP_MEMORY_SCOPE_AGENT); }
__device__ __forceinline__ unsigned xb_add(unsigned* p, unsigned v) { return __hip_atomic_fetch_add(p, v, __ATOMIC_RELAXED, __HIP_MEMORY_SCOPE_AGENT); }
__device__ __forceinline__ unsigned xb_xcc_id() { return (unsigned)__builtin_amdgcn_s_getreg((3 << 11) | 20) & 0xFu; }
#define XB_SPIN(cond, bar) do { unsigned _sp = 0; while (cond) { __builtin_amdgcn_s_sleep(1); \
    if ((++_sp & 255u) == 0u) { if (xb_ld(&(bar)[XB_TMO])) break; if (_sp > XB_SPIN_CAP) { atomicAdd(&(bar)[XB_TMO], 1u); break; } } } } while (0)

struct XcdBarrier {
    unsigned* bar; unsigned x;
    volatile LAS unsigned* st;
};

__device__ __forceinline__ XcdBarrier xcd_barrier_post(unsigned* bar, volatile LAS unsigned* st) {
    XcdBarrier b; b.bar = bar; b.x = xb_xcc_id(); b.st = st;
    if (threadIdx.x == 0) (void)xb_add(&bar[XB_XCNT(b.x)], 1u);
    return b;
}
__device__ __forceinline__ void xcd_barrier_complete(unsigned* bar, unsigned x, unsigned& nloc, unsigned& nx) {
    const unsigned G = gridDim.x * gridDim.y * gridDim.z;
    unsigned sum, cnt, mine, sp = 0u;
    for (;;) {
        sum = 0u; cnt = 0u; mine = 0u;
#pragma unroll
        for (unsigned j = 0; j < 16; ++j) { const unsigned c = xb_ld(&bar[XB_XCNT(j)]); sum += c; cnt += (c > 0u) ? 1u : 0u; mine = (j == x) ? c : mine; }
        if (sum == G) break;
        __builtin_amdgcn_s_sleep(1);
        if ((++sp & 255u) == 0u) { if (xb_ld(&bar[XB_TMO])) break; if (sp > XB_SPIN_CAP) { atomicAdd(&bar[XB_TMO], 1u); break; } }
    }
    nloc = mine > 0u ? mine : 1u; nx = cnt > 0u ? cnt : 1u;
}

__device__ __forceinline__ void xcd_barrier(const XcdBarrier& b) {
    asm volatile("s_waitcnt vmcnt(0)" ::: "memory");
    __syncthreads();
    if (threadIdx.x == 0) {
        unsigned* bar = b.bar;
        __builtin_amdgcn_s_waitcnt(0);
        unsigned nloc = b.st[0], nx = b.st[1];
        if (nloc == 0u) { xcd_barrier_complete(bar, b.x, nloc, nx); b.st[0] = nloc; b.st[1] = nx; }
        const unsigned old = xb_add(&bar[XB_XSUB(b.x)], 1u);
        const unsigned gen = old / nloc;
        if (old + 1u == (gen + 1u) * nloc) {
            __builtin_amdgcn_fence(__ATOMIC_RELEASE, "agent");
            asm volatile("s_waitcnt vmcnt(0)" ::: "memory");
            const unsigned og = xb_add(&bar[XB_TOP], 1u);
            const unsigned tg = og / nx;
            if (og + 1u == (tg + 1u) * nx) xb_add(&bar[XB_TOPGEN], 1u);
            else XB_SPIN(xb_ld(&bar[XB_TOPGEN]) == tg, bar);
            __builtin_amdgcn_fence(__ATOMIC_ACQUIRE, "agent");
            xb_add(&bar[XB_XGEN(b.x)], 1u);
            asm volatile("s_waitcnt vmcnt(0)" ::: "memory");
        } else {
            XB_SPIN(xb_ld(&bar[XB_XGEN(b.x)]) == gen, bar);
            __builtin_amdgcn_fence(__ATOMIC_ACQUIRE, "agent");
            asm volatile("s_waitcnt vmcnt(0)" ::: "memory");
        }
    }
    __syncthreads();
}
struct Frame {
    LAS unsigned char* lds;
    volatile LAS unsigned* MISC;
    gu32* ctl;
    int tid, lane, wave, G, bx;
    unsigned char* ws;
    float* out;
};
struct Args { const float* in[28]; float* out; unsigned char* ws; };
typedef const __attribute__((address_space(4))) Args* KArgs;
__device__ __forceinline__ KArgs kargs() { KArgs k = (KArgs)__builtin_amdgcn_kernarg_segment_ptr(); asm volatile("" : "+s"(k)); return k; }
enum { I_X = 0, I_P, I_WIN, I_CONVW, I_CONVB, I_LRUWA, I_LRUBA, I_LRUWX, I_LRUBX, I_LAM, I_WBRA, I_WBRR, I_WO, I_RELB, I_LN1G, I_LN1B, I_FFG, I_FFU, I_FFD, I_ROUTER, I_ROUTERB, I_MOEG, I_MOEU, I_MOED, I_PLEG, I_PLEP, I_LN2G, I_LN2B };

__device__ __forceinline__ Frame launder(const Frame& F0) { Frame F = F0; unsigned char* w = F0.ws; int l = (int)__builtin_amdgcn_mbcnt_hi(~0u, __builtin_amdgcn_mbcnt_lo(~0u, 0u)); asm volatile("" : "+s"(w)); asm volatile("" : "+v"(l));
    F.ws = w; F.lane = l; F.tid = F0.wave * 64 + l; F.ctl = (gu32*)(w + WS_CTL); return F; }
__device__ __forceinline__ float lane_get(float v, int src_lane) { return __builtin_bit_cast(float, __builtin_amdgcn_ds_bpermute(src_lane << 2, __builtin_bit_cast(int, v))); }
__device__ __forceinline__ float lane_xor(float v, int mask, int lane) { return lane_get(v, lane ^ mask); }
__device__ __forceinline__ float lane_up(float v, int d, int lane) { return lane_get(v, lane >= d ? lane - d : lane); }
__device__ __forceinline__ float wave_sum(float v, int lane) {
#pragma unroll
    for (int o = 1; o < 64; o <<= 1) v += lane_xor(v, o, lane);
    return v;
}
__device__ __forceinline__ unsigned pk2(float lo, float hi) { return cvt_pk_bf16(lo, hi); }

__device__ __forceinline__ void cvt_item(const float* W, int ldw, int K, bf16* WT, int d0, int sc0, int nvalid, float scale, int k0, LAS float* scr, int lane) {
    const int n4 = (lane & 7) * 4;
    f32x4 v[8];
#pragma unroll
    for (int i = 0; i < 8; ++i) { const int kk = 8 * i + (lane >> 3); v[i] = (f32x4){0.f, 0.f, 0.f, 0.f}; if (n4 < nvalid) v[i] = *(const GAS f32x4*)(W + (size_t)(k0 + kk) * ldw + sc0 + n4); }
#pragma unroll
    for (int i = 0; i < 8; ++i) { const int kk = 8 * i + (lane >> 3); LAS float* d = scr + kk * 33 + n4; d[0] = v[i][0] * scale; d[1] = v[i][1] * scale; d[2] = v[i][2] * scale; d[3] = v[i][3] * scale; }
    LDS_WAIT(); asm volatile("" ::: "memory");
    const int c = lane & 7;
#pragma unroll
    for (int j = 0; j < 4; ++j) { const int nn = (lane >> 3) + 8 * j; const LAS float* s = scr + (8 * c) * 33 + nn;
        v4u o; o.x = pk2(s[0 * 33], s[1 * 33]); o.y = pk2(s[2 * 33], s[3 * 33]); o.z = pk2(s[4 * 33], s[5 * 33]); o.w = pk2(s[6 * 33], s[7 * 33]);
        *(GAS v4u*)(WT + (size_t)(d0 + nn) * K + k0 + 8 * c) = o; }
    LDS_WAIT(); asm volatile("" ::: "memory");
}
__device__ __forceinline__ void cvt_plain(const float* W, int K, int N, bf16* WT, int item, LAS float* scr, int lane) {
    const int nblk = N / 32, kb = item / nblk, nb = item % nblk;
    cvt_item(W, N, K, WT, 32 * nb, 32 * nb, 32, 1.0f, 64 * kb, scr, lane);
}
__device__ __forceinline__ void cvt_gateup(const float* Wg, const float* Wu, int dff, bf16* WT, int item, LAS float* scr, int lane) {
    const int nblk = 2 * dff / 32, kb = item / nblk, db = item % nblk, d0 = 32 * db, pn = d0 >> 8, r = d0 & 255;
    const float* W = r < 128 ? Wg : Wu; const int sc0 = 128 * pn + (r & 127);
    cvt_item(W, dff, D, WT, d0, sc0, 32, 1.0f, 64 * kb, scr, lane);
}
__device__ __forceinline__ void cvt_win(const float* W, bf16* WT, int item, LAS float* scr, int lane) {
    const int nblk = NIN / 32, kb = item / nblk, db = item % nblk, d0 = 32 * db;
    int sc0, nv = 32; float sc = 1.0f;
    if (d0 < 1024) { sc0 = d0; sc = 0.125f; }
    else if (d0 < 2048) sc0 = 1736 + (d0 - 1024);
    else if (d0 < 3072) sc0 = 2760 + (d0 - 2048);
    else if (d0 < 4096) sc0 = 3784 + (d0 - 3072);
    else if (d0 < 5120) sc0 = 4808 + (d0 - 4096);
    else if (d0 < 5632) sc0 = 1152 + (d0 - 5120);
    else if (d0 < 5696) sc0 = 1024 + (d0 - 5632);
    else if (d0 < 5760) sc0 = 1088 + (d0 - 5696);
    else if (d0 < 5824) sc0 = 1664 + (d0 - 5760);
    else if (d0 == 5824) { sc0 = 1728; nv = 8; }
    else { sc0 = 0; nv = 0; }
    cvt_item(W, D_IN, D, WT, d0, sc0, nv, sc, 64 * kb, scr, lane);
}
__device__ __forceinline__ void p0_convert(const Frame& F0, int L) {
    Frame F = launder(F0);
    const KArgs ka = kargs();
    LAS float* scr = (LAS float*)(F.lds + RING_OFF + F.wave * 16384);
    const int gw = F.bx * NWAVES + F.wave, NGW = F.G * NWAVES;
    unsigned char* wb = F.ws + WS_W;
    const int odd = L & 1, jj = L >> 1;
    constexpr int I_IN = (D / 64) * (NIN / 32), I_SQ = (D / 64) * (D / 32), I_PPJ = (PLE / 64) * (D / 32), I_LRU1 = 2 * 4;
    constexpr int I_GU_D = (D / 64) * (2 * DFF / 32), I_DN_D = (DFF / 64) * (D / 32), I_GU_E = (D / 64) * (2 * DFFE / 32), I_DN_E = (DFFE / 64) * (D / 32);
    const int n_ff = odd ? NEXP * (I_GU_E + I_DN_E) : (I_GU_D + I_DN_D);
    const int NITEMS = I_IN + 4 * I_SQ + I_PPJ + 16 * I_LRU1 + n_ff;
    for (int it = gw; it < NITEMS; it += NGW) {
        int r = it;
        if (r < I_IN) { cvt_win(ka->in[I_WIN] + (size_t)L * D * D_IN, (bf16*)(wb + W_IN), r, scr, F.lane); continue; } r -= I_IN;
        if (r < I_SQ) { cvt_plain(ka->in[I_WBRA] + (size_t)L * D * D, D, D, (bf16*)(wb + W_BRA), r, scr, F.lane); continue; } r -= I_SQ;
        if (r < I_SQ) { cvt_plain(ka->in[I_WBRR] + (size_t)L * D * D, D, D, (bf16*)(wb + W_BRR), r, scr, F.lane); continue; } r -= I_SQ;
        if (r < I_SQ) { cvt_plain(ka->in[I_WO] + (size_t)L * D * D, D, D, (bf16*)(wb + W_O), r, scr, F.lane); continue; } r -= I_SQ;
        if (r < I_SQ) { cvt_plain(ka->in[I_PLEG] + (size_t)L * D * D, D, D, (bf16*)(wb + W_PG), r, scr, F.lane); continue; } r -= I_SQ;
        if (r < I_PPJ) { cvt_plain(ka->in[I_PLEP] + (size_t)L * PLE * D, PLE, D, (bf16*)(wb + W_PP), r, scr, F.lane); continue; } r -= I_PPJ;
        if (r < 16 * I_LRU1) { const int m = r / I_LRU1, blk = m & 7, which = m >> 3;
            const float* src = ka->in[which ? I_LRUWX : I_LRUWA] + (size_t)L * 8 * 128 * 128 + (size_t)blk * 128 * 128;
            cvt_plain(src, 128, 128, (bf16*)(wb + W_LRU) + (size_t)which * 8 * 128 * 128 + (size_t)blk * 128 * 128, r % I_LRU1, scr, F.lane); continue; } r -= 16 * I_LRU1;
        if (!odd) {
            if (r < I_GU_D) { cvt_gateup(ka->in[I_FFG] + (size_t)jj * D * DFF, ka->in[I_FFU] + (size_t)jj * D * DFF, DFF, (bf16*)(wb + W_FF), r, scr, F.lane); continue; } r -= I_GU_D;
            cvt_plain(ka->in[I_FFD] + (size_t)jj * DFF * D, DFF, D, (bf16*)(wb + W_FF_DN_DENSE), r, scr, F.lane);
        } else {
            if (r < NEXP * I_GU_E) { const int e = r / I_GU_E; const size_t eo = ((size_t)jj * NEXP + e) * D * DFFE;
                cvt_gateup(ka->in[I_MOEG] + eo, ka->in[I_MOEU] + eo, DFFE, (bf16*)(wb + W_FF) + (size_t)e * 2 * DFFE * D, r % I_GU_E, scr, F.lane); continue; } r -= NEXP * I_GU_E;
            const int e = r / I_DN_E; const size_t eo = ((size_t)jj * NEXP + e) * DFFE * D;
            cvt_plain(ka->in[I_MOED] + eo, DFFE, D, (bf16*)(wb + W_FF_DN_MOE) + (size_t)e * D * DFFE, r % I_DN_E, scr, F.lane);
        }
    }
    if (L == 0) {
        const GAS f32x4* x4 = (const GAS f32x4*)ka->in[I_X]; GAS v4u* o = (GAS v4u*)(F.ws + WS_XB);
        const size_t n8 = (size_t)T_TOK * D / 8;
        for (size_t i = (size_t)F.bx * 512 + F.tid; i < n8; i += (size_t)F.G * 512) { const f32x4 a = x4[2 * i], b = x4[2 * i + 1];
            v4u w; w.x = pk2(a[0], a[1]); w.y = pk2(a[2], a[3]); w.z = pk2(b[0], b[1]); w.w = pk2(b[2], b[3]); o[i] = w; }
    }
}

template <bool LN2, bool ODD, bool DRY = false>
__device__ __forceinline__ void ln_phase(const Frame& F0, int L) {
    Frame F = launder(F0);
    const KArgs ka = kargs();
    const int jj = L >> 1;
    float* X32 = F.out; bf16* XB = (bf16*)(F.ws + WS_XB);
    const float* gam = ka->in[LN2 ? I_LN2G : I_LN1G] + (size_t)L * D; const float* bet = ka->in[LN2 ? I_LN2B : I_LN1B] + (size_t)L * D;
    f32x4 gv[4], bv[4];
#pragma unroll
    for (int j = 0; j < 4; ++j) { gv[j] = ((const GAS f32x4*)gam)[F.lane + 64 * j]; bv[j] = ((const GAS f32x4*)bet)[F.lane + 64 * j]; }
    LAS float* RT = (LAS float*)(F.lds + RING_OFF);
    LAS unsigned* TE = (LAS unsigned*)(F.lds + RING_OFF + 32768);
    volatile LAS unsigned* lcnt = F.MISC + 48; volatile LAS unsigned* gbase = F.MISC + 56;
    float rb[8];
    if (!LN2 && ODD) {
        const float* R = ka->in[I_ROUTER] + (size_t)jj * D * NEXP;
        for (int i = F.tid; i < D * NEXP; i += 512) RT[i] = R[i];
        if (F.tid < 8) lcnt[F.tid] = 0u;
#pragma unroll
        for (int e = 0; e < 8; ++e) rb[e] = ka->in[I_ROUTERB][jj * NEXP + e];
        __syncthreads();
    }
    const unsigned* route = (const unsigned*)(F.ws + WS_ROUTE);
    const bf16* YE = (const bf16*)(F.ws + F_YE);
    f32x4 nv[4];
    { const GAS f32x4* x0 = (const GAS f32x4*)(X32 + ((size_t)F.bx * 256 + F.wave) * D) + F.lane;
#pragma unroll
      for (int j = 0; j < 4; ++j) nv[j] = x0[64 * j]; }
    for (int it = 0; it < 32; ++it) {
        const int rl = F.wave + 8 * it; const size_t row = (size_t)F.bx * 256 + rl;
        GAS f32x4* xr = (GAS f32x4*)(X32 + row * D) + F.lane;
        f32x4 v[4]; float s = 0.f;
#pragma unroll
        for (int j = 0; j < 4; ++j) v[j] = nv[j];
        if (it < 31) {
#pragma unroll
            for (int j = 0; j < 4; ++j) nv[j] = xr[8 * (D / 4) + 64 * j]; }
        if (LN2 && ODD) {
            const unsigned e1 = route[row * 8 + 0], e2 = route[row * 8 + 1], p1 = route[row * 8 + 2], p2 = route[row * 8 + 3];
            const float g1 = __builtin_bit_cast(float, route[row * 8 + 4]), g2 = __builtin_bit_cast(float, route[row * 8 + 5]);
            const size_t r1 = (size_t)F.MISC[16 + e1] * 256 + p1, r2 = (size_t)F.MISC[16 + e2] * 256 + p2;
            const GAS v2u* y1 = (const GAS v2u*)(YE + r1 * D) + F.lane; const GAS v2u* y2 = (const GAS v2u*)(YE + r2 * D) + F.lane;
#pragma unroll
            for (int j = 0; j < 4; ++j) { const v2u a = y1[64 * j], b = y2[64 * j];
                v[j][0] += g1 * bf_lo(a.x) + g2 * bf_lo(b.x); v[j][1] += g1 * bf_hi(a.x) + g2 * bf_hi(b.x);
                v[j][2] += g1 * bf_lo(a.y) + g2 * bf_lo(b.y); v[j][3] += g1 * bf_hi(a.y) + g2 * bf_hi(b.y); }
        }
#pragma unroll
        for (int j = 0; j < 4; ++j) s += (v[j][0] + v[j][1]) + (v[j][2] + v[j][3]);
        const float mean = wave_sum(s, F.lane) * (1.f / D); float s2 = 0.f;
#pragma unroll
        for (int j = 0; j < 4; ++j) { v[j] = v[j] - mean; s2 += (v[j][0] * v[j][0] + v[j][1] * v[j][1]) + (v[j][2] * v[j][2] + v[j][3] * v[j][3]); }
        const float rstd = 1.f / sqrtf(wave_sum(s2, F.lane) * (1.f / D) + LN_EPS);
        GAS v2u* o8 = (GAS v2u*)((DRY ? (bf16*)(F.ws + WS_NEED) : XB) + row * D) + F.lane;
        GAS f32x4* xw = DRY ? (GAS f32x4*)((float*)(F.ws + WS_NEED) + row * D) + F.lane : xr;
#pragma unroll
        for (int j = 0; j < 4; ++j) { v[j] = v[j] * rstd * gv[j] + bv[j]; if (DRY || (LN2 && L == DEPTH - 1)) xw[64 * j] = v[j];
            v2u w; w.x = pk2(v[j][0], v[j][1]); w.y = pk2(v[j][2], v[j][3]); o8[64 * j] = w; }
        if (!LN2) {
            const f32x4 pv = ((const GAS f32x4*)(ka->in[I_P] + ((size_t)L * T_TOK + row) * PLE))[F.lane];
            v2u w; w.x = pk2(pv[0], pv[1]); w.y = pk2(pv[2], pv[3]); ((GAS v2u*)(F.ws + (DRY ? WS_NEED : F_PB) + row * PLE * 2))[F.lane] = w;
        }
        if (!LN2 && ODD) {
            float lg[8];
#pragma unroll
            for (int e = 0; e < 8; ++e) lg[e] = 0.f;
#pragma unroll
            for (int j = 0; j < 4; ++j)
#pragma unroll
                for (int q = 0; q < 4; ++q) { const int c = 4 * F.lane + 256 * j + q; const f32x4 ra = *(const LAS f32x4*)(RT + c * 8), rc = *(const LAS f32x4*)(RT + c * 8 + 4); const float xv = v[j][q];
                    lg[0] += xv * ra[0]; lg[1] += xv * ra[1]; lg[2] += xv * ra[2]; lg[3] += xv * ra[3]; lg[4] += xv * rc[0]; lg[5] += xv * rc[1]; lg[6] += xv * rc[2]; lg[7] += xv * rc[3]; }
#pragma unroll
            for (int e = 0; e < 8; ++e) lg[e] = wave_sum(lg[e], F.lane) + rb[e];
            int e1 = 0; float v1 = lg[0];
#pragma unroll
            for (int e = 1; e < 8; ++e) if (lg[e] > v1) { v1 = lg[e]; e1 = e; }
            int e2 = -1; float v2 = 0.f;
#pragma unroll
            for (int e = 0; e < 8; ++e) if (e != e1 && (e2 < 0 || lg[e] > v2)) { v2 = lg[e]; e2 = e; }
            const float ex = __expf(v2 - v1), g1 = 1.f / (1.f + ex), g2 = ex * g1;
            if (F.lane == 0) { const unsigned lp1 = __hip_atomic_fetch_add((LAS unsigned*)lcnt + e1, 1u, __ATOMIC_RELAXED, __HIP_MEMORY_SCOPE_WORKGROUP), lp2 = __hip_atomic_fetch_add((LAS unsigned*)lcnt + e2, 1u, __ATOMIC_RELAXED, __HIP_MEMORY_SCOPE_WORKGROUP);
                TE[rl * 4 + 0] = (unsigned)e1 | ((unsigned)e2 << 8) | (lp1 << 16); TE[rl * 4 + 1] = lp2; TE[rl * 4 + 2] = __builtin_bit_cast(unsigned, g1); TE[rl * 4 + 3] = __builtin_bit_cast(unsigned, g2); }
        }
    }
    if (!LN2 && ODD) {
        __syncthreads();
        if (F.tid < 8) gbase[F.tid] = __hip_atomic_fetch_add(F.ctl + CW_CNT + jj * 1024 + 64 * F.tid, lcnt[F.tid], RLX_AGENT);
        __syncthreads();
        if (F.tid < 256) { const unsigned w0 = TE[F.tid * 4], lp2 = TE[F.tid * 4 + 1]; const unsigned e1 = w0 & 255u, e2 = (w0 >> 8) & 255u, lp1 = w0 >> 16;
            const unsigned p1 = gbase[e1] + lp1, p2 = gbase[e2] + lp2; const unsigned tok = (unsigned)F.bx * 256 + F.tid;
            GAS int* list = (GAS int*)(F.ws + WS_LIST); list[(size_t)e1 * T_TOK + p1] = (int)tok; list[(size_t)e2 * T_TOK + p2] = (int)tok;
            GAS v4u* ro = (GAS v4u*)(F.ws + WS_ROUTE) + (size_t)tok * 2; v4u a; a.x = e1; a.y = e2; a.z = p1; a.w = p2; ro[0] = a; v4u b; b.x = TE[F.tid * 4 + 2]; b.y = TE[F.tid * 4 + 3]; b.z = 0u; b.w = 0u; ro[1] = b; }
        __syncthreads();
    }
}
template <int NJ>
__device__ __forceinline__ void select_topk_n(LAS const float* sc, int n_adm, GAS unsigned short* out, int lane) {
    const int nj = n_adm >> 6;
    unsigned u[NJ];
#pragma unroll
    for (int j = 0; j < NJ; ++j) { unsigned b = 0u;
        if (j < NJ - 8 || j < nj) { b = __builtin_bit_cast(unsigned, sc[64 * j + lane]); b = (b == 0x80000000u) ? 0u : b; b = (b & 0x80000000u) ? ~b : (b | 0x80000000u); }
        u[j] = b; }
    unsigned prefix = 0u; bool exact = false;
    for (int bit = 31; bit >= 0; --bit) {
        const unsigned cand = prefix | (1u << bit); int cnt = 0;
#pragma unroll
        for (int j = 0; j < NJ; ++j) cnt += __popcll(__ballot(u[j] >= cand));
        if (cnt >= 256) { prefix = cand; if (cnt == 256) { exact = true; break; } }
    }
    const unsigned thr = exact ? prefix - 1u : prefix;
    int ngt = 0;
#pragma unroll
    for (int j = 0; j < NJ; ++j) ngt += __popcll(__ballot(u[j] > thr));
    const int quota = 256 - ngt;
    int obase = 0, tbase = 0; const unsigned long long lt = (1ull << lane) - 1ull;
#pragma unroll
    for (int j = 0; j < NJ; ++j) {
        const bool gt = u[j] > thr, eq = u[j] == thr;
        const unsigned long long meq = __ballot(eq);
        const bool seleq = eq && (tbase + __popcll(meq & lt) < quota);
        const unsigned long long msel = __ballot(gt || seleq);
        if (gt || seleq) out[obase + __popcll(msel & lt)] = (unsigned short)(64 * j + lane);
        obase += __popcll(msel); tbase += __popcll(meq);
    }
}
__device__ __forceinline__ void select_topk(LAS const float* sc, int n_adm, GAS unsigned short* out, int lane) {
    if (n_adm <= 256) {
#pragma unroll
        for (int j = 0; j < 4; ++j) { const int p = lane + 64 * j; out[p] = (unsigned short)(p < n_adm ? p : 0); }
        return;
    }
    if (n_adm <= 512) select_topk_n<8>(sc, n_adm, out, lane);
    else if (n_adm <= 1024) select_topk_n<16>(sc, n_adm, out, lane);
    else if (n_adm <= 1536) select_topk_n<24>(sc, n_adm, out, lane);
    else select_topk_n<32>(sc, n_adm, out, lane);
}
__device__ __forceinline__ void indexer_phase(const Frame& F0) {
    Frame F = launder(F0);
    LAS float* sc = (LAS float*)(F.lds + RING_OFF);
    const bf16* QI = (const bf16*)(F.ws + Z_QI); const bf16* SM = (const bf16*)(F.ws + Z_SM);
    GAS unsigned short* IDX = (GAS unsigned short*)(F.ws + WS_IDX);
    const int lane = F.lane, h = lane >> 5, r = lane & 31;
    const int rq = 2 * ((r >> 2) & 1) + ((r >> 4) & 1), rh = (r & 3) + 4 * ((r >> 3) & 1);
    const int vcu = (F.bx & 7) * (F.G >> 3) + (F.bx >> 3);
    bf16x8 A[4][4]; v4u wq[4][2];
#define IDX_TILE(pi_, b_, tq_) const int pid_ = vcu * 8 + ((pi_) >> 1), b_ = pid_ >> 6, jp_ = pid_ & 63, tq_ = 16 * (((pi_) & 1) ? 127 - jp_ : jp_)
#define IDX_LOAD_A(t0_) do { _Pragma("unroll") for (int mt = 0; mt < 4; ++mt) { \
        _Pragma("unroll") for (int s = 0; s < 4; ++s) A[mt][s] = *(const GAS bf16x8*)(QI + (size_t)((t0_) + 4 * mt + rq) * 512 + rh * 64 + 16 * s + 8 * h); \
        _Pragma("unroll") for (int qq = 0; qq < 2; ++qq) wq[mt][qq] = *(const GAS v4u*)(SM + (size_t)((t0_) + 4 * mt + 2 * h + qq) * 256 + 192); } } while (0)
    { IDX_TILE(0, b0, tq0); if (tq0 >= 256) IDX_LOAD_A(b0 * SEQ + tq0); }
    for (int pi = 0; pi < 16; ++pi) {
        IDX_TILE(pi, b, tq);
        const int t0 = b * SEQ + tq;
        const int n_adm = ((tq >> 6) + 1) * 64, nkb = n_adm >> 5;
        if (n_adm > 256) {
            for (int kb = F.wave; kb < nkb; kb += 8) {
                const int key = 32 * kb + r;
                bf16x8 B[4];
#pragma unroll
                for (int s = 0; s < 4; ++s) B[s] = *(const GAS bf16x8*)(SM + (size_t)(b * SEQ + key) * 256 + 128 + 16 * s + 8 * h);
#pragma unroll
                for (int mt = 0; mt < 4; ++mt) {
                    f32x16 acc;
#pragma unroll
                    for (int i = 0; i < 16; ++i) acc[i] = 0.f;
#pragma unroll
                    for (int s = 0; s < 4; ++s) acc = __builtin_amdgcn_mfma_f32_32x32x16_bf16(A[mt][s], B[s], acc, 0, 0, 0);
                    float sA = 0.f, sB = 0.f;
#pragma unroll
                    for (int i = 0; i < 8; ++i) { const unsigned wa = wq[mt][0][i >> 1], wb = wq[mt][1][i >> 1];
                        const float fa = (i & 1) ? bf_hi(wa) : bf_lo(wa), fb = (i & 1) ? bf_hi(wb) : bf_lo(wb);
                        sA += fmaxf(acc[i], 0.f) * fa; sB += fmaxf(acc[8 + i], 0.f) * fb; }
                    sc[(4 * mt + 2 * h) * 2048 + key] = sA; sc[(4 * mt + 2 * h + 1) * 2048 + key] = sB;
                }
            }
        }
        __syncthreads();
        if (pi < 15) { IDX_TILE(pi + 1, bn, tqn); if (tqn >= 256) IDX_LOAD_A(bn * SEQ + tqn); }
#pragma unroll 1
        for (int qq = 0; qq < 2; ++qq) { const int q = 2 * F.wave + qq; select_topk(sc + q * 2048, n_adm, IDX + (size_t)(t0 + q) * 256, lane); }
        __syncthreads();
    }
#undef IDX_TILE
#undef IDX_LOAD_A
}

__device__ __forceinline__ unsigned vst_off(unsigned r, unsigned ch) { return r * 128u + 16u * (ch ^ ((((r >> 1) ^ (r >> 4)) & 1u) << 1) ^ (((r >> 3) & 1u) << 2)); }
__device__ __forceinline__ int t5_bucket_dev(int rel) {
    const int n = rel < 0 ? -rel : rel;
    int v = n;
    if (n >= 8) v = 8 + (n >= 12) + (n >= 16) + (n >= 23) + (n >= 32) + (n >= 46) + (n >= 64) + (n >= 91);
    return v + (rel > 0 ? 16 : 0);
}
#ifndef ATT_REPS
#define ATT_REPS 1
#endif
#ifndef ATT_FIXKEYS
#define ATT_FIXKEYS 0
#endif
template <int FIX = 0>
__device__ __forceinline__ void attention_phase(const Frame& F0) {
#pragma unroll 1
    for (int rep = 0; rep < ATT_REPS; ++rep) {
    Frame F = launder(F0);
    const bf16* SM = (const bf16*)(F.ws + Z_SM); const bf16* Q = (const bf16*)(F.ws + Z_Q); bf16* OB = (bf16*)(F.ws + Z_XR);
    const GAS unsigned short* IDX = (const GAS unsigned short*)(F.ws + WS_IDX);
    const int lane = F.lane, g = lane >> 4, m = lane & 15;
    LAS unsigned char* vst = F.lds + RING_OFF + F.wave * 4096;
    const unsigned vbase = (unsigned)(size_t)vst;
    LAS unsigned char* BK = F.lds + RING_OFF + 32768; LAS unsigned char* OH = F.lds + RING_OFF + 32768 + 2176;
    for (int i = F.tid; i < 2112; i += 512) BK[i] = (unsigned char)t5_bucket_dev(i - 2047);
    if (F.tid < 128) { const int bkt = F.tid >> 2, gg = F.tid & 3, j = bkt - 8 * gg; v4u oh; oh.x = oh.y = oh.z = oh.w = 0u;
        if (j >= 0 && j < 8) { const unsigned val = (j & 1) ? 0x3F800000u : 0x3F80u; if ((j >> 1) == 0) oh.x = val; else if ((j >> 1) == 1) oh.y = val; else if ((j >> 1) == 2) oh.z = val; else oh.w = val; }
        *(LAS v4u*)(OH + F.tid * 16) = oh; }
    __syncthreads();
    bf16x8 bb;
    { const float* rbias = kargs()->in[I_RELB]; unsigned w[4];
#pragma unroll
      for (int j = 0; j < 4; ++j) w[j] = pk2(rbias[(8 * g + 2 * j) * 16 + m], rbias[(8 * g + 2 * j + 1) * 16 + m]);
      v4u t; t.x = w[0]; t.y = w[1]; t.z = w[2]; t.w = w[3]; bb = __builtin_bit_cast(bf16x8, t); }
    unsigned tra[4][2];
    { const unsigned q = (lane & 15) >> 2, p = lane & 3;
#pragma unroll
      for (int c = 0; c < 4; ++c)
#pragma unroll
        for (int t = 0; t < 2; ++t) tra[c][t] = vst_off(8 * g + 4 * t + q, 2 * c + (p >> 1)) + 8 * (p & 1); }
    const int vcu = (F.bx & 7) * (F.G >> 3) + (F.bx >> 3);
    v4u ni0, ni1; bf16x8 nq[2]; bf16x8 ka[16][2]; unsigned koff[16];
#define ATT_KOFF(i0_, i1_) do { _Pragma("unroll") for (int k = 0; k < 4; ++k) { koff[2 * k] = ((i0_)[k] & 0xffffu) * 512u + 16u * g; koff[2 * k + 1] = ((i0_)[k] >> 16) * 512u + 16u * g; \
        koff[8 + 2 * k] = ((i1_)[k] & 0xffffu) * 512u + 16u * g; koff[8 + 2 * k + 1] = ((i1_)[k] >> 16) * 512u + 16u * g; } } while (0)
#define ATT_KLOAD(kvb_) do { const GAS char* kb_ = (kvb_); _Pragma("unroll") for (int T = 0; T < 16; ++T) { \
        asm volatile("global_load_dwordx4 %0, %2, %3\n\tglobal_load_dwordx4 %1, %2, %3 offset:64" : "=&v"(ka[T][0]), "=&v"(ka[T][1]) : "v"(koff[T]), "s"(kb_) : "memory"); } } while (0)
#define ATT_KWAIT(n_, T0_) asm volatile("s_waitcnt vmcnt(" #n_ ")" : "+v"(ka[T0_][0]), "+v"(ka[T0_][1]), "+v"(ka[T0_ + 1][0]), "+v"(ka[T0_ + 1][1]), "+v"(ka[T0_ + 2][0]), "+v"(ka[T0_ + 2][1]), "+v"(ka[T0_ + 3][0]), "+v"(ka[T0_ + 3][1]), \
        "+v"(ka[T0_ + 4][0]), "+v"(ka[T0_ + 4][1]), "+v"(ka[T0_ + 5][0]), "+v"(ka[T0_ + 5][1]), "+v"(ka[T0_ + 6][0]), "+v"(ka[T0_ + 6][1]), "+v"(ka[T0_ + 7][0]), "+v"(ka[T0_ + 7][1]) :: "memory")
    { const int tok0 = vcu * 256 + F.wave; const GAS v4u* ip = (const GAS v4u*)(IDX + (size_t)tok0 * 256 + 16 * m); ni0 = ip[0]; ni1 = ip[1];
#pragma unroll
      for (int s = 0; s < 2; ++s) nq[s] = *(const GAS bf16x8*)(Q + (size_t)tok0 * D + m * 64 + 32 * s + 8 * g);
      ATT_KOFF(ni0, ni1); ATT_KLOAD((const GAS char*)(SM + (size_t)(tok0 >> 11) * SEQ * 256)); }
    for (int it = 0; it < 32; ++it) {
        const int tok = vcu * 256 + F.wave + 8 * it, b = tok >> 11, tq = tok & (SEQ - 1);
        const int n_valid = (((tq >> 6) + 1) * 64) < 256 ? ((tq >> 6) + 1) * 64 : 256;
        bf16x8 qf[2]; qf[0] = nq[0]; qf[1] = nq[1];
        const GAS char* kvb = (const GAS char*)(SM + (size_t)b * SEQ * 256);
        f32x4 S[16];
#pragma unroll
        for (int T = 0; T < 16; ++T) {
            if (T == 0) ATT_KWAIT(16, 0);
            if (T == 8) ATT_KWAIT(0, 8);
            const unsigned bkt = BK[(koff[T] >> 9) + (2047 - tq)];
            const v4u oh = *(const LAS v4u*)(OH + bkt * 64 + g * 16);
            f32x4 a = (f32x4){0.f, 0.f, 0.f, 0.f};
            a = __builtin_amdgcn_mfma_f32_16x16x32_bf16(__builtin_bit_cast(bf16x8, oh), bb, a, 0, 0, 0);
            a = __builtin_amdgcn_mfma_f32_16x16x32_bf16(ka[T][0], qf[0], a, 0, 0, 0);
            a = __builtin_amdgcn_mfma_f32_16x16x32_bf16(ka[T][1], qf[1], a, 0, 0, 0);
            S[T] = a;
        }
        __builtin_amdgcn_sched_barrier(0);
        v4u vv[16][2];
#pragma unroll
        for (int T = 0; T < 12; ++T) { vv[T][0] = *(const GAS v4u*)(kvb + koff[T] + 128); vv[T][1] = *(const GAS v4u*)(kvb + koff[T] + 192); }
        if (n_valid < 256) {
#pragma unroll
            for (int T = 0; T < 16; ++T)
#pragma unroll
                for (int i = 0; i < 4; ++i) if (16 * (4 * g + i) + T >= n_valid) S[T][i] = -1e30f;
        }
        float mx = -3.0e38f;
#pragma unroll
        for (int T = 0; T < 16; ++T) mx = fmaxf(fmaxf(fmaxf(S[T][0], S[T][1]), fmaxf(S[T][2], S[T][3])), mx);
        mx = fmaxf(mx, lane_xor(mx, 16, lane)); mx = fmaxf(mx, lane_xor(mx, 32, lane));
        const float mneg = -mx * 1.4426950408889634f; float sum = 0.f;
#pragma unroll
        for (int T = 0; T < 16; ++T)
#pragma unroll
            for (int i = 0; i < 4; ++i) { const float p = __builtin_amdgcn_exp2f(S[T][i] * 1.4426950408889634f + mneg); S[T][i] = p; sum += p; }
        sum += lane_xor(sum, 16, lane); sum += lane_xor(sum, 32, lane);
        { const int tokn = vcu * 256 + F.wave + 8 * (it < 31 ? it + 1 : it); const GAS v4u* ip = (const GAS v4u*)(IDX + (size_t)tokn * 256 + 16 * m); ni0 = ip[0]; ni1 = ip[1];
#pragma unroll
          for (int s = 0; s < 2; ++s) nq[s] = *(const GAS bf16x8*)(Q + (size_t)tokn * D + m * 64 + 32 * s + 8 * g); }
        f32x4 O[4];
#pragma unroll
        for (int c = 0; c < 4; ++c) O[c] = (f32x4){0.f, 0.f, 0.f, 0.f};
#pragma unroll
        for (int ks = 0; ks < 8; ++ks) {
            const unsigned vb = vbase;
            if (ks == 2) {
#pragma unroll
                for (int T = 12; T < 16; ++T) { vv[T][0] = *(const GAS v4u*)(kvb + koff[T] + 128); vv[T][1] = *(const GAS v4u*)(kvb + koff[T] + 192); }
            }
#pragma unroll
            for (int tt = 0; tt < 2; ++tt) { const v4u v0 = vv[2 * ks + tt][0], v1 = vv[2 * ks + tt][1];
                const unsigned rr = 8 * (m >> 2) + 4 * tt + (m & 3);
                *(LAS v4u*)(vst + vst_off(rr, g)) = v0; *(LAS v4u*)(vst + vst_off(rr, g + 4)) = v1; }
            v4u pw; pw.x = pk2(S[2 * ks][0], S[2 * ks][1]); pw.y = pk2(S[2 * ks][2], S[2 * ks][3]); pw.z = pk2(S[2 * ks + 1][0], S[2 * ks + 1][1]); pw.w = pk2(S[2 * ks + 1][2], S[2 * ks + 1][3]);
            const bf16x8 pf = __builtin_bit_cast(bf16x8, pw);
            v2u f[4][2];
            asm volatile("s_waitcnt lgkmcnt(0)\n\t"
                         "ds_read_b64_tr_b16 %0, %8\n\tds_read_b64_tr_b16 %1, %9\n\tds_read_b64_tr_b16 %2, %10\n\tds_read_b64_tr_b16 %3, %11\n\t"
                         "ds_read_b64_tr_b16 %4, %12\n\tds_read_b64_tr_b16 %5, %13\n\tds_read_b64_tr_b16 %6, %14\n\tds_read_b64_tr_b16 %7, %15\n\t"
                         "s_waitcnt lgkmcnt(0)"
                         : "=&v"(f[0][0]), "=&v"(f[0][1]), "=&v"(f[1][0]), "=&v"(f[1][1]), "=&v"(f[2][0]), "=&v"(f[2][1]), "=&v"(f[3][0]), "=&v"(f[3][1])
                         : "v"(vb + tra[0][0]), "v"(vb + tra[0][1]), "v"(vb + tra[1][0]), "v"(vb + tra[1][1]), "v"(vb + tra[2][0]), "v"(vb + tra[2][1]), "v"(vb + tra[3][0]), "v"(vb + tra[3][1])
                         : "memory");
#pragma unroll
            for (int c = 0; c < 4; ++c) { v4u t; t.x = f[c][0].x; t.y = f[c][0].y; t.z = f[c][1].x; t.w = f[c][1].y;
                O[c] = __builtin_amdgcn_mfma_f32_16x16x32_bf16(__builtin_bit_cast(bf16x8, t), pf, O[c], 0, 0, 0); }
        }
        const float inv = 1.0f / sum;
#pragma unroll
        for (int c = 0; c < 4; ++c) { v2u w; w.x = pk2(O[c][0] * inv, O[c][1] * inv); w.y = pk2(O[c][2] * inv, O[c][3] * inv);
            *(GAS v2u*)(OB + (size_t)tok * D + m * 64 + 16 * c + 4 * g) = w; }
        { const int tokn = vcu * 256 + F.wave + 8 * (it < 31 ? it + 1 : it); ATT_KOFF(ni0, ni1); ATT_KLOAD((const GAS char*)(SM + (size_t)(tokn >> 11) * SEQ * 256)); }
    }
#undef ATT_KOFF
#undef ATT_KLOAD
#undef ATT_KWAIT
    }
}
constexpr int XCS = 136;
constexpr int HHS = 132;
__device__ __forceinline__ float gelu_tanh(float x) {
    const float z = 0.7978845608028654f * (x + 0.044715f * x * x * x);
    const float e = __builtin_amdgcn_exp2f(2.885390081777927f * z);
    const float th = 1.0f - 2.0f * __builtin_amdgcn_rcpf(e + 1.0f);
    return 0.5f * x * (1.0f + th);
}
template <bool DRY = false>
__device__ __forceinline__ void lru_phase(const Frame& F0, int L) {
    Frame F = launder(F0);
    const KArgs ka = kargs();
    const int b = F.bx >> 3, nb = F.bx & 7;
    const bf16* XR = (const bf16*)(F.ws + Z_XR); bf16* YR = (bf16*)(F.ws + Z_YR);
    const bf16* WL = (const bf16*)(F.ws + WS_W + W_LRU);
    LAS bf16* XC = (LAS bf16*)(F.lds + RING_OFF);
    LAS float* HH = (LAS float*)(F.lds + RING_OFF + 2 * 64 * XCS * 2);
    const int tid = F.tid, lane = F.lane, w = F.wave, g = lane >> 4, m = lane & 15;
    const int cc = tid & 15, tp = tid >> 4;
    const int ch0 = nb * 128 + 8 * cc;
    float cw[4][8], cbias[8];
#pragma unroll
    for (int j = 0; j < 4; ++j)
#pragma unroll
        for (int k = 0; k < 8; ++k) cw[j][k] = ka->in[I_CONVW][(size_t)L * 4 * D + j * D + ch0 + k];
#pragma unroll
    for (int k = 0; k < 8; ++k) cbias[k] = ka->in[I_CONVB][(size_t)L * D + ch0 + k];
    bf16x8 Br[4], Bi[4];
#pragma unroll
    for (int s = 0; s < 4; ++s) { Br[s] = *(const GAS bf16x8*)(WL + ((size_t)nb * 128 + 16 * w + m) * 128 + 32 * s + 8 * g);
                                  Bi[s] = *(const GAS bf16x8*)(WL + (size_t)8 * 128 * 128 + ((size_t)nb * 128 + 16 * w + m) * 128 + 32 * s + 8 * g); }
    const int chl = 16 * w + m, chg = nb * 128 + chl;
    const float ba = ka->in[I_LRUBA][(size_t)L * D + chg], bx = ka->in[I_LRUBX][(size_t)L * D + chg];
    const float lam = ka->in[I_LAM][(size_t)L * D + chg];
    const float sp8 = -8.0f * (fmaxf(-lam, 0.f) + log1pf(__expf(-fabsf(lam))));
    float carry = 0.f;
    const size_t rowb = (size_t)b * SEQ;
    v4u nxin[5], nyin[2];
#pragma unroll
    for (int k = 0; k < 5; ++k) { const int t = 2 * tp - 3 + k; v4u z; z.x = z.y = z.z = z.w = 0u; nxin[k] = (t >= 0) ? *(const GAS v4u*)(XR + (rowb + t) * D + ch0) : z; }
#pragma unroll
    for (int k = 0; k < 2; ++k) nyin[k] = *(const GAS v4u*)(YR + (rowb + 2 * tp + k) * D + ch0);
    for (int tile = 0; tile < 32; ++tile) {
        const int t0 = tile * 64, buf = tile & 1;
        LAS bf16* xc = XC + buf * 64 * XCS; LAS float* hh = HH + buf * 64 * HHS;
        v4u xin[5], yin[2];
#pragma unroll
        for (int k = 0; k < 5; ++k) xin[k] = nxin[k];
#pragma unroll
        for (int k = 0; k < 2; ++k) yin[k] = nyin[k];
        if (tile < 31) {
#pragma unroll
            for (int k = 0; k < 5; ++k) nxin[k] = *(const GAS v4u*)(XR + (rowb + t0 + 64 + 2 * tp - 3 + k) * D + ch0);
#pragma unroll
            for (int k = 0; k < 2; ++k) nyin[k] = *(const GAS v4u*)(YR + (rowb + t0 + 64 + 2 * tp + k) * D + ch0);
        }
#pragma unroll
        for (int k = 0; k < 2; ++k) { float o[8];
#pragma unroll
            for (int c = 0; c < 8; ++c) { float a = cbias[c];
#pragma unroll
                for (int j = 0; j < 4; ++j) { const unsigned wv = xin[k + j][c >> 1]; a += ((c & 1) ? bf_hi(wv) : bf_lo(wv)) * cw[j][c]; }
                o[c] = a; }
            v4u pw; pw.x = pk2(o[0], o[1]); pw.y = pk2(o[2], o[3]); pw.z = pk2(o[4], o[5]); pw.w = pk2(o[6], o[7]);
            *(LAS v4u*)(xc + (2 * tp + k) * XCS + 8 * cc) = pw; }
        __syncthreads();
#pragma unroll
        for (int mt = 0; mt < 4; ++mt) {
            f32x4 ar = (f32x4){0.f, 0.f, 0.f, 0.f}, ai = (f32x4){0.f, 0.f, 0.f, 0.f};
#pragma unroll
            for (int s = 0; s < 4; ++s) { const bf16x8 A = *(const LAS bf16x8*)(xc + (16 * mt + m) * XCS + 32 * s + 8 * g);
                ar = __builtin_amdgcn_mfma_f32_16x16x32_bf16(A, Br[s], ar, 0, 0, 0); ai = __builtin_amdgcn_mfma_f32_16x16x32_bf16(A, Bi[s], ai, 0, 0, 0); }
            float P[4], W[4];
#pragma unroll
            for (int i = 0; i < 4; ++i) {
                const float rr = sigmoidf_fast(ar[i] + ba), ig = sigmoidf_fast(ai[i] + bx);
                const float la = sp8 * rr;
                const float a = __builtin_amdgcn_exp2f(1.4426950408889634f * la);
                const float mult = __builtin_amdgcn_sqrtf(fmaxf(__builtin_fmaf(-a, a, 1.0f), 0.f));
                const float xv = __builtin_bit_cast(float, (unsigned)xc[(16 * mt + 4 * g + i) * XCS + chl] << 16);
                const float u = mult * (ig * xv);
                if (i == 0) { P[0] = a; W[0] = u; } else { P[i] = a * P[i - 1]; W[i] = a * W[i - 1] + u; }
            }
            float Ac = P[3], Uc = W[3];
            { const float A1 = lane_up(Ac, 16, lane), U1 = lane_up(Uc, 16, lane); if (g >= 1) { Uc = Ac * U1 + Uc; Ac = Ac * A1; } }
            { const float A2 = lane_up(Ac, 32, lane), U2 = lane_up(Uc, 32, lane); if (g >= 2) { Uc = Ac * U2 + Uc; Ac = Ac * A2; } }
            float Ae = lane_up(Ac, 16, lane), Ue = lane_up(Uc, 16, lane); if (g == 0) { Ae = 1.f; Ue = 0.f; }
            const float hin = Ae * carry + Ue;
            const float cnew = Ac * carry + Uc;
            carry = lane_get(cnew, 48 + m);
#pragma unroll
            for (int i = 0; i < 4; ++i) hh[(16 * mt + 4 * g + i) * HHS + chl] = P[i] * hin + W[i];
        }
        __syncthreads();
#pragma unroll
        for (int k = 0; k < 2; ++k) { const f32x4 h0 = *(const LAS f32x4*)(hh + (2 * tp + k) * HHS + 8 * cc), h1 = *(const LAS f32x4*)(hh + (2 * tp + k) * HHS + 8 * cc + 4);
            float o[8];
#pragma unroll
            for (int c = 0; c < 8; ++c) { const unsigned wv = yin[k][c >> 1]; const float y = (c & 1) ? bf_hi(wv) : bf_lo(wv); o[c] = (c < 4 ? h0[c] : h1[c - 4]) * gelu_tanh(y); }
            v4u pw; pw.x = pk2(o[0], o[1]); pw.y = pk2(o[2], o[3]); pw.z = pk2(o[4], o[5]); pw.w = pk2(o[6], o[7]);
            *(GAS v4u*)((DRY ? (bf16*)(F.ws + WS_NEED) : YR) + (rowb + t0 + 2 * tp + k) * D + ch0) = pw; }
    }
    __syncthreads();
}

struct MoeOrder : pg8::StaticOrder {
    const volatile LAS unsigned* tb; int tile0; const int* list; size_t bstride;
    __device__ __forceinline__ int expert_of(int gt) const { int e = 0;
#pragma unroll
        for (int k = 1; k < 8; ++k) e += (gt >= (int)tb[k]) ? 1 : 0;
        return e; }
    __device__ __forceinline__ const char* b_base(const pg8::Gemm& g, const pg8::Unit& u, size_t tstep) const { return (const char*)g.Bt + (size_t)expert_of(tile0 + u.pm) * bstride + (size_t)u.pn * tstep; }
};
struct MoeGatherOrder : MoeOrder {
    static constexpr bool GATHER = true;
    __device__ __forceinline__ const char* a_base(const pg8::Gemm& g, const pg8::Unit&, size_t) const { return (const char*)g.A; }
    __device__ __forceinline__ void a_rows(const pg8::Unit& u, int R0, int R1, int C0, int C1, int K, unsigned (&off)[2][2]) const {
        const int gt = tile0 + u.pm, e = expert_of(gt), j = gt - (int)tb[e], n = (int)tb[16 + e];
        const GAS int* le = (const GAS int*)list + (size_t)e * T_TOK;
#pragma unroll
        for (int h = 0; h < 2; ++h) { int p0 = 256 * j + 128 * h + R0, p1 = 256 * j + 128 * h + R1; p0 = p0 < n ? p0 : n - 1; p1 = p1 < n ? p1 : n - 1;
            off[h][0] = ((unsigned)le[p0] * (unsigned)K + (unsigned)C0) * 2u; off[h][1] = ((unsigned)le[p1] * (unsigned)K + (unsigned)C1) * 2u; }
    }
};
#ifdef SELFCHECK
#ifndef SC_TOL
#define SC_TOL 0.03f
#define SC_ABS 1e-5f
#endif
__device__ __forceinline__ float sc_bf(const bf16* p, size_t i) { return __builtin_bit_cast(float, (unsigned)((const GAS bf16*)p)[i] << 16); }
__device__ __forceinline__ void sc_fail(const Frame& F, unsigned code) { __hip_atomic_fetch_or(F.ctl + CW_CODE, code, RLX_AGENT); }
__device__ __forceinline__ int sc_bucket_ref(int rel) {
    const int half = 16, max_exact = 8; const int ret = rel > 0 ? half : 0; const int n = rel < 0 ? -rel : rel;
    const float nf = (float)(n > 1 ? n : 1);
    int large = max_exact + (int)(logf(nf / (float)max_exact) / logf(16.0f) * (float)(half - max_exact));
    large = large < half - 1 ? large : half - 1;
    return ret + (n < max_exact ? n : large);
}
__device__ __forceinline__ void selfcheck_topk(const Frame& F0) {
    Frame F = launder(F0);
    if (F.wave != 0) return;
    const bf16* QI = (const bf16*)(F.ws + Z_QI); const bf16* SM = (const bf16*)(F.ws + Z_SM);
    const GAS unsigned short* IDX = (const GAS unsigned short*)(F.ws + WS_IDX);
    LAS float* sc = (LAS float*)(F.lds + RING_OFF);
    LAS unsigned* bm = (LAS unsigned*)(F.lds + RING_OFF + 8192);
    const int tok = F.bx * 256 + ((F.bx * 37) & 255), b = tok >> 11, tq = tok & (SEQ - 1), n_adm = ((tq >> 6) + 1) * 64;
    const int lane = F.lane;
    bm[lane] = 0u;
    for (int s = lane; s < n_adm; s += 64) { float score = 0.f;
        for (int h = 0; h < 8; ++h) { float d = 0.f;
            for (int k = 0; k < 64; ++k) d += sc_bf(QI, (size_t)tok * 512 + h * 64 + k) * sc_bf(SM, (size_t)(b * SEQ + s) * 256 + 128 + k);
            score += fmaxf(d, 0.f) * sc_bf(SM, (size_t)tok * 256 + 192 + h); }
        sc[s] = score; }
    asm volatile("s_waitcnt lgkmcnt(0)" ::: "memory");
    const int nsel = n_adm < 256 ? n_adm : 256;
    float msel = 3.0e38f; bool bad = false;
    for (int p = lane; p < nsel; p += 64) { const int key = IDX[(size_t)tok * 256 + p]; if (key >= n_adm) { bad = true; continue; }
        const unsigned old = __hip_atomic_fetch_or(bm + (key >> 5), 1u << (key & 31), __ATOMIC_RELAXED, __HIP_MEMORY_SCOPE_WORKGROUP); if (old & (1u << (key & 31))) bad = true;
        msel = fminf(msel, sc[key]); }
    asm volatile("s_waitcnt lgkmcnt(0)" ::: "memory");
    float muns = -3.0e38f, amax = 0.f;
    for (int s = lane; s < n_adm; s += 64) { amax = fmaxf(amax, fabsf(sc[s])); if (!((bm[s >> 5] >> (s & 31)) & 1u)) muns = fmaxf(muns, sc[s]); }
#pragma unroll
    for (int o = 1; o < 64; o <<= 1) { msel = fminf(msel, lane_xor(msel, o, lane)); muns = fmaxf(muns, lane_xor(muns, o, lane)); amax = fmaxf(amax, lane_xor(amax, o, lane)); }
    if (muns > msel + 1e-4f * amax) bad = true;
    if (__any(bad)) { if (lane == 0) sc_fail(F, 1u); }
}
__device__ __forceinline__ void selfcheck_attn(const Frame& F0) {
    Frame F = launder(F0);
    if (F.wave != 0) return;
    const KArgs ka = kargs();
    const bf16* SM = (const bf16*)(F.ws + Z_SM); const bf16* Q = (const bf16*)(F.ws + Z_Q); const bf16* OB = (const bf16*)(F.ws + Z_XR);
    const GAS unsigned short* IDX = (const GAS unsigned short*)(F.ws + WS_IDX);
    LAS float* lg = (LAS float*)(F.lds + RING_OFF + 65536);
    const int tok = F.bx * 256 + ((F.bx * 37) & 255), b = tok >> 11, tq = tok & (SEQ - 1), n_adm = ((tq >> 6) + 1) * 64, nv = n_adm < 256 ? n_adm : 256;
    const int lane = F.lane;
    for (int p = lane; p < 256; p += 64) { const int key = IDX[(size_t)tok * 256 + p]; const int bk = sc_bucket_ref(key - tq);
        for (int h = 0; h < 16; ++h) { float d = 0.f;
            for (int k = 0; k < 64; ++k) d += sc_bf(Q, (size_t)tok * D + h * 64 + k) * sc_bf(SM, (size_t)(b * SEQ + key) * 256 + k);
            lg[h * 256 + p] = p < nv ? d + ((const GAS float*)ka->in[I_RELB])[bk * 16 + h] : -1e30f; } }
    asm volatile("s_waitcnt lgkmcnt(0)" ::: "memory");
    if (lane < 16) { float mx = -3.0e38f; for (int p = 0; p < 256; ++p) mx = fmaxf(mx, lg[lane * 256 + p]); float sum = 0.f;
        for (int p = 0; p < 256; ++p) { const float e = __expf(lg[lane * 256 + p] - mx); lg[lane * 256 + p] = e; sum += e; }
        const float inv = 1.f / sum; for (int p = 0; p < 256; ++p) lg[lane * 256 + p] *= inv; }
    asm volatile("s_waitcnt lgkmcnt(0)" ::: "memory");
    float emax = 0.f, omax = 0.f;
    for (int o = lane; o < 1024; o += 64) { const int h = o >> 6, d = o & 63; float acc = 0.f;
        for (int p = 0; p < 256; ++p) { const int key = IDX[(size_t)tok * 256 + p]; acc += lg[h * 256 + p] * sc_bf(SM, (size_t)(b * SEQ + key) * 256 + 64 + d); }
        const float got = sc_bf(OB, (size_t)tok * D + o); emax = fmaxf(emax, fabsf(got - acc)); omax = fmaxf(omax, fabsf(acc)); }
#pragma unroll
    for (int o = 1; o < 64; o <<= 1) { emax = fmaxf(emax, lane_xor(emax, o, lane)); omax = fmaxf(omax, lane_xor(omax, o, lane)); }
    if (!(emax <= SC_TOL * omax + SC_ABS)) { if (lane == 0) sc_fail(F, 2u); }
}
__device__ __forceinline__ void selfcheck_lru(const Frame& F0, int L, bool after) {
    Frame F = launder(F0);
    if (F.wave != 0) return;
    const KArgs ka = kargs();
    const bf16* XR = (const bf16*)(F.ws + Z_XR); const bf16* YR = (const bf16*)(F.ws + Z_YR);
    GAS float* EXP = (GAS float*)(F.ws + WS_NEED) + (size_t)F.bx * SEQ;
    const int b = F.bx >> 3, ch = ((F.bx & 7) * 128 + ((F.bx * 29) & 127)), nb = ch >> 7, lane = F.lane;
    if (after) { float emax = 0.f, omax = 0.f;
        for (int t = lane; t < SEQ; t += 64) { const float e = EXP[t], g = sc_bf(YR, (size_t)(b * SEQ + t) * D + ch); emax = fmaxf(emax, fabsf(e - g)); omax = fmaxf(omax, fabsf(e)); }
#pragma unroll
        for (int o = 1; o < 64; o <<= 1) { emax = fmaxf(emax, lane_xor(emax, o, lane)); omax = fmaxf(omax, lane_xor(omax, o, lane)); }
        if (!(emax <= SC_TOL * omax + SC_ABS)) { if (lane == 0) sc_fail(F, 4u); }
        return; }
    const float* cw = ka->in[I_CONVW] + (size_t)L * 4 * D; const float* cb = ka->in[I_CONVB] + (size_t)L * D;
    const float* wa = ka->in[I_LRUWA] + ((size_t)L * 8 + nb) * 128 * 128; const float* wx = ka->in[I_LRUWX] + ((size_t)L * 8 + nb) * 128 * 128;
    const float lam = ka->in[I_LAM][(size_t)L * D + ch], ba = ka->in[I_LRUBA][(size_t)L * D + ch], bx = ka->in[I_LRUBX][(size_t)L * D + ch];
    const float sp = fmaxf(-lam, 0.f) + log1pf(expf(-fabsf(lam)));
    const int dl = ch & 127;
    float h = 0.f;
    for (int t = 0; t < SEQ; ++t) {
        float pr = 0.f, pi = 0.f, xcc = 0.f;
#pragma unroll
        for (int q = 0; q < 2; ++q) { const int cl = lane + 64 * q, cg = nb * 128 + cl; float xc = cb[cg];
            for (int j = 0; j < 4; ++j) { const int tt = t - 3 + j; if (tt >= 0) xc += sc_bf(XR, (size_t)(b * SEQ + tt) * D + cg) * cw[j * D + cg]; }
            pr += xc * wa[cl * 128 + dl]; pi += xc * wx[cl * 128 + dl]; if (cl == dl) xcc = xc; }
#pragma unroll
        for (int o = 1; o < 64; o <<= 1) { pr += lane_xor(pr, o, lane); pi += lane_xor(pi, o, lane); xcc += lane_xor(xcc, o, lane); }
        const float r = 1.f / (1.f + expf(-(pr + ba))), ig = 1.f / (1.f + expf(-(pi + bx)));
        const float la = -8.0f * r * sp, a = expf(la), u = sqrtf(-expm1f(2.0f * la)) * (ig * xcc);
        h = a * h + u;
        const float y = sc_bf(YR, (size_t)(b * SEQ + t) * D + ch);
        const float gl = 0.5f * y * (1.f + tanhf(0.7978845608028654f * (y + 0.044715f * y * y * y)));
        if (lane == 0) EXP[t] = h * gl;
    }
}
#endif
__global__ void __launch_bounds__(NWAVES * 64, 2) mk_fwd(Args args) {
    extern __shared__ __attribute__((aligned(16))) unsigned char lds[];
    Frame F;
    F.lds = (LAS unsigned char*)lds;
    F.MISC = (volatile LAS unsigned*)(F.lds + MISC_OFF);
    F.tid = threadIdx.x; F.lane = F.tid & 63; F.wave = __builtin_amdgcn_readfirstlane(F.tid >> 6);
    F.G = gridDim.x; F.bx = blockIdx.x;
    F.ws = args.ws; F.ctl = (gu32*)(args.ws + WS_CTL); F.out = args.out;
    for (int u = threadIdx.x; u < (LDS_BYTES - LDSCTL_OFF) / 4; u += NWAVES * 64) ((LAS unsigned*)(F.lds + LDSCTL_OFF))[u] = 0u;
    __syncthreads();
    XcdBarrier bar = xcd_barrier_post((unsigned*)(F.ctl + CW_BAR), F.MISC + 8);
#define GRID_BAR() do { XcdBarrier b_ = bar; unsigned* p_ = bar.bar; asm volatile("" : "+s"(p_)); b_.bar = p_; xcd_barrier(b_); } while (0)
    float* X32 = args.out;
#define LOCAL_HANDOFF() do { asm volatile("s_waitcnt vmcnt(0)" ::: "memory"); __syncthreads(); __builtin_amdgcn_fence(__ATOMIC_ACQUIRE, "agent"); asm volatile("s_waitcnt vmcnt(0)" ::: "memory"); __syncthreads(); } while (0)
    LAS unsigned char* ring = F.lds + RING_OFF;
    using pg8::Gemm; using pg8::StaticOrder;

    for (int L = 0; L < DEPTH; ++L) {
        const int odd = L & 1;
#ifndef SK_P0
        p0_convert(F, L);
#endif
#ifdef DUP_P0
        __syncthreads(); p0_convert(F, L);
#endif
        GRID_BAR();
        { const Frame P = launder(F); unsigned char* ws = P.ws; unsigned char* wb = ws + WS_W; bf16* XB = (bf16*)(ws + WS_XB); (void)XB; (void)wb;
          Gemm g{XB, (const bf16*)(wb + W_IN), T_TOK, NIN, D}; StaticOrder S; S.init(T_TOK, NIN, P.G, P.bx);
          pg8::EpiZ E{(bf16*)(ws + Z_Q), (bf16*)(ws + Z_QI), (bf16*)(ws + Z_SM)};
#ifndef SK_G1
          pg8::gemm_phase<pg8::EpiZ, StaticOrder>(ring, g, S, E, P.wave);
#endif
        }
        GRID_BAR();
#if defined(SELFCHECK) && SELFCHECK == 3
        if (L == 0) { selfcheck_lru(F, L, false); __syncthreads(); }
#endif
#ifndef SK_IDX
        indexer_phase(F);
#endif
#ifdef DUP_IDX
        indexer_phase(F);
#endif
#ifdef DUP_LRU
        lru_phase<true>(F, L);
#endif
#ifndef SK_LRU
        lru_phase(F, L);
#endif
        GRID_BAR();
#if defined(SELFCHECK) && SELFCHECK == 1
        if (L == 0) { selfcheck_topk(F); __syncthreads(); }
#endif
#if defined(SELFCHECK) && SELFCHECK == 3
        if (L == 0) { selfcheck_lru(F, L, true); __syncthreads(); }
#endif
#ifdef DUP_ATT
        attention_phase<DUP_ATT>(F); __syncthreads();
#endif
#ifndef SK_ATT
        attention_phase(F);
#endif
        GRID_BAR();
#if defined(SELFCHECK) && SELFCHECK == 2
        if (L == 0) { selfcheck_attn(F); __syncthreads(); }
#endif
        { const Frame P = launder(F); unsigned char* ws = P.ws; unsigned char* wb = ws + WS_W; bf16* XB = (bf16*)(ws + WS_XB); (void)XB; (void)wb;
          Gemm g{(const bf16*)(ws + Z_XR), (const bf16*)(wb + W_BRA), T_TOK, D, D}; StaticOrder S; S.init(T_TOK, D, F.G, F.bx);
          pg8::EpiGate<0> E{(bf16*)(ws + Z_GA), nullptr};
#ifndef SK_G2
          pg8::gemm_phase<pg8::EpiGate<0>, StaticOrder>(ring, g, S, E, P.wave);
#endif
        }
        LOCAL_HANDOFF();
        { const Frame P = launder(F); unsigned char* ws = P.ws; unsigned char* wb = ws + WS_W; bf16* XB = (bf16*)(ws + WS_XB); (void)XB; (void)wb;
          Gemm g{(const bf16*)(ws + Z_YR), (const bf16*)(wb + W_BRR), T_TOK, D, D}; StaticOrder S; S.init(T_TOK, D, F.G, F.bx);
          pg8::EpiGate<1> E{(bf16*)(ws + Z_GA), (const bf16*)(ws + Z_GR)};
#ifndef SK_G3
          pg8::gemm_phase<pg8::EpiGate<1>, StaticOrder>(ring, g, S, E, P.wave);
#endif
        }
        GRID_BAR();
        { const Frame P = launder(F); unsigned char* ws = P.ws; unsigned char* wb = ws + WS_W; bf16* XB = (bf16*)(ws + WS_XB); (void)XB; (void)wb;
          Gemm g{(const bf16*)(ws + Z_GA), (const bf16*)(wb + W_O), T_TOK, D, D}; StaticOrder S; S.init(T_TOK, D, F.G, F.bx);
          pg8::EpiRes<0> E{X32, XB, nullptr};
#ifndef SK_G4
          pg8::gemm_phase<pg8::EpiRes<0>, StaticOrder>(ring, g, S, E, P.wave);
#endif
        }
        GRID_BAR();
#ifdef DUP_LN
        ln_phase<false, false, true>(F, L); ln_phase<false, false, true>(F, L);
#endif
#ifndef SK_LN
        if (odd) ln_phase<false, true>(F, L); else ln_phase<false, false>(F, L);
#endif
        GRID_BAR();
        if (odd) {
            if (launder(F).tid == 0) { unsigned acc = 0u; F.MISC[16] = 0u;
                for (int e = 0; e < 8; ++e) { const unsigned c = __hip_atomic_load(F.ctl + CW_CNT + (L >> 1) * 1024 + 64 * e, RLX_AGENT); F.MISC[32 + e] = c; acc += (c + 255u) >> 8; F.MISC[17 + e] = acc; } }
            __syncthreads();
        }
        { const Frame P = launder(F); unsigned char* ws = P.ws; unsigned char* wb = ws + WS_W; bf16* XB = (bf16*)(ws + WS_XB); (void)XB; (void)wb;
          Gemm g{(const bf16*)(ws + F_PB), (const bf16*)(wb + W_PP), T_TOK, D, PLE}; StaticOrder S; S.init(T_TOK, D, F.G, F.bx);
          pg8::EpiBf16 E{(bf16*)(ws + F_U), D, 0};
#ifndef SK_G5
          pg8::gemm_phase<pg8::EpiBf16, StaticOrder>(ring, g, S, E, P.wave);
#endif
        }
        LOCAL_HANDOFF();
        { const Frame P = launder(F); unsigned char* ws = P.ws; unsigned char* wb = ws + WS_W; bf16* XB = (bf16*)(ws + WS_XB); (void)XB; (void)wb;
          Gemm g{XB, (const bf16*)(wb + W_PG), T_TOK, D, D}; StaticOrder S; S.init(T_TOK, D, F.G, F.bx);
          pg8::EpiRes<1> E{X32, XB, (const bf16*)(ws + F_U)};
#ifndef SK_G6
          pg8::gemm_phase<pg8::EpiRes<1>, StaticOrder>(ring, g, S, E, P.wave);
#endif
        }
        if (!odd) {
            { const Frame P = launder(F); unsigned char* ws = P.ws; unsigned char* wb = ws + WS_W; bf16* XB = (bf16*)(ws + WS_XB); (void)XB; (void)wb;
          Gemm g{XB, (const bf16*)(wb + W_FF), T_TOK, 2 * DFF, D}; StaticOrder S; S.init(T_TOK, 2 * DFF, F.G, F.bx);
              pg8::EpiSwiglu E{(bf16*)(ws + F_H), DFF};
#ifndef SK_G7
              pg8::gemm_phase<pg8::EpiSwiglu, StaticOrder>(ring, g, S, E, P.wave);
#endif
        }
            GRID_BAR();
            { const Frame P = launder(F); unsigned char* ws = P.ws; unsigned char* wb = ws + WS_W; bf16* XB = (bf16*)(ws + WS_XB); (void)XB; (void)wb;
          Gemm g{(const bf16*)(ws + F_H), (const bf16*)(wb + W_FF_DN_DENSE), T_TOK, D, DFF}; StaticOrder S; S.init(T_TOK, D, F.G, F.bx);
              pg8::EpiRes<2> E{X32, nullptr, nullptr};
#ifndef SK_G8
              pg8::gemm_phase<pg8::EpiRes<2>, StaticOrder>(ring, g, S, E, P.wave);
#endif
        }
            GRID_BAR();
#ifndef SK_LN
            ln_phase<true, false>(F, L);
#endif
        } else {
            const int ntiles = (int)F.MISC[24];
            const int nchunks = (ntiles + MOE_CHUNK_TILES - 1) / MOE_CHUNK_TILES;
            for (int c = 0; c < nchunks; ++c) {
                const int tile0 = c * MOE_CHUNK_TILES, ntl = (ntiles - tile0) < MOE_CHUNK_TILES ? (ntiles - tile0) : MOE_CHUNK_TILES;
                const size_t hc_off = (c & 1) ? F_H1 : F_H;
                { const Frame P = launder(F); unsigned char* ws = P.ws; unsigned char* wb = ws + WS_W; bf16* XB = (bf16*)(ws + WS_XB); (void)XB; (void)wb;
          Gemm g{XB, (const bf16*)(wb + W_FF), ntl * 256, 2 * DFFE, D}; MoeGatherOrder S; S.init(ntl * 256, 2 * DFFE, F.G, F.bx);
                  S.tb = F.MISC + 16; S.tile0 = tile0; S.list = (const int*)(ws + WS_LIST); S.bstride = (size_t)2 * DFFE * D * 2;
                  pg8::EpiSwiglu E{(bf16*)(ws + hc_off), DFFE};
#ifndef SK_G9
                  pg8::gemm_phase<pg8::EpiSwiglu, MoeGatherOrder>(ring, g, S, E, P.wave);
#endif
        }
                GRID_BAR();
                { const Frame P = launder(F); unsigned char* ws = P.ws; unsigned char* wb = ws + WS_W; bf16* XB = (bf16*)(ws + WS_XB); (void)XB; (void)wb;
          Gemm g{(const bf16*)(ws + hc_off), (const bf16*)(wb + W_FF_DN_MOE), ntl * 256, D, DFFE}; MoeOrder S; S.init(ntl * 256, D, F.G, F.bx);
                  S.tb = F.MISC + 16; S.tile0 = tile0; S.list = nullptr; S.bstride = (size_t)D * DFFE * 2;
                  pg8::EpiBf16 E{(bf16*)(ws + F_YE), D, tile0 * 256};
#ifndef SK_G10
                  pg8::gemm_phase<pg8::EpiBf16, MoeOrder>(ring, g, S, E, P.wave);
#endif
        }
            }
            GRID_BAR();
#ifndef SK_LN
            ln_phase<true, true>(F, L);
#endif
        }
        GRID_BAR();
    }
    if (__hip_atomic_load(F.ctl + CW_BAR + XB_TMO, RLX_AGENT) != 0u || __hip_atomic_load(F.ctl + CW_CODE, RLX_AGENT) != 0u) {
        const float q = __builtin_nanf("");
        for (size_t i = (size_t)F.bx * 512 + launder(F).tid; i < (size_t)T_TOK * D; i += (size_t)F.G * 512) X32[i] = q;
    }
}

#if defined(SELFCHECK)
constexpr size_t WS_DRY_EXTRA = 4 * MiB;
#elif defined(DUP_LRU) || defined(DUP_LN)
constexpr size_t WS_DRY_EXTRA = 80 * MiB;
#else
constexpr size_t WS_DRY_EXTRA = 0;
#endif
extern "C" void kernel_launch(void* const* d_in, const int* in_sizes, int n_in, void* d_out, int out_size, void* d_ws, size_t ws_size, hipStream_t stream) {
    static int grid = 0;
    if (grid == 0) {
        if (n_in != 28 || out_size != T_TOK * D || ws_size < WS_NEED + WS_DRY_EXTRA) { fprintf(stderr, "kernel_launch: unexpected shapes: n_in %d out %d ws %zu (need %zu)\n", n_in, out_size, ws_size, (size_t)WS_END); grid = -1; return; }
        int dev = 0, cus = 0, per_cu = 0;
        if (hipGetDevice(&dev) != hipSuccess || hipDeviceGetAttribute(&cus, hipDeviceAttributeMultiprocessorCount, dev) != hipSuccess) { grid = -1; return; }
        if (hipFuncSetAttribute((const void*)mk_fwd, hipFuncAttributeMaxDynamicSharedMemorySize, LDS_BYTES) != hipSuccess) { fprintf(stderr, "kernel_launch: hipFuncSetAttribute failed\n"); grid = -1; return; }
        if (hipOccupancyMaxActiveBlocksPerMultiprocessor(&per_cu, (const void*)mk_fwd, NWAVES * 64, LDS_BYTES) != hipSuccess || per_cu < 1) { fprintf(stderr, "kernel_launch: occupancy query says %d blocks per CU\n", per_cu); }
        (void)hipGetLastError();
        grid = cus;
        if (grid != 256) { fprintf(stderr, "kernel_launch: this kernel needs a 256-CU device (got %d)\n", cus); grid = -1; return; }
    }
    if (grid < 0) return;
    if (hipMemsetAsync((char*)d_ws + WS_CTL, 0, CTL_ZERO_BYTES, stream) != hipSuccess) return;
    Args a{};
    for (int i = 0; i < 28; ++i) a.in[i] = (const float*)d_in[i];
    a.out = (float*)d_out; a.ws = (unsigned char*)d_ws;
    hipLaunchKernelGGL(mk_fwd, dim3(grid), dim3(NWAVES * 64), LDS_BYTES, stream, a);
}
```

```cpp
#include <hip/hip_runtime.h>
#include <cstdio>
#include <cstdint>

constexpr int T_TOK = 65536, D = 1024, SEQ = 2048, NBATCH = 32, DEPTH = 4;
constexpr int D_IN = 5832, NIN = 5888;
constexpr int DFF = 2816, DFFE = 3584, NEXP = 8, PLE = 256;
constexpr float LN_EPS = 1e-5f;
constexpr float DN_ALPHA = 1.681792830507429f;

namespace pg8 {
#define PG8_LAS __attribute__((address_space(3)))
typedef unsigned short bf16_t;
typedef short bf16x8 __attribute__((ext_vector_type(8)));
typedef float f32x4 __attribute__((ext_vector_type(4)));
typedef unsigned u32x4 __attribute__((ext_vector_type(4)));
typedef unsigned u32x2 __attribute__((ext_vector_type(2)));
constexpr int BM = 256, BK = 64, HALF = 128, HTB = HALF * BK * 2  , STAGE_BYTES = 8 * HTB, NXCD = 8, WGM = 8;

__host__ __device__ __forceinline__ int lds_byte(int r, int c) { const int st = (r >> 4) * 2 + (c >> 5), rr = r & 15, cc = c & 31, ob = rr * 64 + cc * 2; return st * 1024 + (ob ^ (((ob >> 9) & 1) << 5)); }
__host__ __device__ __forceinline__ void stage_rc(int b, int& R, int& C) { const int st = b / 1024, sb = b % 1024, swz = sb ^ (((sb >> 9) & 1) << 5); R = (st >> 1) * 16 + swz / 64; C = (st & 1) * 32 + (swz % 64) / 2; }
__host__ __device__ __forceinline__ int perm32(int rho) { const int n = rho >> 4, i = rho & 15; return 8 * (i >> 2) + 4 * n + (i & 3); }

struct Unit { int pm, pn; };
struct Gemm { const bf16_t* A; const bf16_t* Bt; int M, N, K; };

struct StaticOrder {
    static constexpr bool GATHER = false;
    int nM, nN, nwg, G, c;
    __host__ __device__ void init(int M, int N, int G_, int c_) { nM = M / BM; nN = N / BM; nwg = nM * nN; G = G_; c = c_; }
    __host__ __device__ bool next(int i, Unit& u) const {
        const long L = (long)i * G + c; if (L >= nwg) return false;
        int wgid = (int)L; { const int q = nwg / NXCD, r = nwg % NXCD, xcd = wgid % NXCD, off = wgid / NXCD; wgid = (xcd < r ? xcd * (q + 1) : r * (q + 1) + (xcd - r) * q) + off; }
        const int nig = WGM * nN, gid = wgid / nig, fm = gid * WGM, gsz = (nM - fm) < WGM ? (nM - fm) : WGM;
        u.pm = fm + ((wgid % nig) % gsz); u.pn = (wgid % nig) / gsz; return true;
    }
    __device__ __forceinline__ const char* a_base(const Gemm& g, const Unit& u, size_t tstep) const { return (const char*)g.A + (size_t)u.pm * tstep; }
    __device__ __forceinline__ const char* b_base(const Gemm& g, const Unit& u, size_t tstep) const { return (const char*)g.Bt + (size_t)u.pn * tstep; }
    __device__ __forceinline__ void a_rows(const Unit&, int, int, int, int, int, unsigned (&)[2][2]) const {}
    __device__ __forceinline__ void a_ready(const Unit&) const {}
    __device__ __forceinline__ void done(const Unit&) const {}
};

__device__ __forceinline__ unsigned cvt_pk_bf16(float lo, float hi) { unsigned r; asm volatile("v_cvt_pk_bf16_f32 %0, %1, %2" : "=v"(r) : "v"(lo), "v"(hi)); return r; }
__device__ __forceinline__ float bf_lo(unsigned w) { return __builtin_bit_cast(float, w << 16); }
__device__ __forceinline__ float bf_hi(unsigned w) { return __builtin_bit_cast(float, w & 0xffff0000u); }
__device__ __forceinline__ float sigmoidf_fast(float x) { return __builtin_amdgcn_rcpf(1.0f + __builtin_amdgcn_exp2f(-1.4426950408889634f * x)); }
#define EPI_FENCE() asm volatile("" ::: "memory")
#define EGAS __attribute__((address_space(1)))
__device__ __forceinline__ u32x4 pack8(const f32x4 v0, const f32x4 v1) { u32x4 w; w.x = cvt_pk_bf16(v0[0], v0[1]); w.y = cvt_pk_bf16(v0[2], v0[3]); w.z = cvt_pk_bf16(v1[0], v1[1]); w.w = cvt_pk_bf16(v1[2], v1[3]); return w; }

struct EpiBf16 {
    static constexpr bool PERM = true, AFTER_DRAIN = false;
    bf16_t* O; int ldc; int row_off;
    __device__ __forceinline__ void operator()(const f32x4 (&acc)[2][2][4][2], const Unit& u, int wr, int wc, int fr, int fq) const {
        { int l_ = (int)__builtin_amdgcn_mbcnt_hi(~0u, __builtin_amdgcn_mbcnt_lo(~0u, 0u)); asm volatile("" : "+v"(l_)); fr = l_ & 15; fq = l_ >> 4; }
        const int row0 = row_off + u.pm * BM + wr * 64 + fr, col0 = u.pn * BM + wc * 32 + 8 * fq;
#pragma unroll
        for (int ai = 0; ai < 2; ++ai)
#pragma unroll
            for (int m = 0; m < 4; ++m) { bf16_t* rowp = O + (size_t)(row0 + ai * HALF + m * 16) * ldc + col0;
#pragma unroll
                for (int bj = 0; bj < 2; ++bj) *(EGAS u32x4*)(rowp + bj * HALF) = pack8(acc[ai][bj][m][0], acc[ai][bj][m][1]); }
    }
};
__device__ __forceinline__ u32x2 pack8_fp8(const f32x4 v0, const f32x4 v1) { int a = __builtin_amdgcn_cvt_pk_fp8_f32(v0[0], v0[1], 0, false); a = __builtin_amdgcn_cvt_pk_fp8_f32(v0[2], v0[3], a, true);
    int b = __builtin_amdgcn_cvt_pk_fp8_f32(v1[0], v1[1], 0, false); b = __builtin_amdgcn_cvt_pk_fp8_f32(v1[2], v1[3], b, true); u32x2 r; r.x = (unsigned)a; r.y = (unsigned)b; return r; }
struct EpiZ {
    static constexpr bool PERM = true, AFTER_DRAIN = false;
    bf16_t* zbig; bf16_t* zqi; bf16_t* zsm; unsigned char* q8; unsigned char* kv8;
    __device__ __forceinline__ void operator()(const f32x4 (&acc)[2][2][4][2], const Unit& u, int wr, int wc, int fr, int fq) const {
        { int l_ = (int)__builtin_amdgcn_mbcnt_hi(~0u, __builtin_amdgcn_mbcnt_lo(~0u, 0u)); asm volatile("" : "+v"(l_)); fr = l_ & 15; fq = l_ >> 4; }
        const int row0 = u.pm * BM + wr * 64 + fr;
        if (u.pn < 4) {
            const int col0 = u.pn * BM + wc * 32 + 8 * fq;
#pragma unroll
            for (int ai = 0; ai < 2; ++ai)
#pragma unroll
                for (int m = 0; m < 4; ++m) { unsigned char* rowp = q8 + (size_t)(row0 + ai * HALF + m * 16) * D + col0;
#pragma unroll
                    for (int bj = 0; bj < 2; ++bj) *(EGAS u32x2*)(rowp + bj * HALF) = pack8_fp8(acc[ai][bj][m][0], acc[ai][bj][m][1]); }
            return;
        }
        bf16_t* base; int ld, colt;
        if (u.pn < 20) { base = zbig + (size_t)(u.pn >> 2) * ((size_t)T_TOK * D); ld = D; colt = (u.pn & 3) * BM; }
        else if (u.pn < 22) { base = zqi; ld = 512; colt = (u.pn - 20) * BM; }
        else { base = zsm; ld = 256; colt = 0; }
        const int col0 = colt + wc * 32 + 8 * fq;
#pragma unroll
        for (int ai = 0; ai < 2; ++ai)
#pragma unroll
            for (int m = 0; m < 4; ++m) { bf16_t* rowp = base + (size_t)(row0 + ai * HALF + m * 16) * ld + col0;
#pragma unroll
                for (int bj = 0; bj < 2; ++bj) *(EGAS u32x4*)(rowp + bj * HALF) = pack8(acc[ai][bj][m][0], acc[ai][bj][m][1]); }
        if (u.pn == 22) {
#pragma unroll
            for (int ai = 0; ai < 2; ++ai)
#pragma unroll
                for (int m = 0; m < 4; ++m) *(EGAS u32x2*)(kv8 + (size_t)(row0 + ai * HALF + m * 16) * 128 + wc * 32 + 8 * fq) = pack8_fp8(acc[ai][0][m][0], acc[ai][0][m][1]);
        }
    }
};
template <int MODE> struct EpiGate {
    static constexpr bool PERM = true, AFTER_DRAIN = false;
    bf16_t* G; const bf16_t* G2;
    __device__ __forceinline__ void operator()(const f32x4 (&acc)[2][2][4][2], const Unit& u, int wr, int wc, int fr, int fq) const {
        { int l_ = (int)__builtin_amdgcn_mbcnt_hi(~0u, __builtin_amdgcn_mbcnt_lo(~0u, 0u)); asm volatile("" : "+v"(l_)); fr = l_ & 15; fq = l_ >> 4; }
        const int row0 = u.pm * BM + wr * 64 + fr, col0 = u.pn * BM + wc * 32 + 8 * fq;
#pragma unroll
        for (int ai = 0; ai < 2; ++ai) {
            u32x4 gw[4][2], g2[4][2];
#pragma unroll
            for (int m = 0; m < 4; ++m)
#pragma unroll
                for (int bj = 0; bj < 2; ++bj) { const size_t o = (size_t)(row0 + ai * HALF + m * 16) * D + col0 + bj * HALF;
                    gw[m][bj] = *(const EGAS u32x4*)(G + o); if (MODE == 1) g2[m][bj] = *(const EGAS u32x4*)(G2 + o); }
#pragma unroll
            for (int m = 0; m < 4; ++m)
#pragma unroll
                for (int bj = 0; bj < 2; ++bj) { const size_t o = (size_t)(row0 + ai * HALF + m * 16) * D + col0 + bj * HALF;
                    f32x4 v0 = acc[ai][bj][m][0], v1 = acc[ai][bj][m][1];
#pragma unroll
                    for (int j = 0; j < 4; ++j) { const unsigned wa = gw[m][bj][j >> 1], wb = gw[m][bj][2 + (j >> 1)];
                        const float ga = (j & 1) ? bf_hi(wa) : bf_lo(wa), gb = (j & 1) ? bf_hi(wb) : bf_lo(wb);
                        if (MODE == 0) { v0[j] *= sigmoidf_fast(ga); v1[j] *= sigmoidf_fast(gb); }
                        else { const unsigned xa = g2[m][bj][j >> 1], xb = g2[m][bj][2 + (j >> 1)];
                            v0[j] = ga + v0[j] * sigmoidf_fast((j & 1) ? bf_hi(xa) : bf_lo(xa)); v1[j] = gb + v1[j] * sigmoidf_fast((j & 1) ? bf_hi(xb) : bf_lo(xb)); } }
                    *(EGAS u32x4*)(G + o) = pack8(v0, v1); }
            EPI_FENCE(); }
    }
};
template <int MODE> struct EpiRes {
    static constexpr bool PERM = false, AFTER_DRAIN = false;
    float* Y; const bf16_t* XB; const bf16_t* U;
    __device__ __forceinline__ void operator()(const f32x4 (&acc)[2][2][4][2], const Unit& u, int wr, int wc, int fr, int fq) const {
        { int l_ = (int)__builtin_amdgcn_mbcnt_hi(~0u, __builtin_amdgcn_mbcnt_lo(~0u, 0u)); asm volatile("" : "+v"(l_)); fr = l_ & 15; fq = l_ >> 4; }
        const int row0 = u.pm * BM + wr * 64 + fr, col0 = u.pn * BM + wc * 32 + 4 * fq;
#pragma unroll
        for (int ai = 0; ai < 2; ++ai) {
            u32x2 xw[4][2][2], uw[4][2][2]; f32x4 yv[4][2][2];
#pragma unroll
            for (int m = 0; m < 4; ++m)
#pragma unroll
                for (int bj = 0; bj < 2; ++bj)
#pragma unroll
                    for (int n = 0; n < 2; ++n) { const size_t o = (size_t)(row0 + ai * HALF + m * 16) * D + col0 + bj * HALF + n * 16;
                        if (MODE == 0 || MODE == 1) xw[m][bj][n] = *(const EGAS u32x2*)(XB + o);
                        if (MODE == 1) uw[m][bj][n] = *(const EGAS u32x2*)(U + o);
                        if (MODE == 2) yv[m][bj][n] = *(const EGAS f32x4*)(Y + o); }
#pragma unroll
            for (int m = 0; m < 4; ++m)
#pragma unroll
                for (int bj = 0; bj < 2; ++bj)
#pragma unroll
                    for (int n = 0; n < 2; ++n) { const size_t o = (size_t)(row0 + ai * HALF + m * 16) * D + col0 + bj * HALF + n * 16; const f32x4 a = acc[ai][bj][m][n]; f32x4 r;
                        if (MODE == 0) { const u32x2 x = xw[m][bj][n];
                            r[0] = bf_lo(x.x) * DN_ALPHA + a[0]; r[1] = bf_hi(x.x) * DN_ALPHA + a[1]; r[2] = bf_lo(x.y) * DN_ALPHA + a[2]; r[3] = bf_hi(x.y) * DN_ALPHA + a[3]; }
                        else if (MODE == 1) { const u32x2 x = xw[m][bj][n], w = uw[m][bj][n];
                            r[0] = bf_lo(x.x) * DN_ALPHA + sigmoidf_fast(a[0]) * bf_lo(w.x); r[1] = bf_hi(x.x) * DN_ALPHA + sigmoidf_fast(a[1]) * bf_hi(w.x);
                            r[2] = bf_lo(x.y) * DN_ALPHA + sigmoidf_fast(a[2]) * bf_lo(w.y); r[3] = bf_hi(x.y) * DN_ALPHA + sigmoidf_fast(a[3]) * bf_hi(w.y); }
                        else r = yv[m][bj][n] + a;
                        *(EGAS f32x4*)(Y + o) = r; }
            EPI_FENCE(); }
    }
};
struct EpiSwiglu {
    static constexpr bool PERM = true, AFTER_DRAIN = false;
    bf16_t* H; int ldh;
    __device__ __forceinline__ void operator()(const f32x4 (&acc)[2][2][4][2], const Unit& u, int wr, int wc, int fr, int fq) const {
        { int l_ = (int)__builtin_amdgcn_mbcnt_hi(~0u, __builtin_amdgcn_mbcnt_lo(~0u, 0u)); asm volatile("" : "+v"(l_)); fr = l_ & 15; fq = l_ >> 4; }
        const int row0 = u.pm * BM + wr * 64 + fr, col0 = u.pn * HALF + wc * 32 + 8 * fq;
#pragma unroll
        for (int ai = 0; ai < 2; ++ai)
#pragma unroll
            for (int m = 0; m < 4; ++m) { bf16_t* rowp = H + (size_t)(row0 + ai * HALF + m * 16) * ldh + col0;
                f32x4 v0, v1;
#pragma unroll
                for (int j = 0; j < 4; ++j) { const float g0 = acc[ai][0][m][0][j], g1 = acc[ai][0][m][1][j];
                    v0[j] = g0 * sigmoidf_fast(g0) * acc[ai][1][m][0][j]; v1[j] = g1 * sigmoidf_fast(g1) * acc[ai][1][m][1][j]; }
                *(EGAS u32x4*)rowp = pack8(v0, v1); }
    }
};
template <class Epi, class Sched, bool ALIGN_EPI = true>
__device__ __forceinline__ void gemm_phase(PG8_LAS unsigned char* lds, const Gemm g, const Sched& S, const Epi& E, const int wave_id) {
    int lane_ = (int)__builtin_amdgcn_mbcnt_hi(~0u, __builtin_amdgcn_mbcnt_lo(~0u, 0u)); asm volatile("" : "+v"(lane_));
    const int wid = wave_id, lane = lane_, tid = wid * 64 + lane, wr = wid >> 2, wc = wid & 3, fr = lane & 15, fq = lane >> 4;
    const int K = g.K, nt = K / BK;
    unsigned voffA[2], voffB[2]; int RA[2], CA[2];
#pragma unroll
    for (int i = 0; i < 2; ++i) { int R, C; stage_rc(tid * 16 + i * 8192, R, C); const int Rb = Epi::PERM ? ((R & ~31) + perm32(R & 31)) : R; RA[i] = R; CA[i] = C;
        voffA[i] = (unsigned)(R * K + C) * 2u; voffB[i] = (unsigned)(Rb * K + C) * 2u; }
    const size_t kstep = (size_t)(BK * 2);
    const size_t hstep = (size_t)HALF * K * 2;
    const size_t tstep = 2 * hstep;
    const unsigned ldsw = (unsigned)wid * 1024u;
    const int aoff = lds_byte(wr * 64 + fr, fq * 8), boff = lds_byte(wc * 32 + fr, fq * 8);
    unsigned offC[2][2] = {{0u, 0u}, {0u, 0u}}, offN[2][2] = {{0u, 0u}, {0u, 0u}};
#define PG8_SA(b, h) (((b) * 2 + (h)) * HTB)
#define PG8_SB(b, h) ((4 + (b) * 2 + (h)) * HTB)
#define PG8_STAGE(bufoff, gbase, voff) do { _Pragma("unroll") for (int _i = 0; _i < 2; ++_i) \
        __builtin_amdgcn_global_load_lds((const unsigned*)((const char*)(gbase) + (voff)[_i]), (PG8_LAS unsigned*)(lds + (bufoff) + ldsw + _i * 8192), 16, 0, 0); } while (0)
#define PG8_STA(bufoff, ptr, h, NX) do { if constexpr (Sched::GATHER) { _Pragma("unroll") for (int _i = 0; _i < 2; ++_i) { const unsigned _o = (NX) ? offN[h][_i] : offC[h][_i]; \
        __builtin_amdgcn_global_load_lds((const unsigned*)((const char*)(ptr) + _o), (PG8_LAS unsigned*)(lds + (bufoff) + ldsw + _i * 8192), 16, 0, 0); } } \
        else { PG8_STAGE(bufoff, (ptr) + (h) * hstep, voffA); } } while (0)
#define PG8_LDA(dst, b, h) do { _Pragma("unroll") for (int m = 0; m < 4; ++m) _Pragma("unroll") for (int k = 0; k < 2; ++k) dst[m][k] = *(const PG8_LAS bf16x8*)(lds + PG8_SA(b, h) + aoff + m * 2048 + k * 1024); } while (0)
#define PG8_LDB(dst, b, h) do { _Pragma("unroll") for (int n = 0; n < 2; ++n) _Pragma("unroll") for (int k = 0; k < 2; ++k) dst[n][k] = *(const PG8_LAS bf16x8*)(lds + PG8_SB(b, h) + boff + n * 2048 + k * 1024); } while (0)
#define PG8_MMA(ai, bj, At, Bt) do { __builtin_amdgcn_s_setprio(1); _Pragma("unroll") for (int m = 0; m < 4; ++m) _Pragma("unroll") for (int n = 0; n < 2; ++n) _Pragma("unroll") for (int k = 0; k < 2; ++k) \
        acc[ai][bj][m][n] = __builtin_amdgcn_mfma_f32_16x16x32_bf16(Bt[n][k], At[m][k], acc[ai][bj][m][n], 0, 0, 0); __builtin_amdgcn_s_setprio(0); } while (0)
#define PG8_WAIT_V(n) asm volatile("s_waitcnt vmcnt(" #n ")" ::: "memory")
#define PG8_WAIT_L(n) asm volatile("s_waitcnt lgkmcnt(" #n ")" ::: "memory")
#define PG8_BAR __builtin_amdgcn_s_barrier()
#define PG8_SCHED __builtin_amdgcn_sched_barrier(0)
    Unit cur, nxt; int ui = 0;
    if (!S.next(0, cur)) return;
    f32x4 acc[2][2][4][2];
#pragma unroll
    for (int a = 0; a < 2; ++a)
#pragma unroll
        for (int b = 0; b < 2; ++b)
#pragma unroll
            for (int m = 0; m < 4; ++m)
#pragma unroll
                for (int n = 0; n < 2; ++n) acc[a][b][m][n] = (f32x4){0.f, 0.f, 0.f, 0.f};
    bf16x8 At[4][2], B0[2][2], B1[2][2];
    const char* cA = S.a_base(g, cur, tstep); const char* cB = S.b_base(g, cur, tstep);
    if constexpr (Sched::GATHER) S.a_rows(cur, RA[0], RA[1], CA[0], CA[1], K, offC);
    S.a_ready(cur);
    PG8_STAGE(PG8_SB(0, 0), cB, voffB); PG8_STAGE(PG8_SB(0, 1), cB + hstep, voffB); PG8_STA(PG8_SA(0, 0), cA, 0, false); PG8_STA(PG8_SA(0, 1), cA, 1, false);
    if (wr == 1) PG8_BAR;
    PG8_WAIT_V(2); PG8_BAR;
    PG8_STAGE(PG8_SB(1, 0), cB + kstep, voffB); PG8_STA(PG8_SA(1, 0), cA + kstep, 0, false); PG8_STAGE(PG8_SB(1, 1), cB + hstep + kstep, voffB);
    PG8_WAIT_V(6); PG8_BAR;
    for (;;) {
        const bool has_next = S.next(ui + 1, nxt);
        const char* nA = has_next ? S.a_base(g, nxt, tstep) : cA; const char* nB = has_next ? S.b_base(g, nxt, tstep) : cB;
        if constexpr (Sched::GATHER) { if (has_next) S.a_rows(nxt, RA[0], RA[1], CA[0], CA[1], K, offN); else {
#pragma unroll
            for (int h = 0; h < 2; ++h)
#pragma unroll
                for (int i = 0; i < 2; ++i) offN[h][i] = offC[h][i]; } }
        for (int t = 0; t < nt; t += 2) {
            const bool last = (t == nt - 2);
            const char* a1 = cA + (size_t)(t + 1) * kstep;
            const char* a2 = last ? nA : cA + (size_t)(t + 2) * kstep; const char* b2 = last ? nB : cB + (size_t)(t + 2) * kstep;
            const char* a3 = a2 + kstep; const char* b3 = b2 + kstep;
            if (last && has_next) S.a_ready(nxt);
            PG8_LDB(B0, 0, 0); PG8_LDB(B1, 0, 1); PG8_SCHED; PG8_LDA(At, 0, 0); PG8_STA(PG8_SA(1, 1), a1, 1, false);
            PG8_WAIT_V(8); PG8_WAIT_L(0); PG8_BAR; PG8_MMA(0, 0, At, B0); PG8_MMA(0, 1, At, B1); PG8_BAR; PG8_SCHED;
            PG8_LDA(At, 0, 1); PG8_STAGE(PG8_SB(0, 0), b2, voffB); PG8_STAGE(PG8_SB(0, 1), b2 + hstep, voffB); PG8_STA(PG8_SA(0, 0), a2, 0, last);
            PG8_WAIT_V(8); PG8_WAIT_L(0); PG8_BAR; PG8_MMA(1, 0, At, B0); PG8_MMA(1, 1, At, B1); PG8_BAR; PG8_SCHED;
            PG8_LDB(B0, 1, 0); PG8_LDB(B1, 1, 1); PG8_SCHED; PG8_LDA(At, 1, 0); PG8_STA(PG8_SA(0, 1), a2, 1, last);
            PG8_WAIT_V(8); PG8_WAIT_L(0); PG8_BAR; PG8_MMA(0, 0, At, B0); PG8_MMA(0, 1, At, B1); PG8_BAR; PG8_SCHED;
            PG8_LDA(At, 1, 1); PG8_STAGE(PG8_SB(1, 0), b3, voffB); PG8_STAGE(PG8_SB(1, 1), b3 + hstep, voffB); PG8_STA(PG8_SA(1, 0), a3, 0, last);
            PG8_WAIT_V(8); PG8_WAIT_L(0); PG8_BAR; PG8_MMA(1, 0, At, B0); PG8_MMA(1, 1, At, B1); PG8_BAR; PG8_SCHED;
        }
        if constexpr (ALIGN_EPI) { if (wr == 0) PG8_BAR; }
        E(acc, cur, wr, wc, fr, fq); S.done(cur);
        if (!has_next) break;
#pragma unroll
        for (int a = 0; a < 2; ++a)
#pragma unroll
            for (int b = 0; b < 2; ++b)
#pragma unroll
                for (int m = 0; m < 4; ++m)
#pragma unroll
                    for (int n = 0; n < 2; ++n) acc[a][b][m][n] = (f32x4){0.f, 0.f, 0.f, 0.f};
        cur = nxt; cA = nA; cB = nB; ++ui;
        if constexpr (Sched::GATHER) {
#pragma unroll
            for (int h = 0; h < 2; ++h)
#pragma unroll
                for (int i = 0; i < 2; ++i) offC[h][i] = offN[h][i]; }
        if constexpr (ALIGN_EPI) { if (wr == 1) PG8_BAR; }
    }
    PG8_WAIT_V(0);
    if constexpr (!ALIGN_EPI) { if (wr == 0) PG8_BAR; }
    PG8_BAR;
#undef PG8_SA
#undef PG8_SB
#undef PG8_STAGE
#undef PG8_STA
#undef PG8_LDA
#undef PG8_LDB
#undef PG8_MMA
#undef PG8_WAIT_V
#undef PG8_WAIT_L
#undef PG8_BAR
#undef PG8_SCHED
}
}
constexpr int NWAVES = 8;
constexpr size_t MiB = 1u << 20;
constexpr size_t WS_CTL = 0, CTL_ZERO_BYTES = 1 * MiB;
constexpr size_t WS_ROUTE = 1 * MiB;
constexpr size_t WS_LIST = 3 * MiB;
constexpr size_t WS_W = 8 * MiB;
constexpr size_t W_IN = 0, W_BRA = 12 * MiB, W_BRR = 14 * MiB, W_O = 16 * MiB, W_PG = 18 * MiB, W_PP = 20 * MiB, W_LRU = 21 * MiB, W_FF = 22 * MiB;
constexpr size_t W_FF_DN_DENSE = W_FF + 11 * MiB, W_FF_DN_MOE = W_FF + 112 * MiB;
constexpr size_t WS_XB = 208 * MiB;
constexpr size_t WS_IDX = 336 * MiB;
constexpr size_t WS_Z = 368 * MiB;
constexpr size_t Z_Q = WS_Z, Z_XR = WS_Z + 128 * MiB, Z_YR = WS_Z + 256 * MiB, Z_GA = WS_Z + 384 * MiB, Z_GR = WS_Z + 512 * MiB, Z_QI = WS_Z + 640 * MiB, Z_SM = WS_Z + 704 * MiB;
constexpr size_t Z_Q8 = Z_Q, Z_KV8 = Z_Q + 64 * MiB;
constexpr size_t WS_END = WS_Z + 736 * MiB;
constexpr size_t F_U = Z_Q;
constexpr size_t F_PB = Z_SM;
constexpr size_t F_H = Z_XR;
constexpr size_t F_H1 = WS_END;
constexpr size_t F_YE = Z_GA;
constexpr int MOE_CHUNK_TILES = 128;
constexpr size_t F_H_CHUNK_BYTES = (size_t)MOE_CHUNK_TILES * 256 * DFFE * 2;
constexpr size_t WS_NEED = F_H1 + F_H_CHUNK_BYTES;
static_assert(F_H + F_H_CHUNK_BYTES <= F_YE && F_YE + (size_t)520 * 256 * D * 2 <= Z_SM && F_H + (size_t)T_TOK * DFF * 2 <= Z_GR, "overlay map");
constexpr int CW_TMO = 0, CW_CODE = 1, CW_BAR = 4096, CW_CNT = 16384;
constexpr int RING_OFF = 0, RING_BYTES = 131072;
constexpr int LDSCTL_OFF = RING_BYTES, MISC_OFF = LDSCTL_OFF + 320;
constexpr int LDS_BYTES = 147456;

#define GAS __attribute__((address_space(1)))
#define LAS __attribute__((address_space(3)))
typedef unsigned short bf16;
typedef unsigned v4u __attribute__((ext_vector_type(4)));
typedef unsigned v2u __attribute__((ext_vector_type(2)));
typedef float f32x4 __attribute__((ext_vector_type(4)));
typedef float f32x16 __attribute__((ext_vector_type(16)));
typedef short bf16x8 __attribute__((ext_vector_type(8)));
typedef GAS unsigned gu32;
#define RLX_AGENT __ATOMIC_RELAXED, __HIP_MEMORY_SCOPE_AGENT
#define LDS_WAIT() asm volatile("s_waitcnt lgkmcnt(0)" ::: "memory")
#define VM_WAIT() asm volatile("s_waitcnt vmcnt(0)" ::: "memory")
using pg8::cvt_pk_bf16; using pg8::bf_lo; using pg8::bf_hi; using pg8::sigmoidf_fast;
#define XB_TMO      128
#define XB_XCNT(j)  (256  + 64 * (j))
#define XB_XSUB(j)  (1280 + 64 * (j))
#define XB_XGEN(j)  (2304 + 64 * (j))
#define XB_TOP      3328
#define XB_TOPGEN   3392
#define XCD_BAR_WORDS 3456
#define XB_SPIN_CAP (1u << 21)

__device__ __forceinline__ unsigned xb_ld(unsigned* p)              { return __hip_atomic_load(p, __ATOMIC_RELAXED, __HIP_MEMORY_SCOPE_AGENT); }
__device__ __forceinline__ unsigned xb_add(unsigned* p, unsigned v) { return __hip_atomic_fetch_add(p, v, __ATOMIC_RELAXED, __HIP_MEMORY_SCOPE_AGENT); }
__device__ __forceinline__ unsigned xb_xcc_id() { return (unsigned)__builtin_amdgcn_s_getreg((3 << 11) | 20) & 0xFu; }
#define XB_SPIN(cond, bar) do { unsigned _sp = 0; while (cond) { __builtin_amdgcn_s_sleep(1); \
    if ((++_sp & 255u) == 0u) { if (xb_ld(&(bar)[XB_TMO])) break; if (_sp > XB_SPIN_CAP) { atomicAdd(&(bar)[XB_TMO], 1u); break; } } } } while (0)

struct XcdBarrier {
    unsigned* bar; unsigned x;
    volatile LAS unsigned* st;
};

__device__ __forceinline__ XcdBarrier xcd_barrier_post(unsigned* bar, volatile LAS unsigned* st) {
    XcdBarrier b; b.bar = bar; b.x = xb_xcc_id(); b.st = st;
    if (threadIdx.x == 0) (void)xb_add(&bar[XB_XCNT(b.x)], 1u);
    return b;
}
__device__ __forceinline__ void xcd_barrier_complete(unsigned* bar, unsigned x, unsigned& nloc, unsigned& nx) {
    const unsigned G = gridDim.x * gridDim.y * gridDim.z;
    unsigned sum, cnt, mine, sp = 0u;
    for (;;) {
        sum = 0u; cnt = 0u; mine = 0u;
#pragma unroll
        for (unsigned j = 0; j < 16; ++j) { const unsigned c = xb_ld(&bar[XB_XCNT(j)]); sum += c; cnt += (c > 0u) ? 1u : 0u; mine = (j == x) ? c : mine; }
        if (sum == G) break;
        __builtin_amdgcn_s_sleep(1);
        if ((++sp & 255u) == 0u) { if (xb_ld(&bar[XB_TMO])) break; if (sp > XB_SPIN_CAP) { atomicAdd(&bar[XB_TMO], 1u); break; } }
    }
    nloc = mine > 0u ? mine : 1u; nx = cnt > 0u ? cnt : 1u;
}

__device__ __forceinline__ void xcd_barrier(const XcdBarrier& b) {
    asm volatile("s_waitcnt vmcnt(0)" ::: "memory");
    __syncthreads();
    if (threadIdx.x == 0) {
        unsigned* bar = b.bar;
        __builtin_amdgcn_s_waitcnt(0);
        unsigned nloc = b.st[0], nx = b.st[1];
        if (nloc == 0u) { xcd_barrier_complete(bar, b.x, nloc, nx); b.st[0] = nloc; b.st[1] = nx; }
        const unsigned old = xb_add(&bar[XB_XSUB(b.x)], 1u);
        const unsigned gen = old / nloc;
        if (old + 1u == (gen + 1u) * nloc) {
            __builtin_amdgcn_fence(__ATOMIC_RELEASE, "agent");
            asm volatile("s_waitcnt vmcnt(0)" ::: "memory");
            const unsigned og = xb_add(&bar[XB_TOP], 1u);
            const unsigned tg = og / nx;
            if (og + 1u == (tg + 1u) * nx) xb_add(&bar[XB_TOPGEN], 1u);
            else XB_SPIN(xb_ld(&bar[XB_TOPGEN]) == tg, bar);
            __builtin_amdgcn_fence(__ATOMIC_ACQUIRE, "agent");
            xb_add(&bar[XB_XGEN(b.x)], 1u);
            asm volatile("s_waitcnt vmcnt(0)" ::: "memory");
        } else {
            XB_SPIN(xb_ld(&bar[XB_XGEN(b.x)]) == gen, bar);
            __builtin_amdgcn_fence(__ATOMIC_ACQUIRE, "agent");
            asm volatile("s_waitcnt vmcnt(0)" ::: "memory");
        }
    }
    __syncthreads();
}
struct Frame {
    LAS unsigned char* lds;
    volatile LAS unsigned* MISC;
    gu32* ctl;
    int tid, lane, wave, G, bx;
    unsigned char* ws;
    float* out;
};
struct Args { const float* in[28]; float* out; unsigned char* ws; };
typedef const __attribute__((address_space(4))) Args* KArgs;
__device__ __forceinline__ KArgs kargs() { KArgs k = (KArgs)__builtin_amdgcn_kernarg_segment_ptr(); asm volatile("" : "+s"(k)); return k; }
enum { I_X = 0, I_P, I_WIN, I_CONVW, I_CONVB, I_LRUWA, I_LRUBA, I_LRUWX, I_LRUBX, I_LAM, I_WBRA, I_WBRR, I_WO, I_RELB, I_LN1G, I_LN1B, I_FFG, I_FFU, I_FFD, I_ROUTER, I_ROUTERB, I_MOEG, I_MOEU, I_MOED, I_PLEG, I_PLEP, I_LN2G, I_LN2B };

__device__ __forceinline__ Frame launder(const Frame& F0) { Frame F = F0; unsigned char* w = F0.ws; int l = (int)__builtin_amdgcn_mbcnt_hi(~0u, __builtin_amdgcn_mbcnt_lo(~0u, 0u)); asm volatile("" : "+s"(w)); asm volatile("" : "+v"(l));
    F.ws = w; F.lane = l; F.tid = F0.wave * 64 + l; F.ctl = (gu32*)(w + WS_CTL); return F; }
__device__ __forceinline__ float lane_get(float v, int src_lane) { return __builtin_bit_cast(float, __builtin_amdgcn_ds_bpermute(src_lane << 2, __builtin_bit_cast(int, v))); }
__device__ __forceinline__ float lane_xor(float v, int mask, int lane) { return lane_get(v, lane ^ mask); }
__device__ __forceinline__ float lane_up(float v, int d, int lane) { return lane_get(v, lane >= d ? lane - d : lane); }
__device__ __forceinline__ float wave_sum(float v, int lane) {
#pragma unroll
    for (int o = 1; o < 64; o <<= 1) v += lane_xor(v, o, lane);
    return v;
}
__device__ __forceinline__ unsigned pk2(float lo, float hi) { return cvt_pk_bf16(lo, hi); }

__device__ __forceinline__ void cvt_item(const float* W, int ldw, int K, bf16* WT, int d0, int sc0, int nvalid, float scale, int k0, LAS float* scr, int lane) {
    const int n4 = (lane & 7) * 4;
    f32x4 v[8];
#pragma unroll
    for (int i = 0; i < 8; ++i) { const int kk = 8 * i + (lane >> 3); v[i] = (f32x4){0.f, 0.f, 0.f, 0.f}; if (n4 < nvalid) v[i] = *(const GAS f32x4*)(W + (size_t)(k0 + kk) * ldw + sc0 + n4); }
#pragma unroll
    for (int i = 0; i < 8; ++i) { const int kk = 8 * i + (lane >> 3); LAS float* d = scr + kk * 33 + n4; d[0] = v[i][0] * scale; d[1] = v[i][1] * scale; d[2] = v[i][2] * scale; d[3] = v[i][3] * scale; }
    LDS_WAIT(); asm volatile("" ::: "memory");
    const int c = lane & 7;
#pragma unroll
    for (int j = 0; j < 4; ++j) { const int nn = (lane >> 3) + 8 * j; const LAS float* s = scr + (8 * c) * 33 + nn;
        v4u o; o.x = pk2(s[0 * 33], s[1 * 33]); o.y = pk2(s[2 * 33], s[3 * 33]); o.z = pk2(s[4 * 33], s[5 * 33]); o.w = pk2(s[6 * 33], s[7 * 33]);
        *(GAS v4u*)(WT + (size_t)(d0 + nn) * K + k0 + 8 * c) = o; }
    LDS_WAIT(); asm volatile("" ::: "memory");
}
__device__ __forceinline__ void cvt_plain(const float* W, int K, int N, bf16* WT, int item, LAS float* scr, int lane) {
    const int nblk = N / 32, kb = item / nblk, nb = item % nblk;
    cvt_item(W, N, K, WT, 32 * nb, 32 * nb, 32, 1.0f, 64 * kb, scr, lane);
}
__device__ __forceinline__ void cvt_gateup(const float* Wg, const float* Wu, int dff, bf16* WT, int item, LAS float* scr, int lane) {
    const int nblk = 2 * dff / 32, kb = item / nblk, db = item % nblk, d0 = 32 * db, pn = d0 >> 8, r = d0 & 255;
    const float* W = r < 128 ? Wg : Wu; const int sc0 = 128 * pn + (r & 127);
    cvt_item(W, dff, D, WT, d0, sc0, 32, 1.0f, 64 * kb, scr, lane);
}
__device__ __forceinline__ void cvt_win(const float* W, bf16* WT, int item, LAS float* scr, int lane) {
    const int nblk = NIN / 32, kb = item / nblk, db = item % nblk, d0 = 32 * db;
    int sc0, nv = 32; float sc = 1.0f;
    if (d0 < 1024) { sc0 = d0; }
    else if (d0 < 2048) sc0 = 1736 + (d0 - 1024);
    else if (d0 < 3072) sc0 = 2760 + (d0 - 2048);
    else if (d0 < 4096) sc0 = 3784 + (d0 - 3072);
    else if (d0 < 5120) sc0 = 4808 + (d0 - 4096);
    else if (d0 < 5632) sc0 = 1152 + (d0 - 5120);
    else if (d0 < 5696) sc0 = 1024 + (d0 - 5632);
    else if (d0 < 5760) sc0 = 1088 + (d0 - 5696);
    else if (d0 < 5824) sc0 = 1664 + (d0 - 5760);
    else if (d0 == 5824) { sc0 = 1728; nv = 8; }
    else { sc0 = 0; nv = 0; }
    cvt_item(W, D_IN, D, WT, d0, sc0, nv, sc, 64 * kb, scr, lane);
}
__device__ __forceinline__ void p0_convert(const Frame& F0, int L) {
    Frame F = launder(F0);
    const KArgs ka = kargs();
    LAS float* scr = (LAS float*)(F.lds + RING_OFF + F.wave * 16384);
    const int gw = F.bx * NWAVES + F.wave, NGW = F.G * NWAVES;
    unsigned char* wb = F.ws + WS_W;
    const int odd = L & 1, jj = L >> 1;
    constexpr int I_IN = (D / 64) * (NIN / 32), I_SQ = (D / 64) * (D / 32), I_PPJ = (PLE / 64) * (D / 32), I_LRU1 = 2 * 4;
    constexpr int I_GU_D = (D / 64) * (2 * DFF / 32), I_DN_D = (DFF / 64) * (D / 32), I_GU_E = (D / 64) * (2 * DFFE / 32), I_DN_E = (DFFE / 64) * (D / 32);
    const int n_ff = odd ? NEXP * (I_GU_E + I_DN_E) : (I_GU_D + I_DN_D);
    const int NITEMS = I_IN + 4 * I_SQ + I_PPJ + 16 * I_LRU1 + n_ff;
    for (int it = gw; it < NITEMS; it += NGW) {
        int r = it;
        if (r < I_IN) { cvt_win(ka->in[I_WIN] + (size_t)L * D * D_IN, (bf16*)(wb + W_IN), r, scr, F.lane); continue; } r -= I_IN;
        if (r < I_SQ) { cvt_plain(ka->in[I_WBRA] + (size_t)L * D * D, D, D, (bf16*)(wb + W_BRA), r, scr, F.lane); continue; } r -= I_SQ;
        if (r < I_SQ) { cvt_plain(ka->in[I_WBRR] + (size_t)L * D * D, D, D, (bf16*)(wb + W_BRR), r, scr, F.lane); continue; } r -= I_SQ;
        if (r < I_SQ) { cvt_plain(ka->in[I_WO] + (size_t)L * D * D, D, D, (bf16*)(wb + W_O), r, scr, F.lane); continue; } r -= I_SQ;
        if (r < I_SQ) { cvt_plain(ka->in[I_PLEG] + (size_t)L * D * D, D, D, (bf16*)(wb + W_PG), r, scr, F.lane); continue; } r -= I_SQ;
        if (r < I_PPJ) { cvt_plain(ka->in[I_PLEP] + (size_t)L * PLE * D, PLE, D, (bf16*)(wb + W_PP), r, scr, F.lane); continue; } r -= I_PPJ;
        if (r < 16 * I_LRU1) { const int m = r / I_LRU1, blk = m & 7, which = m >> 3;
            const float* src = ka->in[which ? I_LRUWX : I_LRUWA] + (size_t)L * 8 * 128 * 128 + (size_t)blk * 128 * 128;
            cvt_plain(src, 128, 128, (bf16*)(wb + W_LRU) + (size_t)which * 8 * 128 * 128 + (size_t)blk * 128 * 128, r % I_LRU1, scr, F.lane); continue; } r -= 16 * I_LRU1;
        if (!odd) {
            if (r < I_GU_D) { cvt_gateup(ka->in[I_FFG] + (size_t)jj * D * DFF, ka->in[I_FFU] + (size_t)jj * D * DFF, DFF, (bf16*)(wb + W_FF), r, scr, F.lane); continue; } r -= I_GU_D;
            cvt_plain(ka->in[I_FFD] + (size_t)jj * DFF * D, DFF, D, (bf16*)(wb + W_FF_DN_DENSE), r, scr, F.lane);
        } else {
            if (r < NEXP * I_GU_E) { const int e = r / I_GU_E; const size_t eo = ((size_t)jj * NEXP + e) * D * DFFE;
                cvt_gateup(ka->in[I_MOEG] + eo, ka->in[I_MOEU] + eo, DFFE, (bf16*)(wb + W_FF) + (size_t)e * 2 * DFFE * D, r % I_GU_E, scr, F.lane); continue; } r -= NEXP * I_GU_E;
            const int e = r / I_DN_E; const size_t eo = ((size_t)jj * NEXP + e) * DFFE * D;
            cvt_plain(ka->in[I_MOED] + eo, DFFE, D, (bf16*)(wb + W_FF_DN_MOE) + (size_t)e * D * DFFE, r % I_DN_E, scr, F.lane);
        }
    }
    if (L == 0) {
        const GAS f32x4* x4 = (const GAS f32x4*)ka->in[I_X]; GAS v4u* o = (GAS v4u*)(F.ws + WS_XB);
        const size_t n8 = (size_t)T_TOK * D / 8;
        for (size_t i = (size_t)F.bx * 512 + F.tid; i < n8; i += (size_t)F.G * 512) { const f32x4 a = x4[2 * i], b = x4[2 * i + 1];
            v4u w; w.x = pk2(a[0], a[1]); w.y = pk2(a[2], a[3]); w.z = pk2(b[0], b[1]); w.w = pk2(b[2], b[3]); o[i] = w; }
    }
}

template <bool LN2, bool ODD, bool DRY = false>
__device__ __forceinline__ void ln_phase(const Frame& F0, int L) {
    Frame F = launder(F0);
    const KArgs ka = kargs();
    const int jj = L >> 1;
    float* X32 = F.out; bf16* XB = (bf16*)(F.ws + WS_XB);
    const float* gam = ka->in[LN2 ? I_LN2G : I_LN1G] + (size_t)L * D; const float* bet = ka->in[LN2 ? I_LN2B : I_LN1B] + (size_t)L * D;
    f32x4 gv[4], bv[4];
#pragma unroll
    for (int j = 0; j < 4; ++j) { gv[j] = ((const GAS f32x4*)gam)[F.lane + 64 * j]; bv[j] = ((const GAS f32x4*)bet)[F.lane + 64 * j]; }
    LAS float* RT = (LAS float*)(F.lds + RING_OFF);
    LAS unsigned* TE = (LAS unsigned*)(F.lds + RING_OFF + 32768);
    volatile LAS unsigned* lcnt = F.MISC + 48; volatile LAS unsigned* gbase = F.MISC + 56;
    float rb[8];
    if (!LN2 && ODD) {
        const float* R = ka->in[I_ROUTER] + (size_t)jj * D * NEXP;
        for (int i = F.tid; i < D * NEXP; i += 512) RT[i] = R[i];
        if (F.tid < 8) lcnt[F.tid] = 0u;
#pragma unroll
        for (int e = 0; e < 8; ++e) rb[e] = ka->in[I_ROUTERB][jj * NEXP + e];
        __syncthreads();
    }
    const unsigned* route = (const unsigned*)(F.ws + WS_ROUTE);
    const bf16* YE = (const bf16*)(F.ws + F_YE);
    f32x4 nv[4];
    { const GAS f32x4* x0 = (const GAS f32x4*)(X32 + ((size_t)F.bx * 256 + F.wave) * D) + F.lane;
#pragma unroll
      for (int j = 0; j < 4; ++j) nv[j] = x0[64 * j]; }
    for (int it = 0; it < 32; ++it) {
        const int rl = F.wave + 8 * it; const size_t row = (size_t)F.bx * 256 + rl;
        GAS f32x4* xr = (GAS f32x4*)(X32 + row * D) + F.lane;
        f32x4 v[4]; float s = 0.f;
#pragma unroll
        for (int j = 0; j < 4; ++j) v[j] = nv[j];
        if (it < 31) {
#pragma unroll
            for (int j = 0; j < 4; ++j) nv[j] = xr[8 * (D / 4) + 64 * j]; }
        if (LN2 && ODD) {
            const unsigned e1 = route[row * 8 + 0], e2 = route[row * 8 + 1], p1 = route[row * 8 + 2], p2 = route[row * 8 + 3];
            const float g1 = __builtin_bit_cast(float, route[row * 8 + 4]), g2 = __builtin_bit_cast(float, route[row * 8 + 5]);
            const size_t r1 = (size_t)F.MISC[16 + e1] * 256 + p1, r2 = (size_t)F.MISC[16 + e2] * 256 + p2;
            const GAS v2u* y1 = (const GAS v2u*)(YE + r1 * D) + F.lane; const GAS v2u* y2 = (const GAS v2u*)(YE + r2 * D) + F.lane;
#pragma unroll
            for (int j = 0; j < 4; ++j) { const v2u a = y1[64 * j], b = y2[64 * j];
                v[j][0] += g1 * bf_lo(a.x) + g2 * bf_lo(b.x); v[j][1] += g1 * bf_hi(a.x) + g2 * bf_hi(b.x);
                v[j][2] += g1 * bf_lo(a.y) + g2 * bf_lo(b.y); v[j][3] += g1 * bf_hi(a.y) + g2 * bf_hi(b.y); }
        }
#pragma unroll
        for (int j = 0; j < 4; ++j) s += (v[j][0] + v[j][1]) + (v[j][2] + v[j][3]);
        const float mean = wave_sum(s, F.lane) * (1.f / D); float s2 = 0.f;
#pragma unroll
        for (int j = 0; j < 4; ++j) { v[j] = v[j] - mean; s2 += (v[j][0] * v[j][0] + v[j][1] * v[j][1]) + (v[j][2] * v[j][2] + v[j][3] * v[j][3]); }
        const float rstd = 1.f / sqrtf(wave_sum(s2, F.lane) * (1.f / D) + LN_EPS);
        GAS v2u* o8 = (GAS v2u*)((DRY ? (bf16*)(F.ws + WS_NEED) : XB) + row * D) + F.lane;
        GAS f32x4* xw = DRY ? (GAS f32x4*)((float*)(F.ws + WS_NEED) + row * D) + F.lane : xr;
#pragma unroll
        for (int j = 0; j < 4; ++j) { v[j] = v[j] * rstd * gv[j] + bv[j]; if (DRY || (LN2 && L == DEPTH - 1)) xw[64 * j] = v[j];
            v2u w; w.x = pk2(v[j][0], v[j][1]); w.y = pk2(v[j][2], v[j][3]); o8[64 * j] = w; }
        if (!LN2) {
            const f32x4 pv = ((const GAS f32x4*)(ka->in[I_P] + ((size_t)L * T_TOK + row) * PLE))[F.lane];
            v2u w; w.x = pk2(pv[0], pv[1]); w.y = pk2(pv[2], pv[3]); ((GAS v2u*)(F.ws + (DRY ? WS_NEED : F_PB) + row * PLE * 2))[F.lane] = w;
        }
        if (!LN2 && ODD) {
            float lg[8];
#pragma unroll
            for (int e = 0; e < 8; ++e) lg[e] = 0.f;
#pragma unroll
            for (int j = 0; j < 4; ++j)
#pragma unroll
                for (int q = 0; q < 4; ++q) { const int c = 4 * F.lane + 256 * j + q; const f32x4 ra = *(const LAS f32x4*)(RT + c * 8), rc = *(const LAS f32x4*)(RT + c * 8 + 4); const float xv = v[j][q];
                    lg[0] += xv * ra[0]; lg[1] += xv * ra[1]; lg[2] += xv * ra[2]; lg[3] += xv * ra[3]; lg[4] += xv * rc[0]; lg[5] += xv * rc[1]; lg[6] += xv * rc[2]; lg[7] += xv * rc[3]; }
#pragma unroll
            for (int e = 0; e < 8; ++e) lg[e] = wave_sum(lg[e], F.lane) + rb[e];
            int e1 = 0; float v1 = lg[0];
#pragma unroll
            for (int e = 1; e < 8; ++e) if (lg[e] > v1) { v1 = lg[e]; e1 = e; }
            int e2 = -1; float v2 = 0.f;
#pragma unroll
            for (int e = 0; e < 8; ++e) if (e != e1 && (e2 < 0 || lg[e] > v2)) { v2 = lg[e]; e2 = e; }
            const float ex = __expf(v2 - v1), g1 = 1.f / (1.f + ex), g2 = ex * g1;
            if (F.lane == 0) { const unsigned lp1 = __hip_atomic_fetch_add((LAS unsigned*)lcnt + e1, 1u, __ATOMIC_RELAXED, __HIP_MEMORY_SCOPE_WORKGROUP), lp2 = __hip_atomic_fetch_add((LAS unsigned*)lcnt + e2, 1u, __ATOMIC_RELAXED, __HIP_MEMORY_SCOPE_WORKGROUP);
                TE[rl * 4 + 0] = (unsigned)e1 | ((unsigned)e2 << 8) | (lp1 << 16); TE[rl * 4 + 1] = lp2; TE[rl * 4 + 2] = __builtin_bit_cast(unsigned, g1); TE[rl * 4 + 3] = __builtin_bit_cast(unsigned, g2); }
        }
    }
    if (!LN2 && ODD) {
        __syncthreads();
        if (F.tid < 8) gbase[F.tid] = __hip_atomic_fetch_add(F.ctl + CW_CNT + jj * 1024 + 64 * F.tid, lcnt[F.tid], RLX_AGENT);
        __syncthreads();
        if (F.tid < 256) { const unsigned w0 = TE[F.tid * 4], lp2 = TE[F.tid * 4 + 1]; const unsigned e1 = w0 & 255u, e2 = (w0 >> 8) & 255u, lp1 = w0 >> 16;
            const unsigned p1 = gbase[e1] + lp1, p2 = gbase[e2] + lp2; const unsigned tok = (unsigned)F.bx * 256 + F.tid;
            GAS int* list = (GAS int*)(F.ws + WS_LIST); list[(size_t)e1 * T_TOK + p1] = (int)tok; list[(size_t)e2 * T_TOK + p2] = (int)tok;
            GAS v4u* ro = (GAS v4u*)(F.ws + WS_ROUTE) + (size_t)tok * 2; v4u a; a.x = e1; a.y = e2; a.z = p1; a.w = p2; ro[0] = a; v4u b; b.x = TE[F.tid * 4 + 2]; b.y = TE[F.tid * 4 + 3]; b.z = 0u; b.w = 0u; ro[1] = b; }
        __syncthreads();
    }
}
template <int NJ>
__device__ __forceinline__ unsigned select_topk_n(LAS const float* sc, int n_adm, GAS unsigned short* out, int lane, unsigned guess) {
    const int nj = n_adm >> 6;
    unsigned u[NJ];
#pragma unroll
    for (int j = 0; j < NJ; ++j) { unsigned b = 0u;
        if (j < NJ - 8 || j < nj) { b = __builtin_bit_cast(unsigned, sc[64 * j + lane]); b = (b == 0x80000000u) ? 0u : b; b = (b & 0x80000000u) ? ~b : (b | 0x80000000u); }
        u[j] = b; }
#define SEL_COUNT(c_, dst_) do { int cnt_ = 0; _Pragma("unroll") for (int j = 0; j < NJ; ++j) cnt_ += __popcll(__ballot(u[j] >= (c_))); dst_ = cnt_; } while (0)
    unsigned lo = 0u, hi = 0xFFFFFFFFu, ex = 0u; bool exact = false; int c;
    if (guess != 0u) {
        SEL_COUNT(guess, c);
        if (c == 256) { exact = true; ex = guess; }
        else if (c > 256) { lo = guess; unsigned d = 1u << 17;
            for (int e = 0; e < 7 && !exact; ++e) { const unsigned h = lo + d; if (h < lo) break; SEL_COUNT(h, c);
                if (c == 256) { exact = true; ex = h; } else if (c < 256) { hi = h; break; } else { lo = h; d <<= 2; } } }
        else { hi = guess; unsigned d = 1u << 17;
            for (int e = 0; e < 7 && !exact; ++e) { if (d >= hi) break; const unsigned l = hi - d; SEL_COUNT(l, c);
                if (c == 256) { exact = true; ex = l; } else if (c > 256) { lo = l; break; } else { hi = l; d <<= 2; } } }
    }
    while (!exact && hi - lo > 1u) { const unsigned mid = lo + ((hi - lo) >> 1); SEL_COUNT(mid, c);
        if (c == 256) { exact = true; ex = mid; } else if (c > 256) lo = mid; else hi = mid; }
#undef SEL_COUNT
    const unsigned thr = exact ? ex - 1u : lo;
    int ngt = 0;
#pragma unroll
    for (int j = 0; j < NJ; ++j) ngt += __popcll(__ballot(u[j] > thr));
    const int quota = 256 - ngt;
    int obase = 0, tbase = 0; const unsigned long long lt = (1ull << lane) - 1ull;
#pragma unroll
    for (int j = 0; j < NJ; ++j) {
        const bool gt = u[j] > thr, eq = u[j] == thr;
        const unsigned long long meq = __ballot(eq);
        const bool seleq = eq && (tbase + __popcll(meq & lt) < quota);
        const unsigned long long msel = __ballot(gt || seleq);
        if (gt || seleq) out[obase + __popcll(msel & lt)] = (unsigned short)(64 * j + lane);
        obase += __popcll(msel); tbase += __popcll(meq);
    }
    return thr;
}
__device__ __forceinline__ unsigned select_topk(LAS const float* sc, int n_adm, GAS unsigned short* out, int lane, unsigned guess) {
    if (n_adm <= 256) {
#pragma unroll
        for (int j = 0; j < 4; ++j) { const int p = lane + 64 * j; out[p] = (unsigned short)(p < n_adm ? p : 0); }
        return 0u;
    }
    if (n_adm <= 512) return select_topk_n<8>(sc, n_adm, out, lane, guess);
    else if (n_adm <= 1024) return select_topk_n<16>(sc, n_adm, out, lane, guess);
    else if (n_adm <= 1536) return select_topk_n<24>(sc, n_adm, out, lane, guess);
    return select_topk_n<32>(sc, n_adm, out, lane, guess);
}
__device__ __forceinline__ void indexer_phase(const Frame& F0) {
    Frame F = launder(F0);
    LAS float* sc = (LAS float*)(F.lds + RING_OFF);
    const bf16* QI = (const bf16*)(F.ws + Z_QI); const bf16* SM = (const bf16*)(F.ws + Z_SM);
    GAS unsigned short* IDX = (GAS unsigned short*)(F.ws + WS_IDX);
    const int lane = F.lane, h = lane >> 5, r = lane & 31;
    const int rq = 2 * ((r >> 2) & 1) + ((r >> 4) & 1), rh = (r & 3) + 4 * ((r >> 3) & 1);
    const int vcu = (F.bx & 7) * (F.G >> 3) + (F.bx >> 3);
    unsigned guess[2] = {0u, 0u};
    bf16x8 A[4][4]; v4u wq[4][2];
#define IDX_TILE(pi_, b_, tq_) const int pid_ = vcu * 8 + ((pi_) >> 1), b_ = pid_ >> 6, jp_ = pid_ & 63, tq_ = 16 * (((pi_) & 1) ? 127 - jp_ : jp_)
#define IDX_LOAD_A(t0_) do { _Pragma("unroll") for (int mt = 0; mt < 4; ++mt) { \
        _Pragma("unroll") for (int s = 0; s < 4; ++s) A[mt][s] = *(const GAS bf16x8*)(QI + (size_t)((t0_) + 4 * mt + rq) * 512 + rh * 64 + 16 * s + 8 * h); \
        _Pragma("unroll") for (int qq = 0; qq < 2; ++qq) wq[mt][qq] = *(const GAS v4u*)(SM + (size_t)((t0_) + 4 * mt + 2 * h + qq) * 256 + 192); } } while (0)
    for (int pi = 0; pi < 16; ++pi) {
        IDX_TILE(pi, b, tq);
        const int t0 = b * SEQ + tq;
        const int n_adm = ((tq >> 6) + 1) * 64, nkb = n_adm >> 5;
        if (n_adm > 256) {
            IDX_LOAD_A(t0);
            bf16x8 B[4], Bn[4];
#pragma unroll
            for (int s = 0; s < 4; ++s) Bn[s] = *(const GAS bf16x8*)(SM + (size_t)(b * SEQ + 32 * F.wave + r) * 256 + 128 + 16 * s + 8 * h);
            for (int kb = F.wave; kb < nkb; kb += 8) {
                const int key = 32 * kb + r;
                const int keyn = (kb + 8 < nkb) ? key + 256 : key;
#pragma unroll
                for (int s = 0; s < 4; ++s) B[s] = Bn[s];
#pragma unroll
                for (int s = 0; s < 4; ++s) Bn[s] = *(const GAS bf16x8*)(SM + (size_t)(b * SEQ + keyn) * 256 + 128 + 16 * s + 8 * h);
#pragma unroll
                for (int mt = 0; mt < 4; ++mt) {
                    f32x16 acc;
#pragma unroll
                    for (int i = 0; i < 16; ++i) acc[i] = 0.f;
#pragma unroll
                    for (int s = 0; s < 4; ++s) acc = __builtin_amdgcn_mfma_f32_32x32x16_bf16(A[mt][s], B[s], acc, 0, 0, 0);
                    float sA = 0.f, sB = 0.f;
#pragma unroll
                    for (int i = 0; i < 8; ++i) { const unsigned wa = wq[mt][0][i >> 1], wb = wq[mt][1][i >> 1];
                        const float fa = (i & 1) ? bf_hi(wa) : bf_lo(wa), fb = (i & 1) ? bf_hi(wb) : bf_lo(wb);
                        sA += fmaxf(acc[i], 0.f) * fa; sB += fmaxf(acc[8 + i], 0.f) * fb; }
                    sc[(4 * mt + 2 * h) * 2048 + key] = sA; sc[(4 * mt + 2 * h + 1) * 2048 + key] = sB;
                }
            }
        }
        __syncthreads();
#pragma unroll 1
        for (int qq = 0; qq < 2; ++qq) { const int q = 2 * F.wave + qq; const unsigned g_ = (pi & 1) ? guess[1] : guess[0];
            const unsigned t_ = select_topk(sc + q * 2048, n_adm, IDX + (size_t)(t0 + q) * 256, lane, g_); if (pi & 1) guess[1] = t_; else guess[0] = t_; }
        __syncthreads();
    }
#undef IDX_TILE
#undef IDX_LOAD_A
}

__device__ __forceinline__ unsigned vst_off(unsigned r, unsigned ch) { return r * 128u + 16u * (ch ^ ((((r >> 1) ^ (r >> 4)) & 1u) << 1) ^ (((r >> 3) & 1u) << 2)); }
__device__ __forceinline__ int t5_bucket_dev(int rel) {
    const int n = rel < 0 ? -rel : rel;
    int v = n;
    if (n >= 8) v = 8 + (n >= 12) + (n >= 16) + (n >= 23) + (n >= 32) + (n >= 46) + (n >= 64) + (n >= 91);
    return v + (rel > 0 ? 16 : 0);
}
#ifndef ATT_REPS
#define ATT_REPS 1
#endif
#ifndef ATT_FIXKEYS
#define ATT_FIXKEYS 0
#endif
template <int FIX = 0>
__device__ __forceinline__ void attention_phase(const Frame& F0) {
#pragma unroll 1
    for (int rep = 0; rep < ATT_REPS; ++rep) {
    Frame F = launder(F0);
    const GAS unsigned char* Q8 = (const GAS unsigned char*)(F.ws + Z_Q8); const GAS unsigned char* KV8 = (const GAS unsigned char*)(F.ws + Z_KV8); bf16* OB = (bf16*)(F.ws + Z_XR);
    const GAS unsigned short* IDX = (const GAS unsigned short*)(F.ws + WS_IDX);
    const int lane = F.lane, g = lane >> 4, m = lane & 15;
    LAS unsigned char* vst = F.lds + RING_OFF + F.wave * 4096;
    const unsigned vbase = (unsigned)(size_t)vst;
    LAS unsigned char* BK = F.lds + RING_OFF + 32768; LAS unsigned char* OH = F.lds + RING_OFF + 32768 + 2176;
    for (int i = F.tid; i < 2112; i += 512) BK[i] = (unsigned char)t5_bucket_dev(i - 2047);
    if (F.tid < 128) { const int bkt = F.tid >> 2, gg = F.tid & 3, j = bkt - 8 * gg; v4u oh; oh.x = oh.y = oh.z = oh.w = 0u;
        if (j >= 0 && j < 8) { const unsigned val = (j & 1) ? 0x3F800000u : 0x3F80u; if ((j >> 1) == 0) oh.x = val; else if ((j >> 1) == 1) oh.y = val; else if ((j >> 1) == 2) oh.z = val; else oh.w = val; }
        *(LAS v4u*)(OH + F.tid * 16) = oh; }
    __syncthreads();
    bf16x8 bb;
    { const float* rbias = kargs()->in[I_RELB]; unsigned w[4];
#pragma unroll
      for (int j = 0; j < 4; ++j) w[j] = pk2(8.0f * rbias[(8 * g + 2 * j) * 16 + m], 8.0f * rbias[(8 * g + 2 * j + 1) * 16 + m]);
      v4u t; t.x = w[0]; t.y = w[1]; t.z = w[2]; t.w = w[3]; bb = __builtin_bit_cast(bf16x8, t); }
    unsigned tra[4][2];
    { const unsigned q = (lane & 15) >> 2, p = lane & 3;
#pragma unroll
      for (int c = 0; c < 4; ++c)
#pragma unroll
        for (int t = 0; t < 2; ++t) tra[c][t] = vst_off(8 * g + 4 * t + q, 2 * c + (p >> 1)) + 8 * (p & 1); }
    const int vcu = (F.bx & 7) * (F.G >> 3) + (F.bx >> 3);
    typedef long fp8x8;
    v4u ni0, ni1, nq; v4u ka[16]; unsigned koff[16];
#define ATT_KOFF(i0_, i1_) do { _Pragma("unroll") for (int k = 0; k < 4; ++k) { koff[2 * k] = ((i0_)[k] & 0xffffu) * 128u + 16u * g; koff[2 * k + 1] = ((i0_)[k] >> 16) * 128u + 16u * g; \
        koff[8 + 2 * k] = ((i1_)[k] & 0xffffu) * 128u + 16u * g; koff[8 + 2 * k + 1] = ((i1_)[k] >> 16) * 128u + 16u * g; } } while (0)
#ifdef ATT_NO_ASM
#define ATT_KLOAD(kvb_) do { const GAS unsigned char* kb_ = (kvb_); _Pragma("unroll") for (int T = 0; T < 16; ++T) ka[T] = *(const GAS v4u*)(kb_ + koff[T]); } while (0)
#define ATT_KWAIT(n_, T0_) do {} while (0)
#else
#define ATT_KLOAD(kvb_) do { const GAS unsigned char* kb_ = (kvb_); _Pragma("unroll") for (int T = 0; T < 16; ++T) { \
        asm volatile("global_load_dwordx4 %0, %1, %2" : "=&v"(ka[T]) : "v"(koff[T]), "s"(kb_) : "memory"); } } while (0)
#define ATT_KWAIT(n_, T0_) asm volatile("s_waitcnt vmcnt(" #n_ ")" : "+v"(ka[T0_]), "+v"(ka[T0_ + 1]), "+v"(ka[T0_ + 2]), "+v"(ka[T0_ + 3]), "+v"(ka[T0_ + 4]), "+v"(ka[T0_ + 5]), "+v"(ka[T0_ + 6]), "+v"(ka[T0_ + 7]) :: "memory")
#endif
    { const int tok0 = vcu * 256 + F.wave; const GAS v4u* ip = (const GAS v4u*)(IDX + (size_t)tok0 * 256 + 16 * m); ni0 = ip[0]; ni1 = ip[1];
      nq = *(const GAS v4u*)(Q8 + (size_t)tok0 * D + m * 64 + 16 * g);
      ATT_KOFF(ni0, ni1); ATT_KLOAD(KV8 + (size_t)(tok0 >> 11) * SEQ * 128); }
    for (int it = 0; it < 32; ++it) {
        const int tok = vcu * 256 + F.wave + 8 * it, b = tok >> 11, tq = tok & (SEQ - 1);
        const int n_valid = (((tq >> 6) + 1) * 64) < 256 ? ((tq >> 6) + 1) * 64 : 256;
        const v4u qv = nq;
        const fp8x8 qf0 = (fp8x8)(((unsigned long long)qv.y << 32) | qv.x), qf1 = (fp8x8)(((unsigned long long)qv.w << 32) | qv.z);
        const GAS unsigned char* kvb = KV8 + (size_t)b * SEQ * 128;
        f32x4 S[16];
#pragma unroll
        for (int T = 0; T < 16; ++T) {
            if (T == 0) ATT_KWAIT(8, 0);
            if (T == 8) ATT_KWAIT(0, 8);
            const unsigned bkt = BK[(koff[T] >> 7) + (2047 - tq)];
            const v4u oh = *(const LAS v4u*)(OH + bkt * 64 + g * 16);
            f32x4 ab = (f32x4){0.f, 0.f, 0.f, 0.f}, a = (f32x4){0.f, 0.f, 0.f, 0.f};
            ab = __builtin_amdgcn_mfma_f32_16x16x32_bf16(__builtin_bit_cast(bf16x8, oh), bb, ab, 0, 0, 0);
            a = __builtin_amdgcn_mfma_f32_16x16x32_fp8_fp8((fp8x8)(((unsigned long long)ka[T].y << 32) | ka[T].x), qf0, a, 0, 0, 0);
            a = __builtin_amdgcn_mfma_f32_16x16x32_fp8_fp8((fp8x8)(((unsigned long long)ka[T].w << 32) | ka[T].z), qf1, a, 0, 0, 0);
            a = a + ab;
            S[T] = a;
        }
        __builtin_amdgcn_sched_barrier(0);
        v4u vv[16];
#pragma unroll
        for (int T = 0; T < 16; ++T) vv[T] = *(const GAS v4u*)(kvb + koff[T] + 64);
        if (n_valid < 256) {
#pragma unroll
            for (int T = 0; T < 16; ++T)
#pragma unroll
                for (int i = 0; i < 4; ++i) if (16 * (4 * g + i) + T >= n_valid) S[T][i] = -1e30f;
        }
        float mx = -3.0e38f;
#pragma unroll
        for (int T = 0; T < 16; ++T) mx = fmaxf(fmaxf(fmaxf(S[T][0], S[T][1]), fmaxf(S[T][2], S[T][3])), mx);
        mx = fmaxf(mx, lane_xor(mx, 16, lane)); mx = fmaxf(mx, lane_xor(mx, 32, lane));
        constexpr float SC = 1.4426950408889634f * 0.125f;
        const float mneg = -mx * SC; float sum = 0.f;
#pragma unroll
        for (int T = 0; T < 16; ++T)
#pragma unroll
            for (int i = 0; i < 4; ++i) { const float p = __builtin_amdgcn_exp2f(S[T][i] * SC + mneg); S[T][i] = p; sum += p; }
        sum += lane_xor(sum, 16, lane); sum += lane_xor(sum, 32, lane);
        { const int tokn = vcu * 256 + F.wave + 8 * (it < 31 ? it + 1 : it); const GAS v4u* ip = (const GAS v4u*)(IDX + (size_t)tokn * 256 + 16 * m); ni0 = ip[0]; ni1 = ip[1];
          nq = *(const GAS v4u*)(Q8 + (size_t)tokn * D + m * 64 + 16 * g); }
        f32x4 O[4];
#pragma unroll
        for (int c = 0; c < 4; ++c) O[c] = (f32x4){0.f, 0.f, 0.f, 0.f};
#pragma unroll
        for (int ks = 0; ks < 8; ++ks) {
            const unsigned vb = vbase;
#pragma unroll
            for (int tt = 0; tt < 2; ++tt) { const v4u w8 = vv[2 * ks + tt]; v4u c0, c1;
#pragma unroll
                for (int q = 0; q < 4; ++q) { const int src = (int)w8[q];
                    const __attribute__((ext_vector_type(2))) float lo2 = __builtin_amdgcn_cvt_pk_f32_fp8(src, false), hi2 = __builtin_amdgcn_cvt_pk_f32_fp8(src, true);
                    const unsigned w0 = pk2(lo2.x, lo2.y), w1 = pk2(hi2.x, hi2.y);
                    if (q < 2) { c0[2 * q] = w0; c0[2 * q + 1] = w1; } else { c1[2 * (q - 2)] = w0; c1[2 * (q - 2) + 1] = w1; } }
                const unsigned rr = 8 * (m >> 2) + 4 * tt + (m & 3);
                *(LAS v4u*)(vst + vst_off(rr, 2 * g)) = c0; *(LAS v4u*)(vst + vst_off(rr, 2 * g + 1)) = c1; }
            v4u pw; pw.x = pk2(S[2 * ks][0], S[2 * ks][1]); pw.y = pk2(S[2 * ks][2], S[2 * ks][3]); pw.z = pk2(S[2 * ks + 1][0], S[2 * ks + 1][1]); pw.w = pk2(S[2 * ks + 1][2], S[2 * ks + 1][3]);
            const bf16x8 pf = __builtin_bit_cast(bf16x8, pw);
            v2u f[4][2];
            asm volatile("s_waitcnt lgkmcnt(0)\n\t"
                         "ds_read_b64_tr_b16 %0, %8\n\tds_read_b64_tr_b16 %1, %9\n\tds_read_b64_tr_b16 %2, %10\n\tds_read_b64_tr_b16 %3, %11\n\t"
                         "ds_read_b64_tr_b16 %4, %12\n\tds_read_b64_tr_b16 %5, %13\n\tds_read_b64_tr_b16 %6, %14\n\tds_read_b64_tr_b16 %7, %15\n\t"
                         "s_waitcnt lgkmcnt(0)"
                         : "=&v"(f[0][0]), "=&v"(f[0][1]), "=&v"(f[1][0]), "=&v"(f[1][1]), "=&v"(f[2][0]), "=&v"(f[2][1]), "=&v"(f[3][0]), "=&v"(f[3][1])
                         : "v"(vb + tra[0][0]), "v"(vb + tra[0][1]), "v"(vb + tra[1][0]), "v"(vb + tra[1][1]), "v"(vb + tra[2][0]), "v"(vb + tra[2][1]), "v"(vb + tra[3][0]), "v"(vb + tra[3][1])
                         : "memory");
#pragma unroll
            for (int c = 0; c < 4; ++c) { v4u t; t.x = f[c][0].x; t.y = f[c][0].y; t.z = f[c][1].x; t.w = f[c][1].y;
                O[c] = __builtin_amdgcn_mfma_f32_16x16x32_bf16(__builtin_bit_cast(bf16x8, t), pf, O[c], 0, 0, 0); }
        }
        const float inv = 1.0f / sum;
#pragma unroll
        for (int c = 0; c < 4; ++c) { v2u w; w.x = pk2(O[c][0] * inv, O[c][1] * inv); w.y = pk2(O[c][2] * inv, O[c][3] * inv);
            *(GAS v2u*)(OB + (size_t)tok * D + m * 64 + 16 * c + 4 * g) = w; }
        { const int tokn = vcu * 256 + F.wave + 8 * (it < 31 ? it + 1 : it); ATT_KOFF(ni0, ni1); ATT_KLOAD(KV8 + (size_t)(tokn >> 11) * SEQ * 128); }
    }
#undef ATT_KOFF
#undef ATT_KLOAD
#undef ATT_KWAIT
    }
}
constexpr int XCS = 136;
constexpr int HHS = 132;
__device__ __forceinline__ float gelu_tanh(float x) {
    const float z = 0.7978845608028654f * (x + 0.044715f * x * x * x);
    const float e = __builtin_amdgcn_exp2f(2.885390081777927f * z);
    const float th = 1.0f - 2.0f * __builtin_amdgcn_rcpf(e + 1.0f);
    return 0.5f * x * (1.0f + th);
}
template <bool DRY = false>
__device__ __forceinline__ void lru_phase(const Frame& F0, int L) {
    Frame F = launder(F0);
    const KArgs ka = kargs();
    const int b = F.bx >> 3, nb = F.bx & 7;
    const bf16* XR = (const bf16*)(F.ws + Z_XR); bf16* YR = (bf16*)(F.ws + Z_YR);
    const bf16* WL = (const bf16*)(F.ws + WS_W + W_LRU);
    LAS bf16* XC = (LAS bf16*)(F.lds + RING_OFF);
    LAS float* HH = (LAS float*)(F.lds + RING_OFF + 2 * 64 * XCS * 2);
    const int tid = F.tid, lane = F.lane, w = F.wave, g = lane >> 4, m = lane & 15;
    const int cc = tid & 15, tp = tid >> 4;
    const int ch0 = nb * 128 + 8 * cc;
    float cw[4][8], cbias[8];
#pragma unroll
    for (int j = 0; j < 4; ++j)
#pragma unroll
        for (int k = 0; k < 8; ++k) cw[j][k] = ka->in[I_CONVW][(size_t)L * 4 * D + j * D + ch0 + k];
#pragma unroll
    for (int k = 0; k < 8; ++k) cbias[k] = ka->in[I_CONVB][(size_t)L * D + ch0 + k];
    bf16x8 Br[4], Bi[4];
#pragma unroll
    for (int s = 0; s < 4; ++s) { Br[s] = *(const GAS bf16x8*)(WL + ((size_t)nb * 128 + 16 * w + m) * 128 + 32 * s + 8 * g);
                                  Bi[s] = *(const GAS bf16x8*)(WL + (size_t)8 * 128 * 128 + ((size_t)nb * 128 + 16 * w + m) * 128 + 32 * s + 8 * g); }
    const int chl = 16 * w + m, chg = nb * 128 + chl;
    const float ba = ka->in[I_LRUBA][(size_t)L * D + chg], bx = ka->in[I_LRUBX][(size_t)L * D + chg];
    const float lam = ka->in[I_LAM][(size_t)L * D + chg];
    const float sp8 = -8.0f * (fmaxf(-lam, 0.f) + log1pf(__expf(-fabsf(lam))));
    float carry = 0.f;
    const size_t rowb = (size_t)b * SEQ;
    v4u nxin[5], nyin[2];
#pragma unroll
    for (int k = 0; k < 5; ++k) { const int t = 2 * tp - 3 + k; v4u z; z.x = z.y = z.z = z.w = 0u; nxin[k] = (t >= 0) ? *(const GAS v4u*)(XR + (rowb + t) * D + ch0) : z; }
#pragma unroll
    for (int k = 0; k < 2; ++k) nyin[k] = *(const GAS v4u*)(YR + (rowb + 2 * tp + k) * D + ch0);
    for (int tile = 0; tile < 32; ++tile) {
        const int t0 = tile * 64, buf = tile & 1;
        LAS bf16* xc = XC + buf * 64 * XCS; LAS float* hh = HH + buf * 64 * HHS;
        v4u xin[5], yin[2];
#pragma unroll
        for (int k = 0; k < 5; ++k) xin[k] = nxin[k];
#pragma unroll
        for (int k = 0; k < 2; ++k) yin[k] = nyin[k];
        if (tile < 31) {
#pragma unroll
            for (int k = 0; k < 5; ++k) nxin[k] = *(const GAS v4u*)(XR + (rowb + t0 + 64 + 2 * tp - 3 + k) * D + ch0);
#pragma unroll
            for (int k = 0; k < 2; ++k) nyin[k] = *(const GAS v4u*)(YR + (rowb + t0 + 64 + 2 * tp + k) * D + ch0);
        }
#pragma unroll
        for (int k = 0; k < 2; ++k) { float o[8];
#pragma unroll
            for (int c = 0; c < 8; ++c) { float a = cbias[c];
#pragma unroll
                for (int j = 0; j < 4; ++j) { const unsigned wv = xin[k + j][c >> 1]; a += ((c & 1) ? bf_hi(wv) : bf_lo(wv)) * cw[j][c]; }
                o[c] = a; }
            v4u pw; pw.x = pk2(o[0], o[1]); pw.y = pk2(o[2], o[3]); pw.z = pk2(o[4], o[5]); pw.w = pk2(o[6], o[7]);
            *(LAS v4u*)(xc + (2 * tp + k) * XCS + 8 * cc) = pw; }
        __syncthreads();
#pragma unroll
        for (int mt = 0; mt < 4; ++mt) {
            f32x4 ar = (f32x4){0.f, 0.f, 0.f, 0.f}, ai = (f32x4){0.f, 0.f, 0.f, 0.f};
#pragma unroll
            for (int s = 0; s < 4; ++s) { const bf16x8 A = *(const LAS bf16x8*)(xc + (16 * mt + m) * XCS + 32 * s + 8 * g);
                ar = __builtin_amdgcn_mfma_f32_16x16x32_bf16(A, Br[s], ar, 0, 0, 0); ai = __builtin_amdgcn_mfma_f32_16x16x32_bf16(A, Bi[s], ai, 0, 0, 0); }
            float P[4], W[4];
#pragma unroll
            for (int i = 0; i < 4; ++i) {
                const float rr = sigmoidf_fast(ar[i] + ba), ig = sigmoidf_fast(ai[i] + bx);
                const float la = sp8 * rr;
                const float a = __builtin_amdgcn_exp2f(1.4426950408889634f * la);
                const float mult = __builtin_amdgcn_sqrtf(fmaxf(__builtin_fmaf(-a, a, 1.0f), 0.f));
                const float xv = __builtin_bit_cast(float, (unsigned)xc[(16 * mt + 4 * g + i) * XCS + chl] << 16);
                const float u = mult * (ig * xv);
                if (i == 0) { P[0] = a; W[0] = u; } else { P[i] = a * P[i - 1]; W[i] = a * W[i - 1] + u; }
            }
            float Ac = P[3], Uc = W[3];
            { const float A1 = lane_up(Ac, 16, lane), U1 = lane_up(Uc, 16, lane); if (g >= 1) { Uc = Ac * U1 + Uc; Ac = Ac * A1; } }
            { const float A2 = lane_up(Ac, 32, lane), U2 = lane_up(Uc, 32, lane); if (g >= 2) { Uc = Ac * U2 + Uc; Ac = Ac * A2; } }
            float Ae = lane_up(Ac, 16, lane), Ue = lane_up(Uc, 16, lane); if (g == 0) { Ae = 1.f; Ue = 0.f; }
            const float hin = Ae * carry + Ue;
            const float cnew = Ac * carry + Uc;
            carry = lane_get(cnew, 48 + m);
#pragma unroll
            for (int i = 0; i < 4; ++i) hh[(16 * mt + 4 * g + i) * HHS + chl] = P[i] * hin + W[i];
        }
        __syncthreads();
#pragma unroll
        for (int k = 0; k < 2; ++k) { const f32x4 h0 = *(const LAS f32x4*)(hh + (2 * tp + k) * HHS + 8 * cc), h1 = *(const LAS f32x4*)(hh + (2 * tp + k) * HHS + 8 * cc + 4);
            float o[8];
#pragma unroll
            for (int c = 0; c < 8; ++c) { const unsigned wv = yin[k][c >> 1]; const float y = (c & 1) ? bf_hi(wv) : bf_lo(wv); o[c] = (c < 4 ? h0[c] : h1[c - 4]) * gelu_tanh(y); }
            v4u pw; pw.x = pk2(o[0], o[1]); pw.y = pk2(o[2], o[3]); pw.z = pk2(o[4], o[5]); pw.w = pk2(o[6], o[7]);
            *(GAS v4u*)((DRY ? (bf16*)(F.ws + WS_NEED) : YR) + (rowb + t0 + 2 * tp + k) * D + ch0) = pw; }
    }
    __syncthreads();
}

struct MoeOrder : pg8::StaticOrder {
    const volatile LAS unsigned* tb; int tile0; const int* list; size_t bstride;
    __device__ __forceinline__ int expert_of(int gt) const { int e = 0;
#pragma unroll
        for (int k = 1; k < 8; ++k) e += (gt >= (int)tb[k]) ? 1 : 0;
        return e; }
    __device__ __forceinline__ const char* b_base(const pg8::Gemm& g, const pg8::Unit& u, size_t tstep) const { return (const char*)g.Bt + (size_t)expert_of(tile0 + u.pm) * bstride + (size_t)u.pn * tstep; }
};
struct MoeGatherOrder : MoeOrder {
    static constexpr bool GATHER = true;
    __device__ __forceinline__ const char* a_base(const pg8::Gemm& g, const pg8::Unit&, size_t) const { return (const char*)g.A; }
    __device__ __forceinline__ void a_rows(const pg8::Unit& u, int R0, int R1, int C0, int C1, int K, unsigned (&off)[2][2]) const {
        const int gt = tile0 + u.pm, e = expert_of(gt), j = gt - (int)tb[e], n = (int)tb[16 + e];
        const GAS int* le = (const GAS int*)list + (size_t)e * T_TOK;
#pragma unroll
        for (int h = 0; h < 2; ++h) { int p0 = 256 * j + 128 * h + R0, p1 = 256 * j + 128 * h + R1; p0 = p0 < n ? p0 : n - 1; p1 = p1 < n ? p1 : n - 1;
            off[h][0] = ((unsigned)le[p0] * (unsigned)K + (unsigned)C0) * 2u; off[h][1] = ((unsigned)le[p1] * (unsigned)K + (unsigned)C1) * 2u; }
    }
};
#ifdef SELFCHECK
#ifndef SC_TOL
#define SC_TOL 0.03f
#define SC_ABS 1e-5f
#endif
__device__ __forceinline__ float sc_bf(const bf16* p, size_t i) { return __builtin_bit_cast(float, (unsigned)((const GAS bf16*)p)[i] << 16); }
__device__ __forceinline__ float sc_f8(const unsigned char* p, size_t i) {
    const unsigned v = ((const GAS unsigned char*)p)[i]; const unsigned e = (v >> 3) & 15u, mn = v & 7u; float r;
    if (e == 0u) r = (float)mn * 0.001953125f; else r = (1.0f + (float)mn * 0.125f) * exp2f((float)e - 7.0f);
    return (v & 128u) ? -r : r; }
__device__ __forceinline__ void sc_fail(const Frame& F, unsigned code) { __hip_atomic_fetch_or(F.ctl + CW_CODE, code, RLX_AGENT); }
__device__ __forceinline__ int sc_bucket_ref(int rel) {
    const int half = 16, max_exact = 8; const int ret = rel > 0 ? half : 0; const int n = rel < 0 ? -rel : rel;
    const float nf = (float)(n > 1 ? n : 1);
    int large = max_exact + (int)(logf(nf / (float)max_exact) / logf(16.0f) * (float)(half - max_exact));
    large = large < half - 1 ? large : half - 1;
    return ret + (n < max_exact ? n : large);
}
__device__ __forceinline__ void selfcheck_topk(const Frame& F0) {
    Frame F = launder(F0);
    if (F.wave != 0) return;
    const bf16* QI = (const bf16*)(F.ws + Z_QI); const bf16* SM = (const bf16*)(F.ws + Z_SM);
    const GAS unsigned short* IDX = (const GAS unsigned short*)(F.ws + WS_IDX);
    LAS float* sc = (LAS float*)(F.lds + RING_OFF);
    LAS unsigned* bm = (LAS unsigned*)(F.lds + RING_OFF + 8192);
    const int tok = F.bx * 256 + ((F.bx * 37) & 255), b = tok >> 11, tq = tok & (SEQ - 1), n_adm = ((tq >> 6) + 1) * 64;
    const int lane = F.lane;
    bm[lane] = 0u;
    for (int s = lane; s < n_adm; s += 64) { float score = 0.f;
        for (int h = 0; h < 8; ++h) { float d = 0.f;
            for (int k = 0; k < 64; ++k) d += sc_bf(QI, (size_t)tok * 512 + h * 64 + k) * sc_bf(SM, (size_t)(b * SEQ + s) * 256 + 128 + k);
            score += fmaxf(d, 0.f) * sc_bf(SM, (size_t)tok * 256 + 192 + h); }
        sc[s] = score; }
    asm volatile("s_waitcnt lgkmcnt(0)" ::: "memory");
    const int nsel = n_adm < 256 ? n_adm : 256;
    float msel = 3.0e38f; bool bad = false;
    for (int p = lane; p < nsel; p += 64) { const int key = IDX[(size_t)tok * 256 + p]; if (key >= n_adm) { bad = true; continue; }
        const unsigned old = __hip_atomic_fetch_or(bm + (key >> 5), 1u << (key & 31), __ATOMIC_RELAXED, __HIP_MEMORY_SCOPE_WORKGROUP); if (old & (1u << (key & 31))) bad = true;
        msel = fminf(msel, sc[key]); }
    asm volatile("s_waitcnt lgkmcnt(0)" ::: "memory");
    float muns = -3.0e38f, amax = 0.f;
    for (int s = lane; s < n_adm; s += 64) { amax = fmaxf(amax, fabsf(sc[s])); if (!((bm[s >> 5] >> (s & 31)) & 1u)) muns = fmaxf(muns, sc[s]); }
#pragma unroll
    for (int o = 1; o < 64; o <<= 1) { msel = fminf(msel, lane_xor(msel, o, lane)); muns = fmaxf(muns, lane_xor(muns, o, lane)); amax = fmaxf(amax, lane_xor(amax, o, lane)); }
    if (muns > msel + 1e-4f * amax) bad = true;
    if (__any(bad)) { if (lane == 0) sc_fail(F, 1u); }
}
__device__ __forceinline__ void selfcheck_attn(const Frame& F0) {
    Frame F = launder(F0);
    if (F.wave != 0) return;
    const KArgs ka = kargs();
    const unsigned char* Q8 = F.ws + Z_Q8; const unsigned char* KV8 = F.ws + Z_KV8; const bf16* OB = (const bf16*)(F.ws + Z_XR);
    const GAS unsigned short* IDX = (const GAS unsigned short*)(F.ws + WS_IDX);
    LAS float* lg = (LAS float*)(F.lds + RING_OFF + 65536);
    const int tok = F.bx * 256 + ((F.bx * 37) & 255), b = tok >> 11, tq = tok & (SEQ - 1), n_adm = ((tq >> 6) + 1) * 64, nv = n_adm < 256 ? n_adm : 256;
    const int lane = F.lane;
    for (int p = lane; p < 256; p += 64) { const int key = IDX[(size_t)tok * 256 + p]; const int bk = sc_bucket_ref(key - tq);
        for (int h = 0; h < 16; ++h) { float d = 0.f;
            for (int k = 0; k < 64; ++k) d += sc_f8(Q8, (size_t)tok * D + h * 64 + k) * sc_f8(KV8, (size_t)(b * SEQ + key) * 128 + k);
            lg[h * 256 + p] = p < nv ? 0.125f * d + ((const GAS float*)ka->in[I_RELB])[bk * 16 + h] : -1e30f; } }
    asm volatile("s_waitcnt lgkmcnt(0)" ::: "memory");
    if (lane < 16) { float mx = -3.0e38f; for (int p = 0; p < 256; ++p) mx = fmaxf(mx, lg[lane * 256 + p]); float sum = 0.f;
        for (int p = 0; p < 256; ++p) { const float e = __expf(lg[lane * 256 + p] - mx); lg[lane * 256 + p] = e; sum += e; }
        const float inv = 1.f / sum; for (int p = 0; p < 256; ++p) lg[lane * 256 + p] *= inv; }
    asm volatile("s_waitcnt lgkmcnt(0)" ::: "memory");
    float emax = 0.f, omax = 0.f;
    for (int o = lane; o < 1024; o += 64) { const int h = o >> 6, d = o & 63; float acc = 0.f;
        for (int p = 0; p < 256; ++p) { const int key = IDX[(size_t)tok * 256 + p]; acc += lg[h * 256 + p] * sc_f8(KV8, (size_t)(b * SEQ + key) * 128 + 64 + d); }
        const float got = sc_bf(OB, (size_t)tok * D + o); emax = fmaxf(emax, fabsf(got - acc)); omax = fmaxf(omax, fabsf(acc)); }
#pragma unroll
    for (int o = 1; o < 64; o <<= 1) { emax = fmaxf(emax, lane_xor(emax, o, lane)); omax = fmaxf(omax, lane_xor(omax, o, lane)); }
    if (!(emax <= SC_TOL * omax + SC_ABS)) { if (lane == 0) sc_fail(F, 2u); }
}
__device__ __forceinline__ void selfcheck_lru(const Frame& F0, int L, bool after) {
    Frame F = launder(F0);
    if (F.wave != 0) return;
    const KArgs ka = kargs();
    const bf16* XR = (const bf16*)(F.ws + Z_XR); const bf16* YR = (const bf16*)(F.ws + Z_YR);
    GAS float* EXP = (GAS float*)(F.ws + WS_NEED) + (size_t)F.bx * SEQ;
    const int b = F.bx >> 3, ch = ((F.bx & 7) * 128 + ((F.bx * 29) & 127)), nb = ch >> 7, lane = F.lane;
    if (after) { float emax = 0.f, omax = 0.f;
        for (int t = lane; t < SEQ; t += 64) { const float e = EXP[t], g = sc_bf(YR, (size_t)(b * SEQ + t) * D + ch); emax = fmaxf(emax, fabsf(e - g)); omax = fmaxf(omax, fabsf(e)); }
#pragma unroll
        for (int o = 1; o < 64; o <<= 1) { emax = fmaxf(emax, lane_xor(emax, o, lane)); omax = fmaxf(omax, lane_xor(omax, o, lane)); }
        if (!(emax <= SC_TOL * omax + SC_ABS)) { if (lane == 0) sc_fail(F, 4u); }
        return; }
    const float* cw = ka->in[I_CONVW] + (size_t)L * 4 * D; const float* cb = ka->in[I_CONVB] + (size_t)L * D;
    const float* wa = ka->in[I_LRUWA] + ((size_t)L * 8 + nb) * 128 * 128; const float* wx = ka->in[I_LRUWX] + ((size_t)L * 8 + nb) * 128 * 128;
    const float lam = ka->in[I_LAM][(size_t)L * D + ch], ba = ka->in[I_LRUBA][(size_t)L * D + ch], bx = ka->in[I_LRUBX][(size_t)L * D + ch];
    const float sp = fmaxf(-lam, 0.f) + log1pf(expf(-fabsf(lam)));
    const int dl = ch & 127;
    float h = 0.f;
    for (int t = 0; t < SEQ; ++t) {
        float pr = 0.f, pi = 0.f, xcc = 0.f;
#pragma unroll
        for (int q = 0; q < 2; ++q) { const int cl = lane + 64 * q, cg = nb * 128 + cl; float xc = cb[cg];
            for (int j = 0; j < 4; ++j) { const int tt = t - 3 + j; if (tt >= 0) xc += sc_bf(XR, (size_t)(b * SEQ + tt) * D + cg) * cw[j * D + cg]; }
            pr += xc * wa[cl * 128 + dl]; pi += xc * wx[cl * 128 + dl]; if (cl == dl) xcc = xc; }
#pragma unroll
        for (int o = 1; o < 64; o <<= 1) { pr += lane_xor(pr, o, lane); pi += lane_xor(pi, o, lane); xcc += lane_xor(xcc, o, lane); }
        const float r = 1.f / (1.f + expf(-(pr + ba))), ig = 1.f / (1.f + expf(-(pi + bx)));
        const float la = -8.0f * r * sp, a = expf(la), u = sqrtf(-expm1f(2.0f * la)) * (ig * xcc);
        h = a * h + u;
        const float y = sc_bf(YR, (size_t)(b * SEQ + t) * D + ch);
        const float gl = 0.5f * y * (1.f + tanhf(0.7978845608028654f * (y + 0.044715f * y * y * y)));
        if (lane == 0) EXP[t] = h * gl;
    }
}
#endif
__global__ void __launch_bounds__(NWAVES * 64, 2) mk_fwd(Args args) {
    extern __shared__ __attribute__((aligned(16))) unsigned char lds[];
    Frame F;
    F.lds = (LAS unsigned char*)lds;
    F.MISC = (volatile LAS unsigned*)(F.lds + MISC_OFF);
    F.tid = threadIdx.x; F.lane = F.tid & 63; F.wave = __builtin_amdgcn_readfirstlane(F.tid >> 6);
    F.G = gridDim.x; F.bx = blockIdx.x;
    F.ws = args.ws; F.ctl = (gu32*)(args.ws + WS_CTL); F.out = args.out;
    for (int u = threadIdx.x; u < (LDS_BYTES - LDSCTL_OFF) / 4; u += NWAVES * 64) ((LAS unsigned*)(F.lds + LDSCTL_OFF))[u] = 0u;
    __syncthreads();
    XcdBarrier bar = xcd_barrier_post((unsigned*)(F.ctl + CW_BAR), F.MISC + 8);
#define GRID_BAR() do { XcdBarrier b_ = bar; unsigned* p_ = bar.bar; asm volatile("" : "+s"(p_)); b_.bar = p_; xcd_barrier(b_); } while (0)
    float* X32 = args.out;
#define LOCAL_HANDOFF() do { asm volatile("s_waitcnt vmcnt(0)" ::: "memory"); __syncthreads(); __builtin_amdgcn_fence(__ATOMIC_ACQUIRE, "agent"); asm volatile("s_waitcnt vmcnt(0)" ::: "memory"); __syncthreads(); } while (0)
    LAS unsigned char* ring = F.lds + RING_OFF;
    using pg8::Gemm; using pg8::StaticOrder;

    for (int L = 0; L < DEPTH; ++L) {
        const int odd = L & 1;
#ifndef SK_P0
        p0_convert(F, L);
#endif
#ifdef DUP_P0
        __syncthreads(); p0_convert(F, L);
#endif
        GRID_BAR();
        { const Frame P = launder(F); unsigned char* ws = P.ws; unsigned char* wb = ws + WS_W; bf16* XB = (bf16*)(ws + WS_XB); (void)XB; (void)wb;
          Gemm g{XB, (const bf16*)(wb + W_IN), T_TOK, NIN, D}; StaticOrder S; S.init(T_TOK, NIN, P.G, P.bx);
          pg8::EpiZ E{(bf16*)(ws + Z_Q), (bf16*)(ws + Z_QI), (bf16*)(ws + Z_SM), ws + Z_Q8, ws + Z_KV8};
#ifndef SK_G1
          pg8::gemm_phase<pg8::EpiZ, StaticOrder>(ring, g, S, E, P.wave);
#endif
        }
        GRID_BAR();
#if defined(SELFCHECK) && SELFCHECK == 3
        if (L == 0) { selfcheck_lru(F, L, false); __syncthreads(); }
#endif
#ifndef SK_IDX
        indexer_phase(F);
#endif
#ifdef DUP_IDX
        indexer_phase(F);
#endif
#ifdef DUP_LRU
        lru_phase<true>(F, L);
#endif
#ifndef SK_LRU
        lru_phase(F, L);
#endif
        GRID_BAR();
#if defined(SELFCHECK) && SELFCHECK == 1
        if (L == 0) { selfcheck_topk(F); __syncthreads(); }
#endif
#if defined(SELFCHECK) && SELFCHECK == 3
        if (L == 0) { selfcheck_lru(F, L, true); __syncthreads(); }
#endif
#ifdef DUP_ATT
        attention_phase<DUP_ATT>(F); __syncthreads();
#endif
#ifndef SK_ATT
        attention_phase(F);
#endif
        GRID_BAR();
#if defined(SELFCHECK) && SELFCHECK == 2
        if (L == 0) { selfcheck_attn(F); __syncthreads(); }
#endif
        { const Frame P = launder(F); unsigned char* ws = P.ws; unsigned char* wb = ws + WS_W; bf16* XB = (bf16*)(ws + WS_XB); (void)XB; (void)wb;
          Gemm g{(const bf16*)(ws + Z_XR), (const bf16*)(wb + W_BRA), T_TOK, D, D}; StaticOrder S; S.init(T_TOK, D, F.G, F.bx);
          pg8::EpiGate<0> E{(bf16*)(ws + Z_GA), nullptr};
#ifndef SK_G2
          pg8::gemm_phase<pg8::EpiGate<0>, StaticOrder>(ring, g, S, E, P.wave);
#endif
        }
        LOCAL_HANDOFF();
        { const Frame P = launder(F); unsigned char* ws = P.ws; unsigned char* wb = ws + WS_W; bf16* XB = (bf16*)(ws + WS_XB); (void)XB; (void)wb;
          Gemm g{(const bf16*)(ws + Z_YR), (const bf16*)(wb + W_BRR), T_TOK, D, D}; StaticOrder S; S.init(T_TOK, D, F.G, F.bx);
          pg8::EpiGate<1> E{(bf16*)(ws + Z_GA), (const bf16*)(ws + Z_GR)};
#ifndef SK_G3
          pg8::gemm_phase<pg8::EpiGate<1>, StaticOrder>(ring, g, S, E, P.wave);
#endif
        }
        GRID_BAR();
        { const Frame P = launder(F); unsigned char* ws = P.ws; unsigned char* wb = ws + WS_W; bf16* XB = (bf16*)(ws + WS_XB); (void)XB; (void)wb;
          Gemm g{(const bf16*)(ws + Z_GA), (const bf16*)(wb + W_O), T_TOK, D, D}; StaticOrder S; S.init(T_TOK, D, F.G, F.bx);
          pg8::EpiRes<0> E{X32, XB, nullptr};
#ifndef SK_G4
          pg8::gemm_phase<pg8::EpiRes<0>, StaticOrder>(ring, g, S, E, P.wave);
#endif
        }
        GRID_BAR();
#ifdef DUP_LN
        ln_phase<false, false, true>(F, L); ln_phase<false, false, true>(F, L);
#endif
#ifndef SK_LN
        if (odd) ln_phase<false, true>(F, L); else ln_phase<false, false>(F, L);
#endif
        GRID_BAR();
        if (odd) {
            if (launder(F).tid == 0) { unsigned acc = 0u; F.MISC[16] = 0u;
                for (int e = 0; e < 8; ++e) { const unsigned c = __hip_atomic_load(F.ctl + CW_CNT + (L >> 1) * 1024 + 64 * e, RLX_AGENT); F.MISC[32 + e] = c; acc += (c + 255u) >> 8; F.MISC[17 + e] = acc; } }
            __syncthreads();
        }
        { const Frame P = launder(F); unsigned char* ws = P.ws; unsigned char* wb = ws + WS_W; bf16* XB = (bf16*)(ws + WS_XB); (void)XB; (void)wb;
          Gemm g{(const bf16*)(ws + F_PB), (const bf16*)(wb + W_PP), T_TOK, D, PLE}; StaticOrder S; S.init(T_TOK, D, F.G, F.bx);
          pg8::EpiBf16 E{(bf16*)(ws + F_U), D, 0};
#ifndef SK_G5
          pg8::gemm_phase<pg8::EpiBf16, StaticOrder>(ring, g, S, E, P.wave);
#endif
        }
        LOCAL_HANDOFF();
        { const Frame P = launder(F); unsigned char* ws = P.ws; unsigned char* wb = ws + WS_W; bf16* XB = (bf16*)(ws + WS_XB); (void)XB; (void)wb;
          Gemm g{XB, (const bf16*)(wb + W_PG), T_TOK, D, D}; StaticOrder S; S.init(T_TOK, D, F.G, F.bx);
          pg8::EpiRes<1> E{X32, XB, (const bf16*)(ws + F_U)};
#ifndef SK_G6
          pg8::gemm_phase<pg8::EpiRes<1>, StaticOrder>(ring, g, S, E, P.wave);
#endif
        }
        if (!odd) {
            { const Frame P = launder(F); unsigned char* ws = P.ws; unsigned char* wb = ws + WS_W; bf16* XB = (bf16*)(ws + WS_XB); (void)XB; (void)wb;
          Gemm g{XB, (const bf16*)(wb + W_FF), T_TOK, 2 * DFF, D}; StaticOrder S; S.init(T_TOK, 2 * DFF, F.G, F.bx);
              pg8::EpiSwiglu E{(bf16*)(ws + F_H), DFF};
#ifndef SK_G7
              pg8::gemm_phase<pg8::EpiSwiglu, StaticOrder>(ring, g, S, E, P.wave);
#endif
        }
            GRID_BAR();
            { const Frame P = launder(F); unsigned char* ws = P.ws; unsigned char* wb = ws + WS_W; bf16* XB = (bf16*)(ws + WS_XB); (void)XB; (void)wb;
          Gemm g{(const bf16*)(ws + F_H), (const bf16*)(wb + W_FF_DN_DENSE), T_TOK, D, DFF}; StaticOrder S; S.init(T_TOK, D, F.G, F.bx);
              pg8::EpiRes<2> E{X32, nullptr, nullptr};
#ifndef SK_G8
              pg8::gemm_phase<pg8::EpiRes<2>, StaticOrder>(ring, g, S, E, P.wave);
#endif
        }
            GRID_BAR();
#ifndef SK_LN
            ln_phase<true, false>(F, L);
#endif
        } else {
            const int ntiles = (int)F.MISC[24];
            const int nchunks = (ntiles + MOE_CHUNK_TILES - 1) / MOE_CHUNK_TILES;
            for (int c = 0; c < nchunks; ++c) {
                const int tile0 = c * MOE_CHUNK_TILES, ntl = (ntiles - tile0) < MOE_CHUNK_TILES ? (ntiles - tile0) : MOE_CHUNK_TILES;
                const size_t hc_off = (c & 1) ? F_H1 : F_H;
                { const Frame P = launder(F); unsigned char* ws = P.ws; unsigned char* wb = ws + WS_W; bf16* XB = (bf16*)(ws + WS_XB); (void)XB; (void)wb;
          Gemm g{XB, (const bf16*)(wb + W_FF), ntl * 256, 2 * DFFE, D}; MoeGatherOrder S; S.init(ntl * 256, 2 * DFFE, F.G, F.bx);
                  S.tb = F.MISC + 16; S.tile0 = tile0; S.list = (const int*)(ws + WS_LIST); S.bstride = (size_t)2 * DFFE * D * 2;
                  pg8::EpiSwiglu E{(bf16*)(ws + hc_off), DFFE};
#ifndef SK_G9
                  pg8::gemm_phase<pg8::EpiSwiglu, MoeGatherOrder>(ring, g, S, E, P.wave);
#endif
        }
                GRID_BAR();
                { const Frame P = launder(F); unsigned char* ws = P.ws; unsigned char* wb = ws + WS_W; bf16* XB = (bf16*)(ws + WS_XB); (void)XB; (void)wb;
          Gemm g{(const bf16*)(ws + hc_off), (const bf16*)(wb + W_FF_DN_MOE), ntl * 256, D, DFFE}; MoeOrder S; S.init(ntl * 256, D, F.G, F.bx);
                  S.tb = F.MISC + 16; S.tile0 = tile0; S.list = nullptr; S.bstride = (size_t)D * DFFE * 2;
                  pg8::EpiBf16 E{(bf16*)(ws + F_YE), D, tile0 * 256};
#ifndef SK_G10
                  pg8::gemm_phase<pg8::EpiBf16, MoeOrder>(ring, g, S, E, P.wave);
#endif
        }
            }
            GRID_BAR();
#ifndef SK_LN
            ln_phase<true, true>(F, L);
#endif
        }
        GRID_BAR();
    }
    if (__hip_atomic_load(F.ctl + CW_BAR + XB_TMO, RLX_AGENT) != 0u || __hip_atomic_load(F.ctl + CW_CODE, RLX_AGENT) != 0u) {
        const float q = __builtin_nanf("");
        for (size_t i = (size_t)F.bx * 512 + launder(F).tid; i < (size_t)T_TOK * D; i += (size_t)F.G * 512) X32[i] = q;
    }
}

#if defined(SELFCHECK)
constexpr size_t WS_DRY_EXTRA = 4 * MiB;
#elif defined(DUP_LRU) || defined(DUP_LN)
constexpr size_t WS_DRY_EXTRA = 80 * MiB;
#else
constexpr size_t WS_DRY_EXTRA = 0;
#endif
extern "C" void kernel_launch(void* const* d_in, const int* in_sizes, int n_in, void* d_out, int out_size, void* d_ws, size_t ws_size, hipStream_t stream) {
    static int grid = 0;
    if (grid == 0) {
        if (n_in != 28 || out_size != T_TOK * D || ws_size < WS_NEED + WS_DRY_EXTRA) { fprintf(stderr, "kernel_launch: unexpected shapes: n_in %d out %d ws %zu (need %zu)\n", n_in, out_size, ws_size, (size_t)WS_END); grid = -1; return; }
        int dev = 0, cus = 0, per_cu = 0;
        if (hipGetDevice(&dev) != hipSuccess || hipDeviceGetAttribute(&cus, hipDeviceAttributeMultiprocessorCount, dev) != hipSuccess) { grid = -1; return; }
        if (hipFuncSetAttribute((const void*)mk_fwd, hipFuncAttributeMaxDynamicSharedMemorySize, LDS_BYTES) != hipSuccess) { fprintf(stderr, "kernel_launch: hipFuncSetAttribute failed\n"); grid = -1; return; }
        if (hipOccupancyMaxActiveBlocksPerMultiprocessor(&per_cu, (const void*)mk_fwd, NWAVES * 64, LDS_BYTES) != hipSuccess || per_cu < 1) { fprintf(stderr, "kernel_launch: occupancy query says %d blocks per CU\n", per_cu); }
        (void)hipGetLastError();
        grid = cus;
        if (grid != 256) { fprintf(stderr, "kernel_launch: this kernel needs a 256-CU device (got %d)\n", cus); grid = -1; return; }
    }
    if (grid < 0) return;
    if (hipMemsetAsync((char*)d_ws + WS_CTL, 0, CTL_ZERO_BYTES, stream) != hipSuccess) return;
    Args a{};
    for (int i = 0; i < 28; ++i) a.in[i] = (const float*)d_in[i];
    a.out = (float*)d_out; a.ws = (unsigned char*)d_ws;
    hipLaunchKernelGGL(mk_fwd, dim3(grid), dim3(NWAVES * 64), LDS_BYTES, stream, a);
}
```

```cpp
#include <hip/hip_runtime.h>
#include <cstdio>
#include <cstdint>

constexpr int T_TOK = 65536, D = 1024, SEQ = 2048, NBATCH = 32, DEPTH = 4;
constexpr int D_IN = 5832, NIN = 5888;
constexpr int DFF = 2816, DFFE = 3584, NEXP = 8, PLE = 256;
constexpr float LN_EPS = 1e-5f;
constexpr float DN_ALPHA = 1.681792830507429f;

namespace pg8 {
#define PG8_LAS __attribute__((address_space(3)))
typedef unsigned short bf16_t;
typedef short bf16x8 __attribute__((ext_vector_type(8)));
typedef float f32x4 __attribute__((ext_vector_type(4)));
typedef unsigned u32x4 __attribute__((ext_vector_type(4)));
typedef unsigned u32x2 __attribute__((ext_vector_type(2)));
constexpr int BM = 256, BK = 64, HALF = 128, HTB = HALF * BK * 2  , STAGE_BYTES = 8 * HTB, NXCD = 8, WGM = 8;

__host__ __device__ __forceinline__ int lds_byte(int r, int c) { const int st = (r >> 4) * 2 + (c >> 5), rr = r & 15, cc = c & 31, ob = rr * 64 + cc * 2; return st * 1024 + (ob ^ (((ob >> 9) & 1) << 5)); }
__host__ __device__ __forceinline__ void stage_rc(int b, int& R, int& C) { const int st = b / 1024, sb = b % 1024, swz = sb ^ (((sb >> 9) & 1) << 5); R = (st >> 1) * 16 + swz / 64; C = (st & 1) * 32 + (swz % 64) / 2; }
__host__ __device__ __forceinline__ int perm32(int rho) { const int n = rho >> 4, i = rho & 15; return 8 * (i >> 2) + 4 * n + (i & 3); }

struct Unit { int pm, pn; };
struct Gemm { const bf16_t* A; const bf16_t* Bt; int M, N, K; };

struct StaticOrder {
    static constexpr bool GATHER = false;
    int nM, nN, nwg, G, c;
    __host__ __device__ void init(int M, int N, int G_, int c_) { nM = M / BM; nN = N / BM; nwg = nM * nN; G = G_; c = c_; }
    __host__ __device__ bool next(int i, Unit& u) const {
        const long L = (long)i * G + c; if (L >= nwg) return false;
        int wgid = (int)L; { const int q = nwg / NXCD, r = nwg % NXCD, xcd = wgid % NXCD, off = wgid / NXCD; wgid = (xcd < r ? xcd * (q + 1) : r * (q + 1) + (xcd - r) * q) + off; }
        const int nig = WGM * nN, gid = wgid / nig, fm = gid * WGM, gsz = (nM - fm) < WGM ? (nM - fm) : WGM;
        u.pm = fm + ((wgid % nig) % gsz); u.pn = (wgid % nig) / gsz; return true;
    }
    __device__ __forceinline__ const char* a_base(const Gemm& g, const Unit& u, size_t tstep) const { return (const char*)g.A + (size_t)u.pm * tstep; }
    __device__ __forceinline__ const char* b_base(const Gemm& g, const Unit& u, size_t tstep) const { return (const char*)g.Bt + (size_t)u.pn * tstep; }
    __device__ __forceinline__ void a_rows(const Unit&, int, int, int, int, int, unsigned (&)[2][2]) const {}
    __device__ __forceinline__ void a_ready(const Unit&) const {}
    __device__ __forceinline__ void done(const Unit&) const {}
};

__device__ __forceinline__ unsigned cvt_pk_bf16(float lo, float hi) { unsigned r; asm volatile("v_cvt_pk_bf16_f32 %0, %1, %2" : "=v"(r) : "v"(lo), "v"(hi)); return r; }
__device__ __forceinline__ float bf_lo(unsigned w) { return __builtin_bit_cast(float, w << 16); }
__device__ __forceinline__ float bf_hi(unsigned w) { return __builtin_bit_cast(float, w & 0xffff0000u); }
__device__ __forceinline__ float sigmoidf_fast(float x) { return __builtin_amdgcn_rcpf(1.0f + __builtin_amdgcn_exp2f(-1.4426950408889634f * x)); }
#define EPI_FENCE() asm volatile("" ::: "memory")
#define EGAS __attribute__((address_space(1)))
__device__ __forceinline__ u32x4 pack8(const f32x4 v0, const f32x4 v1) { u32x4 w; w.x = cvt_pk_bf16(v0[0], v0[1]); w.y = cvt_pk_bf16(v0[2], v0[3]); w.z = cvt_pk_bf16(v1[0], v1[1]); w.w = cvt_pk_bf16(v1[2], v1[3]); return w; }

struct EpiBf16 {
    static constexpr bool PERM = true, AFTER_DRAIN = false;
    bf16_t* O; int ldc; int row_off;
    __device__ __forceinline__ void operator()(const f32x4 (&acc)[2][2][4][2], const Unit& u, int wr, int wc, int fr, int fq) const {
        { int l_ = (int)__builtin_amdgcn_mbcnt_hi(~0u, __builtin_amdgcn_mbcnt_lo(~0u, 0u)); asm volatile("" : "+v"(l_)); fr = l_ & 15; fq = l_ >> 4; }
        const int row0 = row_off + u.pm * BM + wr * 64 + fr, col0 = u.pn * BM + wc * 32 + 8 * fq;
#pragma unroll
        for (int ai = 0; ai < 2; ++ai)
#pragma unroll
            for (int m = 0; m < 4; ++m) { bf16_t* rowp = O + (size_t)(row0 + ai * HALF + m * 16) * ldc + col0;
#pragma unroll
                for (int bj = 0; bj < 2; ++bj) *(EGAS u32x4*)(rowp + bj * HALF) = pack8(acc[ai][bj][m][0], acc[ai][bj][m][1]); }
    }
};
__device__ __forceinline__ u32x2 pack8_fp8(const f32x4 v0, const f32x4 v1) { int a = __builtin_amdgcn_cvt_pk_fp8_f32(v0[0], v0[1], 0, false); a = __builtin_amdgcn_cvt_pk_fp8_f32(v0[2], v0[3], a, true);
    int b = __builtin_amdgcn_cvt_pk_fp8_f32(v1[0], v1[1], 0, false); b = __builtin_amdgcn_cvt_pk_fp8_f32(v1[2], v1[3], b, true); u32x2 r; r.x = (unsigned)a; r.y = (unsigned)b; return r; }
struct EpiZ {
    static constexpr bool PERM = true, AFTER_DRAIN = false;
    bf16_t* zbig; bf16_t* zqi; bf16_t* zsm; unsigned char* q8; unsigned char* kv8;
    __device__ __forceinline__ void operator()(const f32x4 (&acc)[2][2][4][2], const Unit& u, int wr, int wc, int fr, int fq) const {
        { int l_ = (int)__builtin_amdgcn_mbcnt_hi(~0u, __builtin_amdgcn_mbcnt_lo(~0u, 0u)); asm volatile("" : "+v"(l_)); fr = l_ & 15; fq = l_ >> 4; }
        const int row0 = u.pm * BM + wr * 64 + fr;
        if (u.pn < 4) {
            const int col0 = u.pn * BM + wc * 32 + 8 * fq;
#pragma unroll
            for (int ai = 0; ai < 2; ++ai)
#pragma unroll
                for (int m = 0; m < 4; ++m) { unsigned char* rowp = q8 + (size_t)(row0 + ai * HALF + m * 16) * D + col0;
#pragma unroll
                    for (int bj = 0; bj < 2; ++bj) *(EGAS u32x2*)(rowp + bj * HALF) = pack8_fp8(acc[ai][bj][m][0], acc[ai][bj][m][1]); }
            return;
        }
        bf16_t* base; int ld, colt;
        if (u.pn < 20) { base = zbig + (size_t)(u.pn >> 2) * ((size_t)T_TOK * D); ld = D; colt = (u.pn & 3) * BM; }
        else if (u.pn < 22) { base = zqi; ld = 512; colt = (u.pn - 20) * BM; }
        else { base = zsm; ld = 256; colt = 0; }
        const int col0 = colt + wc * 32 + 8 * fq;
#pragma unroll
        for (int ai = 0; ai < 2; ++ai)
#pragma unroll
            for (int m = 0; m < 4; ++m) { bf16_t* rowp = base + (size_t)(row0 + ai * HALF + m * 16) * ld + col0;
#pragma unroll
                for (int bj = 0; bj < 2; ++bj) *(EGAS u32x4*)(rowp + bj * HALF) = pack8(acc[ai][bj][m][0], acc[ai][bj][m][1]); }
        if (u.pn == 22) {
#pragma unroll
            for (int ai = 0; ai < 2; ++ai)
#pragma unroll
                for (int m = 0; m < 4; ++m) *(EGAS u32x2*)(kv8 + (size_t)(row0 + ai * HALF + m * 16) * 128 + wc * 32 + 8 * fq) = pack8_fp8(acc[ai][0][m][0], acc[ai][0][m][1]);
        }
    }
};
template <int MODE> struct EpiGate {
    static constexpr bool PERM = true, AFTER_DRAIN = false;
    bf16_t* G; const bf16_t* G2;
    __device__ __forceinline__ void operator()(const f32x4 (&acc)[2][2][4][2], const Unit& u, int wr, int wc, int fr, int fq) const {
        { int l_ = (int)__builtin_amdgcn_mbcnt_hi(~0u, __builtin_amdgcn_mbcnt_lo(~0u, 0u)); asm volatile("" : "+v"(l_)); fr = l_ & 15; fq = l_ >> 4; }
        const int row0 = u.pm * BM + wr * 64 + fr, col0 = u.pn * BM + wc * 32 + 8 * fq;
#pragma unroll
        for (int ai = 0; ai < 2; ++ai) {
            u32x4 gw[4][2], g2[4][2];
#pragma unroll
            for (int m = 0; m < 4; ++m)
#pragma unroll
                for (int bj = 0; bj < 2; ++bj) { const size_t o = (size_t)(row0 + ai * HALF + m * 16) * D + col0 + bj * HALF;
                    gw[m][bj] = *(const EGAS u32x4*)(G + o); if (MODE == 1) g2[m][bj] = *(const EGAS u32x4*)(G2 + o); }
#pragma unroll
            for (int m = 0; m < 4; ++m)
#pragma unroll
                for (int bj = 0; bj < 2; ++bj) { const size_t o = (size_t)(row0 + ai * HALF + m * 16) * D + col0 + bj * HALF;
                    f32x4 v0 = acc[ai][bj][m][0], v1 = acc[ai][bj][m][1];
#pragma unroll
                    for (int j = 0; j < 4; ++j) { const unsigned wa = gw[m][bj][j >> 1], wb = gw[m][bj][2 + (j >> 1)];
                        const float ga = (j & 1) ? bf_hi(wa) : bf_lo(wa), gb = (j & 1) ? bf_hi(wb) : bf_lo(wb);
                        if (MODE == 0) { v0[j] *= sigmoidf_fast(ga); v1[j] *= sigmoidf_fast(gb); }
                        else { const unsigned xa = g2[m][bj][j >> 1], xb = g2[m][bj][2 + (j >> 1)];
                            v0[j] = ga + v0[j] * sigmoidf_fast((j & 1) ? bf_hi(xa) : bf_lo(xa)); v1[j] = gb + v1[j] * sigmoidf_fast((j & 1) ? bf_hi(xb) : bf_lo(xb)); } }
                    *(EGAS u32x4*)(G + o) = pack8(v0, v1); }
            EPI_FENCE(); }
    }
};
template <int MODE> struct EpiRes {
    static constexpr bool PERM = false, AFTER_DRAIN = false;
    float* Y; const bf16_t* XB; const bf16_t* U;
    __device__ __forceinline__ void operator()(const f32x4 (&acc)[2][2][4][2], const Unit& u, int wr, int wc, int fr, int fq) const {
        { int l_ = (int)__builtin_amdgcn_mbcnt_hi(~0u, __builtin_amdgcn_mbcnt_lo(~0u, 0u)); asm volatile("" : "+v"(l_)); fr = l_ & 15; fq = l_ >> 4; }
        const int row0 = u.pm * BM + wr * 64 + fr, col0 = u.pn * BM + wc * 32 + 4 * fq;
#pragma unroll
        for (int ai = 0; ai < 2; ++ai) {
            u32x2 xw[4][2][2], uw[4][2][2]; f32x4 yv[4][2][2];
#pragma unroll
            for (int m = 0; m < 4; ++m)
#pragma unroll
                for (int bj = 0; bj < 2; ++bj)
#pragma unroll
                    for (int n = 0; n < 2; ++n) { const size_t o = (size_t)(row0 + ai * HALF + m * 16) * D + col0 + bj * HALF + n * 16;
                        if (MODE == 0 || MODE == 1) xw[m][bj][n] = *(const EGAS u32x2*)(XB + o);
                        if (MODE == 1) uw[m][bj][n] = *(const EGAS u32x2*)(U + o);
                        if (MODE == 2) yv[m][bj][n] = *(const EGAS f32x4*)(Y + o); }
#pragma unroll
            for (int m = 0; m < 4; ++m)
#pragma unroll
                for (int bj = 0; bj < 2; ++bj)
#pragma unroll
                    for (int n = 0; n < 2; ++n) { const size_t o = (size_t)(row0 + ai * HALF + m * 16) * D + col0 + bj * HALF + n * 16; const f32x4 a = acc[ai][bj][m][n]; f32x4 r;
                        if (MODE == 0) { const u32x2 x = xw[m][bj][n];
                            r[0] = bf_lo(x.x) * DN_ALPHA + a[0]; r[1] = bf_hi(x.x) * DN_ALPHA + a[1]; r[2] = bf_lo(x.y) * DN_ALPHA + a[2]; r[3] = bf_hi(x.y) * DN_ALPHA + a[3]; }
                        else if (MODE == 1) { const u32x2 x = xw[m][bj][n], w = uw[m][bj][n];
                            r[0] = bf_lo(x.x) * DN_ALPHA + sigmoidf_fast(a[0]) * bf_lo(w.x); r[1] = bf_hi(x.x) * DN_ALPHA + sigmoidf_fast(a[1]) * bf_hi(w.x);
                            r[2] = bf_lo(x.y) * DN_ALPHA + sigmoidf_fast(a[2]) * bf_lo(w.y); r[3] = bf_hi(x.y) * DN_ALPHA + sigmoidf_fast(a[3]) * bf_hi(w.y); }
                        else r = yv[m][bj][n] + a;
                        *(EGAS f32x4*)(Y + o) = r; }
            EPI_FENCE(); }
    }
};
struct EpiSwiglu {
    static constexpr bool PERM = true, AFTER_DRAIN = false;
    bf16_t* H; int ldh;
    __device__ __forceinline__ void operator()(const f32x4 (&acc)[2][2][4][2], const Unit& u, int wr, int wc, int fr, int fq) const {
        { int l_ = (int)__builtin_amdgcn_mbcnt_hi(~0u, __builtin_amdgcn_mbcnt_lo(~0u, 0u)); asm volatile("" : "+v"(l_)); fr = l_ & 15; fq = l_ >> 4; }
        const int row0 = u.pm * BM + wr * 64 + fr, col0 = u.pn * HALF + wc * 32 + 8 * fq;
#pragma unroll
        for (int ai = 0; ai < 2; ++ai)
#pragma unroll
            for (int m = 0; m < 4; ++m) { bf16_t* rowp = H + (size_t)(row0 + ai * HALF + m * 16) * ldh + col0;
                f32x4 v0, v1;
#pragma unroll
                for (int j = 0; j < 4; ++j) { const float g0 = acc[ai][0][m][0][j], g1 = acc[ai][0][m][1][j];
                    v0[j] = g0 * sigmoidf_fast(g0) * acc[ai][1][m][0][j]; v1[j] = g1 * sigmoidf_fast(g1) * acc[ai][1][m][1][j]; }
                *(EGAS u32x4*)rowp = pack8(v0, v1); }
    }
};
template <class Epi, class Sched, bool ALIGN_EPI = true>
__device__ __forceinline__ void gemm_phase(PG8_LAS unsigned char* lds, const Gemm g, const Sched& S, const Epi& E, const int wave_id) {
    int lane_ = (int)__builtin_amdgcn_mbcnt_hi(~0u, __builtin_amdgcn_mbcnt_lo(~0u, 0u)); asm volatile("" : "+v"(lane_));
    const int wid = wave_id, lane = lane_, tid = wid * 64 + lane, wr = wid >> 2, wc = wid & 3, fr = lane & 15, fq = lane >> 4;
    const int K = g.K, nt = K / BK;
    unsigned voffA[2], voffB[2]; int RA[2], CA[2];
#pragma unroll
    for (int i = 0; i < 2; ++i) { int R, C; stage_rc(tid * 16 + i * 8192, R, C); const int Rb = Epi::PERM ? ((R & ~31) + perm32(R & 31)) : R; RA[i] = R; CA[i] = C;
        voffA[i] = (unsigned)(R * K + C) * 2u; voffB[i] = (unsigned)(Rb * K + C) * 2u; }
    const size_t kstep = (size_t)(BK * 2);
    const size_t hstep = (size_t)HALF * K * 2;
    const size_t tstep = 2 * hstep;
    const unsigned ldsw = (unsigned)wid * 1024u;
    const int aoff = lds_byte(wr * 64 + fr, fq * 8), boff = lds_byte(wc * 32 + fr, fq * 8);
    unsigned offC[2][2] = {{0u, 0u}, {0u, 0u}}, offN[2][2] = {{0u, 0u}, {0u, 0u}};
#define PG8_SA(b, h) (((b) * 2 + (h)) * HTB)
#define PG8_SB(b, h) ((4 + (b) * 2 + (h)) * HTB)
#define PG8_STAGE(bufoff, gbase, voff) do { _Pragma("unroll") for (int _i = 0; _i < 2; ++_i) \
        __builtin_amdgcn_global_load_lds((const unsigned*)((const char*)(gbase) + (voff)[_i]), (PG8_LAS unsigned*)(lds + (bufoff) + ldsw + _i * 8192), 16, 0, 0); } while (0)
#define PG8_STA(bufoff, ptr, h, NX) do { if constexpr (Sched::GATHER) { _Pragma("unroll") for (int _i = 0; _i < 2; ++_i) { const unsigned _o = (NX) ? offN[h][_i] : offC[h][_i]; \
        __builtin_amdgcn_global_load_lds((const unsigned*)((const char*)(ptr) + _o), (PG8_LAS unsigned*)(lds + (bufoff) + ldsw + _i * 8192), 16, 0, 0); } } \
        else { PG8_STAGE(bufoff, (ptr) + (h) * hstep, voffA); } } while (0)
#define PG8_LDA(dst, b, h) do { _Pragma("unroll") for (int m = 0; m < 4; ++m) _Pragma("unroll") for (int k = 0; k < 2; ++k) dst[m][k] = *(const PG8_LAS bf16x8*)(lds + PG8_SA(b, h) + aoff + m * 2048 + k * 1024); } while (0)
#define PG8_LDB(dst, b, h) do { _Pragma("unroll") for (int n = 0; n < 2; ++n) _Pragma("unroll") for (int k = 0; k < 2; ++k) dst[n][k] = *(const PG8_LAS bf16x8*)(lds + PG8_SB(b, h) + boff + n * 2048 + k * 1024); } while (0)
#define PG8_MMA(ai, bj, At, Bt) do { __builtin_amdgcn_s_setprio(1); _Pragma("unroll") for (int m = 0; m < 4; ++m) _Pragma("unroll") for (int n = 0; n < 2; ++n) _Pragma("unroll") for (int k = 0; k < 2; ++k) \
        acc[ai][bj][m][n] = __builtin_amdgcn_mfma_f32_16x16x32_bf16(Bt[n][k], At[m][k], acc[ai][bj][m][n], 0, 0, 0); __builtin_amdgcn_s_setprio(0); } while (0)
#define PG8_WAIT_V(n) asm volatile("s_waitcnt vmcnt(" #n ")" ::: "memory")
#define PG8_WAIT_L(n) asm volatile("s_waitcnt lgkmcnt(" #n ")" ::: "memory")
#define PG8_BAR __builtin_amdgcn_s_barrier()
#define PG8_SCHED __builtin_amdgcn_sched_barrier(0)
    Unit cur, nxt; int ui = 0;
    if (!S.next(0, cur)) return;
    f32x4 acc[2][2][4][2];
#pragma unroll
    for (int a = 0; a < 2; ++a)
#pragma unroll
        for (int b = 0; b < 2; ++b)
#pragma unroll
            for (int m = 0; m < 4; ++m)
#pragma unroll
                for (int n = 0; n < 2; ++n) acc[a][b][m][n] = (f32x4){0.f, 0.f, 0.f, 0.f};
    bf16x8 At[4][2], B0[2][2], B1[2][2];
    const char* cA = S.a_base(g, cur, tstep); const char* cB = S.b_base(g, cur, tstep);
    if constexpr (Sched::GATHER) S.a_rows(cur, RA[0], RA[1], CA[0], CA[1], K, offC);
    S.a_ready(cur);
    PG8_STAGE(PG8_SB(0, 0), cB, voffB); PG8_STAGE(PG8_SB(0, 1), cB + hstep, voffB); PG8_STA(PG8_SA(0, 0), cA, 0, false); PG8_STA(PG8_SA(0, 1), cA, 1, false);
    if (wr == 1) PG8_BAR;
    PG8_WAIT_V(2); PG8_BAR;
    PG8_STAGE(PG8_SB(1, 0), cB + kstep, voffB); PG8_STA(PG8_SA(1, 0), cA + kstep, 0, false); PG8_STAGE(PG8_SB(1, 1), cB + hstep + kstep, voffB);
    PG8_WAIT_V(6); PG8_BAR;
    for (;;) {
        const bool has_next = S.next(ui + 1, nxt);
        const char* nA = has_next ? S.a_base(g, nxt, tstep) : cA; const char* nB = has_next ? S.b_base(g, nxt, tstep) : cB;
        if constexpr (Sched::GATHER) { if (has_next) S.a_rows(nxt, RA[0], RA[1], CA[0], CA[1], K, offN); else {
#pragma unroll
            for (int h = 0; h < 2; ++h)
#pragma unroll
                for (int i = 0; i < 2; ++i) offN[h][i] = offC[h][i]; } }
        for (int t = 0; t < nt; t += 2) {
            const bool last = (t == nt - 2);
            const char* a1 = cA + (size_t)(t + 1) * kstep;
            const char* a2 = last ? nA : cA + (size_t)(t + 2) * kstep; const char* b2 = last ? nB : cB + (size_t)(t + 2) * kstep;
            const char* a3 = a2 + kstep; const char* b3 = b2 + kstep;
            if (last && has_next) S.a_ready(nxt);
            PG8_LDB(B0, 0, 0); PG8_LDB(B1, 0, 1); PG8_SCHED; PG8_LDA(At, 0, 0); PG8_STA(PG8_SA(1, 1), a1, 1, false);
            PG8_WAIT_V(8); PG8_WAIT_L(0); PG8_BAR; PG8_MMA(0, 0, At, B0); PG8_MMA(0, 1, At, B1); PG8_BAR; PG8_SCHED;
            PG8_LDA(At, 0, 1); PG8_STAGE(PG8_SB(0, 0), b2, voffB); PG8_STAGE(PG8_SB(0, 1), b2 + hstep, voffB); PG8_STA(PG8_SA(0, 0), a2, 0, last);
            PG8_WAIT_V(8); PG8_WAIT_L(0); PG8_BAR; PG8_MMA(1, 0, At, B0); PG8_MMA(1, 1, At, B1); PG8_BAR; PG8_SCHED;
            PG8_LDB(B0, 1, 0); PG8_LDB(B1, 1, 1); PG8_SCHED; PG8_LDA(At, 1, 0); PG8_STA(PG8_SA(0, 1), a2, 1, last);
            PG8_WAIT_V(8); PG8_WAIT_L(0); PG8_BAR; PG8_MMA(0, 0, At, B0); PG8_MMA(0, 1, At, B1); PG8_BAR; PG8_SCHED;
            PG8_LDA(At, 1, 1); PG8_STAGE(PG8_SB(1, 0), b3, voffB); PG8_STAGE(PG8_SB(1, 1), b3 + hstep, voffB); PG8_STA(PG8_SA(1, 0), a3, 0, last);
            PG8_WAIT_V(8); PG8_WAIT_L(0); PG8_BAR; PG8_MMA(1, 0, At, B0); PG8_MMA(1, 1, At, B1); PG8_BAR; PG8_SCHED;
        }
        if constexpr (ALIGN_EPI) { if (wr == 0) PG8_BAR; }
        E(acc, cur, wr, wc, fr, fq); S.done(cur);
        if (!has_next) break;
#pragma unroll
        for (int a = 0; a < 2; ++a)
#pragma unroll
            for (int b = 0; b < 2; ++b)
#pragma unroll
                for (int m = 0; m < 4; ++m)
#pragma unroll
                    for (int n = 0; n < 2; ++n) acc[a][b][m][n] = (f32x4){0.f, 0.f, 0.f, 0.f};
        cur = nxt; cA = nA; cB = nB; ++ui;
        if constexpr (Sched::GATHER) {
#pragma unroll
            for (int h = 0; h < 2; ++h)
#pragma unroll
                for (int i = 0; i < 2; ++i) offC[h][i] = offN[h][i]; }
        if constexpr (ALIGN_EPI) { if (wr == 1) PG8_BAR; }
    }
    PG8_WAIT_V(0);
    if constexpr (!ALIGN_EPI) { if (wr == 0) PG8_BAR; }
    PG8_BAR;
#undef PG8_SA
#undef PG8_SB
#undef PG8_STAGE
#undef PG8_STA
#undef PG8_LDA
#undef PG8_LDB
#undef PG8_MMA
#undef PG8_WAIT_V
#undef PG8_WAIT_L
#undef PG8_BAR
#undef PG8_SCHED
}
}
constexpr int NWAVES = 8;
constexpr size_t MiB = 1u << 20;
constexpr size_t WS_CTL = 0, CTL_ZERO_BYTES = 1 * MiB;
constexpr size_t WS_ROUTE = 1 * MiB;
constexpr size_t WS_LIST = 3 * MiB;
constexpr size_t WS_W = 8 * MiB;
constexpr size_t W_IN = 0, W_BRA = 12 * MiB, W_BRR = 14 * MiB, W_O = 16 * MiB, W_PG = 18 * MiB, W_PP = 20 * MiB, W_LRU = 21 * MiB, W_FF = 22 * MiB;
constexpr size_t W_FF_DN_DENSE = W_FF + 11 * MiB, W_FF_DN_MOE = W_FF + 112 * MiB;
constexpr size_t WS_XB = 208 * MiB;
constexpr size_t WS_IDX = 336 * MiB;
constexpr size_t WS_Z = 368 * MiB;
constexpr size_t Z_Q = WS_Z, Z_XR = WS_Z + 128 * MiB, Z_YR = WS_Z + 256 * MiB, Z_GA = WS_Z + 384 * MiB, Z_GR = WS_Z + 512 * MiB, Z_QI = WS_Z + 640 * MiB, Z_SM = WS_Z + 704 * MiB;
constexpr size_t Z_Q8 = Z_Q, Z_KV8 = Z_Q + 64 * MiB;
constexpr size_t WS_END = WS_Z + 736 * MiB;
constexpr size_t F_U = Z_Q;
constexpr size_t F_PB = Z_SM;
constexpr size_t F_H = Z_XR;
constexpr size_t F_H1 = WS_END;
constexpr size_t F_YE = Z_GA;
constexpr int MOE_CHUNK_TILES = 128;
constexpr size_t F_H_CHUNK_BYTES = (size_t)MOE_CHUNK_TILES * 256 * DFFE * 2;
constexpr size_t WS_NEED = F_H1 + F_H_CHUNK_BYTES;
static_assert(F_H + F_H_CHUNK_BYTES <= F_YE && F_YE + (size_t)520 * 256 * D * 2 <= Z_SM && F_H + (size_t)T_TOK * DFF * 2 <= Z_GR, "overlay map");
constexpr int CW_TMO = 0, CW_CODE = 1, CW_BAR = 4096, CW_CNT = 16384;
constexpr int RING_OFF = 0, RING_BYTES = 131072;
constexpr int LDSCTL_OFF = RING_BYTES, MISC_OFF = LDSCTL_OFF + 320;
constexpr int LDS_BYTES = 147456;

#define GAS __attribute__((address_space(1)))
#define LAS __attribute__((address_space(3)))
typedef unsigned short bf16;
typedef unsigned v4u __attribute__((ext_vector_type(4)));
typedef unsigned v2u __attribute__((ext_vector_type(2)));
typedef float f32x4 __attribute__((ext_vector_type(4)));
typedef float f32x16 __attribute__((ext_vector_type(16)));
typedef short bf16x8 __attribute__((ext_vector_type(8)));
typedef GAS unsigned gu32;
#define RLX_AGENT __ATOMIC_RELAXED, __HIP_MEMORY_SCOPE_AGENT
#define LDS_WAIT() asm volatile("s_waitcnt lgkmcnt(0)" ::: "memory")
#define VM_WAIT() asm volatile("s_waitcnt vmcnt(0)" ::: "memory")
using pg8::cvt_pk_bf16; using pg8::bf_lo; using pg8::bf_hi; using pg8::sigmoidf_fast;
#define XB_TMO      128
#define XB_XCNT(j)  (256  + 64 * (j))
#define XB_XSUB(j)  (1280 + 64 * (j))
#define XB_XGEN(j)  (2304 + 64 * (j))
#define XB_TOP      3328
#define XB_TOPGEN   3392
#define XCD_BAR_WORDS 3456
#define XB_SPIN_CAP (1u << 21)

__device__ __forceinline__ unsigned xb_ld(unsigned* p)              { return __hip_atomic_load(p, __ATOMIC_RELAXED, __HIP_MEMORY_SCOPE_AGENT); }
__device__ __forceinline__ unsigned xb_add(unsigned* p, unsigned v) { return __hip_atomic_fetch_add(p, v, __ATOMIC_RELAXED, __HIP_MEMORY_SCOPE_AGENT); }
__device__ __forceinline__ unsigned xb_xcc_id() { return (unsigned)__builtin_amdgcn_s_getreg((3 << 11) | 20) & 0xFu; }
#define XB_SPIN(cond, bar) do { unsigned _sp = 0; while (cond) { __builtin_amdgcn_s_sleep(1); \
    if ((++_sp & 255u) == 0u) { if (xb_ld(&(bar)[XB_TMO])) break; if (_sp > XB_SPIN_CAP) { atomicAdd(&(bar)[XB_TMO], 1u); break; } } } } while (0)

struct XcdBarrier {
    unsigned* bar; unsigned x;
    volatile LAS unsigned* st;
};

__device__ __forceinline__ XcdBarrier xcd_barrier_post(unsigned* bar, volatile LAS unsigned* st) {
    XcdBarrier b; b.bar = bar; b.x = xb_xcc_id(); b.st = st;
    if (threadIdx.x == 0) (void)xb_add(&bar[XB_XCNT(b.x)], 1u);
    return b;
}
__device__ __forceinline__ void xcd_barrier_complete(unsigned* bar, unsigned x, unsigned& nloc, unsigned& nx) {
    const unsigned G = gridDim.x * gridDim.y * gridDim.z;
    unsigned sum, cnt, mine, sp = 0u;
    for (;;) {
        sum = 0u; cnt = 0u; mine = 0u;
#pragma unroll
        for (unsigned j = 0; j < 16; ++j) { const unsigned c = xb_ld(&bar[XB_XCNT(j)]); sum += c; cnt += (c > 0u) ? 1u : 0u; mine = (j == x) ? c : mine; }
        if (sum == G) break;
        __builtin_amdgcn_s_sleep(1);
        if ((++sp & 255u) == 0u) { if (xb_ld(&bar[XB_TMO])) break; if (sp > XB_SPIN_CAP) { atomicAdd(&bar[XB_TMO], 1u); break; } }
    }
    nloc = mine > 0u ? mine : 1u; nx = cnt > 0u ? cnt : 1u;
}

__device__ __forceinline__ void xcd_barrier(const XcdBarrier& b) {
    asm volatile("s_waitcnt vmcnt(0)" ::: "memory");
    __syncthreads();
    if (threadIdx.x == 0) {
        unsigned* bar = b.bar;
        __builtin_amdgcn_s_waitcnt(0);
        unsigned nloc = b.st[0], nx = b.st[1];
        if (nloc == 0u) { xcd_barrier_complete(bar, b.x, nloc, nx); b.st[0] = nloc; b.st[1] = nx; }
        const unsigned old = xb_add(&bar[XB_XSUB(b.x)], 1u);
        const unsigned gen = old / nloc;
        if (old + 1u == (gen + 1u) * nloc) {
            __builtin_amdgcn_fence(__ATOMIC_RELEASE, "agent");
            asm volatile("s_waitcnt vmcnt(0)" ::: "memory");
            const unsigned og = xb_add(&bar[XB_TOP], 1u);
            const unsigned tg = og / nx;
            if (og + 1u == (tg + 1u) * nx) xb_add(&bar[XB_TOPGEN], 1u);
            else XB_SPIN(xb_ld(&bar[XB_TOPGEN]) == tg, bar);
            __builtin_amdgcn_fence(__ATOMIC_ACQUIRE, "agent");
            xb_add(&bar[XB_XGEN(b.x)], 1u);
            asm volatile("s_waitcnt vmcnt(0)" ::: "memory");
        } else {
            XB_SPIN(xb_ld(&bar[XB_XGEN(b.x)]) == gen, bar);
            __builtin_amdgcn_fence(__ATOMIC_ACQUIRE, "agent");
            asm volatile("s_waitcnt vmcnt(0)" ::: "memory");
        }
    }
    __syncthreads();
}
struct Frame {
    LAS unsigned char* lds;
    volatile LAS unsigned* MISC;
    gu32* ctl;
    int tid, lane, wave, G, bx;
    unsigned char* ws;
    float* out;
};
struct Args { const float* in[28]; float* out; unsigned char* ws; };
typedef const __attribute__((address_space(4))) Args* KArgs;
__device__ __forceinline__ KArgs kargs() { KArgs k = (KArgs)__builtin_amdgcn_kernarg_segment_ptr(); asm volatile("" : "+s"(k)); return k; }
enum { I_X = 0, I_P, I_WIN, I_CONVW, I_CONVB, I_LRUWA, I_LRUBA, I_LRUWX, I_LRUBX, I_LAM, I_WBRA, I_WBRR, I_WO, I_RELB, I_LN1G, I_LN1B, I_FFG, I_FFU, I_FFD, I_ROUTER, I_ROUTERB, I_MOEG, I_MOEU, I_MOED, I_PLEG, I_PLEP, I_LN2G, I_LN2B };

__device__ __forceinline__ Frame launder(const Frame& F0) { Frame F = F0; unsigned char* w = F0.ws; int l = (int)__builtin_amdgcn_mbcnt_hi(~0u, __builtin_amdgcn_mbcnt_lo(~0u, 0u)); asm volatile("" : "+s"(w)); asm volatile("" : "+v"(l));
    F.ws = w; F.lane = l; F.tid = F0.wave * 64 + l; F.ctl = (gu32*)(w + WS_CTL); return F; }
__device__ __forceinline__ float lane_get(float v, int src_lane) { return __builtin_bit_cast(float, __builtin_amdgcn_ds_bpermute(src_lane << 2, __builtin_bit_cast(int, v))); }
__device__ __forceinline__ float lane_xor(float v, int mask, int lane) { return lane_get(v, lane ^ mask); }
__device__ __forceinline__ float lane_up(float v, int d, int lane) { return lane_get(v, lane >= d ? lane - d : lane); }
__device__ __forceinline__ float wave_sum(float v, int lane) {
#pragma unroll
    for (int o = 1; o < 64; o <<= 1) v += lane_xor(v, o, lane);
    return v;
}
__device__ __forceinline__ unsigned pk2(float lo, float hi) { return cvt_pk_bf16(lo, hi); }

__device__ __forceinline__ void cvt_item(const float* W, int ldw, int K, bf16* WT, int d0, int sc0, int nvalid, float scale, int k0, LAS float* scr, int lane) {
    const int n4 = (lane & 7) * 4;
    f32x4 v[8];
#pragma unroll
    for (int i = 0; i < 8; ++i) { const int kk = 8 * i + (lane >> 3); v[i] = (f32x4){0.f, 0.f, 0.f, 0.f}; if (n4 < nvalid) v[i] = *(const GAS f32x4*)(W + (size_t)(k0 + kk) * ldw + sc0 + n4); }
#pragma unroll
    for (int i = 0; i < 8; ++i) { const int kk = 8 * i + (lane >> 3); LAS float* d = scr + kk * 33 + n4; d[0] = v[i][0] * scale; d[1] = v[i][1] * scale; d[2] = v[i][2] * scale; d[3] = v[i][3] * scale; }
    LDS_WAIT(); asm volatile("" ::: "memory");
    const int c = lane & 7;
#pragma unroll
    for (int j = 0; j < 4; ++j) { const int nn = (lane >> 3) + 8 * j; const LAS float* s = scr + (8 * c) * 33 + nn;
        v4u o; o.x = pk2(s[0 * 33], s[1 * 33]); o.y = pk2(s[2 * 33], s[3 * 33]); o.z = pk2(s[4 * 33], s[5 * 33]); o.w = pk2(s[6 * 33], s[7 * 33]);
        *(GAS v4u*)(WT + (size_t)(d0 + nn) * K + k0 + 8 * c) = o; }
    LDS_WAIT(); asm volatile("" ::: "memory");
}
__device__ __forceinline__ void cvt_plain(const float* W, int K, int N, bf16* WT, int item, LAS float* scr, int lane) {
    const int nblk = N / 32, kb = item / nblk, nb = item % nblk;
    cvt_item(W, N, K, WT, 32 * nb, 32 * nb, 32, 1.0f, 64 * kb, scr, lane);
}
__device__ __forceinline__ void cvt_gateup(const float* Wg, const float* Wu, int dff, bf16* WT, int item, LAS float* scr, int lane) {
    const int nblk = 2 * dff / 32, kb = item / nblk, db = item % nblk, d0 = 32 * db, pn = d0 >> 8, r = d0 & 255;
    const float* W = r < 128 ? Wg : Wu; const int sc0 = 128 * pn + (r & 127);
    cvt_item(W, dff, D, WT, d0, sc0, 32, 1.0f, 64 * kb, scr, lane);
}
__device__ __forceinline__ void cvt_win(const float* W, bf16* WT, int item, LAS float* scr, int lane) {
    const int nblk = NIN / 32, kb = item / nblk, db = item % nblk, d0 = 32 * db;
    int sc0, nv = 32; float sc = 1.0f;
    if (d0 < 1024) { sc0 = d0; }
    else if (d0 < 2048) sc0 = 1736 + (d0 - 1024);
    else if (d0 < 3072) sc0 = 2760 + (d0 - 2048);
    else if (d0 < 4096) sc0 = 3784 + (d0 - 3072);
    else if (d0 < 5120) sc0 = 4808 + (d0 - 4096);
    else if (d0 < 5632) sc0 = 1152 + (d0 - 5120);
    else if (d0 < 5696) sc0 = 1024 + (d0 - 5632);
    else if (d0 < 5760) sc0 = 1088 + (d0 - 5696);
    else if (d0 < 5824) sc0 = 1664 + (d0 - 5760);
    else if (d0 == 5824) { sc0 = 1728; nv = 8; }
    else { sc0 = 0; nv = 0; }
    cvt_item(W, D_IN, D, WT, d0, sc0, nv, sc, 64 * kb, scr, lane);
}
__device__ __forceinline__ void p0_convert(const Frame& F0, int L) {
    Frame F = launder(F0);
    const KArgs ka = kargs();
    LAS float* scr = (LAS float*)(F.lds + RING_OFF + F.wave * 16384);
    const int gw = F.bx * NWAVES + F.wave, NGW = F.G * NWAVES;
    unsigned char* wb = F.ws + WS_W;
    const int odd = L & 1, jj = L >> 1;
    constexpr int I_IN = (D / 64) * (NIN / 32), I_SQ = (D / 64) * (D / 32), I_PPJ = (PLE / 64) * (D / 32), I_LRU1 = 2 * 4;
    constexpr int I_GU_D = (D / 64) * (2 * DFF / 32), I_DN_D = (DFF / 64) * (D / 32), I_GU_E = (D / 64) * (2 * DFFE / 32), I_DN_E = (DFFE / 64) * (D / 32);
    const int n_ff = odd ? NEXP * (I_GU_E + I_DN_E) : (I_GU_D + I_DN_D);
    const int NITEMS = I_IN + 4 * I_SQ + I_PPJ + 16 * I_LRU1 + n_ff;
    for (int it = gw; it < NITEMS; it += NGW) {
        int r = it;
        if (r < I_IN) { cvt_win(ka->in[I_WIN] + (size_t)L * D * D_IN, (bf16*)(wb + W_IN), r, scr, F.lane); continue; } r -= I_IN;
        if (r < I_SQ) { cvt_plain(ka->in[I_WBRA] + (size_t)L * D * D, D, D, (bf16*)(wb + W_BRA), r, scr, F.lane); continue; } r -= I_SQ;
        if (r < I_SQ) { cvt_plain(ka->in[I_WBRR] + (size_t)L * D * D, D, D, (bf16*)(wb + W_BRR), r, scr, F.lane); continue; } r -= I_SQ;
        if (r < I_SQ) { cvt_plain(ka->in[I_WO] + (size_t)L * D * D, D, D, (bf16*)(wb + W_O), r, scr, F.lane); continue; } r -= I_SQ;
        if (r < I_SQ) { cvt_plain(ka->in[I_PLEG] + (size_t)L * D * D, D, D, (bf16*)(wb + W_PG), r, scr, F.lane); continue; } r -= I_SQ;
        if (r < I_PPJ) { cvt_plain(ka->in[I_PLEP] + (size_t)L * PLE * D, PLE, D, (bf16*)(wb + W_PP), r, scr, F.lane); continue; } r -= I_PPJ;
        if (r < 16 * I_LRU1) { const int m = r / I_LRU1, blk = m & 7, which = m >> 3;
            const float* src = ka->in[which ? I_LRUWX : I_LRUWA] + (size_t)L * 8 * 128 * 128 + (size_t)blk * 128 * 128;
            cvt_plain(src, 128, 128, (bf16*)(wb + W_LRU) + (size_t)which * 8 * 128 * 128 + (size_t)blk * 128 * 128, r % I_LRU1, scr, F.lane); continue; } r -= 16 * I_LRU1;
        if (!odd) {
            if (r < I_GU_D) { cvt_gateup(ka->in[I_FFG] + (size_t)jj * D * DFF, ka->in[I_FFU] + (size_t)jj * D * DFF, DFF, (bf16*)(wb + W_FF), r, scr, F.lane); continue; } r -= I_GU_D;
            cvt_plain(ka->in[I_FFD] + (size_t)jj * DFF * D, DFF, D, (bf16*)(wb + W_FF_DN_DENSE), r, scr, F.lane);
        } else {
            if (r < NEXP * I_GU_E) { const int e = r / I_GU_E; const size_t eo = ((size_t)jj * NEXP + e) * D * DFFE;
                cvt_gateup(ka->in[I_MOEG] + eo, ka->in[I_MOEU] + eo, DFFE, (bf16*)(wb + W_FF) + (size_t)e * 2 * DFFE * D, r % I_GU_E, scr, F.lane); continue; } r -= NEXP * I_GU_E;
            const int e = r / I_DN_E; const size_t eo = ((size_t)jj * NEXP + e) * DFFE * D;
            cvt_plain(ka->in[I_MOED] + eo, DFFE, D, (bf16*)(wb + W_FF_DN_MOE) + (size_t)e * D * DFFE, r % I_DN_E, scr, F.lane);
        }
    }
    if (L == 0) {
        const GAS f32x4* x4 = (const GAS f32x4*)ka->in[I_X]; GAS v4u* o = (GAS v4u*)(F.ws + WS_XB);
        const size_t n8 = (size_t)T_TOK * D / 8;
        for (size_t i = (size_t)F.bx * 512 + F.tid; i < n8; i += (size_t)F.G * 512) { const f32x4 a = x4[2 * i], b = x4[2 * i + 1];
            v4u w; w.x = pk2(a[0], a[1]); w.y = pk2(a[2], a[3]); w.z = pk2(b[0], b[1]); w.w = pk2(b[2], b[3]); o[i] = w; }
    }
}

template <bool LN2, bool ODD, bool DRY = false>
__device__ __forceinline__ void ln_phase(const Frame& F0, int L) {
    Frame F = launder(F0);
    const KArgs ka = kargs();
    const int jj = L >> 1;
    float* X32 = F.out; bf16* XB = (bf16*)(F.ws + WS_XB);
    const float* gam = ka->in[LN2 ? I_LN2G : I_LN1G] + (size_t)L * D; const float* bet = ka->in[LN2 ? I_LN2B : I_LN1B] + (size_t)L * D;
    f32x4 gv[4], bv[4];
#pragma unroll
    for (int j = 0; j < 4; ++j) { gv[j] = ((const GAS f32x4*)gam)[F.lane + 64 * j]; bv[j] = ((const GAS f32x4*)bet)[F.lane + 64 * j]; }
    LAS float* RT = (LAS float*)(F.lds + RING_OFF);
    LAS unsigned* TE = (LAS unsigned*)(F.lds + RING_OFF + 32768);
    volatile LAS unsigned* lcnt = F.MISC + 48; volatile LAS unsigned* gbase = F.MISC + 56;
    float rb[8];
    if (!LN2 && ODD) {
        const float* R = ka->in[I_ROUTER] + (size_t)jj * D * NEXP;
        for (int i = F.tid; i < D * NEXP; i += 512) RT[i] = R[i];
        if (F.tid < 8) lcnt[F.tid] = 0u;
#pragma unroll
        for (int e = 0; e < 8; ++e) rb[e] = ka->in[I_ROUTERB][jj * NEXP + e];
        __syncthreads();
    }
    const unsigned* route = (const unsigned*)(F.ws + WS_ROUTE);
    const bf16* YE = (const bf16*)(F.ws + F_YE);
    f32x4 nv[4];
    { const GAS f32x4* x0 = (const GAS f32x4*)(X32 + ((size_t)F.bx * 256 + F.wave) * D) + F.lane;
#pragma unroll
      for (int j = 0; j < 4; ++j) nv[j] = x0[64 * j]; }
    for (int it = 0; it < 32; ++it) {
        const int rl = F.wave + 8 * it; const size_t row = (size_t)F.bx * 256 + rl;
        GAS f32x4* xr = (GAS f32x4*)(X32 + row * D) + F.lane;
        f32x4 v[4]; float s = 0.f;
#pragma unroll
        for (int j = 0; j < 4; ++j) v[j] = nv[j];
        if (it < 31) {
#pragma unroll
            for (int j = 0; j < 4; ++j) nv[j] = xr[8 * (D / 4) + 64 * j]; }
        if (LN2 && ODD) {
            const unsigned e1 = route[row * 8 + 0], e2 = route[row * 8 + 1], p1 = route[row * 8 + 2], p2 = route[row * 8 + 3];
            const float g1 = __builtin_bit_cast(float, route[row * 8 + 4]), g2 = __builtin_bit_cast(float, route[row * 8 + 5]);
            const size_t r1 = (size_t)F.MISC[16 + e1] * 256 + p1, r2 = (size_t)F.MISC[16 + e2] * 256 + p2;
            const GAS v2u* y1 = (const GAS v2u*)(YE + r1 * D) + F.lane; const GAS v2u* y2 = (const GAS v2u*)(YE + r2 * D) + F.lane;
#pragma unroll
            for (int j = 0; j < 4; ++j) { const v2u a = y1[64 * j], b = y2[64 * j];
                v[j][0] += g1 * bf_lo(a.x) + g2 * bf_lo(b.x); v[j][1] += g1 * bf_hi(a.x) + g2 * bf_hi(b.x);
                v[j][2] += g1 * bf_lo(a.y) + g2 * bf_lo(b.y); v[j][3] += g1 * bf_hi(a.y) + g2 * bf_hi(b.y); }
        }
#pragma unroll
        for (int j = 0; j < 4; ++j) s += (v[j][0] + v[j][1]) + (v[j][2] + v[j][3]);
        const float mean = wave_sum(s, F.lane) * (1.f / D); float s2 = 0.f;
#pragma unroll
        for (int j = 0; j < 4; ++j) { v[j] = v[j] - mean; s2 += (v[j][0] * v[j][0] + v[j][1] * v[j][1]) + (v[j][2] * v[j][2] + v[j][3] * v[j][3]); }
        const float rstd = 1.f / sqrtf(wave_sum(s2, F.lane) * (1.f / D) + LN_EPS);
        GAS v2u* o8 = (GAS v2u*)((DRY ? (bf16*)(F.ws + WS_NEED) : XB) + row * D) + F.lane;
        GAS f32x4* xw = DRY ? (GAS f32x4*)((float*)(F.ws + WS_NEED) + row * D) + F.lane : xr;
#pragma unroll
        for (int j = 0; j < 4; ++j) { v[j] = v[j] * rstd * gv[j] + bv[j]; if (DRY || (LN2 && L == DEPTH - 1)) xw[64 * j] = v[j];
            v2u w; w.x = pk2(v[j][0], v[j][1]); w.y = pk2(v[j][2], v[j][3]); o8[64 * j] = w; }
        if (!LN2) {
            const f32x4 pv = ((const GAS f32x4*)(ka->in[I_P] + ((size_t)L * T_TOK + row) * PLE))[F.lane];
            v2u w; w.x = pk2(pv[0], pv[1]); w.y = pk2(pv[2], pv[3]); ((GAS v2u*)(F.ws + (DRY ? WS_NEED : F_PB) + row * PLE * 2))[F.lane] = w;
        }
        if (!LN2 && ODD) {
            float lg[8];
#pragma unroll
            for (int e = 0; e < 8; ++e) lg[e] = 0.f;
#pragma unroll
            for (int j = 0; j < 4; ++j)
#pragma unroll
                for (int q = 0; q < 4; ++q) { const int c = 4 * F.lane + 256 * j + q; const f32x4 ra = *(const LAS f32x4*)(RT + c * 8), rc = *(const LAS f32x4*)(RT + c * 8 + 4); const float xv = v[j][q];
                    lg[0] += xv * ra[0]; lg[1] += xv * ra[1]; lg[2] += xv * ra[2]; lg[3] += xv * ra[3]; lg[4] += xv * rc[0]; lg[5] += xv * rc[1]; lg[6] += xv * rc[2]; lg[7] += xv * rc[3]; }
#pragma unroll
            for (int e = 0; e < 8; ++e) lg[e] = wave_sum(lg[e], F.lane) + rb[e];
            int e1 = 0; float v1 = lg[0];
#pragma unroll
            for (int e = 1; e < 8; ++e) if (lg[e] > v1) { v1 = lg[e]; e1 = e; }
            int e2 = -1; float v2 = 0.f;
#pragma unroll
            for (int e = 0; e < 8; ++e) if (e != e1 && (e2 < 0 || lg[e] > v2)) { v2 = lg[e]; e2 = e; }
            const float ex = __expf(v2 - v1), g1 = 1.f / (1.f + ex), g2 = ex * g1;
            if (F.lane == 0) { const unsigned lp1 = __hip_atomic_fetch_add((LAS unsigned*)lcnt + e1, 1u, __ATOMIC_RELAXED, __HIP_MEMORY_SCOPE_WORKGROUP), lp2 = __hip_atomic_fetch_add((LAS unsigned*)lcnt + e2, 1u, __ATOMIC_RELAXED, __HIP_MEMORY_SCOPE_WORKGROUP);
                TE[rl * 4 + 0] = (unsigned)e1 | ((unsigned)e2 << 8) | (lp1 << 16); TE[rl * 4 + 1] = lp2; TE[rl * 4 + 2] = __builtin_bit_cast(unsigned, g1); TE[rl * 4 + 3] = __builtin_bit_cast(unsigned, g2); }
        }
    }
    if (!LN2 && ODD) {
        __syncthreads();
        if (F.tid < 8) gbase[F.tid] = __hip_atomic_fetch_add(F.ctl + CW_CNT + jj * 1024 + 64 * F.tid, lcnt[F.tid], RLX_AGENT);
        __syncthreads();
        if (F.tid < 256) { const unsigned w0 = TE[F.tid * 4], lp2 = TE[F.tid * 4 + 1]; const unsigned e1 = w0 & 255u, e2 = (w0 >> 8) & 255u, lp1 = w0 >> 16;
            const unsigned p1 = gbase[e1] + lp1, p2 = gbase[e2] + lp2; const unsigned tok = (unsigned)F.bx * 256 + F.tid;
            GAS int* list = (GAS int*)(F.ws + WS_LIST); list[(size_t)e1 * T_TOK + p1] = (int)tok; list[(size_t)e2 * T_TOK + p2] = (int)tok;
            GAS v4u* ro = (GAS v4u*)(F.ws + WS_ROUTE) + (size_t)tok * 2; v4u a; a.x = e1; a.y = e2; a.z = p1; a.w = p2; ro[0] = a; v4u b; b.x = TE[F.tid * 4 + 2]; b.y = TE[F.tid * 4 + 3]; b.z = 0u; b.w = 0u; ro[1] = b; }
        __syncthreads();
    }
}
template <int NJ>
__device__ __forceinline__ unsigned select_topk_n(LAS const float* sc, int n_adm, GAS unsigned short* out, int lane, unsigned guess) {
    const int nj = n_adm >> 6;
    unsigned u[NJ];
#pragma unroll
    for (int j = 0; j < NJ; ++j) { unsigned b = 0u;
        if (j < NJ - 8 || j < nj) { b = __builtin_bit_cast(unsigned, sc[64 * j + lane]); b = (b == 0x80000000u) ? 0u : b; b = (b & 0x80000000u) ? ~b : (b | 0x80000000u); }
        u[j] = b; }
#define SEL_COUNT(c_, dst_) do { int cnt_ = 0; _Pragma("unroll") for (int j = 0; j < NJ; ++j) cnt_ += __popcll(__ballot(u[j] >= (c_))); dst_ = cnt_; } while (0)
    unsigned lo = 0u, hi = 0xFFFFFFFFu, ex = 0u; bool exact = false; int c;
    if (guess != 0u) {
        SEL_COUNT(guess, c);
        if (c == 256) { exact = true; ex = guess; }
        else if (c > 256) { lo = guess; unsigned d = 1u << 17;
            for (int e = 0; e < 7 && !exact; ++e) { const unsigned h = lo + d; if (h < lo) break; SEL_COUNT(h, c);
                if (c == 256) { exact = true; ex = h; } else if (c < 256) { hi = h; break; } else { lo = h; d <<= 2; } } }
        else { hi = guess; unsigned d = 1u << 17;
            for (int e = 0; e < 7 && !exact; ++e) { if (d >= hi) break; const unsigned l = hi - d; SEL_COUNT(l, c);
                if (c == 256) { exact = true; ex = l; } else if (c > 256) { lo = l; break; } else { hi = l; d <<= 2; } } }
    }
    while (!exact && hi - lo > 1u) { const unsigned mid = lo + ((hi - lo) >> 1); SEL_COUNT(mid, c);
        if (c == 256) { exact = true; ex = mid; } else if (c > 256) lo = mid; else hi = mid; }
#undef SEL_COUNT
    const unsigned thr = exact ? ex - 1u : lo;
    int ngt = 0;
#pragma unroll
    for (int j = 0; j < NJ; ++j) ngt += __popcll(__ballot(u[j] > thr));
    const int quota = 256 - ngt;
    int obase = 0; const unsigned long long lt = (1ull << lane) - 1ull;
#pragma unroll
    for (int j = 0; j < NJ; ++j) {
        const bool gt = u[j] > thr; const unsigned long long msel = __ballot(gt);
        if (gt) out[obase + __popcll(msel & lt)] = (unsigned short)(64 * j + lane);
        obase += __popcll(msel);
    }
    if (quota > 0) {
        int tbase = 0;
#pragma unroll
        for (int j = 0; j < NJ; ++j) {
            const bool eq = u[j] == thr; const unsigned long long meq = __ballot(eq); const int rk = tbase + __popcll(meq & lt);
            if (eq && rk < quota) out[obase + rk] = (unsigned short)(64 * j + lane);
            tbase += __popcll(meq);
        }
    }
    return thr;
}
__device__ __forceinline__ unsigned select_topk(LAS const float* sc, int n_adm, GAS unsigned short* out, int lane, unsigned guess) {
    if (n_adm <= 256) {
#pragma unroll
        for (int j = 0; j < 4; ++j) { const int p = lane + 64 * j; out[p] = (unsigned short)(p < n_adm ? p : 0); }
        return 0u;
    }
    if (n_adm <= 512) return select_topk_n<8>(sc, n_adm, out, lane, guess);
    else if (n_adm <= 1024) return select_topk_n<16>(sc, n_adm, out, lane, guess);
    else if (n_adm <= 1536) return select_topk_n<24>(sc, n_adm, out, lane, guess);
    return select_topk_n<32>(sc, n_adm, out, lane, guess);
}
__device__ __forceinline__ void indexer_phase(const Frame& F0) {
    Frame F = launder(F0);
    LAS float* sc = (LAS float*)(F.lds + RING_OFF);
    const bf16* QI = (const bf16*)(F.ws + Z_QI); const bf16* SM = (const bf16*)(F.ws + Z_SM);
    GAS unsigned short* IDX = (GAS unsigned short*)(F.ws + WS_IDX);
    const int lane = F.lane, h = lane >> 5, r = lane & 31;
    const int rq = 2 * ((r >> 2) & 1) + ((r >> 4) & 1), rh = (r & 3) + 4 * ((r >> 3) & 1);
    const int vcu = (F.bx & 7) * (F.G >> 3) + (F.bx >> 3);
    unsigned guess[2] = {0u, 0u};
    bf16x8 A[4][4]; v4u wq[4][2];
#define IDX_TILE(pi_, b_, tq_) const int pid_ = vcu * 8 + ((pi_) >> 1), b_ = pid_ >> 6, jp_ = pid_ & 63, tq_ = 16 * (((pi_) & 1) ? 127 - jp_ : jp_)
#define IDX_LOAD_A(t0_) do { _Pragma("unroll") for (int mt = 0; mt < 4; ++mt) { \
        _Pragma("unroll") for (int s = 0; s < 4; ++s) A[mt][s] = *(const GAS bf16x8*)(QI + (size_t)((t0_) + 4 * mt + rq) * 512 + rh * 64 + 16 * s + 8 * h); \
        _Pragma("unroll") for (int qq = 0; qq < 2; ++qq) wq[mt][qq] = *(const GAS v4u*)(SM + (size_t)((t0_) + 4 * mt + 2 * h + qq) * 256 + 192); } } while (0)
    for (int pi = 0; pi < 16; ++pi) {
        IDX_TILE(pi, b, tq);
        const int t0 = b * SEQ + tq;
        const int n_adm = ((tq >> 6) + 1) * 64, nkb = n_adm >> 5;
        if (n_adm > 256) {
            IDX_LOAD_A(t0);
            bf16x8 B[4], Bn[4];
#pragma unroll
            for (int s = 0; s < 4; ++s) Bn[s] = *(const GAS bf16x8*)(SM + (size_t)(b * SEQ + 32 * F.wave + r) * 256 + 128 + 16 * s + 8 * h);
            for (int kb = F.wave; kb < nkb; kb += 8) {
                const int key = 32 * kb + r;
                const int keyn = (kb + 8 < nkb) ? key + 256 : key;
#pragma unroll
                for (int s = 0; s < 4; ++s) B[s] = Bn[s];
#pragma unroll
                for (int s = 0; s < 4; ++s) Bn[s] = *(const GAS bf16x8*)(SM + (size_t)(b * SEQ + keyn) * 256 + 128 + 16 * s + 8 * h);
#pragma unroll
                for (int mt = 0; mt < 4; ++mt) {
                    f32x16 acc;
#pragma unroll
                    for (int i = 0; i < 16; ++i) acc[i] = 0.f;
#pragma unroll
                    for (int s = 0; s < 4; ++s) acc = __builtin_amdgcn_mfma_f32_32x32x16_bf16(A[mt][s], B[s], acc, 0, 0, 0);
                    float sA = 0.f, sB = 0.f;
#pragma unroll
                    for (int i = 0; i < 8; ++i) { const unsigned wa = wq[mt][0][i >> 1], wb = wq[mt][1][i >> 1];
                        const float fa = (i & 1) ? bf_hi(wa) : bf_lo(wa), fb = (i & 1) ? bf_hi(wb) : bf_lo(wb);
                        sA += fmaxf(acc[i], 0.f) * fa; sB += fmaxf(acc[8 + i], 0.f) * fb; }
                    sc[(4 * mt + 2 * h) * 2048 + key] = sA; sc[(4 * mt + 2 * h + 1) * 2048 + key] = sB;
                }
            }
        }
        __syncthreads();
#pragma unroll 1
        for (int qq = 0; qq < 2; ++qq) { const int q = 2 * F.wave + qq; const unsigned g_ = (pi & 1) ? guess[1] : guess[0];
            const unsigned t_ = select_topk(sc + q * 2048, n_adm, IDX + (size_t)(t0 + q) * 256, lane, g_); if (pi & 1) guess[1] = t_; else guess[0] = t_; }
        __syncthreads();
    }
#undef IDX_TILE
#undef IDX_LOAD_A
}

__device__ __forceinline__ unsigned vst_off(unsigned r, unsigned ch) { return r * 128u + 16u * (ch ^ ((((r >> 1) ^ (r >> 4)) & 1u) << 1) ^ (((r >> 3) & 1u) << 2)); }
__device__ __forceinline__ int t5_bucket_dev(int rel) {
    const int n = rel < 0 ? -rel : rel;
    int v = n;
    if (n >= 8) v = 8 + (n >= 12) + (n >= 16) + (n >= 23) + (n >= 32) + (n >= 46) + (n >= 64) + (n >= 91);
    return v + (rel > 0 ? 16 : 0);
}
#ifndef ATT_REPS
#define ATT_REPS 1
#endif
#ifndef ATT_FIXKEYS
#define ATT_FIXKEYS 0
#endif
template <int FIX = 0>
__device__ __forceinline__ void attention_phase(const Frame& F0) {
#pragma unroll 1
    for (int rep = 0; rep < ATT_REPS; ++rep) {
    Frame F = launder(F0);
    const GAS unsigned char* Q8 = (const GAS unsigned char*)(F.ws + Z_Q8); const GAS unsigned char* KV8 = (const GAS unsigned char*)(F.ws + Z_KV8); bf16* OB = (bf16*)(F.ws + Z_XR);
    const GAS unsigned short* IDX = (const GAS unsigned short*)(F.ws + WS_IDX);
    const int lane = F.lane, g = lane >> 4, m = lane & 15;
    LAS unsigned char* vst = F.lds + RING_OFF + F.wave * 4096;
    const unsigned vbase = (unsigned)(size_t)vst;
    LAS unsigned char* BK = F.lds + RING_OFF + 32768; LAS unsigned char* OH = F.lds + RING_OFF + 32768 + 2176;
    for (int i = F.tid; i < 2112; i += 512) BK[i] = (unsigned char)t5_bucket_dev(i - 2047);
    if (F.tid < 128) { const int bkt = F.tid >> 2, gg = F.tid & 3, j = bkt - 8 * gg; v4u oh; oh.x = oh.y = oh.z = oh.w = 0u;
        if (j >= 0 && j < 8) { const unsigned val = (j & 1) ? 0x3F800000u : 0x3F80u; if ((j >> 1) == 0) oh.x = val; else if ((j >> 1) == 1) oh.y = val; else if ((j >> 1) == 2) oh.z = val; else oh.w = val; }
        *(LAS v4u*)(OH + F.tid * 16) = oh; }
    __syncthreads();
    bf16x8 bb;
    { const float* rbias = kargs()->in[I_RELB]; unsigned w[4];
#pragma unroll
      for (int j = 0; j < 4; ++j) w[j] = pk2(8.0f * rbias[(8 * g + 2 * j) * 16 + m], 8.0f * rbias[(8 * g + 2 * j + 1) * 16 + m]);
      v4u t; t.x = w[0]; t.y = w[1]; t.z = w[2]; t.w = w[3]; bb = __builtin_bit_cast(bf16x8, t); }
    unsigned tra[4][2];
    { const unsigned q = (lane & 15) >> 2, p = lane & 3;
#pragma unroll
      for (int c = 0; c < 4; ++c)
#pragma unroll
        for (int t = 0; t < 2; ++t) tra[c][t] = vst_off(8 * g + 4 * t + q, 2 * c + (p >> 1)) + 8 * (p & 1); }
    const int vcu = (F.bx & 7) * (F.G >> 3) + (F.bx >> 3);
    typedef long fp8x8;
    v4u ni0, ni1, nq; v4u ka[16]; unsigned koff[16];
#define ATT_KOFF(i0_, i1_) do { _Pragma("unroll") for (int k = 0; k < 4; ++k) { koff[2 * k] = ((i0_)[k] & 0xffffu) * 128u + 16u * g; koff[2 * k + 1] = ((i0_)[k] >> 16) * 128u + 16u * g; \
        koff[8 + 2 * k] = ((i1_)[k] & 0xffffu) * 128u + 16u * g; koff[8 + 2 * k + 1] = ((i1_)[k] >> 16) * 128u + 16u * g; } } while (0)
#ifdef ATT_NO_ASM
#define ATT_KLOAD(kvb_) do { const GAS unsigned char* kb_ = (kvb_); _Pragma("unroll") for (int T = 0; T < 16; ++T) ka[T] = *(const GAS v4u*)(kb_ + koff[T]); } while (0)
#define ATT_KWAIT(n_, T0_) do {} while (0)
#else
#define ATT_KLOAD(kvb_) do { const GAS unsigned char* kb_ = (kvb_); _Pragma("unroll") for (int T = 0; T < 16; ++T) { \
        asm volatile("global_load_dwordx4 %0, %1, %2" : "=&v"(ka[T]) : "v"(koff[T]), "s"(kb_) : "memory"); } } while (0)
#define ATT_KWAIT(n_, T0_) asm volatile("s_waitcnt vmcnt(" #n_ ")" : "+v"(ka[T0_]), "+v"(ka[T0_ + 1]), "+v"(ka[T0_ + 2]), "+v"(ka[T0_ + 3]), "+v"(ka[T0_ + 4]), "+v"(ka[T0_ + 5]), "+v"(ka[T0_ + 6]), "+v"(ka[T0_ + 7]) :: "memory")
#endif
    { const int tok0 = vcu * 256 + F.wave; const GAS v4u* ip = (const GAS v4u*)(IDX + (size_t)tok0 * 256 + 16 * m); ni0 = ip[0]; ni1 = ip[1];
      nq = *(const GAS v4u*)(Q8 + (size_t)tok0 * D + m * 64 + 16 * g);
      ATT_KOFF(ni0, ni1); ATT_KLOAD(KV8 + (size_t)(tok0 >> 11) * SEQ * 128); }
    for (int it = 0; it < 32; ++it) {
        const int tok = vcu * 256 + F.wave + 8 * it, b = tok >> 11, tq = tok & (SEQ - 1);
        const int n_valid = (((tq >> 6) + 1) * 64) < 256 ? ((tq >> 6) + 1) * 64 : 256;
        const v4u qv = nq;
        const fp8x8 qf0 = (fp8x8)(((unsigned long long)qv.y << 32) | qv.x), qf1 = (fp8x8)(((unsigned long long)qv.w << 32) | qv.z);
        const GAS unsigned char* kvb = KV8 + (size_t)b * SEQ * 128;
        f32x4 S[16];
#pragma unroll
        for (int T = 0; T < 16; ++T) {
            if (T == 0) ATT_KWAIT(8, 0);
            if (T == 8) ATT_KWAIT(0, 8);
            const unsigned bkt = BK[(koff[T] >> 7) + (2047 - tq)];
            const v4u oh = *(const LAS v4u*)(OH + bkt * 64 + g * 16);
            f32x4 ab = (f32x4){0.f, 0.f, 0.f, 0.f}, a = (f32x4){0.f, 0.f, 0.f, 0.f};
            ab = __builtin_amdgcn_mfma_f32_16x16x32_bf16(__builtin_bit_cast(bf16x8, oh), bb, ab, 0, 0, 0);
            a = __builtin_amdgcn_mfma_f32_16x16x32_fp8_fp8((fp8x8)(((unsigned long long)ka[T].y << 32) | ka[T].x), qf0, a, 0, 0, 0);
            a = __builtin_amdgcn_mfma_f32_16x16x32_fp8_fp8((fp8x8)(((unsigned long long)ka[T].w << 32) | ka[T].z), qf1, a, 0, 0, 0);
            a = a + ab;
            S[T] = a;
        }
        __builtin_amdgcn_sched_barrier(0);
        v4u vv[16];
#pragma unroll
        for (int T = 0; T < 16; ++T) vv[T] = *(const GAS v4u*)(kvb + koff[T] + 64);
        if (n_valid < 256) {
#pragma unroll
            for (int T = 0; T < 16; ++T)
#pragma unroll
                for (int i = 0; i < 4; ++i) if (16 * (4 * g + i) + T >= n_valid) S[T][i] = -1e30f;
        }
        float mx = -3.0e38f;
#pragma unroll
        for (int T = 0; T < 16; ++T) mx = fmaxf(fmaxf(fmaxf(S[T][0], S[T][1]), fmaxf(S[T][2], S[T][3])), mx);
        mx = fmaxf(mx, lane_xor(mx, 16, lane)); mx = fmaxf(mx, lane_xor(mx, 32, lane));
        constexpr float SC = 1.4426950408889634f * 0.125f;
        const float mneg = -mx * SC; float sum = 0.f;
#pragma unroll
        for (int T = 0; T < 16; ++T)
#pragma unroll
            for (int i = 0; i < 4; ++i) { const float p = __builtin_amdgcn_exp2f(S[T][i] * SC + mneg); S[T][i] = p; sum += p; }
        sum += lane_xor(sum, 16, lane); sum += lane_xor(sum, 32, lane);
        { const int tokn = vcu * 256 + F.wave + 8 * (it < 31 ? it + 1 : it); const GAS v4u* ip = (const GAS v4u*)(IDX + (size_t)tokn * 256 + 16 * m); ni0 = ip[0]; ni1 = ip[1];
          nq = *(const GAS v4u*)(Q8 + (size_t)tokn * D + m * 64 + 16 * g); }
        f32x4 O[4];
#pragma unroll
        for (int c = 0; c < 4; ++c) O[c] = (f32x4){0.f, 0.f, 0.f, 0.f};
#pragma unroll
        for (int ks = 0; ks < 8; ++ks) {
            const unsigned vb = vbase;
#pragma unroll
            for (int tt = 0; tt < 2; ++tt) { const v4u w8 = vv[2 * ks + tt]; v4u c0, c1;
#pragma unroll
                for (int q = 0; q < 4; ++q) { const int src = (int)w8[q];
                    const __attribute__((ext_vector_type(2))) float lo2 = __builtin_amdgcn_cvt_pk_f32_fp8(src, false), hi2 = __builtin_amdgcn_cvt_pk_f32_fp8(src, true);
                    const unsigned w0 = pk2(lo2.x, lo2.y), w1 = pk2(hi2.x, hi2.y);
                    if (q < 2) { c0[2 * q] = w0; c0[2 * q + 1] = w1; } else { c1[2 * (q - 2)] = w0; c1[2 * (q - 2) + 1] = w1; } }
                const unsigned rr = 8 * (m >> 2) + 4 * tt + (m & 3);
                *(LAS v4u*)(vst + vst_off(rr, 2 * g)) = c0; *(LAS v4u*)(vst + vst_off(rr, 2 * g + 1)) = c1; }
            v4u pw; pw.x = pk2(S[2 * ks][0], S[2 * ks][1]); pw.y = pk2(S[2 * ks][2], S[2 * ks][3]); pw.z = pk2(S[2 * ks + 1][0], S[2 * ks + 1][1]); pw.w = pk2(S[2 * ks + 1][2], S[2 * ks + 1][3]);
            const bf16x8 pf = __builtin_bit_cast(bf16x8, pw);
            v2u f[4][2];
            asm volatile("s_waitcnt lgkmcnt(0)\n\t"
                         "ds_read_b64_tr_b16 %0, %8\n\tds_read_b64_tr_b16 %1, %9\n\tds_read_b64_tr_b16 %2, %10\n\tds_read_b64_tr_b16 %3, %11\n\t"
                         "ds_read_b64_tr_b16 %4, %12\n\tds_read_b64_tr_b16 %5, %13\n\tds_read_b64_tr_b16 %6, %14\n\tds_read_b64_tr_b16 %7, %15\n\t"
                         "s_waitcnt lgkmcnt(0)"
                         : "=&v"(f[0][0]), "=&v"(f[0][1]), "=&v"(f[1][0]), "=&v"(f[1][1]), "=&v"(f[2][0]), "=&v"(f[2][1]), "=&v"(f[3][0]), "=&v"(f[3][1])
                         : "v"(vb + tra[0][0]), "v"(vb + tra[0][1]), "v"(vb + tra[1][0]), "v"(vb + tra[1][1]), "v"(vb + tra[2][0]), "v"(vb + tra[2][1]), "v"(vb + tra[3][0]), "v"(vb + tra[3][1])
                         : "memory");
#pragma unroll
            for (int c = 0; c < 4; ++c) { v4u t; t.x = f[c][0].x; t.y = f[c][0].y; t.z = f[c][1].x; t.w = f[c][1].y;
                O[c] = __builtin_amdgcn_mfma_f32_16x16x32_bf16(__builtin_bit_cast(bf16x8, t), pf, O[c], 0, 0, 0); }
        }
        const float inv = 1.0f / sum;
#pragma unroll
        for (int c = 0; c < 4; ++c) { v2u w; w.x = pk2(O[c][0] * inv, O[c][1] * inv); w.y = pk2(O[c][2] * inv, O[c][3] * inv);
            *(GAS v2u*)(OB + (size_t)tok * D + m * 64 + 16 * c + 4 * g) = w; }
        { const int tokn = vcu * 256 + F.wave + 8 * (it < 31 ? it + 1 : it); ATT_KOFF(ni0, ni1); ATT_KLOAD(KV8 + (size_t)(tokn >> 11) * SEQ * 128); }
    }
    asm volatile("s_waitcnt vmcnt(0)" ::: "memory");
#undef ATT_KOFF
#undef ATT_KLOAD
#undef ATT_KWAIT
    }
}
constexpr int XCS = 136;
constexpr int HHS = 132;
__device__ __forceinline__ float gelu_tanh(float x) {
    const float z = 0.7978845608028654f * (x + 0.044715f * x * x * x);
    const float e = __builtin_amdgcn_exp2f(2.885390081777927f * z);
    const float th = 1.0f - 2.0f * __builtin_amdgcn_rcpf(e + 1.0f);
    return 0.5f * x * (1.0f + th);
}
template <bool DRY = false>
__device__ __forceinline__ void lru_phase(const Frame& F0, int L) {
    Frame F = launder(F0);
    const KArgs ka = kargs();
    const int b = F.bx >> 3, nb = F.bx & 7;
    const bf16* XR = (const bf16*)(F.ws + Z_XR); bf16* YR = (bf16*)(F.ws + Z_YR);
    const bf16* WL = (const bf16*)(F.ws + WS_W + W_LRU);
    LAS bf16* XC = (LAS bf16*)(F.lds + RING_OFF);
    LAS float* HH = (LAS float*)(F.lds + RING_OFF + 2 * 64 * XCS * 2);
    const int tid = F.tid, lane = F.lane, w = F.wave, g = lane >> 4, m = lane & 15;
    const int cc = tid & 15, tp = tid >> 4;
    const int ch0 = nb * 128 + 8 * cc;
    float cw[4][8], cbias[8];
#pragma unroll
    for (int j = 0; j < 4; ++j)
#pragma unroll
        for (int k = 0; k < 8; ++k) cw[j][k] = ka->in[I_CONVW][(size_t)L * 4 * D + j * D + ch0 + k];
#pragma unroll
    for (int k = 0; k < 8; ++k) cbias[k] = ka->in[I_CONVB][(size_t)L * D + ch0 + k];
    bf16x8 Br[4], Bi[4];
#pragma unroll
    for (int s = 0; s < 4; ++s) { Br[s] = *(const GAS bf16x8*)(WL + ((size_t)nb * 128 + 16 * w + m) * 128 + 32 * s + 8 * g);
                                  Bi[s] = *(const GAS bf16x8*)(WL + (size_t)8 * 128 * 128 + ((size_t)nb * 128 + 16 * w + m) * 128 + 32 * s + 8 * g); }
    const int chl = 16 * w + m, chg = nb * 128 + chl;
    const float ba = ka->in[I_LRUBA][(size_t)L * D + chg], bx = ka->in[I_LRUBX][(size_t)L * D + chg];
    const float lam = ka->in[I_LAM][(size_t)L * D + chg];
    const float sp8 = -8.0f * (fmaxf(-lam, 0.f) + log1pf(__expf(-fabsf(lam))));
    float carry = 0.f;
    const size_t rowb = (size_t)b * SEQ;
    v4u nxin[5], nyin[2];
#pragma unroll
    for (int k = 0; k < 5; ++k) { const int t = 2 * tp - 3 + k; v4u z; z.x = z.y = z.z = z.w = 0u; nxin[k] = (t >= 0) ? *(const GAS v4u*)(XR + (rowb + t) * D + ch0) : z; }
#pragma unroll
    for (int k = 0; k < 2; ++k) nyin[k] = *(const GAS v4u*)(YR + (rowb + 2 * tp + k) * D + ch0);
    for (int tile = 0; tile < 32; ++tile) {
        const int t0 = tile * 64, buf = tile & 1;
        LAS bf16* xc = XC + buf * 64 * XCS; LAS float* hh = HH + buf * 64 * HHS;
        v4u xin[5], yin[2];
#pragma unroll
        for (int k = 0; k < 5; ++k) xin[k] = nxin[k];
#pragma unroll
        for (int k = 0; k < 2; ++k) yin[k] = nyin[k];
        if (tile < 31) {
#pragma unroll
            for (int k = 0; k < 5; ++k) nxin[k] = *(const GAS v4u*)(XR + (rowb + t0 + 64 + 2 * tp - 3 + k) * D + ch0);
#pragma unroll
            for (int k = 0; k < 2; ++k) nyin[k] = *(const GAS v4u*)(YR + (rowb + t0 + 64 + 2 * tp + k) * D + ch0);
        }
#pragma unroll
        for (int k = 0; k < 2; ++k) { float o[8];
#pragma unroll
            for (int c = 0; c < 8; ++c) { float a = cbias[c];
#pragma unroll
                for (int j = 0; j < 4; ++j) { const unsigned wv = xin[k + j][c >> 1]; a += ((c & 1) ? bf_hi(wv) : bf_lo(wv)) * cw[j][c]; }
                o[c] = a; }
            v4u pw; pw.x = pk2(o[0], o[1]); pw.y = pk2(o[2], o[3]); pw.z = pk2(o[4], o[5]); pw.w = pk2(o[6], o[7]);
            *(LAS v4u*)(xc + (2 * tp + k) * XCS + 8 * cc) = pw; }
        __syncthreads();
#pragma unroll
        for (int mt = 0; mt < 4; ++mt) {
            f32x4 ar = (f32x4){0.f, 0.f, 0.f, 0.f}, ai = (f32x4){0.f, 0.f, 0.f, 0.f};
#pragma unroll
            for (int s = 0; s < 4; ++s) { const bf16x8 A = *(const LAS bf16x8*)(xc + (16 * mt + m) * XCS + 32 * s + 8 * g);
                ar = __builtin_amdgcn_mfma_f32_16x16x32_bf16(A, Br[s], ar, 0, 0, 0); ai = __builtin_amdgcn_mfma_f32_16x16x32_bf16(A, Bi[s], ai, 0, 0, 0); }
            float P[4], W[4];
#pragma unroll
            for (int i = 0; i < 4; ++i) {
                const float rr = sigmoidf_fast(ar[i] + ba), ig = sigmoidf_fast(ai[i] + bx);
                const float la = sp8 * rr;
                const float a = __builtin_amdgcn_exp2f(1.4426950408889634f * la);
                const float mult = __builtin_amdgcn_sqrtf(fmaxf(__builtin_fmaf(-a, a, 1.0f), 0.f));
                const float xv = __builtin_bit_cast(float, (unsigned)xc[(16 * mt + 4 * g + i) * XCS + chl] << 16);
                const float u = mult * (ig * xv);
                if (i == 0) { P[0] = a; W[0] = u; } else { P[i] = a * P[i - 1]; W[i] = a * W[i - 1] + u; }
            }
            float Ac = P[3], Uc = W[3];
            { const float A1 = lane_up(Ac, 16, lane), U1 = lane_up(Uc, 16, lane); if (g >= 1) { Uc = Ac * U1 + Uc; Ac = Ac * A1; } }
            { const float A2 = lane_up(Ac, 32, lane), U2 = lane_up(Uc, 32, lane); if (g >= 2) { Uc = Ac * U2 + Uc; Ac = Ac * A2; } }
            float Ae = lane_up(Ac, 16, lane), Ue = lane_up(Uc, 16, lane); if (g == 0) { Ae = 1.f; Ue = 0.f; }
            const float hin = Ae * carry + Ue;
            const float cnew = Ac * carry + Uc;
            carry = lane_get(cnew, 48 + m);
#pragma unroll
            for (int i = 0; i < 4; ++i) hh[(16 * mt + 4 * g + i) * HHS + chl] = P[i] * hin + W[i];
        }
        __syncthreads();
#pragma unroll
        for (int k = 0; k < 2; ++k) { const f32x4 h0 = *(const LAS f32x4*)(hh + (2 * tp + k) * HHS + 8 * cc), h1 = *(const LAS f32x4*)(hh + (2 * tp + k) * HHS + 8 * cc + 4);
            float o[8];
#pragma unroll
            for (int c = 0; c < 8; ++c) { const unsigned wv = yin[k][c >> 1]; const float y = (c & 1) ? bf_hi(wv) : bf_lo(wv); o[c] = (c < 4 ? h0[c] : h1[c - 4]) * gelu_tanh(y); }
            v4u pw; pw.x = pk2(o[0], o[1]); pw.y = pk2(o[2], o[3]); pw.z = pk2(o[4], o[5]); pw.w = pk2(o[6], o[7]);
            *(GAS v4u*)((DRY ? (bf16*)(F.ws + WS_NEED) : YR) + (rowb + t0 + 2 * tp + k) * D + ch0) = pw; }
    }
    __syncthreads();
}

struct MoeOrder : pg8::StaticOrder {
    const volatile LAS unsigned* tb; int tile0; const int* list; size_t bstride;
    __device__ __forceinline__ int expert_of(int gt) const { int e = 0;
#pragma unroll
        for (int k = 1; k < 8; ++k) e += (gt >= (int)tb[k]) ? 1 : 0;
        return e; }
    __device__ __forceinline__ const char* b_base(const pg8::Gemm& g, const pg8::Unit& u, size_t tstep) const { return (const char*)g.Bt + (size_t)expert_of(tile0 + u.pm) * bstride + (size_t)u.pn * tstep; }
};
struct MoeGatherOrder : MoeOrder {
    static constexpr bool GATHER = true;
    __device__ __forceinline__ const char* a_base(const pg8::Gemm& g, const pg8::Unit&, size_t) const { return (const char*)g.A; }
    __device__ __forceinline__ void a_rows(const pg8::Unit& u, int R0, int R1, int C0, int C1, int K, unsigned (&off)[2][2]) const {
        const int gt = tile0 + u.pm, e = expert_of(gt), j = gt - (int)tb[e], n = (int)tb[16 + e];
        const GAS int* le = (const GAS int*)list + (size_t)e * T_TOK;
#pragma unroll
        for (int h = 0; h < 2; ++h) { int p0 = 256 * j + 128 * h + R0, p1 = 256 * j + 128 * h + R1; p0 = p0 < n ? p0 : n - 1; p1 = p1 < n ? p1 : n - 1;
            off[h][0] = ((unsigned)le[p0] * (unsigned)K + (unsigned)C0) * 2u; off[h][1] = ((unsigned)le[p1] * (unsigned)K + (unsigned)C1) * 2u; }
    }
};
#ifdef SELFCHECK
#ifndef SC_TOL
#define SC_TOL 0.03f
#define SC_ABS 1e-5f
#endif
__device__ __forceinline__ float sc_bf(const bf16* p, size_t i) { return __builtin_bit_cast(float, (unsigned)((const GAS bf16*)p)[i] << 16); }
__device__ __forceinline__ float sc_f8(const unsigned char* p, size_t i) {
    const unsigned v = ((const GAS unsigned char*)p)[i]; const unsigned e = (v >> 3) & 15u, mn = v & 7u; float r;
    if (e == 0u) r = (float)mn * 0.001953125f; else r = (1.0f + (float)mn * 0.125f) * exp2f((float)e - 7.0f);
    return (v & 128u) ? -r : r; }
__device__ __forceinline__ void sc_fail(const Frame& F, unsigned code) { __hip_atomic_fetch_or(F.ctl + CW_CODE, code, RLX_AGENT); }
__device__ __forceinline__ int sc_bucket_ref(int rel) {
    const int half = 16, max_exact = 8; const int ret = rel > 0 ? half : 0; const int n = rel < 0 ? -rel : rel;
    const float nf = (float)(n > 1 ? n : 1);
    int large = max_exact + (int)(logf(nf / (float)max_exact) / logf(16.0f) * (float)(half - max_exact));
    large = large < half - 1 ? large : half - 1;
    return ret + (n < max_exact ? n : large);
}
__device__ __forceinline__ void selfcheck_topk(const Frame& F0) {
    Frame F = launder(F0);
    if (F.wave != 0) return;
    const bf16* QI = (const bf16*)(F.ws + Z_QI); const bf16* SM = (const bf16*)(F.ws + Z_SM);
    const GAS unsigned short* IDX = (const GAS unsigned short*)(F.ws + WS_IDX);
    LAS float* sc = (LAS float*)(F.lds + RING_OFF);
    LAS unsigned* bm = (LAS unsigned*)(F.lds + RING_OFF + 8192);
    const int tok = F.bx * 256 + ((F.bx * 37) & 255), b = tok >> 11, tq = tok & (SEQ - 1), n_adm = ((tq >> 6) + 1) * 64;
    const int lane = F.lane;
    bm[lane] = 0u;
    for (int s = lane; s < n_adm; s += 64) { float score = 0.f;
        for (int h = 0; h < 8; ++h) { float d = 0.f;
            for (int k = 0; k < 64; ++k) d += sc_bf(QI, (size_t)tok * 512 + h * 64 + k) * sc_bf(SM, (size_t)(b * SEQ + s) * 256 + 128 + k);
            score += fmaxf(d, 0.f) * sc_bf(SM, (size_t)tok * 256 + 192 + h); }
        sc[s] = score; }
    asm volatile("s_waitcnt lgkmcnt(0)" ::: "memory");
    const int nsel = n_adm < 256 ? n_adm : 256;
    float msel = 3.0e38f; bool bad = false;
    for (int p = lane; p < nsel; p += 64) { const int key = IDX[(size_t)tok * 256 + p]; if (key >= n_adm) { bad = true; continue; }
        const unsigned old = __hip_atomic_fetch_or(bm + (key >> 5), 1u << (key & 31), __ATOMIC_RELAXED, __HIP_MEMORY_SCOPE_WORKGROUP); if (old & (1u << (key & 31))) bad = true;
        msel = fminf(msel, sc[key]); }
    asm volatile("s_waitcnt lgkmcnt(0)" ::: "memory");
    float muns = -3.0e38f, amax = 0.f;
    for (int s = lane; s < n_adm; s += 64) { amax = fmaxf(amax, fabsf(sc[s])); if (!((bm[s >> 5] >> (s & 31)) & 1u)) muns = fmaxf(muns, sc[s]); }
#pragma unroll
    for (int o = 1; o < 64; o <<= 1) { msel = fminf(msel, lane_xor(msel, o, lane)); muns = fmaxf(muns, lane_xor(muns, o, lane)); amax = fmaxf(amax, lane_xor(amax, o, lane)); }
    if (muns > msel + 1e-4f * amax) bad = true;
    if (__any(bad)) { if (lane == 0) sc_fail(F, 1u); }
}
__device__ __forceinline__ void selfcheck_attn(const Frame& F0) {
    Frame F = launder(F0);
    if (F.wave != 0) return;
    const KArgs ka = kargs();
    const unsigned char* Q8 = F.ws + Z_Q8; const unsigned char* KV8 = F.ws + Z_KV8; const bf16* OB = (const bf16*)(F.ws + Z_XR);
    const GAS unsigned short* IDX = (const GAS unsigned short*)(F.ws + WS_IDX);
    LAS float* lg = (LAS float*)(F.lds + RING_OFF + 65536);
    const int tok = F.bx * 256 + ((F.bx * 37) & 255), b = tok >> 11, tq = tok & (SEQ - 1), n_adm = ((tq >> 6) + 1) * 64, nv = n_adm < 256 ? n_adm : 256;
    const int lane = F.lane;
    for (int p = lane; p < 256; p += 64) { const int key = IDX[(size_t)tok * 256 + p]; const int bk = sc_bucket_ref(key - tq);
        for (int h = 0; h < 16; ++h) { float d = 0.f;
            for (int k = 0; k < 64; ++k) d += sc_f8(Q8, (size_t)tok * D + h * 64 + k) * sc_f8(KV8, (size_t)(b * SEQ + key) * 128 + k);
            lg[h * 256 + p] = p < nv ? 0.125f * d + ((const GAS float*)ka->in[I_RELB])[bk * 16 + h] : -1e30f; } }
    asm volatile("s_waitcnt lgkmcnt(0)" ::: "memory");
    if (lane < 16) { float mx = -3.0e38f; for (int p = 0; p < 256; ++p) mx = fmaxf(mx, lg[lane * 256 + p]); float sum = 0.f;
        for (int p = 0; p < 256; ++p) { const float e = __expf(lg[lane * 256 + p] - mx); lg[lane * 256 + p] = e; sum += e; }
        const float inv = 1.f / sum; for (int p = 0; p < 256; ++p) lg[lane * 256 + p] *= inv; }
    asm volatile("s_waitcnt lgkmcnt(0)" ::: "memory");
    float emax = 0.f, omax = 0.f;
    for (int o = lane; o < 1024; o += 64) { const int h = o >> 6, d = o & 63; float acc = 0.f;
        for (int p = 0; p < 256; ++p) { const int key = IDX[(size_t)tok * 256 + p]; acc += lg[h * 256 + p] * sc_f8(KV8, (size_t)(b * SEQ + key) * 128 + 64 + d); }
        const float got = sc_bf(OB, (size_t)tok * D + o); emax = fmaxf(emax, fabsf(got - acc)); omax = fmaxf(omax, fabsf(acc)); }
#pragma unroll
    for (int o = 1; o < 64; o <<= 1) { emax = fmaxf(emax, lane_xor(emax, o, lane)); omax = fmaxf(omax, lane_xor(omax, o, lane)); }
    if (!(emax <= SC_TOL * omax + SC_ABS)) { if (lane == 0) sc_fail(F, 2u); }
}
__device__ __forceinline__ void selfcheck_lru(const Frame& F0, int L, bool after) {
    Frame F = launder(F0);
    if (F.wave != 0) return;
    const KArgs ka = kargs();
    const bf16* XR = (const bf16*)(F.ws + Z_XR); const bf16* YR = (const bf16*)(F.ws + Z_YR);
    GAS float* EXP = (GAS float*)(F.ws + WS_NEED) + (size_t)F.bx * SEQ;
    const int b = F.bx >> 3, ch = ((F.bx & 7) * 128 + ((F.bx * 29) & 127)), nb = ch >> 7, lane = F.lane;
    if (after) { float emax = 0.f, omax = 0.f;
        for (int t = lane; t < SEQ; t += 64) { const float e = EXP[t], g = sc_bf(YR, (size_t)(b * SEQ + t) * D + ch); emax = fmaxf(emax, fabsf(e - g)); omax = fmaxf(omax, fabsf(e)); }
#pragma unroll
        for (int o = 1; o < 64; o <<= 1) { emax = fmaxf(emax, lane_xor(emax, o, lane)); omax = fmaxf(omax, lane_xor(omax, o, lane)); }
        if (!(emax <= SC_TOL * omax + SC_ABS)) { if (lane == 0) sc_fail(F, 4u); }
        return; }
    const float* cw = ka->in[I_CONVW] + (size_t)L * 4 * D; const float* cb = ka->in[I_CONVB] + (size_t)L * D;
    const float* wa = ka->in[I_LRUWA] + ((size_t)L * 8 + nb) * 128 * 128; const float* wx = ka->in[I_LRUWX] + ((size_t)L * 8 + nb) * 128 * 128;
    const float lam = ka->in[I_LAM][(size_t)L * D + ch], ba = ka->in[I_LRUBA][(size_t)L * D + ch], bx = ka->in[I_LRUBX][(size_t)L * D + ch];
    const float sp = fmaxf(-lam, 0.f) + log1pf(expf(-fabsf(lam)));
    const int dl = ch & 127;
    float h = 0.f;
    for (int t = 0; t < SEQ; ++t) {
        float pr = 0.f, pi = 0.f, xcc = 0.f;
#pragma unroll
        for (int q = 0; q < 2; ++q) { const int cl = lane + 64 * q, cg = nb * 128 + cl; float xc = cb[cg];
            for (int j = 0; j < 4; ++j) { const int tt = t - 3 + j; if (tt >= 0) xc += sc_bf(XR, (size_t)(b * SEQ + tt) * D + cg) * cw[j * D + cg]; }
            pr += xc * wa[cl * 128 + dl]; pi += xc * wx[cl * 128 + dl]; if (cl == dl) xcc = xc; }
#pragma unroll
        for (int o = 1; o < 64; o <<= 1) { pr += lane_xor(pr, o, lane); pi += lane_xor(pi, o, lane); xcc += lane_xor(xcc, o, lane); }
        const float r = 1.f / (1.f + expf(-(pr + ba))), ig = 1.f / (1.f + expf(-(pi + bx)));
        const float la = -8.0f * r * sp, a = expf(la), u = sqrtf(-expm1f(2.0f * la)) * (ig * xcc);
        h = a * h + u;
        const float y = sc_bf(YR, (size_t)(b * SEQ + t) * D + ch);
        const float gl = 0.5f * y * (1.f + tanhf(0.7978845608028654f * (y + 0.044715f * y * y * y)));
        if (lane == 0) EXP[t] = h * gl;
    }
}
#endif
__global__ void __launch_bounds__(NWAVES * 64, 2) mk_fwd(Args args) {
    extern __shared__ __attribute__((aligned(16))) unsigned char lds[];
    Frame F;
    F.lds = (LAS unsigned char*)lds;
    F.MISC = (volatile LAS unsigned*)(F.lds + MISC_OFF);
    F.tid = threadIdx.x; F.lane = F.tid & 63; F.wave = __builtin_amdgcn_readfirstlane(F.tid >> 6);
    F.G = gridDim.x; F.bx = blockIdx.x;
    F.ws = args.ws; F.ctl = (gu32*)(args.ws + WS_CTL); F.out = args.out;
    for (int u = threadIdx.x; u < (LDS_BYTES - LDSCTL_OFF) / 4; u += NWAVES * 64) ((LAS unsigned*)(F.lds + LDSCTL_OFF))[u] = 0u;
    __syncthreads();
    XcdBarrier bar = xcd_barrier_post((unsigned*)(F.ctl + CW_BAR), F.MISC + 8);
#define GRID_BAR() do { XcdBarrier b_ = bar; unsigned* p_ = bar.bar; asm volatile("" : "+s"(p_)); b_.bar = p_; xcd_barrier(b_); } while (0)
    float* X32 = args.out;
#define LOCAL_HANDOFF() do { asm volatile("s_waitcnt vmcnt(0)" ::: "memory"); __syncthreads(); __builtin_amdgcn_fence(__ATOMIC_ACQUIRE, "agent"); asm volatile("s_waitcnt vmcnt(0)" ::: "memory"); __syncthreads(); } while (0)
    LAS unsigned char* ring = F.lds + RING_OFF;
    using pg8::Gemm; using pg8::StaticOrder;

    for (int L = 0; L < DEPTH; ++L) {
        const int odd = L & 1;
#ifndef SK_P0
        p0_convert(F, L);
#endif
#ifdef DUP_P0
        __syncthreads(); p0_convert(F, L);
#endif
        GRID_BAR();
        { const Frame P = launder(F); unsigned char* ws = P.ws; unsigned char* wb = ws + WS_W; bf16* XB = (bf16*)(ws + WS_XB); (void)XB; (void)wb;
          Gemm g{XB, (const bf16*)(wb + W_IN), T_TOK, NIN, D}; StaticOrder S; S.init(T_TOK, NIN, P.G, P.bx);
          pg8::EpiZ E{(bf16*)(ws + Z_Q), (bf16*)(ws + Z_QI), (bf16*)(ws + Z_SM), ws + Z_Q8, ws + Z_KV8};
#ifndef SK_G1
          pg8::gemm_phase<pg8::EpiZ, StaticOrder>(ring, g, S, E, P.wave);
#endif
        }
        GRID_BAR();
#if defined(SELFCHECK) && SELFCHECK == 3
        if (L == 0) { selfcheck_lru(F, L, false); __syncthreads(); }
#endif
#ifndef SK_IDX
        indexer_phase(F);
#endif
#ifdef DUP_IDX
        indexer_phase(F);
#endif
#ifdef DUP_LRU
        lru_phase<true>(F, L);
#endif
#ifndef SK_LRU
        lru_phase(F, L);
#endif
        GRID_BAR();
#if defined(SELFCHECK) && SELFCHECK == 1
        if (L == 0) { selfcheck_topk(F); __syncthreads(); }
#endif
#if defined(SELFCHECK) && SELFCHECK == 3
        if (L == 0) { selfcheck_lru(F, L, true); __syncthreads(); }
#endif
#ifdef DUP_ATT
        attention_phase<DUP_ATT>(F); __syncthreads();
#endif
#ifndef SK_ATT
        attention_phase(F);
#endif
        GRID_BAR();
#if defined(SELFCHECK) && SELFCHECK == 2
        if (L == 0) { selfcheck_attn(F); __syncthreads(); }
#endif
        { const Frame P = launder(F); unsigned char* ws = P.ws; unsigned char* wb = ws + WS_W; bf16* XB = (bf16*)(ws + WS_XB); (void)XB; (void)wb;
          Gemm g{(const bf16*)(ws + Z_XR), (const bf16*)(wb + W_BRA), T_TOK, D, D}; StaticOrder S; S.init(T_TOK, D, F.G, F.bx);
          pg8::EpiGate<0> E{(bf16*)(ws + Z_GA), nullptr};
#ifndef SK_G2
          pg8::gemm_phase<pg8::EpiGate<0>, StaticOrder>(ring, g, S, E, P.wave);
#endif
        }
        LOCAL_HANDOFF();
        { const Frame P = launder(F); unsigned char* ws = P.ws; unsigned char* wb = ws + WS_W; bf16* XB = (bf16*)(ws + WS_XB); (void)XB; (void)wb;
          Gemm g{(const bf16*)(ws + Z_YR), (const bf16*)(wb + W_BRR), T_TOK, D, D}; StaticOrder S; S.init(T_TOK, D, F.G, F.bx);
          pg8::EpiGate<1> E{(bf16*)(ws + Z_GA), (const bf16*)(ws + Z_GR)};
#ifndef SK_G3
          pg8::gemm_phase<pg8::EpiGate<1>, StaticOrder>(ring, g, S, E, P.wave);
#endif
        }
        GRID_BAR();
        { const Frame P = launder(F); unsigned char* ws = P.ws; unsigned char* wb = ws + WS_W; bf16* XB = (bf16*)(ws + WS_XB); (void)XB; (void)wb;
          Gemm g{(const bf16*)(ws + Z_GA), (const bf16*)(wb + W_O), T_TOK, D, D}; StaticOrder S; S.init(T_TOK, D, F.G, F.bx);
          pg8::EpiRes<0> E{X32, XB, nullptr};
#ifndef SK_G4
          pg8::gemm_phase<pg8::EpiRes<0>, StaticOrder>(ring, g, S, E, P.wave);
#endif
        }
        GRID_BAR();
#ifdef DUP_LN
        ln_phase<false, false, true>(F, L); ln_phase<false, false, true>(F, L);
#endif
#ifndef SK_LN
        if (odd) ln_phase<false, true>(F, L); else ln_phase<false, false>(F, L);
#endif
        GRID_BAR();
        if (odd) {
            if (launder(F).tid == 0) { unsigned acc = 0u; F.MISC[16] = 0u;
                for (int e = 0; e < 8; ++e) { const unsigned c = __hip_atomic_load(F.ctl + CW_CNT + (L >> 1) * 1024 + 64 * e, RLX_AGENT); F.MISC[32 + e] = c; acc += (c + 255u) >> 8; F.MISC[17 + e] = acc; } }
            __syncthreads();
        }
        { const Frame P = launder(F); unsigned char* ws = P.ws; unsigned char* wb = ws + WS_W; bf16* XB = (bf16*)(ws + WS_XB); (void)XB; (void)wb;
          Gemm g{(const bf16*)(ws + F_PB), (const bf16*)(wb + W_PP), T_TOK, D, PLE}; StaticOrder S; S.init(T_TOK, D, F.G, F.bx);
          pg8::EpiBf16 E{(bf16*)(ws + F_U), D, 0};
#ifndef SK_G5
          pg8::gemm_phase<pg8::EpiBf16, StaticOrder>(ring, g, S, E, P.wave);
#endif
        }
        LOCAL_HANDOFF();
        { const Frame P = launder(F); unsigned char* ws = P.ws; unsigned char* wb = ws + WS_W; bf16* XB = (bf16*)(ws + WS_XB); (void)XB; (void)wb;
          Gemm g{XB, (const bf16*)(wb + W_PG), T_TOK, D, D}; StaticOrder S; S.init(T_TOK, D, F.G, F.bx);
          pg8::EpiRes<1> E{X32, XB, (const bf16*)(ws + F_U)};
#ifndef SK_G6
          pg8::gemm_phase<pg8::EpiRes<1>, StaticOrder>(ring, g, S, E, P.wave);
#endif
        }
        if (!odd) {
            { const Frame P = launder(F); unsigned char* ws = P.ws; unsigned char* wb = ws + WS_W; bf16* XB = (bf16*)(ws + WS_XB); (void)XB; (void)wb;
          Gemm g{XB, (const bf16*)(wb + W_FF), T_TOK, 2 * DFF, D}; StaticOrder S; S.init(T_TOK, 2 * DFF, F.G, F.bx);
              pg8::EpiSwiglu E{(bf16*)(ws + F_H), DFF};
#ifndef SK_G7
              pg8::gemm_phase<pg8::EpiSwiglu, StaticOrder>(ring, g, S, E, P.wave);
#endif
        }
            GRID_BAR();
            { const Frame P = launder(F); unsigned char* ws = P.ws; unsigned char* wb = ws + WS_W; bf16* XB = (bf16*)(ws + WS_XB); (void)XB; (void)wb;
          Gemm g{(const bf16*)(ws + F_H), (const bf16*)(wb + W_FF_DN_DENSE), T_TOK, D, DFF}; StaticOrder S; S.init(T_TOK, D, F.G, F.bx);
              pg8::EpiRes<2> E{X32, nullptr, nullptr};
#ifndef SK_G8
              pg8::gemm_phase<pg8::EpiRes<2>, StaticOrder>(ring, g, S, E, P.wave);
#endif
        }
            GRID_BAR();
#ifndef SK_LN
            ln_phase<true, false>(F, L);
#endif
        } else {
            const int ntiles = (int)F.MISC[24];
            const int nchunks = (ntiles + MOE_CHUNK_TILES - 1) / MOE_CHUNK_TILES;
            for (int c = 0; c < nchunks; ++c) {
                const int tile0 = c * MOE_CHUNK_TILES, ntl = (ntiles - tile0) < MOE_CHUNK_TILES ? (ntiles - tile0) : MOE_CHUNK_TILES;
                const size_t hc_off = (c & 1) ? F_H1 : F_H;
                { const Frame P = launder(F); unsigned char* ws = P.ws; unsigned char* wb = ws + WS_W; bf16* XB = (bf16*)(ws + WS_XB); (void)XB; (void)wb;
          Gemm g{XB, (const bf16*)(wb + W_FF), ntl * 256, 2 * DFFE, D}; MoeGatherOrder S; S.init(ntl * 256, 2 * DFFE, F.G, F.bx);
                  S.tb = F.MISC + 16; S.tile0 = tile0; S.list = (const int*)(ws + WS_LIST); S.bstride = (size_t)2 * DFFE * D * 2;
                  pg8::EpiSwiglu E{(bf16*)(ws + hc_off), DFFE};
#ifndef SK_G9
                  pg8::gemm_phase<pg8::EpiSwiglu, MoeGatherOrder>(ring, g, S, E, P.wave);
#endif
        }
                GRID_BAR();
                { const Frame P = launder(F); unsigned char* ws = P.ws; unsigned char* wb = ws + WS_W; bf16* XB = (bf16*)(ws + WS_XB); (void)XB; (void)wb;
          Gemm g{(const bf16*)(ws + hc_off), (const bf16*)(wb + W_FF_DN_MOE), ntl * 256, D, DFFE}; MoeOrder S; S.init(ntl * 256, D, F.G, F.bx);
                  S.tb = F.MISC + 16; S.tile0 = tile0; S.list = nullptr; S.bstride = (size_t)D * DFFE * 2;
                  pg8::EpiBf16 E{(bf16*)(ws + F_YE), D, tile0 * 256};
#ifndef SK_G10
                  pg8::gemm_phase<pg8::EpiBf16, MoeOrder>(ring, g, S, E, P.wave);
#endif
        }
            }
            GRID_BAR();
#ifndef SK_LN
            ln_phase<true, true>(F, L);
#endif
        }
        GRID_BAR();
    }
    if (__hip_atomic_load(F.ctl + CW_BAR + XB_TMO, RLX_AGENT) != 0u || __hip_atomic_load(F.ctl + CW_CODE, RLX_AGENT) != 0u) {
        const float q = __builtin_nanf("");
        for (size_t i = (size_t)F.bx * 512 + launder(F).tid; i < (size_t)T_TOK * D; i += (size_t)F.G * 512) X32[i] = q;
    }
}

#if defined(SELFCHECK)
constexpr size_t WS_DRY_EXTRA = 4 * MiB;
#elif defined(DUP_LRU) || defined(DUP_LN)
constexpr size_t WS_DRY_EXTRA = 80 * MiB;
#else
constexpr size_t WS_DRY_EXTRA = 0;
#endif
extern "C" void kernel_launch(void* const* d_in, const int* in_sizes, int n_in, void* d_out, int out_size, void* d_ws, size_t ws_size, hipStream_t stream) {
    static int grid = 0;
    if (grid == 0) {
        if (n_in != 28 || out_size != T_TOK * D || ws_size < WS_NEED + WS_DRY_EXTRA) { fprintf(stderr, "kernel_launch: unexpected shapes: n_in %d out %d ws %zu (need %zu)\n", n_in, out_size, ws_size, (size_t)WS_END); grid = -1; return; }
        int dev = 0, cus = 0, per_cu = 0;
        if (hipGetDevice(&dev) != hipSuccess || hipDeviceGetAttribute(&cus, hipDeviceAttributeMultiprocessorCount, dev) != hipSuccess) { grid = -1; return; }
        if (hipFuncSetAttribute((const void*)mk_fwd, hipFuncAttributeMaxDynamicSharedMemorySize, LDS_BYTES) != hipSuccess) { fprintf(stderr, "kernel_launch: hipFuncSetAttribute failed\n"); grid = -1; return; }
        if (hipOccupancyMaxActiveBlocksPerMultiprocessor(&per_cu, (const void*)mk_fwd, NWAVES * 64, LDS_BYTES) != hipSuccess || per_cu < 1) { fprintf(stderr, "kernel_launch: occupancy query says %d blocks per CU\n", per_cu); }
        (void)hipGetLastError();
        grid = cus;
        if (grid != 256) { fprintf(stderr, "kernel_launch: this kernel needs a 256-CU device (got %d)\n", cus); grid = -1; return; }
    }
    if (grid < 0) return;
    if (hipMemsetAsync((char*)d_ws + WS_CTL, 0, CTL_ZERO_BYTES, stream) != hipSuccess) return;
    Args a{};
    for (int i = 0; i < 28; ++i) a.in[i] = (const float*)d_in[i];
    a.out = (float*)d_out; a.ws = (unsigned char*)d_ws;
    hipLaunchKernelGGL(mk_fwd, dim3(grid), dim3(NWAVES * 64), LDS_BYTES, stream, a);
}
```

```cpp
#include <hip/hip_runtime.h>
#include <cstdio>
#include <cstdint>

constexpr int T_TOK = 65536, D = 1024, SEQ = 2048, NBATCH = 32, DEPTH = 4;
constexpr int D_IN = 5832, NIN = 5888;
constexpr int DFF = 2816, DFFE = 3584, NEXP = 8, PLE = 256;
constexpr float LN_EPS = 1e-5f;
constexpr float DN_ALPHA = 1.681792830507429f;

namespace pg8 {
#define PG8_LAS __attribute__((address_space(3)))
typedef unsigned short bf16_t;
typedef short bf16x8 __attribute__((ext_vector_type(8)));
typedef float f32x4 __attribute__((ext_vector_type(4)));
typedef unsigned u32x4 __attribute__((ext_vector_type(4)));
typedef unsigned u32x2 __attribute__((ext_vector_type(2)));
constexpr int BM = 256, BK = 64, HALF = 128, HTB = HALF * BK * 2  , STAGE_BYTES = 8 * HTB, NXCD = 8, WGM = 8;

__host__ __device__ __forceinline__ int lds_byte(int r, int c) { const int st = (r >> 4) * 2 + (c >> 5), rr = r & 15, cc = c & 31, ob = rr * 64 + cc * 2; return st * 1024 + (ob ^ (((ob >> 9) & 1) << 5)); }
__host__ __device__ __forceinline__ void stage_rc(int b, int& R, int& C) { const int st = b / 1024, sb = b % 1024, swz = sb ^ (((sb >> 9) & 1) << 5); R = (st >> 1) * 16 + swz / 64; C = (st & 1) * 32 + (swz % 64) / 2; }
__host__ __device__ __forceinline__ int perm32(int rho) { const int n = rho >> 4, i = rho & 15; return 8 * (i >> 2) + 4 * n + (i & 3); }

struct Unit { int pm, pn; };
struct Gemm { const bf16_t* A; const bf16_t* Bt; int M, N, K; };

struct StaticOrder {
    static constexpr bool GATHER = false;
    int nM, nN, nwg, G, c;
    __host__ __device__ void init(int M, int N, int G_, int c_) { nM = M / BM; nN = N / BM; nwg = nM * nN; G = G_; c = c_; }
    __host__ __device__ bool next(int i, Unit& u) const {
        const long L = (long)i * G + c; if (L >= nwg) return false;
        int wgid = (int)L; { const int q = nwg / NXCD, r = nwg % NXCD, xcd = wgid % NXCD, off = wgid / NXCD; wgid = (xcd < r ? xcd * (q + 1) : r * (q + 1) + (xcd - r) * q) + off; }
        const int nig = WGM * nN, gid = wgid / nig, fm = gid * WGM, gsz = (nM - fm) < WGM ? (nM - fm) : WGM;
        u.pm = fm + ((wgid % nig) % gsz); u.pn = (wgid % nig) / gsz; return true;
    }
    __device__ __forceinline__ const char* a_base(const Gemm& g, const Unit& u, size_t tstep) const { return (const char*)g.A + (size_t)u.pm * tstep; }
    __device__ __forceinline__ const char* b_base(const Gemm& g, const Unit& u, size_t tstep) const { return (const char*)g.Bt + (size_t)u.pn * tstep; }
    __device__ __forceinline__ void a_rows(const Unit&, int, int, int, int, int, unsigned (&)[2][2]) const {}
    __device__ __forceinline__ void a_ready(const Unit&) const {}
    __device__ __forceinline__ void done(const Unit&) const {}
};

__device__ __forceinline__ unsigned cvt_pk_bf16(float lo, float hi) { unsigned r; asm volatile("v_cvt_pk_bf16_f32 %0, %1, %2" : "=v"(r) : "v"(lo), "v"(hi)); return r; }
__device__ __forceinline__ float bf_lo(unsigned w) { return __builtin_bit_cast(float, w << 16); }
__device__ __forceinline__ float bf_hi(unsigned w) { return __builtin_bit_cast(float, w & 0xffff0000u); }
__device__ __forceinline__ float sigmoidf_fast(float x) { return __builtin_amdgcn_rcpf(1.0f + __builtin_amdgcn_exp2f(-1.4426950408889634f * x)); }
#define EPI_FENCE() asm volatile("" ::: "memory")
#define EGAS __attribute__((address_space(1)))
__device__ __forceinline__ u32x4 pack8(const f32x4 v0, const f32x4 v1) { u32x4 w; w.x = cvt_pk_bf16(v0[0], v0[1]); w.y = cvt_pk_bf16(v0[2], v0[3]); w.z = cvt_pk_bf16(v1[0], v1[1]); w.w = cvt_pk_bf16(v1[2], v1[3]); return w; }

struct EpiBf16 {
    static constexpr bool PERM = true, AFTER_DRAIN = false;
    bf16_t* O; int ldc; int row_off;
    __device__ __forceinline__ void operator()(const f32x4 (&acc)[2][2][4][2], const Unit& u, int wr, int wc, int fr, int fq) const {
        { int l_ = (int)__builtin_amdgcn_mbcnt_hi(~0u, __builtin_amdgcn_mbcnt_lo(~0u, 0u)); asm volatile("" : "+v"(l_)); fr = l_ & 15; fq = l_ >> 4; }
        const int row0 = row_off + u.pm * BM + wr * 64 + fr, col0 = u.pn * BM + wc * 32 + 8 * fq;
#pragma unroll
        for (int ai = 0; ai < 2; ++ai)
#pragma unroll
            for (int m = 0; m < 4; ++m) { bf16_t* rowp = O + (size_t)(row0 + ai * HALF + m * 16) * ldc + col0;
#pragma unroll
                for (int bj = 0; bj < 2; ++bj) *(EGAS u32x4*)(rowp + bj * HALF) = pack8(acc[ai][bj][m][0], acc[ai][bj][m][1]); }
    }
};
__device__ __forceinline__ u32x2 pack8_fp8(const f32x4 v0, const f32x4 v1) { int a = __builtin_amdgcn_cvt_pk_fp8_f32(v0[0], v0[1], 0, false); a = __builtin_amdgcn_cvt_pk_fp8_f32(v0[2], v0[3], a, true);
    int b = __builtin_amdgcn_cvt_pk_fp8_f32(v1[0], v1[1], 0, false); b = __builtin_amdgcn_cvt_pk_fp8_f32(v1[2], v1[3], b, true); u32x2 r; r.x = (unsigned)a; r.y = (unsigned)b; return r; }
struct EpiZ {
    static constexpr bool PERM = true, AFTER_DRAIN = false;
    bf16_t* zbig; bf16_t* zqi; bf16_t* zsm; unsigned char* q8; unsigned char* kv8;
    __device__ __forceinline__ void operator()(const f32x4 (&acc)[2][2][4][2], const Unit& u, int wr, int wc, int fr, int fq) const {
        { int l_ = (int)__builtin_amdgcn_mbcnt_hi(~0u, __builtin_amdgcn_mbcnt_lo(~0u, 0u)); asm volatile("" : "+v"(l_)); fr = l_ & 15; fq = l_ >> 4; }
        const int row0 = u.pm * BM + wr * 64 + fr;
        if (u.pn < 4) {
            const int col0 = u.pn * BM + wc * 32 + 8 * fq;
#pragma unroll
            for (int ai = 0; ai < 2; ++ai)
#pragma unroll
                for (int m = 0; m < 4; ++m) { unsigned char* rowp = q8 + (size_t)(row0 + ai * HALF + m * 16) * D + col0;
#pragma unroll
                    for (int bj = 0; bj < 2; ++bj) *(EGAS u32x2*)(rowp + bj * HALF) = pack8_fp8(acc[ai][bj][m][0], acc[ai][bj][m][1]); }
            return;
        }
        bf16_t* base; int ld, colt;
        if (u.pn < 20) { base = zbig + (size_t)(u.pn >> 2) * ((size_t)T_TOK * D); ld = D; colt = (u.pn & 3) * BM; }
        else if (u.pn < 22) { base = zqi; ld = 512; colt = (u.pn - 20) * BM; }
        else { base = zsm; ld = 256; colt = 0; }
        const int col0 = colt + wc * 32 + 8 * fq;
#pragma unroll
        for (int ai = 0; ai < 2; ++ai)
#pragma unroll
            for (int m = 0; m < 4; ++m) { bf16_t* rowp = base + (size_t)(row0 + ai * HALF + m * 16) * ld + col0;
#pragma unroll
                for (int bj = 0; bj < 2; ++bj) *(EGAS u32x4*)(rowp + bj * HALF) = pack8(acc[ai][bj][m][0], acc[ai][bj][m][1]); }
        if (u.pn == 22) {
#pragma unroll
            for (int ai = 0; ai < 2; ++ai)
#pragma unroll
                for (int m = 0; m < 4; ++m) *(EGAS u32x2*)(kv8 + (size_t)(row0 + ai * HALF + m * 16) * 128 + wc * 32 + 8 * fq) = pack8_fp8(acc[ai][0][m][0], acc[ai][0][m][1]);
        }
    }
};
template <int MODE> struct EpiGate {
    static constexpr bool PERM = true, AFTER_DRAIN = false;
    bf16_t* G; const bf16_t* G2;
    __device__ __forceinline__ void operator()(const f32x4 (&acc)[2][2][4][2], const Unit& u, int wr, int wc, int fr, int fq) const {
        { int l_ = (int)__builtin_amdgcn_mbcnt_hi(~0u, __builtin_amdgcn_mbcnt_lo(~0u, 0u)); asm volatile("" : "+v"(l_)); fr = l_ & 15; fq = l_ >> 4; }
        const int row0 = u.pm * BM + wr * 64 + fr, col0 = u.pn * BM + wc * 32 + 8 * fq;
#pragma unroll
        for (int ai = 0; ai < 2; ++ai) {
            u32x4 gw[4][2], g2[4][2];
#pragma unroll
            for (int m = 0; m < 4; ++m)
#pragma unroll
                for (int bj = 0; bj < 2; ++bj) { const size_t o = (size_t)(row0 + ai * HALF + m * 16) * D + col0 + bj * HALF;
                    gw[m][bj] = *(const EGAS u32x4*)(G + o); if (MODE == 1) g2[m][bj] = *(const EGAS u32x4*)(G2 + o); }
#pragma unroll
            for (int m = 0; m < 4; ++m)
#pragma unroll
                for (int bj = 0; bj < 2; ++bj) { const size_t o = (size_t)(row0 + ai * HALF + m * 16) * D + col0 + bj * HALF;
                    f32x4 v0 = acc[ai][bj][m][0], v1 = acc[ai][bj][m][1];
#pragma unroll
                    for (int j = 0; j < 4; ++j) { const unsigned wa = gw[m][bj][j >> 1], wb = gw[m][bj][2 + (j >> 1)];
                        const float ga = (j & 1) ? bf_hi(wa) : bf_lo(wa), gb = (j & 1) ? bf_hi(wb) : bf_lo(wb);
                        if (MODE == 0) { v0[j] *= sigmoidf_fast(ga); v1[j] *= sigmoidf_fast(gb); }
                        else { const unsigned xa = g2[m][bj][j >> 1], xb = g2[m][bj][2 + (j >> 1)];
                            v0[j] = ga + v0[j] * sigmoidf_fast((j & 1) ? bf_hi(xa) : bf_lo(xa)); v1[j] = gb + v1[j] * sigmoidf_fast((j & 1) ? bf_hi(xb) : bf_lo(xb)); } }
                    *(EGAS u32x4*)(G + o) = pack8(v0, v1); }
            EPI_FENCE(); }
    }
};
template <int MODE> struct EpiRes {
    static constexpr bool PERM = false, AFTER_DRAIN = false;
    float* Y; const bf16_t* XB; const bf16_t* U;
    __device__ __forceinline__ void operator()(const f32x4 (&acc)[2][2][4][2], const Unit& u, int wr, int wc, int fr, int fq) const {
        { int l_ = (int)__builtin_amdgcn_mbcnt_hi(~0u, __builtin_amdgcn_mbcnt_lo(~0u, 0u)); asm volatile("" : "+v"(l_)); fr = l_ & 15; fq = l_ >> 4; }
        const int row0 = u.pm * BM + wr * 64 + fr, col0 = u.pn * BM + wc * 32 + 4 * fq;
#pragma unroll
        for (int ai = 0; ai < 2; ++ai) {
            u32x2 xw[4][2][2], uw[4][2][2]; f32x4 yv[4][2][2];
#pragma unroll
            for (int m = 0; m < 4; ++m)
#pragma unroll
                for (int bj = 0; bj < 2; ++bj)
#pragma unroll
                    for (int n = 0; n < 2; ++n) { const size_t o = (size_t)(row0 + ai * HALF + m * 16) * D + col0 + bj * HALF + n * 16;
                        if (MODE == 0 || MODE == 1) xw[m][bj][n] = *(const EGAS u32x2*)(XB + o);
                        if (MODE == 1) uw[m][bj][n] = *(const EGAS u32x2*)(U + o);
                        if (MODE == 2) yv[m][bj][n] = *(const EGAS f32x4*)(Y + o); }
#pragma unroll
            for (int m = 0; m < 4; ++m)
#pragma unroll
                for (int bj = 0; bj < 2; ++bj)
#pragma unroll
                    for (int n = 0; n < 2; ++n) { const size_t o = (size_t)(row0 + ai * HALF + m * 16) * D + col0 + bj * HALF + n * 16; const f32x4 a = acc[ai][bj][m][n]; f32x4 r;
                        if (MODE == 0) { const u32x2 x = xw[m][bj][n];
                            r[0] = bf_lo(x.x) * DN_ALPHA + a[0]; r[1] = bf_hi(x.x) * DN_ALPHA + a[1]; r[2] = bf_lo(x.y) * DN_ALPHA + a[2]; r[3] = bf_hi(x.y) * DN_ALPHA + a[3]; }
                        else if (MODE == 1) { const u32x2 x = xw[m][bj][n], w = uw[m][bj][n];
                            r[0] = bf_lo(x.x) * DN_ALPHA + sigmoidf_fast(a[0]) * bf_lo(w.x); r[1] = bf_hi(x.x) * DN_ALPHA + sigmoidf_fast(a[1]) * bf_hi(w.x);
                            r[2] = bf_lo(x.y) * DN_ALPHA + sigmoidf_fast(a[2]) * bf_lo(w.y); r[3] = bf_hi(x.y) * DN_ALPHA + sigmoidf_fast(a[3]) * bf_hi(w.y); }
                        else r = yv[m][bj][n] + a;
                        *(EGAS f32x4*)(Y + o) = r; }
            EPI_FENCE(); }
    }
};
struct EpiSwiglu {
    static constexpr bool PERM = true, AFTER_DRAIN = false;
    bf16_t* H; int ldh;
    __device__ __forceinline__ void operator()(const f32x4 (&acc)[2][2][4][2], const Unit& u, int wr, int wc, int fr, int fq) const {
        { int l_ = (int)__builtin_amdgcn_mbcnt_hi(~0u, __builtin_amdgcn_mbcnt_lo(~0u, 0u)); asm volatile("" : "+v"(l_)); fr = l_ & 15; fq = l_ >> 4; }
        const int row0 = u.pm * BM + wr * 64 + fr, col0 = u.pn * HALF + wc * 32 + 8 * fq;
#pragma unroll
        for (int ai = 0; ai < 2; ++ai)
#pragma unroll
            for (int m = 0; m < 4; ++m) { bf16_t* rowp = H + (size_t)(row0 + ai * HALF + m * 16) * ldh + col0;
                f32x4 v0, v1;
#pragma unroll
                for (int j = 0; j < 4; ++j) { const float g0 = acc[ai][0][m][0][j], g1 = acc[ai][0][m][1][j];
                    v0[j] = g0 * sigmoidf_fast(g0) * acc[ai][1][m][0][j]; v1[j] = g1 * sigmoidf_fast(g1) * acc[ai][1][m][1][j]; }
                *(EGAS u32x4*)rowp = pack8(v0, v1); }
    }
};
template <class Epi, class Sched, bool ALIGN_EPI = true>
__device__ __forceinline__ void gemm_phase(PG8_LAS unsigned char* lds, const Gemm g, const Sched& S, const Epi& E, const int wave_id) {
    int lane_ = (int)__builtin_amdgcn_mbcnt_hi(~0u, __builtin_amdgcn_mbcnt_lo(~0u, 0u)); asm volatile("" : "+v"(lane_));
    const int wid = wave_id, lane = lane_, tid = wid * 64 + lane, wr = wid >> 2, wc = wid & 3, fr = lane & 15, fq = lane >> 4;
    const int K = g.K, nt = K / BK;
    unsigned voffA[2], voffB[2]; int RA[2], CA[2];
#pragma unroll
    for (int i = 0; i < 2; ++i) { int R, C; stage_rc(tid * 16 + i * 8192, R, C); const int Rb = Epi::PERM ? ((R & ~31) + perm32(R & 31)) : R; RA[i] = R; CA[i] = C;
        voffA[i] = (unsigned)(R * K + C) * 2u; voffB[i] = (unsigned)(Rb * K + C) * 2u; }
    const size_t kstep = (size_t)(BK * 2);
    const size_t hstep = (size_t)HALF * K * 2;
    const size_t tstep = 2 * hstep;
    const unsigned ldsw = (unsigned)wid * 1024u;
    const int aoff = lds_byte(wr * 64 + fr, fq * 8), boff = lds_byte(wc * 32 + fr, fq * 8);
    unsigned offC[2][2] = {{0u, 0u}, {0u, 0u}}, offN[2][2] = {{0u, 0u}, {0u, 0u}};
#define PG8_SA(b, h) (((b) * 2 + (h)) * HTB)
#define PG8_SB(b, h) ((4 + (b) * 2 + (h)) * HTB)
#define PG8_STAGE(bufoff, gbase, voff) do { _Pragma("unroll") for (int _i = 0; _i < 2; ++_i) \
        __builtin_amdgcn_global_load_lds((const unsigned*)((const char*)(gbase) + (voff)[_i]), (PG8_LAS unsigned*)(lds + (bufoff) + ldsw + _i * 8192), 16, 0, 0); } while (0)
#define PG8_STA(bufoff, ptr, h, NX) do { if constexpr (Sched::GATHER) { _Pragma("unroll") for (int _i = 0; _i < 2; ++_i) { const unsigned _o = (NX) ? offN[h][_i] : offC[h][_i]; \
        __builtin_amdgcn_global_load_lds((const unsigned*)((const char*)(ptr) + _o), (PG8_LAS unsigned*)(lds + (bufoff) + ldsw + _i * 8192), 16, 0, 0); } } \
        else { PG8_STAGE(bufoff, (ptr) + (h) * hstep, voffA); } } while (0)
#define PG8_LDA(dst, b, h) do { _Pragma("unroll") for (int m = 0; m < 4; ++m) _Pragma("unroll") for (int k = 0; k < 2; ++k) dst[m][k] = *(const PG8_LAS bf16x8*)(lds + PG8_SA(b, h) + aoff + m * 2048 + k * 1024); } while (0)
#define PG8_LDB(dst, b, h) do { _Pragma("unroll") for (int n = 0; n < 2; ++n) _Pragma("unroll") for (int k = 0; k < 2; ++k) dst[n][k] = *(const PG8_LAS bf16x8*)(lds + PG8_SB(b, h) + boff + n * 2048 + k * 1024); } while (0)
#define PG8_MMA(ai, bj, At, Bt) do { __builtin_amdgcn_s_setprio(1); _Pragma("unroll") for (int m = 0; m < 4; ++m) _Pragma("unroll") for (int n = 0; n < 2; ++n) _Pragma("unroll") for (int k = 0; k < 2; ++k) \
        acc[ai][bj][m][n] = __builtin_amdgcn_mfma_f32_16x16x32_bf16(Bt[n][k], At[m][k], acc[ai][bj][m][n], 0, 0, 0); __builtin_amdgcn_s_setprio(0); } while (0)
#define PG8_WAIT_V(n) asm volatile("s_waitcnt vmcnt(" #n ")" ::: "memory")
#define PG8_WAIT_L(n) asm volatile("s_waitcnt lgkmcnt(" #n ")" ::: "memory")
#define PG8_BAR __builtin_amdgcn_s_barrier()
#define PG8_SCHED __builtin_amdgcn_sched_barrier(0)
    Unit cur, nxt; int ui = 0;
    if (!S.next(0, cur)) return;
    f32x4 acc[2][2][4][2];
#pragma unroll
    for (int a = 0; a < 2; ++a)
#pragma unroll
        for (int b = 0; b < 2; ++b)
#pragma unroll
            for (int m = 0; m < 4; ++m)
#pragma unroll
                for (int n = 0; n < 2; ++n) acc[a][b][m][n] = (f32x4){0.f, 0.f, 0.f, 0.f};
    bf16x8 At[4][2], B0[2][2], B1[2][2];
    const char* cA = S.a_base(g, cur, tstep); const char* cB = S.b_base(g, cur, tstep);
    if constexpr (Sched::GATHER) S.a_rows(cur, RA[0], RA[1], CA[0], CA[1], K, offC);
    S.a_ready(cur);
    PG8_STAGE(PG8_SB(0, 0), cB, voffB); PG8_STAGE(PG8_SB(0, 1), cB + hstep, voffB); PG8_STA(PG8_SA(0, 0), cA, 0, false); PG8_STA(PG8_SA(0, 1), cA, 1, false);
    if (wr == 1) PG8_BAR;
    PG8_WAIT_V(2); PG8_BAR;
    PG8_STAGE(PG8_SB(1, 0), cB + kstep, voffB); PG8_STA(PG8_SA(1, 0), cA + kstep, 0, false); PG8_STAGE(PG8_SB(1, 1), cB + hstep + kstep, voffB);
    PG8_WAIT_V(6); PG8_BAR;
    for (;;) {
        const bool has_next = S.next(ui + 1, nxt);
        const char* nA = has_next ? S.a_base(g, nxt, tstep) : cA; const char* nB = has_next ? S.b_base(g, nxt, tstep) : cB;
        if constexpr (Sched::GATHER) { if (has_next) S.a_rows(nxt, RA[0], RA[1], CA[0], CA[1], K, offN); else {
#pragma unroll
            for (int h = 0; h < 2; ++h)
#pragma unroll
                for (int i = 0; i < 2; ++i) offN[h][i] = offC[h][i]; } }
        for (int t = 0; t < nt; t += 2) {
            const bool last = (t == nt - 2);
            const char* a1 = cA + (size_t)(t + 1) * kstep;
            const char* a2 = last ? nA : cA + (size_t)(t + 2) * kstep; const char* b2 = last ? nB : cB + (size_t)(t + 2) * kstep;
            const char* a3 = a2 + kstep; const char* b3 = b2 + kstep;
            if (last && has_next) S.a_ready(nxt);
            PG8_LDB(B0, 0, 0); PG8_LDB(B1, 0, 1); PG8_SCHED; PG8_LDA(At, 0, 0); PG8_STA(PG8_SA(1, 1), a1, 1, false);
            PG8_WAIT_V(8); PG8_WAIT_L(0); PG8_BAR; PG8_MMA(0, 0, At, B0); PG8_MMA(0, 1, At, B1); PG8_BAR; PG8_SCHED;
            PG8_LDA(At, 0, 1); PG8_STAGE(PG8_SB(0, 0), b2, voffB); PG8_STAGE(PG8_SB(0, 1), b2 + hstep, voffB); PG8_STA(PG8_SA(0, 0), a2, 0, last);
            PG8_WAIT_V(8); PG8_WAIT_L(0); PG8_BAR; PG8_MMA(1, 0, At, B0); PG8_MMA(1, 1, At, B1); PG8_BAR; PG8_SCHED;
            PG8_LDB(B0, 1, 0); PG8_LDB(B1, 1, 1); PG8_SCHED; PG8_LDA(At, 1, 0); PG8_STA(PG8_SA(0, 1), a2, 1, last);
            PG8_WAIT_V(8); PG8_WAIT_L(0); PG8_BAR; PG8_MMA(0, 0, At, B0); PG8_MMA(0, 1, At, B1); PG8_BAR; PG8_SCHED;
            PG8_LDA(At, 1, 1); PG8_STAGE(PG8_SB(1, 0), b3, voffB); PG8_STAGE(PG8_SB(1, 1), b3 + hstep, voffB); PG8_STA(PG8_SA(1, 0), a3, 0, last);
            PG8_WAIT_V(8); PG8_WAIT_L(0); PG8_BAR; PG8_MMA(1, 0, At, B0); PG8_MMA(1, 1, At, B1); PG8_BAR; PG8_SCHED;
        }
        if constexpr (ALIGN_EPI) { if (wr == 0) PG8_BAR; }
        E(acc, cur, wr, wc, fr, fq); S.done(cur);
        if (!has_next) break;
#pragma unroll
        for (int a = 0; a < 2; ++a)
#pragma unroll
            for (int b = 0; b < 2; ++b)
#pragma unroll
                for (int m = 0; m < 4; ++m)
#pragma unroll
                    for (int n = 0; n < 2; ++n) acc[a][b][m][n] = (f32x4){0.f, 0.f, 0.f, 0.f};
        cur = nxt; cA = nA; cB = nB; ++ui;
        if constexpr (Sched::GATHER) {
#pragma unroll
            for (int h = 0; h < 2; ++h)
#pragma unroll
                for (int i = 0; i < 2; ++i) offC[h][i] = offN[h][i]; }
        if constexpr (ALIGN_EPI) { if (wr == 1) PG8_BAR; }
    }
    PG8_WAIT_V(0);
    if constexpr (!ALIGN_EPI) { if (wr == 0) PG8_BAR; }
    PG8_BAR;
#undef PG8_SA
#undef PG8_SB
#undef PG8_STAGE
#undef PG8_STA
#undef PG8_LDA
#undef PG8_LDB
#undef PG8_MMA
#undef PG8_WAIT_V
#undef PG8_WAIT_L
#undef PG8_BAR
#undef PG8_SCHED
}
}
constexpr int NWAVES = 8;
constexpr size_t MiB = 1u << 20;
constexpr size_t WS_CTL = 0, CTL_ZERO_BYTES = 1 * MiB;
constexpr size_t WS_ROUTE = 1 * MiB;
constexpr size_t WS_LIST = 3 * MiB;
constexpr size_t WS_W = 8 * MiB;
constexpr size_t W_IN = 0, W_BRA = 12 * MiB, W_BRR = 14 * MiB, W_O = 16 * MiB, W_PG = 18 * MiB, W_PP = 20 * MiB, W_LRU = 21 * MiB, W_FF = 22 * MiB;
constexpr size_t W_FF_DN_DENSE = W_FF + 11 * MiB, W_FF_DN_MOE = W_FF + 112 * MiB;
constexpr size_t WS_XB = 208 * MiB;
constexpr size_t WS_IDX = 336 * MiB;
constexpr size_t WS_Z = 368 * MiB;
constexpr size_t Z_Q = WS_Z, Z_XR = WS_Z + 128 * MiB, Z_YR = WS_Z + 256 * MiB, Z_GA = WS_Z + 384 * MiB, Z_GR = WS_Z + 512 * MiB, Z_QI = WS_Z + 640 * MiB, Z_SM = WS_Z + 704 * MiB;
constexpr size_t Z_Q8 = Z_Q, Z_KV8 = Z_Q + 64 * MiB;
constexpr size_t WS_END = WS_Z + 736 * MiB;
constexpr size_t F_U = Z_Q;
constexpr size_t F_PB = Z_SM;
constexpr size_t F_H = Z_XR;
constexpr size_t F_H1 = WS_END;
constexpr size_t F_YE = Z_GA;
constexpr int MOE_CHUNK_TILES = 128;
constexpr size_t F_H_CHUNK_BYTES = (size_t)MOE_CHUNK_TILES * 256 * DFFE * 2;
constexpr size_t WS_NEED = F_H1 + F_H_CHUNK_BYTES;
static_assert(F_H + F_H_CHUNK_BYTES <= F_YE && F_YE + (size_t)520 * 256 * D * 2 <= Z_SM && F_H + (size_t)T_TOK * DFF * 2 <= Z_GR, "overlay map");
constexpr int CW_TMO = 0, CW_CODE = 1, CW_BAR = 4096, CW_CNT = 16384;
constexpr int RING_OFF = 0, RING_BYTES = 131072;
constexpr int LDSCTL_OFF = RING_BYTES, MISC_OFF = LDSCTL_OFF + 320;
constexpr int LDS_BYTES = 147456;

#define GAS __attribute__((address_space(1)))
#define LAS __attribute__((address_space(3)))
typedef unsigned short bf16;
typedef unsigned v4u __attribute__((ext_vector_type(4)));
typedef unsigned v2u __attribute__((ext_vector_type(2)));
typedef float f32x4 __attribute__((ext_vector_type(4)));
typedef float f32x16 __attribute__((ext_vector_type(16)));
typedef short bf16x8 __attribute__((ext_vector_type(8)));
typedef GAS unsigned gu32;
#define RLX_AGENT __ATOMIC_RELAXED, __HIP_MEMORY_SCOPE_AGENT
#define LDS_WAIT() asm volatile("s_waitcnt lgkmcnt(0)" ::: "memory")
#define VM_WAIT() asm volatile("s_waitcnt vmcnt(0)" ::: "memory")
using pg8::cvt_pk_bf16; using pg8::bf_lo; using pg8::bf_hi; using pg8::sigmoidf_fast;
#define XB_TMO      128
#define XB_XCNT(j)  (256  + 64 * (j))
#define XB_XSUB(j)  (1280 + 64 * (j))
#define XB_XGEN(j)  (2304 + 64 * (j))
#define XB_TOP      3328
#define XB_TOPGEN   3392
#define XCD_BAR_WORDS 3456
#define XB_SPIN_CAP (1u << 21)

__device__ __forceinline__ unsigned xb_ld(unsigned* p)              { return __hip_atomic_load(p, __ATOMIC_RELAXED, __HIP_MEMORY_SCOPE_AGENT); }
__device__ __forceinline__ unsigned xb_add(unsigned* p, unsigned v) { return __hip_atomic_fetch_add(p, v, __ATOMIC_RELAXED, __HIP_MEMORY_SCOPE_AGENT); }
__device__ __forceinline__ unsigned xb_xcc_id() { return (unsigned)__builtin_amdgcn_s_getreg((3 << 11) | 20) & 0xFu; }
#define XB_SPIN(cond, bar) do { unsigned _sp = 0; while (cond) { __builtin_amdgcn_s_sleep(1); \
    if ((++_sp & 255u) == 0u) { if (xb_ld(&(bar)[XB_TMO])) break; if (_sp > XB_SPIN_CAP) { atomicAdd(&(bar)[XB_TMO], 1u); break; } } } } while (0)

struct XcdBarrier {
    unsigned* bar; unsigned x;
    volatile LAS unsigned* st;
};

__device__ __forceinline__ XcdBarrier xcd_barrier_post(unsigned* bar, volatile LAS unsigned* st) {
    XcdBarrier b; b.bar = bar; b.x = xb_xcc_id(); b.st = st;
    if (threadIdx.x == 0) (void)xb_add(&bar[XB_XCNT(b.x)], 1u);
    return b;
}
__device__ __forceinline__ void xcd_barrier_complete(unsigned* bar, unsigned x, unsigned& nloc, unsigned& nx) {
    const unsigned G = gridDim.x * gridDim.y * gridDim.z;
    unsigned sum, cnt, mine, sp = 0u;
    for (;;) {
        sum = 0u; cnt = 0u; mine = 0u;
#pragma unroll
        for (unsigned j = 0; j < 16; ++j) { const unsigned c = xb_ld(&bar[XB_XCNT(j)]); sum += c; cnt += (c > 0u) ? 1u : 0u; mine = (j == x) ? c : mine; }
        if (sum == G) break;
        __builtin_amdgcn_s_sleep(1);
        if ((++sp & 255u) == 0u) { if (xb_ld(&bar[XB_TMO])) break; if (sp > XB_SPIN_CAP) { atomicAdd(&bar[XB_TMO], 1u); break; } }
    }
    nloc = mine > 0u ? mine : 1u; nx = cnt > 0u ? cnt : 1u;
}

__device__ __forceinline__ void xcd_barrier(const XcdBarrier& b) {
    asm volatile("s_waitcnt vmcnt(0)" ::: "memory");
    __syncthreads();
    if (threadIdx.x == 0) {
        unsigned* bar = b.bar;
        __builtin_amdgcn_s_waitcnt(0);
        unsigned nloc = b.st[0], nx = b.st[1];
        if (nloc == 0u) { xcd_barrier_complete(bar, b.x, nloc, nx); b.st[0] = nloc; b.st[1] = nx; }
        const unsigned old = xb_add(&bar[XB_XSUB(b.x)], 1u);
        const unsigned gen = old / nloc;
        if (old + 1u == (gen + 1u) * nloc) {
            __builtin_amdgcn_fence(__ATOMIC_RELEASE, "agent");
            asm volatile("s_waitcnt vmcnt(0)" ::: "memory");
            const unsigned og = xb_add(&bar[XB_TOP], 1u);
            const unsigned tg = og / nx;
            if (og + 1u == (tg + 1u) * nx) xb_add(&bar[XB_TOPGEN], 1u);
            else XB_SPIN(xb_ld(&bar[XB_TOPGEN]) == tg, bar);
            __builtin_amdgcn_fence(__ATOMIC_ACQUIRE, "agent");
            xb_add(&bar[XB_XGEN(b.x)], 1u);
            asm volatile("s_waitcnt vmcnt(0)" ::: "memory");
        } else {
            XB_SPIN(xb_ld(&bar[XB_XGEN(b.x)]) == gen, bar);
            __builtin_amdgcn_fence(__ATOMIC_ACQUIRE, "agent");
            asm volatile("s_waitcnt vmcnt(0)" ::: "memory");
        }
    }
    __syncthreads();
}
struct Frame {
    LAS unsigned char* lds;
    volatile LAS unsigned* MISC;
    gu32* ctl;
    int tid, lane, wave, G, bx;
    unsigned char* ws;
    float* out;
};
struct Args { const float* in[28]; float* out; unsigned char* ws; };
typedef const __attribute__((address_space(4))) Args* KArgs;
__device__ __forceinline__ KArgs kargs() { KArgs k = (KArgs)__builtin_amdgcn_kernarg_segment_ptr(); asm volatile("" : "+s"(k)); return k; }
enum { I_X = 0, I_P, I_WIN, I_CONVW, I_CONVB, I_LRUWA, I_LRUBA, I_LRUWX, I_LRUBX, I_LAM, I_WBRA, I_WBRR, I_WO, I_RELB, I_LN1G, I_LN1B, I_FFG, I_FFU, I_FFD, I_ROUTER, I_ROUTERB, I_MOEG, I_MOEU, I_MOED, I_PLEG, I_PLEP, I_LN2G, I_LN2B };

__device__ __forceinline__ Frame launder(const Frame& F0) { Frame F = F0; unsigned char* w = F0.ws; int l = (int)__builtin_amdgcn_mbcnt_hi(~0u, __builtin_amdgcn_mbcnt_lo(~0u, 0u)); asm volatile("" : "+s"(w)); asm volatile("" : "+v"(l));
    F.ws = w; F.lane = l; F.tid = F0.wave * 64 + l; F.ctl = (gu32*)(w + WS_CTL); return F; }
__device__ __forceinline__ float lane_get(float v, int src_lane) { return __builtin_bit_cast(float, __builtin_amdgcn_ds_bpermute(src_lane << 2, __builtin_bit_cast(int, v))); }
__device__ __forceinline__ float lane_xor(float v, int mask, int lane) { return lane_get(v, lane ^ mask); }
__device__ __forceinline__ float lane_up(float v, int d, int lane) { return lane_get(v, lane >= d ? lane - d : lane); }
__device__ __forceinline__ float wave_sum(float v, int lane) {
#pragma unroll
    for (int o = 1; o < 64; o <<= 1) v += lane_xor(v, o, lane);
    return v;
}
__device__ __forceinline__ unsigned pk2(float lo, float hi) { return cvt_pk_bf16(lo, hi); }

__device__ __forceinline__ void cvt_item(const float* W, int ldw, int K, bf16* WT, int d0, int sc0, int nvalid, float scale, int k0, LAS float* scr, int lane) {
    const int n4 = (lane & 7) * 4;
    f32x4 v[8];
#pragma unroll
    for (int i = 0; i < 8; ++i) { const int kk = 8 * i + (lane >> 3); v[i] = (f32x4){0.f, 0.f, 0.f, 0.f}; if (n4 < nvalid) v[i] = *(const GAS f32x4*)(W + (size_t)(k0 + kk) * ldw + sc0 + n4); }
#pragma unroll
    for (int i = 0; i < 8; ++i) { const int kk = 8 * i + (lane >> 3); LAS float* d = scr + kk * 33 + n4; d[0] = v[i][0] * scale; d[1] = v[i][1] * scale; d[2] = v[i][2] * scale; d[3] = v[i][3] * scale; }
    LDS_WAIT(); asm volatile("" ::: "memory");
    const int c = lane & 7;
#pragma unroll
    for (int j = 0; j < 4; ++j) { const int nn = (lane >> 3) + 8 * j; const LAS float* s = scr + (8 * c) * 33 + nn;
        v4u o; o.x = pk2(s[0 * 33], s[1 * 33]); o.y = pk2(s[2 * 33], s[3 * 33]); o.z = pk2(s[4 * 33], s[5 * 33]); o.w = pk2(s[6 * 33], s[7 * 33]);
        *(GAS v4u*)(WT + (size_t)(d0 + nn) * K + k0 + 8 * c) = o; }
    LDS_WAIT(); asm volatile("" ::: "memory");
}
__device__ __forceinline__ void cvt_plain(const float* W, int K, int N, bf16* WT, int item, LAS float* scr, int lane) {
    const int nblk = N / 32, kb = item / nblk, nb = item % nblk;
    cvt_item(W, N, K, WT, 32 * nb, 32 * nb, 32, 1.0f, 64 * kb, scr, lane);
}
__device__ __forceinline__ void cvt_gateup(const float* Wg, const float* Wu, int dff, bf16* WT, int item, LAS float* scr, int lane) {
    const int nblk = 2 * dff / 32, kb = item / nblk, db = item % nblk, d0 = 32 * db, pn = d0 >> 8, r = d0 & 255;
    const float* W = r < 128 ? Wg : Wu; const int sc0 = 128 * pn + (r & 127);
    cvt_item(W, dff, D, WT, d0, sc0, 32, 1.0f, 64 * kb, scr, lane);
}
__device__ __forceinline__ void cvt_win(const float* W, bf16* WT, int item, LAS float* scr, int lane) {
    const int nblk = NIN / 32, kb = item / nblk, db = item % nblk, d0 = 32 * db;
    int sc0, nv = 32; float sc = 1.0f;
    if (d0 < 1024) { sc0 = d0; }
    else if (d0 < 2048) sc0 = 1736 + (d0 - 1024);
    else if (d0 < 3072) sc0 = 2760 + (d0 - 2048);
    else if (d0 < 4096) sc0 = 3784 + (d0 - 3072);
    else if (d0 < 5120) sc0 = 4808 + (d0 - 4096);
    else if (d0 < 5632) sc0 = 1152 + (d0 - 5120);
    else if (d0 < 5696) sc0 = 1024 + (d0 - 5632);
    else if (d0 < 5760) sc0 = 1088 + (d0 - 5696);
    else if (d0 < 5824) sc0 = 1664 + (d0 - 5760);
    else if (d0 == 5824) { sc0 = 1728; nv = 8; }
    else { sc0 = 0; nv = 0; }
    cvt_item(W, D_IN, D, WT, d0, sc0, nv, sc, 64 * kb, scr, lane);
}
__device__ __forceinline__ void p0_convert(const Frame& F0, int L) {
    Frame F = launder(F0);
    const KArgs ka = kargs();
    LAS float* scr = (LAS float*)(F.lds + RING_OFF + F.wave * 16384);
    const int gw = F.bx * NWAVES + F.wave, NGW = F.G * NWAVES;
    unsigned char* wb = F.ws + WS_W;
    const int odd = L & 1, jj = L >> 1;
    constexpr int I_IN = (D / 64) * (NIN / 32), I_SQ = (D / 64) * (D / 32), I_PPJ = (PLE / 64) * (D / 32), I_LRU1 = 2 * 4;
    constexpr int I_GU_D = (D / 64) * (2 * DFF / 32), I_DN_D = (DFF / 64) * (D / 32), I_GU_E = (D / 64) * (2 * DFFE / 32), I_DN_E = (DFFE / 64) * (D / 32);
    const int n_ff = odd ? NEXP * (I_GU_E + I_DN_E) : (I_GU_D + I_DN_D);
    const int NITEMS = I_IN + 4 * I_SQ + I_PPJ + 16 * I_LRU1 + n_ff;
    for (int it = gw; it < NITEMS; it += NGW) {
        int r = it;
        if (r < I_IN) { cvt_win(ka->in[I_WIN] + (size_t)L * D * D_IN, (bf16*)(wb + W_IN), r, scr, F.lane); continue; } r -= I_IN;
        if (r < I_SQ) { cvt_plain(ka->in[I_WBRA] + (size_t)L * D * D, D, D, (bf16*)(wb + W_BRA), r, scr, F.lane); continue; } r -= I_SQ;
        if (r < I_SQ) { cvt_plain(ka->in[I_WBRR] + (size_t)L * D * D, D, D, (bf16*)(wb + W_BRR), r, scr, F.lane); continue; } r -= I_SQ;
        if (r < I_SQ) { cvt_plain(ka->in[I_WO] + (size_t)L * D * D, D, D, (bf16*)(wb + W_O), r, scr, F.lane); continue; } r -= I_SQ;
        if (r < I_SQ) { cvt_plain(ka->in[I_PLEG] + (size_t)L * D * D, D, D, (bf16*)(wb + W_PG), r, scr, F.lane); continue; } r -= I_SQ;
        if (r < I_PPJ) { cvt_plain(ka->in[I_PLEP] + (size_t)L * PLE * D, PLE, D, (bf16*)(wb + W_PP), r, scr, F.lane); continue; } r -= I_PPJ;
        if (r < 16 * I_LRU1) { const int m = r / I_LRU1, blk = m & 7, which = m >> 3;
            const float* src = ka->in[which ? I_LRUWX : I_LRUWA] + (size_t)L * 8 * 128 * 128 + (size_t)blk * 128 * 128;
            cvt_plain(src, 128, 128, (bf16*)(wb + W_LRU) + (size_t)which * 8 * 128 * 128 + (size_t)blk * 128 * 128, r % I_LRU1, scr, F.lane); continue; } r -= 16 * I_LRU1;
        if (!odd) {
            if (r < I_GU_D) { cvt_gateup(ka->in[I_FFG] + (size_t)jj * D * DFF, ka->in[I_FFU] + (size_t)jj * D * DFF, DFF, (bf16*)(wb + W_FF), r, scr, F.lane); continue; } r -= I_GU_D;
            cvt_plain(ka->in[I_FFD] + (size_t)jj * DFF * D, DFF, D, (bf16*)(wb + W_FF_DN_DENSE), r, scr, F.lane);
        } else {
            if (r < NEXP * I_GU_E) { const int e = r / I_GU_E; const size_t eo = ((size_t)jj * NEXP + e) * D * DFFE;
                cvt_gateup(ka->in[I_MOEG] + eo, ka->in[I_MOEU] + eo, DFFE, (bf16*)(wb + W_FF) + (size_t)e * 2 * DFFE * D, r % I_GU_E, scr, F.lane); continue; } r -= NEXP * I_GU_E;
            const int e = r / I_DN_E; const size_t eo = ((size_t)jj * NEXP + e) * DFFE * D;
            cvt_plain(ka->in[I_MOED] + eo, DFFE, D, (bf16*)(wb + W_FF_DN_MOE) + (size_t)e * D * DFFE, r % I_DN_E, scr, F.lane);
        }
    }
    if (L == 0) {
        const GAS f32x4* x4 = (const GAS f32x4*)ka->in[I_X]; GAS v4u* o = (GAS v4u*)(F.ws + WS_XB);
        const size_t n8 = (size_t)T_TOK * D / 8;
        for (size_t i = (size_t)F.bx * 512 + F.tid; i < n8; i += (size_t)F.G * 512) { const f32x4 a = x4[2 * i], b = x4[2 * i + 1];
            v4u w; w.x = pk2(a[0], a[1]); w.y = pk2(a[2], a[3]); w.z = pk2(b[0], b[1]); w.w = pk2(b[2], b[3]); o[i] = w; }
    }
}

template <bool LN2, bool ODD, bool DRY = false>
__device__ __forceinline__ void ln_phase(const Frame& F0, int L) {
    Frame F = launder(F0);
    const KArgs ka = kargs();
    const int jj = L >> 1;
    float* X32 = F.out; bf16* XB = (bf16*)(F.ws + WS_XB);
    const float* gam = ka->in[LN2 ? I_LN2G : I_LN1G] + (size_t)L * D; const float* bet = ka->in[LN2 ? I_LN2B : I_LN1B] + (size_t)L * D;
    f32x4 gv[4], bv[4];
#pragma unroll
    for (int j = 0; j < 4; ++j) { gv[j] = ((const GAS f32x4*)gam)[F.lane + 64 * j]; bv[j] = ((const GAS f32x4*)bet)[F.lane + 64 * j]; }
    LAS float* RT = (LAS float*)(F.lds + RING_OFF);
    LAS unsigned* TE = (LAS unsigned*)(F.lds + RING_OFF + 32768);
    volatile LAS unsigned* lcnt = F.MISC + 48; volatile LAS unsigned* gbase = F.MISC + 56;
    float rb[8];
    if (!LN2 && ODD) {
        const float* R = ka->in[I_ROUTER] + (size_t)jj * D * NEXP;
        for (int i = F.tid; i < D * NEXP; i += 512) RT[i] = R[i];
        if (F.tid < 8) lcnt[F.tid] = 0u;
#pragma unroll
        for (int e = 0; e < 8; ++e) rb[e] = ka->in[I_ROUTERB][jj * NEXP + e];
        __syncthreads();
    }
    const unsigned* route = (const unsigned*)(F.ws + WS_ROUTE);
    const bf16* YE = (const bf16*)(F.ws + F_YE);
    f32x4 nv[4];
    { const GAS f32x4* x0 = (const GAS f32x4*)(X32 + ((size_t)F.bx * 256 + F.wave) * D) + F.lane;
#pragma unroll
      for (int j = 0; j < 4; ++j) nv[j] = x0[64 * j]; }
    for (int it = 0; it < 32; ++it) {
        const int rl = F.wave + 8 * it; const size_t row = (size_t)F.bx * 256 + rl;
        GAS f32x4* xr = (GAS f32x4*)(X32 + row * D) + F.lane;
        f32x4 v[4]; float s = 0.f;
#pragma unroll
        for (int j = 0; j < 4; ++j) v[j] = nv[j];
        if (it < 31) {
#pragma unroll
            for (int j = 0; j < 4; ++j) nv[j] = xr[8 * (D / 4) + 64 * j]; }
        if (LN2 && ODD) {
            const unsigned e1 = route[row * 8 + 0], e2 = route[row * 8 + 1], p1 = route[row * 8 + 2], p2 = route[row * 8 + 3];
            const float g1 = __builtin_bit_cast(float, route[row * 8 + 4]), g2 = __builtin_bit_cast(float, route[row * 8 + 5]);
            const size_t r1 = (size_t)F.MISC[16 + e1] * 256 + p1, r2 = (size_t)F.MISC[16 + e2] * 256 + p2;
            const GAS v2u* y1 = (const GAS v2u*)(YE + r1 * D) + F.lane; const GAS v2u* y2 = (const GAS v2u*)(YE + r2 * D) + F.lane;
#pragma unroll
            for (int j = 0; j < 4; ++j) { const v2u a = y1[64 * j], b = y2[64 * j];
                v[j][0] += g1 * bf_lo(a.x) + g2 * bf_lo(b.x); v[j][1] += g1 * bf_hi(a.x) + g2 * bf_hi(b.x);
                v[j][2] += g1 * bf_lo(a.y) + g2 * bf_lo(b.y); v[j][3] += g1 * bf_hi(a.y) + g2 * bf_hi(b.y); }
        }
#pragma unroll
        for (int j = 0; j < 4; ++j) s += (v[j][0] + v[j][1]) + (v[j][2] + v[j][3]);
        const float mean = wave_sum(s, F.lane) * (1.f / D); float s2 = 0.f;
#pragma unroll
        for (int j = 0; j < 4; ++j) { v[j] = v[j] - mean; s2 += (v[j][0] * v[j][0] + v[j][1] * v[j][1]) + (v[j][2] * v[j][2] + v[j][3] * v[j][3]); }
        const float rstd = 1.f / sqrtf(wave_sum(s2, F.lane) * (1.f / D) + LN_EPS);
        GAS v2u* o8 = (GAS v2u*)((DRY ? (bf16*)(F.ws + WS_NEED) : XB) + row * D) + F.lane;
        GAS f32x4* xw = DRY ? (GAS f32x4*)((float*)(F.ws + WS_NEED) + row * D) + F.lane : xr;
#pragma unroll
        for (int j = 0; j < 4; ++j) { v[j] = v[j] * rstd * gv[j] + bv[j]; if (DRY || (LN2 && L == DEPTH - 1)) xw[64 * j] = v[j];
            v2u w; w.x = pk2(v[j][0], v[j][1]); w.y = pk2(v[j][2], v[j][3]); o8[64 * j] = w; }
        if (!LN2) {
            const f32x4 pv = ((const GAS f32x4*)(ka->in[I_P] + ((size_t)L * T_TOK + row) * PLE))[F.lane];
            v2u w; w.x = pk2(pv[0], pv[1]); w.y = pk2(pv[2], pv[3]); ((GAS v2u*)(F.ws + (DRY ? WS_NEED : F_PB) + row * PLE * 2))[F.lane] = w;
        }
        if (!LN2 && ODD) {
            float lg[8];
#pragma unroll
            for (int e = 0; e < 8; ++e) lg[e] = 0.f;
#pragma unroll
            for (int j = 0; j < 4; ++j)
#pragma unroll
                for (int q = 0; q < 4; ++q) { const int c = 4 * F.lane + 256 * j + q; const f32x4 ra = *(const LAS f32x4*)(RT + c * 8), rc = *(const LAS f32x4*)(RT + c * 8 + 4); const float xv = v[j][q];
                    lg[0] += xv * ra[0]; lg[1] += xv * ra[1]; lg[2] += xv * ra[2]; lg[3] += xv * ra[3]; lg[4] += xv * rc[0]; lg[5] += xv * rc[1]; lg[6] += xv * rc[2]; lg[7] += xv * rc[3]; }
#pragma unroll
            for (int e = 0; e < 8; ++e) lg[e] = wave_sum(lg[e], F.lane) + rb[e];
            int e1 = 0; float v1 = lg[0];
#pragma unroll
            for (int e = 1; e < 8; ++e) if (lg[e] > v1) { v1 = lg[e]; e1 = e; }
            int e2 = -1; float v2 = 0.f;
#pragma unroll
            for (int e = 0; e < 8; ++e) if (e != e1 && (e2 < 0 || lg[e] > v2)) { v2 = lg[e]; e2 = e; }
            const float ex = __expf(v2 - v1), g1 = 1.f / (1.f + ex), g2 = ex * g1;
            if (F.lane == 0) { const unsigned lp1 = __hip_atomic_fetch_add((LAS unsigned*)lcnt + e1, 1u, __ATOMIC_RELAXED, __HIP_MEMORY_SCOPE_WORKGROUP), lp2 = __hip_atomic_fetch_add((LAS unsigned*)lcnt + e2, 1u, __ATOMIC_RELAXED, __HIP_MEMORY_SCOPE_WORKGROUP);
                TE[rl * 4 + 0] = (unsigned)e1 | ((unsigned)e2 << 8) | (lp1 << 16); TE[rl * 4 + 1] = lp2; TE[rl * 4 + 2] = __builtin_bit_cast(unsigned, g1); TE[rl * 4 + 3] = __builtin_bit_cast(unsigned, g2); }
        }
    }
    if (!LN2 && ODD) {
        __syncthreads();
        if (F.tid < 8) gbase[F.tid] = __hip_atomic_fetch_add(F.ctl + CW_CNT + jj * 1024 + 64 * F.tid, lcnt[F.tid], RLX_AGENT);
        __syncthreads();
        if (F.tid < 256) { const unsigned w0 = TE[F.tid * 4], lp2 = TE[F.tid * 4 + 1]; const unsigned e1 = w0 & 255u, e2 = (w0 >> 8) & 255u, lp1 = w0 >> 16;
            const unsigned p1 = gbase[e1] + lp1, p2 = gbase[e2] + lp2; const unsigned tok = (unsigned)F.bx * 256 + F.tid;
            GAS int* list = (GAS int*)(F.ws + WS_LIST); list[(size_t)e1 * T_TOK + p1] = (int)tok; list[(size_t)e2 * T_TOK + p2] = (int)tok;
            GAS v4u* ro = (GAS v4u*)(F.ws + WS_ROUTE) + (size_t)tok * 2; v4u a; a.x = e1; a.y = e2; a.z = p1; a.w = p2; ro[0] = a; v4u b; b.x = TE[F.tid * 4 + 2]; b.y = TE[F.tid * 4 + 3]; b.z = 0u; b.w = 0u; ro[1] = b; }
        __syncthreads();
    }
}
__device__ __forceinline__ int wave_scan_add(int x) {
    x += __builtin_amdgcn_update_dpp(0, x, 0x111, 0xf, 0xf, false);
    x += __builtin_amdgcn_update_dpp(0, x, 0x112, 0xf, 0xf, false);
    x += __builtin_amdgcn_update_dpp(0, x, 0x114, 0xf, 0xf, false);
    x += __builtin_amdgcn_update_dpp(0, x, 0x118, 0xf, 0xf, false);
    x += __builtin_amdgcn_update_dpp(0, x, 0x142, 0xa, 0xf, false);
    x += __builtin_amdgcn_update_dpp(0, x, 0x143, 0xc, 0xf, false);
    return x;
}
template <int NJ>
__device__ __forceinline__ unsigned select_topk_n(LAS const float* sc, int n_adm, GAS unsigned short* gout, LAS unsigned short* out, int lane, unsigned guess) {
    const int nj = n_adm >> 6;
    unsigned u[NJ];
#pragma unroll
    for (int j = 0; j < NJ; ++j) { unsigned b = 0u;
        if (j < NJ - 8 || j < nj) { b = __builtin_bit_cast(unsigned, sc[64 * j + lane]); b = (b == 0x80000000u) ? 0u : b; b = (b & 0x80000000u) ? ~b : (b | 0x80000000u); }
        u[j] = b; }
#define SEL_COUNT(c_, dst_) do { int cl_ = 0; _Pragma("unroll") for (int j = 0; j < NJ; ++j) cl_ += (u[j] >= (c_)) ? 1 : 0; dst_ = __builtin_amdgcn_readlane(wave_scan_add(cl_), 63); } while (0)
    unsigned lo = 0u, hi = 0xFFFFFFFFu, ex = 0u; bool exact = false; int c;
    if (guess != 0u) {
        SEL_COUNT(guess, c);
        if (c == 256) { exact = true; ex = guess; }
        else if (c > 256) { lo = guess; unsigned d = 1u << 17;
            for (int e = 0; e < 7 && !exact; ++e) { const unsigned h = lo + d; if (h < lo) break; SEL_COUNT(h, c);
                if (c == 256) { exact = true; ex = h; } else if (c < 256) { hi = h; break; } else { lo = h; d <<= 2; } } }
        else { hi = guess; unsigned d = 1u << 17;
            for (int e = 0; e < 7 && !exact; ++e) { if (d >= hi) break; const unsigned l = hi - d; SEL_COUNT(l, c);
                if (c == 256) { exact = true; ex = l; } else if (c > 256) { lo = l; break; } else { hi = l; d <<= 2; } } }
    }
    while (!exact && hi - lo > 1u) { const unsigned mid = lo + ((hi - lo) >> 1); SEL_COUNT(mid, c);
        if (c == 256) { exact = true; ex = mid; } else if (c > 256) lo = mid; else hi = mid; }
#undef SEL_COUNT
    const unsigned thr = exact ? ex - 1u : lo;
    int nl = 0;
#pragma unroll
    for (int j = 0; j < NJ; ++j) nl += (u[j] > thr) ? 1 : 0;
    const int incl = wave_scan_add(nl); const int ngt = __builtin_amdgcn_readlane(incl, 63);
    int pos = incl - nl;
#pragma unroll
    for (int j = 0; j < NJ; ++j) if (u[j] > thr) { out[pos] = (unsigned short)(64 * j + lane); ++pos; }
    const int quota = 256 - ngt;
    if (quota > 0) {
        int tbase = 0; const unsigned long long lt = (1ull << lane) - 1ull;
#pragma unroll
        for (int j = 0; j < NJ; ++j) {
            const bool eq = u[j] == thr; const unsigned long long meq = __ballot(eq); const int rk = tbase + __popcll(meq & lt);
            if (eq && rk < quota) out[ngt + rk] = (unsigned short)(64 * j + lane);
            tbase += __popcll(meq);
        }
    }
    asm volatile("s_waitcnt lgkmcnt(0)" ::: "memory");
    if (lane < 32) *(GAS v4u*)(gout + 8 * lane) = *(const LAS v4u*)(out + 8 * lane);
    asm volatile("s_waitcnt lgkmcnt(0)" ::: "memory");
    return thr;
}
__device__ __forceinline__ unsigned select_topk(LAS const float* sc, int n_adm, GAS unsigned short* out, LAS unsigned short* orow, int lane, unsigned guess) {
    if (n_adm <= 256) {
#pragma unroll
        for (int j = 0; j < 4; ++j) { const int p = lane + 64 * j; out[p] = (unsigned short)(p < n_adm ? p : 0); }
        return 0u;
    }
    if (n_adm <= 512) return select_topk_n<8>(sc, n_adm, out, orow, lane, guess);
    else if (n_adm <= 1024) return select_topk_n<16>(sc, n_adm, out, orow, lane, guess);
    else if (n_adm <= 1536) return select_topk_n<24>(sc, n_adm, out, orow, lane, guess);
    return select_topk_n<32>(sc, n_adm, out, orow, lane, guess);
}
template <int MODE = 0>
__device__ __forceinline__ void indexer_phase(const Frame& F0) {
    Frame F = launder(F0);
    LAS float* sc = (LAS float*)(F.lds + RING_OFF);
    const bf16* QI = (const bf16*)(F.ws + Z_QI); const bf16* SM = (const bf16*)(F.ws + Z_SM);
    GAS unsigned short* IDX = (GAS unsigned short*)(F.ws + WS_IDX);
    const int lane = F.lane, h = lane >> 5, r = lane & 31;
    const int rq = 2 * ((r >> 2) & 1) + ((r >> 4) & 1), rh = (r & 3) + 4 * ((r >> 3) & 1);
    const int vcu = (F.bx & 7) * (F.G >> 3) + (F.bx >> 3);
    unsigned guess[2] = {0u, 0u};
    bf16x8 A[4][4]; v4u wq[4][2];
#define IDX_TILE(pi_, b_, tq_) const int pid_ = vcu * 8 + ((pi_) >> 1), b_ = pid_ >> 6, jp_ = pid_ & 63, tq_ = 16 * (((pi_) & 1) ? 127 - jp_ : jp_)
#define IDX_LOAD_A(t0_) do { _Pragma("unroll") for (int mt = 0; mt < 4; ++mt) { \
        _Pragma("unroll") for (int s = 0; s < 4; ++s) A[mt][s] = *(const GAS bf16x8*)(QI + (size_t)((t0_) + 4 * mt + rq) * 512 + rh * 64 + 16 * s + 8 * h); \
        _Pragma("unroll") for (int qq = 0; qq < 2; ++qq) wq[mt][qq] = *(const GAS v4u*)(SM + (size_t)((t0_) + 4 * mt + 2 * h + qq) * 256 + 192); } } while (0)
    for (int pi = 0; pi < 16; ++pi) {
        IDX_TILE(pi, b, tq);
        const int t0 = b * SEQ + tq;
        const int n_adm = ((tq >> 6) + 1) * 64, nkb = n_adm >> 5;
        if (n_adm > 256 && MODE != 2) {
            IDX_LOAD_A(t0);
            bf16x8 B[4], Bn[4];
#pragma unroll
            for (int s = 0; s < 4; ++s) Bn[s] = *(const GAS bf16x8*)(SM + (size_t)(b * SEQ + 32 * F.wave + r) * 256 + 128 + 16 * s + 8 * h);
            for (int kb = F.wave; kb < nkb; kb += 8) {
                const int key = 32 * kb + r;
                const int keyn = (kb + 8 < nkb) ? key + 256 : key;
#pragma unroll
                for (int s = 0; s < 4; ++s) B[s] = Bn[s];
#pragma unroll
                for (int s = 0; s < 4; ++s) Bn[s] = *(const GAS bf16x8*)(SM + (size_t)(b * SEQ + keyn) * 256 + 128 + 16 * s + 8 * h);
#pragma unroll
                for (int mt = 0; mt < 4; ++mt) {
                    f32x16 acc;
#pragma unroll
                    for (int i = 0; i < 16; ++i) acc[i] = 0.f;
#pragma unroll
                    for (int s = 0; s < 4; ++s) acc = __builtin_amdgcn_mfma_f32_32x32x16_bf16(A[mt][s], B[s], acc, 0, 0, 0);
                    float sA = 0.f, sB = 0.f;
#pragma unroll
                    for (int i = 0; i < 8; ++i) { const unsigned wa = wq[mt][0][i >> 1], wb = wq[mt][1][i >> 1];
                        const float fa = (i & 1) ? bf_hi(wa) : bf_lo(wa), fb = (i & 1) ? bf_hi(wb) : bf_lo(wb);
                        sA += fmaxf(acc[i], 0.f) * fa; sB += fmaxf(acc[8 + i], 0.f) * fb; }
                    sc[(4 * mt + 2 * h) * 2048 + key] = sA; sc[(4 * mt + 2 * h + 1) * 2048 + key] = sB;
                }
            }
        }
        __syncthreads();
#pragma unroll 1
        for (int qq = 0; qq < 2 && MODE != 1; ++qq) { const int q = 2 * F.wave + qq; const unsigned g_ = (pi & 1) ? guess[1] : guess[0];
            const unsigned t_ = select_topk(sc + q * 2048, n_adm, IDX + (size_t)(t0 + q) * 256, (LAS unsigned short*)(F.lds + LDSCTL_OFF + 1024 + F.wave * 512), lane, g_); if (pi & 1) guess[1] = t_; else guess[0] = t_; }
        __syncthreads();
    }
#undef IDX_TILE
#undef IDX_LOAD_A
}

__device__ __forceinline__ unsigned vst_off(unsigned r, unsigned ch) { return r * 128u + 16u * (ch ^ ((((r >> 1) ^ (r >> 4)) & 1u) << 1) ^ (((r >> 3) & 1u) << 2)); }
__device__ __forceinline__ int t5_bucket_dev(int rel) {
    const int n = rel < 0 ? -rel : rel;
    int v = n;
    if (n >= 8) v = 8 + (n >= 12) + (n >= 16) + (n >= 23) + (n >= 32) + (n >= 46) + (n >= 64) + (n >= 91);
    return v + (rel > 0 ? 16 : 0);
}
#ifndef ATT_REPS
#define ATT_REPS 1
#endif
#ifndef ATT_FIXKEYS
#define ATT_FIXKEYS 0
#endif
template <int FIX = 0>
__device__ __forceinline__ void attention_phase(const Frame& F0) {
#pragma unroll 1
    for (int rep = 0; rep < ATT_REPS; ++rep) {
    Frame F = launder(F0);
    const GAS unsigned char* Q8 = (const GAS unsigned char*)(F.ws + Z_Q8); const GAS unsigned char* KV8 = (const GAS unsigned char*)(F.ws + Z_KV8); bf16* OB = (bf16*)(F.ws + Z_XR);
    const GAS unsigned short* IDX = (const GAS unsigned short*)(F.ws + WS_IDX);
    const int lane = F.lane, g = lane >> 4, m = lane & 15;
    LAS unsigned char* vst = F.lds + RING_OFF + F.wave * 4096;
    const unsigned vbase = (unsigned)(size_t)vst;
    LAS unsigned char* BK = F.lds + RING_OFF + 32768; LAS unsigned char* OH = F.lds + RING_OFF + 32768 + 2176;
    for (int i = F.tid; i < 2112; i += 512) BK[i] = (unsigned char)t5_bucket_dev(i - 2047);
    if (F.tid < 128) { const int bkt = F.tid >> 2, gg = F.tid & 3, j = bkt - 8 * gg; v4u oh; oh.x = oh.y = oh.z = oh.w = 0u;
        if (j >= 0 && j < 8) { const unsigned val = (j & 1) ? 0x3F800000u : 0x3F80u; if ((j >> 1) == 0) oh.x = val; else if ((j >> 1) == 1) oh.y = val; else if ((j >> 1) == 2) oh.z = val; else oh.w = val; }
        *(LAS v4u*)(OH + F.tid * 16) = oh; }
    __syncthreads();
    bf16x8 bb;
    { const float* rbias = kargs()->in[I_RELB]; unsigned w[4];
#pragma unroll
      for (int j = 0; j < 4; ++j) w[j] = pk2(8.0f * rbias[(8 * g + 2 * j) * 16 + m], 8.0f * rbias[(8 * g + 2 * j + 1) * 16 + m]);
      v4u t; t.x = w[0]; t.y = w[1]; t.z = w[2]; t.w = w[3]; bb = __builtin_bit_cast(bf16x8, t); }
    unsigned tra[4][2];
    { const unsigned q = (lane & 15) >> 2, p = lane & 3;
#pragma unroll
      for (int c = 0; c < 4; ++c)
#pragma unroll
        for (int t = 0; t < 2; ++t) tra[c][t] = vst_off(8 * g + 4 * t + q, 2 * c + (p >> 1)) + 8 * (p & 1); }
    const int vcu = (F.bx & 7) * (F.G >> 3) + (F.bx >> 3);
    typedef long fp8x8;
    v4u ni0, ni1, nq; v4u ka[16]; unsigned koff[16];
#define ATT_KOFF(i0_, i1_) do { _Pragma("unroll") for (int k = 0; k < 4; ++k) { koff[2 * k] = ((i0_)[k] & 0xffffu) * 128u + 16u * g; koff[2 * k + 1] = ((i0_)[k] >> 16) * 128u + 16u * g; \
        koff[8 + 2 * k] = ((i1_)[k] & 0xffffu) * 128u + 16u * g; koff[8 + 2 * k + 1] = ((i1_)[k] >> 16) * 128u + 16u * g; } } while (0)
#ifdef ATT_NO_ASM
#define ATT_KLOAD(kvb_) do { const GAS unsigned char* kb_ = (kvb_); _Pragma("unroll") for (int T = 0; T < 16; ++T) ka[T] = *(const GAS v4u*)(kb_ + koff[T]); } while (0)
#define ATT_KWAIT(n_, T0_) do {} while (0)
#else
#define ATT_KLOAD(kvb_) do { const GAS unsigned char* kb_ = (kvb_); _Pragma("unroll") for (int T = 0; T < 16; ++T) { \
        asm volatile("global_load_dwordx4 %0, %1, %2" : "=&v"(ka[T]) : "v"(koff[T]), "s"(kb_) : "memory"); } } while (0)
#define ATT_KWAIT(n_, T0_) asm volatile("s_waitcnt vmcnt(" #n_ ")" : "+v"(ka[T0_]), "+v"(ka[T0_ + 1]), "+v"(ka[T0_ + 2]), "+v"(ka[T0_ + 3]), "+v"(ka[T0_ + 4]), "+v"(ka[T0_ + 5]), "+v"(ka[T0_ + 6]), "+v"(ka[T0_ + 7]) :: "memory")
#endif
    { const int tok0 = vcu * 256 + F.wave; const GAS v4u* ip = (const GAS v4u*)(IDX + (size_t)tok0 * 256 + 16 * m); ni0 = ip[0]; ni1 = ip[1];
      nq = *(const GAS v4u*)(Q8 + (size_t)tok0 * D + m * 64 + 16 * g);
      ATT_KOFF(ni0, ni1); ATT_KLOAD(KV8 + (size_t)(tok0 >> 11) * SEQ * 128); }
    for (int it = 0; it < 32; ++it) {
        const int tok = vcu * 256 + F.wave + 8 * it, b = tok >> 11, tq = tok & (SEQ - 1);
        const int n_valid = (((tq >> 6) + 1) * 64) < 256 ? ((tq >> 6) + 1) * 64 : 256;
        const v4u qv = nq;
        const fp8x8 qf0 = (fp8x8)(((unsigned long long)qv.y << 32) | qv.x), qf1 = (fp8x8)(((unsigned long long)qv.w << 32) | qv.z);
        const GAS unsigned char* kvb = KV8 + (size_t)b * SEQ * 128;
        f32x4 S[16];
#pragma unroll
        for (int T = 0; T < 16; ++T) {
            if (T == 0) ATT_KWAIT(8, 0);
            if (T == 8) ATT_KWAIT(0, 8);
            const unsigned bkt = BK[(koff[T] >> 7) + (2047 - tq)];
            const v4u oh = *(const LAS v4u*)(OH + bkt * 64 + g * 16);
            f32x4 ab = (f32x4){0.f, 0.f, 0.f, 0.f}, a = (f32x4){0.f, 0.f, 0.f, 0.f};
            ab = __builtin_amdgcn_mfma_f32_16x16x32_bf16(__builtin_bit_cast(bf16x8, oh), bb, ab, 0, 0, 0);
            a = __builtin_amdgcn_mfma_f32_16x16x32_fp8_fp8((fp8x8)(((unsigned long long)ka[T].y << 32) | ka[T].x), qf0, a, 0, 0, 0);
            a = __builtin_amdgcn_mfma_f32_16x16x32_fp8_fp8((fp8x8)(((unsigned long long)ka[T].w << 32) | ka[T].z), qf1, a, 0, 0, 0);
            a = a + ab;
            S[T] = a;
        }
        __builtin_amdgcn_sched_barrier(0);
        v4u vv[16];
#pragma unroll
        for (int T = 0; T < 16; ++T) vv[T] = *(const GAS v4u*)(kvb + koff[T] + 64);
        if (n_valid < 256) {
#pragma unroll
            for (int T = 0; T < 16; ++T)
#pragma unroll
                for (int i = 0; i < 4; ++i) if (16 * (4 * g + i) + T >= n_valid) S[T][i] = -1e30f;
        }
        float mx = -3.0e38f;
#pragma unroll
        for (int T = 0; T < 16; ++T) mx = fmaxf(fmaxf(fmaxf(S[T][0], S[T][1]), fmaxf(S[T][2], S[T][3])), mx);
        mx = fmaxf(mx, lane_xor(mx, 16, lane)); mx = fmaxf(mx, lane_xor(mx, 32, lane));
        constexpr float SC = 1.4426950408889634f * 0.125f;
        const float mneg = -mx * SC; float sum = 0.f;
#pragma unroll
        for (int T = 0; T < 16; ++T)
#pragma unroll
            for (int i = 0; i < 4; ++i) { const float p = __builtin_amdgcn_exp2f(S[T][i] * SC + mneg); S[T][i] = p; sum += p; }
        sum += lane_xor(sum, 16, lane); sum += lane_xor(sum, 32, lane);
        { const int tokn = vcu * 256 + F.wave + 8 * (it < 31 ? it + 1 : it); const GAS v4u* ip = (const GAS v4u*)(IDX + (size_t)tokn * 256 + 16 * m); ni0 = ip[0]; ni1 = ip[1];
          nq = *(const GAS v4u*)(Q8 + (size_t)tokn * D + m * 64 + 16 * g); }
        f32x4 O[4];
#pragma unroll
        for (int c = 0; c < 4; ++c) O[c] = (f32x4){0.f, 0.f, 0.f, 0.f};
#pragma unroll
        for (int ks = 0; ks < 8; ++ks) {
            const unsigned vb = vbase;
#pragma unroll
            for (int tt = 0; tt < 2; ++tt) { const v4u w8 = vv[2 * ks + tt]; v4u c0, c1;
#pragma unroll
                for (int q = 0; q < 4; ++q) { const int src = (int)w8[q];
                    const __attribute__((ext_vector_type(2))) float lo2 = __builtin_amdgcn_cvt_pk_f32_fp8(src, false), hi2 = __builtin_amdgcn_cvt_pk_f32_fp8(src, true);
                    const unsigned w0 = pk2(lo2.x, lo2.y), w1 = pk2(hi2.x, hi2.y);
                    if (q < 2) { c0[2 * q] = w0; c0[2 * q + 1] = w1; } else { c1[2 * (q - 2)] = w0; c1[2 * (q - 2) + 1] = w1; } }
                const unsigned rr = 8 * (m >> 2) + 4 * tt + (m & 3);
                *(LAS v4u*)(vst + vst_off(rr, 2 * g)) = c0; *(LAS v4u*)(vst + vst_off(rr, 2 * g + 1)) = c1; }
            v4u pw; pw.x = pk2(S[2 * ks][0], S[2 * ks][1]); pw.y = pk2(S[2 * ks][2], S[2 * ks][3]); pw.z = pk2(S[2 * ks + 1][0], S[2 * ks + 1][1]); pw.w = pk2(S[2 * ks + 1][2], S[2 * ks + 1][3]);
            const bf16x8 pf = __builtin_bit_cast(bf16x8, pw);
            v2u f[4][2];
            asm volatile("s_waitcnt lgkmcnt(0)\n\t"
                         "ds_read_b64_tr_b16 %0, %8\n\tds_read_b64_tr_b16 %1, %9\n\tds_read_b64_tr_b16 %2, %10\n\tds_read_b64_tr_b16 %3, %11\n\t"
                         "ds_read_b64_tr_b16 %4, %12\n\tds_read_b64_tr_b16 %5, %13\n\tds_read_b64_tr_b16 %6, %14\n\tds_read_b64_tr_b16 %7, %15\n\t"
                         "s_waitcnt lgkmcnt(0)"
                         : "=&v"(f[0][0]), "=&v"(f[0][1]), "=&v"(f[1][0]), "=&v"(f[1][1]), "=&v"(f[2][0]), "=&v"(f[2][1]), "=&v"(f[3][0]), "=&v"(f[3][1])
                         : "v"(vb + tra[0][0]), "v"(vb + tra[0][1]), "v"(vb + tra[1][0]), "v"(vb + tra[1][1]), "v"(vb + tra[2][0]), "v"(vb + tra[2][1]), "v"(vb + tra[3][0]), "v"(vb + tra[3][1])
                         : "memory");
#pragma unroll
            for (int c = 0; c < 4; ++c) { v4u t; t.x = f[c][0].x; t.y = f[c][0].y; t.z = f[c][1].x; t.w = f[c][1].y;
                O[c] = __builtin_amdgcn_mfma_f32_16x16x32_bf16(__builtin_bit_cast(bf16x8, t), pf, O[c], 0, 0, 0); }
        }
        const float inv = 1.0f / sum;
#pragma unroll
        for (int c = 0; c < 4; ++c) { v2u w; w.x = pk2(O[c][0] * inv, O[c][1] * inv); w.y = pk2(O[c][2] * inv, O[c][3] * inv);
            *(GAS v2u*)(OB + (size_t)tok * D + m * 64 + 16 * c + 4 * g) = w; }
        { const int tokn = vcu * 256 + F.wave + 8 * (it < 31 ? it + 1 : it); ATT_KOFF(ni0, ni1); ATT_KLOAD(KV8 + (size_t)(tokn >> 11) * SEQ * 128); }
    }
    asm volatile("s_waitcnt vmcnt(0)" ::: "memory");
#undef ATT_KOFF
#undef ATT_KLOAD
#undef ATT_KWAIT
    }
}
constexpr int XCS = 136;
constexpr int HHS = 132;
__device__ __forceinline__ float gelu_tanh(float x) {
    const float z = 0.7978845608028654f * (x + 0.044715f * x * x * x);
    const float e = __builtin_amdgcn_exp2f(2.885390081777927f * z);
    const float th = 1.0f - 2.0f * __builtin_amdgcn_rcpf(e + 1.0f);
    return 0.5f * x * (1.0f + th);
}
template <bool DRY = false>
__device__ __forceinline__ void lru_phase(const Frame& F0, int L) {
    Frame F = launder(F0);
    const KArgs ka = kargs();
    const int b = F.bx >> 3, nb = F.bx & 7;
    const bf16* XR = (const bf16*)(F.ws + Z_XR); bf16* YR = (bf16*)(F.ws + Z_YR);
    const bf16* WL = (const bf16*)(F.ws + WS_W + W_LRU);
    LAS bf16* XC = (LAS bf16*)(F.lds + RING_OFF);
    LAS float* HH = (LAS float*)(F.lds + RING_OFF + 2 * 64 * XCS * 2);
    const int tid = F.tid, lane = F.lane, w = F.wave, g = lane >> 4, m = lane & 15;
    const int cc = tid & 15, tp = tid >> 4;
    const int ch0 = nb * 128 + 8 * cc;
    float cw[4][8], cbias[8];
#pragma unroll
    for (int j = 0; j < 4; ++j)
#pragma unroll
        for (int k = 0; k < 8; ++k) cw[j][k] = ka->in[I_CONVW][(size_t)L * 4 * D + j * D + ch0 + k];
#pragma unroll
    for (int k = 0; k < 8; ++k) cbias[k] = ka->in[I_CONVB][(size_t)L * D + ch0 + k];
    bf16x8 Br[4], Bi[4];
#pragma unroll
    for (int s = 0; s < 4; ++s) { Br[s] = *(const GAS bf16x8*)(WL + ((size_t)nb * 128 + 16 * w + m) * 128 + 32 * s + 8 * g);
                                  Bi[s] = *(const GAS bf16x8*)(WL + (size_t)8 * 128 * 128 + ((size_t)nb * 128 + 16 * w + m) * 128 + 32 * s + 8 * g); }
    const int chl = 16 * w + m, chg = nb * 128 + chl;
    const float ba = ka->in[I_LRUBA][(size_t)L * D + chg], bx = ka->in[I_LRUBX][(size_t)L * D + chg];
    const float lam = ka->in[I_LAM][(size_t)L * D + chg];
    const float sp8 = -8.0f * (fmaxf(-lam, 0.f) + log1pf(__expf(-fabsf(lam))));
    float carry = 0.f;
    const size_t rowb = (size_t)b * SEQ;
    v4u nxin[5], nyin[2];
#pragma unroll
    for (int k = 0; k < 5; ++k) { const int t = 2 * tp - 3 + k; v4u z; z.x = z.y = z.z = z.w = 0u; nxin[k] = (t >= 0) ? *(const GAS v4u*)(XR + (rowb + t) * D + ch0) : z; }
#pragma unroll
    for (int k = 0; k < 2; ++k) nyin[k] = *(const GAS v4u*)(YR + (rowb + 2 * tp + k) * D + ch0);
    for (int tile = 0; tile < 32; ++tile) {
        const int t0 = tile * 64, buf = tile & 1;
        LAS bf16* xc = XC + buf * 64 * XCS; LAS float* hh = HH + buf * 64 * HHS;
        v4u xin[5], yin[2];
#pragma unroll
        for (int k = 0; k < 5; ++k) xin[k] = nxin[k];
#pragma unroll
        for (int k = 0; k < 2; ++k) yin[k] = nyin[k];
        if (tile < 31) {
#pragma unroll
            for (int k = 0; k < 5; ++k) nxin[k] = *(const GAS v4u*)(XR + (rowb + t0 + 64 + 2 * tp - 3 + k) * D + ch0);
#pragma unroll
            for (int k = 0; k < 2; ++k) nyin[k] = *(const GAS v4u*)(YR + (rowb + t0 + 64 + 2 * tp + k) * D + ch0);
        }
#pragma unroll
        for (int k = 0; k < 2; ++k) { float o[8];
#pragma unroll
            for (int c = 0; c < 8; ++c) { float a = cbias[c];
#pragma unroll
                for (int j = 0; j < 4; ++j) { const unsigned wv = xin[k + j][c >> 1]; a += ((c & 1) ? bf_hi(wv) : bf_lo(wv)) * cw[j][c]; }
                o[c] = a; }
            v4u pw; pw.x = pk2(o[0], o[1]); pw.y = pk2(o[2], o[3]); pw.z = pk2(o[4], o[5]); pw.w = pk2(o[6], o[7]);
            *(LAS v4u*)(xc + (2 * tp + k) * XCS + 8 * cc) = pw; }
        __syncthreads();
#pragma unroll
        for (int mt = 0; mt < 4; ++mt) {
            f32x4 ar = (f32x4){0.f, 0.f, 0.f, 0.f}, ai = (f32x4){0.f, 0.f, 0.f, 0.f};
#pragma unroll
            for (int s = 0; s < 4; ++s) { const bf16x8 A = *(const LAS bf16x8*)(xc + (16 * mt + m) * XCS + 32 * s + 8 * g);
                ar = __builtin_amdgcn_mfma_f32_16x16x32_bf16(A, Br[s], ar, 0, 0, 0); ai = __builtin_amdgcn_mfma_f32_16x16x32_bf16(A, Bi[s], ai, 0, 0, 0); }
            float P[4], W[4];
#pragma unroll
            for (int i = 0; i < 4; ++i) {
                const float rr = sigmoidf_fast(ar[i] + ba), ig = sigmoidf_fast(ai[i] + bx);
                const float la = sp8 * rr;
                const float a = __builtin_amdgcn_exp2f(1.4426950408889634f * la);
                const float mult = __builtin_amdgcn_sqrtf(fmaxf(__builtin_fmaf(-a, a, 1.0f), 0.f));
                const float xv = __builtin_bit_cast(float, (unsigned)xc[(16 * mt + 4 * g + i) * XCS + chl] << 16);
                const float u = mult * (ig * xv);
                if (i == 0) { P[0] = a; W[0] = u; } else { P[i] = a * P[i - 1]; W[i] = a * W[i - 1] + u; }
            }
            float Ac = P[3], Uc = W[3];
            { const float A1 = lane_up(Ac, 16, lane), U1 = lane_up(Uc, 16, lane); if (g >= 1) { Uc = Ac * U1 + Uc; Ac = Ac * A1; } }
            { const float A2 = lane_up(Ac, 32, lane), U2 = lane_up(Uc, 32, lane); if (g >= 2) { Uc = Ac * U2 + Uc; Ac = Ac * A2; } }
            float Ae = lane_up(Ac, 16, lane), Ue = lane_up(Uc, 16, lane); if (g == 0) { Ae = 1.f; Ue = 0.f; }
            const float hin = Ae * carry + Ue;
            const float cnew = Ac * carry + Uc;
            carry = lane_get(cnew, 48 + m);
#pragma unroll
            for (int i = 0; i < 4; ++i) hh[(16 * mt + 4 * g + i) * HHS + chl] = P[i] * hin + W[i];
        }
        __syncthreads();
#pragma unroll
        for (int k = 0; k < 2; ++k) { const f32x4 h0 = *(const LAS f32x4*)(hh + (2 * tp + k) * HHS + 8 * cc), h1 = *(const LAS f32x4*)(hh + (2 * tp + k) * HHS + 8 * cc + 4);
            float o[8];
#pragma unroll
            for (int c = 0; c < 8; ++c) { const unsigned wv = yin[k][c >> 1]; const float y = (c & 1) ? bf_hi(wv) : bf_lo(wv); o[c] = (c < 4 ? h0[c] : h1[c - 4]) * gelu_tanh(y); }
            v4u pw; pw.x = pk2(o[0], o[1]); pw.y = pk2(o[2], o[3]); pw.z = pk2(o[4], o[5]); pw.w = pk2(o[6], o[7]);
            *(GAS v4u*)((DRY ? (bf16*)(F.ws + WS_NEED) : YR) + (rowb + t0 + 2 * tp + k) * D + ch0) = pw; }
    }
    __syncthreads();
}

struct MoeOrder : pg8::StaticOrder {
    const volatile LAS unsigned* tb; int tile0; const int* list; size_t bstride;
    __device__ __forceinline__ int expert_of(int gt) const { int e = 0;
#pragma unroll
        for (int k = 1; k < 8; ++k) e += (gt >= (int)tb[k]) ? 1 : 0;
        return e; }
    __device__ __forceinline__ const char* b_base(const pg8::Gemm& g, const pg8::Unit& u, size_t tstep) const { return (const char*)g.Bt + (size_t)expert_of(tile0 + u.pm) * bstride + (size_t)u.pn * tstep; }
};
struct MoeGatherOrder : MoeOrder {
    static constexpr bool GATHER = true;
    __device__ __forceinline__ const char* a_base(const pg8::Gemm& g, const pg8::Unit&, size_t) const { return (const char*)g.A; }
    __device__ __forceinline__ void a_rows(const pg8::Unit& u, int R0, int R1, int C0, int C1, int K, unsigned (&off)[2][2]) const {
        const int gt = tile0 + u.pm, e = expert_of(gt), j = gt - (int)tb[e], n = (int)tb[16 + e];
        const GAS int* le = (const GAS int*)list + (size_t)e * T_TOK;
#pragma unroll
        for (int h = 0; h < 2; ++h) { int p0 = 256 * j + 128 * h + R0, p1 = 256 * j + 128 * h + R1; p0 = p0 < n ? p0 : n - 1; p1 = p1 < n ? p1 : n - 1;
            off[h][0] = ((unsigned)le[p0] * (unsigned)K + (unsigned)C0) * 2u; off[h][1] = ((unsigned)le[p1] * (unsigned)K + (unsigned)C1) * 2u; }
    }
};
#ifdef SELFCHECK
#ifndef SC_TOL
#define SC_TOL 0.03f
#define SC_ABS 1e-5f
#endif
__device__ __forceinline__ float sc_bf(const bf16* p, size_t i) { return __builtin_bit_cast(float, (unsigned)((const GAS bf16*)p)[i] << 16); }
__device__ __forceinline__ float sc_f8(const unsigned char* p, size_t i) {
    const unsigned v = ((const GAS unsigned char*)p)[i]; const unsigned e = (v >> 3) & 15u, mn = v & 7u; float r;
    if (e == 0u) r = (float)mn * 0.001953125f; else r = (1.0f + (float)mn * 0.125f) * exp2f((float)e - 7.0f);
    return (v & 128u) ? -r : r; }
__device__ __forceinline__ void sc_fail(const Frame& F, unsigned code) { __hip_atomic_fetch_or(F.ctl + CW_CODE, code, RLX_AGENT); }
__device__ __forceinline__ int sc_bucket_ref(int rel) {
    const int half = 16, max_exact = 8; const int ret = rel > 0 ? half : 0; const int n = rel < 0 ? -rel : rel;
    const float nf = (float)(n > 1 ? n : 1);
    int large = max_exact + (int)(logf(nf / (float)max_exact) / logf(16.0f) * (float)(half - max_exact));
    large = large < half - 1 ? large : half - 1;
    return ret + (n < max_exact ? n : large);
}
__device__ __forceinline__ void selfcheck_topk(const Frame& F0) {
    Frame F = launder(F0);
    if (F.wave != 0) return;
    const bf16* QI = (const bf16*)(F.ws + Z_QI); const bf16* SM = (const bf16*)(F.ws + Z_SM);
    const GAS unsigned short* IDX = (const GAS unsigned short*)(F.ws + WS_IDX);
    LAS float* sc = (LAS float*)(F.lds + RING_OFF);
    LAS unsigned* bm = (LAS unsigned*)(F.lds + RING_OFF + 8192);
    const int tok = F.bx * 256 + ((F.bx * 37) & 255), b = tok >> 11, tq = tok & (SEQ - 1), n_adm = ((tq >> 6) + 1) * 64;
    const int lane = F.lane;
    bm[lane] = 0u;
    for (int s = lane; s < n_adm; s += 64) { float score = 0.f;
        for (int h = 0; h < 8; ++h) { float d = 0.f;
            for (int k = 0; k < 64; ++k) d += sc_bf(QI, (size_t)tok * 512 + h * 64 + k) * sc_bf(SM, (size_t)(b * SEQ + s) * 256 + 128 + k);
            score += fmaxf(d, 0.f) * sc_bf(SM, (size_t)tok * 256 + 192 + h); }
        sc[s] = score; }
    asm volatile("s_waitcnt lgkmcnt(0)" ::: "memory");
    const int nsel = n_adm < 256 ? n_adm : 256;
    float msel = 3.0e38f; bool bad = false;
    for (int p = lane; p < nsel; p += 64) { const int key = IDX[(size_t)tok * 256 + p]; if (key >= n_adm) { bad = true; continue; }
        const unsigned old = __hip_atomic_fetch_or(bm + (key >> 5), 1u << (key & 31), __ATOMIC_RELAXED, __HIP_MEMORY_SCOPE_WORKGROUP); if (old & (1u << (key & 31))) bad = true;
        msel = fminf(msel, sc[key]); }
    asm volatile("s_waitcnt lgkmcnt(0)" ::: "memory");
    float muns = -3.0e38f, amax = 0.f;
    for (int s = lane; s < n_adm; s += 64) { amax = fmaxf(amax, fabsf(sc[s])); if (!((bm[s >> 5] >> (s & 31)) & 1u)) muns = fmaxf(muns, sc[s]); }
#pragma unroll
    for (int o = 1; o < 64; o <<= 1) { msel = fminf(msel, lane_xor(msel, o, lane)); muns = fmaxf(muns, lane_xor(muns, o, lane)); amax = fmaxf(amax, lane_xor(amax, o, lane)); }
    if (muns > msel + 1e-4f * amax) bad = true;
    if (__any(bad)) { if (lane == 0) sc_fail(F, 1u); }
}
__device__ __forceinline__ void selfcheck_attn(const Frame& F0) {
    Frame F = launder(F0);
    if (F.wave != 0) return;
    const KArgs ka = kargs();
    const unsigned char* Q8 = F.ws + Z_Q8; const unsigned char* KV8 = F.ws + Z_KV8; const bf16* OB = (const bf16*)(F.ws + Z_XR);
    const GAS unsigned short* IDX = (const GAS unsigned short*)(F.ws + WS_IDX);
    LAS float* lg = (LAS float*)(F.lds + RING_OFF + 65536);
    const int tok = F.bx * 256 + ((F.bx * 37) & 255), b = tok >> 11, tq = tok & (SEQ - 1), n_adm = ((tq >> 6) + 1) * 64, nv = n_adm < 256 ? n_adm : 256;
    const int lane = F.lane;
    for (int p = lane; p < 256; p += 64) { const int key = IDX[(size_t)tok * 256 + p]; const int bk = sc_bucket_ref(key - tq);
        for (int h = 0; h < 16; ++h) { float d = 0.f;
            for (int k = 0; k < 64; ++k) d += sc_f8(Q8, (size_t)tok * D + h * 64 + k) * sc_f8(KV8, (size_t)(b * SEQ + key) * 128 + k);
            lg[h * 256 + p] = p < nv ? 0.125f * d + ((const GAS float*)ka->in[I_RELB])[bk * 16 + h] : -1e30f; } }
    asm volatile("s_waitcnt lgkmcnt(0)" ::: "memory");
    if (lane < 16) { float mx = -3.0e38f; for (int p = 0; p < 256; ++p) mx = fmaxf(mx, lg[lane * 256 + p]); float sum = 0.f;
        for (int p = 0; p < 256; ++p) { const float e = __expf(lg[lane * 256 + p] - mx); lg[lane * 256 + p] = e; sum += e; }
        const float inv = 1.f / sum; for (int p = 0; p < 256; ++p) lg[lane * 256 + p] *= inv; }
    asm volatile("s_waitcnt lgkmcnt(0)" ::: "memory");
    float emax = 0.f, omax = 0.f;
    for (int o = lane; o < 1024; o += 64) { const int h = o >> 6, d = o & 63; float acc = 0.f;
        for (int p = 0; p < 256; ++p) { const int key = IDX[(size_t)tok * 256 + p]; acc += lg[h * 256 + p] * sc_f8(KV8, (size_t)(b * SEQ + key) * 128 + 64 + d); }
        const float got = sc_bf(OB, (size_t)tok * D + o); emax = fmaxf(emax, fabsf(got - acc)); omax = fmaxf(omax, fabsf(acc)); }
#pragma unroll
    for (int o = 1; o < 64; o <<= 1) { emax = fmaxf(emax, lane_xor(emax, o, lane)); omax = fmaxf(omax, lane_xor(omax, o, lane)); }
    if (!(emax <= SC_TOL * omax + SC_ABS)) { if (lane == 0) sc_fail(F, 2u); }
}
__device__ __forceinline__ void selfcheck_lru(const Frame& F0, int L, bool after) {
    Frame F = launder(F0);
    if (F.wave != 0) return;
    const KArgs ka = kargs();
    const bf16* XR = (const bf16*)(F.ws + Z_XR); const bf16* YR = (const bf16*)(F.ws + Z_YR);
    GAS float* EXP = (GAS float*)(F.ws + WS_NEED) + (size_t)F.bx * SEQ;
    const int b = F.bx >> 3, ch = ((F.bx & 7) * 128 + ((F.bx * 29) & 127)), nb = ch >> 7, lane = F.lane;
    if (after) { float emax = 0.f, omax = 0.f;
        for (int t = lane; t < SEQ; t += 64) { const float e = EXP[t], g = sc_bf(YR, (size_t)(b * SEQ + t) * D + ch); emax = fmaxf(emax, fabsf(e - g)); omax = fmaxf(omax, fabsf(e)); }
#pragma unroll
        for (int o = 1; o < 64; o <<= 1) { emax = fmaxf(emax, lane_xor(emax, o, lane)); omax = fmaxf(omax, lane_xor(omax, o, lane)); }
        if (!(emax <= SC_TOL * omax + SC_ABS)) { if (lane == 0) sc_fail(F, 4u); }
        return; }
    const float* cw = ka->in[I_CONVW] + (size_t)L * 4 * D; const float* cb = ka->in[I_CONVB] + (size_t)L * D;
    const float* wa = ka->in[I_LRUWA] + ((size_t)L * 8 + nb) * 128 * 128; const float* wx = ka->in[I_LRUWX] + ((size_t)L * 8 + nb) * 128 * 128;
    const float lam = ka->in[I_LAM][(size_t)L * D + ch], ba = ka->in[I_LRUBA][(size_t)L * D + ch], bx = ka->in[I_LRUBX][(size_t)L * D + ch];
    const float sp = fmaxf(-lam, 0.f) + log1pf(expf(-fabsf(lam)));
    const int dl = ch & 127;
    float h = 0.f;
    for (int t = 0; t < SEQ; ++t) {
        float pr = 0.f, pi = 0.f, xcc = 0.f;
#pragma unroll
        for (int q = 0; q < 2; ++q) { const int cl = lane + 64 * q, cg = nb * 128 + cl; float xc = cb[cg];
            for (int j = 0; j < 4; ++j) { const int tt = t - 3 + j; if (tt >= 0) xc += sc_bf(XR, (size_t)(b * SEQ + tt) * D + cg) * cw[j * D + cg]; }
            pr += xc * wa[cl * 128 + dl]; pi += xc * wx[cl * 128 + dl]; if (cl == dl) xcc = xc; }
#pragma unroll
        for (int o = 1; o < 64; o <<= 1) { pr += lane_xor(pr, o, lane); pi += lane_xor(pi, o, lane); xcc += lane_xor(xcc, o, lane); }
        const float r = 1.f / (1.f + expf(-(pr + ba))), ig = 1.f / (1.f + expf(-(pi + bx)));
        const float la = -8.0f * r * sp, a = expf(la), u = sqrtf(-expm1f(2.0f * la)) * (ig * xcc);
        h = a * h + u;
        const float y = sc_bf(YR, (size_t)(b * SEQ + t) * D + ch);
        const float gl = 0.5f * y * (1.f + tanhf(0.7978845608028654f * (y + 0.044715f * y * y * y)));
        if (lane == 0) EXP[t] = h * gl;
    }
}
#endif
__global__ void __launch_bounds__(NWAVES * 64, 2) mk_fwd(Args args) {
    extern __shared__ __attribute__((aligned(16))) unsigned char lds[];
    Frame F;
    F.lds = (LAS unsigned char*)lds;
    F.MISC = (volatile LAS unsigned*)(F.lds + MISC_OFF);
    F.tid = threadIdx.x; F.lane = F.tid & 63; F.wave = __builtin_amdgcn_readfirstlane(F.tid >> 6);
    F.G = gridDim.x; F.bx = blockIdx.x;
    F.ws = args.ws; F.ctl = (gu32*)(args.ws + WS_CTL); F.out = args.out;
    for (int u = threadIdx.x; u < (LDS_BYTES - LDSCTL_OFF) / 4; u += NWAVES * 64) ((LAS unsigned*)(F.lds + LDSCTL_OFF))[u] = 0u;
    __syncthreads();
    XcdBarrier bar = xcd_barrier_post((unsigned*)(F.ctl + CW_BAR), F.MISC + 8);
#define GRID_BAR() do { XcdBarrier b_ = bar; unsigned* p_ = bar.bar; asm volatile("" : "+s"(p_)); b_.bar = p_; xcd_barrier(b_); } while (0)
    float* X32 = args.out;
#define LOCAL_HANDOFF() do { asm volatile("s_waitcnt vmcnt(0)" ::: "memory"); __syncthreads(); __builtin_amdgcn_fence(__ATOMIC_ACQUIRE, "agent"); asm volatile("s_waitcnt vmcnt(0)" ::: "memory"); __syncthreads(); } while (0)
    LAS unsigned char* ring = F.lds + RING_OFF;
    using pg8::Gemm; using pg8::StaticOrder;

    for (int L = 0; L < DEPTH; ++L) {
        const int odd = L & 1;
#ifndef SK_P0
        p0_convert(F, L);
#endif
#ifdef DUP_P0
        __syncthreads(); p0_convert(F, L);
#endif
        GRID_BAR();
        { const Frame P = launder(F); unsigned char* ws = P.ws; unsigned char* wb = ws + WS_W; bf16* XB = (bf16*)(ws + WS_XB); (void)XB; (void)wb;
          Gemm g{XB, (const bf16*)(wb + W_IN), T_TOK, NIN, D}; StaticOrder S; S.init(T_TOK, NIN, P.G, P.bx);
          pg8::EpiZ E{(bf16*)(ws + Z_Q), (bf16*)(ws + Z_QI), (bf16*)(ws + Z_SM), ws + Z_Q8, ws + Z_KV8};
#ifndef SK_G1
          pg8::gemm_phase<pg8::EpiZ, StaticOrder>(ring, g, S, E, P.wave);
#endif
        }
        GRID_BAR();
#if defined(SELFCHECK) && SELFCHECK == 3
        if (L == 0) { selfcheck_lru(F, L, false); __syncthreads(); }
#endif
#ifdef DUP_IDX
        indexer_phase<DUP_IDX>(F);
#endif
#ifndef SK_IDX
        indexer_phase(F);
#endif
#ifdef DUP_LRU
        lru_phase<true>(F, L);
#endif
#ifndef SK_LRU
        lru_phase(F, L);
#endif
        GRID_BAR();
#if defined(SELFCHECK) && SELFCHECK == 1
        if (L == 0) { selfcheck_topk(F); __syncthreads(); }
#endif
#if defined(SELFCHECK) && SELFCHECK == 3
        if (L == 0) { selfcheck_lru(F, L, true); __syncthreads(); }
#endif
#ifdef DUP_ATT
        attention_phase<DUP_ATT>(F); __syncthreads();
#endif
#ifndef SK_ATT
        attention_phase(F);
#endif
        GRID_BAR();
#if defined(SELFCHECK) && SELFCHECK == 2
        if (L == 0) { selfcheck_attn(F); __syncthreads(); }
#endif
        { const Frame P = launder(F); unsigned char* ws = P.ws; unsigned char* wb = ws + WS_W; bf16* XB = (bf16*)(ws + WS_XB); (void)XB; (void)wb;
          Gemm g{(const bf16*)(ws + Z_XR), (const bf16*)(wb + W_BRA), T_TOK, D, D}; StaticOrder S; S.init(T_TOK, D, F.G, F.bx);
          pg8::EpiGate<0> E{(bf16*)(ws + Z_GA), nullptr};
#ifndef SK_G2
          pg8::gemm_phase<pg8::EpiGate<0>, StaticOrder>(ring, g, S, E, P.wave);
#endif
        }
        LOCAL_HANDOFF();
        { const Frame P = launder(F); unsigned char* ws = P.ws; unsigned char* wb = ws + WS_W; bf16* XB = (bf16*)(ws + WS_XB); (void)XB; (void)wb;
          Gemm g{(const bf16*)(ws + Z_YR), (const bf16*)(wb + W_BRR), T_TOK, D, D}; StaticOrder S; S.init(T_TOK, D, F.G, F.bx);
          pg8::EpiGate<1> E{(bf16*)(ws + Z_GA), (const bf16*)(ws + Z_GR)};
#ifndef SK_G3
          pg8::gemm_phase<pg8::EpiGate<1>, StaticOrder>(ring, g, S, E, P.wave);
#endif
        }
        GRID_BAR();
        { const Frame P = launder(F); unsigned char* ws = P.ws; unsigned char* wb = ws + WS_W; bf16* XB = (bf16*)(ws + WS_XB); (void)XB; (void)wb;
          Gemm g{(const bf16*)(ws + Z_GA), (const bf16*)(wb + W_O), T_TOK, D, D}; StaticOrder S; S.init(T_TOK, D, F.G, F.bx);
          pg8::EpiRes<0> E{X32, XB, nullptr};
#ifndef SK_G4
          pg8::gemm_phase<pg8::EpiRes<0>, StaticOrder>(ring, g, S, E, P.wave);
#endif
        }
        GRID_BAR();
#ifdef DUP_LN
        ln_phase<false, false, true>(F, L); ln_phase<false, false, true>(F, L);
#endif
#ifndef SK_LN
        if (odd) ln_phase<false, true>(F, L); else ln_phase<false, false>(F, L);
#endif
        GRID_BAR();
        if (odd) {
            if (launder(F).tid == 0) { unsigned acc = 0u; F.MISC[16] = 0u;
                for (int e = 0; e < 8; ++e) { const unsigned c = __hip_atomic_load(F.ctl + CW_CNT + (L >> 1) * 1024 + 64 * e, RLX_AGENT); F.MISC[32 + e] = c; acc += (c + 255u) >> 8; F.MISC[17 + e] = acc; } }
            __syncthreads();
        }
        { const Frame P = launder(F); unsigned char* ws = P.ws; unsigned char* wb = ws + WS_W; bf16* XB = (bf16*)(ws + WS_XB); (void)XB; (void)wb;
          Gemm g{(const bf16*)(ws + F_PB), (const bf16*)(wb + W_PP), T_TOK, D, PLE}; StaticOrder S; S.init(T_TOK, D, F.G, F.bx);
          pg8::EpiBf16 E{(bf16*)(ws + F_U), D, 0};
#ifndef SK_G5
          pg8::gemm_phase<pg8::EpiBf16, StaticOrder>(ring, g, S, E, P.wave);
#endif
        }
        LOCAL_HANDOFF();
        { const Frame P = launder(F); unsigned char* ws = P.ws; unsigned char* wb = ws + WS_W; bf16* XB = (bf16*)(ws + WS_XB); (void)XB; (void)wb;
          Gemm g{XB, (const bf16*)(wb + W_PG), T_TOK, D, D}; StaticOrder S; S.init(T_TOK, D, F.G, F.bx);
          pg8::EpiRes<1> E{X32, XB, (const bf16*)(ws + F_U)};
#ifndef SK_G6
          pg8::gemm_phase<pg8::EpiRes<1>, StaticOrder>(ring, g, S, E, P.wave);
#endif
        }
        if (!odd) {
            { const Frame P = launder(F); unsigned char* ws = P.ws; unsigned char* wb = ws + WS_W; bf16* XB = (bf16*)(ws + WS_XB); (void)XB; (void)wb;
          Gemm g{XB, (const bf16*)(wb + W_FF), T_TOK, 2 * DFF, D}; StaticOrder S; S.init(T_TOK, 2 * DFF, F.G, F.bx);
              pg8::EpiSwiglu E{(bf16*)(ws + F_H), DFF};
#ifndef SK_G7
              pg8::gemm_phase<pg8::EpiSwiglu, StaticOrder>(ring, g, S, E, P.wave);
#endif
        }
            GRID_BAR();
            { const Frame P = launder(F); unsigned char* ws = P.ws; unsigned char* wb = ws + WS_W; bf16* XB = (bf16*)(ws + WS_XB); (void)XB; (void)wb;
          Gemm g{(const bf16*)(ws + F_H), (const bf16*)(wb + W_FF_DN_DENSE), T_TOK, D, DFF}; StaticOrder S; S.init(T_TOK, D, F.G, F.bx);
              pg8::EpiRes<2> E{X32, nullptr, nullptr};
#ifndef SK_G8
              pg8::gemm_phase<pg8::EpiRes<2>, StaticOrder>(ring, g, S, E, P.wave);
#endif
        }
            GRID_BAR();
#ifndef SK_LN
            ln_phase<true, false>(F, L);
#endif
        } else {
            const int ntiles = (int)F.MISC[24];
            const int nchunks = (ntiles + MOE_CHUNK_TILES - 1) / MOE_CHUNK_TILES;
            for (int c = 0; c < nchunks; ++c) {
                const int tile0 = c * MOE_CHUNK_TILES, ntl = (ntiles - tile0) < MOE_CHUNK_TILES ? (ntiles - tile0) : MOE_CHUNK_TILES;
                const size_t hc_off = (c & 1) ? F_H1 : F_H;
                { const Frame P = launder(F); unsigned char* ws = P.ws; unsigned char* wb = ws + WS_W; bf16* XB = (bf16*)(ws + WS_XB); (void)XB; (void)wb;
          Gemm g{XB, (const bf16*)(wb + W_FF), ntl * 256, 2 * DFFE, D}; MoeGatherOrder S; S.init(ntl * 256, 2 * DFFE, F.G, F.bx);
                  S.tb = F.MISC + 16; S.tile0 = tile0; S.list = (const int*)(ws + WS_LIST); S.bstride = (size_t)2 * DFFE * D * 2;
                  pg8::EpiSwiglu E{(bf16*)(ws + hc_off), DFFE};
#ifndef SK_G9
                  pg8::gemm_phase<pg8::EpiSwiglu, MoeGatherOrder>(ring, g, S, E, P.wave);
#endif
        }
                GRID_BAR();
                { const Frame P = launder(F); unsigned char* ws = P.ws; unsigned char* wb = ws + WS_W; bf16* XB = (bf16*)(ws + WS_XB); (void)XB; (void)wb;
          Gemm g{(const bf16*)(ws + hc_off), (const bf16*)(wb + W_FF_DN_MOE), ntl * 256, D, DFFE}; MoeOrder S; S.init(ntl * 256, D, F.G, F.bx);
                  S.tb = F.MISC + 16; S.tile0 = tile0; S.list = nullptr; S.bstride = (size_t)D * DFFE * 2;
                  pg8::EpiBf16 E{(bf16*)(ws + F_YE), D, tile0 * 256};
#ifndef SK_G10
                  pg8::gemm_phase<pg8::EpiBf16, MoeOrder>(ring, g, S, E, P.wave);
#endif
        }
            }
            GRID_BAR();
#ifndef SK_LN
            ln_phase<true, true>(F, L);
#endif
        }
        GRID_BAR();
    }
    if (__hip_atomic_load(F.ctl + CW_BAR + XB_TMO, RLX_AGENT) != 0u || __hip_atomic_load(F.ctl + CW_CODE, RLX_AGENT) != 0u) {
        const float q = __builtin_nanf("");
        for (size_t i = (size_t)F.bx * 512 + launder(F).tid; i < (size_t)T_TOK * D; i += (size_t)F.G * 512) X32[i] = q;
    }
}

#if defined(SELFCHECK)
constexpr size_t WS_DRY_EXTRA = 4 * MiB;
#elif defined(DUP_LRU) || defined(DUP_LN)
constexpr size_t WS_DRY_EXTRA = 80 * MiB;
#else
constexpr size_t WS_DRY_EXTRA = 0;
#endif
extern "C" void kernel_launch(void* const* d_in, const int* in_sizes, int n_in, void* d_out, int out_size, void* d_ws, size_t ws_size, hipStream_t stream) {
    static int grid = 0;
    if (grid == 0) {
        if (n_in != 28 || out_size != T_TOK * D || ws_size < WS_NEED + WS_DRY_EXTRA) { fprintf(stderr, "kernel_launch: unexpected shapes: n_in %d out %d ws %zu (need %zu)\n", n_in, out_size, ws_size, (size_t)WS_END); grid = -1; return; }
        int dev = 0, cus = 0, per_cu = 0;
        if (hipGetDevice(&dev) != hipSuccess || hipDeviceGetAttribute(&cus, hipDeviceAttributeMultiprocessorCount, dev) != hipSuccess) { grid = -1; return; }
        if (hipFuncSetAttribute((const void*)mk_fwd, hipFuncAttributeMaxDynamicSharedMemorySize, LDS_BYTES) != hipSuccess) { fprintf(stderr, "kernel_launch: hipFuncSetAttribute failed\n"); grid = -1; return; }
        if (hipOccupancyMaxActiveBlocksPerMultiprocessor(&per_cu, (const void*)mk_fwd, NWAVES * 64, LDS_BYTES) != hipSuccess || per_cu < 1) { fprintf(stderr, "kernel_launch: occupancy query says %d blocks per CU\n", per_cu); }
        (void)hipGetLastError();
        grid = cus;
        if (grid != 256) { fprintf(stderr, "kernel_launch: this kernel needs a 256-CU device (got %d)\n", cus); grid = -1; return; }
    }
    if (grid < 0) return;
    if (hipMemsetAsync((char*)d_ws + WS_CTL, 0, CTL_ZERO_BYTES, stream) != hipSuccess) return;
    Args a{};
    for (int i = 0; i < 28; ++i) a.in[i] = (const float*)d_in[i];
    a.out = (float*)d_out; a.ws = (unsigned char*)d_ws;
    hipLaunchKernelGGL(mk_fwd, dim3(grid), dim3(NWAVES * 64), LDS_BYTES, stream, a);
}
```

```cpp
#include <hip/hip_runtime.h>
#include <cstdio>
#include <cstdint>

constexpr int T_TOK = 65536, D = 1024, SEQ = 2048, NBATCH = 32, DEPTH = 4;
constexpr int D_IN = 5832, NIN = 5888;
constexpr int DFF = 2816, DFFE = 3584, NEXP = 8, PLE = 256;
constexpr float LN_EPS = 1e-5f;
constexpr float DN_ALPHA = 1.681792830507429f;

namespace pg8 {
#define PG8_LAS __attribute__((address_space(3)))
typedef unsigned short bf16_t;
typedef short bf16x8 __attribute__((ext_vector_type(8)));
typedef float f32x4 __attribute__((ext_vector_type(4)));
typedef unsigned u32x4 __attribute__((ext_vector_type(4)));
typedef unsigned u32x2 __attribute__((ext_vector_type(2)));
constexpr int BM = 256, BK = 64, HALF = 128, HTB = HALF * BK * 2  , STAGE_BYTES = 8 * HTB, NXCD = 8, WGM = 8;

__host__ __device__ __forceinline__ int lds_byte(int r, int c) { const int st = (r >> 4) * 2 + (c >> 5), rr = r & 15, cc = c & 31, ob = rr * 64 + cc * 2; return st * 1024 + (ob ^ (((ob >> 9) & 1) << 5)); }
__host__ __device__ __forceinline__ void stage_rc(int b, int& R, int& C) { const int st = b / 1024, sb = b % 1024, swz = sb ^ (((sb >> 9) & 1) << 5); R = (st >> 1) * 16 + swz / 64; C = (st & 1) * 32 + (swz % 64) / 2; }
__host__ __device__ __forceinline__ int perm32(int rho) { const int n = rho >> 4, i = rho & 15; return 8 * (i >> 2) + 4 * n + (i & 3); }

struct Unit { int pm, pn; };
struct Gemm { const bf16_t* A; const bf16_t* Bt; int M, N, K; };

struct StaticOrder {
    static constexpr bool GATHER = false;
    int nM, nN, nwg, G, c;
    __host__ __device__ void init(int M, int N, int G_, int c_) { nM = M / BM; nN = N / BM; nwg = nM * nN; G = G_; c = c_; }
    __host__ __device__ bool next(int i, Unit& u) const {
        const long L = (long)i * G + c; if (L >= nwg) return false;
        int wgid = (int)L; { const int q = nwg / NXCD, r = nwg % NXCD, xcd = wgid % NXCD, off = wgid / NXCD; wgid = (xcd < r ? xcd * (q + 1) : r * (q + 1) + (xcd - r) * q) + off; }
        const int nig = WGM * nN, gid = wgid / nig, fm = gid * WGM, gsz = (nM - fm) < WGM ? (nM - fm) : WGM;
        u.pm = fm + ((wgid % nig) % gsz); u.pn = (wgid % nig) / gsz; return true;
    }
    __device__ __forceinline__ const char* a_base(const Gemm& g, const Unit& u, size_t tstep) const { return (const char*)g.A + (size_t)u.pm * tstep; }
    __device__ __forceinline__ const char* b_base(const Gemm& g, const Unit& u, size_t tstep) const { return (const char*)g.Bt + (size_t)u.pn * tstep; }
    __device__ __forceinline__ void a_rows(const Unit&, int, int, int, int, int, unsigned (&)[2][2]) const {}
    __device__ __forceinline__ void a_ready(const Unit&) const {}
    __device__ __forceinline__ void done(const Unit&) const {}
};

__device__ __forceinline__ unsigned cvt_pk_bf16(float lo, float hi) { unsigned r; asm volatile("v_cvt_pk_bf16_f32 %0, %1, %2" : "=v"(r) : "v"(lo), "v"(hi)); return r; }
__device__ __forceinline__ float bf_lo(unsigned w) { return __builtin_bit_cast(float, w << 16); }
__device__ __forceinline__ float bf_hi(unsigned w) { return __builtin_bit_cast(float, w & 0xffff0000u); }
__device__ __forceinline__ float sigmoidf_fast(float x) { return __builtin_amdgcn_rcpf(1.0f + __builtin_amdgcn_exp2f(-1.4426950408889634f * x)); }
#define EPI_FENCE() asm volatile("" ::: "memory")
#define EGAS __attribute__((address_space(1)))
__device__ __forceinline__ u32x4 pack8(const f32x4 v0, const f32x4 v1) { u32x4 w; w.x = cvt_pk_bf16(v0[0], v0[1]); w.y = cvt_pk_bf16(v0[2], v0[3]); w.z = cvt_pk_bf16(v1[0], v1[1]); w.w = cvt_pk_bf16(v1[2], v1[3]); return w; }

struct EpiBf16 {
    static constexpr bool PERM = true, AFTER_DRAIN = false;
    bf16_t* O; int ldc; int row_off;
    __device__ __forceinline__ void operator()(const f32x4 (&acc)[2][2][4][2], const Unit& u, int wr, int wc, int fr, int fq) const {
        { int l_ = (int)__builtin_amdgcn_mbcnt_hi(~0u, __builtin_amdgcn_mbcnt_lo(~0u, 0u)); asm volatile("" : "+v"(l_)); fr = l_ & 15; fq = l_ >> 4; }
        const int row0 = row_off + u.pm * BM + wr * 64 + fr, col0 = u.pn * BM + wc * 32 + 8 * fq;
#pragma unroll
        for (int ai = 0; ai < 2; ++ai)
#pragma unroll
            for (int m = 0; m < 4; ++m) { bf16_t* rowp = O + (size_t)(row0 + ai * HALF + m * 16) * ldc + col0;
#pragma unroll
                for (int bj = 0; bj < 2; ++bj) *(EGAS u32x4*)(rowp + bj * HALF) = pack8(acc[ai][bj][m][0], acc[ai][bj][m][1]); }
    }
};
__device__ __forceinline__ u32x2 pack8_fp8(const f32x4 v0, const f32x4 v1) { int a = __builtin_amdgcn_cvt_pk_fp8_f32(v0[0], v0[1], 0, false); a = __builtin_amdgcn_cvt_pk_fp8_f32(v0[2], v0[3], a, true);
    int b = __builtin_amdgcn_cvt_pk_fp8_f32(v1[0], v1[1], 0, false); b = __builtin_amdgcn_cvt_pk_fp8_f32(v1[2], v1[3], b, true); u32x2 r; r.x = (unsigned)a; r.y = (unsigned)b; return r; }
struct EpiZ {
    static constexpr bool PERM = true, AFTER_DRAIN = false;
    bf16_t* zbig; bf16_t* zqi; bf16_t* zsm; unsigned char* q8; unsigned char* kv8;
    __device__ __forceinline__ void operator()(const f32x4 (&acc)[2][2][4][2], const Unit& u, int wr, int wc, int fr, int fq) const {
        { int l_ = (int)__builtin_amdgcn_mbcnt_hi(~0u, __builtin_amdgcn_mbcnt_lo(~0u, 0u)); asm volatile("" : "+v"(l_)); fr = l_ & 15; fq = l_ >> 4; }
        const int row0 = u.pm * BM + wr * 64 + fr;
        if (u.pn < 4) {
            const int col0 = u.pn * BM + wc * 32 + 8 * fq;
#pragma unroll
            for (int ai = 0; ai < 2; ++ai)
#pragma unroll
                for (int m = 0; m < 4; ++m) { unsigned char* rowp = q8 + (size_t)(row0 + ai * HALF + m * 16) * D + col0;
#pragma unroll
                    for (int bj = 0; bj < 2; ++bj) *(EGAS u32x2*)(rowp + bj * HALF) = pack8_fp8(acc[ai][bj][m][0], acc[ai][bj][m][1]); }
            return;
        }
        bf16_t* base; int ld, colt;
        if (u.pn < 20) { base = zbig + (size_t)(u.pn >> 2) * ((size_t)T_TOK * D); ld = D; colt = (u.pn & 3) * BM; }
        else if (u.pn < 22) { base = zqi; ld = 512; colt = (u.pn - 20) * BM; }
        else { base = zsm; ld = 256; colt = 0; }
        const int col0 = colt + wc * 32 + 8 * fq;
#pragma unroll
        for (int ai = 0; ai < 2; ++ai)
#pragma unroll
            for (int m = 0; m < 4; ++m) { bf16_t* rowp = base + (size_t)(row0 + ai * HALF + m * 16) * ld + col0;
#pragma unroll
                for (int bj = 0; bj < 2; ++bj) *(EGAS u32x4*)(rowp + bj * HALF) = pack8(acc[ai][bj][m][0], acc[ai][bj][m][1]); }
        if (u.pn == 22) {
#pragma unroll
            for (int ai = 0; ai < 2; ++ai)
#pragma unroll
                for (int m = 0; m < 4; ++m) *(EGAS u32x2*)(kv8 + (size_t)(row0 + ai * HALF + m * 16) * 128 + wc * 32 + 8 * fq) = pack8_fp8(acc[ai][0][m][0], acc[ai][0][m][1]);
        }
    }
};
template <int MODE> struct EpiGate {
    static constexpr bool PERM = true, AFTER_DRAIN = false;
    bf16_t* G; const bf16_t* G2;
    __device__ __forceinline__ void operator()(const f32x4 (&acc)[2][2][4][2], const Unit& u, int wr, int wc, int fr, int fq) const {
        { int l_ = (int)__builtin_amdgcn_mbcnt_hi(~0u, __builtin_amdgcn_mbcnt_lo(~0u, 0u)); asm volatile("" : "+v"(l_)); fr = l_ & 15; fq = l_ >> 4; }
        const int row0 = u.pm * BM + wr * 64 + fr, col0 = u.pn * BM + wc * 32 + 8 * fq;
#pragma unroll
        for (int ai = 0; ai < 2; ++ai) {
            u32x4 gw[4][2], g2[4][2];
#pragma unroll
            for (int m = 0; m < 4; ++m)
#pragma unroll
                for (int bj = 0; bj < 2; ++bj) { const size_t o = (size_t)(row0 + ai * HALF + m * 16) * D + col0 + bj * HALF;
                    gw[m][bj] = *(const EGAS u32x4*)(G + o); if (MODE == 1) g2[m][bj] = *(const EGAS u32x4*)(G2 + o); }
#pragma unroll
            for (int m = 0; m < 4; ++m)
#pragma unroll
                for (int bj = 0; bj < 2; ++bj) { const size_t o = (size_t)(row0 + ai * HALF + m * 16) * D + col0 + bj * HALF;
                    f32x4 v0 = acc[ai][bj][m][0], v1 = acc[ai][bj][m][1];
#pragma unroll
                    for (int j = 0; j < 4; ++j) { const unsigned wa = gw[m][bj][j >> 1], wb = gw[m][bj][2 + (j >> 1)];
                        const float ga = (j & 1) ? bf_hi(wa) : bf_lo(wa), gb = (j & 1) ? bf_hi(wb) : bf_lo(wb);
                        if (MODE == 0) { v0[j] *= sigmoidf_fast(ga); v1[j] *= sigmoidf_fast(gb); }
                        else { const unsigned xa = g2[m][bj][j >> 1], xb = g2[m][bj][2 + (j >> 1)];
                            v0[j] = ga + v0[j] * sigmoidf_fast((j & 1) ? bf_hi(xa) : bf_lo(xa)); v1[j] = gb + v1[j] * sigmoidf_fast((j & 1) ? bf_hi(xb) : bf_lo(xb)); } }
                    *(EGAS u32x4*)(G + o) = pack8(v0, v1); }
            EPI_FENCE(); }
    }
};
template <int MODE> struct EpiRes {
    static constexpr bool PERM = true, AFTER_DRAIN = false;
    float* Y; const bf16_t* XB; const bf16_t* U;
    __device__ __forceinline__ void operator()(const f32x4 (&acc)[2][2][4][2], const Unit& u, int wr, int wc, int fr, int fq) const {
        { int l_ = (int)__builtin_amdgcn_mbcnt_hi(~0u, __builtin_amdgcn_mbcnt_lo(~0u, 0u)); asm volatile("" : "+v"(l_)); fr = l_ & 15; fq = l_ >> 4; }
        const int row0 = u.pm * BM + wr * 64 + fr, col0 = u.pn * BM + wc * 32 + 8 * fq;
#pragma unroll
        for (int ai = 0; ai < 2; ++ai) {
            u32x4 xw[4][2], uw[4][2];
#pragma unroll
            for (int m = 0; m < 4; ++m)
#pragma unroll
                for (int bj = 0; bj < 2; ++bj) { const size_t o = (size_t)(row0 + ai * HALF + m * 16) * D + col0 + bj * HALF;
                    xw[m][bj] = *(const EGAS u32x4*)(XB + o);
                    if (MODE == 1) uw[m][bj] = *(const EGAS u32x4*)(U + o); }
#pragma unroll
            for (int m = 0; m < 4; ++m)
#pragma unroll
                for (int bj = 0; bj < 2; ++bj) { const size_t o = (size_t)(row0 + ai * HALF + m * 16) * D + col0 + bj * HALF;
#pragma unroll
                    for (int n = 0; n < 2; ++n) { const f32x4 a = acc[ai][bj][m][n]; f32x4 r;
                        if (MODE == 0) { const unsigned x0 = xw[m][bj][2 * n], x1 = xw[m][bj][2 * n + 1];
                            r[0] = bf_lo(x0) * DN_ALPHA + a[0]; r[1] = bf_hi(x0) * DN_ALPHA + a[1]; r[2] = bf_lo(x1) * DN_ALPHA + a[2]; r[3] = bf_hi(x1) * DN_ALPHA + a[3]; }
                        else { const unsigned x0 = xw[m][bj][2 * n], x1 = xw[m][bj][2 * n + 1], w0 = uw[m][bj][2 * n], w1 = uw[m][bj][2 * n + 1];
                            r[0] = bf_lo(x0) * DN_ALPHA + bf_lo(w0) + a[0]; r[1] = bf_hi(x0) * DN_ALPHA + bf_hi(w0) + a[1];
                            r[2] = bf_lo(x1) * DN_ALPHA + bf_lo(w1) + a[2]; r[3] = bf_hi(x1) * DN_ALPHA + bf_hi(w1) + a[3]; }
                        *(EGAS f32x4*)(Y + o + 4 * n) = r; } }
            EPI_FENCE(); }
    }
};
struct EpiPle {
    static constexpr bool PERM = true, AFTER_DRAIN = false;
    bf16_t* U;
    __device__ __forceinline__ void operator()(const f32x4 (&acc)[2][2][4][2], const Unit& u, int wr, int wc, int fr, int fq) const {
        { int l_ = (int)__builtin_amdgcn_mbcnt_hi(~0u, __builtin_amdgcn_mbcnt_lo(~0u, 0u)); asm volatile("" : "+v"(l_)); fr = l_ & 15; fq = l_ >> 4; }
        const int row0 = u.pm * BM + wr * 64 + fr, col0 = u.pn * BM + wc * 32 + 8 * fq;
#pragma unroll
        for (int ai = 0; ai < 2; ++ai) {
            u32x4 uw[4][2];
#pragma unroll
            for (int m = 0; m < 4; ++m)
#pragma unroll
                for (int bj = 0; bj < 2; ++bj) uw[m][bj] = *(const EGAS u32x4*)(U + (size_t)(row0 + ai * HALF + m * 16) * D + col0 + bj * HALF);
#pragma unroll
            for (int m = 0; m < 4; ++m)
#pragma unroll
                for (int bj = 0; bj < 2; ++bj) { f32x4 v0 = acc[ai][bj][m][0], v1 = acc[ai][bj][m][1];
#pragma unroll
                    for (int j = 0; j < 4; ++j) { const unsigned wa = uw[m][bj][j >> 1], wb = uw[m][bj][2 + (j >> 1)];
                        v0[j] = sigmoidf_fast(v0[j]) * ((j & 1) ? bf_hi(wa) : bf_lo(wa)); v1[j] = sigmoidf_fast(v1[j]) * ((j & 1) ? bf_hi(wb) : bf_lo(wb)); }
                    *(EGAS u32x4*)(U + (size_t)(row0 + ai * HALF + m * 16) * D + col0 + bj * HALF) = pack8(v0, v1); }
            EPI_FENCE(); }
    }
};
struct EpiSwiglu {
    static constexpr bool PERM = true, AFTER_DRAIN = false;
    bf16_t* H; int ldh;
    __device__ __forceinline__ void operator()(const f32x4 (&acc)[2][2][4][2], const Unit& u, int wr, int wc, int fr, int fq) const {
        { int l_ = (int)__builtin_amdgcn_mbcnt_hi(~0u, __builtin_amdgcn_mbcnt_lo(~0u, 0u)); asm volatile("" : "+v"(l_)); fr = l_ & 15; fq = l_ >> 4; }
        const int row0 = u.pm * BM + wr * 64 + fr, col0 = u.pn * HALF + wc * 32 + 8 * fq;
#pragma unroll
        for (int ai = 0; ai < 2; ++ai)
#pragma unroll
            for (int m = 0; m < 4; ++m) { bf16_t* rowp = H + (size_t)(row0 + ai * HALF + m * 16) * ldh + col0;
                f32x4 v0, v1;
#pragma unroll
                for (int j = 0; j < 4; ++j) { const float g0 = acc[ai][0][m][0][j], g1 = acc[ai][0][m][1][j];
                    v0[j] = g0 * sigmoidf_fast(g0) * acc[ai][1][m][0][j]; v1[j] = g1 * sigmoidf_fast(g1) * acc[ai][1][m][1][j]; }
                *(EGAS u32x4*)rowp = pack8(v0, v1); }
    }
};
template <class Epi, class Sched, bool ALIGN_EPI = true>
__device__ __forceinline__ void gemm_phase(PG8_LAS unsigned char* lds, const Gemm g, const Sched& S, const Epi& E, const int wave_id) {
    int lane_ = (int)__builtin_amdgcn_mbcnt_hi(~0u, __builtin_amdgcn_mbcnt_lo(~0u, 0u)); asm volatile("" : "+v"(lane_));
    const int wid = wave_id, lane = lane_, tid = wid * 64 + lane, wr = wid >> 2, wc = wid & 3, fr = lane & 15, fq = lane >> 4;
    const int K = g.K, nt = K / BK;
    unsigned voffA[2], voffB[2]; int RA[2], CA[2];
#pragma unroll
    for (int i = 0; i < 2; ++i) { int R, C; stage_rc(tid * 16 + i * 8192, R, C); const int Rb = Epi::PERM ? ((R & ~31) + perm32(R & 31)) : R; RA[i] = R; CA[i] = C;
        voffA[i] = (unsigned)(R * K + C) * 2u; voffB[i] = (unsigned)(Rb * K + C) * 2u; }
    const size_t kstep = (size_t)(BK * 2);
    const size_t hstep = (size_t)HALF * K * 2;
    const size_t tstep = 2 * hstep;
    const unsigned ldsw = (unsigned)wid * 1024u;
    const int aoff = lds_byte(wr * 64 + fr, fq * 8), boff = lds_byte(wc * 32 + fr, fq * 8);
    unsigned offC[2][2] = {{0u, 0u}, {0u, 0u}}, offN[2][2] = {{0u, 0u}, {0u, 0u}};
#define PG8_SA(b, h) (((b) * 2 + (h)) * HTB)
#define PG8_SB(b, h) ((4 + (b) * 2 + (h)) * HTB)
#define PG8_STAGE(bufoff, gbase, voff) do { _Pragma("unroll") for (int _i = 0; _i < 2; ++_i) \
        __builtin_amdgcn_global_load_lds((const unsigned*)((const char*)(gbase) + (voff)[_i]), (PG8_LAS unsigned*)(lds + (bufoff) + ldsw + _i * 8192), 16, 0, 0); } while (0)
#define PG8_STA(bufoff, ptr, h, NX) do { if constexpr (Sched::GATHER) { _Pragma("unroll") for (int _i = 0; _i < 2; ++_i) { const unsigned _o = (NX) ? offN[h][_i] : offC[h][_i]; \
        __builtin_amdgcn_global_load_lds((const unsigned*)((const char*)(ptr) + _o), (PG8_LAS unsigned*)(lds + (bufoff) + ldsw + _i * 8192), 16, 0, 0); } } \
        else { PG8_STAGE(bufoff, (ptr) + (h) * hstep, voffA); } } while (0)
#define PG8_LDA(dst, b, h) do { _Pragma("unroll") for (int m = 0; m < 4; ++m) _Pragma("unroll") for (int k = 0; k < 2; ++k) dst[m][k] = *(const PG8_LAS bf16x8*)(lds + PG8_SA(b, h) + aoff + m * 2048 + k * 1024); } while (0)
#define PG8_LDB(dst, b, h) do { _Pragma("unroll") for (int n = 0; n < 2; ++n) _Pragma("unroll") for (int k = 0; k < 2; ++k) dst[n][k] = *(const PG8_LAS bf16x8*)(lds + PG8_SB(b, h) + boff + n * 2048 + k * 1024); } while (0)
#define PG8_MMA(ai, bj, At, Bt) do { __builtin_amdgcn_s_setprio(1); _Pragma("unroll") for (int m = 0; m < 4; ++m) _Pragma("unroll") for (int n = 0; n < 2; ++n) _Pragma("unroll") for (int k = 0; k < 2; ++k) \
        acc[ai][bj][m][n] = __builtin_amdgcn_mfma_f32_16x16x32_bf16(Bt[n][k], At[m][k], acc[ai][bj][m][n], 0, 0, 0); __builtin_amdgcn_s_setprio(0); } while (0)
#define PG8_WAIT_V(n) asm volatile("s_waitcnt vmcnt(" #n ")" ::: "memory")
#define PG8_WAIT_L(n) asm volatile("s_waitcnt lgkmcnt(" #n ")" ::: "memory")
#define PG8_BAR __builtin_amdgcn_s_barrier()
#define PG8_SCHED __builtin_amdgcn_sched_barrier(0)
    Unit cur, nxt; int ui = 0;
    if (!S.next(0, cur)) return;
    f32x4 acc[2][2][4][2];
#pragma unroll
    for (int a = 0; a < 2; ++a)
#pragma unroll
        for (int b = 0; b < 2; ++b)
#pragma unroll
            for (int m = 0; m < 4; ++m)
#pragma unroll
                for (int n = 0; n < 2; ++n) acc[a][b][m][n] = (f32x4){0.f, 0.f, 0.f, 0.f};
    bf16x8 At[4][2], B0[2][2], B1[2][2];
    const char* cA = S.a_base(g, cur, tstep); const char* cB = S.b_base(g, cur, tstep);
    if constexpr (Sched::GATHER) S.a_rows(cur, RA[0], RA[1], CA[0], CA[1], K, offC);
    S.a_ready(cur);
    PG8_STAGE(PG8_SB(0, 0), cB, voffB); PG8_STAGE(PG8_SB(0, 1), cB + hstep, voffB); PG8_STA(PG8_SA(0, 0), cA, 0, false); PG8_STA(PG8_SA(0, 1), cA, 1, false);
    if (wr == 1) PG8_BAR;
    PG8_WAIT_V(2); PG8_BAR;
    PG8_STAGE(PG8_SB(1, 0), cB + kstep, voffB); PG8_STA(PG8_SA(1, 0), cA + kstep, 0, false); PG8_STAGE(PG8_SB(1, 1), cB + hstep + kstep, voffB);
    PG8_WAIT_V(6); PG8_BAR;
    for (;;) {
        const bool has_next = S.next(ui + 1, nxt);
        const char* nA = has_next ? S.a_base(g, nxt, tstep) : cA; const char* nB = has_next ? S.b_base(g, nxt, tstep) : cB;
        if constexpr (Sched::GATHER) { if (has_next) S.a_rows(nxt, RA[0], RA[1], CA[0], CA[1], K, offN); else {
#pragma unroll
            for (int h = 0; h < 2; ++h)
#pragma unroll
                for (int i = 0; i < 2; ++i) offN[h][i] = offC[h][i]; } }
        for (int t = 0; t < nt; t += 2) {
            const bool last = (t == nt - 2);
            const char* a1 = cA + (size_t)(t + 1) * kstep;
            const char* a2 = last ? nA : cA + (size_t)(t + 2) * kstep; const char* b2 = last ? nB : cB + (size_t)(t + 2) * kstep;
            const char* a3 = a2 + kstep; const char* b3 = b2 + kstep;
            if (last && has_next) S.a_ready(nxt);
            PG8_LDB(B0, 0, 0); PG8_LDB(B1, 0, 1); PG8_SCHED; PG8_LDA(At, 0, 0); PG8_STA(PG8_SA(1, 1), a1, 1, false);
            PG8_WAIT_V(8); PG8_WAIT_L(0); PG8_BAR; PG8_MMA(0, 0, At, B0); PG8_MMA(0, 1, At, B1); PG8_BAR; PG8_SCHED;
            PG8_LDA(At, 0, 1); PG8_STAGE(PG8_SB(0, 0), b2, voffB); PG8_STAGE(PG8_SB(0, 1), b2 + hstep, voffB); PG8_STA(PG8_SA(0, 0), a2, 0, last);
            PG8_WAIT_V(8); PG8_WAIT_L(0); PG8_BAR; PG8_MMA(1, 0, At, B0); PG8_MMA(1, 1, At, B1); PG8_BAR; PG8_SCHED;
            PG8_LDB(B0, 1, 0); PG8_LDB(B1, 1, 1); PG8_SCHED; PG8_LDA(At, 1, 0); PG8_STA(PG8_SA(0, 1), a2, 1, last);
            PG8_WAIT_V(8); PG8_WAIT_L(0); PG8_BAR; PG8_MMA(0, 0, At, B0); PG8_MMA(0, 1, At, B1); PG8_BAR; PG8_SCHED;
            PG8_LDA(At, 1, 1); PG8_STAGE(PG8_SB(1, 0), b3, voffB); PG8_STAGE(PG8_SB(1, 1), b3 + hstep, voffB); PG8_STA(PG8_SA(1, 0), a3, 0, last);
            PG8_WAIT_V(8); PG8_WAIT_L(0); PG8_BAR; PG8_MMA(1, 0, At, B0); PG8_MMA(1, 1, At, B1); PG8_BAR; PG8_SCHED;
        }
        if constexpr (ALIGN_EPI) { if (wr == 0) PG8_BAR; }
        E(acc, cur, wr, wc, fr, fq); S.done(cur);
        if (!has_next) break;
#pragma unroll
        for (int a = 0; a < 2; ++a)
#pragma unroll
            for (int b = 0; b < 2; ++b)
#pragma unroll
                for (int m = 0; m < 4; ++m)
#pragma unroll
                    for (int n = 0; n < 2; ++n) acc[a][b][m][n] = (f32x4){0.f, 0.f, 0.f, 0.f};
        cur = nxt; cA = nA; cB = nB; ++ui;
        if constexpr (Sched::GATHER) {
#pragma unroll
            for (int h = 0; h < 2; ++h)
#pragma unroll
                for (int i = 0; i < 2; ++i) offC[h][i] = offN[h][i]; }
        if constexpr (ALIGN_EPI) { if (wr == 1) PG8_BAR; }
    }
    PG8_WAIT_V(0);
    if constexpr (!ALIGN_EPI) { if (wr == 0) PG8_BAR; }
    PG8_BAR;
#undef PG8_SA
#undef PG8_SB
#undef PG8_STAGE
#undef PG8_STA
#undef PG8_LDA
#undef PG8_LDB
#undef PG8_MMA
#undef PG8_WAIT_V
#undef PG8_WAIT_L
#undef PG8_BAR
#undef PG8_SCHED
}
}
constexpr int NWAVES = 8;
constexpr size_t MiB = 1u << 20;
constexpr size_t WS_CTL = 0, CTL_ZERO_BYTES = 1 * MiB;
constexpr size_t WS_ROUTE = 1 * MiB;
constexpr size_t WS_LIST = 3 * MiB;
constexpr size_t WS_W = 8 * MiB;
constexpr size_t W_IN = 0, W_BRA = 12 * MiB, W_BRR = 14 * MiB, W_O = 16 * MiB, W_PG = 18 * MiB, W_PP = 20 * MiB, W_LRU = 21 * MiB, W_FF = 22 * MiB;
constexpr size_t W_FF_DN_DENSE = W_FF + 11 * MiB, W_FF_DN_MOE = W_FF + 112 * MiB;
constexpr size_t WS_XB = 208 * MiB;
constexpr size_t WS_IDX = 336 * MiB;
constexpr size_t WS_Z = 368 * MiB;
constexpr size_t Z_Q = WS_Z, Z_XR = WS_Z + 128 * MiB, Z_YR = WS_Z + 256 * MiB, Z_GA = WS_Z + 384 * MiB, Z_GR = WS_Z + 512 * MiB, Z_QI = WS_Z + 640 * MiB, Z_SM = WS_Z + 704 * MiB;
constexpr size_t Z_Q8 = Z_Q, Z_KV8 = Z_Q + 64 * MiB;
constexpr size_t WS_END = WS_Z + 736 * MiB;
constexpr size_t F_U = Z_Q;
constexpr size_t F_PB = Z_SM;
constexpr size_t F_H = Z_XR;
constexpr size_t F_H1 = WS_END;
constexpr size_t F_YE = Z_GA;
constexpr int MOE_CHUNK_TILES = 128;
constexpr size_t F_H_CHUNK_BYTES = (size_t)MOE_CHUNK_TILES * 256 * DFFE * 2;
constexpr size_t WS_NEED = F_H1 + F_H_CHUNK_BYTES;
static_assert(F_H + F_H_CHUNK_BYTES <= F_YE && F_YE + (size_t)520 * 256 * D * 2 <= Z_SM && F_H + (size_t)T_TOK * DFF * 2 <= Z_GR, "overlay map");
constexpr int CW_TMO = 0, CW_CODE = 1, CW_BAR = 4096, CW_CNT = 16384;
constexpr int RING_OFF = 0, RING_BYTES = 131072;
constexpr int LDSCTL_OFF = RING_BYTES, MISC_OFF = LDSCTL_OFF + 320;
constexpr int LDS_BYTES = 147456;

#define GAS __attribute__((address_space(1)))
#define LAS __attribute__((address_space(3)))
typedef unsigned short bf16;
typedef unsigned v4u __attribute__((ext_vector_type(4)));
typedef unsigned v2u __attribute__((ext_vector_type(2)));
typedef float f32x4 __attribute__((ext_vector_type(4)));
typedef float f32x16 __attribute__((ext_vector_type(16)));
typedef short bf16x8 __attribute__((ext_vector_type(8)));
typedef GAS unsigned gu32;
#define RLX_AGENT __ATOMIC_RELAXED, __HIP_MEMORY_SCOPE_AGENT
#define LDS_WAIT() asm volatile("s_waitcnt lgkmcnt(0)" ::: "memory")
#define VM_WAIT() asm volatile("s_waitcnt vmcnt(0)" ::: "memory")
using pg8::cvt_pk_bf16; using pg8::bf_lo; using pg8::bf_hi; using pg8::sigmoidf_fast;
#define XB_TMO      128
#define XB_XCNT(j)  (256  + 64 * (j))
#define XB_XSUB(j)  (1280 + 64 * (j))
#define XB_XGEN(j)  (2304 + 64 * (j))
#define XB_TOP      3328
#define XB_TOPGEN   3392
#define XCD_BAR_WORDS 3456
#define XB_SPIN_CAP (1u << 21)

__device__ __forceinline__ unsigned xb_ld(unsigned* p)              { return __hip_atomic_load(p, __ATOMIC_RELAXED, __HIP_MEMORY_SCOPE_AGENT); }
__device__ __forceinline__ unsigned xb_add(unsigned* p, unsigned v) { return __hip_atomic_fetch_add(p, v, __ATOMIC_RELAXED, __HIP_MEMORY_SCOPE_AGENT); }
__device__ __forceinline__ unsigned xb_xcc_id() { return (unsigned)__builtin_amdgcn_s_getreg((3 << 11) | 20) & 0xFu; }
#define XB_SPIN(cond, bar) do { unsigned _sp = 0; while (cond) { __builtin_amdgcn_s_sleep(1); \
    if ((++_sp & 255u) == 0u) { if (xb_ld(&(bar)[XB_TMO])) break; if (_sp > XB_SPIN_CAP) { atomicAdd(&(bar)[XB_TMO], 1u); break; } } } } while (0)

struct XcdBarrier {
    unsigned* bar; unsigned x;
    volatile LAS unsigned* st;
};

__device__ __forceinline__ XcdBarrier xcd_barrier_post(unsigned* bar, volatile LAS unsigned* st) {
    XcdBarrier b; b.bar = bar; b.x = xb_xcc_id(); b.st = st;
    if (threadIdx.x == 0) (void)xb_add(&bar[XB_XCNT(b.x)], 1u);
    return b;
}
__device__ __forceinline__ void xcd_barrier_complete(unsigned* bar, unsigned x, unsigned& nloc, unsigned& nx) {
    const unsigned G = gridDim.x * gridDim.y * gridDim.z;
    unsigned sum, cnt, mine, sp = 0u;
    for (;;) {
        sum = 0u; cnt = 0u; mine = 0u;
#pragma unroll
        for (unsigned j = 0; j < 16; ++j) { const unsigned c = xb_ld(&bar[XB_XCNT(j)]); sum += c; cnt += (c > 0u) ? 1u : 0u; mine = (j == x) ? c : mine; }
        if (sum == G) break;
        __builtin_amdgcn_s_sleep(1);
        if ((++sp & 255u) == 0u) { if (xb_ld(&bar[XB_TMO])) break; if (sp > XB_SPIN_CAP) { atomicAdd(&bar[XB_TMO], 1u); break; } }
    }
    nloc = mine > 0u ? mine : 1u; nx = cnt > 0u ? cnt : 1u;
}

__device__ __forceinline__ void xcd_barrier(const XcdBarrier& b) {
    asm volatile("s_waitcnt vmcnt(0)" ::: "memory");
    __syncthreads();
    if (threadIdx.x == 0) {
        unsigned* bar = b.bar;
        __builtin_amdgcn_s_waitcnt(0);
        unsigned nloc = b.st[0], nx = b.st[1];
        if (nloc == 0u) { xcd_barrier_complete(bar, b.x, nloc, nx); b.st[0] = nloc; b.st[1] = nx; }
        const unsigned old = xb_add(&bar[XB_XSUB(b.x)], 1u);
        const unsigned gen = old / nloc;
        if (old + 1u == (gen + 1u) * nloc) {
            __builtin_amdgcn_fence(__ATOMIC_RELEASE, "agent");
            asm volatile("s_waitcnt vmcnt(0)" ::: "memory");
            const unsigned og = xb_add(&bar[XB_TOP], 1u);
            const unsigned tg = og / nx;
            if (og + 1u == (tg + 1u) * nx) xb_add(&bar[XB_TOPGEN], 1u);
            else XB_SPIN(xb_ld(&bar[XB_TOPGEN]) == tg, bar);
            __builtin_amdgcn_fence(__ATOMIC_ACQUIRE, "agent");
            xb_add(&bar[XB_XGEN(b.x)], 1u);
            asm volatile("s_waitcnt vmcnt(0)" ::: "memory");
        } else {
            XB_SPIN(xb_ld(&bar[XB_XGEN(b.x)]) == gen, bar);
            __builtin_amdgcn_fence(__ATOMIC_ACQUIRE, "agent");
            asm volatile("s_waitcnt vmcnt(0)" ::: "memory");
        }
    }
    __syncthreads();
}
struct Frame {
    LAS unsigned char* lds;
    volatile LAS unsigned* MISC;
    gu32* ctl;
    int tid, lane, wave, G, bx;
    unsigned char* ws;
    float* out;
};
struct Args { const float* in[28]; float* out; unsigned char* ws; };
typedef const __attribute__((address_space(4))) Args* KArgs;
__device__ __forceinline__ KArgs kargs() { KArgs k = (KArgs)__builtin_amdgcn_kernarg_segment_ptr(); asm volatile("" : "+s"(k)); return k; }
enum { I_X = 0, I_P, I_WIN, I_CONVW, I_CONVB, I_LRUWA, I_LRUBA, I_LRUWX, I_LRUBX, I_LAM, I_WBRA, I_WBRR, I_WO, I_RELB, I_LN1G, I_LN1B, I_FFG, I_FFU, I_FFD, I_ROUTER, I_ROUTERB, I_MOEG, I_MOEU, I_MOED, I_PLEG, I_PLEP, I_LN2G, I_LN2B };

__device__ __forceinline__ Frame launder(const Frame& F0) { Frame F = F0; unsigned char* w = F0.ws; int l = (int)__builtin_amdgcn_mbcnt_hi(~0u, __builtin_amdgcn_mbcnt_lo(~0u, 0u)); asm volatile("" : "+s"(w)); asm volatile("" : "+v"(l));
    F.ws = w; F.lane = l; F.tid = F0.wave * 64 + l; F.ctl = (gu32*)(w + WS_CTL); return F; }
__device__ __forceinline__ float lane_get(float v, int src_lane) { return __builtin_bit_cast(float, __builtin_amdgcn_ds_bpermute(src_lane << 2, __builtin_bit_cast(int, v))); }
__device__ __forceinline__ float lane_xor(float v, int mask, int lane) { return lane_get(v, lane ^ mask); }
__device__ __forceinline__ float lane_up(float v, int d, int lane) { return lane_get(v, lane >= d ? lane - d : lane); }
__device__ __forceinline__ float wave_sum(float v, int lane) {
#pragma unroll
    for (int o = 1; o < 64; o <<= 1) v += lane_xor(v, o, lane);
    return v;
}
__device__ __forceinline__ unsigned pk2(float lo, float hi) { return cvt_pk_bf16(lo, hi); }

__device__ __forceinline__ void cvt_item(const float* W, int ldw, int K, bf16* WT, int d0, int sc0, int nvalid, float scale, int k0, LAS float* scr, int lane) {
    const int n4 = (lane & 7) * 4;
    f32x4 v[8];
#pragma unroll
    for (int i = 0; i < 8; ++i) { const int kk = 8 * i + (lane >> 3); v[i] = (f32x4){0.f, 0.f, 0.f, 0.f}; if (n4 < nvalid) v[i] = *(const GAS f32x4*)(W + (size_t)(k0 + kk) * ldw + sc0 + n4); }
#pragma unroll
    for (int i = 0; i < 8; ++i) { const int kk = 8 * i + (lane >> 3); LAS float* d = scr + kk * 33 + n4; d[0] = v[i][0] * scale; d[1] = v[i][1] * scale; d[2] = v[i][2] * scale; d[3] = v[i][3] * scale; }
    LDS_WAIT(); asm volatile("" ::: "memory");
    const int c = lane & 7;
#pragma unroll
    for (int j = 0; j < 4; ++j) { const int nn = (lane >> 3) + 8 * j; const LAS float* s = scr + (8 * c) * 33 + nn;
        v4u o; o.x = pk2(s[0 * 33], s[1 * 33]); o.y = pk2(s[2 * 33], s[3 * 33]); o.z = pk2(s[4 * 33], s[5 * 33]); o.w = pk2(s[6 * 33], s[7 * 33]);
        *(GAS v4u*)(WT + (size_t)(d0 + nn) * K + k0 + 8 * c) = o; }
    LDS_WAIT(); asm volatile("" ::: "memory");
}
__device__ __forceinline__ void cvt_plain(const float* W, int K, int N, bf16* WT, int item, LAS float* scr, int lane) {
    const int nblk = N / 32, kb = item / nblk, nb = item % nblk;
    cvt_item(W, N, K, WT, 32 * nb, 32 * nb, 32, 1.0f, 64 * kb, scr, lane);
}
__device__ __forceinline__ void cvt_gateup(const float* Wg, const float* Wu, int dff, bf16* WT, int item, LAS float* scr, int lane) {
    const int nblk = 2 * dff / 32, kb = item / nblk, db = item % nblk, d0 = 32 * db, pn = d0 >> 8, r = d0 & 255;
    const float* W = r < 128 ? Wg : Wu; const int sc0 = 128 * pn + (r & 127);
    cvt_item(W, dff, D, WT, d0, sc0, 32, 1.0f, 64 * kb, scr, lane);
}
__device__ __forceinline__ void cvt_win(const float* W, bf16* WT, int item, LAS float* scr, int lane) {
    const int nblk = NIN / 32, kb = item / nblk, db = item % nblk, d0 = 32 * db;
    int sc0, nv = 32; float sc = 1.0f;
    if (d0 < 1024) { sc0 = d0; }
    else if (d0 < 2048) sc0 = 1736 + (d0 - 1024);
    else if (d0 < 3072) sc0 = 2760 + (d0 - 2048);
    else if (d0 < 4096) sc0 = 3784 + (d0 - 3072);
    else if (d0 < 5120) sc0 = 4808 + (d0 - 4096);
    else if (d0 < 5632) sc0 = 1152 + (d0 - 5120);
    else if (d0 < 5696) sc0 = 1024 + (d0 - 5632);
    else if (d0 < 5760) sc0 = 1088 + (d0 - 5696);
    else if (d0 < 5824) sc0 = 1664 + (d0 - 5760);
    else if (d0 == 5824) { sc0 = 1728; nv = 8; }
    else { sc0 = 0; nv = 0; }
    cvt_item(W, D_IN, D, WT, d0, sc0, nv, sc, 64 * kb, scr, lane);
}
__device__ __forceinline__ void p0_convert(const Frame& F0, int L) {
    Frame F = launder(F0);
    const KArgs ka = kargs();
    LAS float* scr = (LAS float*)(F.lds + RING_OFF + F.wave * 16384);
    const int gw = F.bx * NWAVES + F.wave, NGW = F.G * NWAVES;
    unsigned char* wb = F.ws + WS_W;
    const int odd = L & 1, jj = L >> 1;
    constexpr int I_IN = (D / 64) * (NIN / 32), I_SQ = (D / 64) * (D / 32), I_PPJ = (PLE / 64) * (D / 32), I_LRU1 = 2 * 4;
    constexpr int I_GU_D = (D / 64) * (2 * DFF / 32), I_DN_D = (DFF / 64) * (D / 32), I_GU_E = (D / 64) * (2 * DFFE / 32), I_DN_E = (DFFE / 64) * (D / 32);
    const int n_ff = odd ? NEXP * (I_GU_E + I_DN_E) : (I_GU_D + I_DN_D);
    const int NITEMS = I_IN + 4 * I_SQ + I_PPJ + 16 * I_LRU1 + n_ff;
    for (int it = gw; it < NITEMS; it += NGW) {
        const float* W; bf16* WT; int ldw, K, d0, sc0, nv = 32, k0; float scale = 1.0f;
        int r = it, kind = 0, m = 0;
        if (r < I_IN) kind = 1;
        else { r -= I_IN;
            if (r < 4 * I_SQ) { m = r / I_SQ; r -= m * I_SQ; }
            else { r -= 4 * I_SQ;
                if (r < I_PPJ) m = 4;
                else { r -= I_PPJ;
                    if (r < 16 * I_LRU1) m = 5;
                    else { r -= 16 * I_LRU1;
                        if (!odd) { if (r < I_GU_D) kind = 2; else { r -= I_GU_D; m = 6; } }
                        else { if (r < NEXP * I_GU_E) kind = 3; else { r -= NEXP * I_GU_E; m = 7; } } } } } }
        if (kind == 1) { const int nblk = NIN / 32, kb = r / nblk, db = r % nblk; d0 = 32 * db; k0 = 64 * kb;
            W = ka->in[I_WIN] + (size_t)L * D * D_IN; WT = (bf16*)(wb + W_IN); ldw = D_IN; K = D;
            if (d0 < 1024) sc0 = d0;
            else if (d0 < 2048) sc0 = 1736 + (d0 - 1024);
            else if (d0 < 3072) sc0 = 2760 + (d0 - 2048);
            else if (d0 < 4096) sc0 = 3784 + (d0 - 3072);
            else if (d0 < 5120) sc0 = 4808 + (d0 - 4096);
            else if (d0 < 5632) sc0 = 1152 + (d0 - 5120);
            else if (d0 < 5696) sc0 = 1024 + (d0 - 5632);
            else if (d0 < 5760) sc0 = 1088 + (d0 - 5696);
            else if (d0 < 5824) sc0 = 1664 + (d0 - 5760);
            else if (d0 == 5824) { sc0 = 1728; nv = 8; }
            else { sc0 = 0; nv = 0; } }
        else if (kind >= 2) { const int dff = kind == 2 ? DFF : DFFE; int e = 0; if (kind == 3) { e = r / I_GU_E; r -= e * I_GU_E; }
            const size_t eo = kind == 2 ? (size_t)jj * D * DFF : ((size_t)jj * NEXP + e) * D * DFFE;
            const int nblk = 2 * dff / 32, kb = r / nblk, db = r % nblk; d0 = 32 * db; k0 = 64 * kb; const int pn = d0 >> 8, rr = d0 & 255;
            W = (rr < 128 ? ka->in[kind == 2 ? I_FFG : I_MOEG] : ka->in[kind == 2 ? I_FFU : I_MOEU]) + eo; sc0 = 128 * pn + (rr & 127); ldw = dff; K = D;
            WT = (bf16*)(wb + W_FF) + (kind == 3 ? (size_t)e * 2 * DFFE * D : 0); }
        else { int Kk, Nn;
            if (m < 4) { Kk = D; Nn = D; W = ka->in[m == 0 ? I_WBRA : m == 1 ? I_WBRR : m == 2 ? I_WO : I_PLEG] + (size_t)L * D * D; WT = (bf16*)(wb + (m == 0 ? W_BRA : m == 1 ? W_BRR : m == 2 ? W_O : W_PG)); }
            else if (m == 4) { Kk = PLE; Nn = D; W = ka->in[I_PLEP] + (size_t)L * PLE * D; WT = (bf16*)(wb + W_PP); }
            else if (m == 5) { const int mm = r / I_LRU1, blk = mm & 7, which = mm >> 3; r -= mm * I_LRU1; Kk = 128; Nn = 128;
                W = ka->in[which ? I_LRUWX : I_LRUWA] + (size_t)L * 8 * 128 * 128 + (size_t)blk * 128 * 128; WT = (bf16*)(wb + W_LRU) + (size_t)which * 8 * 128 * 128 + (size_t)blk * 128 * 128; }
            else if (m == 6) { Kk = DFF; Nn = D; W = ka->in[I_FFD] + (size_t)jj * DFF * D; WT = (bf16*)(wb + W_FF_DN_DENSE); }
            else { const int e = r / I_DN_E; r -= e * I_DN_E; Kk = DFFE; Nn = D; W = ka->in[I_MOED] + ((size_t)jj * NEXP + e) * DFFE * D; WT = (bf16*)(wb + W_FF_DN_MOE) + (size_t)e * D * DFFE; }
            const int nblk = Nn / 32, kb = r / nblk, nb = r % nblk; d0 = 32 * nb; sc0 = 32 * nb; k0 = 64 * kb; ldw = Nn; K = Kk; }
        cvt_item(W, ldw, K, WT, d0, sc0, nv, scale, k0, scr, F.lane);
    }
    if (L == 0) {
        const GAS f32x4* x4 = (const GAS f32x4*)ka->in[I_X]; GAS v4u* o = (GAS v4u*)(F.ws + WS_XB);
        const size_t n8 = (size_t)T_TOK * D / 8;
        for (size_t i = (size_t)F.bx * 512 + F.tid; i < n8; i += (size_t)F.G * 512) { const f32x4 a = x4[2 * i], b = x4[2 * i + 1];
            v4u w; w.x = pk2(a[0], a[1]); w.y = pk2(a[2], a[3]); w.z = pk2(b[0], b[1]); w.w = pk2(b[2], b[3]); o[i] = w; }
    }
}

template <bool LN2, bool ODD, bool DRY = false>
__device__ __forceinline__ void ln_phase(const Frame& F0, int L) {
    Frame F = launder(F0);
    const KArgs ka = kargs();
    const int jj = L >> 1;
    float* X32 = F.out; bf16* XB = (bf16*)(F.ws + WS_XB);
    const float* gam = ka->in[LN2 ? I_LN2G : I_LN1G] + (size_t)L * D; const float* bet = ka->in[LN2 ? I_LN2B : I_LN1B] + (size_t)L * D;
    f32x4 gv[4], bv[4];
#pragma unroll
    for (int j = 0; j < 4; ++j) { gv[j] = ((const GAS f32x4*)gam)[F.lane + 64 * j]; bv[j] = ((const GAS f32x4*)bet)[F.lane + 64 * j]; }
    LAS float* RT = (LAS float*)(F.lds + RING_OFF);
    LAS unsigned* TE = (LAS unsigned*)(F.lds + RING_OFF + 32768);
    volatile LAS unsigned* lcnt = F.MISC + 48; volatile LAS unsigned* gbase = F.MISC + 56;
    float rb[8];
    if (!LN2 && ODD) {
        const float* R = ka->in[I_ROUTER] + (size_t)jj * D * NEXP;
        for (int i = F.tid; i < D * NEXP; i += 512) RT[i] = R[i];
        if (F.tid < 8) lcnt[F.tid] = 0u;
#pragma unroll
        for (int e = 0; e < 8; ++e) rb[e] = ka->in[I_ROUTERB][jj * NEXP + e];
        __syncthreads();
    }
    const unsigned* route = (const unsigned*)(F.ws + WS_ROUTE);
    const bf16* YE = (const bf16*)(F.ws + F_YE);
    const bf16* T1 = (const bf16*)(F.ws + (LN2 ? F_U : Z_GR)); const bf16* T2 = (const bf16*)(F.ws + Z_GR);
    v2u nx[4], n1[4];
    { const size_t r0 = ((size_t)F.bx * 256 + F.wave) * D; const GAS v2u* a0 = (const GAS v2u*)(XB + r0) + F.lane; const GAS v2u* b0 = (const GAS v2u*)(T1 + r0) + F.lane;
#pragma unroll
      for (int j = 0; j < 4; ++j) { nx[j] = a0[64 * j]; n1[j] = b0[64 * j]; } }
    for (int it = 0; it < 32; ++it) {
        const int rl = F.wave + 8 * it; const size_t row = (size_t)F.bx * 256 + rl;
        GAS f32x4* xr = (GAS f32x4*)(X32 + row * D) + F.lane;
        f32x4 v[4]; float s = 0.f;
#pragma unroll
        for (int j = 0; j < 4; ++j) { const v2u a = nx[j], b = n1[j];
            v[j][0] = DN_ALPHA * bf_lo(a.x) + bf_lo(b.x); v[j][1] = DN_ALPHA * bf_hi(a.x) + bf_hi(b.x); v[j][2] = DN_ALPHA * bf_lo(a.y) + bf_lo(b.y); v[j][3] = DN_ALPHA * bf_hi(a.y) + bf_hi(b.y); }
        if (it < 31) { const GAS v2u* a0 = (const GAS v2u*)(XB + (row + 8) * D) + F.lane; const GAS v2u* b0 = (const GAS v2u*)(T1 + (row + 8) * D) + F.lane;
#pragma unroll
            for (int j = 0; j < 4; ++j) { nx[j] = a0[64 * j]; n1[j] = b0[64 * j]; } }
        if (LN2 && !ODD) {
            const GAS v2u* fp = (const GAS v2u*)(T2 + row * D) + F.lane;
#pragma unroll
            for (int j = 0; j < 4; ++j) { const v2u b = fp[64 * j]; v[j][0] += bf_lo(b.x); v[j][1] += bf_hi(b.x); v[j][2] += bf_lo(b.y); v[j][3] += bf_hi(b.y); }
        }
        if (LN2 && ODD) {
            const unsigned e1 = route[row * 8 + 0], e2 = route[row * 8 + 1], p1 = route[row * 8 + 2], p2 = route[row * 8 + 3];
            const float g1 = __builtin_bit_cast(float, route[row * 8 + 4]), g2 = __builtin_bit_cast(float, route[row * 8 + 5]);
            const size_t r1 = (size_t)F.MISC[16 + e1] * 256 + p1, r2 = (size_t)F.MISC[16 + e2] * 256 + p2;
            const GAS v2u* y1 = (const GAS v2u*)(YE + r1 * D) + F.lane; const GAS v2u* y2 = (const GAS v2u*)(YE + r2 * D) + F.lane;
#pragma unroll
            for (int j = 0; j < 4; ++j) { const v2u a = y1[64 * j], b = y2[64 * j];
                v[j][0] += g1 * bf_lo(a.x) + g2 * bf_lo(b.x); v[j][1] += g1 * bf_hi(a.x) + g2 * bf_hi(b.x);
                v[j][2] += g1 * bf_lo(a.y) + g2 * bf_lo(b.y); v[j][3] += g1 * bf_hi(a.y) + g2 * bf_hi(b.y); }
        }
#pragma unroll
        for (int j = 0; j < 4; ++j) s += (v[j][0] + v[j][1]) + (v[j][2] + v[j][3]);
        const float mean = wave_sum(s, F.lane) * (1.f / D); float s2 = 0.f;
#pragma unroll
        for (int j = 0; j < 4; ++j) { v[j] = v[j] - mean; s2 += (v[j][0] * v[j][0] + v[j][1] * v[j][1]) + (v[j][2] * v[j][2] + v[j][3] * v[j][3]); }
        const float rstd = 1.f / sqrtf(wave_sum(s2, F.lane) * (1.f / D) + LN_EPS);
        GAS v2u* o8 = (GAS v2u*)((DRY ? (bf16*)(F.ws + WS_NEED) : XB) + row * D) + F.lane;
        GAS f32x4* xw = DRY ? (GAS f32x4*)((float*)(F.ws + WS_NEED) + row * D) + F.lane : xr;
#pragma unroll
        for (int j = 0; j < 4; ++j) { v[j] = v[j] * rstd * gv[j] + bv[j]; if (DRY || (LN2 && L == DEPTH - 1)) xw[64 * j] = v[j];
            v2u w; w.x = pk2(v[j][0], v[j][1]); w.y = pk2(v[j][2], v[j][3]); o8[64 * j] = w; }
        if (!LN2) {
            const f32x4 pv = ((const GAS f32x4*)(ka->in[I_P] + ((size_t)L * T_TOK + row) * PLE))[F.lane];
            v2u w; w.x = pk2(pv[0], pv[1]); w.y = pk2(pv[2], pv[3]); ((GAS v2u*)(F.ws + (DRY ? WS_NEED : F_PB) + row * PLE * 2))[F.lane] = w;
        }
        if (!LN2 && ODD) {
            float lg[8];
#pragma unroll
            for (int e = 0; e < 8; ++e) lg[e] = 0.f;
#pragma unroll
            for (int j = 0; j < 4; ++j)
#pragma unroll
                for (int q = 0; q < 4; ++q) { const int c = 4 * F.lane + 256 * j + q; const f32x4 ra = *(const LAS f32x4*)(RT + c * 8), rc = *(const LAS f32x4*)(RT + c * 8 + 4); const float xv = v[j][q];
                    lg[0] += xv * ra[0]; lg[1] += xv * ra[1]; lg[2] += xv * ra[2]; lg[3] += xv * ra[3]; lg[4] += xv * rc[0]; lg[5] += xv * rc[1]; lg[6] += xv * rc[2]; lg[7] += xv * rc[3]; }
#pragma unroll
            for (int e = 0; e < 8; ++e) lg[e] = wave_sum(lg[e], F.lane) + rb[e];
            int e1 = 0; float v1 = lg[0];
#pragma unroll
            for (int e = 1; e < 8; ++e) if (lg[e] > v1) { v1 = lg[e]; e1 = e; }
            int e2 = -1; float v2 = 0.f;
#pragma unroll
            for (int e = 0; e < 8; ++e) if (e != e1 && (e2 < 0 || lg[e] > v2)) { v2 = lg[e]; e2 = e; }
            const float ex = __expf(v2 - v1), g1 = 1.f / (1.f + ex), g2 = ex * g1;
            if (F.lane == 0) { const unsigned lp1 = __hip_atomic_fetch_add((LAS unsigned*)lcnt + e1, 1u, __ATOMIC_RELAXED, __HIP_MEMORY_SCOPE_WORKGROUP), lp2 = __hip_atomic_fetch_add((LAS unsigned*)lcnt + e2, 1u, __ATOMIC_RELAXED, __HIP_MEMORY_SCOPE_WORKGROUP);
                TE[rl * 4 + 0] = (unsigned)e1 | ((unsigned)e2 << 8) | (lp1 << 16); TE[rl * 4 + 1] = lp2; TE[rl * 4 + 2] = __builtin_bit_cast(unsigned, g1); TE[rl * 4 + 3] = __builtin_bit_cast(unsigned, g2); }
        }
    }
    if (!LN2 && ODD) {
        __syncthreads();
        if (F.tid < 8) gbase[F.tid] = __hip_atomic_fetch_add(F.ctl + CW_CNT + jj * 1024 + 64 * F.tid, lcnt[F.tid], RLX_AGENT);
        __syncthreads();
        if (F.tid < 256) { const unsigned w0 = TE[F.tid * 4], lp2 = TE[F.tid * 4 + 1]; const unsigned e1 = w0 & 255u, e2 = (w0 >> 8) & 255u, lp1 = w0 >> 16;
            const unsigned p1 = gbase[e1] + lp1, p2 = gbase[e2] + lp2; const unsigned tok = (unsigned)F.bx * 256 + F.tid;
            GAS int* list = (GAS int*)(F.ws + WS_LIST); list[(size_t)e1 * T_TOK + p1] = (int)tok; list[(size_t)e2 * T_TOK + p2] = (int)tok;
            GAS v4u* ro = (GAS v4u*)(F.ws + WS_ROUTE) + (size_t)tok * 2; v4u a; a.x = e1; a.y = e2; a.z = p1; a.w = p2; ro[0] = a; v4u b; b.x = TE[F.tid * 4 + 2]; b.y = TE[F.tid * 4 + 3]; b.z = 0u; b.w = 0u; ro[1] = b; }
        __syncthreads();
    }
}
__device__ __forceinline__ int wave_scan_add(int x) {
    x += __builtin_amdgcn_update_dpp(0, x, 0x111, 0xf, 0xf, false);
    x += __builtin_amdgcn_update_dpp(0, x, 0x112, 0xf, 0xf, false);
    x += __builtin_amdgcn_update_dpp(0, x, 0x114, 0xf, 0xf, false);
    x += __builtin_amdgcn_update_dpp(0, x, 0x118, 0xf, 0xf, false);
    x += __builtin_amdgcn_update_dpp(0, x, 0x142, 0xa, 0xf, false);
    x += __builtin_amdgcn_update_dpp(0, x, 0x143, 0xc, 0xf, false);
    return x;
}
template <int NJ>
__device__ __forceinline__ unsigned select_topk_n(LAS const float* sc, int n_adm, GAS unsigned short* gout, LAS unsigned short* out, int lane, unsigned guess) {
    const int nj = n_adm >> 6;
    unsigned u[NJ];
#pragma unroll
    for (int j = 0; j < NJ; ++j) { unsigned b = 0u;
        if (j < NJ - 8 || j < nj) { b = __builtin_bit_cast(unsigned, sc[64 * j + lane]); b = (b == 0x80000000u) ? 0u : b; b = (b & 0x80000000u) ? ~b : (b | 0x80000000u); }
        u[j] = b; }
#define SEL_COUNT(c_, dst_) do { int cl_ = 0; _Pragma("unroll") for (int j = 0; j < NJ; ++j) cl_ += (u[j] >= (c_)) ? 1 : 0; dst_ = __builtin_amdgcn_readlane(wave_scan_add(cl_), 63); } while (0)
    unsigned lo = 0u, hi = 0xFFFFFFFFu, ex = 0u; bool exact = false; int c;
    if (guess != 0u) {
        SEL_COUNT(guess, c);
        if (c == 256) { exact = true; ex = guess; }
        else if (c > 256) { lo = guess; unsigned d = 1u << 17;
            for (int e = 0; e < 7 && !exact; ++e) { const unsigned h = lo + d; if (h < lo) break; SEL_COUNT(h, c);
                if (c == 256) { exact = true; ex = h; } else if (c < 256) { hi = h; break; } else { lo = h; d <<= 2; } } }
        else { hi = guess; unsigned d = 1u << 17;
            for (int e = 0; e < 7 && !exact; ++e) { if (d >= hi) break; const unsigned l = hi - d; SEL_COUNT(l, c);
                if (c == 256) { exact = true; ex = l; } else if (c > 256) { lo = l; break; } else { hi = l; d <<= 2; } } }
    }
    while (!exact && hi - lo > 1u) { const unsigned mid = lo + ((hi - lo) >> 1); SEL_COUNT(mid, c);
        if (c == 256) { exact = true; ex = mid; } else if (c > 256) lo = mid; else hi = mid; }
#undef SEL_COUNT
    const unsigned thr = exact ? ex - 1u : lo;
    int nl = 0;
#pragma unroll
    for (int j = 0; j < NJ; ++j) nl += (u[j] > thr) ? 1 : 0;
    const int incl = wave_scan_add(nl); const int ngt = __builtin_amdgcn_readlane(incl, 63);
    int pos = incl - nl;
#pragma unroll
    for (int j = 0; j < NJ; ++j) if (u[j] > thr) { out[pos] = (unsigned short)(64 * j + lane); ++pos; }
    const int quota = 256 - ngt;
    if (quota > 0) {
        int tbase = 0; const unsigned long long lt = (1ull << lane) - 1ull;
#pragma unroll
        for (int j = 0; j < NJ; ++j) {
            const bool eq = u[j] == thr; const unsigned long long meq = __ballot(eq); const int rk = tbase + __popcll(meq & lt);
            if (eq && rk < quota) out[ngt + rk] = (unsigned short)(64 * j + lane);
            tbase += __popcll(meq);
        }
    }
    asm volatile("s_waitcnt lgkmcnt(0)" ::: "memory");
    if (lane < 32) *(GAS v4u*)(gout + 8 * lane) = *(const LAS v4u*)(out + 8 * lane);
    asm volatile("s_waitcnt lgkmcnt(0)" ::: "memory");
    return thr;
}
__device__ __forceinline__ unsigned select_topk(LAS const float* sc, int n_adm, GAS unsigned short* out, LAS unsigned short* orow, int lane, unsigned guess) {
    if (n_adm <= 256) {
#pragma unroll
        for (int j = 0; j < 4; ++j) { const int p = lane + 64 * j; out[p] = (unsigned short)(p < n_adm ? p : 0); }
        return 0u;
    }
    if (n_adm <= 512) return select_topk_n<8>(sc, n_adm, out, orow, lane, guess);
    else if (n_adm <= 1024) return select_topk_n<16>(sc, n_adm, out, orow, lane, guess);
    else if (n_adm <= 1536) return select_topk_n<24>(sc, n_adm, out, orow, lane, guess);
    return select_topk_n<32>(sc, n_adm, out, orow, lane, guess);
}
template <int MODE = 0>
__device__ __forceinline__ void indexer_phase(const Frame& F0) {
    Frame F = launder(F0);
    LAS float* sc = (LAS float*)(F.lds + RING_OFF);
    const bf16* QI = (const bf16*)(F.ws + Z_QI); const bf16* SM = (const bf16*)(F.ws + Z_SM);
    GAS unsigned short* IDX = (GAS unsigned short*)(F.ws + WS_IDX);
    const int lane = F.lane, h = lane >> 5, r = lane & 31;
    const int rq = 2 * ((r >> 2) & 1) + ((r >> 4) & 1), rh = (r & 3) + 4 * ((r >> 3) & 1);
    const int vcu = (F.bx & 7) * (F.G >> 3) + (F.bx >> 3);
    unsigned guess[2] = {0u, 0u};
    bf16x8 A[4][4]; v4u wq[4][2];
#define IDX_TILE(pi_, b_, tq_) const int pid_ = vcu * 8 + ((pi_) >> 1), b_ = pid_ >> 6, jp_ = pid_ & 63, tq_ = 16 * (((pi_) & 1) ? 127 - jp_ : jp_)
#define IDX_LOAD_A(t0_) do { _Pragma("unroll") for (int mt = 0; mt < 4; ++mt) { \
        _Pragma("unroll") for (int s = 0; s < 4; ++s) A[mt][s] = *(const GAS bf16x8*)(QI + (size_t)((t0_) + 4 * mt + rq) * 512 + rh * 64 + 16 * s + 8 * h); \
        _Pragma("unroll") for (int qq = 0; qq < 2; ++qq) wq[mt][qq] = *(const GAS v4u*)(SM + (size_t)((t0_) + 4 * mt + 2 * h + qq) * 256 + 192); } } while (0)
    for (int pi = 0; pi < 16; ++pi) {
        IDX_TILE(pi, b, tq);
        const int t0 = b * SEQ + tq;
        const int n_adm = ((tq >> 6) + 1) * 64, nkb = n_adm >> 5;
        if (n_adm > 256 && MODE != 2) {
            IDX_LOAD_A(t0);
            bf16x8 B[4], Bn[4];
#pragma unroll
            for (int s = 0; s < 4; ++s) Bn[s] = *(const GAS bf16x8*)(SM + (size_t)(b * SEQ + 32 * F.wave + r) * 256 + 128 + 16 * s + 8 * h);
            for (int kb = F.wave; kb < nkb; kb += 8) {
                const int key = 32 * kb + r;
                const int keyn = (kb + 8 < nkb) ? key + 256 : key;
#pragma unroll
                for (int s = 0; s < 4; ++s) B[s] = Bn[s];
#pragma unroll
                for (int s = 0; s < 4; ++s) Bn[s] = *(const GAS bf16x8*)(SM + (size_t)(b * SEQ + keyn) * 256 + 128 + 16 * s + 8 * h);
#pragma unroll
                for (int mt = 0; mt < 4; ++mt) {
                    f32x16 acc;
#pragma unroll
                    for (int i = 0; i < 16; ++i) acc[i] = 0.f;
#pragma unroll
                    for (int s = 0; s < 4; ++s) acc = __builtin_amdgcn_mfma_f32_32x32x16_bf16(A[mt][s], B[s], acc, 0, 0, 0);
                    float sA = 0.f, sB = 0.f;
#pragma unroll
                    for (int i = 0; i < 8; ++i) { const unsigned wa = wq[mt][0][i >> 1], wb = wq[mt][1][i >> 1];
                        const float fa = (i & 1) ? bf_hi(wa) : bf_lo(wa), fb = (i & 1) ? bf_hi(wb) : bf_lo(wb);
                        sA += fmaxf(acc[i], 0.f) * fa; sB += fmaxf(acc[8 + i], 0.f) * fb; }
                    sc[(4 * mt + 2 * h) * 2048 + key] = sA; sc[(4 * mt + 2 * h + 1) * 2048 + key] = sB;
                }
            }
        }
        __syncthreads();
#pragma unroll 1
        for (int qq = 0; qq < 2 && MODE != 1; ++qq) { const int q = 2 * F.wave + qq; const unsigned g_ = (pi & 1) ? guess[1] : guess[0];
            const unsigned t_ = select_topk(sc + q * 2048, n_adm, IDX + (size_t)(t0 + q) * 256, (LAS unsigned short*)(F.lds + LDSCTL_OFF + 1024 + F.wave * 512), lane, g_); if (pi & 1) guess[1] = t_; else guess[0] = t_; }
        __syncthreads();
    }
#undef IDX_TILE
#undef IDX_LOAD_A
}

__device__ __forceinline__ unsigned vst_off(unsigned r, unsigned ch) { return r * 128u + 16u * (ch ^ ((((r >> 1) ^ (r >> 4)) & 1u) << 1) ^ (((r >> 3) & 1u) << 2)); }
__device__ __forceinline__ int t5_bucket_dev(int rel) {
    const int n = rel < 0 ? -rel : rel;
    int v = n;
    if (n >= 8) v = 8 + (n >= 12) + (n >= 16) + (n >= 23) + (n >= 32) + (n >= 46) + (n >= 64) + (n >= 91);
    return v + (rel > 0 ? 16 : 0);
}
#ifndef ATT_REPS
#define ATT_REPS 1
#endif
#ifndef ATT_FIXKEYS
#define ATT_FIXKEYS 0
#endif
template <int FIX = 0>
__device__ __forceinline__ void attention_phase(const Frame& F0) {
#pragma unroll 1
    for (int rep = 0; rep < ATT_REPS; ++rep) {
    Frame F = launder(F0);
    const GAS unsigned char* Q8 = (const GAS unsigned char*)(F.ws + Z_Q8); const GAS unsigned char* KV8 = (const GAS unsigned char*)(F.ws + Z_KV8); bf16* OB = (bf16*)(F.ws + Z_XR);
    const GAS unsigned short* IDX = (const GAS unsigned short*)(F.ws + WS_IDX);
    const int lane = F.lane, g = lane >> 4, m = lane & 15;
    LAS unsigned char* vst = F.lds + RING_OFF + F.wave * 4096;
    const unsigned vbase = (unsigned)(size_t)vst;
    LAS unsigned char* BK = F.lds + RING_OFF + 32768; LAS unsigned char* OH = F.lds + RING_OFF + 32768 + 2176;
    for (int i = F.tid; i < 2112; i += 512) BK[i] = (unsigned char)t5_bucket_dev(i - 2047);
    if (F.tid < 128) { const int bkt = F.tid >> 2, gg = F.tid & 3, j = bkt - 8 * gg; v4u oh; oh.x = oh.y = oh.z = oh.w = 0u;
        if (j >= 0 && j < 8) { const unsigned val = (j & 1) ? 0x3F800000u : 0x3F80u; if ((j >> 1) == 0) oh.x = val; else if ((j >> 1) == 1) oh.y = val; else if ((j >> 1) == 2) oh.z = val; else oh.w = val; }
        *(LAS v4u*)(OH + F.tid * 16) = oh; }
    __syncthreads();
    bf16x8 bb;
    { const float* rbias = kargs()->in[I_RELB]; unsigned w[4];
#pragma unroll
      for (int j = 0; j < 4; ++j) w[j] = pk2(8.0f * rbias[(8 * g + 2 * j) * 16 + m], 8.0f * rbias[(8 * g + 2 * j + 1) * 16 + m]);
      v4u t; t.x = w[0]; t.y = w[1]; t.z = w[2]; t.w = w[3]; bb = __builtin_bit_cast(bf16x8, t); }
    unsigned tra[4][2];
    { const unsigned q = (lane & 15) >> 2, p = lane & 3;
#pragma unroll
      for (int c = 0; c < 4; ++c)
#pragma unroll
        for (int t = 0; t < 2; ++t) tra[c][t] = vst_off(8 * g + 4 * t + q, 2 * c + (p >> 1)) + 8 * (p & 1); }
    const int vcu = (F.bx & 7) * (F.G >> 3) + (F.bx >> 3);
    typedef long fp8x8;
    v4u ni0, ni1, nq; v4u ka[16]; unsigned koff[16];
#define ATT_KOFF(i0_, i1_) do { _Pragma("unroll") for (int k = 0; k < 4; ++k) { koff[2 * k] = ((i0_)[k] & 0xffffu) * 128u + 16u * g; koff[2 * k + 1] = ((i0_)[k] >> 16) * 128u + 16u * g; \
        koff[8 + 2 * k] = ((i1_)[k] & 0xffffu) * 128u + 16u * g; koff[8 + 2 * k + 1] = ((i1_)[k] >> 16) * 128u + 16u * g; } } while (0)
#ifdef ATT_NO_ASM
#define ATT_KLOAD(kvb_) do { const GAS unsigned char* kb_ = (kvb_); _Pragma("unroll") for (int T = 0; T < 16; ++T) ka[T] = *(const GAS v4u*)(kb_ + koff[T]); } while (0)
#define ATT_KWAIT(n_, T0_) do {} while (0)
#else
#define ATT_KLOAD(kvb_) do { const GAS unsigned char* kb_ = (kvb_); _Pragma("unroll") for (int T = 0; T < 16; ++T) { \
        asm volatile("global_load_dwordx4 %0, %1, %2" : "=&v"(ka[T]) : "v"(koff[T]), "s"(kb_) : "memory"); } } while (0)
#define ATT_KWAIT(n_, T0_) asm volatile("s_waitcnt vmcnt(" #n_ ")" : "+v"(ka[T0_]), "+v"(ka[T0_ + 1]), "+v"(ka[T0_ + 2]), "+v"(ka[T0_ + 3]), "+v"(ka[T0_ + 4]), "+v"(ka[T0_ + 5]), "+v"(ka[T0_ + 6]), "+v"(ka[T0_ + 7]) :: "memory")
#endif
    { const int tok0 = vcu * 256 + F.wave; const GAS v4u* ip = (const GAS v4u*)(IDX + (size_t)tok0 * 256 + 16 * m); ni0 = ip[0]; ni1 = ip[1];
      nq = *(const GAS v4u*)(Q8 + (size_t)tok0 * D + m * 64 + 16 * g);
      ATT_KOFF(ni0, ni1); ATT_KLOAD(KV8 + (size_t)(tok0 >> 11) * SEQ * 128); }
    for (int it = 0; it < 32; ++it) {
        const int tok = vcu * 256 + F.wave + 8 * it, b = tok >> 11, tq = tok & (SEQ - 1);
        const int n_valid = (((tq >> 6) + 1) * 64) < 256 ? ((tq >> 6) + 1) * 64 : 256;
        const v4u qv = nq;
        const fp8x8 qf0 = (fp8x8)(((unsigned long long)qv.y << 32) | qv.x), qf1 = (fp8x8)(((unsigned long long)qv.w << 32) | qv.z);
        const GAS unsigned char* kvb = KV8 + (size_t)b * SEQ * 128;
        f32x4 S[16];
#pragma unroll
        for (int T = 0; T < 16; ++T) {
            if (T == 0) ATT_KWAIT(8, 0);
            if (T == 8) ATT_KWAIT(0, 8);
            const unsigned bkt = BK[(koff[T] >> 7) + (2047 - tq)];
            const v4u oh = *(const LAS v4u*)(OH + bkt * 64 + g * 16);
            f32x4 ab = (f32x4){0.f, 0.f, 0.f, 0.f}, a = (f32x4){0.f, 0.f, 0.f, 0.f};
            ab = __builtin_amdgcn_mfma_f32_16x16x32_bf16(__builtin_bit_cast(bf16x8, oh), bb, ab, 0, 0, 0);
            a = __builtin_amdgcn_mfma_f32_16x16x32_fp8_fp8((fp8x8)(((unsigned long long)ka[T].y << 32) | ka[T].x), qf0, a, 0, 0, 0);
            a = __builtin_amdgcn_mfma_f32_16x16x32_fp8_fp8((fp8x8)(((unsigned long long)ka[T].w << 32) | ka[T].z), qf1, a, 0, 0, 0);
            a = a + ab;
            S[T] = a;
        }
        __builtin_amdgcn_sched_barrier(0);
        v4u vv[16];
#pragma unroll
        for (int T = 0; T < 16; ++T) vv[T] = *(const GAS v4u*)(kvb + koff[T] + 64);
        if (n_valid < 256) {
#pragma unroll
            for (int T = 0; T < 16; ++T)
#pragma unroll
                for (int i = 0; i < 4; ++i) if (16 * (4 * g + i) + T >= n_valid) S[T][i] = -1e30f;
        }
        float mx = -3.0e38f;
#pragma unroll
        for (int T = 0; T < 16; ++T) mx = fmaxf(fmaxf(fmaxf(S[T][0], S[T][1]), fmaxf(S[T][2], S[T][3])), mx);
        mx = fmaxf(mx, lane_xor(mx, 16, lane)); mx = fmaxf(mx, lane_xor(mx, 32, lane));
        constexpr float SC = 1.4426950408889634f * 0.125f;
        const float mneg = -mx * SC; float sum = 0.f;
#pragma unroll
        for (int T = 0; T < 16; ++T)
#pragma unroll
            for (int i = 0; i < 4; ++i) { const float p = __builtin_amdgcn_exp2f(S[T][i] * SC + mneg); S[T][i] = p; sum += p; }
        sum += lane_xor(sum, 16, lane); sum += lane_xor(sum, 32, lane);
        { const int tokn = vcu * 256 + F.wave + 8 * (it < 31 ? it + 1 : it); const GAS v4u* ip = (const GAS v4u*)(IDX + (size_t)tokn * 256 + 16 * m); ni0 = ip[0]; ni1 = ip[1];
          nq = *(const GAS v4u*)(Q8 + (size_t)tokn * D + m * 64 + 16 * g); }
        f32x4 O[4];
#pragma unroll
        for (int c = 0; c < 4; ++c) O[c] = (f32x4){0.f, 0.f, 0.f, 0.f};
#pragma unroll
        for (int ks = 0; ks < 8; ++ks) {
            const unsigned vb = vbase;
#pragma unroll
            for (int tt = 0; tt < 2; ++tt) { const v4u w8 = vv[2 * ks + tt]; v4u c0, c1;
#pragma unroll
                for (int q = 0; q < 4; ++q) { const int src = (int)w8[q];
                    const __attribute__((ext_vector_type(2))) float lo2 = __builtin_amdgcn_cvt_pk_f32_fp8(src, false), hi2 = __builtin_amdgcn_cvt_pk_f32_fp8(src, true);
                    const unsigned w0 = pk2(lo2.x, lo2.y), w1 = pk2(hi2.x, hi2.y);
                    if (q < 2) { c0[2 * q] = w0; c0[2 * q + 1] = w1; } else { c1[2 * (q - 2)] = w0; c1[2 * (q - 2) + 1] = w1; } }
                const unsigned rr = 8 * (m >> 2) + 4 * tt + (m & 3);
                *(LAS v4u*)(vst + vst_off(rr, 2 * g)) = c0; *(LAS v4u*)(vst + vst_off(rr, 2 * g + 1)) = c1; }
            v4u pw; pw.x = pk2(S[2 * ks][0], S[2 * ks][1]); pw.y = pk2(S[2 * ks][2], S[2 * ks][3]); pw.z = pk2(S[2 * ks + 1][0], S[2 * ks + 1][1]); pw.w = pk2(S[2 * ks + 1][2], S[2 * ks + 1][3]);
            const bf16x8 pf = __builtin_bit_cast(bf16x8, pw);
            v2u f[4][2];
            asm volatile("s_waitcnt lgkmcnt(0)\n\t"
                         "ds_read_b64_tr_b16 %0, %8\n\tds_read_b64_tr_b16 %1, %9\n\tds_read_b64_tr_b16 %2, %10\n\tds_read_b64_tr_b16 %3, %11\n\t"
                         "ds_read_b64_tr_b16 %4, %12\n\tds_read_b64_tr_b16 %5, %13\n\tds_read_b64_tr_b16 %6, %14\n\tds_read_b64_tr_b16 %7, %15\n\t"
                         "s_waitcnt lgkmcnt(0)"
                         : "=&v"(f[0][0]), "=&v"(f[0][1]), "=&v"(f[1][0]), "=&v"(f[1][1]), "=&v"(f[2][0]), "=&v"(f[2][1]), "=&v"(f[3][0]), "=&v"(f[3][1])
                         : "v"(vb + tra[0][0]), "v"(vb + tra[0][1]), "v"(vb + tra[1][0]), "v"(vb + tra[1][1]), "v"(vb + tra[2][0]), "v"(vb + tra[2][1]), "v"(vb + tra[3][0]), "v"(vb + tra[3][1])
                         : "memory");
#pragma unroll
            for (int c = 0; c < 4; ++c) { v4u t; t.x = f[c][0].x; t.y = f[c][0].y; t.z = f[c][1].x; t.w = f[c][1].y;
                O[c] = __builtin_amdgcn_mfma_f32_16x16x32_bf16(__builtin_bit_cast(bf16x8, t), pf, O[c], 0, 0, 0); }
        }
        const float inv = 1.0f / sum;
#pragma unroll
        for (int c = 0; c < 4; ++c) { v2u w; w.x = pk2(O[c][0] * inv, O[c][1] * inv); w.y = pk2(O[c][2] * inv, O[c][3] * inv);
            *(GAS v2u*)(OB + (size_t)tok * D + m * 64 + 16 * c + 4 * g) = w; }
        { const int tokn = vcu * 256 + F.wave + 8 * (it < 31 ? it + 1 : it); ATT_KOFF(ni0, ni1); ATT_KLOAD(KV8 + (size_t)(tokn >> 11) * SEQ * 128); }
    }
    asm volatile("s_waitcnt vmcnt(0)" ::: "memory");
#undef ATT_KOFF
#undef ATT_KLOAD
#undef ATT_KWAIT
    }
}
constexpr int XCS = 136;
constexpr int HHS = 132;
__device__ __forceinline__ float gelu_tanh(float x) {
    const float z = 0.7978845608028654f * (x + 0.044715f * x * x * x);
    const float e = __builtin_amdgcn_exp2f(2.885390081777927f * z);
    const float th = 1.0f - 2.0f * __builtin_amdgcn_rcpf(e + 1.0f);
    return 0.5f * x * (1.0f + th);
}
template <bool DRY = false>
__device__ __forceinline__ void lru_phase(const Frame& F0, int L) {
    Frame F = launder(F0);
    const KArgs ka = kargs();
    const int b = F.bx >> 3, nb = F.bx & 7;
    const bf16* XR = (const bf16*)(F.ws + Z_XR); bf16* YR = (bf16*)(F.ws + Z_YR);
    const bf16* WL = (const bf16*)(F.ws + WS_W + W_LRU);
    LAS bf16* XC = (LAS bf16*)(F.lds + RING_OFF);
    LAS float* HH = (LAS float*)(F.lds + RING_OFF + 2 * 64 * XCS * 2);
    const int tid = F.tid, lane = F.lane, w = F.wave, g = lane >> 4, m = lane & 15;
    const int cc = tid & 15, tp = tid >> 4;
    const int ch0 = nb * 128 + 8 * cc;
    float cw[4][8], cbias[8];
#pragma unroll
    for (int j = 0; j < 4; ++j)
#pragma unroll
        for (int k = 0; k < 8; ++k) cw[j][k] = ka->in[I_CONVW][(size_t)L * 4 * D + j * D + ch0 + k];
#pragma unroll
    for (int k = 0; k < 8; ++k) cbias[k] = ka->in[I_CONVB][(size_t)L * D + ch0 + k];
    bf16x8 Br[4], Bi[4];
#pragma unroll
    for (int s = 0; s < 4; ++s) { Br[s] = *(const GAS bf16x8*)(WL + ((size_t)nb * 128 + 16 * w + m) * 128 + 32 * s + 8 * g);
                                  Bi[s] = *(const GAS bf16x8*)(WL + (size_t)8 * 128 * 128 + ((size_t)nb * 128 + 16 * w + m) * 128 + 32 * s + 8 * g); }
    const int chl = 16 * w + m, chg = nb * 128 + chl;
    const float ba = ka->in[I_LRUBA][(size_t)L * D + chg], bx = ka->in[I_LRUBX][(size_t)L * D + chg];
    const float lam = ka->in[I_LAM][(size_t)L * D + chg];
    const float sp8 = -8.0f * (fmaxf(-lam, 0.f) + log1pf(__expf(-fabsf(lam))));
    float carry = 0.f;
    const size_t rowb = (size_t)b * SEQ;
    v4u nxin[5], nyin[2];
#pragma unroll
    for (int k = 0; k < 5; ++k) { const int t = 2 * tp - 3 + k; v4u z; z.x = z.y = z.z = z.w = 0u; nxin[k] = (t >= 0) ? *(const GAS v4u*)(XR + (rowb + t) * D + ch0) : z; }
#pragma unroll
    for (int k = 0; k < 2; ++k) nyin[k] = *(const GAS v4u*)(YR + (rowb + 2 * tp + k) * D + ch0);
    for (int tile = 0; tile < 32; ++tile) {
        const int t0 = tile * 64, buf = tile & 1;
        LAS bf16* xc = XC + buf * 64 * XCS; LAS float* hh = HH + buf * 64 * HHS;
        v4u xin[5], yin[2];
#pragma unroll
        for (int k = 0; k < 5; ++k) xin[k] = nxin[k];
#pragma unroll
        for (int k = 0; k < 2; ++k) yin[k] = nyin[k];
        if (tile < 31) {
#pragma unroll
            for (int k = 0; k < 5; ++k) nxin[k] = *(const GAS v4u*)(XR + (rowb + t0 + 64 + 2 * tp - 3 + k) * D + ch0);
#pragma unroll
            for (int k = 0; k < 2; ++k) nyin[k] = *(const GAS v4u*)(YR + (rowb + t0 + 64 + 2 * tp + k) * D + ch0);
        }
#pragma unroll
        for (int k = 0; k < 2; ++k) { float o[8];
#pragma unroll
            for (int c = 0; c < 8; ++c) { float a = cbias[c];
#pragma unroll
                for (int j = 0; j < 4; ++j) { const unsigned wv = xin[k + j][c >> 1]; a += ((c & 1) ? bf_hi(wv) : bf_lo(wv)) * cw[j][c]; }
                o[c] = a; }
            v4u pw; pw.x = pk2(o[0], o[1]); pw.y = pk2(o[2], o[3]); pw.z = pk2(o[4], o[5]); pw.w = pk2(o[6], o[7]);
            *(LAS v4u*)(xc + (2 * tp + k) * XCS + 8 * cc) = pw; }
        __syncthreads();
#pragma unroll
        for (int mt = 0; mt < 4; ++mt) {
            f32x4 ar = (f32x4){0.f, 0.f, 0.f, 0.f}, ai = (f32x4){0.f, 0.f, 0.f, 0.f};
#pragma unroll
            for (int s = 0; s < 4; ++s) { const bf16x8 A = *(const LAS bf16x8*)(xc + (16 * mt + m) * XCS + 32 * s + 8 * g);
                ar = __builtin_amdgcn_mfma_f32_16x16x32_bf16(A, Br[s], ar, 0, 0, 0); ai = __builtin_amdgcn_mfma_f32_16x16x32_bf16(A, Bi[s], ai, 0, 0, 0); }
            float P[4], W[4];
#pragma unroll
            for (int i = 0; i < 4; ++i) {
                const float rr = sigmoidf_fast(ar[i] + ba), ig = sigmoidf_fast(ai[i] + bx);
                const float la = sp8 * rr;
                const float a = __builtin_amdgcn_exp2f(1.4426950408889634f * la);
                const float mult = __builtin_amdgcn_sqrtf(fmaxf(__builtin_fmaf(-a, a, 1.0f), 0.f));
                const float xv = __builtin_bit_cast(float, (unsigned)xc[(16 * mt + 4 * g + i) * XCS + chl] << 16);
                const float u = mult * (ig * xv);
                if (i == 0) { P[0] = a; W[0] = u; } else { P[i] = a * P[i - 1]; W[i] = a * W[i - 1] + u; }
            }
            float Ac = P[3], Uc = W[3];
            { const float A1 = lane_up(Ac, 16, lane), U1 = lane_up(Uc, 16, lane); if (g >= 1) { Uc = Ac * U1 + Uc; Ac = Ac * A1; } }
            { const float A2 = lane_up(Ac, 32, lane), U2 = lane_up(Uc, 32, lane); if (g >= 2) { Uc = Ac * U2 + Uc; Ac = Ac * A2; } }
            float Ae = lane_up(Ac, 16, lane), Ue = lane_up(Uc, 16, lane); if (g == 0) { Ae = 1.f; Ue = 0.f; }
            const float hin = Ae * carry + Ue;
            const float cnew = Ac * carry + Uc;
            carry = lane_get(cnew, 48 + m);
#pragma unroll
            for (int i = 0; i < 4; ++i) hh[(16 * mt + 4 * g + i) * HHS + chl] = P[i] * hin + W[i];
        }
        __syncthreads();
#pragma unroll
        for (int k = 0; k < 2; ++k) { const f32x4 h0 = *(const LAS f32x4*)(hh + (2 * tp + k) * HHS + 8 * cc), h1 = *(const LAS f32x4*)(hh + (2 * tp + k) * HHS + 8 * cc + 4);
            float o[8];
#pragma unroll
            for (int c = 0; c < 8; ++c) { const unsigned wv = yin[k][c >> 1]; const float y = (c & 1) ? bf_hi(wv) : bf_lo(wv); o[c] = (c < 4 ? h0[c] : h1[c - 4]) * gelu_tanh(y); }
            v4u pw; pw.x = pk2(o[0], o[1]); pw.y = pk2(o[2], o[3]); pw.z = pk2(o[4], o[5]); pw.w = pk2(o[6], o[7]);
            *(GAS v4u*)((DRY ? (bf16*)(F.ws + WS_NEED) : YR) + (rowb + t0 + 2 * tp + k) * D + ch0) = pw; }
    }
    __syncthreads();
}

struct MoeOrder : pg8::StaticOrder {
    const volatile LAS unsigned* tb; int tile0; const int* list; size_t bstride;
    __device__ __forceinline__ int expert_of(int gt) const { int e = 0;
#pragma unroll
        for (int k = 1; k < 8; ++k) e += (gt >= (int)tb[k]) ? 1 : 0;
        return e; }
    __device__ __forceinline__ const char* b_base(const pg8::Gemm& g, const pg8::Unit& u, size_t tstep) const { return (const char*)g.Bt + (size_t)expert_of(tile0 + u.pm) * bstride + (size_t)u.pn * tstep; }
};
struct MoeGatherOrder : MoeOrder {
    static constexpr bool GATHER = true;
    __device__ __forceinline__ const char* a_base(const pg8::Gemm& g, const pg8::Unit&, size_t) const { return (const char*)g.A; }
    __device__ __forceinline__ void a_rows(const pg8::Unit& u, int R0, int R1, int C0, int C1, int K, unsigned (&off)[2][2]) const {
        const int gt = tile0 + u.pm, e = expert_of(gt), j = gt - (int)tb[e], n = (int)tb[16 + e];
        const GAS int* le = (const GAS int*)list + (size_t)e * T_TOK;
#pragma unroll
        for (int h = 0; h < 2; ++h) { int p0 = 256 * j + 128 * h + R0, p1 = 256 * j + 128 * h + R1; p0 = p0 < n ? p0 : n - 1; p1 = p1 < n ? p1 : n - 1;
            off[h][0] = ((unsigned)le[p0] * (unsigned)K + (unsigned)C0) * 2u; off[h][1] = ((unsigned)le[p1] * (unsigned)K + (unsigned)C1) * 2u; }
    }
};
#ifdef SELFCHECK
#ifndef SC_TOL
#define SC_TOL 0.03f
#define SC_ABS 1e-5f
#endif
__device__ __forceinline__ float sc_bf(const bf16* p, size_t i) { return __builtin_bit_cast(float, (unsigned)((const GAS bf16*)p)[i] << 16); }
__device__ __forceinline__ float sc_f8(const unsigned char* p, size_t i) {
    const unsigned v = ((const GAS unsigned char*)p)[i]; const unsigned e = (v >> 3) & 15u, mn = v & 7u; float r;
    if (e == 0u) r = (float)mn * 0.001953125f; else r = (1.0f + (float)mn * 0.125f) * exp2f((float)e - 7.0f);
    return (v & 128u) ? -r : r; }
__device__ __forceinline__ void sc_fail(const Frame& F, unsigned code) { __hip_atomic_fetch_or(F.ctl + CW_CODE, code, RLX_AGENT); }
__device__ __forceinline__ int sc_bucket_ref(int rel) {
    const int half = 16, max_exact = 8; const int ret = rel > 0 ? half : 0; const int n = rel < 0 ? -rel : rel;
    const float nf = (float)(n > 1 ? n : 1);
    int large = max_exact + (int)(logf(nf / (float)max_exact) / logf(16.0f) * (float)(half - max_exact));
    large = large < half - 1 ? large : half - 1;
    return ret + (n < max_exact ? n : large);
}
__device__ __forceinline__ void selfcheck_topk(const Frame& F0) {
    Frame F = launder(F0);
    if (F.wave != 0) return;
    const bf16* QI = (const bf16*)(F.ws + Z_QI); const bf16* SM = (const bf16*)(F.ws + Z_SM);
    const GAS unsigned short* IDX = (const GAS unsigned short*)(F.ws + WS_IDX);
    LAS float* sc = (LAS float*)(F.lds + RING_OFF);
    LAS unsigned* bm = (LAS unsigned*)(F.lds + RING_OFF + 8192);
    const int tok = F.bx * 256 + ((F.bx * 37) & 255), b = tok >> 11, tq = tok & (SEQ - 1), n_adm = ((tq >> 6) + 1) * 64;
    const int lane = F.lane;
    bm[lane] = 0u;
    for (int s = lane; s < n_adm; s += 64) { float score = 0.f;
        for (int h = 0; h < 8; ++h) { float d = 0.f;
            for (int k = 0; k < 64; ++k) d += sc_bf(QI, (size_t)tok * 512 + h * 64 + k) * sc_bf(SM, (size_t)(b * SEQ + s) * 256 + 128 + k);
            score += fmaxf(d, 0.f) * sc_bf(SM, (size_t)tok * 256 + 192 + h); }
        sc[s] = score; }
    asm volatile("s_waitcnt lgkmcnt(0)" ::: "memory");
    const int nsel = n_adm < 256 ? n_adm : 256;
    float msel = 3.0e38f; bool bad = false;
    for (int p = lane; p < nsel; p += 64) { const int key = IDX[(size_t)tok * 256 + p]; if (key >= n_adm) { bad = true; continue; }
        const unsigned old = __hip_atomic_fetch_or(bm + (key >> 5), 1u << (key & 31), __ATOMIC_RELAXED, __HIP_MEMORY_SCOPE_WORKGROUP); if (old & (1u << (key & 31))) bad = true;
        msel = fminf(msel, sc[key]); }
    asm volatile("s_waitcnt lgkmcnt(0)" ::: "memory");
    float muns = -3.0e38f, amax = 0.f;
    for (int s = lane; s < n_adm; s += 64) { amax = fmaxf(amax, fabsf(sc[s])); if (!((bm[s >> 5] >> (s & 31)) & 1u)) muns = fmaxf(muns, sc[s]); }
#pragma unroll
    for (int o = 1; o < 64; o <<= 1) { msel = fminf(msel, lane_xor(msel, o, lane)); muns = fmaxf(muns, lane_xor(muns, o, lane)); amax = fmaxf(amax, lane_xor(amax, o, lane)); }
    if (muns > msel + 1e-4f * amax) bad = true;
    if (__any(bad)) { if (lane == 0) sc_fail(F, 1u); }
}
__device__ __forceinline__ void selfcheck_attn(const Frame& F0) {
    Frame F = launder(F0);
    if (F.wave != 0) return;
    const KArgs ka = kargs();
    const unsigned char* Q8 = F.ws + Z_Q8; const unsigned char* KV8 = F.ws + Z_KV8; const bf16* OB = (const bf16*)(F.ws + Z_XR);
    const GAS unsigned short* IDX = (const GAS unsigned short*)(F.ws + WS_IDX);
    LAS float* lg = (LAS float*)(F.lds + RING_OFF + 65536);
    const int tok = F.bx * 256 + ((F.bx * 37) & 255), b = tok >> 11, tq = tok & (SEQ - 1), n_adm = ((tq >> 6) + 1) * 64, nv = n_adm < 256 ? n_adm : 256;
    const int lane = F.lane;
    for (int p = lane; p < 256; p += 64) { const int key = IDX[(size_t)tok * 256 + p]; const int bk = sc_bucket_ref(key - tq);
        for (int h = 0; h < 16; ++h) { float d = 0.f;
            for (int k = 0; k < 64; ++k) d += sc_f8(Q8, (size_t)tok * D + h * 64 + k) * sc_f8(KV8, (size_t)(b * SEQ + key) * 128 + k);
            lg[h * 256 + p] = p < nv ? 0.125f * d + ((const GAS float*)ka->in[I_RELB])[bk * 16 + h] : -1e30f; } }
    asm volatile("s_waitcnt lgkmcnt(0)" ::: "memory");
    if (lane < 16) { float mx = -3.0e38f; for (int p = 0; p < 256; ++p) mx = fmaxf(mx, lg[lane * 256 + p]); float sum = 0.f;
        for (int p = 0; p < 256; ++p) { const float e = __expf(lg[lane * 256 + p] - mx); lg[lane * 256 + p] = e; sum += e; }
        const float inv = 1.f / sum; for (int p = 0; p < 256; ++p) lg[lane * 256 + p] *= inv; }
    asm volatile("s_waitcnt lgkmcnt(0)" ::: "memory");
    float emax = 0.f, omax = 0.f;
    for (int o = lane; o < 1024; o += 64) { const int h = o >> 6, d = o & 63; float acc = 0.f;
        for (int p = 0; p < 256; ++p) { const int key = IDX[(size_t)tok * 256 + p]; acc += lg[h * 256 + p] * sc_f8(KV8, (size_t)(b * SEQ + key) * 128 + 64 + d); }
        const float got = sc_bf(OB, (size_t)tok * D + o); emax = fmaxf(emax, fabsf(got - acc)); omax = fmaxf(omax, fabsf(acc)); }
#pragma unroll
    for (int o = 1; o < 64; o <<= 1) { emax = fmaxf(emax, lane_xor(emax, o, lane)); omax = fmaxf(omax, lane_xor(omax, o, lane)); }
    if (!(emax <= SC_TOL * omax + SC_ABS)) { if (lane == 0) sc_fail(F, 2u); }
}
__device__ __forceinline__ void selfcheck_lru(const Frame& F0, int L, bool after) {
    Frame F = launder(F0);
    if (F.wave != 0) return;
    const KArgs ka = kargs();
    const bf16* XR = (const bf16*)(F.ws + Z_XR); const bf16* YR = (const bf16*)(F.ws + Z_YR);
    GAS float* EXP = (GAS float*)(F.ws + WS_NEED) + (size_t)F.bx * SEQ;
    const int b = F.bx >> 3, ch = ((F.bx & 7) * 128 + ((F.bx * 29) & 127)), nb = ch >> 7, lane = F.lane;
    if (after) { float emax = 0.f, omax = 0.f;
        for (int t = lane; t < SEQ; t += 64) { const float e = EXP[t], g = sc_bf(YR, (size_t)(b * SEQ + t) * D + ch); emax = fmaxf(emax, fabsf(e - g)); omax = fmaxf(omax, fabsf(e)); }
#pragma unroll
        for (int o = 1; o < 64; o <<= 1) { emax = fmaxf(emax, lane_xor(emax, o, lane)); omax = fmaxf(omax, lane_xor(omax, o, lane)); }
        if (!(emax <= SC_TOL * omax + SC_ABS)) { if (lane == 0) sc_fail(F, 4u); }
        return; }
    const float* cw = ka->in[I_CONVW] + (size_t)L * 4 * D; const float* cb = ka->in[I_CONVB] + (size_t)L * D;
    const float* wa = ka->in[I_LRUWA] + ((size_t)L * 8 + nb) * 128 * 128; const float* wx = ka->in[I_LRUWX] + ((size_t)L * 8 + nb) * 128 * 128;
    const float lam = ka->in[I_LAM][(size_t)L * D + ch], ba = ka->in[I_LRUBA][(size_t)L * D + ch], bx = ka->in[I_LRUBX][(size_t)L * D + ch];
    const float sp = fmaxf(-lam, 0.f) + log1pf(expf(-fabsf(lam)));
    const int dl = ch & 127;
    float h = 0.f;
    for (int t = 0; t < SEQ; ++t) {
        float pr = 0.f, pi = 0.f, xcc = 0.f;
#pragma unroll
        for (int q = 0; q < 2; ++q) { const int cl = lane + 64 * q, cg = nb * 128 + cl; float xc = cb[cg];
            for (int j = 0; j < 4; ++j) { const int tt = t - 3 + j; if (tt >= 0) xc += sc_bf(XR, (size_t)(b * SEQ + tt) * D + cg) * cw[j * D + cg]; }
            pr += xc * wa[cl * 128 + dl]; pi += xc * wx[cl * 128 + dl]; if (cl == dl) xcc = xc; }
#pragma unroll
        for (int o = 1; o < 64; o <<= 1) { pr += lane_xor(pr, o, lane); pi += lane_xor(pi, o, lane); xcc += lane_xor(xcc, o, lane); }
        const float r = 1.f / (1.f + expf(-(pr + ba))), ig = 1.f / (1.f + expf(-(pi + bx)));
        const float la = -8.0f * r * sp, a = expf(la), u = sqrtf(-expm1f(2.0f * la)) * (ig * xcc);
        h = a * h + u;
        const float y = sc_bf(YR, (size_t)(b * SEQ + t) * D + ch);
        const float gl = 0.5f * y * (1.f + tanhf(0.7978845608028654f * (y + 0.044715f * y * y * y)));
        if (lane == 0) EXP[t] = h * gl;
    }
}
#endif
__global__ void __launch_bounds__(NWAVES * 64, 2) mk_fwd(Args args) {
    extern __shared__ __attribute__((aligned(16))) unsigned char lds[];
    Frame F;
    F.lds = (LAS unsigned char*)lds;
    F.MISC = (volatile LAS unsigned*)(F.lds + MISC_OFF);
    F.tid = threadIdx.x; F.lane = F.tid & 63; F.wave = __builtin_amdgcn_readfirstlane(F.tid >> 6);
    F.G = gridDim.x; F.bx = blockIdx.x;
    F.ws = args.ws; F.ctl = (gu32*)(args.ws + WS_CTL); F.out = args.out;
    for (int u = threadIdx.x; u < (LDS_BYTES - LDSCTL_OFF) / 4; u += NWAVES * 64) ((LAS unsigned*)(F.lds + LDSCTL_OFF))[u] = 0u;
    __syncthreads();
    XcdBarrier bar = xcd_barrier_post((unsigned*)(F.ctl + CW_BAR), F.MISC + 8);
#ifdef PROBE_XCC
    if ((blockIdx.x & 7u) != (bar.x & 7u)) { const unsigned long long t0 = __builtin_amdgcn_s_memrealtime(); while (__builtin_amdgcn_s_memrealtime() - t0 < 200000ull) __builtin_amdgcn_s_sleep(8); }
#endif
#define GRID_BAR() do { XcdBarrier b_ = bar; unsigned* p_ = bar.bar; asm volatile("" : "+s"(p_)); b_.bar = p_; xcd_barrier(b_); } while (0)
    float* X32 = args.out;
#define LOCAL_HANDOFF() do { asm volatile("s_waitcnt vmcnt(0)" ::: "memory"); __syncthreads(); __builtin_amdgcn_fence(__ATOMIC_ACQUIRE, "agent"); asm volatile("s_waitcnt vmcnt(0)" ::: "memory"); __syncthreads(); } while (0)
    LAS unsigned char* ring = F.lds + RING_OFF;
    using pg8::Gemm; using pg8::StaticOrder;

    for (int L = 0; L < DEPTH; ++L) {
        const int odd = L & 1;
#ifndef SK_P0
        p0_convert(F, L);
#endif
#ifdef DUP_P0
        __syncthreads(); p0_convert(F, L);
#endif
        GRID_BAR();
        { const Frame P = launder(F); unsigned char* ws = P.ws; unsigned char* wb = ws + WS_W; bf16* XB = (bf16*)(ws + WS_XB); (void)XB; (void)wb;
          Gemm g{XB, (const bf16*)(wb + W_IN), T_TOK, NIN, D}; StaticOrder S; S.init(T_TOK, NIN, P.G, P.bx);
          pg8::EpiZ E{(bf16*)(ws + Z_Q), (bf16*)(ws + Z_QI), (bf16*)(ws + Z_SM), ws + Z_Q8, ws + Z_KV8};
#ifndef SK_G1
          pg8::gemm_phase<pg8::EpiZ, StaticOrder>(ring, g, S, E, P.wave);
#endif
#ifdef DUP_G1
          pg8::gemm_phase<pg8::EpiZ, StaticOrder>(ring, g, S, E, P.wave);
#endif
        }
        GRID_BAR();
#if defined(SELFCHECK) && SELFCHECK == 3
        if (L == 0) { selfcheck_lru(F, L, false); __syncthreads(); }
#endif
#ifdef DUP_IDX
        indexer_phase<DUP_IDX>(F);
#endif
#ifndef SK_IDX
        indexer_phase(F);
#endif
#ifdef DUP_LRU
        lru_phase<true>(F, L);
#endif
#ifndef SK_LRU
        lru_phase(F, L);
#endif
        GRID_BAR();
#if defined(SELFCHECK) && SELFCHECK == 1
        if (L == 0) { selfcheck_topk(F); __syncthreads(); }
#endif
#if defined(SELFCHECK) && SELFCHECK == 3
        if (L == 0) { selfcheck_lru(F, L, true); __syncthreads(); }
#endif
#ifdef DUP_ATT
        attention_phase<DUP_ATT>(F); __syncthreads();
#endif
#ifndef SK_ATT
        attention_phase(F);
#endif
        GRID_BAR();
#if defined(SELFCHECK) && SELFCHECK == 2
        if (L == 0) { selfcheck_attn(F); __syncthreads(); }
#endif
        { const Frame P = launder(F); unsigned char* ws = P.ws; unsigned char* wb = ws + WS_W; bf16* XB = (bf16*)(ws + WS_XB); (void)XB; (void)wb;
          Gemm g{(const bf16*)(ws + Z_XR), (const bf16*)(wb + W_BRA), T_TOK, D, D}; StaticOrder S; S.init(T_TOK, D, F.G, F.bx);
          pg8::EpiGate<0> E{(bf16*)(ws + Z_GA), nullptr};
#ifndef SK_G2
          pg8::gemm_phase<pg8::EpiGate<0>, StaticOrder>(ring, g, S, E, P.wave);
#endif
        }
        LOCAL_HANDOFF();
        { const Frame P = launder(F); unsigned char* ws = P.ws; unsigned char* wb = ws + WS_W; bf16* XB = (bf16*)(ws + WS_XB); (void)XB; (void)wb;
          Gemm g{(const bf16*)(ws + Z_YR), (const bf16*)(wb + W_BRR), T_TOK, D, D}; StaticOrder S; S.init(T_TOK, D, F.G, F.bx);
          pg8::EpiGate<1> E{(bf16*)(ws + Z_GA), (const bf16*)(ws + Z_GR)};
#ifndef SK_G3
          pg8::gemm_phase<pg8::EpiGate<1>, StaticOrder>(ring, g, S, E, P.wave);
#endif
        }
        GRID_BAR();
        { const Frame P = launder(F); unsigned char* ws = P.ws; unsigned char* wb = ws + WS_W; bf16* XB = (bf16*)(ws + WS_XB); (void)XB; (void)wb;
          Gemm g{(const bf16*)(ws + Z_GA), (const bf16*)(wb + W_O), T_TOK, D, D}; StaticOrder S; S.init(T_TOK, D, F.G, F.bx);
          pg8::EpiBf16 E{(bf16*)(ws + Z_GR), D, 0};
#ifndef SK_G4
          pg8::gemm_phase<pg8::EpiBf16, StaticOrder>(ring, g, S, E, P.wave);
#endif
        }
        GRID_BAR();
#ifdef DUP_LN
        ln_phase<false, false, true>(F, L); ln_phase<false, false, true>(F, L);
#endif
#ifndef SK_LN
        if (odd) ln_phase<false, true>(F, L); else ln_phase<false, false>(F, L);
#endif
        GRID_BAR();
        if (odd) {
            if (launder(F).tid == 0) { unsigned acc = 0u; F.MISC[16] = 0u;
                for (int e = 0; e < 8; ++e) { const unsigned c = __hip_atomic_load(F.ctl + CW_CNT + (L >> 1) * 1024 + 64 * e, RLX_AGENT); F.MISC[32 + e] = c; acc += (c + 255u) >> 8; F.MISC[17 + e] = acc; } }
            __syncthreads();
        }
        { const Frame P = launder(F); unsigned char* ws = P.ws; unsigned char* wb = ws + WS_W; bf16* XB = (bf16*)(ws + WS_XB); (void)XB; (void)wb;
          Gemm g{(const bf16*)(ws + F_PB), (const bf16*)(wb + W_PP), T_TOK, D, PLE}; StaticOrder S; S.init(T_TOK, D, F.G, F.bx);
          pg8::EpiBf16 E{(bf16*)(ws + F_U), D, 0};
#ifndef SK_G5
          pg8::gemm_phase<pg8::EpiBf16, StaticOrder>(ring, g, S, E, P.wave);
#endif
        }
        LOCAL_HANDOFF();
        { const Frame P = launder(F); unsigned char* ws = P.ws; unsigned char* wb = ws + WS_W; bf16* XB = (bf16*)(ws + WS_XB); (void)XB; (void)wb;
          Gemm g{XB, (const bf16*)(wb + W_PG), T_TOK, D, D}; StaticOrder S; S.init(T_TOK, D, F.G, F.bx);
          pg8::EpiPle E{(bf16*)(ws + F_U)};
#ifndef SK_G6
          pg8::gemm_phase<pg8::EpiPle, StaticOrder>(ring, g, S, E, P.wave);
#endif
        }
        if (!odd) {
            { const Frame P = launder(F); unsigned char* ws = P.ws; unsigned char* wb = ws + WS_W; bf16* XB = (bf16*)(ws + WS_XB); (void)XB; (void)wb;
          Gemm g{XB, (const bf16*)(wb + W_FF), T_TOK, 2 * DFF, D}; StaticOrder S; S.init(T_TOK, 2 * DFF, F.G, F.bx);
              pg8::EpiSwiglu E{(bf16*)(ws + F_H), DFF};
#ifndef SK_G7
              pg8::gemm_phase<pg8::EpiSwiglu, StaticOrder>(ring, g, S, E, P.wave);
#endif
        }
            GRID_BAR();
            { const Frame P = launder(F); unsigned char* ws = P.ws; unsigned char* wb = ws + WS_W; bf16* XB = (bf16*)(ws + WS_XB); (void)XB; (void)wb;
          Gemm g{(const bf16*)(ws + F_H), (const bf16*)(wb + W_FF_DN_DENSE), T_TOK, D, DFF}; StaticOrder S; S.init(T_TOK, D, F.G, F.bx);
              pg8::EpiBf16 E{(bf16*)(ws + Z_GR), D, 0};
#ifndef SK_G8
              pg8::gemm_phase<pg8::EpiBf16, StaticOrder>(ring, g, S, E, P.wave);
#endif
        }
            GRID_BAR();
#ifndef SK_LN
            ln_phase<true, false>(F, L);
#endif
        } else {
            const int ntiles = (int)F.MISC[24];
            const int nchunks = (ntiles + MOE_CHUNK_TILES - 1) / MOE_CHUNK_TILES;
            for (int c = 0; c < nchunks; ++c) {
                const int tile0 = c * MOE_CHUNK_TILES, ntl = (ntiles - tile0) < MOE_CHUNK_TILES ? (ntiles - tile0) : MOE_CHUNK_TILES;
                const size_t hc_off = (c & 1) ? F_H1 : F_H;
                { const Frame P = launder(F); unsigned char* ws = P.ws; unsigned char* wb = ws + WS_W; bf16* XB = (bf16*)(ws + WS_XB); (void)XB; (void)wb;
          Gemm g{XB, (const bf16*)(wb + W_FF), ntl * 256, 2 * DFFE, D}; MoeGatherOrder S; S.init(ntl * 256, 2 * DFFE, F.G, F.bx);
                  S.tb = F.MISC + 16; S.tile0 = tile0; S.list = (const int*)(ws + WS_LIST); S.bstride = (size_t)2 * DFFE * D * 2;
                  pg8::EpiSwiglu E{(bf16*)(ws + hc_off), DFFE};
#ifndef SK_G9
                  pg8::gemm_phase<pg8::EpiSwiglu, MoeGatherOrder>(ring, g, S, E, P.wave);
#endif
        }
                GRID_BAR();
                { const Frame P = launder(F); unsigned char* ws = P.ws; unsigned char* wb = ws + WS_W; bf16* XB = (bf16*)(ws + WS_XB); (void)XB; (void)wb;
          Gemm g{(const bf16*)(ws + hc_off), (const bf16*)(wb + W_FF_DN_MOE), ntl * 256, D, DFFE}; MoeOrder S; S.init(ntl * 256, D, F.G, F.bx);
                  S.tb = F.MISC + 16; S.tile0 = tile0; S.list = nullptr; S.bstride = (size_t)D * DFFE * 2;
                  pg8::EpiBf16 E{(bf16*)(ws + F_YE), D, tile0 * 256};
#ifndef SK_G10
                  pg8::gemm_phase<pg8::EpiBf16, MoeOrder>(ring, g, S, E, P.wave);
#endif
        }
            }
            GRID_BAR();
#ifndef SK_LN
            ln_phase<true, true>(F, L);
#endif
        }
        GRID_BAR();
    }
    if (__hip_atomic_load(F.ctl + CW_BAR + XB_TMO, RLX_AGENT) != 0u || __hip_atomic_load(F.ctl + CW_CODE, RLX_AGENT) != 0u) {
        const float q = __builtin_nanf("");
        for (size_t i = (size_t)F.bx * 512 + launder(F).tid; i < (size_t)T_TOK * D; i += (size_t)F.G * 512) X32[i] = q;
    }
}

#if defined(SELFCHECK)
constexpr size_t WS_DRY_EXTRA = 4 * MiB;
#elif defined(DUP_LRU) || defined(DUP_LN)
constexpr size_t WS_DRY_EXTRA = 80 * MiB;
#else
constexpr size_t WS_DRY_EXTRA = 0;
#endif
extern "C" void kernel_launch(void* const* d_in, const int* in_sizes, int n_in, void* d_out, int out_size, void* d_ws, size_t ws_size, hipStream_t stream) {
    static int grid = 0;
    if (grid == 0) {
        if (n_in != 28 || out_size != T_TOK * D || ws_size < WS_NEED + WS_DRY_EXTRA) { fprintf(stderr, "kernel_launch: unexpected shapes: n_in %d out %d ws %zu (need %zu)\n", n_in, out_size, ws_size, (size_t)WS_END); grid = -1; return; }
        int dev = 0, cus = 0, per_cu = 0;
        if (hipGetDevice(&dev) != hipSuccess || hipDeviceGetAttribute(&cus, hipDeviceAttributeMultiprocessorCount, dev) != hipSuccess) { grid = -1; return; }
        if (hipFuncSetAttribute((const void*)mk_fwd, hipFuncAttributeMaxDynamicSharedMemorySize, LDS_BYTES) != hipSuccess) { fprintf(stderr, "kernel_launch: hipFuncSetAttribute failed\n"); grid = -1; return; }
        if (hipOccupancyMaxActiveBlocksPerMultiprocessor(&per_cu, (const void*)mk_fwd, NWAVES * 64, LDS_BYTES) != hipSuccess || per_cu < 1) { fprintf(stderr, "kernel_launch: occupancy query says %d blocks per CU\n", per_cu); }
        (void)hipGetLastError();
        grid = cus;
        if (grid != 256) { fprintf(stderr, "kernel_launch: this kernel needs a 256-CU device (got %d)\n", cus); grid = -1; return; }
    }
    if (grid < 0) return;
    if (hipMemsetAsync((char*)d_ws + WS_CTL, 0, CTL_ZERO_BYTES, stream) != hipSuccess) return;
    Args a{};
    for (int i = 0; i < 28; ++i) a.in[i] = (const float*)d_in[i];
    a.out = (float*)d_out; a.ws = (unsigned char*)d_ws;
    hipLaunchKernelGGL(mk_fwd, dim3(grid), dim3(NWAVES * 64), LDS_BYTES, stream, a);
}
```

```cpp
#include <hip/hip_runtime.h>
#include <cstdio>
#include <cstdint>

constexpr int T_TOK = 65536, D = 1024, SEQ = 2048, NBATCH = 32, DEPTH = 4;
constexpr int D_IN = 5832, NIN = 5888;
constexpr int DFF = 2816, DFFE = 3584, NEXP = 8, PLE = 256;
constexpr float LN_EPS = 1e-5f;
constexpr float DN_ALPHA = 1.681792830507429f;

namespace pg8 {
#define PG8_LAS __attribute__((address_space(3)))
typedef unsigned short bf16_t;
typedef short bf16x8 __attribute__((ext_vector_type(8)));
typedef float f32x4 __attribute__((ext_vector_type(4)));
typedef unsigned u32x4 __attribute__((ext_vector_type(4)));
typedef unsigned u32x2 __attribute__((ext_vector_type(2)));
constexpr int BM = 256, BK = 64, HALF = 128, HTB = HALF * BK * 2  , STAGE_BYTES = 8 * HTB, NXCD = 8, WGM = 8;

__host__ __device__ __forceinline__ int lds_byte(int r, int c) { const int st = (r >> 4) * 2 + (c >> 5), rr = r & 15, cc = c & 31, ob = rr * 64 + cc * 2; return st * 1024 + (ob ^ (((ob >> 9) & 1) << 5)); }
__host__ __device__ __forceinline__ void stage_rc(int b, int& R, int& C) { const int st = b / 1024, sb = b % 1024, swz = sb ^ (((sb >> 9) & 1) << 5); R = (st >> 1) * 16 + swz / 64; C = (st & 1) * 32 + (swz % 64) / 2; }
__host__ __device__ __forceinline__ int perm32(int rho) { const int n = rho >> 4, i = rho & 15; return 8 * (i >> 2) + 4 * n + (i & 3); }

struct Unit { int pm, pn; };
struct Gemm { const bf16_t* A; const bf16_t* Bt; int M, N, K; };

struct StaticOrder {
    static constexpr bool GATHER = false;
    int nM, nN, nwg, G, c;
    __host__ __device__ void init(int M, int N, int G_, int c_) { nM = M / BM; nN = N / BM; nwg = nM * nN; G = G_; c = c_; }
    __host__ __device__ bool next(int i, Unit& u) const {
        const long L = (long)i * G + c; if (L >= nwg) return false;
        int wgid = (int)L; { const int q = nwg / NXCD, r = nwg % NXCD, xcd = wgid % NXCD, off = wgid / NXCD; wgid = (xcd < r ? xcd * (q + 1) : r * (q + 1) + (xcd - r) * q) + off; }
        const int nig = WGM * nN, gid = wgid / nig, fm = gid * WGM, gsz = (nM - fm) < WGM ? (nM - fm) : WGM;
        u.pm = fm + ((wgid % nig) % gsz); u.pn = (wgid % nig) / gsz; return true;
    }
    __device__ __forceinline__ const char* a_base(const Gemm& g, const Unit& u, size_t tstep) const { return (const char*)g.A + (size_t)u.pm * tstep; }
    __device__ __forceinline__ const char* b_base(const Gemm& g, const Unit& u, size_t tstep) const { return (const char*)g.Bt + (size_t)u.pn * tstep; }
    __device__ __forceinline__ void a_rows(const Unit&, int, int, int, int, int, unsigned (&)[2][2]) const {}
    __device__ __forceinline__ void a_ready(const Unit&) const {}
    __device__ __forceinline__ void done(const Unit&) const {}
};

__device__ __forceinline__ unsigned cvt_pk_bf16(float lo, float hi) { unsigned r; asm volatile("v_cvt_pk_bf16_f32 %0, %1, %2" : "=v"(r) : "v"(lo), "v"(hi)); return r; }
__device__ __forceinline__ float bf_lo(unsigned w) { return __builtin_bit_cast(float, w << 16); }
__device__ __forceinline__ float bf_hi(unsigned w) { return __builtin_bit_cast(float, w & 0xffff0000u); }
__device__ __forceinline__ float sigmoidf_fast(float x) { return __builtin_amdgcn_rcpf(1.0f + __builtin_amdgcn_exp2f(-1.4426950408889634f * x)); }
#define EPI_FENCE() asm volatile("" ::: "memory")
#define EGAS __attribute__((address_space(1)))
__device__ __forceinline__ u32x4 pack8(const f32x4 v0, const f32x4 v1) { u32x4 w; w.x = cvt_pk_bf16(v0[0], v0[1]); w.y = cvt_pk_bf16(v0[2], v0[3]); w.z = cvt_pk_bf16(v1[0], v1[1]); w.w = cvt_pk_bf16(v1[2], v1[3]); return w; }

struct EpiBf16 {
    static constexpr bool PERM = true, AFTER_DRAIN = false;
    bf16_t* O; int ldc; int row_off;
    __device__ __forceinline__ void operator()(const f32x4 (&acc)[2][2][4][2], const Unit& u, int wr, int wc, int fr, int fq) const {
        { int l_ = (int)__builtin_amdgcn_mbcnt_hi(~0u, __builtin_amdgcn_mbcnt_lo(~0u, 0u)); asm volatile("" : "+v"(l_)); fr = l_ & 15; fq = l_ >> 4; }
        const int row0 = row_off + u.pm * BM + wr * 64 + fr, col0 = u.pn * BM + wc * 32 + 8 * fq;
#pragma unroll
        for (int ai = 0; ai < 2; ++ai)
#pragma unroll
            for (int m = 0; m < 4; ++m) { bf16_t* rowp = O + (size_t)(row0 + ai * HALF + m * 16) * ldc + col0;
#pragma unroll
                for (int bj = 0; bj < 2; ++bj) *(EGAS u32x4*)(rowp + bj * HALF) = pack8(acc[ai][bj][m][0], acc[ai][bj][m][1]); }
    }
};
__device__ __forceinline__ u32x2 pack8_fp8(const f32x4 v0, const f32x4 v1) { int a = __builtin_amdgcn_cvt_pk_fp8_f32(v0[0], v0[1], 0, false); a = __builtin_amdgcn_cvt_pk_fp8_f32(v0[2], v0[3], a, true);
    int b = __builtin_amdgcn_cvt_pk_fp8_f32(v1[0], v1[1], 0, false); b = __builtin_amdgcn_cvt_pk_fp8_f32(v1[2], v1[3], b, true); u32x2 r; r.x = (unsigned)a; r.y = (unsigned)b; return r; }
struct EpiZ {
    static constexpr bool PERM = true, AFTER_DRAIN = false;
    bf16_t* zbig; bf16_t* zqi; bf16_t* zsm; unsigned char* q8; unsigned char* kv8;
    __device__ __forceinline__ void operator()(const f32x4 (&acc)[2][2][4][2], const Unit& u, int wr, int wc, int fr, int fq) const {
        { int l_ = (int)__builtin_amdgcn_mbcnt_hi(~0u, __builtin_amdgcn_mbcnt_lo(~0u, 0u)); asm volatile("" : "+v"(l_)); fr = l_ & 15; fq = l_ >> 4; }
        const int row0 = u.pm * BM + wr * 64 + fr;
        if (u.pn < 4) {
            const int col0 = u.pn * BM + wc * 32 + 8 * fq;
#pragma unroll
            for (int ai = 0; ai < 2; ++ai)
#pragma unroll
                for (int m = 0; m < 4; ++m) { unsigned char* rowp = q8 + (size_t)(row0 + ai * HALF + m * 16) * D + col0;
#pragma unroll
                    for (int bj = 0; bj < 2; ++bj) *(EGAS u32x2*)(rowp + bj * HALF) = pack8_fp8(acc[ai][bj][m][0], acc[ai][bj][m][1]); }
            return;
        }
        bf16_t* base; int ld, colt;
        if (u.pn < 20) { base = zbig + (size_t)(u.pn >> 2) * ((size_t)T_TOK * D); ld = D; colt = (u.pn & 3) * BM; }
        else if (u.pn < 22) { base = zqi; ld = 512; colt = (u.pn - 20) * BM; }
        else { base = zsm; ld = 256; colt = 0; }
        const int col0 = colt + wc * 32 + 8 * fq;
#pragma unroll
        for (int ai = 0; ai < 2; ++ai)
#pragma unroll
            for (int m = 0; m < 4; ++m) { bf16_t* rowp = base + (size_t)(row0 + ai * HALF + m * 16) * ld + col0;
#pragma unroll
                for (int bj = 0; bj < 2; ++bj) *(EGAS u32x4*)(rowp + bj * HALF) = pack8(acc[ai][bj][m][0], acc[ai][bj][m][1]); }
        if (u.pn == 22) {
#pragma unroll
            for (int ai = 0; ai < 2; ++ai)
#pragma unroll
                for (int m = 0; m < 4; ++m) *(EGAS u32x2*)(kv8 + (size_t)(row0 + ai * HALF + m * 16) * 128 + wc * 32 + 8 * fq) = pack8_fp8(acc[ai][0][m][0], acc[ai][0][m][1]);
        }
    }
};
template <int MODE> struct EpiGate {
    static constexpr bool PERM = true, AFTER_DRAIN = false;
    bf16_t* G; const bf16_t* G2;
    __device__ __forceinline__ void operator()(const f32x4 (&acc)[2][2][4][2], const Unit& u, int wr, int wc, int fr, int fq) const {
        { int l_ = (int)__builtin_amdgcn_mbcnt_hi(~0u, __builtin_amdgcn_mbcnt_lo(~0u, 0u)); asm volatile("" : "+v"(l_)); fr = l_ & 15; fq = l_ >> 4; }
        const int row0 = u.pm * BM + wr * 64 + fr, col0 = u.pn * BM + wc * 32 + 8 * fq;
#pragma unroll
        for (int ai = 0; ai < 2; ++ai) {
            u32x4 gw[4][2], g2[4][2];
#pragma unroll
            for (int m = 0; m < 4; ++m)
#pragma unroll
                for (int bj = 0; bj < 2; ++bj) { const size_t o = (size_t)(row0 + ai * HALF + m * 16) * D + col0 + bj * HALF;
                    gw[m][bj] = *(const EGAS u32x4*)(G + o); if (MODE == 1) g2[m][bj] = *(const EGAS u32x4*)(G2 + o); }
#pragma unroll
            for (int m = 0; m < 4; ++m)
#pragma unroll
                for (int bj = 0; bj < 2; ++bj) { const size_t o = (size_t)(row0 + ai * HALF + m * 16) * D + col0 + bj * HALF;
                    f32x4 v0 = acc[ai][bj][m][0], v1 = acc[ai][bj][m][1];
#pragma unroll
                    for (int j = 0; j < 4; ++j) { const unsigned wa = gw[m][bj][j >> 1], wb = gw[m][bj][2 + (j >> 1)];
                        const float ga = (j & 1) ? bf_hi(wa) : bf_lo(wa), gb = (j & 1) ? bf_hi(wb) : bf_lo(wb);
                        if (MODE == 0) { v0[j] *= sigmoidf_fast(ga); v1[j] *= sigmoidf_fast(gb); }
                        else { const unsigned xa = g2[m][bj][j >> 1], xb = g2[m][bj][2 + (j >> 1)];
                            v0[j] = ga + v0[j] * sigmoidf_fast((j & 1) ? bf_hi(xa) : bf_lo(xa)); v1[j] = gb + v1[j] * sigmoidf_fast((j & 1) ? bf_hi(xb) : bf_lo(xb)); } }
                    *(EGAS u32x4*)(G + o) = pack8(v0, v1); }
            EPI_FENCE(); }
    }
};
template <int MODE> struct EpiRes {
    static constexpr bool PERM = true, AFTER_DRAIN = false;
    float* Y; const bf16_t* XB; const bf16_t* U;
    __device__ __forceinline__ void operator()(const f32x4 (&acc)[2][2][4][2], const Unit& u, int wr, int wc, int fr, int fq) const {
        { int l_ = (int)__builtin_amdgcn_mbcnt_hi(~0u, __builtin_amdgcn_mbcnt_lo(~0u, 0u)); asm volatile("" : "+v"(l_)); fr = l_ & 15; fq = l_ >> 4; }
        const int row0 = u.pm * BM + wr * 64 + fr, col0 = u.pn * BM + wc * 32 + 8 * fq;
#pragma unroll
        for (int ai = 0; ai < 2; ++ai) {
            u32x4 xw[4][2], uw[4][2];
#pragma unroll
            for (int m = 0; m < 4; ++m)
#pragma unroll
                for (int bj = 0; bj < 2; ++bj) { const size_t o = (size_t)(row0 + ai * HALF + m * 16) * D + col0 + bj * HALF;
                    xw[m][bj] = *(const EGAS u32x4*)(XB + o);
                    if (MODE == 1) uw[m][bj] = *(const EGAS u32x4*)(U + o); }
#pragma unroll
            for (int m = 0; m < 4; ++m)
#pragma unroll
                for (int bj = 0; bj < 2; ++bj) { const size_t o = (size_t)(row0 + ai * HALF + m * 16) * D + col0 + bj * HALF;
#pragma unroll
                    for (int n = 0; n < 2; ++n) { const f32x4 a = acc[ai][bj][m][n]; f32x4 r;
                        if (MODE == 0) { const unsigned x0 = xw[m][bj][2 * n], x1 = xw[m][bj][2 * n + 1];
                            r[0] = bf_lo(x0) * DN_ALPHA + a[0]; r[1] = bf_hi(x0) * DN_ALPHA + a[1]; r[2] = bf_lo(x1) * DN_ALPHA + a[2]; r[3] = bf_hi(x1) * DN_ALPHA + a[3]; }
                        else { const unsigned x0 = xw[m][bj][2 * n], x1 = xw[m][bj][2 * n + 1], w0 = uw[m][bj][2 * n], w1 = uw[m][bj][2 * n + 1];
                            r[0] = bf_lo(x0) * DN_ALPHA + bf_lo(w0) + a[0]; r[1] = bf_hi(x0) * DN_ALPHA + bf_hi(w0) + a[1];
                            r[2] = bf_lo(x1) * DN_ALPHA + bf_lo(w1) + a[2]; r[3] = bf_hi(x1) * DN_ALPHA + bf_hi(w1) + a[3]; }
                        *(EGAS f32x4*)(Y + o + 4 * n) = r; } }
            EPI_FENCE(); }
    }
};
struct EpiPle {
    static constexpr bool PERM = true, AFTER_DRAIN = false;
    bf16_t* U;
    __device__ __forceinline__ void operator()(const f32x4 (&acc)[2][2][4][2], const Unit& u, int wr, int wc, int fr, int fq) const {
        { int l_ = (int)__builtin_amdgcn_mbcnt_hi(~0u, __builtin_amdgcn_mbcnt_lo(~0u, 0u)); asm volatile("" : "+v"(l_)); fr = l_ & 15; fq = l_ >> 4; }
        const int row0 = u.pm * BM + wr * 64 + fr, col0 = u.pn * BM + wc * 32 + 8 * fq;
#pragma unroll
        for (int ai = 0; ai < 2; ++ai) {
            u32x4 uw[4][2];
#pragma unroll
            for (int m = 0; m < 4; ++m)
#pragma unroll
                for (int bj = 0; bj < 2; ++bj) uw[m][bj] = *(const EGAS u32x4*)(U + (size_t)(row0 + ai * HALF + m * 16) * D + col0 + bj * HALF);
#pragma unroll
            for (int m = 0; m < 4; ++m)
#pragma unroll
                for (int bj = 0; bj < 2; ++bj) { f32x4 v0 = acc[ai][bj][m][0], v1 = acc[ai][bj][m][1];
#pragma unroll
                    for (int j = 0; j < 4; ++j) { const unsigned wa = uw[m][bj][j >> 1], wb = uw[m][bj][2 + (j >> 1)];
                        v0[j] = sigmoidf_fast(v0[j]) * ((j & 1) ? bf_hi(wa) : bf_lo(wa)); v1[j] = sigmoidf_fast(v1[j]) * ((j & 1) ? bf_hi(wb) : bf_lo(wb)); }
                    *(EGAS u32x4*)(U + (size_t)(row0 + ai * HALF + m * 16) * D + col0 + bj * HALF) = pack8(v0, v1); }
            EPI_FENCE(); }
    }
};
struct EpiSwiglu {
    static constexpr bool PERM = true, AFTER_DRAIN = false;
    bf16_t* H; int ldh;
    __device__ __forceinline__ void operator()(const f32x4 (&acc)[2][2][4][2], const Unit& u, int wr, int wc, int fr, int fq) const {
        { int l_ = (int)__builtin_amdgcn_mbcnt_hi(~0u, __builtin_amdgcn_mbcnt_lo(~0u, 0u)); asm volatile("" : "+v"(l_)); fr = l_ & 15; fq = l_ >> 4; }
        const int row0 = u.pm * BM + wr * 64 + fr, col0 = u.pn * HALF + wc * 32 + 8 * fq;
#pragma unroll
        for (int ai = 0; ai < 2; ++ai)
#pragma unroll
            for (int m = 0; m < 4; ++m) { bf16_t* rowp = H + (size_t)(row0 + ai * HALF + m * 16) * ldh + col0;
                f32x4 v0, v1;
#pragma unroll
                for (int j = 0; j < 4; ++j) { const float g0 = acc[ai][0][m][0][j], g1 = acc[ai][0][m][1][j];
                    v0[j] = g0 * sigmoidf_fast(g0) * acc[ai][1][m][0][j]; v1[j] = g1 * sigmoidf_fast(g1) * acc[ai][1][m][1][j]; }
                *(EGAS u32x4*)rowp = pack8(v0, v1); }
    }
};
template <class Epi, class Sched, bool ALIGN_EPI = true>
__device__ __forceinline__ void gemm_phase(PG8_LAS unsigned char* lds, const Gemm g, const Sched& S, const Epi& E, const int wave_id) {
    int lane_ = (int)__builtin_amdgcn_mbcnt_hi(~0u, __builtin_amdgcn_mbcnt_lo(~0u, 0u)); asm volatile("" : "+v"(lane_));
    const int wid = wave_id, lane = lane_, tid = wid * 64 + lane, wr = wid >> 2, wc = wid & 3, fr = lane & 15, fq = lane >> 4;
    const int K = g.K, nt = K / BK;
    unsigned voffA[2], voffB[2]; int RA[2], CA[2];
#pragma unroll
    for (int i = 0; i < 2; ++i) { int R, C; stage_rc(tid * 16 + i * 8192, R, C); const int Rb = Epi::PERM ? ((R & ~31) + perm32(R & 31)) : R; RA[i] = R; CA[i] = C;
        voffA[i] = (unsigned)(R * K + C) * 2u; voffB[i] = (unsigned)(Rb * K + C) * 2u; }
    const size_t kstep = (size_t)(BK * 2);
    const size_t hstep = (size_t)HALF * K * 2;
    const size_t tstep = 2 * hstep;
    const unsigned ldsw = (unsigned)wid * 1024u;
    const int aoff = lds_byte(wr * 64 + fr, fq * 8), boff = lds_byte(wc * 32 + fr, fq * 8);
    unsigned offC[2][2] = {{0u, 0u}, {0u, 0u}}, offN[2][2] = {{0u, 0u}, {0u, 0u}};
#define PG8_SA(b, h) (((b) * 2 + (h)) * HTB)
#define PG8_SB(b, h) ((4 + (b) * 2 + (h)) * HTB)
#define PG8_STAGE(bufoff, gbase, voff) do { _Pragma("unroll") for (int _i = 0; _i < 2; ++_i) \
        __builtin_amdgcn_global_load_lds((const unsigned*)((const char*)(gbase) + (voff)[_i]), (PG8_LAS unsigned*)(lds + (bufoff) + ldsw + _i * 8192), 16, 0, 0); } while (0)
#define PG8_STA(bufoff, ptr, h, NX) do { if constexpr (Sched::GATHER) { _Pragma("unroll") for (int _i = 0; _i < 2; ++_i) { const unsigned _o = (NX) ? offN[h][_i] : offC[h][_i]; \
        __builtin_amdgcn_global_load_lds((const unsigned*)((const char*)(ptr) + _o), (PG8_LAS unsigned*)(lds + (bufoff) + ldsw + _i * 8192), 16, 0, 0); } } \
        else { PG8_STAGE(bufoff, (ptr) + (h) * hstep, voffA); } } while (0)
#define PG8_LDA(dst, b, h) do { _Pragma("unroll") for (int m = 0; m < 4; ++m) _Pragma("unroll") for (int k = 0; k < 2; ++k) dst[m][k] = *(const PG8_LAS bf16x8*)(lds + PG8_SA(b, h) + aoff + m * 2048 + k * 1024); } while (0)
#define PG8_LDB(dst, b, h) do { _Pragma("unroll") for (int n = 0; n < 2; ++n) _Pragma("unroll") for (int k = 0; k < 2; ++k) dst[n][k] = *(const PG8_LAS bf16x8*)(lds + PG8_SB(b, h) + boff + n * 2048 + k * 1024); } while (0)
#define PG8_MMA(ai, bj, At, Bt) do { __builtin_amdgcn_s_setprio(1); _Pragma("unroll") for (int m = 0; m < 4; ++m) _Pragma("unroll") for (int n = 0; n < 2; ++n) _Pragma("unroll") for (int k = 0; k < 2; ++k) \
        acc[ai][bj][m][n] = __builtin_amdgcn_mfma_f32_16x16x32_bf16(Bt[n][k], At[m][k], acc[ai][bj][m][n], 0, 0, 0); __builtin_amdgcn_s_setprio(0); } while (0)
#define PG8_WAIT_V(n) asm volatile("s_waitcnt vmcnt(" #n ")" ::: "memory")
#define PG8_WAIT_L(n) asm volatile("s_waitcnt lgkmcnt(" #n ")" ::: "memory")
#define PG8_BAR __builtin_amdgcn_s_barrier()
#define PG8_SCHED __builtin_amdgcn_sched_barrier(0)
    Unit cur, nxt; int ui = 0;
    if (!S.next(0, cur)) return;
    f32x4 acc[2][2][4][2];
#pragma unroll
    for (int a = 0; a < 2; ++a)
#pragma unroll
        for (int b = 0; b < 2; ++b)
#pragma unroll
            for (int m = 0; m < 4; ++m)
#pragma unroll
                for (int n = 0; n < 2; ++n) acc[a][b][m][n] = (f32x4){0.f, 0.f, 0.f, 0.f};
    bf16x8 At[4][2], B0[2][2], B1[2][2];
    const char* cA = S.a_base(g, cur, tstep); const char* cB = S.b_base(g, cur, tstep);
    if constexpr (Sched::GATHER) S.a_rows(cur, RA[0], RA[1], CA[0], CA[1], K, offC);
    S.a_ready(cur);
    PG8_STAGE(PG8_SB(0, 0), cB, voffB); PG8_STAGE(PG8_SB(0, 1), cB + hstep, voffB); PG8_STA(PG8_SA(0, 0), cA, 0, false); PG8_STA(PG8_SA(0, 1), cA, 1, false);
    if (wr == 1) PG8_BAR;
    PG8_WAIT_V(2); PG8_BAR;
    PG8_STAGE(PG8_SB(1, 0), cB + kstep, voffB); PG8_STA(PG8_SA(1, 0), cA + kstep, 0, false); PG8_STAGE(PG8_SB(1, 1), cB + hstep + kstep, voffB);
    PG8_WAIT_V(6); PG8_BAR;
    for (;;) {
        const bool has_next = S.next(ui + 1, nxt);
        const char* nA = has_next ? S.a_base(g, nxt, tstep) : cA; const char* nB = has_next ? S.b_base(g, nxt, tstep) : cB;
        if constexpr (Sched::GATHER) { if (has_next) S.a_rows(nxt, RA[0], RA[1], CA[0], CA[1], K, offN); else {
#pragma unroll
            for (int h = 0; h < 2; ++h)
#pragma unroll
                for (int i = 0; i < 2; ++i) offN[h][i] = offC[h][i]; } }
        for (int t = 0; t < nt; t += 2) {
            const bool last = (t == nt - 2);
            const char* a1 = cA + (size_t)(t + 1) * kstep;
            const char* a2 = last ? nA : cA + (size_t)(t + 2) * kstep; const char* b2 = last ? nB : cB + (size_t)(t + 2) * kstep;
            const char* a3 = a2 + kstep; const char* b3 = b2 + kstep;
            if (last && has_next) S.a_ready(nxt);
            PG8_LDB(B0, 0, 0); PG8_LDB(B1, 0, 1); PG8_SCHED; PG8_LDA(At, 0, 0); PG8_STA(PG8_SA(1, 1), a1, 1, false);
            PG8_WAIT_V(8); PG8_WAIT_L(0); PG8_BAR; PG8_MMA(0, 0, At, B0); PG8_MMA(0, 1, At, B1); PG8_BAR; PG8_SCHED;
            PG8_LDA(At, 0, 1); PG8_STAGE(PG8_SB(0, 0), b2, voffB); PG8_STAGE(PG8_SB(0, 1), b2 + hstep, voffB); PG8_STA(PG8_SA(0, 0), a2, 0, last);
            PG8_WAIT_V(8); PG8_WAIT_L(0); PG8_BAR; PG8_MMA(1, 0, At, B0); PG8_MMA(1, 1, At, B1); PG8_BAR; PG8_SCHED;
            PG8_LDB(B0, 1, 0); PG8_LDB(B1, 1, 1); PG8_SCHED; PG8_LDA(At, 1, 0); PG8_STA(PG8_SA(0, 1), a2, 1, last);
            PG8_WAIT_V(8); PG8_WAIT_L(0); PG8_BAR; PG8_MMA(0, 0, At, B0); PG8_MMA(0, 1, At, B1); PG8_BAR; PG8_SCHED;
            PG8_LDA(At, 1, 1); PG8_STAGE(PG8_SB(1, 0), b3, voffB); PG8_STAGE(PG8_SB(1, 1), b3 + hstep, voffB); PG8_STA(PG8_SA(1, 0), a3, 0, last);
            PG8_WAIT_V(8); PG8_WAIT_L(0); PG8_BAR; PG8_MMA(1, 0, At, B0); PG8_MMA(1, 1, At, B1); PG8_BAR; PG8_SCHED;
        }
        if constexpr (ALIGN_EPI) { if (wr == 0) PG8_BAR; }
        E(acc, cur, wr, wc, fr, fq); S.done(cur);
        if (!has_next) break;
#pragma unroll
        for (int a = 0; a < 2; ++a)
#pragma unroll
            for (int b = 0; b < 2; ++b)
#pragma unroll
                for (int m = 0; m < 4; ++m)
#pragma unroll
                    for (int n = 0; n < 2; ++n) acc[a][b][m][n] = (f32x4){0.f, 0.f, 0.f, 0.f};
        cur = nxt; cA = nA; cB = nB; ++ui;
        if constexpr (Sched::GATHER) {
#pragma unroll
            for (int h = 0; h < 2; ++h)
#pragma unroll
                for (int i = 0; i < 2; ++i) offC[h][i] = offN[h][i]; }
        if constexpr (ALIGN_EPI) { if (wr == 1) PG8_BAR; }
    }
    PG8_WAIT_V(0);
    if constexpr (!ALIGN_EPI) { if (wr == 0) PG8_BAR; }
    PG8_BAR;
#undef PG8_SA
#undef PG8_SB
#undef PG8_STAGE
#undef PG8_STA
#undef PG8_LDA
#undef PG8_LDB
#undef PG8_MMA
#undef PG8_WAIT_V
#undef PG8_WAIT_L
#undef PG8_BAR
#undef PG8_SCHED
}
}
constexpr int NWAVES = 8;
constexpr size_t MiB = 1u << 20;
constexpr size_t WS_CTL = 0, CTL_ZERO_BYTES = 1 * MiB;
constexpr size_t WS_ROUTE = 1 * MiB;
constexpr size_t WS_LIST = 3 * MiB;
constexpr size_t WS_W = 8 * MiB;
constexpr size_t W_IN = 0, W_BRA = 12 * MiB, W_BRR = 14 * MiB, W_O = 16 * MiB, W_PG = 18 * MiB, W_PP = 20 * MiB, W_LRU = 21 * MiB, W_FF = 22 * MiB;
constexpr size_t W_FF_DN_DENSE = W_FF + 11 * MiB, W_FF_DN_MOE = W_FF + 112 * MiB;
constexpr size_t WS_XB = 208 * MiB;
constexpr size_t WS_IDX = 336 * MiB;
constexpr size_t WS_Z = 368 * MiB;
constexpr size_t Z_Q = WS_Z, Z_XR = WS_Z + 128 * MiB, Z_YR = WS_Z + 256 * MiB, Z_GA = WS_Z + 384 * MiB, Z_GR = WS_Z + 512 * MiB, Z_QI = WS_Z + 640 * MiB, Z_SM = WS_Z + 704 * MiB;
constexpr size_t Z_Q8 = Z_Q, Z_KV8 = Z_Q + 64 * MiB;
constexpr size_t WS_END = WS_Z + 736 * MiB;
constexpr size_t F_U = Z_Q;
constexpr size_t F_PB = Z_SM;
constexpr size_t F_H = Z_XR;
constexpr size_t F_H1 = WS_END;
constexpr size_t F_YE = Z_GA;
constexpr int MOE_CHUNK_TILES = 128;
constexpr size_t F_H_CHUNK_BYTES = (size_t)MOE_CHUNK_TILES * 256 * DFFE * 2;
constexpr size_t WS_NEED = F_H1 + F_H_CHUNK_BYTES;
static_assert(F_H + F_H_CHUNK_BYTES <= F_YE && F_YE + (size_t)520 * 256 * D * 2 <= Z_SM && F_H + (size_t)T_TOK * DFF * 2 <= Z_GR, "overlay map");
constexpr int CW_TMO = 0, CW_CODE = 1, CW_BAR = 4096, CW_CNT = 16384;
constexpr int RING_OFF = 0, RING_BYTES = 131072;
constexpr int LDSCTL_OFF = RING_BYTES, MISC_OFF = LDSCTL_OFF + 320;
constexpr int LDS_BYTES = 147456;

#define GAS __attribute__((address_space(1)))
#define LAS __attribute__((address_space(3)))
typedef unsigned short bf16;
typedef unsigned v4u __attribute__((ext_vector_type(4)));
typedef unsigned v2u __attribute__((ext_vector_type(2)));
typedef float f32x4 __attribute__((ext_vector_type(4)));
typedef float f32x16 __attribute__((ext_vector_type(16)));
typedef short bf16x8 __attribute__((ext_vector_type(8)));
typedef GAS unsigned gu32;
#define RLX_AGENT __ATOMIC_RELAXED, __HIP_MEMORY_SCOPE_AGENT
#define LDS_WAIT() asm volatile("s_waitcnt lgkmcnt(0)" ::: "memory")
#define VM_WAIT() asm volatile("s_waitcnt vmcnt(0)" ::: "memory")
using pg8::cvt_pk_bf16; using pg8::bf_lo; using pg8::bf_hi; using pg8::sigmoidf_fast;
#define XB_TMO      128
#define XB_XCNT(j)  (256  + 64 * (j))
#define XB_XSUB(j)  (1280 + 64 * (j))
#define XB_XGEN(j)  (2304 + 64 * (j))
#define XB_TOP      3328
#define XB_TOPGEN   3392
#define XCD_BAR_WORDS 3456
#define XB_SPIN_CAP (1u << 21)

__device__ __forceinline__ unsigned xb_ld(unsigned* p)              { return __hip_atomic_load(p, __ATOMIC_RELAXED, __HIP_MEMORY_SCOPE_AGENT); }
__device__ __forceinline__ unsigned xb_add(unsigned* p, unsigned v) { return __hip_atomic_fetch_add(p, v, __ATOMIC_RELAXED, __HIP_MEMORY_SCOPE_AGENT); }
__device__ __forceinline__ unsigned xb_xcc_id() { return (unsigned)__builtin_amdgcn_s_getreg((3 << 11) | 20) & 0xFu; }
#define XB_SPIN(cond, bar) do { unsigned _sp = 0; while (cond) { __builtin_amdgcn_s_sleep(1); \
    if ((++_sp & 255u) == 0u) { if (xb_ld(&(bar)[XB_TMO])) break; if (_sp > XB_SPIN_CAP) { atomicAdd(&(bar)[XB_TMO], 1u); break; } } } } while (0)

struct XcdBarrier {
    unsigned* bar; unsigned x;
    volatile LAS unsigned* st;
};

__device__ __forceinline__ XcdBarrier xcd_barrier_post(unsigned* bar, volatile LAS unsigned* st) {
    XcdBarrier b; b.bar = bar; b.x = xb_xcc_id(); b.st = st;
    if (threadIdx.x == 0) (void)xb_add(&bar[XB_XCNT(b.x)], 1u);
    return b;
}
__device__ __forceinline__ void xcd_barrier_complete(unsigned* bar, unsigned x, unsigned& nloc, unsigned& nx) {
    const unsigned G = gridDim.x * gridDim.y * gridDim.z;
    unsigned sum, cnt, mine, sp = 0u;
    for (;;) {
        sum = 0u; cnt = 0u; mine = 0u;
#pragma unroll
        for (unsigned j = 0; j < 16; ++j) { const unsigned c = xb_ld(&bar[XB_XCNT(j)]); sum += c; cnt += (c > 0u) ? 1u : 0u; mine = (j == x) ? c : mine; }
        if (sum == G) break;
        __builtin_amdgcn_s_sleep(1);
        if ((++sp & 255u) == 0u) { if (xb_ld(&bar[XB_TMO])) break; if (sp > XB_SPIN_CAP) { atomicAdd(&bar[XB_TMO], 1u); break; } }
    }
    nloc = mine > 0u ? mine : 1u; nx = cnt > 0u ? cnt : 1u;
}

__device__ __forceinline__ void xcd_barrier(const XcdBarrier& b) {
    asm volatile("s_waitcnt vmcnt(0)" ::: "memory");
    __syncthreads();
    if (threadIdx.x == 0) {
        unsigned* bar = b.bar;
        __builtin_amdgcn_s_waitcnt(0);
        unsigned nloc = b.st[0], nx = b.st[1];
        if (nloc == 0u) { xcd_barrier_complete(bar, b.x, nloc, nx); b.st[0] = nloc; b.st[1] = nx; }
        const unsigned old = xb_add(&bar[XB_XSUB(b.x)], 1u);
        const unsigned gen = old / nloc;
        if (old + 1u == (gen + 1u) * nloc) {
            __builtin_amdgcn_fence(__ATOMIC_RELEASE, "agent");
            asm volatile("s_waitcnt vmcnt(0)" ::: "memory");
            const unsigned og = xb_add(&bar[XB_TOP], 1u);
            const unsigned tg = og / nx;
            if (og + 1u == (tg + 1u) * nx) xb_add(&bar[XB_TOPGEN], 1u);
            else XB_SPIN(xb_ld(&bar[XB_TOPGEN]) == tg, bar);
            __builtin_amdgcn_fence(__ATOMIC_ACQUIRE, "agent");
            xb_add(&bar[XB_XGEN(b.x)], 1u);
            asm volatile("s_waitcnt vmcnt(0)" ::: "memory");
        } else {
            XB_SPIN(xb_ld(&bar[XB_XGEN(b.x)]) == gen, bar);
            __builtin_amdgcn_fence(__ATOMIC_ACQUIRE, "agent");
            asm volatile("s_waitcnt vmcnt(0)" ::: "memory");
        }
    }
    __syncthreads();
}
struct Frame {
    LAS unsigned char* lds;
    volatile LAS unsigned* MISC;
    gu32* ctl;
    int tid, lane, wave, G, bx;
    unsigned char* ws;
    float* out;
};
struct Args { const float* in[28]; float* out; unsigned char* ws; };
typedef const __attribute__((address_space(4))) Args* KArgs;
__device__ __forceinline__ KArgs kargs() { KArgs k = (KArgs)__builtin_amdgcn_kernarg_segment_ptr(); asm volatile("" : "+s"(k)); return k; }
enum { I_X = 0, I_P, I_WIN, I_CONVW, I_CONVB, I_LRUWA, I_LRUBA, I_LRUWX, I_LRUBX, I_LAM, I_WBRA, I_WBRR, I_WO, I_RELB, I_LN1G, I_LN1B, I_FFG, I_FFU, I_FFD, I_ROUTER, I_ROUTERB, I_MOEG, I_MOEU, I_MOED, I_PLEG, I_PLEP, I_LN2G, I_LN2B };

__device__ __forceinline__ Frame launder(const Frame& F0) { Frame F = F0; unsigned char* w = F0.ws; int l = (int)__builtin_amdgcn_mbcnt_hi(~0u, __builtin_amdgcn_mbcnt_lo(~0u, 0u)); asm volatile("" : "+s"(w)); asm volatile("" : "+v"(l));
    F.ws = w; F.lane = l; F.tid = F0.wave * 64 + l; F.ctl = (gu32*)(w + WS_CTL); return F; }
__device__ __forceinline__ float lane_get(float v, int src_lane) { return __builtin_bit_cast(float, __builtin_amdgcn_ds_bpermute(src_lane << 2, __builtin_bit_cast(int, v))); }
__device__ __forceinline__ float lane_xor(float v, int mask, int lane) { return lane_get(v, lane ^ mask); }
__device__ __forceinline__ float lane_up(float v, int d, int lane) { return lane_get(v, lane >= d ? lane - d : lane); }
__device__ __forceinline__ float wave_sum(float v, int lane) {
#pragma unroll
    for (int o = 1; o < 64; o <<= 1) v += lane_xor(v, o, lane);
    return v;
}
__device__ __forceinline__ unsigned pk2(float lo, float hi) { return cvt_pk_bf16(lo, hi); }

__device__ __forceinline__ void cvt_item(const float* W, int ldw, int K, bf16* WT, int d0, int sc0, int nvalid, float scale, int k0, LAS float* scr, int lane) {
    const int n4 = (lane & 7) * 4;
    f32x4 v[8];
#pragma unroll
    for (int i = 0; i < 8; ++i) { const int kk = 8 * i + (lane >> 3); v[i] = (f32x4){0.f, 0.f, 0.f, 0.f}; if (n4 < nvalid) v[i] = *(const GAS f32x4*)(W + (size_t)(k0 + kk) * ldw + sc0 + n4); }
#pragma unroll
    for (int i = 0; i < 8; ++i) { const int kk = 8 * i + (lane >> 3); LAS float* d = scr + kk * 33 + n4; d[0] = v[i][0] * scale; d[1] = v[i][1] * scale; d[2] = v[i][2] * scale; d[3] = v[i][3] * scale; }
    LDS_WAIT(); asm volatile("" ::: "memory");
    const int c = lane & 7;
#pragma unroll
    for (int j = 0; j < 4; ++j) { const int nn = (lane >> 3) + 8 * j; const LAS float* s = scr + (8 * c) * 33 + nn;
        v4u o; o.x = pk2(s[0 * 33], s[1 * 33]); o.y = pk2(s[2 * 33], s[3 * 33]); o.z = pk2(s[4 * 33], s[5 * 33]); o.w = pk2(s[6 * 33], s[7 * 33]);
        *(GAS v4u*)(WT + (size_t)(d0 + nn) * K + k0 + 8 * c) = o; }
    LDS_WAIT(); asm volatile("" ::: "memory");
}
__device__ __forceinline__ void cvt_plain(const float* W, int K, int N, bf16* WT, int item, LAS float* scr, int lane) {
    const int nblk = N / 32, kb = item / nblk, nb = item % nblk;
    cvt_item(W, N, K, WT, 32 * nb, 32 * nb, 32, 1.0f, 64 * kb, scr, lane);
}
__device__ __forceinline__ void cvt_gateup(const float* Wg, const float* Wu, int dff, bf16* WT, int item, LAS float* scr, int lane) {
    const int nblk = 2 * dff / 32, kb = item / nblk, db = item % nblk, d0 = 32 * db, pn = d0 >> 8, r = d0 & 255;
    const float* W = r < 128 ? Wg : Wu; const int sc0 = 128 * pn + (r & 127);
    cvt_item(W, dff, D, WT, d0, sc0, 32, 1.0f, 64 * kb, scr, lane);
}
__device__ __forceinline__ void cvt_win(const float* W, bf16* WT, int item, LAS float* scr, int lane) {
    const int nblk = NIN / 32, kb = item / nblk, db = item % nblk, d0 = 32 * db;
    int sc0, nv = 32; float sc = 1.0f;
    if (d0 < 1024) { sc0 = d0; }
    else if (d0 < 2048) sc0 = 1736 + (d0 - 1024);
    else if (d0 < 3072) sc0 = 2760 + (d0 - 2048);
    else if (d0 < 4096) sc0 = 3784 + (d0 - 3072);
    else if (d0 < 5120) sc0 = 4808 + (d0 - 4096);
    else if (d0 < 5632) sc0 = 1152 + (d0 - 5120);
    else if (d0 < 5696) sc0 = 1024 + (d0 - 5632);
    else if (d0 < 5760) sc0 = 1088 + (d0 - 5696);
    else if (d0 < 5824) sc0 = 1664 + (d0 - 5760);
    else if (d0 == 5824) { sc0 = 1728; nv = 8; }
    else { sc0 = 0; nv = 0; }
    cvt_item(W, D_IN, D, WT, d0, sc0, nv, sc, 64 * kb, scr, lane);
}
__device__ __forceinline__ void p0_convert(const Frame& F0, int L) {
    Frame F = launder(F0);
    const KArgs ka = kargs();
    LAS float* scr = (LAS float*)(F.lds + RING_OFF + F.wave * 16384);
    const int gw = F.bx * NWAVES + F.wave, NGW = F.G * NWAVES;
    unsigned char* wb = F.ws + WS_W;
    const int odd = L & 1, jj = L >> 1;
    constexpr int I_IN = (D / 64) * (NIN / 32), I_SQ = (D / 64) * (D / 32), I_PPJ = (PLE / 64) * (D / 32), I_LRU1 = 2 * 4;
    constexpr int I_GU_D = (D / 64) * (2 * DFF / 32), I_DN_D = (DFF / 64) * (D / 32), I_GU_E = (D / 64) * (2 * DFFE / 32), I_DN_E = (DFFE / 64) * (D / 32);
    const int n_ff = odd ? NEXP * (I_GU_E + I_DN_E) : (I_GU_D + I_DN_D);
    const int NITEMS = I_IN + 4 * I_SQ + I_PPJ + 16 * I_LRU1 + n_ff;
    for (int it = gw; it < NITEMS; it += NGW) {
        const float* W; bf16* WT; int ldw, K, d0, sc0, nv = 32, k0; float scale = 1.0f;
        int r = it, kind = 0, m = 0;
        if (r < I_IN) kind = 1;
        else { r -= I_IN;
            if (r < 4 * I_SQ) { m = r / I_SQ; r -= m * I_SQ; }
            else { r -= 4 * I_SQ;
                if (r < I_PPJ) m = 4;
                else { r -= I_PPJ;
                    if (r < 16 * I_LRU1) m = 5;
                    else { r -= 16 * I_LRU1;
                        if (!odd) { if (r < I_GU_D) kind = 2; else { r -= I_GU_D; m = 6; } }
                        else { if (r < NEXP * I_GU_E) kind = 3; else { r -= NEXP * I_GU_E; m = 7; } } } } } }
        if (kind == 1) { const int nblk = NIN / 32, kb = r / nblk, db = r % nblk; d0 = 32 * db; k0 = 64 * kb;
            W = ka->in[I_WIN] + (size_t)L * D * D_IN; WT = (bf16*)(wb + W_IN); ldw = D_IN; K = D;
            if (d0 < 1024) sc0 = d0;
            else if (d0 < 2048) sc0 = 1736 + (d0 - 1024);
            else if (d0 < 3072) sc0 = 2760 + (d0 - 2048);
            else if (d0 < 4096) sc0 = 3784 + (d0 - 3072);
            else if (d0 < 5120) sc0 = 4808 + (d0 - 4096);
            else if (d0 < 5632) sc0 = 1152 + (d0 - 5120);
            else if (d0 < 5696) sc0 = 1024 + (d0 - 5632);
            else if (d0 < 5760) sc0 = 1088 + (d0 - 5696);
            else if (d0 < 5824) sc0 = 1664 + (d0 - 5760);
            else if (d0 == 5824) { sc0 = 1728; nv = 8; }
            else { sc0 = 0; nv = 0; } }
        else if (kind >= 2) { const int dff = kind == 2 ? DFF : DFFE; int e = 0; if (kind == 3) { e = r / I_GU_E; r -= e * I_GU_E; }
            const size_t eo = kind == 2 ? (size_t)jj * D * DFF : ((size_t)jj * NEXP + e) * D * DFFE;
            const int nblk = 2 * dff / 32, kb = r / nblk, db = r % nblk; d0 = 32 * db; k0 = 64 * kb; const int pn = d0 >> 8, rr = d0 & 255;
            W = (rr < 128 ? ka->in[kind == 2 ? I_FFG : I_MOEG] : ka->in[kind == 2 ? I_FFU : I_MOEU]) + eo; sc0 = 128 * pn + (rr & 127); ldw = dff; K = D;
            WT = (bf16*)(wb + W_FF) + (kind == 3 ? (size_t)e * 2 * DFFE * D : 0); }
        else { int Kk, Nn;
            if (m < 4) { Kk = D; Nn = D; W = ka->in[m == 0 ? I_WBRA : m == 1 ? I_WBRR : m == 2 ? I_WO : I_PLEG] + (size_t)L * D * D; WT = (bf16*)(wb + (m == 0 ? W_BRA : m == 1 ? W_BRR : m == 2 ? W_O : W_PG)); }
            else if (m == 4) { Kk = PLE; Nn = D; W = ka->in[I_PLEP] + (size_t)L * PLE * D; WT = (bf16*)(wb + W_PP); }
            else if (m == 5) { const int mm = r / I_LRU1, blk = mm & 7, which = mm >> 3; r -= mm * I_LRU1; Kk = 128; Nn = 128;
                W = ka->in[which ? I_LRUWX : I_LRUWA] + (size_t)L * 8 * 128 * 128 + (size_t)blk * 128 * 128; WT = (bf16*)(wb + W_LRU) + (size_t)which * 8 * 128 * 128 + (size_t)blk * 128 * 128; }
            else if (m == 6) { Kk = DFF; Nn = D; W = ka->in[I_FFD] + (size_t)jj * DFF * D; WT = (bf16*)(wb + W_FF_DN_DENSE); }
            else { const int e = r / I_DN_E; r -= e * I_DN_E; Kk = DFFE; Nn = D; W = ka->in[I_MOED] + ((size_t)jj * NEXP + e) * DFFE * D; WT = (bf16*)(wb + W_FF_DN_MOE) + (size_t)e * D * DFFE; }
            const int nblk = Nn / 32, kb = r / nblk, nb = r % nblk; d0 = 32 * nb; sc0 = 32 * nb; k0 = 64 * kb; ldw = Nn; K = Kk; }
        cvt_item(W, ldw, K, WT, d0, sc0, nv, scale, k0, scr, F.lane);
    }
    if (L == 0) {
        const GAS f32x4* x4 = (const GAS f32x4*)ka->in[I_X]; GAS v4u* o = (GAS v4u*)(F.ws + WS_XB);
        const size_t n8 = (size_t)T_TOK * D / 8;
        for (size_t i = (size_t)F.bx * 512 + F.tid; i < n8; i += (size_t)F.G * 512) { const f32x4 a = x4[2 * i], b = x4[2 * i + 1];
            v4u w; w.x = pk2(a[0], a[1]); w.y = pk2(a[2], a[3]); w.z = pk2(b[0], b[1]); w.w = pk2(b[2], b[3]); o[i] = w; }
    }
}

template <bool LN2, bool ODD, bool DRY = false>
__device__ __forceinline__ void ln_phase(const Frame& F0, int L) {
    Frame F = launder(F0);
    const KArgs ka = kargs();
    const int jj = L >> 1;
    float* X32 = F.out; bf16* XB = (bf16*)(F.ws + WS_XB);
    const float* gam = ka->in[LN2 ? I_LN2G : I_LN1G] + (size_t)L * D; const float* bet = ka->in[LN2 ? I_LN2B : I_LN1B] + (size_t)L * D;
    f32x4 gv[4], bv[4];
#pragma unroll
    for (int j = 0; j < 4; ++j) { gv[j] = ((const GAS f32x4*)gam)[F.lane + 64 * j]; bv[j] = ((const GAS f32x4*)bet)[F.lane + 64 * j]; }
    LAS float* RT = (LAS float*)(F.lds + RING_OFF);
    LAS unsigned* TE = (LAS unsigned*)(F.lds + RING_OFF + 32768);
    volatile LAS unsigned* lcnt = F.MISC + 48; volatile LAS unsigned* gbase = F.MISC + 56;
    float rb[8];
    if (!LN2 && ODD) {
        const float* R = ka->in[I_ROUTER] + (size_t)jj * D * NEXP;
        for (int i = F.tid; i < D * NEXP; i += 512) RT[i] = R[i];
        if (F.tid < 8) lcnt[F.tid] = 0u;
#pragma unroll
        for (int e = 0; e < 8; ++e) rb[e] = ka->in[I_ROUTERB][jj * NEXP + e];
        __syncthreads();
    }
    const unsigned* route = (const unsigned*)(F.ws + WS_ROUTE);
    const bf16* YE = (const bf16*)(F.ws + F_YE);
    const bf16* T1 = (const bf16*)(F.ws + (LN2 ? F_U : Z_GR)); const bf16* T2 = (const bf16*)(F.ws + Z_GR);
    v2u nx[4], n1[4];
    { const size_t r0 = ((size_t)F.bx * 256 + F.wave) * D; const GAS v2u* a0 = (const GAS v2u*)(XB + r0) + F.lane; const GAS v2u* b0 = (const GAS v2u*)(T1 + r0) + F.lane;
#pragma unroll
      for (int j = 0; j < 4; ++j) { nx[j] = a0[64 * j]; n1[j] = b0[64 * j]; } }
    for (int it = 0; it < 32; ++it) {
        const int rl = F.wave + 8 * it; const size_t row = (size_t)F.bx * 256 + rl;
        GAS f32x4* xr = (GAS f32x4*)(X32 + row * D) + F.lane;
        f32x4 v[4]; float s = 0.f;
#pragma unroll
        for (int j = 0; j < 4; ++j) { const v2u a = nx[j], b = n1[j];
            v[j][0] = DN_ALPHA * bf_lo(a.x) + bf_lo(b.x); v[j][1] = DN_ALPHA * bf_hi(a.x) + bf_hi(b.x); v[j][2] = DN_ALPHA * bf_lo(a.y) + bf_lo(b.y); v[j][3] = DN_ALPHA * bf_hi(a.y) + bf_hi(b.y); }
        if (it < 31) { const GAS v2u* a0 = (const GAS v2u*)(XB + (row + 8) * D) + F.lane; const GAS v2u* b0 = (const GAS v2u*)(T1 + (row + 8) * D) + F.lane;
#pragma unroll
            for (int j = 0; j < 4; ++j) { nx[j] = a0[64 * j]; n1[j] = b0[64 * j]; } }
        if (LN2 && !ODD) {
            const GAS v2u* fp = (const GAS v2u*)(T2 + row * D) + F.lane;
#pragma unroll
            for (int j = 0; j < 4; ++j) { const v2u b = fp[64 * j]; v[j][0] += bf_lo(b.x); v[j][1] += bf_hi(b.x); v[j][2] += bf_lo(b.y); v[j][3] += bf_hi(b.y); }
        }
        if (LN2 && ODD) {
            const unsigned e1 = route[row * 8 + 0], e2 = route[row * 8 + 1], p1 = route[row * 8 + 2], p2 = route[row * 8 + 3];
            const float g1 = __builtin_bit_cast(float, route[row * 8 + 4]), g2 = __builtin_bit_cast(float, route[row * 8 + 5]);
            const size_t r1 = (size_t)F.MISC[16 + e1] * 256 + p1, r2 = (size_t)F.MISC[16 + e2] * 256 + p2;
            const GAS v2u* y1 = (const GAS v2u*)(YE + r1 * D) + F.lane; const GAS v2u* y2 = (const GAS v2u*)(YE + r2 * D) + F.lane;
#pragma unroll
            for (int j = 0; j < 4; ++j) { const v2u a = y1[64 * j], b = y2[64 * j];
                v[j][0] += g1 * bf_lo(a.x) + g2 * bf_lo(b.x); v[j][1] += g1 * bf_hi(a.x) + g2 * bf_hi(b.x);
                v[j][2] += g1 * bf_lo(a.y) + g2 * bf_lo(b.y); v[j][3] += g1 * bf_hi(a.y) + g2 * bf_hi(b.y); }
        }
#pragma unroll
        for (int j = 0; j < 4; ++j) s += (v[j][0] + v[j][1]) + (v[j][2] + v[j][3]);
        const float mean = wave_sum(s, F.lane) * (1.f / D); float s2 = 0.f;
#pragma unroll
        for (int j = 0; j < 4; ++j) { v[j] = v[j] - mean; s2 += (v[j][0] * v[j][0] + v[j][1] * v[j][1]) + (v[j][2] * v[j][2] + v[j][3] * v[j][3]); }
        const float rstd = 1.f / sqrtf(wave_sum(s2, F.lane) * (1.f / D) + LN_EPS);
        GAS v2u* o8 = (GAS v2u*)((DRY ? (bf16*)(F.ws + WS_NEED) : XB) + row * D) + F.lane;
        GAS f32x4* xw = DRY ? (GAS f32x4*)((float*)(F.ws + WS_NEED) + row * D) + F.lane : xr;
#pragma unroll
        for (int j = 0; j < 4; ++j) { v[j] = v[j] * rstd * gv[j] + bv[j]; if (DRY || (LN2 && L == DEPTH - 1)) xw[64 * j] = v[j];
            v2u w; w.x = pk2(v[j][0], v[j][1]); w.y = pk2(v[j][2], v[j][3]); o8[64 * j] = w; }
        if (!LN2) {
            const f32x4 pv = ((const GAS f32x4*)(ka->in[I_P] + ((size_t)L * T_TOK + row) * PLE))[F.lane];
            v2u w; w.x = pk2(pv[0], pv[1]); w.y = pk2(pv[2], pv[3]); ((GAS v2u*)(F.ws + (DRY ? WS_NEED : F_PB) + row * PLE * 2))[F.lane] = w;
        }
        if (!LN2 && ODD) {
            float lg[8];
#pragma unroll
            for (int e = 0; e < 8; ++e) lg[e] = 0.f;
#pragma unroll
            for (int j = 0; j < 4; ++j)
#pragma unroll
                for (int q = 0; q < 4; ++q) { const int c = 4 * F.lane + 256 * j + q; const f32x4 ra = *(const LAS f32x4*)(RT + c * 8), rc = *(const LAS f32x4*)(RT + c * 8 + 4); const float xv = v[j][q];
                    lg[0] += xv * ra[0]; lg[1] += xv * ra[1]; lg[2] += xv * ra[2]; lg[3] += xv * ra[3]; lg[4] += xv * rc[0]; lg[5] += xv * rc[1]; lg[6] += xv * rc[2]; lg[7] += xv * rc[3]; }
#pragma unroll
            for (int e = 0; e < 8; ++e) lg[e] = wave_sum(lg[e], F.lane) + rb[e];
            int e1 = 0; float v1 = lg[0];
#pragma unroll
            for (int e = 1; e < 8; ++e) if (lg[e] > v1) { v1 = lg[e]; e1 = e; }
            int e2 = -1; float v2 = 0.f;
#pragma unroll
            for (int e = 0; e < 8; ++e) if (e != e1 && (e2 < 0 || lg[e] > v2)) { v2 = lg[e]; e2 = e; }
            const float ex = __expf(v2 - v1), g1 = 1.f / (1.f + ex), g2 = ex * g1;
            if (F.lane == 0) { const unsigned lp1 = __hip_atomic_fetch_add((LAS unsigned*)lcnt + e1, 1u, __ATOMIC_RELAXED, __HIP_MEMORY_SCOPE_WORKGROUP), lp2 = __hip_atomic_fetch_add((LAS unsigned*)lcnt + e2, 1u, __ATOMIC_RELAXED, __HIP_MEMORY_SCOPE_WORKGROUP);
                TE[rl * 4 + 0] = (unsigned)e1 | ((unsigned)e2 << 8) | (lp1 << 16); TE[rl * 4 + 1] = lp2; TE[rl * 4 + 2] = __builtin_bit_cast(unsigned, g1); TE[rl * 4 + 3] = __builtin_bit_cast(unsigned, g2); }
        }
    }
    if (!LN2 && ODD) {
        __syncthreads();
        if (F.tid < 8) gbase[F.tid] = __hip_atomic_fetch_add(F.ctl + CW_CNT + jj * 1024 + 64 * F.tid, lcnt[F.tid], RLX_AGENT);
        __syncthreads();
        if (F.tid < 256) { const unsigned w0 = TE[F.tid * 4], lp2 = TE[F.tid * 4 + 1]; const unsigned e1 = w0 & 255u, e2 = (w0 >> 8) & 255u, lp1 = w0 >> 16;
            const unsigned p1 = gbase[e1] + lp1, p2 = gbase[e2] + lp2; const unsigned tok = (unsigned)F.bx * 256 + F.tid;
            GAS int* list = (GAS int*)(F.ws + WS_LIST); list[(size_t)e1 * T_TOK + p1] = (int)tok; list[(size_t)e2 * T_TOK + p2] = (int)tok;
            GAS v4u* ro = (GAS v4u*)(F.ws + WS_ROUTE) + (size_t)tok * 2; v4u a; a.x = e1; a.y = e2; a.z = p1; a.w = p2; ro[0] = a; v4u b; b.x = TE[F.tid * 4 + 2]; b.y = TE[F.tid * 4 + 3]; b.z = 0u; b.w = 0u; ro[1] = b; }
        __syncthreads();
    }
}
__device__ __forceinline__ int wave_scan_add(int x) {
    x += __builtin_amdgcn_update_dpp(0, x, 0x111, 0xf, 0xf, false);
    x += __builtin_amdgcn_update_dpp(0, x, 0x112, 0xf, 0xf, false);
    x += __builtin_amdgcn_update_dpp(0, x, 0x114, 0xf, 0xf, false);
    x += __builtin_amdgcn_update_dpp(0, x, 0x118, 0xf, 0xf, false);
    x += __builtin_amdgcn_update_dpp(0, x, 0x142, 0xa, 0xf, false);
    x += __builtin_amdgcn_update_dpp(0, x, 0x143, 0xc, 0xf, false);
    return x;
}
template <int NJ>
__device__ __forceinline__ unsigned select_topk_n(LAS const float* sc, int n_adm, GAS unsigned short* gout, LAS unsigned short* out, int lane, unsigned guess) {
    const int nj = n_adm >> 6;
    unsigned u[NJ];
#pragma unroll
    for (int j = 0; j < NJ; ++j) { unsigned b = 0u;
        if (j < NJ - 8 || j < nj) { b = __builtin_bit_cast(unsigned, sc[64 * j + lane]); b = (b == 0x80000000u) ? 0u : b; b = (b & 0x80000000u) ? ~b : (b | 0x80000000u); }
        u[j] = b; }
#define SEL_COUNT(c_, dst_) do { int cl_ = 0; _Pragma("unroll") for (int j = 0; j < NJ; ++j) cl_ += (u[j] >= (c_)) ? 1 : 0; dst_ = __builtin_amdgcn_readlane(wave_scan_add(cl_), 63); } while (0)
    unsigned lo = 0u, hi = 0xFFFFFFFFu, ex = 0u; bool exact = false; int c;
    if (guess != 0u) {
        SEL_COUNT(guess, c);
        if (c == 256) { exact = true; ex = guess; }
        else if (c > 256) { lo = guess; unsigned d = 1u << 17;
            for (int e = 0; e < 7 && !exact; ++e) { const unsigned h = lo + d; if (h < lo) break; SEL_COUNT(h, c);
                if (c == 256) { exact = true; ex = h; } else if (c < 256) { hi = h; break; } else { lo = h; d <<= 2; } } }
        else { hi = guess; unsigned d = 1u << 17;
            for (int e = 0; e < 7 && !exact; ++e) { if (d >= hi) break; const unsigned l = hi - d; SEL_COUNT(l, c);
                if (c == 256) { exact = true; ex = l; } else if (c > 256) { lo = l; break; } else { hi = l; d <<= 2; } } }
    }
    while (!exact && hi - lo > 1u) { const unsigned mid = lo + ((hi - lo) >> 1); SEL_COUNT(mid, c);
        if (c == 256) { exact = true; ex = mid; } else if (c > 256) lo = mid; else hi = mid; }
#undef SEL_COUNT
    const unsigned thr = exact ? ex - 1u : lo;
    int nl = 0;
#pragma unroll
    for (int j = 0; j < NJ; ++j) nl += (u[j] > thr) ? 1 : 0;
    const int incl = wave_scan_add(nl); const int ngt = __builtin_amdgcn_readlane(incl, 63);
    int pos = incl - nl;
#pragma unroll
    for (int j = 0; j < NJ; ++j) if (u[j] > thr) { out[pos] = (unsigned short)(64 * j + lane); ++pos; }
    const int quota = 256 - ngt;
    if (quota > 0) {
        int tbase = 0; const unsigned long long lt = (1ull << lane) - 1ull;
#pragma unroll
        for (int j = 0; j < NJ; ++j) {
            const bool eq = u[j] == thr; const unsigned long long meq = __ballot(eq); const int rk = tbase + __popcll(meq & lt);
            if (eq && rk < quota) out[ngt + rk] = (unsigned short)(64 * j + lane);
            tbase += __popcll(meq);
        }
    }
    asm volatile("s_waitcnt lgkmcnt(0)" ::: "memory");
    if (lane < 32) *(GAS v4u*)(gout + 8 * lane) = *(const LAS v4u*)(out + 8 * lane);
    asm volatile("s_waitcnt lgkmcnt(0)" ::: "memory");
    return thr;
}
__device__ __forceinline__ unsigned select_topk(LAS const float* sc, int n_adm, GAS unsigned short* out, LAS unsigned short* orow, int lane, unsigned guess) {
    if (n_adm <= 256) {
#pragma unroll
        for (int j = 0; j < 4; ++j) { const int p = lane + 64 * j; out[p] = (unsigned short)(p < n_adm ? p : 0); }
        return 0u;
    }
    if (n_adm <= 512) return select_topk_n<8>(sc, n_adm, out, orow, lane, guess);
    else if (n_adm <= 1024) return select_topk_n<16>(sc, n_adm, out, orow, lane, guess);
    else if (n_adm <= 1536) return select_topk_n<24>(sc, n_adm, out, orow, lane, guess);
    return select_topk_n<32>(sc, n_adm, out, orow, lane, guess);
}
template <int MODE = 0>
__device__ __forceinline__ void indexer_phase(const Frame& F0) {
    Frame F = launder(F0);
    LAS float* sc = (LAS float*)(F.lds + RING_OFF);
    const bf16* QI = (const bf16*)(F.ws + Z_QI); const bf16* SM = (const bf16*)(F.ws + Z_SM);
    GAS unsigned short* IDX = (GAS unsigned short*)(F.ws + WS_IDX);
    const int lane = F.lane, h = lane >> 5, r = lane & 31;
    const int rq = 2 * ((r >> 2) & 1) + ((r >> 4) & 1), rh = (r & 3) + 4 * ((r >> 3) & 1);
    const int vcu = (F.bx & 7) * (F.G >> 3) + (F.bx >> 3);
    unsigned guess[2] = {0u, 0u};
    bf16x8 A[4][4]; v4u wq[4][2];
#define IDX_TILE(pi_, b_, tq_) const int pid_ = vcu * 8 + ((pi_) >> 1), b_ = pid_ >> 6, jp_ = pid_ & 63, tq_ = 16 * (((pi_) & 1) ? 127 - jp_ : jp_)
#define IDX_LOAD_A(t0_) do { _Pragma("unroll") for (int mt = 0; mt < 4; ++mt) { \
        _Pragma("unroll") for (int s = 0; s < 4; ++s) A[mt][s] = *(const GAS bf16x8*)(QI + (size_t)((t0_) + 4 * mt + rq) * 512 + rh * 64 + 16 * s + 8 * h); \
        _Pragma("unroll") for (int qq = 0; qq < 2; ++qq) wq[mt][qq] = *(const GAS v4u*)(SM + (size_t)((t0_) + 4 * mt + 2 * h + qq) * 256 + 192); } } while (0)
    for (int pi = 0; pi < 16; ++pi) {
        IDX_TILE(pi, b, tq);
        const int t0 = b * SEQ + tq;
        const int n_adm = ((tq >> 6) + 1) * 64, nkb = n_adm >> 5;
        if (n_adm > 256 && MODE != 2) {
            IDX_LOAD_A(t0);
            bf16x8 B[4], Bn[4];
#pragma unroll
            for (int s = 0; s < 4; ++s) Bn[s] = *(const GAS bf16x8*)(SM + (size_t)(b * SEQ + 32 * F.wave + r) * 256 + 128 + 16 * s + 8 * h);
            for (int kb = F.wave; kb < nkb; kb += 8) {
                const int key = 32 * kb + r;
                const int keyn = (kb + 8 < nkb) ? key + 256 : key;
#pragma unroll
                for (int s = 0; s < 4; ++s) B[s] = Bn[s];
#pragma unroll
                for (int s = 0; s < 4; ++s) Bn[s] = *(const GAS bf16x8*)(SM + (size_t)(b * SEQ + keyn) * 256 + 128 + 16 * s + 8 * h);
#pragma unroll
                for (int mt = 0; mt < 4; ++mt) {
                    f32x16 acc;
#pragma unroll
                    for (int i = 0; i < 16; ++i) acc[i] = 0.f;
#pragma unroll
                    for (int s = 0; s < 4; ++s) acc = __builtin_amdgcn_mfma_f32_32x32x16_bf16(A[mt][s], B[s], acc, 0, 0, 0);
                    float sA = 0.f, sB = 0.f;
#pragma unroll
                    for (int i = 0; i < 8; ++i) { const unsigned wa = wq[mt][0][i >> 1], wb = wq[mt][1][i >> 1];
                        const float fa = (i & 1) ? bf_hi(wa) : bf_lo(wa), fb = (i & 1) ? bf_hi(wb) : bf_lo(wb);
                        sA += fmaxf(acc[i], 0.f) * fa; sB += fmaxf(acc[8 + i], 0.f) * fb; }
                    sc[(4 * mt + 2 * h) * 2048 + key] = sA; sc[(4 * mt + 2 * h + 1) * 2048 + key] = sB;
                }
            }
        }
        __syncthreads();
#pragma unroll 1
        for (int qq = 0; qq < 2 && MODE != 1; ++qq) { const int q = 2 * F.wave + qq; const unsigned g_ = (pi & 1) ? guess[1] : guess[0];
            const unsigned t_ = select_topk(sc + q * 2048, n_adm, IDX + (size_t)(t0 + q) * 256, (LAS unsigned short*)(F.lds + LDSCTL_OFF + 1024 + F.wave * 512), lane, g_); if (pi & 1) guess[1] = t_; else guess[0] = t_; }
        __syncthreads();
    }
#undef IDX_TILE
#undef IDX_LOAD_A
}

__device__ __forceinline__ unsigned vst_off(unsigned r, unsigned ch) { return r * 128u + 16u * (ch ^ ((((r >> 1) ^ (r >> 4)) & 1u) << 1) ^ (((r >> 3) & 1u) << 2)); }
__device__ __forceinline__ int t5_bucket_dev(int rel) {
    const int n = rel < 0 ? -rel : rel;
    int v = n;
    if (n >= 8) v = 8 + (n >= 12) + (n >= 16) + (n >= 23) + (n >= 32) + (n >= 46) + (n >= 64) + (n >= 91);
    return v + (rel > 0 ? 16 : 0);
}
#ifndef ATT_REPS
#define ATT_REPS 1
#endif
#ifndef ATT_FIXKEYS
#define ATT_FIXKEYS 0
#endif
template <int FIX = 0>
__device__ __forceinline__ void attention_phase(const Frame& F0) {
#pragma unroll 1
    for (int rep = 0; rep < ATT_REPS; ++rep) {
    Frame F = launder(F0);
    const GAS unsigned char* Q8 = (const GAS unsigned char*)(F.ws + Z_Q8); const GAS unsigned char* KV8 = (const GAS unsigned char*)(F.ws + Z_KV8); bf16* OB = (bf16*)(F.ws + Z_XR);
    const GAS unsigned short* IDX = (const GAS unsigned short*)(F.ws + WS_IDX);
    const int lane = F.lane, g = lane >> 4, m = lane & 15;
    LAS unsigned char* vst = F.lds + RING_OFF + F.wave * 4096;
    const unsigned vbase = (unsigned)(size_t)vst;
    LAS unsigned char* BK = F.lds + RING_OFF + 32768; LAS unsigned char* OH = F.lds + RING_OFF + 32768 + 2176;
    for (int i = F.tid; i < 2112; i += 512) BK[i] = (unsigned char)t5_bucket_dev(i - 2047);
    if (F.tid < 128) { const int bkt = F.tid >> 2, gg = F.tid & 3, j = bkt - 8 * gg; v4u oh; oh.x = oh.y = oh.z = oh.w = 0u;
        if (j >= 0 && j < 8) { const unsigned val = (j & 1) ? 0x3F800000u : 0x3F80u; if ((j >> 1) == 0) oh.x = val; else if ((j >> 1) == 1) oh.y = val; else if ((j >> 1) == 2) oh.z = val; else oh.w = val; }
        *(LAS v4u*)(OH + F.tid * 16) = oh; }
    __syncthreads();
    bf16x8 bb;
    { const float* rbias = kargs()->in[I_RELB]; unsigned w[4];
#pragma unroll
      for (int j = 0; j < 4; ++j) w[j] = pk2(8.0f * rbias[(8 * g + 2 * j) * 16 + m], 8.0f * rbias[(8 * g + 2 * j + 1) * 16 + m]);
      v4u t; t.x = w[0]; t.y = w[1]; t.z = w[2]; t.w = w[3]; bb = __builtin_bit_cast(bf16x8, t); }
    unsigned tra[4];
    { const unsigned rr_ = 8 * g + (m >> 1), fr_ = ((rr_ >> 2) & 3u) ^ ((rr_ >> 1) & 1u);
#pragma unroll
      for (int c = 0; c < 4; ++c) tra[c] = rr_ * 64u + 16u * ((unsigned)c ^ fr_) + 8u * (m & 1); }
    const long aones = (m == 0) ? 0x3838383838383838L : 0L;
    const int vcu = (F.bx & 7) * (F.G >> 3) + (F.bx >> 3);
    typedef long fp8x8;
    v4u ni0, ni1, nq; v4u ka[16]; unsigned koff[16];
#define ATT_KOFF(i0_, i1_) do { _Pragma("unroll") for (int k = 0; k < 4; ++k) { koff[2 * k] = ((i0_)[k] & 0xffffu) * 128u + 16u * g; koff[2 * k + 1] = ((i0_)[k] >> 16) * 128u + 16u * g; \
        koff[8 + 2 * k] = ((i1_)[k] & 0xffffu) * 128u + 16u * g; koff[8 + 2 * k + 1] = ((i1_)[k] >> 16) * 128u + 16u * g; } } while (0)
#ifdef ATT_NO_ASM
#define ATT_KLOAD(kvb_) do { const GAS unsigned char* kb_ = (kvb_); _Pragma("unroll") for (int T = 0; T < 16; ++T) ka[T] = *(const GAS v4u*)(kb_ + koff[T]); } while (0)
#define ATT_KWAIT(n_, T0_) do {} while (0)
#else
#define ATT_KLOAD(kvb_) do { const GAS unsigned char* kb_ = (kvb_); _Pragma("unroll") for (int T = 0; T < 16; ++T) { \
        asm volatile("global_load_dwordx4 %0, %1, %2" : "=&v"(ka[T]) : "v"(koff[T]), "s"(kb_) : "memory"); } } while (0)
#define ATT_KWAIT(n_, T0_) asm volatile("s_waitcnt vmcnt(" #n_ ")" : "+v"(ka[T0_]), "+v"(ka[T0_ + 1]), "+v"(ka[T0_ + 2]), "+v"(ka[T0_ + 3]), "+v"(ka[T0_ + 4]), "+v"(ka[T0_ + 5]), "+v"(ka[T0_ + 6]), "+v"(ka[T0_ + 7]) :: "memory")
#endif
    { const int tok0 = vcu * 256 + F.wave; const GAS v4u* ip = (const GAS v4u*)(IDX + (size_t)tok0 * 256 + 16 * m); ni0 = ip[0]; ni1 = ip[1];
      nq = *(const GAS v4u*)(Q8 + (size_t)tok0 * D + m * 64 + 16 * g);
      ATT_KOFF(ni0, ni1); ATT_KLOAD(KV8 + (size_t)(tok0 >> 11) * SEQ * 128); }
    for (int it = 0; it < 32; ++it) {
        const int tok = vcu * 256 + F.wave + 8 * it, b = tok >> 11, tq = tok & (SEQ - 1);
        const int n_valid = (((tq >> 6) + 1) * 64) < 256 ? ((tq >> 6) + 1) * 64 : 256;
        const v4u qv = nq;
        const fp8x8 qf0 = (fp8x8)(((unsigned long long)qv.y << 32) | qv.x), qf1 = (fp8x8)(((unsigned long long)qv.w << 32) | qv.z);
        const GAS unsigned char* kvb = KV8 + (size_t)b * SEQ * 128;
        f32x4 S[16];
#pragma unroll
        for (int T = 0; T < 16; ++T) {
            if (T == 0) ATT_KWAIT(8, 0);
            if (T == 8) ATT_KWAIT(0, 8);
            const unsigned bkt = BK[(koff[T] >> 7) + (2047 - tq)];
            const v4u oh = *(const LAS v4u*)(OH + bkt * 64 + g * 16);
            f32x4 ab = (f32x4){0.f, 0.f, 0.f, 0.f}, a = (f32x4){0.f, 0.f, 0.f, 0.f};
            ab = __builtin_amdgcn_mfma_f32_16x16x32_bf16(__builtin_bit_cast(bf16x8, oh), bb, ab, 0, 0, 0);
            a = __builtin_amdgcn_mfma_f32_16x16x32_fp8_fp8((fp8x8)(((unsigned long long)ka[T].y << 32) | ka[T].x), qf0, a, 0, 0, 0);
            a = __builtin_amdgcn_mfma_f32_16x16x32_fp8_fp8((fp8x8)(((unsigned long long)ka[T].w << 32) | ka[T].z), qf1, a, 0, 0, 0);
            a = a + ab;
            S[T] = a;
        }
        __builtin_amdgcn_sched_barrier(0);
        v4u vv[16];
#pragma unroll
        for (int T = 0; T < 16; ++T) vv[T] = *(const GAS v4u*)(kvb + koff[T] + 64);
        if (n_valid < 256) {
#pragma unroll
            for (int T = 0; T < 16; ++T)
#pragma unroll
                for (int i = 0; i < 4; ++i) if (16 * (4 * g + i) + T >= n_valid) S[T][i] = -1e30f;
        }
        float mx = -3.0e38f;
#pragma unroll
        for (int T = 0; T < 16; ++T) { asm("v_max3_f32 %0, %1, %2, %0" : "+v"(mx) : "v"(S[T][0]), "v"(S[T][1])); asm("v_max3_f32 %0, %1, %2, %0" : "+v"(mx) : "v"(S[T][2]), "v"(S[T][3])); }
        mx = fmaxf(mx, lane_xor(mx, 16, lane)); mx = fmaxf(mx, lane_xor(mx, 32, lane));
        constexpr float SC = 1.4426950408889634f * 0.125f;
        const float mneg = 8.0f - mx * SC;
#pragma unroll
        for (int T = 0; T < 16; ++T)
#pragma unroll
            for (int i = 0; i < 4; ++i) S[T][i] = __builtin_amdgcn_exp2f(S[T][i] * SC + mneg);
        { const int tokn = vcu * 256 + F.wave + 8 * (it < 31 ? it + 1 : it); const GAS v4u* ip = (const GAS v4u*)(IDX + (size_t)tokn * 256 + 16 * m); ni0 = ip[0]; ni1 = ip[1];
          nq = *(const GAS v4u*)(Q8 + (size_t)tokn * D + m * 64 + 16 * g); }
        f32x4 O[4], Osum = (f32x4){0.f, 0.f, 0.f, 0.f};
#pragma unroll
        for (int c = 0; c < 4; ++c) O[c] = (f32x4){0.f, 0.f, 0.f, 0.f};
#pragma unroll
        for (int ks = 0; ks < 8; ++ks) {
#pragma unroll
            for (int tt = 0; tt < 2; ++tt) { const unsigned rr = 8 * (m >> 2) + 4 * tt + (m & 3), fr = ((rr >> 2) & 3u) ^ ((rr >> 1) & 1u);
                *(LAS v4u*)(vst + rr * 64u + 16u * ((unsigned)g ^ fr)) = vv[2 * ks + tt]; }
            int p0 = __builtin_amdgcn_cvt_pk_fp8_f32(S[2 * ks][0], S[2 * ks][1], 0, false); p0 = __builtin_amdgcn_cvt_pk_fp8_f32(S[2 * ks][2], S[2 * ks][3], p0, true);
            int p1 = __builtin_amdgcn_cvt_pk_fp8_f32(S[2 * ks + 1][0], S[2 * ks + 1][1], 0, false); p1 = __builtin_amdgcn_cvt_pk_fp8_f32(S[2 * ks + 1][2], S[2 * ks + 1][3], p1, true);
            const fp8x8 pf = (fp8x8)(((unsigned long long)(unsigned)p1 << 32) | (unsigned)p0);
            v2u f[4];
            asm volatile("s_waitcnt lgkmcnt(0)\n\t"
                         "ds_read_b64_tr_b8 %0, %4\n\tds_read_b64_tr_b8 %1, %5\n\tds_read_b64_tr_b8 %2, %6\n\tds_read_b64_tr_b8 %3, %7\n\t"
                         "s_waitcnt lgkmcnt(0)"
                         : "=&v"(f[0]), "=&v"(f[1]), "=&v"(f[2]), "=&v"(f[3])
                         : "v"(vbase + tra[0]), "v"(vbase + tra[1]), "v"(vbase + tra[2]), "v"(vbase + tra[3])
                         : "memory");
#pragma unroll
            for (int c = 0; c < 4; ++c) O[c] = __builtin_amdgcn_mfma_f32_16x16x32_fp8_fp8((fp8x8)(((unsigned long long)f[c].y << 32) | f[c].x), pf, O[c], 0, 0, 0);
            Osum = __builtin_amdgcn_mfma_f32_16x16x32_fp8_fp8(aones, pf, Osum, 0, 0, 0);
        }
        const float inv = 1.0f / lane_get(Osum[0], m);
#pragma unroll
        for (int c = 0; c < 4; ++c) { v2u w; w.x = pk2(O[c][0] * inv, O[c][1] * inv); w.y = pk2(O[c][2] * inv, O[c][3] * inv);
            *(GAS v2u*)(OB + (size_t)tok * D + m * 64 + 16 * c + 4 * g) = w; }
        { const int tokn = vcu * 256 + F.wave + 8 * (it < 31 ? it + 1 : it); ATT_KOFF(ni0, ni1); ATT_KLOAD(KV8 + (size_t)(tokn >> 11) * SEQ * 128); }
    }
    asm volatile("s_waitcnt vmcnt(0)" ::: "memory");
#undef ATT_KOFF
#undef ATT_KLOAD
#undef ATT_KWAIT
    }
}
constexpr int XCS = 136;
constexpr int HHS = 132;
__device__ __forceinline__ float gelu_tanh(float x) {
    const float z = 0.7978845608028654f * (x + 0.044715f * x * x * x);
    const float e = __builtin_amdgcn_exp2f(2.885390081777927f * z);
    const float th = 1.0f - 2.0f * __builtin_amdgcn_rcpf(e + 1.0f);
    return 0.5f * x * (1.0f + th);
}
template <bool DRY = false>
__device__ __forceinline__ void lru_phase(const Frame& F0, int L) {
    Frame F = launder(F0);
    const KArgs ka = kargs();
    const int b = F.bx >> 3, nb = F.bx & 7;
    const bf16* XR = (const bf16*)(F.ws + Z_XR); bf16* YR = (bf16*)(F.ws + Z_YR);
    const bf16* WL = (const bf16*)(F.ws + WS_W + W_LRU);
    LAS bf16* XC = (LAS bf16*)(F.lds + RING_OFF);
    LAS float* HH = (LAS float*)(F.lds + RING_OFF + 2 * 64 * XCS * 2);
    const int tid = F.tid, lane = F.lane, w = F.wave, g = lane >> 4, m = lane & 15;
    const int cc = tid & 15, tp = tid >> 4;
    const int ch0 = nb * 128 + 8 * cc;
    float cw[4][8], cbias[8];
#pragma unroll
    for (int j = 0; j < 4; ++j)
#pragma unroll
        for (int k = 0; k < 8; ++k) cw[j][k] = ka->in[I_CONVW][(size_t)L * 4 * D + j * D + ch0 + k];
#pragma unroll
    for (int k = 0; k < 8; ++k) cbias[k] = ka->in[I_CONVB][(size_t)L * D + ch0 + k];
    bf16x8 Br[4], Bi[4];
#pragma unroll
    for (int s = 0; s < 4; ++s) { Br[s] = *(const GAS bf16x8*)(WL + ((size_t)nb * 128 + 16 * w + m) * 128 + 32 * s + 8 * g);
                                  Bi[s] = *(const GAS bf16x8*)(WL + (size_t)8 * 128 * 128 + ((size_t)nb * 128 + 16 * w + m) * 128 + 32 * s + 8 * g); }
    const int chl = 16 * w + m, chg = nb * 128 + chl;
    const float ba = ka->in[I_LRUBA][(size_t)L * D + chg], bx = ka->in[I_LRUBX][(size_t)L * D + chg];
    const float lam = ka->in[I_LAM][(size_t)L * D + chg];
    const float sp8 = -8.0f * (fmaxf(-lam, 0.f) + log1pf(__expf(-fabsf(lam))));
    float carry = 0.f;
    const size_t rowb = (size_t)b * SEQ;
    v4u nxin[5], nyin[2];
#pragma unroll
    for (int k = 0; k < 5; ++k) { const int t = 2 * tp - 3 + k; v4u z; z.x = z.y = z.z = z.w = 0u; nxin[k] = (t >= 0) ? *(const GAS v4u*)(XR + (rowb + t) * D + ch0) : z; }
#pragma unroll
    for (int k = 0; k < 2; ++k) nyin[k] = *(const GAS v4u*)(YR + (rowb + 2 * tp + k) * D + ch0);
    for (int tile = 0; tile < 32; ++tile) {
        const int t0 = tile * 64, buf = tile & 1;
        LAS bf16* xc = XC + buf * 64 * XCS; LAS float* hh = HH + buf * 64 * HHS;
        v4u xin[5], yin[2];
#pragma unroll
        for (int k = 0; k < 5; ++k) xin[k] = nxin[k];
#pragma unroll
        for (int k = 0; k < 2; ++k) yin[k] = nyin[k];
        if (tile < 31) {
#pragma unroll
            for (int k = 0; k < 5; ++k) nxin[k] = *(const GAS v4u*)(XR + (rowb + t0 + 64 + 2 * tp - 3 + k) * D + ch0);
#pragma unroll
            for (int k = 0; k < 2; ++k) nyin[k] = *(const GAS v4u*)(YR + (rowb + t0 + 64 + 2 * tp + k) * D + ch0);
        }
#pragma unroll
        for (int k = 0; k < 2; ++k) { float o[8];
#pragma unroll
            for (int c = 0; c < 8; ++c) { float a = cbias[c];
#pragma unroll
                for (int j = 0; j < 4; ++j) { const unsigned wv = xin[k + j][c >> 1]; a += ((c & 1) ? bf_hi(wv) : bf_lo(wv)) * cw[j][c]; }
                o[c] = a; }
            v4u pw; pw.x = pk2(o[0], o[1]); pw.y = pk2(o[2], o[3]); pw.z = pk2(o[4], o[5]); pw.w = pk2(o[6], o[7]);
            *(LAS v4u*)(xc + (2 * tp + k) * XCS + 8 * cc) = pw; }
        __syncthreads();
#pragma unroll
        for (int mt = 0; mt < 4; ++mt) {
            f32x4 ar = (f32x4){0.f, 0.f, 0.f, 0.f}, ai = (f32x4){0.f, 0.f, 0.f, 0.f};
#pragma unroll
            for (int s = 0; s < 4; ++s) { const bf16x8 A = *(const LAS bf16x8*)(xc + (16 * mt + m) * XCS + 32 * s + 8 * g);
                ar = __builtin_amdgcn_mfma_f32_16x16x32_bf16(A, Br[s], ar, 0, 0, 0); ai = __builtin_amdgcn_mfma_f32_16x16x32_bf16(A, Bi[s], ai, 0, 0, 0); }
            float P[4], W[4];
#pragma unroll
            for (int i = 0; i < 4; ++i) {
                const float rr = sigmoidf_fast(ar[i] + ba), ig = sigmoidf_fast(ai[i] + bx);
                const float la = sp8 * rr;
                const float a = __builtin_amdgcn_exp2f(1.4426950408889634f * la);
                const float mult = __builtin_amdgcn_sqrtf(fmaxf(__builtin_fmaf(-a, a, 1.0f), 0.f));
                const float xv = __builtin_bit_cast(float, (unsigned)xc[(16 * mt + 4 * g + i) * XCS + chl] << 16);
                const float u = mult * (ig * xv);
                if (i == 0) { P[0] = a; W[0] = u; } else { P[i] = a * P[i - 1]; W[i] = a * W[i - 1] + u; }
            }
            float Ac = P[3], Uc = W[3];
            { const float A1 = lane_up(Ac, 16, lane), U1 = lane_up(Uc, 16, lane); if (g >= 1) { Uc = Ac * U1 + Uc; Ac = Ac * A1; } }
            { const float A2 = lane_up(Ac, 32, lane), U2 = lane_up(Uc, 32, lane); if (g >= 2) { Uc = Ac * U2 + Uc; Ac = Ac * A2; } }
            float Ae = lane_up(Ac, 16, lane), Ue = lane_up(Uc, 16, lane); if (g == 0) { Ae = 1.f; Ue = 0.f; }
            const float hin = Ae * carry + Ue;
            const float cnew = Ac * carry + Uc;
            carry = lane_get(cnew, 48 + m);
#pragma unroll
            for (int i = 0; i < 4; ++i) hh[(16 * mt + 4 * g + i) * HHS + chl] = P[i] * hin + W[i];
        }
        __syncthreads();
#pragma unroll
        for (int k = 0; k < 2; ++k) { const f32x4 h0 = *(const LAS f32x4*)(hh + (2 * tp + k) * HHS + 8 * cc), h1 = *(const LAS f32x4*)(hh + (2 * tp + k) * HHS + 8 * cc + 4);
            float o[8];
#pragma unroll
            for (int c = 0; c < 8; ++c) { const unsigned wv = yin[k][c >> 1]; const float y = (c & 1) ? bf_hi(wv) : bf_lo(wv); o[c] = (c < 4 ? h0[c] : h1[c - 4]) * gelu_tanh(y); }
            v4u pw; pw.x = pk2(o[0], o[1]); pw.y = pk2(o[2], o[3]); pw.z = pk2(o[4], o[5]); pw.w = pk2(o[6], o[7]);
            *(GAS v4u*)((DRY ? (bf16*)(F.ws + WS_NEED) : YR) + (rowb + t0 + 2 * tp + k) * D + ch0) = pw; }
    }
    __syncthreads();
}

struct MoeOrder : pg8::StaticOrder {
    const volatile LAS unsigned* tb; int tile0; const int* list; size_t bstride;
    __device__ __forceinline__ int expert_of(int gt) const { int e = 0;
#pragma unroll
        for (int k = 1; k < 8; ++k) e += (gt >= (int)tb[k]) ? 1 : 0;
        return e; }
    __device__ __forceinline__ const char* b_base(const pg8::Gemm& g, const pg8::Unit& u, size_t tstep) const { return (const char*)g.Bt + (size_t)expert_of(tile0 + u.pm) * bstride + (size_t)u.pn * tstep; }
};
struct MoeGatherOrder : MoeOrder {
    static constexpr bool GATHER = true;
    __device__ __forceinline__ const char* a_base(const pg8::Gemm& g, const pg8::Unit&, size_t) const { return (const char*)g.A; }
    __device__ __forceinline__ void a_rows(const pg8::Unit& u, int R0, int R1, int C0, int C1, int K, unsigned (&off)[2][2]) const {
        const int gt = tile0 + u.pm, e = expert_of(gt), j = gt - (int)tb[e], n = (int)tb[16 + e];
        const GAS int* le = (const GAS int*)list + (size_t)e * T_TOK;
#pragma unroll
        for (int h = 0; h < 2; ++h) { int p0 = 256 * j + 128 * h + R0, p1 = 256 * j + 128 * h + R1; p0 = p0 < n ? p0 : n - 1; p1 = p1 < n ? p1 : n - 1;
            off[h][0] = ((unsigned)le[p0] * (unsigned)K + (unsigned)C0) * 2u; off[h][1] = ((unsigned)le[p1] * (unsigned)K + (unsigned)C1) * 2u; }
    }
};
#ifdef SELFCHECK
#ifndef SC_TOL
#define SC_TOL 0.03f
#define SC_ABS 1e-5f
#endif
__device__ __forceinline__ float sc_bf(const bf16* p, size_t i) { return __builtin_bit_cast(float, (unsigned)((const GAS bf16*)p)[i] << 16); }
__device__ __forceinline__ float sc_f8(const unsigned char* p, size_t i) {
    const unsigned v = ((const GAS unsigned char*)p)[i]; const unsigned e = (v >> 3) & 15u, mn = v & 7u; float r;
    if (e == 0u) r = (float)mn * 0.001953125f; else r = (1.0f + (float)mn * 0.125f) * exp2f((float)e - 7.0f);
    return (v & 128u) ? -r : r; }
__device__ __forceinline__ void sc_fail(const Frame& F, unsigned code) { __hip_atomic_fetch_or(F.ctl + CW_CODE, code, RLX_AGENT); }
__device__ __forceinline__ int sc_bucket_ref(int rel) {
    const int half = 16, max_exact = 8; const int ret = rel > 0 ? half : 0; const int n = rel < 0 ? -rel : rel;
    const float nf = (float)(n > 1 ? n : 1);
    int large = max_exact + (int)(logf(nf / (float)max_exact) / logf(16.0f) * (float)(half - max_exact));
    large = large < half - 1 ? large : half - 1;
    return ret + (n < max_exact ? n : large);
}
__device__ __forceinline__ void selfcheck_topk(const Frame& F0) {
    Frame F = launder(F0);
    if (F.wave != 0) return;
    const bf16* QI = (const bf16*)(F.ws + Z_QI); const bf16* SM = (const bf16*)(F.ws + Z_SM);
    const GAS unsigned short* IDX = (const GAS unsigned short*)(F.ws + WS_IDX);
    LAS float* sc = (LAS float*)(F.lds + RING_OFF);
    LAS unsigned* bm = (LAS unsigned*)(F.lds + RING_OFF + 8192);
    const int tok = F.bx * 256 + ((F.bx * 37) & 255), b = tok >> 11, tq = tok & (SEQ - 1), n_adm = ((tq >> 6) + 1) * 64;
    const int lane = F.lane;
    bm[lane] = 0u;
    for (int s = lane; s < n_adm; s += 64) { float score = 0.f;
        for (int h = 0; h < 8; ++h) { float d = 0.f;
            for (int k = 0; k < 64; ++k) d += sc_bf(QI, (size_t)tok * 512 + h * 64 + k) * sc_bf(SM, (size_t)(b * SEQ + s) * 256 + 128 + k);
            score += fmaxf(d, 0.f) * sc_bf(SM, (size_t)tok * 256 + 192 + h); }
        sc[s] = score; }
    asm volatile("s_waitcnt lgkmcnt(0)" ::: "memory");
    const int nsel = n_adm < 256 ? n_adm : 256;
    float msel = 3.0e38f; bool bad = false;
    for (int p = lane; p < nsel; p += 64) { const int key = IDX[(size_t)tok * 256 + p]; if (key >= n_adm) { bad = true; continue; }
        const unsigned old = __hip_atomic_fetch_or(bm + (key >> 5), 1u << (key & 31), __ATOMIC_RELAXED, __HIP_MEMORY_SCOPE_WORKGROUP); if (old & (1u << (key & 31))) bad = true;
        msel = fminf(msel, sc[key]); }
    asm volatile("s_waitcnt lgkmcnt(0)" ::: "memory");
    float muns = -3.0e38f, amax = 0.f;
    for (int s = lane; s < n_adm; s += 64) { amax = fmaxf(amax, fabsf(sc[s])); if (!((bm[s >> 5] >> (s & 31)) & 1u)) muns = fmaxf(muns, sc[s]); }
#pragma unroll
    for (int o = 1; o < 64; o <<= 1) { msel = fminf(msel, lane_xor(msel, o, lane)); muns = fmaxf(muns, lane_xor(muns, o, lane)); amax = fmaxf(amax, lane_xor(amax, o, lane)); }
    if (muns > msel + 1e-4f * amax) bad = true;
    if (__any(bad)) { if (lane == 0) sc_fail(F, 1u); }
}
__device__ __forceinline__ void selfcheck_attn(const Frame& F0) {
    Frame F = launder(F0);
    if (F.wave != 0) return;
    const KArgs ka = kargs();
    const unsigned char* Q8 = F.ws + Z_Q8; const unsigned char* KV8 = F.ws + Z_KV8; const bf16* OB = (const bf16*)(F.ws + Z_XR);
    const GAS unsigned short* IDX = (const GAS unsigned short*)(F.ws + WS_IDX);
    LAS float* lg = (LAS float*)(F.lds + RING_OFF + 65536);
    const int tok = F.bx * 256 + ((F.bx * 37) & 255), b = tok >> 11, tq = tok & (SEQ - 1), n_adm = ((tq >> 6) + 1) * 64, nv = n_adm < 256 ? n_adm : 256;
    const int lane = F.lane;
    for (int p = lane; p < 256; p += 64) { const int key = IDX[(size_t)tok * 256 + p]; const int bk = sc_bucket_ref(key - tq);
        for (int h = 0; h < 16; ++h) { float d = 0.f;
            for (int k = 0; k < 64; ++k) d += sc_f8(Q8, (size_t)tok * D + h * 64 + k) * sc_f8(KV8, (size_t)(b * SEQ + key) * 128 + k);
            lg[h * 256 + p] = p < nv ? 0.125f * d + ((const GAS float*)ka->in[I_RELB])[bk * 16 + h] : -1e30f; } }
    asm volatile("s_waitcnt lgkmcnt(0)" ::: "memory");
    if (lane < 16) { float mx = -3.0e38f; for (int p = 0; p < 256; ++p) mx = fmaxf(mx, lg[lane * 256 + p]); float sum = 0.f;
        for (int p = 0; p < 256; ++p) { const float e = __expf(lg[lane * 256 + p] - mx); lg[lane * 256 + p] = e; sum += e; }
        const float inv = 1.f / sum; for (int p = 0; p < 256; ++p) lg[lane * 256 + p] *= inv; }
    asm volatile("s_waitcnt lgkmcnt(0)" ::: "memory");
    float emax = 0.f, omax = 0.f;
    for (int o = lane; o < 1024; o += 64) { const int h = o >> 6, d = o & 63; float acc = 0.f;
        for (int p = 0; p < 256; ++p) { const int key = IDX[(size_t)tok * 256 + p]; acc += lg[h * 256 + p] * sc_f8(KV8, (size_t)(b * SEQ + key) * 128 + 64 + d); }
        const float got = sc_bf(OB, (size_t)tok * D + o); emax = fmaxf(emax, fabsf(got - acc)); omax = fmaxf(omax, fabsf(acc)); }
#pragma unroll
    for (int o = 1; o < 64; o <<= 1) { emax = fmaxf(emax, lane_xor(emax, o, lane)); omax = fmaxf(omax, lane_xor(omax, o, lane)); }
    if (!(emax <= SC_TOL * omax + SC_ABS)) { if (lane == 0) sc_fail(F, 2u); }
}
__device__ __forceinline__ void selfcheck_lru(const Frame& F0, int L, bool after) {
    Frame F = launder(F0);
    if (F.wave != 0) return;
    const KArgs ka = kargs();
    const bf16* XR = (const bf16*)(F.ws + Z_XR); const bf16* YR = (const bf16*)(F.ws + Z_YR);
    GAS float* EXP = (GAS float*)(F.ws + WS_NEED) + (size_t)F.bx * SEQ;
    const int b = F.bx >> 3, ch = ((F.bx & 7) * 128 + ((F.bx * 29) & 127)), nb = ch >> 7, lane = F.lane;
    if (after) { float emax = 0.f, omax = 0.f;
        for (int t = lane; t < SEQ; t += 64) { const float e = EXP[t], g = sc_bf(YR, (size_t)(b * SEQ + t) * D + ch); emax = fmaxf(emax, fabsf(e - g)); omax = fmaxf(omax, fabsf(e)); }
#pragma unroll
        for (int o = 1; o < 64; o <<= 1) { emax = fmaxf(emax, lane_xor(emax, o, lane)); omax = fmaxf(omax, lane_xor(omax, o, lane)); }
        if (!(emax <= SC_TOL * omax + SC_ABS)) { if (lane == 0) sc_fail(F, 4u); }
        return; }
    const float* cw = ka->in[I_CONVW] + (size_t)L * 4 * D; const float* cb = ka->in[I_CONVB] + (size_t)L * D;
    const float* wa = ka->in[I_LRUWA] + ((size_t)L * 8 + nb) * 128 * 128; const float* wx = ka->in[I_LRUWX] + ((size_t)L * 8 + nb) * 128 * 128;
    const float lam = ka->in[I_LAM][(size_t)L * D + ch], ba = ka->in[I_LRUBA][(size_t)L * D + ch], bx = ka->in[I_LRUBX][(size_t)L * D + ch];
    const float sp = fmaxf(-lam, 0.f) + log1pf(expf(-fabsf(lam)));
    const int dl = ch & 127;
    float h = 0.f;
    for (int t = 0; t < SEQ; ++t) {
        float pr = 0.f, pi = 0.f, xcc = 0.f;
#pragma unroll
        for (int q = 0; q < 2; ++q) { const int cl = lane + 64 * q, cg = nb * 128 + cl; float xc = cb[cg];
            for (int j = 0; j < 4; ++j) { const int tt = t - 3 + j; if (tt >= 0) xc += sc_bf(XR, (size_t)(b * SEQ + tt) * D + cg) * cw[j * D + cg]; }
            pr += xc * wa[cl * 128 + dl]; pi += xc * wx[cl * 128 + dl]; if (cl == dl) xcc = xc; }
#pragma unroll
        for (int o = 1; o < 64; o <<= 1) { pr += lane_xor(pr, o, lane); pi += lane_xor(pi, o, lane); xcc += lane_xor(xcc, o, lane); }
        const float r = 1.f / (1.f + expf(-(pr + ba))), ig = 1.f / (1.f + expf(-(pi + bx)));
        const float la = -8.0f * r * sp, a = expf(la), u = sqrtf(-expm1f(2.0f * la)) * (ig * xcc);
        h = a * h + u;
        const float y = sc_bf(YR, (size_t)(b * SEQ + t) * D + ch);
        const float gl = 0.5f * y * (1.f + tanhf(0.7978845608028654f * (y + 0.044715f * y * y * y)));
        if (lane == 0) EXP[t] = h * gl;
    }
}
#endif
__global__ void __launch_bounds__(NWAVES * 64, 2) mk_fwd(Args args) {
    extern __shared__ __attribute__((aligned(16))) unsigned char lds[];
    Frame F;
    F.lds = (LAS unsigned char*)lds;
    F.MISC = (volatile LAS unsigned*)(F.lds + MISC_OFF);
    F.tid = threadIdx.x; F.lane = F.tid & 63; F.wave = __builtin_amdgcn_readfirstlane(F.tid >> 6);
    F.G = gridDim.x; F.bx = blockIdx.x;
    F.ws = args.ws; F.ctl = (gu32*)(args.ws + WS_CTL); F.out = args.out;
    for (int u = threadIdx.x; u < (LDS_BYTES - LDSCTL_OFF) / 4; u += NWAVES * 64) ((LAS unsigned*)(F.lds + LDSCTL_OFF))[u] = 0u;
    __syncthreads();
    XcdBarrier bar = xcd_barrier_post((unsigned*)(F.ctl + CW_BAR), F.MISC + 8);
#ifdef PROBE_XCC
    if ((blockIdx.x & 7u) != (bar.x & 7u)) { const unsigned long long t0 = __builtin_amdgcn_s_memrealtime(); while (__builtin_amdgcn_s_memrealtime() - t0 < 200000ull) __builtin_amdgcn_s_sleep(8); }
#endif
#define GRID_BAR() do { XcdBarrier b_ = bar; unsigned* p_ = bar.bar; asm volatile("" : "+s"(p_)); b_.bar = p_; xcd_barrier(b_); } while (0)
    float* X32 = args.out;
#define LOCAL_HANDOFF() do { asm volatile("s_waitcnt vmcnt(0)" ::: "memory"); __syncthreads(); __builtin_amdgcn_fence(__ATOMIC_ACQUIRE, "agent"); asm volatile("s_waitcnt vmcnt(0)" ::: "memory"); __syncthreads(); } while (0)
    LAS unsigned char* ring = F.lds + RING_OFF;
    using pg8::Gemm; using pg8::StaticOrder;

    for (int L = 0; L < DEPTH; ++L) {
        const int odd = L & 1;
#ifndef SK_P0
        p0_convert(F, L);
#endif
#ifdef DUP_P0
        __syncthreads(); p0_convert(F, L);
#endif
        GRID_BAR();
        { const Frame P = launder(F); unsigned char* ws = P.ws; unsigned char* wb = ws + WS_W; bf16* XB = (bf16*)(ws + WS_XB); (void)XB; (void)wb;
          Gemm g{XB, (const bf16*)(wb + W_IN), T_TOK, NIN, D}; StaticOrder S; S.init(T_TOK, NIN, P.G, P.bx);
          pg8::EpiZ E{(bf16*)(ws + Z_Q), (bf16*)(ws + Z_QI), (bf16*)(ws + Z_SM), ws + Z_Q8, ws + Z_KV8};
#ifndef SK_G1
          pg8::gemm_phase<pg8::EpiZ, StaticOrder>(ring, g, S, E, P.wave);
#endif
#ifdef DUP_G1
          pg8::gemm_phase<pg8::EpiZ, StaticOrder>(ring, g, S, E, P.wave);
#endif
        }
        GRID_BAR();
#if defined(SELFCHECK) && SELFCHECK == 3
        if (L == 0) { selfcheck_lru(F, L, false); __syncthreads(); }
#endif
#ifdef DUP_IDX
        indexer_phase<DUP_IDX>(F);
#endif
#ifndef SK_IDX
        indexer_phase(F);
#endif
#ifdef DUP_LRU
        lru_phase<true>(F, L);
#endif
#ifndef SK_LRU
        lru_phase(F, L);
#endif
        GRID_BAR();
#if defined(SELFCHECK) && SELFCHECK == 1
        if (L == 0) { selfcheck_topk(F); __syncthreads(); }
#endif
#if defined(SELFCHECK) && SELFCHECK == 3
        if (L == 0) { selfcheck_lru(F, L, true); __syncthreads(); }
#endif
#ifdef DUP_ATT
        attention_phase<DUP_ATT>(F); __syncthreads();
#endif
#ifndef SK_ATT
        attention_phase(F);
#endif
        GRID_BAR();
#if defined(SELFCHECK) && SELFCHECK == 2
        if (L == 0) { selfcheck_attn(F); __syncthreads(); }
#endif
        { const Frame P = launder(F); unsigned char* ws = P.ws; unsigned char* wb = ws + WS_W; bf16* XB = (bf16*)(ws + WS_XB); (void)XB; (void)wb;
          Gemm g{(const bf16*)(ws + Z_XR), (const bf16*)(wb + W_BRA), T_TOK, D, D}; StaticOrder S; S.init(T_TOK, D, F.G, F.bx);
          pg8::EpiGate<0> E{(bf16*)(ws + Z_GA), nullptr};
#ifndef SK_G2
          pg8::gemm_phase<pg8::EpiGate<0>, StaticOrder>(ring, g, S, E, P.wave);
#endif
        }
        LOCAL_HANDOFF();
        { const Frame P = launder(F); unsigned char* ws = P.ws; unsigned char* wb = ws + WS_W; bf16* XB = (bf16*)(ws + WS_XB); (void)XB; (void)wb;
          Gemm g{(const bf16*)(ws + Z_YR), (const bf16*)(wb + W_BRR), T_TOK, D, D}; StaticOrder S; S.init(T_TOK, D, F.G, F.bx);
          pg8::EpiGate<1> E{(bf16*)(ws + Z_GA), (const bf16*)(ws + Z_GR)};
#ifndef SK_G3
          pg8::gemm_phase<pg8::EpiGate<1>, StaticOrder>(ring, g, S, E, P.wave);
#endif
        }
        GRID_BAR();
        { const Frame P = launder(F); unsigned char* ws = P.ws; unsigned char* wb = ws + WS_W; bf16* XB = (bf16*)(ws + WS_XB); (void)XB; (void)wb;
          Gemm g{(const bf16*)(ws + Z_GA), (const bf16*)(wb + W_O), T_TOK, D, D}; StaticOrder S; S.init(T_TOK, D, F.G, F.bx);
          pg8::EpiBf16 E{(bf16*)(ws + Z_GR), D, 0};
#ifndef SK_G4
          pg8::gemm_phase<pg8::EpiBf16, StaticOrder>(ring, g, S, E, P.wave);
#endif
        }
        GRID_BAR();
#ifdef DUP_LN
        ln_phase<false, false, true>(F, L); ln_phase<false, false, true>(F, L);
#endif
#ifndef SK_LN
        if (odd) ln_phase<false, true>(F, L); else ln_phase<false, false>(F, L);
#endif
        GRID_BAR();
        if (odd) {
            if (launder(F).tid == 0) { unsigned acc = 0u; F.MISC[16] = 0u;
                for (int e = 0; e < 8; ++e) { const unsigned c = __hip_atomic_load(F.ctl + CW_CNT + (L >> 1) * 1024 + 64 * e, RLX_AGENT); F.MISC[32 + e] = c; acc += (c + 255u) >> 8; F.MISC[17 + e] = acc; } }
            __syncthreads();
        }
        { const Frame P = launder(F); unsigned char* ws = P.ws; unsigned char* wb = ws + WS_W; bf16* XB = (bf16*)(ws + WS_XB); (void)XB; (void)wb;
          Gemm g{(const bf16*)(ws + F_PB), (const bf16*)(wb + W_PP), T_TOK, D, PLE}; StaticOrder S; S.init(T_TOK, D, F.G, F.bx);
          pg8::EpiBf16 E{(bf16*)(ws + F_U), D, 0};
#ifndef SK_G5
          pg8::gemm_phase<pg8::EpiBf16, StaticOrder>(ring, g, S, E, P.wave);
#endif
        }
        LOCAL_HANDOFF();
        { const Frame P = launder(F); unsigned char* ws = P.ws; unsigned char* wb = ws + WS_W; bf16* XB = (bf16*)(ws + WS_XB); (void)XB; (void)wb;
          Gemm g{XB, (const bf16*)(wb + W_PG), T_TOK, D, D}; StaticOrder S; S.init(T_TOK, D, F.G, F.bx);
          pg8::EpiPle E{(bf16*)(ws + F_U)};
#ifndef SK_G6
          pg8::gemm_phase<pg8::EpiPle, StaticOrder>(ring, g, S, E, P.wave);
#endif
        }
        if (!odd) {
            { const Frame P = launder(F); unsigned char* ws = P.ws; unsigned char* wb = ws + WS_W; bf16* XB = (bf16*)(ws + WS_XB); (void)XB; (void)wb;
          Gemm g{XB, (const bf16*)(wb + W_FF), T_TOK, 2 * DFF, D}; StaticOrder S; S.init(T_TOK, 2 * DFF, F.G, F.bx);
              pg8::EpiSwiglu E{(bf16*)(ws + F_H), DFF};
#ifndef SK_G7
              pg8::gemm_phase<pg8::EpiSwiglu, StaticOrder>(ring, g, S, E, P.wave);
#endif
        }
            GRID_BAR();
            { const Frame P = launder(F); unsigned char* ws = P.ws; unsigned char* wb = ws + WS_W; bf16* XB = (bf16*)(ws + WS_XB); (void)XB; (void)wb;
          Gemm g{(const bf16*)(ws + F_H), (const bf16*)(wb + W_FF_DN_DENSE), T_TOK, D, DFF}; StaticOrder S; S.init(T_TOK, D, F.G, F.bx);
              pg8::EpiBf16 E{(bf16*)(ws + Z_GR), D, 0};
#ifndef SK_G8
              pg8::gemm_phase<pg8::EpiBf16, StaticOrder>(ring, g, S, E, P.wave);
#endif
        }
            GRID_BAR();
#ifndef SK_LN
            ln_phase<true, false>(F, L);
#endif
        } else {
            const int ntiles = (int)F.MISC[24];
            const int nchunks = (ntiles + MOE_CHUNK_TILES - 1) / MOE_CHUNK_TILES;
            for (int c = 0; c < nchunks; ++c) {
                const int tile0 = c * MOE_CHUNK_TILES, ntl = (ntiles - tile0) < MOE_CHUNK_TILES ? (ntiles - tile0) : MOE_CHUNK_TILES;
                const size_t hc_off = (c & 1) ? F_H1 : F_H;
                { const Frame P = launder(F); unsigned char* ws = P.ws; unsigned char* wb = ws + WS_W; bf16* XB = (bf16*)(ws + WS_XB); (void)XB; (void)wb;
          Gemm g{XB, (const bf16*)(wb + W_FF), ntl * 256, 2 * DFFE, D}; MoeGatherOrder S; S.init(ntl * 256, 2 * DFFE, F.G, F.bx);
                  S.tb = F.MISC + 16; S.tile0 = tile0; S.list = (const int*)(ws + WS_LIST); S.bstride = (size_t)2 * DFFE * D * 2;
                  pg8::EpiSwiglu E{(bf16*)(ws + hc_off), DFFE};
#ifndef SK_G9
                  pg8::gemm_phase<pg8::EpiSwiglu, MoeGatherOrder>(ring, g, S, E, P.wave);
#endif
        }
                GRID_BAR();
                { const Frame P = launder(F); unsigned char* ws = P.ws; unsigned char* wb = ws + WS_W; bf16* XB = (bf16*)(ws + WS_XB); (void)XB; (void)wb;
          Gemm g{(const bf16*)(ws + hc_off), (const bf16*)(wb + W_FF_DN_MOE), ntl * 256, D, DFFE}; MoeOrder S; S.init(ntl * 256, D, F.G, F.bx);
                  S.tb = F.MISC + 16; S.tile0 = tile0; S.list = nullptr; S.bstride = (size_t)D * DFFE * 2;
                  pg8::EpiBf16 E{(bf16*)(ws + F_YE), D, tile0 * 256};
#ifndef SK_G10
                  pg8::gemm_phase<pg8::EpiBf16, MoeOrder>(ring, g, S, E, P.wave);
#endif
        }
            }
            GRID_BAR();
#ifndef SK_LN
            ln_phase<true, true>(F, L);
#endif
        }
        GRID_BAR();
    }
    if (__hip_atomic_load(F.ctl + CW_BAR + XB_TMO, RLX_AGENT) != 0u || __hip_atomic_load(F.ctl + CW_CODE, RLX_AGENT) != 0u) {
        const float q = __builtin_nanf("");
        for (size_t i = (size_t)F.bx * 512 + launder(F).tid; i < (size_t)T_TOK * D; i += (size_t)F.G * 512) X32[i] = q;
    }
}

#if defined(SELFCHECK)
constexpr size_t WS_DRY_EXTRA = 4 * MiB;
#elif defined(DUP_LRU) || defined(DUP_LN)
constexpr size_t WS_DRY_EXTRA = 80 * MiB;
#else
constexpr size_t WS_DRY_EXTRA = 0;
#endif
extern "C" void kernel_launch(void* const* d_in, const int* in_sizes, int n_in, void* d_out, int out_size, void* d_ws, size_t ws_size, hipStream_t stream) {
    static int grid = 0;
    if (grid == 0) {
        if (n_in != 28 || out_size != T_TOK * D || ws_size < WS_NEED + WS_DRY_EXTRA) { fprintf(stderr, "kernel_launch: unexpected shapes: n_in %d out %d ws %zu (need %zu)\n", n_in, out_size, ws_size, (size_t)WS_END); grid = -1; return; }
        int dev = 0, cus = 0, per_cu = 0;
        if (hipGetDevice(&dev) != hipSuccess || hipDeviceGetAttribute(&cus, hipDeviceAttributeMultiprocessorCount, dev) != hipSuccess) { grid = -1; return; }
        if (hipFuncSetAttribute((const void*)mk_fwd, hipFuncAttributeMaxDynamicSharedMemorySize, LDS_BYTES) != hipSuccess) { fprintf(stderr, "kernel_launch: hipFuncSetAttribute failed\n"); grid = -1; return; }
        if (hipOccupancyMaxActiveBlocksPerMultiprocessor(&per_cu, (const void*)mk_fwd, NWAVES * 64, LDS_BYTES) != hipSuccess || per_cu < 1) { fprintf(stderr, "kernel_launch: occupancy query says %d blocks per CU\n", per_cu); }
        (void)hipGetLastError();
        grid = cus;
        if (grid != 256) { fprintf(stderr, "kernel_launch: this kernel needs a 256-CU device (got %d)\n", cus); grid = -1; return; }
    }
    if (grid < 0) return;
    if (hipMemsetAsync((char*)d_ws + WS_CTL, 0, CTL_ZERO_BYTES, stream) != hipSuccess) return;
    Args a{};
    for (int i = 0; i < 28; ++i) a.in[i] = (const float*)d_in[i];
    a.out = (float*)d_out; a.ws = (unsigned char*)d_ws;
    hipLaunchKernelGGL(mk_fwd, dim3(grid), dim3(NWAVES * 64), LDS_BYTES, stream, a);
}
```

```cpp
#include <hip/hip_runtime.h>
#include <cstdio>
#include <cstdint>

constexpr int T_TOK = 65536, D = 1024, SEQ = 2048, NBATCH = 32, DEPTH = 4;
constexpr int D_IN = 5832, NIN = 5888;
constexpr int DFF = 2816, DFFE = 3584, NEXP = 8, PLE = 256;
constexpr float LN_EPS = 1e-5f;
constexpr float DN_ALPHA = 1.681792830507429f;

namespace pg8 {
#define PG8_LAS __attribute__((address_space(3)))
typedef unsigned short bf16_t;
typedef short bf16x8 __attribute__((ext_vector_type(8)));
typedef float f32x4 __attribute__((ext_vector_type(4)));
typedef unsigned u32x4 __attribute__((ext_vector_type(4)));
typedef unsigned u32x2 __attribute__((ext_vector_type(2)));
constexpr int BM = 256, BK = 64, HALF = 128, HTB = HALF * BK * 2  , STAGE_BYTES = 8 * HTB, NXCD = 8, WGM = 8;

__host__ __device__ __forceinline__ int lds_byte(int r, int c) { const int st = (r >> 4) * 2 + (c >> 5), rr = r & 15, cc = c & 31, ob = rr * 64 + cc * 2; return st * 1024 + (ob ^ (((ob >> 9) & 1) << 5)); }
__host__ __device__ __forceinline__ void stage_rc(int b, int& R, int& C) { const int st = b / 1024, sb = b % 1024, swz = sb ^ (((sb >> 9) & 1) << 5); R = (st >> 1) * 16 + swz / 64; C = (st & 1) * 32 + (swz % 64) / 2; }
__host__ __device__ __forceinline__ int perm32(int rho) { const int n = rho >> 4, i = rho & 15; return 8 * (i >> 2) + 4 * n + (i & 3); }

struct Unit { int pm, pn; };
struct Gemm { const bf16_t* A; const bf16_t* Bt; int M, N, K; };

struct StaticOrder {
    static constexpr bool GATHER = false;
    int nM, nN, nwg, G, c;
    __host__ __device__ void init(int M, int N, int G_, int c_) { nM = M / BM; nN = N / BM; nwg = nM * nN; G = G_; c = c_; }
    __host__ __device__ bool next(int i, Unit& u) const {
        const long L = (long)i * G + c; if (L >= nwg) return false;
        int wgid = (int)L; { const int q = nwg / NXCD, r = nwg % NXCD, xcd = wgid % NXCD, off = wgid / NXCD; wgid = (xcd < r ? xcd * (q + 1) : r * (q + 1) + (xcd - r) * q) + off; }
        const int nig = WGM * nN, gid = wgid / nig, fm = gid * WGM, gsz = (nM - fm) < WGM ? (nM - fm) : WGM;
        u.pm = fm + ((wgid % nig) % gsz); u.pn = (wgid % nig) / gsz; return true;
    }
    __device__ __forceinline__ const char* a_base(const Gemm& g, const Unit& u, size_t tstep) const { return (const char*)g.A + (size_t)u.pm * tstep; }
    __device__ __forceinline__ const char* b_base(const Gemm& g, const Unit& u, size_t tstep) const { return (const char*)g.Bt + (size_t)u.pn * tstep; }
    __device__ __forceinline__ void a_rows(const Unit&, int, int, int, int, int, unsigned (&)[2][2]) const {}
    __device__ __forceinline__ void a_ready(const Unit&) const {}
    __device__ __forceinline__ void done(const Unit&) const {}
};

__device__ __forceinline__ unsigned cvt_pk_bf16(float lo, float hi) { unsigned r; asm volatile("v_cvt_pk_bf16_f32 %0, %1, %2" : "=v"(r) : "v"(lo), "v"(hi)); return r; }
__device__ __forceinline__ float bf_lo(unsigned w) { return __builtin_bit_cast(float, w << 16); }
__device__ __forceinline__ float bf_hi(unsigned w) { return __builtin_bit_cast(float, w & 0xffff0000u); }
__device__ __forceinline__ float sigmoidf_fast(float x) { return __builtin_amdgcn_rcpf(1.0f + __builtin_amdgcn_exp2f(-1.4426950408889634f * x)); }
#define EPI_FENCE() asm volatile("" ::: "memory")
#define EGAS __attribute__((address_space(1)))
__device__ __forceinline__ u32x4 pack8(const f32x4 v0, const f32x4 v1) { u32x4 w; w.x = cvt_pk_bf16(v0[0], v0[1]); w.y = cvt_pk_bf16(v0[2], v0[3]); w.z = cvt_pk_bf16(v1[0], v1[1]); w.w = cvt_pk_bf16(v1[2], v1[3]); return w; }

struct EpiBf16 {
    static constexpr bool PERM = true, AFTER_DRAIN = false;
    bf16_t* O; int ldc; int row_off;
    __device__ __forceinline__ void operator()(const f32x4 (&acc)[2][2][4][2], const Unit& u, int wr, int wc, int fr, int fq) const {
        { int l_ = (int)__builtin_amdgcn_mbcnt_hi(~0u, __builtin_amdgcn_mbcnt_lo(~0u, 0u)); asm volatile("" : "+v"(l_)); fr = l_ & 15; fq = l_ >> 4; }
        const int row0 = row_off + u.pm * BM + wr * 64 + fr, col0 = u.pn * BM + wc * 32 + 8 * fq;
#pragma unroll
        for (int ai = 0; ai < 2; ++ai)
#pragma unroll
            for (int m = 0; m < 4; ++m) { bf16_t* rowp = O + (size_t)(row0 + ai * HALF + m * 16) * ldc + col0;
#pragma unroll
                for (int bj = 0; bj < 2; ++bj) *(EGAS u32x4*)(rowp + bj * HALF) = pack8(acc[ai][bj][m][0], acc[ai][bj][m][1]); }
    }
};
__device__ __forceinline__ u32x2 pack8_fp8(const f32x4 v0, const f32x4 v1) { int a = __builtin_amdgcn_cvt_pk_fp8_f32(v0[0], v0[1], 0, false); a = __builtin_amdgcn_cvt_pk_fp8_f32(v0[2], v0[3], a, true);
    int b = __builtin_amdgcn_cvt_pk_fp8_f32(v1[0], v1[1], 0, false); b = __builtin_amdgcn_cvt_pk_fp8_f32(v1[2], v1[3], b, true); u32x2 r; r.x = (unsigned)a; r.y = (unsigned)b; return r; }
struct EpiZ {
    static constexpr bool PERM = true, AFTER_DRAIN = false;
    bf16_t* zbig; bf16_t* zqi; bf16_t* zsm; unsigned char* q8; unsigned char* kv8;
    __device__ __forceinline__ void operator()(const f32x4 (&acc)[2][2][4][2], const Unit& u, int wr, int wc, int fr, int fq) const {
        { int l_ = (int)__builtin_amdgcn_mbcnt_hi(~0u, __builtin_amdgcn_mbcnt_lo(~0u, 0u)); asm volatile("" : "+v"(l_)); fr = l_ & 15; fq = l_ >> 4; }
        const int row0 = u.pm * BM + wr * 64 + fr;
        if (u.pn < 4) {
            const int col0 = u.pn * BM + wc * 32 + 8 * fq;
#pragma unroll
            for (int ai = 0; ai < 2; ++ai)
#pragma unroll
                for (int m = 0; m < 4; ++m) { unsigned char* rowp = q8 + (size_t)(row0 + ai * HALF + m * 16) * D + col0;
#pragma unroll
                    for (int bj = 0; bj < 2; ++bj) *(EGAS u32x2*)(rowp + bj * HALF) = pack8_fp8(acc[ai][bj][m][0], acc[ai][bj][m][1]); }
            return;
        }
        bf16_t* base; int ld, colt;
        if (u.pn < 20) { base = zbig + (size_t)(u.pn >> 2) * ((size_t)T_TOK * D); ld = D; colt = (u.pn & 3) * BM; }
        else if (u.pn < 22) { base = zqi; ld = 512; colt = (u.pn - 20) * BM; }
        else { base = zsm; ld = 256; colt = 0; }
        const int col0 = colt + wc * 32 + 8 * fq;
#pragma unroll
        for (int ai = 0; ai < 2; ++ai)
#pragma unroll
            for (int m = 0; m < 4; ++m) { bf16_t* rowp = base + (size_t)(row0 + ai * HALF + m * 16) * ld + col0;
#pragma unroll
                for (int bj = 0; bj < 2; ++bj) *(EGAS u32x4*)(rowp + bj * HALF) = pack8(acc[ai][bj][m][0], acc[ai][bj][m][1]); }
        if (u.pn == 22) {
#pragma unroll
            for (int ai = 0; ai < 2; ++ai)
#pragma unroll
                for (int m = 0; m < 4; ++m) *(EGAS u32x2*)(kv8 + (size_t)(row0 + ai * HALF + m * 16) * 128 + wc * 32 + 8 * fq) = pack8_fp8(acc[ai][0][m][0], acc[ai][0][m][1]);
        }
    }
};
template <int MODE> struct EpiGate {
    static constexpr bool PERM = true, AFTER_DRAIN = false;
    bf16_t* G; const bf16_t* G2;
    __device__ __forceinline__ void operator()(const f32x4 (&acc)[2][2][4][2], const Unit& u, int wr, int wc, int fr, int fq) const {
        { int l_ = (int)__builtin_amdgcn_mbcnt_hi(~0u, __builtin_amdgcn_mbcnt_lo(~0u, 0u)); asm volatile("" : "+v"(l_)); fr = l_ & 15; fq = l_ >> 4; }
        const int row0 = u.pm * BM + wr * 64 + fr, col0 = u.pn * BM + wc * 32 + 8 * fq;
#pragma unroll
        for (int ai = 0; ai < 2; ++ai) {
            u32x4 gw[4][2], g2[4][2];
#pragma unroll
            for (int m = 0; m < 4; ++m)
#pragma unroll
                for (int bj = 0; bj < 2; ++bj) { const size_t o = (size_t)(row0 + ai * HALF + m * 16) * D + col0 + bj * HALF;
                    gw[m][bj] = *(const EGAS u32x4*)(G + o); if (MODE == 1) g2[m][bj] = *(const EGAS u32x4*)(G2 + o); }
#pragma unroll
            for (int m = 0; m < 4; ++m)
#pragma unroll
                for (int bj = 0; bj < 2; ++bj) { const size_t o = (size_t)(row0 + ai * HALF + m * 16) * D + col0 + bj * HALF;
                    f32x4 v0 = acc[ai][bj][m][0], v1 = acc[ai][bj][m][1];
#pragma unroll
                    for (int j = 0; j < 4; ++j) { const unsigned wa = gw[m][bj][j >> 1], wb = gw[m][bj][2 + (j >> 1)];
                        const float ga = (j & 1) ? bf_hi(wa) : bf_lo(wa), gb = (j & 1) ? bf_hi(wb) : bf_lo(wb);
                        if (MODE == 0) { v0[j] *= sigmoidf_fast(ga); v1[j] *= sigmoidf_fast(gb); }
                        else { const unsigned xa = g2[m][bj][j >> 1], xb = g2[m][bj][2 + (j >> 1)];
                            v0[j] = ga + v0[j] * sigmoidf_fast((j & 1) ? bf_hi(xa) : bf_lo(xa)); v1[j] = gb + v1[j] * sigmoidf_fast((j & 1) ? bf_hi(xb) : bf_lo(xb)); } }
                    *(EGAS u32x4*)(G + o) = pack8(v0, v1); }
            EPI_FENCE(); }
    }
};
template <int MODE> struct EpiRes {
    static constexpr bool PERM = true, AFTER_DRAIN = false;
    float* Y; const bf16_t* XB; const bf16_t* U;
    __device__ __forceinline__ void operator()(const f32x4 (&acc)[2][2][4][2], const Unit& u, int wr, int wc, int fr, int fq) const {
        { int l_ = (int)__builtin_amdgcn_mbcnt_hi(~0u, __builtin_amdgcn_mbcnt_lo(~0u, 0u)); asm volatile("" : "+v"(l_)); fr = l_ & 15; fq = l_ >> 4; }
        const int row0 = u.pm * BM + wr * 64 + fr, col0 = u.pn * BM + wc * 32 + 8 * fq;
#pragma unroll
        for (int ai = 0; ai < 2; ++ai) {
            u32x4 xw[4][2], uw[4][2];
#pragma unroll
            for (int m = 0; m < 4; ++m)
#pragma unroll
                for (int bj = 0; bj < 2; ++bj) { const size_t o = (size_t)(row0 + ai * HALF + m * 16) * D + col0 + bj * HALF;
                    xw[m][bj] = *(const EGAS u32x4*)(XB + o);
                    if (MODE == 1) uw[m][bj] = *(const EGAS u32x4*)(U + o); }
#pragma unroll
            for (int m = 0; m < 4; ++m)
#pragma unroll
                for (int bj = 0; bj < 2; ++bj) { const size_t o = (size_t)(row0 + ai * HALF + m * 16) * D + col0 + bj * HALF;
#pragma unroll
                    for (int n = 0; n < 2; ++n) { const f32x4 a = acc[ai][bj][m][n]; f32x4 r;
                        if (MODE == 0) { const unsigned x0 = xw[m][bj][2 * n], x1 = xw[m][bj][2 * n + 1];
                            r[0] = bf_lo(x0) * DN_ALPHA + a[0]; r[1] = bf_hi(x0) * DN_ALPHA + a[1]; r[2] = bf_lo(x1) * DN_ALPHA + a[2]; r[3] = bf_hi(x1) * DN_ALPHA + a[3]; }
                        else { const unsigned x0 = xw[m][bj][2 * n], x1 = xw[m][bj][2 * n + 1], w0 = uw[m][bj][2 * n], w1 = uw[m][bj][2 * n + 1];
                            r[0] = bf_lo(x0) * DN_ALPHA + bf_lo(w0) + a[0]; r[1] = bf_hi(x0) * DN_ALPHA + bf_hi(w0) + a[1];
                            r[2] = bf_lo(x1) * DN_ALPHA + bf_lo(w1) + a[2]; r[3] = bf_hi(x1) * DN_ALPHA + bf_hi(w1) + a[3]; }
                        *(EGAS f32x4*)(Y + o + 4 * n) = r; } }
            EPI_FENCE(); }
    }
};
struct EpiPle {
    static constexpr bool PERM = true, AFTER_DRAIN = false;
    bf16_t* U;
    __device__ __forceinline__ void operator()(const f32x4 (&acc)[2][2][4][2], const Unit& u, int wr, int wc, int fr, int fq) const {
        { int l_ = (int)__builtin_amdgcn_mbcnt_hi(~0u, __builtin_amdgcn_mbcnt_lo(~0u, 0u)); asm volatile("" : "+v"(l_)); fr = l_ & 15; fq = l_ >> 4; }
        const int row0 = u.pm * BM + wr * 64 + fr, col0 = u.pn * BM + wc * 32 + 8 * fq;
#pragma unroll
        for (int ai = 0; ai < 2; ++ai) {
            u32x4 uw[4][2];
#pragma unroll
            for (int m = 0; m < 4; ++m)
#pragma unroll
                for (int bj = 0; bj < 2; ++bj) uw[m][bj] = *(const EGAS u32x4*)(U + (size_t)(row0 + ai * HALF + m * 16) * D + col0 + bj * HALF);
#pragma unroll
            for (int m = 0; m < 4; ++m)
#pragma unroll
                for (int bj = 0; bj < 2; ++bj) { f32x4 v0 = acc[ai][bj][m][0], v1 = acc[ai][bj][m][1];
#pragma unroll
                    for (int j = 0; j < 4; ++j) { const unsigned wa = uw[m][bj][j >> 1], wb = uw[m][bj][2 + (j >> 1)];
                        v0[j] = sigmoidf_fast(v0[j]) * ((j & 1) ? bf_hi(wa) : bf_lo(wa)); v1[j] = sigmoidf_fast(v1[j]) * ((j & 1) ? bf_hi(wb) : bf_lo(wb)); }
                    *(EGAS u32x4*)(U + (size_t)(row0 + ai * HALF + m * 16) * D + col0 + bj * HALF) = pack8(v0, v1); }
            EPI_FENCE(); }
    }
};
struct EpiSwiglu {
    static constexpr bool PERM = true, AFTER_DRAIN = false;
    bf16_t* H; int ldh;
    __device__ __forceinline__ void operator()(const f32x4 (&acc)[2][2][4][2], const Unit& u, int wr, int wc, int fr, int fq) const {
        { int l_ = (int)__builtin_amdgcn_mbcnt_hi(~0u, __builtin_amdgcn_mbcnt_lo(~0u, 0u)); asm volatile("" : "+v"(l_)); fr = l_ & 15; fq = l_ >> 4; }
        const int row0 = u.pm * BM + wr * 64 + fr, col0 = u.pn * HALF + wc * 32 + 8 * fq;
#pragma unroll
        for (int ai = 0; ai < 2; ++ai)
#pragma unroll
            for (int m = 0; m < 4; ++m) { bf16_t* rowp = H + (size_t)(row0 + ai * HALF + m * 16) * ldh + col0;
                f32x4 v0, v1;
#pragma unroll
                for (int j = 0; j < 4; ++j) { const float g0 = acc[ai][0][m][0][j], g1 = acc[ai][0][m][1][j];
                    v0[j] = g0 * sigmoidf_fast(g0) * acc[ai][1][m][0][j]; v1[j] = g1 * sigmoidf_fast(g1) * acc[ai][1][m][1][j]; }
                *(EGAS u32x4*)rowp = pack8(v0, v1); }
    }
};
template <class Epi, class Sched, bool ALIGN_EPI = true>
__device__ __forceinline__ void gemm_phase(PG8_LAS unsigned char* lds, const Gemm g, const Sched& S, const Epi& E, const int wave_id) {
    int lane_ = (int)__builtin_amdgcn_mbcnt_hi(~0u, __builtin_amdgcn_mbcnt_lo(~0u, 0u)); asm volatile("" : "+v"(lane_));
    const int wid = wave_id, lane = lane_, tid = wid * 64 + lane, wr = wid >> 2, wc = wid & 3, fr = lane & 15, fq = lane >> 4;
    const int K = g.K, nt = K / BK;
    unsigned voffA[2], voffB[2]; int RA[2], CA[2];
#pragma unroll
    for (int i = 0; i < 2; ++i) { int R, C; stage_rc(tid * 16 + i * 8192, R, C); const int Rb = Epi::PERM ? ((R & ~31) + perm32(R & 31)) : R; RA[i] = R; CA[i] = C;
        voffA[i] = (unsigned)(R * K + C) * 2u; voffB[i] = (unsigned)(Rb * K + C) * 2u; }
    const size_t kstep = (size_t)(BK * 2);
    const size_t hstep = (size_t)HALF * K * 2;
    const size_t tstep = 2 * hstep;
    const unsigned ldsw = (unsigned)wid * 1024u;
    const int aoff = lds_byte(wr * 64 + fr, fq * 8), boff = lds_byte(wc * 32 + fr, fq * 8);
    unsigned offC[2][2] = {{0u, 0u}, {0u, 0u}}, offN[2][2] = {{0u, 0u}, {0u, 0u}};
#define PG8_SA(b, h) (((b) * 2 + (h)) * HTB)
#define PG8_SB(b, h) ((4 + (b) * 2 + (h)) * HTB)
#define PG8_STAGE(bufoff, gbase, voff) do { _Pragma("unroll") for (int _i = 0; _i < 2; ++_i) \
        __builtin_amdgcn_global_load_lds((const unsigned*)((const char*)(gbase) + (voff)[_i]), (PG8_LAS unsigned*)(lds + (bufoff) + ldsw + _i * 8192), 16, 0, 0); } while (0)
#define PG8_STA(bufoff, ptr, h, NX) do { if constexpr (Sched::GATHER) { _Pragma("unroll") for (int _i = 0; _i < 2; ++_i) { const unsigned _o = (NX) ? offN[h][_i] : offC[h][_i]; \
        __builtin_amdgcn_global_load_lds((const unsigned*)((const char*)(ptr) + _o), (PG8_LAS unsigned*)(lds + (bufoff) + ldsw + _i * 8192), 16, 0, 0); } } \
        else { PG8_STAGE(bufoff, (ptr) + (h) * hstep, voffA); } } while (0)
#define PG8_LDA(dst, b, h) do { _Pragma("unroll") for (int m = 0; m < 4; ++m) _Pragma("unroll") for (int k = 0; k < 2; ++k) dst[m][k] = *(const PG8_LAS bf16x8*)(lds + PG8_SA(b, h) + aoff + m * 2048 + k * 1024); } while (0)
#define PG8_LDB(dst, b, h) do { _Pragma("unroll") for (int n = 0; n < 2; ++n) _Pragma("unroll") for (int k = 0; k < 2; ++k) dst[n][k] = *(const PG8_LAS bf16x8*)(lds + PG8_SB(b, h) + boff + n * 2048 + k * 1024); } while (0)
#define PG8_MMA(ai, bj, At, Bt) do { __builtin_amdgcn_s_setprio(1); _Pragma("unroll") for (int m = 0; m < 4; ++m) _Pragma("unroll") for (int n = 0; n < 2; ++n) _Pragma("unroll") for (int k = 0; k < 2; ++k) \
        acc[ai][bj][m][n] = __builtin_amdgcn_mfma_f32_16x16x32_bf16(Bt[n][k], At[m][k], acc[ai][bj][m][n], 0, 0, 0); __builtin_amdgcn_s_setprio(0); } while (0)
#define PG8_WAIT_V(n) asm volatile("s_waitcnt vmcnt(" #n ")" ::: "memory")
#define PG8_WAIT_L(n) asm volatile("s_waitcnt lgkmcnt(" #n ")" ::: "memory")
#define PG8_BAR __builtin_amdgcn_s_barrier()
#define PG8_SCHED __builtin_amdgcn_sched_barrier(0)
#ifdef PROF_SEL
#ifndef PROF_KPH
#define PROF_KPH 0
#endif
#define PG8_PROF(slot) do { if (tid == 0) { volatile PG8_LAS unsigned* M_ = (volatile PG8_LAS unsigned*)(lds + 131392); const unsigned t_ = (unsigned)__builtin_amdgcn_s_memrealtime(); const unsigned c_ = (unsigned)__builtin_amdgcn_s_memtime(); if (PROF_KPH == 0 || M_[101] == PROF_KPH) { M_[64 + (slot)] += t_ - M_[97]; if ((slot) == 14) M_[104] += c_ - M_[103]; } M_[97] = t_; M_[103] = c_; } } while (0)
#else
#define PG8_PROF(slot) do { } while (0)
#endif
#ifdef PROF_SEL
#define PG8_WAIT_VT(n) do { unsigned long long a_, b_; asm volatile("s_memtime %0\n\ts_waitcnt vmcnt(" #n ")\n\ts_memtime %1\n\ts_waitcnt lgkmcnt(0)" : "=s"(a_), "=s"(b_) :: "memory"); if (tid == 0) { volatile PG8_LAS unsigned* M_ = (volatile PG8_LAS unsigned*)(lds + 131392); M_[105] += (unsigned)b_ - (unsigned)a_; } } while (0)
#else
#define PG8_WAIT_VT(n) PG8_WAIT_V(n)
#endif
    Unit cur, nxt; int ui = 0;
    if (!S.next(0, cur)) return;
    f32x4 acc[2][2][4][2];
#pragma unroll
    for (int a = 0; a < 2; ++a)
#pragma unroll
        for (int b = 0; b < 2; ++b)
#pragma unroll
            for (int m = 0; m < 4; ++m)
#pragma unroll
                for (int n = 0; n < 2; ++n) acc[a][b][m][n] = (f32x4){0.f, 0.f, 0.f, 0.f};
    bf16x8 At[4][2], B0[2][2], B1[2][2];
    const char* cA = S.a_base(g, cur, tstep); const char* cB = S.b_base(g, cur, tstep);
    if constexpr (Sched::GATHER) S.a_rows(cur, RA[0], RA[1], CA[0], CA[1], K, offC);
    S.a_ready(cur);
    PG8_STAGE(PG8_SB(0, 0), cB, voffB); PG8_STAGE(PG8_SB(0, 1), cB + hstep, voffB); PG8_STA(PG8_SA(0, 0), cA, 0, false); PG8_STA(PG8_SA(0, 1), cA, 1, false);
    if (wr == 1) PG8_BAR;
    PG8_WAIT_V(2); PG8_BAR;
    PG8_STAGE(PG8_SB(1, 0), cB + kstep, voffB); PG8_STA(PG8_SA(1, 0), cA + kstep, 0, false); PG8_STAGE(PG8_SB(1, 1), cB + hstep + kstep, voffB);
    PG8_WAIT_V(6); PG8_BAR;
    PG8_PROF(17);
    for (;;) {
        const bool has_next = S.next(ui + 1, nxt);
        const char* nA = has_next ? S.a_base(g, nxt, tstep) : cA; const char* nB = has_next ? S.b_base(g, nxt, tstep) : cB;
        if constexpr (Sched::GATHER) { if (has_next) S.a_rows(nxt, RA[0], RA[1], CA[0], CA[1], K, offN); else {
#pragma unroll
            for (int h = 0; h < 2; ++h)
#pragma unroll
                for (int i = 0; i < 2; ++i) offN[h][i] = offC[h][i]; } }
        for (int t = 0; t < nt; t += 2) {
            const bool last = (t == nt - 2);
            const char* a1 = cA + (size_t)(t + 1) * kstep;
            const char* a2 = last ? nA : cA + (size_t)(t + 2) * kstep; const char* b2 = last ? nB : cB + (size_t)(t + 2) * kstep;
            const char* a3 = a2 + kstep; const char* b3 = b2 + kstep;
            if (last && has_next) S.a_ready(nxt);
            PG8_LDB(B0, 0, 0); PG8_LDB(B1, 0, 1); PG8_SCHED; PG8_LDA(At, 0, 0); PG8_STA(PG8_SA(1, 1), a1, 1, false);
            PG8_WAIT_VT(8); PG8_WAIT_L(0); PG8_BAR; PG8_MMA(0, 0, At, B0); PG8_MMA(0, 1, At, B1); PG8_BAR; PG8_SCHED;
            PG8_LDA(At, 0, 1); PG8_STAGE(PG8_SB(0, 0), b2, voffB); PG8_STAGE(PG8_SB(0, 1), b2 + hstep, voffB); PG8_STA(PG8_SA(0, 0), a2, 0, last);
            PG8_WAIT_VT(8); PG8_WAIT_L(0); PG8_BAR; PG8_MMA(1, 0, At, B0); PG8_MMA(1, 1, At, B1); PG8_BAR; PG8_SCHED;
            PG8_LDB(B0, 1, 0); PG8_LDB(B1, 1, 1); PG8_SCHED; PG8_LDA(At, 1, 0); PG8_STA(PG8_SA(0, 1), a2, 1, last);
            PG8_WAIT_VT(8); PG8_WAIT_L(0); PG8_BAR; PG8_MMA(0, 0, At, B0); PG8_MMA(0, 1, At, B1); PG8_BAR; PG8_SCHED;
            PG8_LDA(At, 1, 1); PG8_STAGE(PG8_SB(1, 0), b3, voffB); PG8_STAGE(PG8_SB(1, 1), b3 + hstep, voffB); PG8_STA(PG8_SA(1, 0), a3, 0, last);
            PG8_WAIT_VT(8); PG8_WAIT_L(0); PG8_BAR; PG8_MMA(1, 0, At, B0); PG8_MMA(1, 1, At, B1); PG8_BAR; PG8_SCHED;
        }
        if constexpr (ALIGN_EPI) { if (wr == 0) PG8_BAR; }
        PG8_PROF(14);
        E(acc, cur, wr, wc, fr, fq); S.done(cur);
        PG8_PROF(15);
        if (!has_next) break;
#pragma unroll
        for (int a = 0; a < 2; ++a)
#pragma unroll
            for (int b = 0; b < 2; ++b)
#pragma unroll
                for (int m = 0; m < 4; ++m)
#pragma unroll
                    for (int n = 0; n < 2; ++n) acc[a][b][m][n] = (f32x4){0.f, 0.f, 0.f, 0.f};
        cur = nxt; cA = nA; cB = nB; ++ui;
        if constexpr (Sched::GATHER) {
#pragma unroll
            for (int h = 0; h < 2; ++h)
#pragma unroll
                for (int i = 0; i < 2; ++i) offC[h][i] = offN[h][i]; }
        if constexpr (ALIGN_EPI) { if (wr == 1) PG8_BAR; }
    }
    PG8_WAIT_V(0);
    if constexpr (!ALIGN_EPI) { if (wr == 0) PG8_BAR; }
    PG8_BAR;
#undef PG8_PROF
#undef PG8_WAIT_VT
#undef PG8_SA
#undef PG8_SB
#undef PG8_STAGE
#undef PG8_STA
#undef PG8_LDA
#undef PG8_LDB
#undef PG8_MMA
#undef PG8_WAIT_V
#undef PG8_WAIT_L
#undef PG8_BAR
#undef PG8_SCHED
}
}
constexpr int NWAVES = 8;
constexpr size_t MiB = 1u << 20;
constexpr size_t WS_CTL = 0, CTL_ZERO_BYTES = 1 * MiB;
constexpr size_t WS_ROUTE = 1 * MiB;
constexpr size_t WS_LIST = 3 * MiB;
constexpr size_t WS_W = 8 * MiB;
constexpr size_t W_IN = 0, W_BRA = 12 * MiB, W_BRR = 14 * MiB, W_O = 16 * MiB, W_PG = 18 * MiB, W_PP = 20 * MiB, W_LRU = 21 * MiB, W_FF = 22 * MiB;
constexpr size_t W_FF_DN_DENSE = W_FF + 11 * MiB, W_FF_DN_MOE = W_FF + 112 * MiB;
constexpr size_t WS_XB = 208 * MiB;
constexpr size_t WS_IDX = 336 * MiB;
constexpr size_t WS_Z = 368 * MiB;
constexpr size_t Z_Q = WS_Z, Z_XR = WS_Z + 128 * MiB, Z_YR = WS_Z + 256 * MiB, Z_GA = WS_Z + 384 * MiB, Z_GR = WS_Z + 512 * MiB, Z_QI = WS_Z + 640 * MiB, Z_SM = WS_Z + 704 * MiB;
constexpr size_t Z_Q8 = Z_Q, Z_KV8 = Z_Q + 64 * MiB;
constexpr size_t WS_END = WS_Z + 736 * MiB;
constexpr size_t F_U = Z_Q;
constexpr size_t F_PB = Z_SM;
constexpr size_t F_H = Z_XR;
constexpr size_t F_H1 = WS_END;
constexpr size_t F_YE = Z_GA;
constexpr int MOE_CHUNK_TILES = 128;
constexpr size_t F_H_CHUNK_BYTES = (size_t)MOE_CHUNK_TILES * 256 * DFFE * 2;
constexpr size_t WS_NEED = F_H1 + F_H_CHUNK_BYTES;
static_assert(F_H + F_H_CHUNK_BYTES <= F_YE && F_YE + (size_t)520 * 256 * D * 2 <= Z_SM && F_H + (size_t)T_TOK * DFF * 2 <= Z_GR, "overlay map");
constexpr int CW_TMO = 0, CW_CODE = 1, CW_BAR = 4096, CW_CNT = 16384;
constexpr int RING_OFF = 0, RING_BYTES = 131072;
constexpr int LDSCTL_OFF = RING_BYTES, MISC_OFF = LDSCTL_OFF + 320;
constexpr int LDS_BYTES = 147456;

#define GAS __attribute__((address_space(1)))
#define LAS __attribute__((address_space(3)))
typedef unsigned short bf16;
typedef unsigned v4u __attribute__((ext_vector_type(4)));
typedef unsigned v2u __attribute__((ext_vector_type(2)));
typedef float f32x4 __attribute__((ext_vector_type(4)));
typedef float f32x16 __attribute__((ext_vector_type(16)));
typedef short bf16x8 __attribute__((ext_vector_type(8)));
typedef GAS unsigned gu32;
#define RLX_AGENT __ATOMIC_RELAXED, __HIP_MEMORY_SCOPE_AGENT
#define LDS_WAIT() asm volatile("s_waitcnt lgkmcnt(0)" ::: "memory")
#define VM_WAIT() asm volatile("s_waitcnt vmcnt(0)" ::: "memory")
using pg8::cvt_pk_bf16; using pg8::bf_lo; using pg8::bf_hi; using pg8::sigmoidf_fast;
#define XB_TMO      128
#define XB_XCNT(j)  (256  + 64 * (j))
#define XB_XSUB(j)  (1280 + 64 * (j))
#define XB_XGEN(j)  (2304 + 64 * (j))
#define XB_TOP      3328
#define XB_TOPGEN   3392
#define XCD_BAR_WORDS 3456
#define XB_SPIN_CAP (1u << 21)

__device__ __forceinline__ unsigned xb_ld(unsigned* p)              { return __hip_atomic_load(p, __ATOMIC_RELAXED, __HIP_MEMORY_SCOPE_AGENT); }
__device__ __forceinline__ unsigned xb_add(unsigned* p, unsigned v) { return __hip_atomic_fetch_add(p, v, __ATOMIC_RELAXED, __HIP_MEMORY_SCOPE_AGENT); }
__device__ __forceinline__ unsigned xb_xcc_id() { return (unsigned)__builtin_amdgcn_s_getreg((3 << 11) | 20) & 0xFu; }
#define XB_SPIN(cond, bar) do { unsigned _sp = 0; while (cond) { __builtin_amdgcn_s_sleep(1); \
    if ((++_sp & 255u) == 0u) { if (xb_ld(&(bar)[XB_TMO])) break; if (_sp > XB_SPIN_CAP) { atomicAdd(&(bar)[XB_TMO], 1u); break; } } } } while (0)

struct XcdBarrier {
    unsigned* bar; unsigned x;
    volatile LAS unsigned* st;
};

__device__ __forceinline__ XcdBarrier xcd_barrier_post(unsigned* bar, volatile LAS unsigned* st) {
    XcdBarrier b; b.bar = bar; b.x = xb_xcc_id(); b.st = st;
    if (threadIdx.x == 0) (void)xb_add(&bar[XB_XCNT(b.x)], 1u);
    return b;
}
__device__ __forceinline__ void xcd_barrier_complete(unsigned* bar, unsigned x, unsigned& nloc, unsigned& nx) {
    const unsigned G = gridDim.x * gridDim.y * gridDim.z;
    unsigned sum, cnt, mine, sp = 0u;
    for (;;) {
        sum = 0u; cnt = 0u; mine = 0u;
#pragma unroll
        for (unsigned j = 0; j < 16; ++j) { const unsigned c = xb_ld(&bar[XB_XCNT(j)]); sum += c; cnt += (c > 0u) ? 1u : 0u; mine = (j == x) ? c : mine; }
        if (sum == G) break;
        __builtin_amdgcn_s_sleep(1);
        if ((++sp & 255u) == 0u) { if (xb_ld(&bar[XB_TMO])) break; if (sp > XB_SPIN_CAP) { atomicAdd(&bar[XB_TMO], 1u); break; } }
    }
    nloc = mine > 0u ? mine : 1u; nx = cnt > 0u ? cnt : 1u;
}

__device__ __forceinline__ void xcd_barrier(const XcdBarrier& b) {
    asm volatile("s_waitcnt vmcnt(0)" ::: "memory");
    __syncthreads();
    if (threadIdx.x == 0) {
        unsigned* bar = b.bar;
        __builtin_amdgcn_s_waitcnt(0);
        unsigned nloc = b.st[0], nx = b.st[1];
        if (nloc == 0u) { xcd_barrier_complete(bar, b.x, nloc, nx); b.st[0] = nloc; b.st[1] = nx; }
        const unsigned old = xb_add(&bar[XB_XSUB(b.x)], 1u);
        const unsigned gen = old / nloc;
        if (old + 1u == (gen + 1u) * nloc) {
            __builtin_amdgcn_fence(__ATOMIC_RELEASE, "agent");
            asm volatile("s_waitcnt vmcnt(0)" ::: "memory");
            const unsigned og = xb_add(&bar[XB_TOP], 1u);
            const unsigned tg = og / nx;
            if (og + 1u == (tg + 1u) * nx) xb_add(&bar[XB_TOPGEN], 1u);
            else XB_SPIN(xb_ld(&bar[XB_TOPGEN]) == tg, bar);
            __builtin_amdgcn_fence(__ATOMIC_ACQUIRE, "agent");
            xb_add(&bar[XB_XGEN(b.x)], 1u);
            asm volatile("s_waitcnt vmcnt(0)" ::: "memory");
        } else {
            XB_SPIN(xb_ld(&bar[XB_XGEN(b.x)]) == gen, bar);
            __builtin_amdgcn_fence(__ATOMIC_ACQUIRE, "agent");
            asm volatile("s_waitcnt vmcnt(0)" ::: "memory");
        }
    }
    __syncthreads();
}
struct Frame {
    LAS unsigned char* lds;
    volatile LAS unsigned* MISC;
    gu32* ctl;
    int tid, lane, wave, G, bx;
    unsigned char* ws;
    float* out;
};
struct Args { const float* in[28]; float* out; unsigned char* ws; };
typedef const __attribute__((address_space(4))) Args* KArgs;
__device__ __forceinline__ KArgs kargs() { KArgs k = (KArgs)__builtin_amdgcn_kernarg_segment_ptr(); asm volatile("" : "+s"(k)); return k; }
enum { I_X = 0, I_P, I_WIN, I_CONVW, I_CONVB, I_LRUWA, I_LRUBA, I_LRUWX, I_LRUBX, I_LAM, I_WBRA, I_WBRR, I_WO, I_RELB, I_LN1G, I_LN1B, I_FFG, I_FFU, I_FFD, I_ROUTER, I_ROUTERB, I_MOEG, I_MOEU, I_MOED, I_PLEG, I_PLEP, I_LN2G, I_LN2B };

__device__ __forceinline__ Frame launder(const Frame& F0) { Frame F = F0; unsigned char* w = F0.ws; int l = (int)__builtin_amdgcn_mbcnt_hi(~0u, __builtin_amdgcn_mbcnt_lo(~0u, 0u)); asm volatile("" : "+s"(w)); asm volatile("" : "+v"(l));
    F.ws = w; F.lane = l; F.tid = F0.wave * 64 + l; F.ctl = (gu32*)(w + WS_CTL); return F; }
__device__ __forceinline__ float lane_get(float v, int src_lane) { return __builtin_bit_cast(float, __builtin_amdgcn_ds_bpermute(src_lane << 2, __builtin_bit_cast(int, v))); }
__device__ __forceinline__ float lane_xor(float v, int mask, int lane) { return lane_get(v, lane ^ mask); }
__device__ __forceinline__ float lane_up(float v, int d, int lane) { return lane_get(v, lane >= d ? lane - d : lane); }
__device__ __forceinline__ float wave_sum(float v, int lane) {
#pragma unroll
    for (int o = 1; o < 64; o <<= 1) v += lane_xor(v, o, lane);
    return v;
}
__device__ __forceinline__ unsigned pk2(float lo, float hi) { return cvt_pk_bf16(lo, hi); }

__device__ __forceinline__ void cvt_item(const float* W, int ldw, int K, bf16* WT, int d0, int sc0, int nvalid, float scale, int k0, LAS float* scr, int lane) {
    const int n4 = (lane & 7) * 4;
    f32x4 v[8];
#pragma unroll
    for (int i = 0; i < 8; ++i) { const int kk = 8 * i + (lane >> 3); v[i] = (f32x4){0.f, 0.f, 0.f, 0.f}; if (n4 < nvalid) v[i] = *(const GAS f32x4*)(W + (size_t)(k0 + kk) * ldw + sc0 + n4); }
#pragma unroll
    for (int i = 0; i < 8; ++i) { const int kk = 8 * i + (lane >> 3); LAS float* d = scr + kk * 33 + n4; d[0] = v[i][0] * scale; d[1] = v[i][1] * scale; d[2] = v[i][2] * scale; d[3] = v[i][3] * scale; }
    LDS_WAIT(); asm volatile("" ::: "memory");
    const int c = lane & 7;
#pragma unroll
    for (int j = 0; j < 4; ++j) { const int nn = (lane >> 3) + 8 * j; const LAS float* s = scr + (8 * c) * 33 + nn;
        v4u o; o.x = pk2(s[0 * 33], s[1 * 33]); o.y = pk2(s[2 * 33], s[3 * 33]); o.z = pk2(s[4 * 33], s[5 * 33]); o.w = pk2(s[6 * 33], s[7 * 33]);
        *(GAS v4u*)(WT + (size_t)(d0 + nn) * K + k0 + 8 * c) = o; }
    LDS_WAIT(); asm volatile("" ::: "memory");
}
__device__ __forceinline__ void cvt_plain(const float* W, int K, int N, bf16* WT, int item, LAS float* scr, int lane) {
    const int nblk = N / 32, kb = item / nblk, nb = item % nblk;
    cvt_item(W, N, K, WT, 32 * nb, 32 * nb, 32, 1.0f, 64 * kb, scr, lane);
}
__device__ __forceinline__ void cvt_gateup(const float* Wg, const float* Wu, int dff, bf16* WT, int item, LAS float* scr, int lane) {
    const int nblk = 2 * dff / 32, kb = item / nblk, db = item % nblk, d0 = 32 * db, pn = d0 >> 8, r = d0 & 255;
    const float* W = r < 128 ? Wg : Wu; const int sc0 = 128 * pn + (r & 127);
    cvt_item(W, dff, D, WT, d0, sc0, 32, 1.0f, 64 * kb, scr, lane);
}
__device__ __forceinline__ void cvt_win(const float* W, bf16* WT, int item, LAS float* scr, int lane) {
    const int nblk = NIN / 32, kb = item / nblk, db = item % nblk, d0 = 32 * db;
    int sc0, nv = 32; float sc = 1.0f;
    if (d0 < 1024) { sc0 = d0; }
    else if (d0 < 2048) sc0 = 1736 + (d0 - 1024);
    else if (d0 < 3072) sc0 = 2760 + (d0 - 2048);
    else if (d0 < 4096) sc0 = 3784 + (d0 - 3072);
    else if (d0 < 5120) sc0 = 4808 + (d0 - 4096);
    else if (d0 < 5632) sc0 = 1152 + (d0 - 5120);
    else if (d0 < 5696) sc0 = 1024 + (d0 - 5632);
    else if (d0 < 5760) sc0 = 1088 + (d0 - 5696);
    else if (d0 < 5824) sc0 = 1664 + (d0 - 5760);
    else if (d0 == 5824) { sc0 = 1728; nv = 8; }
    else { sc0 = 0; nv = 0; }
    cvt_item(W, D_IN, D, WT, d0, sc0, nv, sc, 64 * kb, scr, lane);
}
__device__ __forceinline__ void p0_convert(const Frame& F0, int L) {
    Frame F = launder(F0);
    const KArgs ka = kargs();
    LAS float* scr = (LAS float*)(F.lds + RING_OFF + F.wave * 16384);
    const int gw = F.bx * NWAVES + F.wave, NGW = F.G * NWAVES;
    unsigned char* wb = F.ws + WS_W;
    const int odd = L & 1, jj = L >> 1;
    constexpr int I_IN = (D / 64) * (NIN / 32), I_SQ = (D / 64) * (D / 32), I_PPJ = (PLE / 64) * (D / 32), I_LRU1 = 2 * 4;
    constexpr int I_GU_D = (D / 64) * (2 * DFF / 32), I_DN_D = (DFF / 64) * (D / 32), I_GU_E = (D / 64) * (2 * DFFE / 32), I_DN_E = (DFFE / 64) * (D / 32);
    const int n_ff = odd ? NEXP * (I_GU_E + I_DN_E) : (I_GU_D + I_DN_D);
    const int NITEMS = I_IN + 4 * I_SQ + I_PPJ + 16 * I_LRU1 + n_ff;
    for (int it = gw; it < NITEMS; it += NGW) {
        const float* W; bf16* WT; int ldw, K, d0, sc0, nv = 32, k0; float scale = 1.0f;
        int r = it, kind = 0, m = 0;
        if (r < I_IN) kind = 1;
        else { r -= I_IN;
            if (r < 4 * I_SQ) { m = r / I_SQ; r -= m * I_SQ; }
            else { r -= 4 * I_SQ;
                if (r < I_PPJ) m = 4;
                else { r -= I_PPJ;
                    if (r < 16 * I_LRU1) m = 5;
                    else { r -= 16 * I_LRU1;
                        if (!odd) { if (r < I_GU_D) kind = 2; else { r -= I_GU_D; m = 6; } }
                        else { if (r < NEXP * I_GU_E) kind = 3; else { r -= NEXP * I_GU_E; m = 7; } } } } } }
        if (kind == 1) { const int nblk = NIN / 32, kb = r / nblk, db = r % nblk; d0 = 32 * db; k0 = 64 * kb;
            W = ka->in[I_WIN] + (size_t)L * D * D_IN; WT = (bf16*)(wb + W_IN); ldw = D_IN; K = D;
            if (d0 < 1024) sc0 = d0;
            else if (d0 < 2048) sc0 = 1736 + (d0 - 1024);
            else if (d0 < 3072) sc0 = 2760 + (d0 - 2048);
            else if (d0 < 4096) sc0 = 3784 + (d0 - 3072);
            else if (d0 < 5120) sc0 = 4808 + (d0 - 4096);
            else if (d0 < 5632) sc0 = 1152 + (d0 - 5120);
            else if (d0 < 5696) sc0 = 1024 + (d0 - 5632);
            else if (d0 < 5760) sc0 = 1088 + (d0 - 5696);
            else if (d0 < 5824) sc0 = 1664 + (d0 - 5760);
            else if (d0 == 5824) { sc0 = 1728; nv = 8; }
            else { sc0 = 0; nv = 0; } }
        else if (kind >= 2) { const int dff = kind == 2 ? DFF : DFFE; int e = 0; if (kind == 3) { e = r / I_GU_E; r -= e * I_GU_E; }
            const size_t eo = kind == 2 ? (size_t)jj * D * DFF : ((size_t)jj * NEXP + e) * D * DFFE;
            const int nblk = 2 * dff / 32, kb = r / nblk, db = r % nblk; d0 = 32 * db; k0 = 64 * kb; const int pn = d0 >> 8, rr = d0 & 255;
            W = (rr < 128 ? ka->in[kind == 2 ? I_FFG : I_MOEG] : ka->in[kind == 2 ? I_FFU : I_MOEU]) + eo; sc0 = 128 * pn + (rr & 127); ldw = dff; K = D;
            WT = (bf16*)(wb + W_FF) + (kind == 3 ? (size_t)e * 2 * DFFE * D : 0); }
        else { int Kk, Nn;
            if (m < 4) { Kk = D; Nn = D; W = ka->in[m == 0 ? I_WBRA : m == 1 ? I_WBRR : m == 2 ? I_WO : I_PLEG] + (size_t)L * D * D; WT = (bf16*)(wb + (m == 0 ? W_BRA : m == 1 ? W_BRR : m == 2 ? W_O : W_PG)); }
            else if (m == 4) { Kk = PLE; Nn = D; W = ka->in[I_PLEP] + (size_t)L * PLE * D; WT = (bf16*)(wb + W_PP); }
            else if (m == 5) { const int mm = r / I_LRU1, blk = mm & 7, which = mm >> 3; r -= mm * I_LRU1; Kk = 128; Nn = 128;
                W = ka->in[which ? I_LRUWX : I_LRUWA] + (size_t)L * 8 * 128 * 128 + (size_t)blk * 128 * 128; WT = (bf16*)(wb + W_LRU) + (size_t)which * 8 * 128 * 128 + (size_t)blk * 128 * 128; }
            else if (m == 6) { Kk = DFF; Nn = D; W = ka->in[I_FFD] + (size_t)jj * DFF * D; WT = (bf16*)(wb + W_FF_DN_DENSE); }
            else { const int e = r / I_DN_E; r -= e * I_DN_E; Kk = DFFE; Nn = D; W = ka->in[I_MOED] + ((size_t)jj * NEXP + e) * DFFE * D; WT = (bf16*)(wb + W_FF_DN_MOE) + (size_t)e * D * DFFE; }
            const int nblk = Nn / 32, kb = r / nblk, nb = r % nblk; d0 = 32 * nb; sc0 = 32 * nb; k0 = 64 * kb; ldw = Nn; K = Kk; }
        cvt_item(W, ldw, K, WT, d0, sc0, nv, scale, k0, scr, F.lane);
    }
    if (L == 0) {
        const GAS f32x4* x4 = (const GAS f32x4*)ka->in[I_X]; GAS v4u* o = (GAS v4u*)(F.ws + WS_XB);
        const size_t n8 = (size_t)T_TOK * D / 8;
        for (size_t i = (size_t)F.bx * 512 + F.tid; i < n8; i += (size_t)F.G * 512) { const f32x4 a = x4[2 * i], b = x4[2 * i + 1];
            v4u w; w.x = pk2(a[0], a[1]); w.y = pk2(a[2], a[3]); w.z = pk2(b[0], b[1]); w.w = pk2(b[2], b[3]); o[i] = w; }
    }
}

template <bool LN2, bool ODD, bool DRY = false>
__device__ __forceinline__ void ln_phase(const Frame& F0, int L) {
    Frame F = launder(F0);
    const KArgs ka = kargs();
    const int jj = L >> 1;
    float* X32 = F.out; bf16* XB = (bf16*)(F.ws + WS_XB);
    const float* gam = ka->in[LN2 ? I_LN2G : I_LN1G] + (size_t)L * D; const float* bet = ka->in[LN2 ? I_LN2B : I_LN1B] + (size_t)L * D;
    f32x4 gv[4], bv[4];
#pragma unroll
    for (int j = 0; j < 4; ++j) { gv[j] = ((const GAS f32x4*)gam)[F.lane + 64 * j]; bv[j] = ((const GAS f32x4*)bet)[F.lane + 64 * j]; }
    LAS float* RT = (LAS float*)(F.lds + RING_OFF);
    LAS unsigned* TE = (LAS unsigned*)(F.lds + RING_OFF + 32768);
    volatile LAS unsigned* lcnt = F.MISC + 48; volatile LAS unsigned* gbase = F.MISC + 56;
    float rb[8];
    if (!LN2 && ODD) {
        const float* R = ka->in[I_ROUTER] + (size_t)jj * D * NEXP;
        for (int i = F.tid; i < D * NEXP; i += 512) RT[i] = R[i];
        if (F.tid < 8) lcnt[F.tid] = 0u;
#pragma unroll
        for (int e = 0; e < 8; ++e) rb[e] = ka->in[I_ROUTERB][jj * NEXP + e];
        __syncthreads();
    }
    const unsigned* route = (const unsigned*)(F.ws + WS_ROUTE);
    const bf16* YE = (const bf16*)(F.ws + F_YE);
    const bf16* T1 = (const bf16*)(F.ws + (LN2 ? F_U : Z_GR)); const bf16* T2 = (const bf16*)(F.ws + Z_GR);
    v2u nx[4], n1[4];
    { const size_t r0 = ((size_t)F.bx * 256 + F.wave) * D; const GAS v2u* a0 = (const GAS v2u*)(XB + r0) + F.lane; const GAS v2u* b0 = (const GAS v2u*)(T1 + r0) + F.lane;
#pragma unroll
      for (int j = 0; j < 4; ++j) { nx[j] = a0[64 * j]; n1[j] = b0[64 * j]; } }
    for (int it = 0; it < 32; ++it) {
        const int rl = F.wave + 8 * it; const size_t row = (size_t)F.bx * 256 + rl;
        GAS f32x4* xr = (GAS f32x4*)(X32 + row * D) + F.lane;
        f32x4 v[4]; float s = 0.f;
#pragma unroll
        for (int j = 0; j < 4; ++j) { const v2u a = nx[j], b = n1[j];
            v[j][0] = DN_ALPHA * bf_lo(a.x) + bf_lo(b.x); v[j][1] = DN_ALPHA * bf_hi(a.x) + bf_hi(b.x); v[j][2] = DN_ALPHA * bf_lo(a.y) + bf_lo(b.y); v[j][3] = DN_ALPHA * bf_hi(a.y) + bf_hi(b.y); }
        if (it < 31) { const GAS v2u* a0 = (const GAS v2u*)(XB + (row + 8) * D) + F.lane; const GAS v2u* b0 = (const GAS v2u*)(T1 + (row + 8) * D) + F.lane;
#pragma unroll
            for (int j = 0; j < 4; ++j) { nx[j] = a0[64 * j]; n1[j] = b0[64 * j]; } }
        if (LN2 && !ODD) {
            const GAS v2u* fp = (const GAS v2u*)(T2 + row * D) + F.lane;
#pragma unroll
            for (int j = 0; j < 4; ++j) { const v2u b = fp[64 * j]; v[j][0] += bf_lo(b.x); v[j][1] += bf_hi(b.x); v[j][2] += bf_lo(b.y); v[j][3] += bf_hi(b.y); }
        }
        if (LN2 && ODD) {
            const unsigned e1 = route[row * 8 + 0], e2 = route[row * 8 + 1], p1 = route[row * 8 + 2], p2 = route[row * 8 + 3];
            const float g1 = __builtin_bit_cast(float, route[row * 8 + 4]), g2 = __builtin_bit_cast(float, route[row * 8 + 5]);
            const size_t r1 = (size_t)F.MISC[16 + e1] * 256 + p1, r2 = (size_t)F.MISC[16 + e2] * 256 + p2;
            const GAS v2u* y1 = (const GAS v2u*)(YE + r1 * D) + F.lane; const GAS v2u* y2 = (const GAS v2u*)(YE + r2 * D) + F.lane;
#pragma unroll
            for (int j = 0; j < 4; ++j) { const v2u a = y1[64 * j], b = y2[64 * j];
                v[j][0] += g1 * bf_lo(a.x) + g2 * bf_lo(b.x); v[j][1] += g1 * bf_hi(a.x) + g2 * bf_hi(b.x);
                v[j][2] += g1 * bf_lo(a.y) + g2 * bf_lo(b.y); v[j][3] += g1 * bf_hi(a.y) + g2 * bf_hi(b.y); }
        }
#pragma unroll
        for (int j = 0; j < 4; ++j) s += (v[j][0] + v[j][1]) + (v[j][2] + v[j][3]);
        const float mean = wave_sum(s, F.lane) * (1.f / D); float s2 = 0.f;
#pragma unroll
        for (int j = 0; j < 4; ++j) { v[j] = v[j] - mean; s2 += (v[j][0] * v[j][0] + v[j][1] * v[j][1]) + (v[j][2] * v[j][2] + v[j][3] * v[j][3]); }
        const float rstd = 1.f / sqrtf(wave_sum(s2, F.lane) * (1.f / D) + LN_EPS);
        GAS v2u* o8 = (GAS v2u*)((DRY ? (bf16*)(F.ws + WS_NEED) : XB) + row * D) + F.lane;
        GAS f32x4* xw = DRY ? (GAS f32x4*)((float*)(F.ws + WS_NEED) + row * D) + F.lane : xr;
#pragma unroll
        for (int j = 0; j < 4; ++j) { v[j] = v[j] * rstd * gv[j] + bv[j]; if (DRY || (LN2 && L == DEPTH - 1)) xw[64 * j] = v[j];
            v2u w; w.x = pk2(v[j][0], v[j][1]); w.y = pk2(v[j][2], v[j][3]); o8[64 * j] = w; }
        if (!LN2) {
            const f32x4 pv = ((const GAS f32x4*)(ka->in[I_P] + ((size_t)L * T_TOK + row) * PLE))[F.lane];
            v2u w; w.x = pk2(pv[0], pv[1]); w.y = pk2(pv[2], pv[3]); ((GAS v2u*)(F.ws + (DRY ? WS_NEED : F_PB) + row * PLE * 2))[F.lane] = w;
        }
        if (!LN2 && ODD) {
            float lg[8];
#pragma unroll
            for (int e = 0; e < 8; ++e) lg[e] = 0.f;
#pragma unroll
            for (int j = 0; j < 4; ++j)
#pragma unroll
                for (int q = 0; q < 4; ++q) { const int c = 4 * F.lane + 256 * j + q; const f32x4 ra = *(const LAS f32x4*)(RT + c * 8), rc = *(const LAS f32x4*)(RT + c * 8 + 4); const float xv = v[j][q];
                    lg[0] += xv * ra[0]; lg[1] += xv * ra[1]; lg[2] += xv * ra[2]; lg[3] += xv * ra[3]; lg[4] += xv * rc[0]; lg[5] += xv * rc[1]; lg[6] += xv * rc[2]; lg[7] += xv * rc[3]; }
#pragma unroll
            for (int e = 0; e < 8; ++e) lg[e] = wave_sum(lg[e], F.lane) + rb[e];
            int e1 = 0; float v1 = lg[0];
#pragma unroll
            for (int e = 1; e < 8; ++e) if (lg[e] > v1) { v1 = lg[e]; e1 = e; }
            int e2 = -1; float v2 = 0.f;
#pragma unroll
            for (int e = 0; e < 8; ++e) if (e != e1 && (e2 < 0 || lg[e] > v2)) { v2 = lg[e]; e2 = e; }
            const float ex = __expf(v2 - v1), g1 = 1.f / (1.f + ex), g2 = ex * g1;
            if (F.lane == 0) { const unsigned lp1 = __hip_atomic_fetch_add((LAS unsigned*)lcnt + e1, 1u, __ATOMIC_RELAXED, __HIP_MEMORY_SCOPE_WORKGROUP), lp2 = __hip_atomic_fetch_add((LAS unsigned*)lcnt + e2, 1u, __ATOMIC_RELAXED, __HIP_MEMORY_SCOPE_WORKGROUP);
                TE[rl * 4 + 0] = (unsigned)e1 | ((unsigned)e2 << 8) | (lp1 << 16); TE[rl * 4 + 1] = lp2; TE[rl * 4 + 2] = __builtin_bit_cast(unsigned, g1); TE[rl * 4 + 3] = __builtin_bit_cast(unsigned, g2); }
        }
    }
    if (!LN2 && ODD) {
        __syncthreads();
        if (F.tid < 8) gbase[F.tid] = __hip_atomic_fetch_add(F.ctl + CW_CNT + jj * 1024 + 64 * F.tid, lcnt[F.tid], RLX_AGENT);
        __syncthreads();
        if (F.tid < 256) { const unsigned w0 = TE[F.tid * 4], lp2 = TE[F.tid * 4 + 1]; const unsigned e1 = w0 & 255u, e2 = (w0 >> 8) & 255u, lp1 = w0 >> 16;
            const unsigned p1 = gbase[e1] + lp1, p2 = gbase[e2] + lp2; const unsigned tok = (unsigned)F.bx * 256 + F.tid;
            GAS int* list = (GAS int*)(F.ws + WS_LIST); list[(size_t)e1 * T_TOK + p1] = (int)tok; list[(size_t)e2 * T_TOK + p2] = (int)tok;
            GAS v4u* ro = (GAS v4u*)(F.ws + WS_ROUTE) + (size_t)tok * 2; v4u a; a.x = e1; a.y = e2; a.z = p1; a.w = p2; ro[0] = a; v4u b; b.x = TE[F.tid * 4 + 2]; b.y = TE[F.tid * 4 + 3]; b.z = 0u; b.w = 0u; ro[1] = b; }
        __syncthreads();
    }
}
__device__ __forceinline__ int wave_scan_add(int x) {
    x += __builtin_amdgcn_update_dpp(0, x, 0x111, 0xf, 0xf, false);
    x += __builtin_amdgcn_update_dpp(0, x, 0x112, 0xf, 0xf, false);
    x += __builtin_amdgcn_update_dpp(0, x, 0x114, 0xf, 0xf, false);
    x += __builtin_amdgcn_update_dpp(0, x, 0x118, 0xf, 0xf, false);
    x += __builtin_amdgcn_update_dpp(0, x, 0x142, 0xa, 0xf, false);
    x += __builtin_amdgcn_update_dpp(0, x, 0x143, 0xc, 0xf, false);
    return x;
}
template <int NJ>
__device__ __forceinline__ unsigned select_topk_n(LAS const float* sc, int n_adm, GAS unsigned short* gout, LAS unsigned short* out, int lane, unsigned guess) {
    const int nj = n_adm >> 6;
    unsigned u[NJ];
#pragma unroll
    for (int j = 0; j < NJ; ++j) { unsigned b = 0u;
        if (j < NJ - 8 || j < nj) { b = __builtin_bit_cast(unsigned, sc[64 * j + lane]); b = (b == 0x80000000u) ? 0u : b; b = (b & 0x80000000u) ? ~b : (b | 0x80000000u); }
        u[j] = b; }
#define SEL_COUNT(c_, dst_) do { int cl_ = 0; _Pragma("unroll") for (int j = 0; j < NJ; ++j) cl_ += (u[j] >= (c_)) ? 1 : 0; dst_ = __builtin_amdgcn_readlane(wave_scan_add(cl_), 63); } while (0)
    unsigned lo = 0u, hi = 0xFFFFFFFFu, ex = 0u; bool exact = false; int c;
    if (guess != 0u) {
        SEL_COUNT(guess, c);
        if (c == 256) { exact = true; ex = guess; }
        else if (c > 256) { lo = guess; unsigned d = 1u << 17;
            for (int e = 0; e < 7 && !exact; ++e) { const unsigned h = lo + d; if (h < lo) break; SEL_COUNT(h, c);
                if (c == 256) { exact = true; ex = h; } else if (c < 256) { hi = h; break; } else { lo = h; d <<= 2; } } }
        else { hi = guess; unsigned d = 1u << 17;
            for (int e = 0; e < 7 && !exact; ++e) { if (d >= hi) break; const unsigned l = hi - d; SEL_COUNT(l, c);
                if (c == 256) { exact = true; ex = l; } else if (c > 256) { lo = l; break; } else { hi = l; d <<= 2; } } }
    }
    while (!exact && hi - lo > 1u) { const unsigned mid = lo + ((hi - lo) >> 1); SEL_COUNT(mid, c);
        if (c == 256) { exact = true; ex = mid; } else if (c > 256) lo = mid; else hi = mid; }
#undef SEL_COUNT
    const unsigned thr = exact ? ex - 1u : lo;
    int nl = 0;
#pragma unroll
    for (int j = 0; j < NJ; ++j) nl += (u[j] > thr) ? 1 : 0;
    const int incl = wave_scan_add(nl); const int ngt = __builtin_amdgcn_readlane(incl, 63);
    int pos = incl - nl;
#pragma unroll
    for (int j = 0; j < NJ; ++j) if (u[j] > thr) { out[pos] = (unsigned short)(64 * j + lane); ++pos; }
    const int quota = 256 - ngt;
    if (quota > 0) {
        int tbase = 0; const unsigned long long lt = (1ull << lane) - 1ull;
#pragma unroll
        for (int j = 0; j < NJ; ++j) {
            const bool eq = u[j] == thr; const unsigned long long meq = __ballot(eq); const int rk = tbase + __popcll(meq & lt);
            if (eq && rk < quota) out[ngt + rk] = (unsigned short)(64 * j + lane);
            tbase += __popcll(meq);
        }
    }
    asm volatile("s_waitcnt lgkmcnt(0)" ::: "memory");
    if (lane < 32) *(GAS v4u*)(gout + 8 * lane) = *(const LAS v4u*)(out + 8 * lane);
    asm volatile("s_waitcnt lgkmcnt(0)" ::: "memory");
    return thr;
}
__device__ __forceinline__ unsigned select_topk(LAS const float* sc, int n_adm, GAS unsigned short* out, LAS unsigned short* orow, int lane, unsigned guess) {
    if (n_adm <= 256) {
#pragma unroll
        for (int j = 0; j < 4; ++j) { const int p = lane + 64 * j; out[p] = (unsigned short)(p < n_adm ? p : 0); }
        return 0u;
    }
    if (n_adm <= 512) return select_topk_n<8>(sc, n_adm, out, orow, lane, guess);
    else if (n_adm <= 1024) return select_topk_n<16>(sc, n_adm, out, orow, lane, guess);
    else if (n_adm <= 1536) return select_topk_n<24>(sc, n_adm, out, orow, lane, guess);
    return select_topk_n<32>(sc, n_adm, out, orow, lane, guess);
}
template <int MODE = 0>
__device__ __forceinline__ void indexer_phase(const Frame& F0) {
    Frame F = launder(F0);
    LAS float* sc = (LAS float*)(F.lds + RING_OFF);
    const bf16* QI = (const bf16*)(F.ws + Z_QI); const bf16* SM = (const bf16*)(F.ws + Z_SM);
    GAS unsigned short* IDX = (GAS unsigned short*)(F.ws + WS_IDX);
    const int lane = F.lane, h = lane >> 5, r = lane & 31;
    const int rq = 2 * ((r >> 2) & 1) + ((r >> 4) & 1), rh = (r & 3) + 4 * ((r >> 3) & 1);
    const int vcu = (F.bx & 7) * (F.G >> 3) + (F.bx >> 3);
    unsigned guess[2] = {0u, 0u};
    bf16x8 A[4][4]; v4u wq[4][2];
#define IDX_TILE(pi_, b_, tq_) const int pid_ = vcu * 8 + ((pi_) >> 1), b_ = pid_ >> 6, jp_ = pid_ & 63, tq_ = 16 * (((pi_) & 1) ? 127 - jp_ : jp_)
#define IDX_LOAD_A(t0_) do { _Pragma("unroll") for (int mt = 0; mt < 4; ++mt) { \
        _Pragma("unroll") for (int s = 0; s < 4; ++s) A[mt][s] = *(const GAS bf16x8*)(QI + (size_t)((t0_) + 4 * mt + rq) * 512 + rh * 64 + 16 * s + 8 * h); \
        _Pragma("unroll") for (int qq = 0; qq < 2; ++qq) wq[mt][qq] = *(const GAS v4u*)(SM + (size_t)((t0_) + 4 * mt + 2 * h + qq) * 256 + 192); } } while (0)
    for (int pi = 0; pi < 16; ++pi) {
        IDX_TILE(pi, b, tq);
        const int t0 = b * SEQ + tq;
        const int n_adm = ((tq >> 6) + 1) * 64, nkb = n_adm >> 5;
        if (n_adm > 256 && MODE != 2) {
            IDX_LOAD_A(t0);
            bf16x8 B[4], Bn[4];
#pragma unroll
            for (int s = 0; s < 4; ++s) Bn[s] = *(const GAS bf16x8*)(SM + (size_t)(b * SEQ + 32 * F.wave + r) * 256 + 128 + 16 * s + 8 * h);
            for (int kb = F.wave; kb < nkb; kb += 8) {
                const int key = 32 * kb + r;
                const int keyn = (kb + 8 < nkb) ? key + 256 : key;
#pragma unroll
                for (int s = 0; s < 4; ++s) B[s] = Bn[s];
#pragma unroll
                for (int s = 0; s < 4; ++s) Bn[s] = *(const GAS bf16x8*)(SM + (size_t)(b * SEQ + keyn) * 256 + 128 + 16 * s + 8 * h);
#pragma unroll
                for (int mt = 0; mt < 4; ++mt) {
                    f32x16 acc;
#pragma unroll
                    for (int i = 0; i < 16; ++i) acc[i] = 0.f;
#pragma unroll
                    for (int s = 0; s < 4; ++s) acc = __builtin_amdgcn_mfma_f32_32x32x16_bf16(A[mt][s], B[s], acc, 0, 0, 0);
                    float sA = 0.f, sB = 0.f;
#pragma unroll
                    for (int i = 0; i < 8; ++i) { const unsigned wa = wq[mt][0][i >> 1], wb = wq[mt][1][i >> 1];
                        const float fa = (i & 1) ? bf_hi(wa) : bf_lo(wa), fb = (i & 1) ? bf_hi(wb) : bf_lo(wb);
                        sA += fmaxf(acc[i], 0.f) * fa; sB += fmaxf(acc[8 + i], 0.f) * fb; }
                    sc[(4 * mt + 2 * h) * 2048 + key] = sA; sc[(4 * mt + 2 * h + 1) * 2048 + key] = sB;
                }
            }
        }
        __syncthreads();
#pragma unroll 1
        for (int qq = 0; qq < 2 && MODE != 1; ++qq) { const int q = 2 * F.wave + qq; const unsigned g_ = (pi & 1) ? guess[1] : guess[0];
            const unsigned t_ = select_topk(sc + q * 2048, n_adm, IDX + (size_t)(t0 + q) * 256, (LAS unsigned short*)(F.lds + LDSCTL_OFF + 1024 + F.wave * 512), lane, g_); if (pi & 1) guess[1] = t_; else guess[0] = t_; }
        __syncthreads();
    }
#undef IDX_TILE
#undef IDX_LOAD_A
}

__device__ __forceinline__ unsigned vst_off(unsigned r, unsigned ch) { return r * 128u + 16u * (ch ^ ((((r >> 1) ^ (r >> 4)) & 1u) << 1) ^ (((r >> 3) & 1u) << 2)); }
__device__ __forceinline__ int t5_bucket_dev(int rel) {
    const int n = rel < 0 ? -rel : rel;
    int v = n;
    if (n >= 8) v = 8 + (n >= 12) + (n >= 16) + (n >= 23) + (n >= 32) + (n >= 46) + (n >= 64) + (n >= 91);
    return v + (rel > 0 ? 16 : 0);
}
#ifndef ATT_REPS
#define ATT_REPS 1
#endif
#ifndef ATT_FIXKEYS
#define ATT_FIXKEYS 0
#endif
template <int FIX = 0>
__device__ __forceinline__ void attention_phase(const Frame& F0) {
#pragma unroll 1
    for (int rep = 0; rep < ATT_REPS; ++rep) {
    Frame F = launder(F0);
    const GAS unsigned char* Q8 = (const GAS unsigned char*)(F.ws + Z_Q8); const GAS unsigned char* KV8 = (const GAS unsigned char*)(F.ws + Z_KV8); bf16* OB = (bf16*)(F.ws + Z_XR);
    const GAS unsigned short* IDX = (const GAS unsigned short*)(F.ws + WS_IDX);
    const int lane = F.lane, g = lane >> 4, m = lane & 15;
    LAS unsigned char* vst = F.lds + RING_OFF + F.wave * 4096;
    const unsigned vbase = (unsigned)(size_t)vst;
    LAS unsigned char* BK = F.lds + RING_OFF + 32768; LAS unsigned char* OH = F.lds + RING_OFF + 32768 + 2176;
    for (int i = F.tid; i < 2112; i += 512) BK[i] = (unsigned char)t5_bucket_dev(i - 2047);
    if (F.tid < 128) { const int bkt = F.tid >> 2, gg = F.tid & 3, j = bkt - 8 * gg; v4u oh; oh.x = oh.y = oh.z = oh.w = 0u;
        if (j >= 0 && j < 8) { const unsigned val = (j & 1) ? 0x3F800000u : 0x3F80u; if ((j >> 1) == 0) oh.x = val; else if ((j >> 1) == 1) oh.y = val; else if ((j >> 1) == 2) oh.z = val; else oh.w = val; }
        *(LAS v4u*)(OH + F.tid * 16) = oh; }
    __syncthreads();
    bf16x8 bb;
    { const float* rbias = kargs()->in[I_RELB]; unsigned w[4];
#pragma unroll
      for (int j = 0; j < 4; ++j) w[j] = pk2(8.0f * rbias[(8 * g + 2 * j) * 16 + m], 8.0f * rbias[(8 * g + 2 * j + 1) * 16 + m]);
      v4u t; t.x = w[0]; t.y = w[1]; t.z = w[2]; t.w = w[3]; bb = __builtin_bit_cast(bf16x8, t); }
    unsigned tra[4];
    { const unsigned rr_ = 8 * g + (m >> 1), fr_ = ((rr_ >> 2) & 3u) ^ ((rr_ >> 1) & 1u);
#pragma unroll
      for (int c = 0; c < 4; ++c) tra[c] = rr_ * 64u + 16u * ((unsigned)c ^ fr_) + 8u * (m & 1); }
    const long aones = (m == 0) ? 0x3838383838383838L : 0L;
    const int vcu = (F.bx & 7) * (F.G >> 3) + (F.bx >> 3);
    typedef long fp8x8;
    v4u ni0, ni1, nq; v4u ka[16]; unsigned koff[16];
#define ATT_KOFF(i0_, i1_) do { _Pragma("unroll") for (int k = 0; k < 4; ++k) { koff[2 * k] = ((i0_)[k] & 0xffffu) * 128u + 16u * g; koff[2 * k + 1] = ((i0_)[k] >> 16) * 128u + 16u * g; \
        koff[8 + 2 * k] = ((i1_)[k] & 0xffffu) * 128u + 16u * g; koff[8 + 2 * k + 1] = ((i1_)[k] >> 16) * 128u + 16u * g; } } while (0)
#ifdef ATT_NO_ASM
#define ATT_KLOAD(kvb_) do { const GAS unsigned char* kb_ = (kvb_); _Pragma("unroll") for (int T = 0; T < 16; ++T) ka[T] = *(const GAS v4u*)(kb_ + koff[T]); } while (0)
#define ATT_KWAIT(n_, T0_) do {} while (0)
#else
#define ATT_KLOAD(kvb_) do { const GAS unsigned char* kb_ = (kvb_); _Pragma("unroll") for (int T = 0; T < 16; ++T) { \
        asm volatile("global_load_dwordx4 %0, %1, %2" : "=&v"(ka[T]) : "v"(koff[T]), "s"(kb_) : "memory"); } } while (0)
#define ATT_KWAIT(n_, T0_) asm volatile("s_waitcnt vmcnt(" #n_ ")" : "+v"(ka[T0_]), "+v"(ka[T0_ + 1]), "+v"(ka[T0_ + 2]), "+v"(ka[T0_ + 3]), "+v"(ka[T0_ + 4]), "+v"(ka[T0_ + 5]), "+v"(ka[T0_ + 6]), "+v"(ka[T0_ + 7]) :: "memory")
#endif
#define ATT_TOK(it_) ((vcu >> 3) * SEQ + ((it_) >> 2) * 256 + (vcu & 7) * 32 + 8 * ((it_) & 3) + F.wave)
    { const int tok0 = ATT_TOK(0); const GAS v4u* ip = (const GAS v4u*)(IDX + (size_t)tok0 * 256 + 16 * m); ni0 = ip[0]; ni1 = ip[1];
      nq = *(const GAS v4u*)(Q8 + (size_t)tok0 * D + m * 64 + 16 * g);
      ATT_KOFF(ni0, ni1); ATT_KLOAD(KV8 + (size_t)(tok0 >> 11) * SEQ * 128); }
    for (int it = 0; it < 32; ++it) {
        const int tok = ATT_TOK(it), b = tok >> 11, tq = tok & (SEQ - 1);
        const int n_valid = (((tq >> 6) + 1) * 64) < 256 ? ((tq >> 6) + 1) * 64 : 256;
        const v4u qv = nq;
        const fp8x8 qf0 = (fp8x8)(((unsigned long long)qv.y << 32) | qv.x), qf1 = (fp8x8)(((unsigned long long)qv.w << 32) | qv.z);
        const GAS unsigned char* kvb = KV8 + (size_t)b * SEQ * 128;
        f32x4 S[16];
#pragma unroll
        for (int T = 0; T < 16; ++T) {
            if (T == 0) ATT_KWAIT(8, 0);
            if (T == 8) ATT_KWAIT(0, 8);
            const unsigned bkt = BK[(koff[T] >> 7) + (2047 - tq)];
            const v4u oh = *(const LAS v4u*)(OH + bkt * 64 + g * 16);
            f32x4 ab = (f32x4){0.f, 0.f, 0.f, 0.f}, a = (f32x4){0.f, 0.f, 0.f, 0.f};
            ab = __builtin_amdgcn_mfma_f32_16x16x32_bf16(__builtin_bit_cast(bf16x8, oh), bb, ab, 0, 0, 0);
            a = __builtin_amdgcn_mfma_f32_16x16x32_fp8_fp8((fp8x8)(((unsigned long long)ka[T].y << 32) | ka[T].x), qf0, a, 0, 0, 0);
            a = __builtin_amdgcn_mfma_f32_16x16x32_fp8_fp8((fp8x8)(((unsigned long long)ka[T].w << 32) | ka[T].z), qf1, a, 0, 0, 0);
            a = a + ab;
            S[T] = a;
        }
        __builtin_amdgcn_sched_barrier(0);
        v4u vv[16];
#pragma unroll
        for (int T = 0; T < 16; ++T) vv[T] = *(const GAS v4u*)(kvb + koff[T] + 64);
        if (n_valid < 256) {
#pragma unroll
            for (int T = 0; T < 16; ++T)
#pragma unroll
                for (int i = 0; i < 4; ++i) if (16 * (4 * g + i) + T >= n_valid) S[T][i] = -1e30f;
        }
        float mx = -3.0e38f;
#pragma unroll
        for (int T = 0; T < 16; ++T) { asm("v_max3_f32 %0, %1, %2, %0" : "+v"(mx) : "v"(S[T][0]), "v"(S[T][1])); asm("v_max3_f32 %0, %1, %2, %0" : "+v"(mx) : "v"(S[T][2]), "v"(S[T][3])); }
        mx = fmaxf(mx, lane_xor(mx, 16, lane)); mx = fmaxf(mx, lane_xor(mx, 32, lane));
        constexpr float SC = 1.4426950408889634f * 0.125f;
        const float mneg = 8.0f - mx * SC;
#pragma unroll
        for (int T = 0; T < 16; ++T)
#pragma unroll
            for (int i = 0; i < 4; ++i) S[T][i] = __builtin_amdgcn_exp2f(S[T][i] * SC + mneg);
        { const int tokn = ATT_TOK(it < 31 ? it + 1 : it); const GAS v4u* ip = (const GAS v4u*)(IDX + (size_t)tokn * 256 + 16 * m); ni0 = ip[0]; ni1 = ip[1];
          nq = *(const GAS v4u*)(Q8 + (size_t)tokn * D + m * 64 + 16 * g); }
        f32x4 O[4], Osum = (f32x4){0.f, 0.f, 0.f, 0.f};
#pragma unroll
        for (int c = 0; c < 4; ++c) O[c] = (f32x4){0.f, 0.f, 0.f, 0.f};
#pragma unroll
        for (int ks = 0; ks < 8; ++ks) {
#pragma unroll
            for (int tt = 0; tt < 2; ++tt) { const unsigned rr = 8 * (m >> 2) + 4 * tt + (m & 3), fr = ((rr >> 2) & 3u) ^ ((rr >> 1) & 1u);
                *(LAS v4u*)(vst + rr * 64u + 16u * ((unsigned)g ^ fr)) = vv[2 * ks + tt]; }
            int p0 = __builtin_amdgcn_cvt_pk_fp8_f32(S[2 * ks][0], S[2 * ks][1], 0, false); p0 = __builtin_amdgcn_cvt_pk_fp8_f32(S[2 * ks][2], S[2 * ks][3], p0, true);
            int p1 = __builtin_amdgcn_cvt_pk_fp8_f32(S[2 * ks + 1][0], S[2 * ks + 1][1], 0, false); p1 = __builtin_amdgcn_cvt_pk_fp8_f32(S[2 * ks + 1][2], S[2 * ks + 1][3], p1, true);
            const fp8x8 pf = (fp8x8)(((unsigned long long)(unsigned)p1 << 32) | (unsigned)p0);
            v2u f[4];
            asm volatile("s_waitcnt lgkmcnt(0)\n\t"
                         "ds_read_b64_tr_b8 %0, %4\n\tds_read_b64_tr_b8 %1, %5\n\tds_read_b64_tr_b8 %2, %6\n\tds_read_b64_tr_b8 %3, %7\n\t"
                         "s_waitcnt lgkmcnt(0)"
                         : "=&v"(f[0]), "=&v"(f[1]), "=&v"(f[2]), "=&v"(f[3])
                         : "v"(vbase + tra[0]), "v"(vbase + tra[1]), "v"(vbase + tra[2]), "v"(vbase + tra[3])
                         : "memory");
#pragma unroll
            for (int c = 0; c < 4; ++c) O[c] = __builtin_amdgcn_mfma_f32_16x16x32_fp8_fp8((fp8x8)(((unsigned long long)f[c].y << 32) | f[c].x), pf, O[c], 0, 0, 0);
            Osum = __builtin_amdgcn_mfma_f32_16x16x32_fp8_fp8(aones, pf, Osum, 0, 0, 0);
        }
        const float inv = 1.0f / lane_get(Osum[0], m);
#pragma unroll
        for (int c = 0; c < 4; ++c) { v2u w; w.x = pk2(O[c][0] * inv, O[c][1] * inv); w.y = pk2(O[c][2] * inv, O[c][3] * inv);
            *(GAS v2u*)(OB + (size_t)tok * D + m * 64 + 16 * c + 4 * g) = w; }
        { const int tokn = ATT_TOK(it < 31 ? it + 1 : it); ATT_KOFF(ni0, ni1); ATT_KLOAD(KV8 + (size_t)(tokn >> 11) * SEQ * 128); }
    }
    asm volatile("s_waitcnt vmcnt(0)" ::: "memory");
#undef ATT_KOFF
#undef ATT_KLOAD
#undef ATT_KWAIT
    }
}

__device__ __forceinline__ void attention_phase2(const Frame& F0) {
    Frame F = launder(F0);
    const GAS unsigned char* Q8 = (const GAS unsigned char*)(F.ws + Z_Q8); const GAS unsigned char* KV8 = (const GAS unsigned char*)(F.ws + Z_KV8); bf16* OB = (bf16*)(F.ws + Z_XR);
    const GAS unsigned short* IDX = (const GAS unsigned short*)(F.ws + WS_IDX);
    const int lane = F.lane, g = lane >> 4, m = lane & 15, r8 = lane >> 3, c8 = lane & 7;
    LAS unsigned char* vbuf = F.lds + RING_OFF + F.wave * 16384;
    const unsigned vbase = (unsigned)(size_t)vbuf;
    LAS unsigned char* irow = F.lds + LDSCTL_OFF + 1024 + F.wave * 512;
    LAS unsigned char* kst = F.lds + LDSCTL_OFF + 5120 + F.wave * 1024;
    LAS unsigned char* BK = F.lds + LDSCTL_OFF + 13312;
    for (int i = F.tid; i < 2112; i += 512) BK[i] = (unsigned char)t5_bucket_dev(i - 2047);
    __syncthreads();
    bf16x8 bb;
    { const float* rbias = kargs()->in[I_RELB]; unsigned w[4];
#pragma unroll
      for (int j = 0; j < 4; ++j) w[j] = pk2(8.0f * rbias[(8 * g + 2 * j) * 16 + m], 8.0f * rbias[(8 * g + 2 * j + 1) * 16 + m]);
      v4u t; t.x = w[0]; t.y = w[1]; t.z = w[2]; t.w = w[3]; bb = __builtin_bit_cast(bf16x8, t); }
    unsigned tra[4];
    { const unsigned rr_ = 8 * g + (m >> 1), fr_ = ((rr_ >> 2) & 3u) ^ ((rr_ >> 1) & 1u);
#pragma unroll
      for (int c = 0; c < 4; ++c) tra[c] = vbase + rr_ * 64u + 16u * ((unsigned)c ^ fr_) + 8u * (m & 1); }
    const long aones = (m == 0) ? 0x3838383838383838L : 0L;
    const int vcu = (F.bx & 7) * (F.G >> 3) + (F.bx >> 3);
    unsigned wa[2][2]; const unsigned vstr = c8 >= 4 ? 2048u : 0u;
#pragma unroll
    for (int j = 0; j < 2; ++j)
#pragma unroll
        for (int t = 0; t < 2; ++t) { const unsigned rho = 8u * j + r8;
            if (c8 < 4) wa[j][t] = (unsigned)(LDSCTL_OFF + 5120) + F.wave * 1024u + rho * 64u + 16u * ((unsigned)c8 ^ (3u * j));
            else { const unsigned rr = 8u * (rho >> 2) + 4u * t + (rho & 3u), fr = ((rr >> 2) & 3u) ^ ((rr >> 1) & 1u); wa[j][t] = (unsigned)RING_OFF + F.wave * 16384u + rr * 64u + 16u * ((unsigned)(c8 - 4) ^ fr); } }
    const unsigned kra = m * 64u + 16u * ((unsigned)g ^ (3u * ((m >> 3) & 1)));
    const unsigned bra = 2u * (32u * (m & 7) + (m >> 3));
    typedef long fp8x8;
    v4u ni, nq;
    { const int tok0 = ATT_TOK(0); ni = *(const GAS v4u*)(IDX + (size_t)tok0 * 256 + 8 * (lane & 31)); nq = *(const GAS v4u*)(Q8 + (size_t)tok0 * D + m * 64 + 16 * g); }
    for (int it = 0; it < 32; ++it) {
        const int tok = ATT_TOK(it), b = tok >> 11, tq = tok & (SEQ - 1);
        const int n_valid = (((tq >> 6) + 1) * 64) < 256 ? ((tq >> 6) + 1) * 64 : 256;
        const v4u qv = nq;
        const fp8x8 qf0 = (fp8x8)(((unsigned long long)qv.y << 32) | qv.x), qf1 = (fp8x8)(((unsigned long long)qv.w << 32) | qv.z);
        const GAS unsigned char* kvb = KV8 + (size_t)b * SEQ * 128;
        if (lane < 32) *(LAS v4u*)(irow + 16 * lane) = ni;
        v4u kv[32];
        { v4u ix[4];
#pragma unroll
          for (int k = 0; k < 4; ++k) ix[k] = *(const LAS v4u*)(irow + 64 * r8 + 16 * k);
#pragma unroll
          for (int q = 0; q < 32; ++q) { const unsigned w = ix[q >> 3][(q >> 1) & 3]; const unsigned off = ((q & 1) ? (w >> 16) : (w & 0xffffu)) * 128u + 16u * c8;
              asm volatile("global_load_dwordx4 %0, %1, %2" : "=&v"(kv[q]) : "v"(off), "s"(kvb) : "memory"); } }
        unsigned bkp[4] = {0u, 0u, 0u, 0u};
#pragma unroll
        for (int T = 0; T < 16; ++T) { const unsigned key = *(const LAS unsigned short*)(irow + bra + 4 * T); bkp[T >> 2] |= (unsigned)BK[key + (2047 - tq)] << (8 * (T & 3)); }
        f32x4 S[16];
#define ATT2_TILE(T, N) do { \
            asm volatile("s_waitcnt vmcnt(" #N ")" : "+v"(kv[2 * (T)]), "+v"(kv[2 * (T) + 1]) :: "memory"); \
            *(LAS v4u*)(F.lds + wa[0][(T) & 1] + ((T) >> 1) * vstr) = kv[2 * (T)]; *(LAS v4u*)(F.lds + wa[1][(T) & 1] + ((T) >> 1) * vstr) = kv[2 * (T) + 1]; \
            const v4u kf = *(const LAS v4u*)(kst + kra); \
            const unsigned ju = ((bkp[(T) >> 2] >> (8 * ((T) & 3))) & 0xffu) - 8u * g, val = 0x3F80u << (16u * (ju & 1u)); v4u oh; \
            oh.x = (ju >> 1) == 0u ? val : 0u; oh.y = (ju >> 1) == 1u ? val : 0u; oh.z = (ju >> 1) == 2u ? val : 0u; oh.w = (ju >> 1) == 3u ? val : 0u; \
            f32x4 ab = (f32x4){0.f, 0.f, 0.f, 0.f}, a = (f32x4){0.f, 0.f, 0.f, 0.f}; \
            ab = __builtin_amdgcn_mfma_f32_16x16x32_bf16(__builtin_bit_cast(bf16x8, oh), bb, ab, 0, 0, 0); \
            a = __builtin_amdgcn_mfma_f32_16x16x32_fp8_fp8((fp8x8)(((unsigned long long)kf.y << 32) | kf.x), qf0, a, 0, 0, 0); \
            a = __builtin_amdgcn_mfma_f32_16x16x32_fp8_fp8((fp8x8)(((unsigned long long)kf.w << 32) | kf.z), qf1, a, 0, 0, 0); \
            S[T] = a + ab; } while (0)
        ATT2_TILE(0, 30); ATT2_TILE(1, 28); ATT2_TILE(2, 26); ATT2_TILE(3, 24); ATT2_TILE(4, 22); ATT2_TILE(5, 20); ATT2_TILE(6, 18); ATT2_TILE(7, 16);
        ATT2_TILE(8, 14); ATT2_TILE(9, 12); ATT2_TILE(10, 10); ATT2_TILE(11, 8); ATT2_TILE(12, 6); ATT2_TILE(13, 4); ATT2_TILE(14, 2); ATT2_TILE(15, 0);
#undef ATT2_TILE
        if (n_valid < 256) {
            int bs0 = 128 * (g & 1) + (g >> 1); asm volatile("" : "+v"(bs0));
#pragma unroll
            for (int T = 0; T < 16; ++T) { const int lim = n_valid - 2 * T;
#pragma unroll
                for (int i = 0; i < 4; ++i) if (bs0 + 32 * i >= lim) S[T][i] = -1e30f; }
        }
        float mx = -3.0e38f;
#pragma unroll
        for (int T = 0; T < 16; ++T) { asm("v_max3_f32 %0, %1, %2, %0" : "+v"(mx) : "v"(S[T][0]), "v"(S[T][1])); asm("v_max3_f32 %0, %1, %2, %0" : "+v"(mx) : "v"(S[T][2]), "v"(S[T][3])); }
        mx = fmaxf(mx, lane_xor(mx, 16, lane)); mx = fmaxf(mx, lane_xor(mx, 32, lane));
        constexpr float SC = 1.4426950408889634f * 0.125f;
        const float mneg = 8.0f - mx * SC;
#pragma unroll
        for (int T = 0; T < 16; ++T)
#pragma unroll
            for (int i = 0; i < 4; ++i) S[T][i] = __builtin_amdgcn_exp2f(S[T][i] * SC + mneg);
        { const int tokn = ATT_TOK(it < 31 ? it + 1 : it); ni = *(const GAS v4u*)(IDX + (size_t)tokn * 256 + 8 * (lane & 31)); nq = *(const GAS v4u*)(Q8 + (size_t)tokn * D + m * 64 + 16 * g); }
        f32x4 O[4], Osum = (f32x4){0.f, 0.f, 0.f, 0.f};
#pragma unroll
        for (int c = 0; c < 4; ++c) O[c] = (f32x4){0.f, 0.f, 0.f, 0.f};
#pragma unroll
        for (int ks = 0; ks < 8; ++ks) {
            int p0 = __builtin_amdgcn_cvt_pk_fp8_f32(S[2 * ks][0], S[2 * ks][1], 0, false); p0 = __builtin_amdgcn_cvt_pk_fp8_f32(S[2 * ks][2], S[2 * ks][3], p0, true);
            int p1 = __builtin_amdgcn_cvt_pk_fp8_f32(S[2 * ks + 1][0], S[2 * ks + 1][1], 0, false); p1 = __builtin_amdgcn_cvt_pk_fp8_f32(S[2 * ks + 1][2], S[2 * ks + 1][3], p1, true);
            const fp8x8 pf = (fp8x8)(((unsigned long long)(unsigned)p1 << 32) | (unsigned)p0);
            v2u f[4];
            asm volatile("s_waitcnt lgkmcnt(0)\n\t"
                         "ds_read_b64_tr_b8 %0, %4\n\tds_read_b64_tr_b8 %1, %5\n\tds_read_b64_tr_b8 %2, %6\n\tds_read_b64_tr_b8 %3, %7\n\t"
                         "s_waitcnt lgkmcnt(0)"
                         : "=&v"(f[0]), "=&v"(f[1]), "=&v"(f[2]), "=&v"(f[3])
                         : "v"(tra[0] + 2048u * ks), "v"(tra[1] + 2048u * ks), "v"(tra[2] + 2048u * ks), "v"(tra[3] + 2048u * ks)
                         : "memory");
#pragma unroll
            for (int c = 0; c < 4; ++c) O[c] = __builtin_amdgcn_mfma_f32_16x16x32_fp8_fp8((fp8x8)(((unsigned long long)f[c].y << 32) | f[c].x), pf, O[c], 0, 0, 0);
            Osum = __builtin_amdgcn_mfma_f32_16x16x32_fp8_fp8(aones, pf, Osum, 0, 0, 0);
        }
        const float inv = 1.0f / lane_get(Osum[0], m);
#pragma unroll
        for (int c = 0; c < 4; ++c) { v2u w; w.x = pk2(O[c][0] * inv, O[c][1] * inv); w.y = pk2(O[c][2] * inv, O[c][3] * inv);
            *(GAS v2u*)(OB + (size_t)tok * D + m * 64 + 16 * c + 4 * g) = w; }
    }
    asm volatile("s_waitcnt vmcnt(0)" ::: "memory");
}
constexpr int XCS = 136;
constexpr int HHS = 132;
__device__ __forceinline__ float gelu_tanh(float x) {
    const float z = 0.7978845608028654f * (x + 0.044715f * x * x * x);
    const float e = __builtin_amdgcn_exp2f(2.885390081777927f * z);
    const float th = 1.0f - 2.0f * __builtin_amdgcn_rcpf(e + 1.0f);
    return 0.5f * x * (1.0f + th);
}
template <bool DRY = false>
__device__ __forceinline__ void lru_phase(const Frame& F0, int L) {
    Frame F = launder(F0);
    const KArgs ka = kargs();
    const int b = F.bx >> 3, nb = F.bx & 7;
    const bf16* XR = (const bf16*)(F.ws + Z_XR); bf16* YR = (bf16*)(F.ws + Z_YR);
    const bf16* WL = (const bf16*)(F.ws + WS_W + W_LRU);
    LAS bf16* XC = (LAS bf16*)(F.lds + RING_OFF);
    LAS float* HH = (LAS float*)(F.lds + RING_OFF + 2 * 64 * XCS * 2);
    const int tid = F.tid, lane = F.lane, w = F.wave, g = lane >> 4, m = lane & 15;
    const int cc = tid & 15, tp = tid >> 4;
    const int ch0 = nb * 128 + 8 * cc;
    float cw[4][8], cbias[8];
#pragma unroll
    for (int j = 0; j < 4; ++j)
#pragma unroll
        for (int k = 0; k < 8; ++k) cw[j][k] = ka->in[I_CONVW][(size_t)L * 4 * D + j * D + ch0 + k];
#pragma unroll
    for (int k = 0; k < 8; ++k) cbias[k] = ka->in[I_CONVB][(size_t)L * D + ch0 + k];
    bf16x8 Br[4], Bi[4];
#pragma unroll
    for (int s = 0; s < 4; ++s) { Br[s] = *(const GAS bf16x8*)(WL + ((size_t)nb * 128 + 16 * w + m) * 128 + 32 * s + 8 * g);
                                  Bi[s] = *(const GAS bf16x8*)(WL + (size_t)8 * 128 * 128 + ((size_t)nb * 128 + 16 * w + m) * 128 + 32 * s + 8 * g); }
    const int chl = 16 * w + m, chg = nb * 128 + chl;
    const float ba = ka->in[I_LRUBA][(size_t)L * D + chg], bx = ka->in[I_LRUBX][(size_t)L * D + chg];
    const float lam = ka->in[I_LAM][(size_t)L * D + chg];
    const float sp8 = -8.0f * (fmaxf(-lam, 0.f) + log1pf(__expf(-fabsf(lam))));
    float carry = 0.f;
    const size_t rowb = (size_t)b * SEQ;
    v4u nxin[5], nyin[2];
#pragma unroll
    for (int k = 0; k < 5; ++k) { const int t = 2 * tp - 3 + k; v4u z; z.x = z.y = z.z = z.w = 0u; nxin[k] = (t >= 0) ? *(const GAS v4u*)(XR + (rowb + t) * D + ch0) : z; }
#pragma unroll
    for (int k = 0; k < 2; ++k) nyin[k] = *(const GAS v4u*)(YR + (rowb + 2 * tp + k) * D + ch0);
    for (int tile = 0; tile < 32; ++tile) {
        const int t0 = tile * 64, buf = tile & 1;
        LAS bf16* xc = XC + buf * 64 * XCS; LAS float* hh = HH + buf * 64 * HHS;
        v4u xin[5], yin[2];
#pragma unroll
        for (int k = 0; k < 5; ++k) xin[k] = nxin[k];
#pragma unroll
        for (int k = 0; k < 2; ++k) yin[k] = nyin[k];
        if (tile < 31) {
#pragma unroll
            for (int k = 0; k < 5; ++k) nxin[k] = *(const GAS v4u*)(XR + (rowb + t0 + 64 + 2 * tp - 3 + k) * D + ch0);
#pragma unroll
            for (int k = 0; k < 2; ++k) nyin[k] = *(const GAS v4u*)(YR + (rowb + t0 + 64 + 2 * tp + k) * D + ch0);
        }
#pragma unroll
        for (int k = 0; k < 2; ++k) { float o[8];
#pragma unroll
            for (int c = 0; c < 8; ++c) { float a = cbias[c];
#pragma unroll
                for (int j = 0; j < 4; ++j) { const unsigned wv = xin[k + j][c >> 1]; a += ((c & 1) ? bf_hi(wv) : bf_lo(wv)) * cw[j][c]; }
                o[c] = a; }
            v4u pw; pw.x = pk2(o[0], o[1]); pw.y = pk2(o[2], o[3]); pw.z = pk2(o[4], o[5]); pw.w = pk2(o[6], o[7]);
            *(LAS v4u*)(xc + (2 * tp + k) * XCS + 8 * cc) = pw; }
        __syncthreads();
#pragma unroll
        for (int mt = 0; mt < 4; ++mt) {
            f32x4 ar = (f32x4){0.f, 0.f, 0.f, 0.f}, ai = (f32x4){0.f, 0.f, 0.f, 0.f};
#pragma unroll
            for (int s = 0; s < 4; ++s) { const bf16x8 A = *(const LAS bf16x8*)(xc + (16 * mt + m) * XCS + 32 * s + 8 * g);
                ar = __builtin_amdgcn_mfma_f32_16x16x32_bf16(A, Br[s], ar, 0, 0, 0); ai = __builtin_amdgcn_mfma_f32_16x16x32_bf16(A, Bi[s], ai, 0, 0, 0); }
            float P[4], W[4];
#pragma unroll
            for (int i = 0; i < 4; ++i) {
                const float rr = sigmoidf_fast(ar[i] + ba), ig = sigmoidf_fast(ai[i] + bx);
                const float la = sp8 * rr;
                const float a = __builtin_amdgcn_exp2f(1.4426950408889634f * la);
                const float mult = __builtin_amdgcn_sqrtf(fmaxf(__builtin_fmaf(-a, a, 1.0f), 0.f));
                const float xv = __builtin_bit_cast(float, (unsigned)xc[(16 * mt + 4 * g + i) * XCS + chl] << 16);
                const float u = mult * (ig * xv);
                if (i == 0) { P[0] = a; W[0] = u; } else { P[i] = a * P[i - 1]; W[i] = a * W[i - 1] + u; }
            }
            float Ac = P[3], Uc = W[3];
            { const float A1 = lane_up(Ac, 16, lane), U1 = lane_up(Uc, 16, lane); if (g >= 1) { Uc = Ac * U1 + Uc; Ac = Ac * A1; } }
            { const float A2 = lane_up(Ac, 32, lane), U2 = lane_up(Uc, 32, lane); if (g >= 2) { Uc = Ac * U2 + Uc; Ac = Ac * A2; } }
            float Ae = lane_up(Ac, 16, lane), Ue = lane_up(Uc, 16, lane); if (g == 0) { Ae = 1.f; Ue = 0.f; }
            const float hin = Ae * carry + Ue;
            const float cnew = Ac * carry + Uc;
            carry = lane_get(cnew, 48 + m);
#pragma unroll
            for (int i = 0; i < 4; ++i) hh[(16 * mt + 4 * g + i) * HHS + chl] = P[i] * hin + W[i];
        }
        __syncthreads();
#pragma unroll
        for (int k = 0; k < 2; ++k) { const f32x4 h0 = *(const LAS f32x4*)(hh + (2 * tp + k) * HHS + 8 * cc), h1 = *(const LAS f32x4*)(hh + (2 * tp + k) * HHS + 8 * cc + 4);
            float o[8];
#pragma unroll
            for (int c = 0; c < 8; ++c) { const unsigned wv = yin[k][c >> 1]; const float y = (c & 1) ? bf_hi(wv) : bf_lo(wv); o[c] = (c < 4 ? h0[c] : h1[c - 4]) * gelu_tanh(y); }
            v4u pw; pw.x = pk2(o[0], o[1]); pw.y = pk2(o[2], o[3]); pw.z = pk2(o[4], o[5]); pw.w = pk2(o[6], o[7]);
            *(GAS v4u*)((DRY ? (bf16*)(F.ws + WS_NEED) : YR) + (rowb + t0 + 2 * tp + k) * D + ch0) = pw; }
    }
    __syncthreads();
}

struct MoeOrder : pg8::StaticOrder {
    const volatile LAS unsigned* tb; int tile0; const int* list; size_t bstride;
    __device__ __forceinline__ int expert_of(int gt) const { int e = 0;
#pragma unroll
        for (int k = 1; k < 8; ++k) e += (gt >= (int)tb[k]) ? 1 : 0;
        return e; }
    __device__ __forceinline__ const char* b_base(const pg8::Gemm& g, const pg8::Unit& u, size_t tstep) const { return (const char*)g.Bt + (size_t)expert_of(tile0 + u.pm) * bstride + (size_t)u.pn * tstep; }
};
struct MoeGatherOrder : MoeOrder {
    static constexpr bool GATHER = true;
    __device__ __forceinline__ const char* a_base(const pg8::Gemm& g, const pg8::Unit&, size_t) const { return (const char*)g.A; }
    __device__ __forceinline__ void a_rows(const pg8::Unit& u, int R0, int R1, int C0, int C1, int K, unsigned (&off)[2][2]) const {
        const int gt = tile0 + u.pm, e = expert_of(gt), j = gt - (int)tb[e], n = (int)tb[16 + e];
        const GAS int* le = (const GAS int*)list + (size_t)e * T_TOK;
#pragma unroll
        for (int h = 0; h < 2; ++h) { int p0 = 256 * j + 128 * h + R0, p1 = 256 * j + 128 * h + R1; p0 = p0 < n ? p0 : n - 1; p1 = p1 < n ? p1 : n - 1;
            off[h][0] = ((unsigned)le[p0] * (unsigned)K + (unsigned)C0) * 2u; off[h][1] = ((unsigned)le[p1] * (unsigned)K + (unsigned)C1) * 2u; }
    }
};
#ifdef SELFCHECK
#ifndef SC_TOL
#define SC_TOL 0.03f
#define SC_ABS 1e-5f
#endif
__device__ __forceinline__ float sc_bf(const bf16* p, size_t i) { return __builtin_bit_cast(float, (unsigned)((const GAS bf16*)p)[i] << 16); }
__device__ __forceinline__ float sc_f8(const unsigned char* p, size_t i) {
    const unsigned v = ((const GAS unsigned char*)p)[i]; const unsigned e = (v >> 3) & 15u, mn = v & 7u; float r;
    if (e == 0u) r = (float)mn * 0.001953125f; else r = (1.0f + (float)mn * 0.125f) * exp2f((float)e - 7.0f);
    return (v & 128u) ? -r : r; }
__device__ __forceinline__ void sc_fail(const Frame& F, unsigned code) { __hip_atomic_fetch_or(F.ctl + CW_CODE, code, RLX_AGENT); }
__device__ __forceinline__ int sc_bucket_ref(int rel) {
    const int half = 16, max_exact = 8; const int ret = rel > 0 ? half : 0; const int n = rel < 0 ? -rel : rel;
    const float nf = (float)(n > 1 ? n : 1);
    int large = max_exact + (int)(logf(nf / (float)max_exact) / logf(16.0f) * (float)(half - max_exact));
    large = large < half - 1 ? large : half - 1;
    return ret + (n < max_exact ? n : large);
}
__device__ __forceinline__ void selfcheck_topk(const Frame& F0) {
    Frame F = launder(F0);
    if (F.wave != 0) return;
    const bf16* QI = (const bf16*)(F.ws + Z_QI); const bf16* SM = (const bf16*)(F.ws + Z_SM);
    const GAS unsigned short* IDX = (const GAS unsigned short*)(F.ws + WS_IDX);
    LAS float* sc = (LAS float*)(F.lds + RING_OFF);
    LAS unsigned* bm = (LAS unsigned*)(F.lds + RING_OFF + 8192);
    const int tok = F.bx * 256 + ((F.bx * 37) & 255), b = tok >> 11, tq = tok & (SEQ - 1), n_adm = ((tq >> 6) + 1) * 64;
    const int lane = F.lane;
    bm[lane] = 0u;
    for (int s = lane; s < n_adm; s += 64) { float score = 0.f;
        for (int h = 0; h < 8; ++h) { float d = 0.f;
            for (int k = 0; k < 64; ++k) d += sc_bf(QI, (size_t)tok * 512 + h * 64 + k) * sc_bf(SM, (size_t)(b * SEQ + s) * 256 + 128 + k);
            score += fmaxf(d, 0.f) * sc_bf(SM, (size_t)tok * 256 + 192 + h); }
        sc[s] = score; }
    asm volatile("s_waitcnt lgkmcnt(0)" ::: "memory");
    const int nsel = n_adm < 256 ? n_adm : 256;
    float msel = 3.0e38f; bool bad = false;
    for (int p = lane; p < nsel; p += 64) { const int key = IDX[(size_t)tok * 256 + p]; if (key >= n_adm) { bad = true; continue; }
        const unsigned old = __hip_atomic_fetch_or(bm + (key >> 5), 1u << (key & 31), __ATOMIC_RELAXED, __HIP_MEMORY_SCOPE_WORKGROUP); if (old & (1u << (key & 31))) bad = true;
        msel = fminf(msel, sc[key]); }
    asm volatile("s_waitcnt lgkmcnt(0)" ::: "memory");
    float muns = -3.0e38f, amax = 0.f;
    for (int s = lane; s < n_adm; s += 64) { amax = fmaxf(amax, fabsf(sc[s])); if (!((bm[s >> 5] >> (s & 31)) & 1u)) muns = fmaxf(muns, sc[s]); }
#pragma unroll
    for (int o = 1; o < 64; o <<= 1) { msel = fminf(msel, lane_xor(msel, o, lane)); muns = fmaxf(muns, lane_xor(muns, o, lane)); amax = fmaxf(amax, lane_xor(amax, o, lane)); }
    if (muns > msel + 1e-4f * amax) bad = true;
    if (__any(bad)) { if (lane == 0) sc_fail(F, 1u); }
}
__device__ __forceinline__ void selfcheck_attn(const Frame& F0) {
    Frame F = launder(F0);
    if (F.wave != 0) return;
    const KArgs ka = kargs();
    const unsigned char* Q8 = F.ws + Z_Q8; const unsigned char* KV8 = F.ws + Z_KV8; const bf16* OB = (const bf16*)(F.ws + Z_XR);
    const GAS unsigned short* IDX = (const GAS unsigned short*)(F.ws + WS_IDX);
    LAS float* lg = (LAS float*)(F.lds + RING_OFF + 65536);
    const int tok = F.bx * 256 + ((F.bx * 37) & 255), b = tok >> 11, tq = tok & (SEQ - 1), n_adm = ((tq >> 6) + 1) * 64, nv = n_adm < 256 ? n_adm : 256;
    const int lane = F.lane;
    for (int p = lane; p < 256; p += 64) { const int key = IDX[(size_t)tok * 256 + p]; const int bk = sc_bucket_ref(key - tq);
        for (int h = 0; h < 16; ++h) { float d = 0.f;
            for (int k = 0; k < 64; ++k) d += sc_f8(Q8, (size_t)tok * D + h * 64 + k) * sc_f8(KV8, (size_t)(b * SEQ + key) * 128 + k);
            lg[h * 256 + p] = p < nv ? 0.125f * d + ((const GAS float*)ka->in[I_RELB])[bk * 16 + h] : -1e30f; } }
    asm volatile("s_waitcnt lgkmcnt(0)" ::: "memory");
    if (lane < 16) { float mx = -3.0e38f; for (int p = 0; p < 256; ++p) mx = fmaxf(mx, lg[lane * 256 + p]); float sum = 0.f;
        for (int p = 0; p < 256; ++p) { const float e = __expf(lg[lane * 256 + p] - mx); lg[lane * 256 + p] = e; sum += e; }
        const float inv = 1.f / sum; for (int p = 0; p < 256; ++p) lg[lane * 256 + p] *= inv; }
    asm volatile("s_waitcnt lgkmcnt(0)" ::: "memory");
    float emax = 0.f, omax = 0.f;
    for (int o = lane; o < 1024; o += 64) { const int h = o >> 6, d = o & 63; float acc = 0.f;
        for (int p = 0; p < 256; ++p) { const int key = IDX[(size_t)tok * 256 + p]; acc += lg[h * 256 + p] * sc_f8(KV8, (size_t)(b * SEQ + key) * 128 + 64 + d); }
        const float got = sc_bf(OB, (size_t)tok * D + o); emax = fmaxf(emax, fabsf(got - acc)); omax = fmaxf(omax, fabsf(acc)); }
#pragma unroll
    for (int o = 1; o < 64; o <<= 1) { emax = fmaxf(emax, lane_xor(emax, o, lane)); omax = fmaxf(omax, lane_xor(omax, o, lane)); }
    if (!(emax <= SC_TOL * omax + SC_ABS)) { if (lane == 0) sc_fail(F, 2u); }
}
__device__ __forceinline__ void selfcheck_lru(const Frame& F0, int L, bool after) {
    Frame F = launder(F0);
    if (F.wave != 0) return;
    const KArgs ka = kargs();
    const bf16* XR = (const bf16*)(F.ws + Z_XR); const bf16* YR = (const bf16*)(F.ws + Z_YR);
    GAS float* EXP = (GAS float*)(F.ws + WS_NEED) + (size_t)F.bx * SEQ;
    const int b = F.bx >> 3, ch = ((F.bx & 7) * 128 + ((F.bx * 29) & 127)), nb = ch >> 7, lane = F.lane;
    if (after) { float emax = 0.f, omax = 0.f;
        for (int t = lane; t < SEQ; t += 64) { const float e = EXP[t], g = sc_bf(YR, (size_t)(b * SEQ + t) * D + ch); emax = fmaxf(emax, fabsf(e - g)); omax = fmaxf(omax, fabsf(e)); }
#pragma unroll
        for (int o = 1; o < 64; o <<= 1) { emax = fmaxf(emax, lane_xor(emax, o, lane)); omax = fmaxf(omax, lane_xor(omax, o, lane)); }
        if (!(emax <= SC_TOL * omax + SC_ABS)) { if (lane == 0) sc_fail(F, 4u); }
        return; }
    const float* cw = ka->in[I_CONVW] + (size_t)L * 4 * D; const float* cb = ka->in[I_CONVB] + (size_t)L * D;
    const float* wa = ka->in[I_LRUWA] + ((size_t)L * 8 + nb) * 128 * 128; const float* wx = ka->in[I_LRUWX] + ((size_t)L * 8 + nb) * 128 * 128;
    const float lam = ka->in[I_LAM][(size_t)L * D + ch], ba = ka->in[I_LRUBA][(size_t)L * D + ch], bx = ka->in[I_LRUBX][(size_t)L * D + ch];
    const float sp = fmaxf(-lam, 0.f) + log1pf(expf(-fabsf(lam)));
    const int dl = ch & 127;
    float h = 0.f;
    for (int t = 0; t < SEQ; ++t) {
        float pr = 0.f, pi = 0.f, xcc = 0.f;
#pragma unroll
        for (int q = 0; q < 2; ++q) { const int cl = lane + 64 * q, cg = nb * 128 + cl; float xc = cb[cg];
            for (int j = 0; j < 4; ++j) { const int tt = t - 3 + j; if (tt >= 0) xc += sc_bf(XR, (size_t)(b * SEQ + tt) * D + cg) * cw[j * D + cg]; }
            pr += xc * wa[cl * 128 + dl]; pi += xc * wx[cl * 128 + dl]; if (cl == dl) xcc = xc; }
#pragma unroll
        for (int o = 1; o < 64; o <<= 1) { pr += lane_xor(pr, o, lane); pi += lane_xor(pi, o, lane); xcc += lane_xor(xcc, o, lane); }
        const float r = 1.f / (1.f + expf(-(pr + ba))), ig = 1.f / (1.f + expf(-(pi + bx)));
        const float la = -8.0f * r * sp, a = expf(la), u = sqrtf(-expm1f(2.0f * la)) * (ig * xcc);
        h = a * h + u;
        const float y = sc_bf(YR, (size_t)(b * SEQ + t) * D + ch);
        const float gl = 0.5f * y * (1.f + tanhf(0.7978845608028654f * (y + 0.044715f * y * y * y)));
        if (lane == 0) EXP[t] = h * gl;
    }
}
#endif
__global__ void __launch_bounds__(NWAVES * 64, 2) mk_fwd(Args args) {
    extern __shared__ __attribute__((aligned(16))) unsigned char lds[];
    Frame F;
    F.lds = (LAS unsigned char*)lds;
    F.MISC = (volatile LAS unsigned*)(F.lds + MISC_OFF);
    F.tid = threadIdx.x; F.lane = F.tid & 63; F.wave = __builtin_amdgcn_readfirstlane(F.tid >> 6);
    F.G = gridDim.x; F.bx = blockIdx.x;
    F.ws = args.ws; F.ctl = (gu32*)(args.ws + WS_CTL); F.out = args.out;
    for (int u = threadIdx.x; u < (LDS_BYTES - LDSCTL_OFF) / 4; u += NWAVES * 64) ((LAS unsigned*)(F.lds + LDSCTL_OFF))[u] = 0u;
    __syncthreads();
    XcdBarrier bar = xcd_barrier_post((unsigned*)(F.ctl + CW_BAR), F.MISC + 8);
#ifdef PROBE_XCC
    if ((blockIdx.x & 7u) != (bar.x & 7u)) { const unsigned long long t0 = __builtin_amdgcn_s_memrealtime(); while (__builtin_amdgcn_s_memrealtime() - t0 < 200000ull) __builtin_amdgcn_s_sleep(8); }
#endif
#ifdef PROF_SEL
#ifndef PROF_WG
#define PROF_WG 0
#endif
#ifndef PROF_SEL2
#define PROF_SEL2 50
#endif
#ifndef PROF_MUL
#define PROF_MUL 1.0f
#endif
#define PROF_END(slot) do { if (launder(F).tid == 0) { const unsigned t_ = (unsigned)__builtin_amdgcn_s_memrealtime(); F.MISC[64 + (slot)] += t_ - F.MISC[96]; F.MISC[96] = t_; F.MISC[99] = (slot); } } while (0)
#define PROF_BEGIN(ph) do { if (launder(F).tid == 0) F.MISC[101] = (ph); } while (0)
#define PROF_WAIT() do { if (launder(F).tid == 0) { const unsigned t_ = (unsigned)__builtin_amdgcn_s_memrealtime(); F.MISC[80 + F.MISC[99]] += t_ - F.MISC[96]; F.MISC[64 + 13] += t_ - F.MISC[96]; F.MISC[96] = t_; } } while (0)
    if (F.tid == 0) { const unsigned t_ = (unsigned)__builtin_amdgcn_s_memrealtime(); F.MISC[96] = t_; F.MISC[98] = t_; }
#else
#define PROF_END(slot) do { } while (0)
#define PROF_BEGIN(ph) do { } while (0)
#define PROF_WAIT() do { } while (0)
#endif
#define GRID_BAR() do { XcdBarrier b_ = bar; unsigned* p_ = bar.bar; asm volatile("" : "+s"(p_)); b_.bar = p_; xcd_barrier(b_); PROF_WAIT(); } while (0)
    float* X32 = args.out;
#define LOCAL_HANDOFF() do { asm volatile("s_waitcnt vmcnt(0)" ::: "memory"); __syncthreads(); __builtin_amdgcn_fence(__ATOMIC_ACQUIRE, "agent"); asm volatile("s_waitcnt vmcnt(0)" ::: "memory"); __syncthreads(); } while (0)
    LAS unsigned char* ring = F.lds + RING_OFF;
    using pg8::Gemm; using pg8::StaticOrder;

    for (int L = -1; L < DEPTH; ++L) {
        const int odd = L & 1;
        if (L >= 0) {
        { const Frame P = launder(F); unsigned char* ws = P.ws; unsigned char* wb = ws + WS_W; bf16* XB = (bf16*)(ws + WS_XB); (void)XB; (void)wb;
          Gemm g{XB, (const bf16*)(wb + W_IN), T_TOK, NIN, D}; StaticOrder S; S.init(T_TOK, NIN, P.G, P.bx);
          pg8::EpiZ E{(bf16*)(ws + Z_Q), (bf16*)(ws + Z_QI), (bf16*)(ws + Z_SM), ws + Z_Q8, ws + Z_KV8};
PROF_BEGIN(1);
#ifndef SK_G1
          pg8::gemm_phase<pg8::EpiZ, StaticOrder>(ring, g, S, E, P.wave);
#endif
#ifdef DUP_G1
          pg8::gemm_phase<pg8::EpiZ, StaticOrder>(ring, g, S, E, P.wave);
#endif
        }
        PROF_END(1);
        GRID_BAR();
#if defined(SELFCHECK) && SELFCHECK == 3
        if (L == 0) { selfcheck_lru(F, L, false); __syncthreads(); }
#endif
#ifdef DUP_IDX
        indexer_phase<DUP_IDX>(F);
#endif
#ifndef SK_IDX
        indexer_phase(F);
#endif
#ifdef DUP_LRU
        lru_phase<true>(F, L);
#endif
#ifndef SK_LRU
        lru_phase(F, L);
#endif
        PROF_END(2);
        GRID_BAR();
#if defined(SELFCHECK) && SELFCHECK == 1
        if (L == 0) { selfcheck_topk(F); __syncthreads(); }
#endif
#if defined(SELFCHECK) && SELFCHECK == 3
        if (L == 0) { selfcheck_lru(F, L, true); __syncthreads(); }
#endif
#ifdef DUP_ATT
        attention_phase<DUP_ATT>(F); __syncthreads();
#endif
#ifndef SK_ATT
#ifdef ATT_V1
        attention_phase(F);
#else
        attention_phase2(F);
#endif
#endif
        PROF_END(3);
        GRID_BAR();
#if defined(SELFCHECK) && SELFCHECK == 2
        if (L == 0) { selfcheck_attn(F); __syncthreads(); }
#endif
        { const Frame P = launder(F); unsigned char* ws = P.ws; unsigned char* wb = ws + WS_W; bf16* XB = (bf16*)(ws + WS_XB); (void)XB; (void)wb;
          Gemm g{(const bf16*)(ws + Z_XR), (const bf16*)(wb + W_BRA), T_TOK, D, D}; StaticOrder S; S.init(T_TOK, D, F.G, F.bx);
          pg8::EpiGate<0> E{(bf16*)(ws + Z_GA), nullptr};
PROF_BEGIN(2);
#ifndef SK_G2
          pg8::gemm_phase<pg8::EpiGate<0>, StaticOrder>(ring, g, S, E, P.wave);
#endif
        }
        LOCAL_HANDOFF();
        { const Frame P = launder(F); unsigned char* ws = P.ws; unsigned char* wb = ws + WS_W; bf16* XB = (bf16*)(ws + WS_XB); (void)XB; (void)wb;
          Gemm g{(const bf16*)(ws + Z_YR), (const bf16*)(wb + W_BRR), T_TOK, D, D}; StaticOrder S; S.init(T_TOK, D, F.G, F.bx);
          pg8::EpiGate<1> E{(bf16*)(ws + Z_GA), (const bf16*)(ws + Z_GR)};
PROF_BEGIN(3);
#ifndef SK_G3
          pg8::gemm_phase<pg8::EpiGate<1>, StaticOrder>(ring, g, S, E, P.wave);
#endif
        }
        PROF_END(4);
        GRID_BAR();
        { const Frame P = launder(F); unsigned char* ws = P.ws; unsigned char* wb = ws + WS_W; bf16* XB = (bf16*)(ws + WS_XB); (void)XB; (void)wb;
          Gemm g{(const bf16*)(ws + Z_GA), (const bf16*)(wb + W_O), T_TOK, D, D}; StaticOrder S; S.init(T_TOK, D, F.G, F.bx);
          pg8::EpiBf16 E{(bf16*)(ws + Z_GR), D, 0};
PROF_BEGIN(4);
#ifndef SK_G4
          pg8::gemm_phase<pg8::EpiBf16, StaticOrder>(ring, g, S, E, P.wave);
#endif
#ifdef DUP_G4
          pg8::gemm_phase<pg8::EpiBf16, StaticOrder>(ring, g, S, E, P.wave);
#endif
        }
        PROF_END(5);
        GRID_BAR();
#ifdef DUP_LN
        ln_phase<false, false, true>(F, L); ln_phase<false, false, true>(F, L);
#endif
#ifndef SK_LN
        if (odd) ln_phase<false, true>(F, L); else ln_phase<false, false>(F, L);
#endif
        PROF_END(6);
        GRID_BAR();
        if (odd) {
            if (launder(F).tid == 0) { unsigned acc = 0u; F.MISC[16] = 0u;
                for (int e = 0; e < 8; ++e) { const unsigned c = __hip_atomic_load(F.ctl + CW_CNT + (L >> 1) * 1024 + 64 * e, RLX_AGENT); F.MISC[32 + e] = c; acc += (c + 255u) >> 8; F.MISC[17 + e] = acc; } }
            __syncthreads();
        }
        { const Frame P = launder(F); unsigned char* ws = P.ws; unsigned char* wb = ws + WS_W; bf16* XB = (bf16*)(ws + WS_XB); (void)XB; (void)wb;
          Gemm g{(const bf16*)(ws + F_PB), (const bf16*)(wb + W_PP), T_TOK, D, PLE}; StaticOrder S; S.init(T_TOK, D, F.G, F.bx);
          pg8::EpiBf16 E{(bf16*)(ws + F_U), D, 0};
PROF_BEGIN(5);
#ifndef SK_G5
          pg8::gemm_phase<pg8::EpiBf16, StaticOrder>(ring, g, S, E, P.wave);
#endif
        }
        LOCAL_HANDOFF();
        { const Frame P = launder(F); unsigned char* ws = P.ws; unsigned char* wb = ws + WS_W; bf16* XB = (bf16*)(ws + WS_XB); (void)XB; (void)wb;
          Gemm g{XB, (const bf16*)(wb + W_PG), T_TOK, D, D}; StaticOrder S; S.init(T_TOK, D, F.G, F.bx);
          pg8::EpiPle E{(bf16*)(ws + F_U)};
PROF_BEGIN(6);
#ifndef SK_G6
          pg8::gemm_phase<pg8::EpiPle, StaticOrder>(ring, g, S, E, P.wave);
#endif
        }
        PROF_END(7);
        if (!odd) {
            { const Frame P = launder(F); unsigned char* ws = P.ws; unsigned char* wb = ws + WS_W; bf16* XB = (bf16*)(ws + WS_XB); (void)XB; (void)wb;
          Gemm g{XB, (const bf16*)(wb + W_FF), T_TOK, 2 * DFF, D}; StaticOrder S; S.init(T_TOK, 2 * DFF, F.G, F.bx);
              pg8::EpiSwiglu E{(bf16*)(ws + F_H), DFF};
PROF_BEGIN(7);
#ifndef SK_G7
              pg8::gemm_phase<pg8::EpiSwiglu, StaticOrder>(ring, g, S, E, P.wave);
#endif
#ifdef DUP_G7
              pg8::gemm_phase<pg8::EpiSwiglu, StaticOrder>(ring, g, S, E, P.wave);
#endif
        }
            PROF_END(8);
            GRID_BAR();
            { const Frame P = launder(F); unsigned char* ws = P.ws; unsigned char* wb = ws + WS_W; bf16* XB = (bf16*)(ws + WS_XB); (void)XB; (void)wb;
          Gemm g{(const bf16*)(ws + F_H), (const bf16*)(wb + W_FF_DN_DENSE), T_TOK, D, DFF}; StaticOrder S; S.init(T_TOK, D, F.G, F.bx);
              pg8::EpiBf16 E{(bf16*)(ws + Z_GR), D, 0};
PROF_BEGIN(8);
#ifndef SK_G8
              pg8::gemm_phase<pg8::EpiBf16, StaticOrder>(ring, g, S, E, P.wave);
#endif
#ifdef DUP_G8
              pg8::gemm_phase<pg8::EpiBf16, StaticOrder>(ring, g, S, E, P.wave);
#endif
        }
            PROF_END(9);
            GRID_BAR();
#ifndef SK_LN
            ln_phase<true, false>(F, L);
#endif
        } else {
            const int ntiles = (int)F.MISC[24];
            const int nchunks = (ntiles + MOE_CHUNK_TILES - 1) / MOE_CHUNK_TILES;
            for (int c = 0; c < nchunks; ++c) {
                const int tile0 = c * MOE_CHUNK_TILES, ntl = (ntiles - tile0) < MOE_CHUNK_TILES ? (ntiles - tile0) : MOE_CHUNK_TILES;
                const size_t hc_off = (c & 1) ? F_H1 : F_H;
                { const Frame P = launder(F); unsigned char* ws = P.ws; unsigned char* wb = ws + WS_W; bf16* XB = (bf16*)(ws + WS_XB); (void)XB; (void)wb;
          Gemm g{XB, (const bf16*)(wb + W_FF), ntl * 256, 2 * DFFE, D}; MoeGatherOrder S; S.init(ntl * 256, 2 * DFFE, F.G, F.bx);
                  S.tb = F.MISC + 16; S.tile0 = tile0; S.list = (const int*)(ws + WS_LIST); S.bstride = (size_t)2 * DFFE * D * 2;
                  pg8::EpiSwiglu E{(bf16*)(ws + hc_off), DFFE};
PROF_BEGIN(9);
#ifndef SK_G9
                  pg8::gemm_phase<pg8::EpiSwiglu, MoeGatherOrder>(ring, g, S, E, P.wave);
#endif
        }
                PROF_END(10);
                GRID_BAR();
                { const Frame P = launder(F); unsigned char* ws = P.ws; unsigned char* wb = ws + WS_W; bf16* XB = (bf16*)(ws + WS_XB); (void)XB; (void)wb;
          Gemm g{(const bf16*)(ws + hc_off), (const bf16*)(wb + W_FF_DN_MOE), ntl * 256, D, DFFE}; MoeOrder S; S.init(ntl * 256, D, F.G, F.bx);
                  S.tb = F.MISC + 16; S.tile0 = tile0; S.list = nullptr; S.bstride = (size_t)D * DFFE * 2;
                  pg8::EpiBf16 E{(bf16*)(ws + F_YE), D, tile0 * 256};
PROF_BEGIN(10);
#ifndef SK_G10
                  pg8::gemm_phase<pg8::EpiBf16, MoeOrder>(ring, g, S, E, P.wave);
#endif
        }
                PROF_END(11);
            }
            PROF_END(11);
            GRID_BAR();
#ifndef SK_LN
            ln_phase<true, true>(F, L);
#endif
        }
        }
        if (L + 1 < DEPTH) { __syncthreads(); p0_convert(F, L + 1); }
        PROF_END(12);
#ifdef PROF_SEL
        if (L == DEPTH - 1 && F.bx == PROF_WG && launder(F).tid == 0) { const unsigned t_ = (unsigned)__builtin_amdgcn_s_memrealtime(); const float tot_ = (float)F.MISC[106] + (float)F.MISC[107] + (float)F.MISC[108] + (float)F.MISC[109] + (float)F.MISC[110] + (float)F.MISC[111] + (float)F.MISC[112] + (float)F.MISC[113];
            const float f_ = (PROF_SEL >= 50) ? (float)F.MISC[106 + (PROF_SEL - 50)] / tot_ : (PROF_SEL == 41) ? (float)F.MISC[105] / (float)F.MISC[104] : (PROF_SEL == 40) ? (float)F.MISC[104] / (float)F.MISC[64 + 14] * (1.0f / 40.0f) : PROF_MUL * (float)F.MISC[64 + PROF_SEL] / (float)(t_ - F.MISC[98]);
            const float g_ = (PROF_SEL >= 50) ? (float)F.MISC[106 + (PROF_SEL2 - 50)] / tot_ : 0.0f;
            __hip_atomic_store(F.ctl + 9, __builtin_bit_cast(unsigned, g_), __ATOMIC_RELAXED, __HIP_MEMORY_SCOPE_AGENT);
            __hip_atomic_store(F.ctl + 8, __builtin_bit_cast(unsigned, f_), __ATOMIC_RELAXED, __HIP_MEMORY_SCOPE_AGENT); }
#endif
        GRID_BAR();
    }
#ifdef PROF_SEL
    { const float f_ = __builtin_bit_cast(float, __hip_atomic_load(F.ctl + 8, RLX_AGENT)); const float s_ = 1.0f + floorf(sqrtf(f_) * 32.0f + 0.5f) * (1.0f / 32.0f);
      for (size_t i = (size_t)F.bx * 512 + launder(F).tid; i < (size_t)T_TOK * D; i += (size_t)F.G * 512) X32[i] *= s_;
      const float g_ = __builtin_bit_cast(float, __hip_atomic_load(F.ctl + 9, RLX_AGENT)); if (F.bx == 0 && launder(F).tid == 0 && g_ > 0.f) X32[0] = 400.0f * floorf(g_ * 32.0f + 0.5f) * (1.0f / 32.0f); }
#endif
    if (__hip_atomic_load(F.ctl + CW_BAR + XB_TMO, RLX_AGENT) != 0u || __hip_atomic_load(F.ctl + CW_CODE, RLX_AGENT) != 0u) {
        const float q = __builtin_nanf("");
        for (size_t i = (size_t)F.bx * 512 + launder(F).tid; i < (size_t)T_TOK * D; i += (size_t)F.G * 512) X32[i] = q;
    }
}

#if defined(SELFCHECK)
constexpr size_t WS_DRY_EXTRA = 4 * MiB;
#elif defined(DUP_LRU) || defined(DUP_LN)
constexpr size_t WS_DRY_EXTRA = 80 * MiB;
#else
constexpr size_t WS_DRY_EXTRA = 0;
#endif
extern "C" void kernel_launch(void* const* d_in, const int* in_sizes, int n_in, void* d_out, int out_size, void* d_ws, size_t ws_size, hipStream_t stream) {
    static int grid = 0;
    if (grid == 0) {
        if (n_in != 28 || out_size != T_TOK * D || ws_size < WS_NEED + WS_DRY_EXTRA) { fprintf(stderr, "kernel_launch: unexpected shapes: n_in %d out %d ws %zu (need %zu)\n", n_in, out_size, ws_size, (size_t)WS_END); grid = -1; return; }
        int dev = 0, cus = 0, per_cu = 0;
        if (hipGetDevice(&dev) != hipSuccess || hipDeviceGetAttribute(&cus, hipDeviceAttributeMultiprocessorCount, dev) != hipSuccess) { grid = -1; return; }
        if (hipFuncSetAttribute((const void*)mk_fwd, hipFuncAttributeMaxDynamicSharedMemorySize, LDS_BYTES) != hipSuccess) { fprintf(stderr, "kernel_launch: hipFuncSetAttribute failed\n"); grid = -1; return; }
        if (hipOccupancyMaxActiveBlocksPerMultiprocessor(&per_cu, (const void*)mk_fwd, NWAVES * 64, LDS_BYTES) != hipSuccess || per_cu < 1) { fprintf(stderr, "kernel_launch: occupancy query says %d blocks per CU\n", per_cu); }
        (void)hipGetLastError();
        grid = cus;
        if (grid != 256) { fprintf(stderr, "kernel_launch: this kernel needs a 256-CU device (got %d)\n", cus); grid = -1; return; }
    }
    if (grid < 0) return;
    if (hipMemsetAsync((char*)d_ws + WS_CTL, 0, CTL_ZERO_BYTES, stream) != hipSuccess) return;
    Args a{};
    for (int i = 0; i < 28; ++i) a.in[i] = (const float*)d_in[i];
    a.out = (float*)d_out; a.ws = (unsigned char*)d_ws;
    hipLaunchKernelGGL(mk_fwd, dim3(grid), dim3(NWAVES * 64), LDS_BYTES, stream, a);
}
```

```cpp
#include <hip/hip_runtime.h>
#include <cstdio>
#include <cstdint>

constexpr int T_TOK = 65536, D = 1024, SEQ = 2048, NBATCH = 32, DEPTH = 4;
constexpr int D_IN = 5832, NIN = 5888;
constexpr int DFF = 2816, DFFE = 3584, NEXP = 8, PLE = 256;
constexpr float LN_EPS = 1e-5f;
constexpr float DN_ALPHA = 1.681792830507429f;

namespace pg8 {
#define PG8_LAS __attribute__((address_space(3)))
typedef unsigned short bf16_t;
typedef short bf16x8 __attribute__((ext_vector_type(8)));
typedef float f32x4 __attribute__((ext_vector_type(4)));
typedef unsigned u32x4 __attribute__((ext_vector_type(4)));
typedef unsigned u32x2 __attribute__((ext_vector_type(2)));
constexpr int BM = 256, BK = 64, HALF = 128, HTB = HALF * BK * 2  , STAGE_BYTES = 8 * HTB, NXCD = 8, WGM = 8;

__host__ __device__ __forceinline__ int lds_byte(int r, int c) { const int st = (r >> 4) * 2 + (c >> 5), rr = r & 15, cc = c & 31, ob = rr * 64 + cc * 2; return st * 1024 + (ob ^ (((ob >> 9) & 1) << 5)); }
__host__ __device__ __forceinline__ void stage_rc(int b, int& R, int& C) { const int st = b / 1024, sb = b % 1024, swz = sb ^ (((sb >> 9) & 1) << 5); R = (st >> 1) * 16 + swz / 64; C = (st & 1) * 32 + (swz % 64) / 2; }
__host__ __device__ __forceinline__ int perm32(int rho) { const int n = rho >> 4, i = rho & 15; return 8 * (i >> 2) + 4 * n + (i & 3); }

struct Unit { int pm, pn; };
struct Gemm { const bf16_t* A; const bf16_t* Bt; int M, N, K; };

struct StaticOrder {
    static constexpr bool GATHER = false;
    int nM, nN, nwg, G, c;
    __host__ __device__ void init(int M, int N, int G_, int c_) { nM = M / BM; nN = N / BM; nwg = nM * nN; G = G_; c = c_; }
    __host__ __device__ bool next(int i, Unit& u) const {
        const long L = (long)i * G + c; if (L >= nwg) return false;
        int wgid = (int)L; { const int q = nwg / NXCD, r = nwg % NXCD, xcd = wgid % NXCD, off = wgid / NXCD; wgid = (xcd < r ? xcd * (q + 1) : r * (q + 1) + (xcd - r) * q) + off; }
        const int nig = WGM * nN, gid = wgid / nig, fm = gid * WGM, gsz = (nM - fm) < WGM ? (nM - fm) : WGM;
        u.pm = fm + ((wgid % nig) % gsz); u.pn = (wgid % nig) / gsz; return true;
    }
    __device__ __forceinline__ const char* a_base(const Gemm& g, const Unit& u, size_t tstep) const { return (const char*)g.A + (size_t)u.pm * tstep; }
    __device__ __forceinline__ const char* b_base(const Gemm& g, const Unit& u, size_t tstep) const { return (const char*)g.Bt + (size_t)u.pn * tstep; }
    __device__ __forceinline__ void a_rows(const Unit&, int, int, int, int, int, unsigned (&)[2][2]) const {}
    __device__ __forceinline__ void a_ready(const Unit&) const {}
    __device__ __forceinline__ void done(const Unit&) const {}
};

__device__ __forceinline__ unsigned cvt_pk_bf16(float lo, float hi) { unsigned r; asm volatile("v_cvt_pk_bf16_f32 %0, %1, %2" : "=v"(r) : "v"(lo), "v"(hi)); return r; }
__device__ __forceinline__ float bf_lo(unsigned w) { return __builtin_bit_cast(float, w << 16); }
__device__ __forceinline__ float bf_hi(unsigned w) { return __builtin_bit_cast(float, w & 0xffff0000u); }
__device__ __forceinline__ float sigmoidf_fast(float x) { return __builtin_amdgcn_rcpf(1.0f + __builtin_amdgcn_exp2f(-1.4426950408889634f * x)); }
#define EPI_FENCE() asm volatile("" ::: "memory")
#define EGAS __attribute__((address_space(1)))
__device__ __forceinline__ u32x4 pack8(const f32x4 v0, const f32x4 v1) { u32x4 w; w.x = cvt_pk_bf16(v0[0], v0[1]); w.y = cvt_pk_bf16(v0[2], v0[3]); w.z = cvt_pk_bf16(v1[0], v1[1]); w.w = cvt_pk_bf16(v1[2], v1[3]); return w; }

struct EpiBf16 {
    static constexpr bool PERM = true, AFTER_DRAIN = false;
    bf16_t* O; int ldc; int row_off;
    __device__ __forceinline__ void operator()(const f32x4 (&acc)[2][2][4][2], const Unit& u, int wr, int wc, int fr, int fq) const {
        { int l_ = (int)__builtin_amdgcn_mbcnt_hi(~0u, __builtin_amdgcn_mbcnt_lo(~0u, 0u)); asm volatile("" : "+v"(l_)); fr = l_ & 15; fq = l_ >> 4; }
        const int row0 = row_off + u.pm * BM + wr * 64 + fr, col0 = u.pn * BM + wc * 32 + 8 * fq;
#pragma unroll
        for (int ai = 0; ai < 2; ++ai)
#pragma unroll
            for (int m = 0; m < 4; ++m) { bf16_t* rowp = O + (size_t)(row0 + ai * HALF + m * 16) * ldc + col0;
#pragma unroll
                for (int bj = 0; bj < 2; ++bj) *(EGAS u32x4*)(rowp + bj * HALF) = pack8(acc[ai][bj][m][0], acc[ai][bj][m][1]); }
    }
};
__device__ __forceinline__ u32x2 pack8_fp8(const f32x4 v0, const f32x4 v1) { int a = __builtin_amdgcn_cvt_pk_fp8_f32(v0[0], v0[1], 0, false); a = __builtin_amdgcn_cvt_pk_fp8_f32(v0[2], v0[3], a, true);
    int b = __builtin_amdgcn_cvt_pk_fp8_f32(v1[0], v1[1], 0, false); b = __builtin_amdgcn_cvt_pk_fp8_f32(v1[2], v1[3], b, true); u32x2 r; r.x = (unsigned)a; r.y = (unsigned)b; return r; }
struct EpiZ {
    static constexpr bool PERM = true, AFTER_DRAIN = false;
    bf16_t* zbig; bf16_t* zqi; bf16_t* zsm; unsigned char* q8; unsigned char* kv8;
    __device__ __forceinline__ void operator()(const f32x4 (&acc)[2][2][4][2], const Unit& u, int wr, int wc, int fr, int fq) const {
        { int l_ = (int)__builtin_amdgcn_mbcnt_hi(~0u, __builtin_amdgcn_mbcnt_lo(~0u, 0u)); asm volatile("" : "+v"(l_)); fr = l_ & 15; fq = l_ >> 4; }
        const int row0 = u.pm * BM + wr * 64 + fr;
        if (u.pn < 4) {
            const int col0 = u.pn * BM + wc * 32 + 8 * fq;
#pragma unroll
            for (int ai = 0; ai < 2; ++ai)
#pragma unroll
                for (int m = 0; m < 4; ++m) { unsigned char* rowp = q8 + (size_t)(row0 + ai * HALF + m * 16) * D + col0;
#pragma unroll
                    for (int bj = 0; bj < 2; ++bj) *(EGAS u32x2*)(rowp + bj * HALF) = pack8_fp8(acc[ai][bj][m][0], acc[ai][bj][m][1]); }
            return;
        }
        bf16_t* base; int ld, colt;
        if (u.pn < 20) { base = zbig + (size_t)(u.pn >> 2) * ((size_t)T_TOK * D); ld = D; colt = (u.pn & 3) * BM; }
        else if (u.pn < 22) { base = zqi; ld = 512; colt = (u.pn - 20) * BM; }
        else { base = zsm; ld = 256; colt = 0; }
        const int col0 = colt + wc * 32 + 8 * fq;
#pragma unroll
        for (int ai = 0; ai < 2; ++ai)
#pragma unroll
            for (int m = 0; m < 4; ++m) { bf16_t* rowp = base + (size_t)(row0 + ai * HALF + m * 16) * ld + col0;
#pragma unroll
                for (int bj = 0; bj < 2; ++bj) *(EGAS u32x4*)(rowp + bj * HALF) = pack8(acc[ai][bj][m][0], acc[ai][bj][m][1]); }
        if (u.pn == 22) {
#pragma unroll
            for (int ai = 0; ai < 2; ++ai)
#pragma unroll
                for (int m = 0; m < 4; ++m) *(EGAS u32x2*)(kv8 + (size_t)(row0 + ai * HALF + m * 16) * 128 + wc * 32 + 8 * fq) = pack8_fp8(acc[ai][0][m][0], acc[ai][0][m][1]);
        }
    }
};
template <int MODE> struct EpiGate {
    static constexpr bool PERM = true, AFTER_DRAIN = false;
    bf16_t* G; const bf16_t* G2;
    __device__ __forceinline__ void operator()(const f32x4 (&acc)[2][2][4][2], const Unit& u, int wr, int wc, int fr, int fq) const {
        { int l_ = (int)__builtin_amdgcn_mbcnt_hi(~0u, __builtin_amdgcn_mbcnt_lo(~0u, 0u)); asm volatile("" : "+v"(l_)); fr = l_ & 15; fq = l_ >> 4; }
        const int row0 = u.pm * BM + wr * 64 + fr, col0 = u.pn * BM + wc * 32 + 8 * fq;
#pragma unroll
        for (int ai = 0; ai < 2; ++ai) {
            u32x4 gw[4][2], g2[4][2];
#pragma unroll
            for (int m = 0; m < 4; ++m)
#pragma unroll
                for (int bj = 0; bj < 2; ++bj) { const size_t o = (size_t)(row0 + ai * HALF + m * 16) * D + col0 + bj * HALF;
                    gw[m][bj] = *(const EGAS u32x4*)(G + o); if (MODE == 1) g2[m][bj] = *(const EGAS u32x4*)(G2 + o); }
#pragma unroll
            for (int m = 0; m < 4; ++m)
#pragma unroll
                for (int bj = 0; bj < 2; ++bj) { const size_t o = (size_t)(row0 + ai * HALF + m * 16) * D + col0 + bj * HALF;
                    f32x4 v0 = acc[ai][bj][m][0], v1 = acc[ai][bj][m][1];
#pragma unroll
                    for (int j = 0; j < 4; ++j) { const unsigned wa = gw[m][bj][j >> 1], wb = gw[m][bj][2 + (j >> 1)];
                        const float ga = (j & 1) ? bf_hi(wa) : bf_lo(wa), gb = (j & 1) ? bf_hi(wb) : bf_lo(wb);
                        if (MODE == 0) { v0[j] *= sigmoidf_fast(ga); v1[j] *= sigmoidf_fast(gb); }
                        else { const unsigned xa = g2[m][bj][j >> 1], xb = g2[m][bj][2 + (j >> 1)];
                            v0[j] = ga + v0[j] * sigmoidf_fast((j & 1) ? bf_hi(xa) : bf_lo(xa)); v1[j] = gb + v1[j] * sigmoidf_fast((j & 1) ? bf_hi(xb) : bf_lo(xb)); } }
                    *(EGAS u32x4*)(G + o) = pack8(v0, v1); }
            EPI_FENCE(); }
    }
};
template <int MODE> struct EpiRes {
    static constexpr bool PERM = true, AFTER_DRAIN = false;
    float* Y; const bf16_t* XB; const bf16_t* U;
    __device__ __forceinline__ void operator()(const f32x4 (&acc)[2][2][4][2], const Unit& u, int wr, int wc, int fr, int fq) const {
        { int l_ = (int)__builtin_amdgcn_mbcnt_hi(~0u, __builtin_amdgcn_mbcnt_lo(~0u, 0u)); asm volatile("" : "+v"(l_)); fr = l_ & 15; fq = l_ >> 4; }
        const int row0 = u.pm * BM + wr * 64 + fr, col0 = u.pn * BM + wc * 32 + 8 * fq;
#pragma unroll
        for (int ai = 0; ai < 2; ++ai) {
            u32x4 xw[4][2], uw[4][2];
#pragma unroll
            for (int m = 0; m < 4; ++m)
#pragma unroll
                for (int bj = 0; bj < 2; ++bj) { const size_t o = (size_t)(row0 + ai * HALF + m * 16) * D + col0 + bj * HALF;
                    xw[m][bj] = *(const EGAS u32x4*)(XB + o);
                    if (MODE == 1) uw[m][bj] = *(const EGAS u32x4*)(U + o); }
#pragma unroll
            for (int m = 0; m < 4; ++m)
#pragma unroll
                for (int bj = 0; bj < 2; ++bj) { const size_t o = (size_t)(row0 + ai * HALF + m * 16) * D + col0 + bj * HALF;
#pragma unroll
                    for (int n = 0; n < 2; ++n) { const f32x4 a = acc[ai][bj][m][n]; f32x4 r;
                        if (MODE == 0) { const unsigned x0 = xw[m][bj][2 * n], x1 = xw[m][bj][2 * n + 1];
                            r[0] = bf_lo(x0) * DN_ALPHA + a[0]; r[1] = bf_hi(x0) * DN_ALPHA + a[1]; r[2] = bf_lo(x1) * DN_ALPHA + a[2]; r[3] = bf_hi(x1) * DN_ALPHA + a[3]; }
                        else { const unsigned x0 = xw[m][bj][2 * n], x1 = xw[m][bj][2 * n + 1], w0 = uw[m][bj][2 * n], w1 = uw[m][bj][2 * n + 1];
                            r[0] = bf_lo(x0) * DN_ALPHA + bf_lo(w0) + a[0]; r[1] = bf_hi(x0) * DN_ALPHA + bf_hi(w0) + a[1];
                            r[2] = bf_lo(x1) * DN_ALPHA + bf_lo(w1) + a[2]; r[3] = bf_hi(x1) * DN_ALPHA + bf_hi(w1) + a[3]; }
                        *(EGAS f32x4*)(Y + o + 4 * n) = r; } }
            EPI_FENCE(); }
    }
};
struct EpiPle {
    static constexpr bool PERM = true, AFTER_DRAIN = false;
    bf16_t* U;
    __device__ __forceinline__ void operator()(const f32x4 (&acc)[2][2][4][2], const Unit& u, int wr, int wc, int fr, int fq) const {
        { int l_ = (int)__builtin_amdgcn_mbcnt_hi(~0u, __builtin_amdgcn_mbcnt_lo(~0u, 0u)); asm volatile("" : "+v"(l_)); fr = l_ & 15; fq = l_ >> 4; }
        const int row0 = u.pm * BM + wr * 64 + fr, col0 = u.pn * BM + wc * 32 + 8 * fq;
#pragma unroll
        for (int ai = 0; ai < 2; ++ai) {
            u32x4 uw[4][2];
#pragma unroll
            for (int m = 0; m < 4; ++m)
#pragma unroll
                for (int bj = 0; bj < 2; ++bj) uw[m][bj] = *(const EGAS u32x4*)(U + (size_t)(row0 + ai * HALF + m * 16) * D + col0 + bj * HALF);
#pragma unroll
            for (int m = 0; m < 4; ++m)
#pragma unroll
                for (int bj = 0; bj < 2; ++bj) { f32x4 v0 = acc[ai][bj][m][0], v1 = acc[ai][bj][m][1];
#pragma unroll
                    for (int j = 0; j < 4; ++j) { const unsigned wa = uw[m][bj][j >> 1], wb = uw[m][bj][2 + (j >> 1)];
                        v0[j] = sigmoidf_fast(v0[j]) * ((j & 1) ? bf_hi(wa) : bf_lo(wa)); v1[j] = sigmoidf_fast(v1[j]) * ((j & 1) ? bf_hi(wb) : bf_lo(wb)); }
                    *(EGAS u32x4*)(U + (size_t)(row0 + ai * HALF + m * 16) * D + col0 + bj * HALF) = pack8(v0, v1); }
            EPI_FENCE(); }
    }
};
struct EpiSwiglu {
    static constexpr bool PERM = true, AFTER_DRAIN = false;
    bf16_t* H; int ldh;
    __device__ __forceinline__ void operator()(const f32x4 (&acc)[2][2][4][2], const Unit& u, int wr, int wc, int fr, int fq) const {
        { int l_ = (int)__builtin_amdgcn_mbcnt_hi(~0u, __builtin_amdgcn_mbcnt_lo(~0u, 0u)); asm volatile("" : "+v"(l_)); fr = l_ & 15; fq = l_ >> 4; }
        const int row0 = u.pm * BM + wr * 64 + fr, col0 = u.pn * HALF + wc * 32 + 8 * fq;
#pragma unroll
        for (int ai = 0; ai < 2; ++ai)
#pragma unroll
            for (int m = 0; m < 4; ++m) { bf16_t* rowp = H + (size_t)(row0 + ai * HALF + m * 16) * ldh + col0;
                f32x4 v0, v1;
#pragma unroll
                for (int j = 0; j < 4; ++j) { const float g0 = acc[ai][0][m][0][j], g1 = acc[ai][0][m][1][j];
                    v0[j] = g0 * sigmoidf_fast(g0) * acc[ai][1][m][0][j]; v1[j] = g1 * sigmoidf_fast(g1) * acc[ai][1][m][1][j]; }
                *(EGAS u32x4*)rowp = pack8(v0, v1); }
    }
};
template <class Epi, class Sched, bool ALIGN_EPI = true>
__device__ __forceinline__ void gemm_phase(PG8_LAS unsigned char* lds, const Gemm g, const Sched& S, const Epi& E, const int wave_id) {
    int lane_ = (int)__builtin_amdgcn_mbcnt_hi(~0u, __builtin_amdgcn_mbcnt_lo(~0u, 0u)); asm volatile("" : "+v"(lane_));
    const int wid = wave_id, lane = lane_, tid = wid * 64 + lane, wr = wid >> 2, wc = wid & 3, fr = lane & 15, fq = lane >> 4;
    const int K = g.K, nt = K / BK;
    unsigned voffA[2], voffB[2]; int RA[2], CA[2];
#pragma unroll
    for (int i = 0; i < 2; ++i) { int R, C; stage_rc(tid * 16 + i * 8192, R, C); const int Rb = Epi::PERM ? ((R & ~31) + perm32(R & 31)) : R; RA[i] = R; CA[i] = C;
        voffA[i] = (unsigned)(R * K + C) * 2u; voffB[i] = (unsigned)(Rb * K + C) * 2u; }
    const size_t kstep = (size_t)(BK * 2);
    const size_t hstep = (size_t)HALF * K * 2;
    const size_t tstep = 2 * hstep;
    const unsigned ldsw = (unsigned)wid * 1024u;
    const int aoff = lds_byte(wr * 64 + fr, fq * 8), boff = lds_byte(wc * 32 + fr, fq * 8);
    unsigned offC[2][2] = {{0u, 0u}, {0u, 0u}}, offN[2][2] = {{0u, 0u}, {0u, 0u}};
#define PG8_SA(b, h) (((b) * 2 + (h)) * HTB)
#define PG8_SB(b, h) ((4 + (b) * 2 + (h)) * HTB)
#define PG8_STAGE(bufoff, gbase, voff) do { _Pragma("unroll") for (int _i = 0; _i < 2; ++_i) \
        __builtin_amdgcn_global_load_lds((const unsigned*)((const char*)(gbase) + (voff)[_i]), (PG8_LAS unsigned*)(lds + (bufoff) + ldsw + _i * 8192), 16, 0, 0); } while (0)
#define PG8_STA(bufoff, ptr, h, NX) do { if constexpr (Sched::GATHER) { _Pragma("unroll") for (int _i = 0; _i < 2; ++_i) { const unsigned _o = (NX) ? offN[h][_i] : offC[h][_i]; \
        __builtin_amdgcn_global_load_lds((const unsigned*)((const char*)(ptr) + _o), (PG8_LAS unsigned*)(lds + (bufoff) + ldsw + _i * 8192), 16, 0, 0); } } \
        else { PG8_STAGE(bufoff, (ptr) + (h) * hstep, voffA); } } while (0)
#define PG8_LDA(dst, b, h) do { _Pragma("unroll") for (int m = 0; m < 4; ++m) _Pragma("unroll") for (int k = 0; k < 2; ++k) dst[m][k] = *(const PG8_LAS bf16x8*)(lds + PG8_SA(b, h) + aoff + m * 2048 + k * 1024); } while (0)
#define PG8_LDB(dst, b, h) do { _Pragma("unroll") for (int n = 0; n < 2; ++n) _Pragma("unroll") for (int k = 0; k < 2; ++k) dst[n][k] = *(const PG8_LAS bf16x8*)(lds + PG8_SB(b, h) + boff + n * 2048 + k * 1024); } while (0)
#define PG8_MMA(ai, bj, At, Bt) do { __builtin_amdgcn_s_setprio(1); _Pragma("unroll") for (int m = 0; m < 4; ++m) _Pragma("unroll") for (int n = 0; n < 2; ++n) _Pragma("unroll") for (int k = 0; k < 2; ++k) \
        acc[ai][bj][m][n] = __builtin_amdgcn_mfma_f32_16x16x32_bf16(Bt[n][k], At[m][k], acc[ai][bj][m][n], 0, 0, 0); __builtin_amdgcn_s_setprio(0); } while (0)
#define PG8_WAIT_V(n) asm volatile("s_waitcnt vmcnt(" #n ")" ::: "memory")
#define PG8_WAIT_L(n) asm volatile("s_waitcnt lgkmcnt(" #n ")" ::: "memory")
#define PG8_BAR __builtin_amdgcn_s_barrier()
#define PG8_SCHED __builtin_amdgcn_sched_barrier(0)
#ifdef PROF_SEL
#ifndef PROF_KPH
#define PROF_KPH 0
#endif
#define PG8_PROF(slot) do { if (tid == 0) { volatile PG8_LAS unsigned* M_ = (volatile PG8_LAS unsigned*)(lds + 131392); const unsigned t_ = (unsigned)__builtin_amdgcn_s_memrealtime(); const unsigned c_ = (unsigned)__builtin_amdgcn_s_memtime(); if (PROF_KPH == 0 || M_[101] == PROF_KPH) { M_[64 + (slot)] += t_ - M_[97]; if ((slot) == 14) M_[104] += c_ - M_[103]; } M_[97] = t_; M_[103] = c_; } } while (0)
#else
#define PG8_PROF(slot) do { } while (0)
#endif
#ifdef PROF_SEL
#define PG8_WAIT_VT(n) do { unsigned long long a_, b_; asm volatile("s_memtime %0\n\ts_waitcnt vmcnt(" #n ")\n\ts_memtime %1\n\ts_waitcnt lgkmcnt(0)" : "=s"(a_), "=s"(b_) :: "memory"); if (tid == 0) { volatile PG8_LAS unsigned* M_ = (volatile PG8_LAS unsigned*)(lds + 131392); M_[105] += (unsigned)b_ - (unsigned)a_; } } while (0)
#else
#define PG8_WAIT_VT(n) PG8_WAIT_V(n)
#endif
    Unit cur, nxt; int ui = 0;
    if (!S.next(0, cur)) return;
    f32x4 acc[2][2][4][2];
#pragma unroll
    for (int a = 0; a < 2; ++a)
#pragma unroll
        for (int b = 0; b < 2; ++b)
#pragma unroll
            for (int m = 0; m < 4; ++m)
#pragma unroll
                for (int n = 0; n < 2; ++n) acc[a][b][m][n] = (f32x4){0.f, 0.f, 0.f, 0.f};
    bf16x8 At[4][2], B0[2][2], B1[2][2];
    const char* cA = S.a_base(g, cur, tstep); const char* cB = S.b_base(g, cur, tstep);
    if constexpr (Sched::GATHER) S.a_rows(cur, RA[0], RA[1], CA[0], CA[1], K, offC);
    S.a_ready(cur);
    PG8_STAGE(PG8_SB(0, 0), cB, voffB); PG8_STAGE(PG8_SB(0, 1), cB + hstep, voffB); PG8_STA(PG8_SA(0, 0), cA, 0, false); PG8_STA(PG8_SA(0, 1), cA, 1, false);
    if (wr == 1) PG8_BAR;
    PG8_WAIT_V(2); PG8_BAR;
    PG8_STAGE(PG8_SB(1, 0), cB + kstep, voffB); PG8_STA(PG8_SA(1, 0), cA + kstep, 0, false); PG8_STAGE(PG8_SB(1, 1), cB + hstep + kstep, voffB);
    PG8_WAIT_V(6); PG8_BAR;
    PG8_PROF(17);
    for (;;) {
        const bool has_next = S.next(ui + 1, nxt);
        const char* nA = has_next ? S.a_base(g, nxt, tstep) : cA; const char* nB = has_next ? S.b_base(g, nxt, tstep) : cB;
        if constexpr (Sched::GATHER) { if (has_next) S.a_rows(nxt, RA[0], RA[1], CA[0], CA[1], K, offN); else {
#pragma unroll
            for (int h = 0; h < 2; ++h)
#pragma unroll
                for (int i = 0; i < 2; ++i) offN[h][i] = offC[h][i]; } }
        for (int t = 0; t < nt; t += 2) {
            const bool last = (t == nt - 2);
            const char* a1 = cA + (size_t)(t + 1) * kstep;
            const char* a2 = last ? nA : cA + (size_t)(t + 2) * kstep; const char* b2 = last ? nB : cB + (size_t)(t + 2) * kstep;
            const char* a3 = a2 + kstep; const char* b3 = b2 + kstep;
            if (last && has_next) S.a_ready(nxt);
            PG8_LDB(B0, 0, 0); PG8_LDB(B1, 0, 1); PG8_SCHED; PG8_LDA(At, 0, 0); PG8_STA(PG8_SA(1, 1), a1, 1, false);
            PG8_WAIT_VT(8); PG8_WAIT_L(0); PG8_BAR; PG8_MMA(0, 0, At, B0); PG8_MMA(0, 1, At, B1); PG8_BAR; PG8_SCHED;
            PG8_LDA(At, 0, 1); PG8_STAGE(PG8_SB(0, 0), b2, voffB); PG8_STAGE(PG8_SB(0, 1), b2 + hstep, voffB); PG8_STA(PG8_SA(0, 0), a2, 0, last);
            PG8_WAIT_VT(8); PG8_WAIT_L(0); PG8_BAR; PG8_MMA(1, 0, At, B0); PG8_MMA(1, 1, At, B1); PG8_BAR; PG8_SCHED;
            PG8_LDB(B0, 1, 0); PG8_LDB(B1, 1, 1); PG8_SCHED; PG8_LDA(At, 1, 0); PG8_STA(PG8_SA(0, 1), a2, 1, last);
            PG8_WAIT_VT(8); PG8_WAIT_L(0); PG8_BAR; PG8_MMA(0, 0, At, B0); PG8_MMA(0, 1, At, B1); PG8_BAR; PG8_SCHED;
            PG8_LDA(At, 1, 1); PG8_STAGE(PG8_SB(1, 0), b3, voffB); PG8_STAGE(PG8_SB(1, 1), b3 + hstep, voffB); PG8_STA(PG8_SA(1, 0), a3, 0, last);
            PG8_WAIT_VT(8); PG8_WAIT_L(0); PG8_BAR; PG8_MMA(1, 0, At, B0); PG8_MMA(1, 1, At, B1); PG8_BAR; PG8_SCHED;
        }
        if constexpr (ALIGN_EPI) { if (wr == 0) PG8_BAR; }
        PG8_PROF(14);
        E(acc, cur, wr, wc, fr, fq); S.done(cur);
        PG8_PROF(15);
        if (!has_next) break;
#pragma unroll
        for (int a = 0; a < 2; ++a)
#pragma unroll
            for (int b = 0; b < 2; ++b)
#pragma unroll
                for (int m = 0; m < 4; ++m)
#pragma unroll
                    for (int n = 0; n < 2; ++n) acc[a][b][m][n] = (f32x4){0.f, 0.f, 0.f, 0.f};
        cur = nxt; cA = nA; cB = nB; ++ui;
        if constexpr (Sched::GATHER) {
#pragma unroll
            for (int h = 0; h < 2; ++h)
#pragma unroll
                for (int i = 0; i < 2; ++i) offC[h][i] = offN[h][i]; }
        if constexpr (ALIGN_EPI) { if (wr == 1) PG8_BAR; }
    }
    PG8_WAIT_V(0);
    if constexpr (!ALIGN_EPI) { if (wr == 0) PG8_BAR; }
    PG8_BAR;
#undef PG8_PROF
#undef PG8_WAIT_VT
#undef PG8_SA
#undef PG8_SB
#undef PG8_STAGE
#undef PG8_STA
#undef PG8_LDA
#undef PG8_LDB
#undef PG8_MMA
#undef PG8_WAIT_V
#undef PG8_WAIT_L
#undef PG8_BAR
#undef PG8_SCHED
}
}
constexpr int NWAVES = 8;
constexpr size_t MiB = 1u << 20;
constexpr size_t WS_CTL = 0, CTL_ZERO_BYTES = 1 * MiB;
constexpr size_t WS_ROUTE = 1 * MiB;
constexpr size_t WS_LIST = 3 * MiB;
constexpr size_t WS_W = 8 * MiB;
constexpr size_t W_IN = 0, W_BRA = 12 * MiB, W_BRR = 14 * MiB, W_O = 16 * MiB, W_PG = 18 * MiB, W_PP = 20 * MiB, W_LRU = 21 * MiB, W_FF = 22 * MiB;
constexpr size_t W_FF_DN_DENSE = W_FF + 11 * MiB, W_FF_DN_MOE = W_FF + 112 * MiB;
constexpr size_t WS_XB = 208 * MiB;
constexpr size_t WS_IDX = 336 * MiB;
constexpr size_t WS_Z = 368 * MiB;
constexpr size_t Z_Q = WS_Z, Z_XR = WS_Z + 128 * MiB, Z_YR = WS_Z + 256 * MiB, Z_GA = WS_Z + 384 * MiB, Z_GR = WS_Z + 512 * MiB, Z_QI = WS_Z + 640 * MiB, Z_SM = WS_Z + 704 * MiB;
constexpr size_t Z_Q8 = Z_Q, Z_KV8 = Z_Q + 64 * MiB;
constexpr size_t WS_END = WS_Z + 736 * MiB;
constexpr size_t F_U = Z_Q;
constexpr size_t F_PB = Z_SM;
constexpr size_t F_H = Z_XR;
constexpr size_t F_H1 = WS_END;
constexpr size_t F_YE = Z_GA;
constexpr int MOE_CHUNK_TILES = 128;
constexpr size_t F_H_CHUNK_BYTES = (size_t)MOE_CHUNK_TILES * 256 * DFFE * 2;
constexpr size_t WS_NEED = F_H1 + F_H_CHUNK_BYTES;
static_assert(F_H + F_H_CHUNK_BYTES <= F_YE && F_YE + (size_t)520 * 256 * D * 2 <= Z_SM && F_H + (size_t)T_TOK * DFF * 2 <= Z_GR, "overlay map");
constexpr int CW_TMO = 0, CW_CODE = 1, CW_BAR = 4096, CW_CNT = 16384;
constexpr int RING_OFF = 0, RING_BYTES = 131072;
constexpr int LDSCTL_OFF = RING_BYTES, MISC_OFF = LDSCTL_OFF + 320;
constexpr int LDS_BYTES = 155648;

#define GAS __attribute__((address_space(1)))
#define LAS __attribute__((address_space(3)))
typedef unsigned short bf16;
typedef unsigned v4u __attribute__((ext_vector_type(4)));
typedef unsigned v2u __attribute__((ext_vector_type(2)));
typedef float f32x4 __attribute__((ext_vector_type(4)));
typedef float f32x16 __attribute__((ext_vector_type(16)));
typedef short bf16x8 __attribute__((ext_vector_type(8)));
typedef GAS unsigned gu32;
#define RLX_AGENT __ATOMIC_RELAXED, __HIP_MEMORY_SCOPE_AGENT
#define LDS_WAIT() asm volatile("s_waitcnt lgkmcnt(0)" ::: "memory")
#define VM_WAIT() asm volatile("s_waitcnt vmcnt(0)" ::: "memory")
using pg8::cvt_pk_bf16; using pg8::bf_lo; using pg8::bf_hi; using pg8::sigmoidf_fast;
#define XB_TMO      128
#define XB_XCNT(j)  (256  + 64 * (j))
#define XB_XSUB(j)  (1280 + 64 * (j))
#define XB_XGEN(j)  (2304 + 64 * (j))
#define XB_TOP      3328
#define XB_TOPGEN   3392
#define XCD_BAR_WORDS 3456
#define XB_SPIN_CAP (1u << 21)

__device__ __forceinline__ unsigned xb_ld(unsigned* p)              { return __hip_atomic_load(p, __ATOMIC_RELAXED, __HIP_MEMORY_SCOPE_AGENT); }
__device__ __forceinline__ unsigned xb_add(unsigned* p, unsigned v) { return __hip_atomic_fetch_add(p, v, __ATOMIC_RELAXED, __HIP_MEMORY_SCOPE_AGENT); }
__device__ __forceinline__ unsigned xb_xcc_id() { return (unsigned)__builtin_amdgcn_s_getreg((3 << 11) | 20) & 0xFu; }
#define XB_SPIN(cond, bar) do { unsigned _sp = 0; while (cond) { __builtin_amdgcn_s_sleep(1); \
    if ((++_sp & 255u) == 0u) { if (xb_ld(&(bar)[XB_TMO])) break; if (_sp > XB_SPIN_CAP) { atomicAdd(&(bar)[XB_TMO], 1u); break; } } } } while (0)

struct XcdBarrier {
    unsigned* bar; unsigned x;
    volatile LAS unsigned* st;
};

__device__ __forceinline__ XcdBarrier xcd_barrier_post(unsigned* bar, volatile LAS unsigned* st) {
    XcdBarrier b; b.bar = bar; b.x = xb_xcc_id(); b.st = st;
    if (threadIdx.x == 0) (void)xb_add(&bar[XB_XCNT(b.x)], 1u);
    return b;
}
__device__ __forceinline__ void xcd_barrier_complete(unsigned* bar, unsigned x, unsigned& nloc, unsigned& nx) {
    const unsigned G = gridDim.x * gridDim.y * gridDim.z;
    unsigned sum, cnt, mine, sp = 0u;
    for (;;) {
        sum = 0u; cnt = 0u; mine = 0u;
#pragma unroll
        for (unsigned j = 0; j < 16; ++j) { const unsigned c = xb_ld(&bar[XB_XCNT(j)]); sum += c; cnt += (c > 0u) ? 1u : 0u; mine = (j == x) ? c : mine; }
        if (sum == G) break;
        __builtin_amdgcn_s_sleep(1);
        if ((++sp & 255u) == 0u) { if (xb_ld(&bar[XB_TMO])) break; if (sp > XB_SPIN_CAP) { atomicAdd(&bar[XB_TMO], 1u); break; } }
    }
    nloc = mine > 0u ? mine : 1u; nx = cnt > 0u ? cnt : 1u;
}

__device__ __forceinline__ void xcd_barrier(const XcdBarrier& b) {
    asm volatile("s_waitcnt vmcnt(0)" ::: "memory");
    __syncthreads();
    if (threadIdx.x == 0) {
        unsigned* bar = b.bar;
        __builtin_amdgcn_s_waitcnt(0);
        unsigned nloc = b.st[0], nx = b.st[1];
        if (nloc == 0u) { xcd_barrier_complete(bar, b.x, nloc, nx); b.st[0] = nloc; b.st[1] = nx; }
        const unsigned old = xb_add(&bar[XB_XSUB(b.x)], 1u);
        const unsigned gen = old / nloc;
        if (old + 1u == (gen + 1u) * nloc) {
            __builtin_amdgcn_fence(__ATOMIC_RELEASE, "agent");
            asm volatile("s_waitcnt vmcnt(0)" ::: "memory");
            const unsigned og = xb_add(&bar[XB_TOP], 1u);
            const unsigned tg = og / nx;
            if (og + 1u == (tg + 1u) * nx) xb_add(&bar[XB_TOPGEN], 1u);
            else XB_SPIN(xb_ld(&bar[XB_TOPGEN]) == tg, bar);
            __builtin_amdgcn_fence(__ATOMIC_ACQUIRE, "agent");
            xb_add(&bar[XB_XGEN(b.x)], 1u);
            asm volatile("s_waitcnt vmcnt(0)" ::: "memory");
        } else {
            XB_SPIN(xb_ld(&bar[XB_XGEN(b.x)]) == gen, bar);
            __builtin_amdgcn_fence(__ATOMIC_ACQUIRE, "agent");
            asm volatile("s_waitcnt vmcnt(0)" ::: "memory");
        }
    }
    __syncthreads();
}
struct Frame {
    LAS unsigned char* lds;
    volatile LAS unsigned* MISC;
    gu32* ctl;
    int tid, lane, wave, G, bx;
    unsigned char* ws;
    float* out;
};
struct Args { const float* in[28]; float* out; unsigned char* ws; };
typedef const __attribute__((address_space(4))) Args* KArgs;
__device__ __forceinline__ KArgs kargs() { KArgs k = (KArgs)__builtin_amdgcn_kernarg_segment_ptr(); asm volatile("" : "+s"(k)); return k; }
enum { I_X = 0, I_P, I_WIN, I_CONVW, I_CONVB, I_LRUWA, I_LRUBA, I_LRUWX, I_LRUBX, I_LAM, I_WBRA, I_WBRR, I_WO, I_RELB, I_LN1G, I_LN1B, I_FFG, I_FFU, I_FFD, I_ROUTER, I_ROUTERB, I_MOEG, I_MOEU, I_MOED, I_PLEG, I_PLEP, I_LN2G, I_LN2B };

__device__ __forceinline__ Frame launder(const Frame& F0) { Frame F = F0; unsigned char* w = F0.ws; int l = (int)__builtin_amdgcn_mbcnt_hi(~0u, __builtin_amdgcn_mbcnt_lo(~0u, 0u)); asm volatile("" : "+s"(w)); asm volatile("" : "+v"(l));
    F.ws = w; F.lane = l; F.tid = F0.wave * 64 + l; F.ctl = (gu32*)(w + WS_CTL); return F; }
__device__ __forceinline__ float lane_get(float v, int src_lane) { return __builtin_bit_cast(float, __builtin_amdgcn_ds_bpermute(src_lane << 2, __builtin_bit_cast(int, v))); }
__device__ __forceinline__ float lane_xor(float v, int mask, int lane) { return lane_get(v, lane ^ mask); }
__device__ __forceinline__ float lane_up(float v, int d, int lane) { return lane_get(v, lane >= d ? lane - d : lane); }
__device__ __forceinline__ float wave_sum(float v, int lane) {
#pragma unroll
    for (int o = 1; o < 64; o <<= 1) v += lane_xor(v, o, lane);
    return v;
}
__device__ __forceinline__ unsigned pk2(float lo, float hi) { return cvt_pk_bf16(lo, hi); }

__device__ __forceinline__ void cvt_item(const float* W, int ldw, int K, bf16* WT, int d0, int sc0, int nvalid, float scale, int k0, LAS float* scr, int lane) {
    const int n4 = (lane & 7) * 4;
    f32x4 v[8];
#pragma unroll
    for (int i = 0; i < 8; ++i) { const int kk = 8 * i + (lane >> 3); v[i] = (f32x4){0.f, 0.f, 0.f, 0.f}; if (n4 < nvalid) v[i] = *(const GAS f32x4*)(W + (size_t)(k0 + kk) * ldw + sc0 + n4); }
#pragma unroll
    for (int i = 0; i < 8; ++i) { const int kk = 8 * i + (lane >> 3); LAS float* d = scr + kk * 33 + n4; d[0] = v[i][0] * scale; d[1] = v[i][1] * scale; d[2] = v[i][2] * scale; d[3] = v[i][3] * scale; }
    LDS_WAIT(); asm volatile("" ::: "memory");
    const int c = lane & 7;
#pragma unroll
    for (int j = 0; j < 4; ++j) { const int nn = (lane >> 3) + 8 * j; const LAS float* s = scr + (8 * c) * 33 + nn;
        v4u o; o.x = pk2(s[0 * 33], s[1 * 33]); o.y = pk2(s[2 * 33], s[3 * 33]); o.z = pk2(s[4 * 33], s[5 * 33]); o.w = pk2(s[6 * 33], s[7 * 33]);
        *(GAS v4u*)(WT + (size_t)(d0 + nn) * K + k0 + 8 * c) = o; }
    LDS_WAIT(); asm volatile("" ::: "memory");
}
__device__ __forceinline__ void cvt_plain(const float* W, int K, int N, bf16* WT, int item, LAS float* scr, int lane) {
    const int nblk = N / 32, kb = item / nblk, nb = item % nblk;
    cvt_item(W, N, K, WT, 32 * nb, 32 * nb, 32, 1.0f, 64 * kb, scr, lane);
}
__device__ __forceinline__ void cvt_gateup(const float* Wg, const float* Wu, int dff, bf16* WT, int item, LAS float* scr, int lane) {
    const int nblk = 2 * dff / 32, kb = item / nblk, db = item % nblk, d0 = 32 * db, pn = d0 >> 8, r = d0 & 255;
    const float* W = r < 128 ? Wg : Wu; const int sc0 = 128 * pn + (r & 127);
    cvt_item(W, dff, D, WT, d0, sc0, 32, 1.0f, 64 * kb, scr, lane);
}
__device__ __forceinline__ void cvt_win(const float* W, bf16* WT, int item, LAS float* scr, int lane) {
    const int nblk = NIN / 32, kb = item / nblk, db = item % nblk, d0 = 32 * db;
    int sc0, nv = 32; float sc = 1.0f;
    if (d0 < 1024) { sc0 = d0; }
    else if (d0 < 2048) sc0 = 1736 + (d0 - 1024);
    else if (d0 < 3072) sc0 = 2760 + (d0 - 2048);
    else if (d0 < 4096) sc0 = 3784 + (d0 - 3072);
    else if (d0 < 5120) sc0 = 4808 + (d0 - 4096);
    else if (d0 < 5632) sc0 = 1152 + (d0 - 5120);
    else if (d0 < 5696) sc0 = 1024 + (d0 - 5632);
    else if (d0 < 5760) sc0 = 1088 + (d0 - 5696);
    else if (d0 < 5824) sc0 = 1664 + (d0 - 5760);
    else if (d0 == 5824) { sc0 = 1728; nv = 8; }
    else { sc0 = 0; nv = 0; }
    cvt_item(W, D_IN, D, WT, d0, sc0, nv, sc, 64 * kb, scr, lane);
}
__device__ __forceinline__ void p0_convert(const Frame& F0, int L) {
    Frame F = launder(F0);
    const KArgs ka = kargs();
    LAS float* scr = (LAS float*)(F.lds + RING_OFF + F.wave * 16384);
    const int gw = F.bx * NWAVES + F.wave, NGW = F.G * NWAVES;
    unsigned char* wb = F.ws + WS_W;
    const int odd = L & 1, jj = L >> 1;
    constexpr int I_IN = (D / 64) * (NIN / 32), I_SQ = (D / 64) * (D / 32), I_PPJ = (PLE / 64) * (D / 32), I_LRU1 = 2 * 4;
    constexpr int I_GU_D = (D / 64) * (2 * DFF / 32), I_DN_D = (DFF / 64) * (D / 32), I_GU_E = (D / 64) * (2 * DFFE / 32), I_DN_E = (DFFE / 64) * (D / 32);
    const int n_ff = odd ? NEXP * (I_GU_E + I_DN_E) : (I_GU_D + I_DN_D);
    const int NITEMS = I_IN + 4 * I_SQ + I_PPJ + 16 * I_LRU1 + n_ff;
    for (int it = gw; it < NITEMS; it += NGW) {
        const float* W; bf16* WT; int ldw, K, d0, sc0, nv = 32, k0; float scale = 1.0f;
        int r = it, kind = 0, m = 0;
        if (r < I_IN) kind = 1;
        else { r -= I_IN;
            if (r < 4 * I_SQ) { m = r / I_SQ; r -= m * I_SQ; }
            else { r -= 4 * I_SQ;
                if (r < I_PPJ) m = 4;
                else { r -= I_PPJ;
                    if (r < 16 * I_LRU1) m = 5;
                    else { r -= 16 * I_LRU1;
                        if (!odd) { if (r < I_GU_D) kind = 2; else { r -= I_GU_D; m = 6; } }
                        else { if (r < NEXP * I_GU_E) kind = 3; else { r -= NEXP * I_GU_E; m = 7; } } } } } }
        if (kind == 1) { const int nblk = NIN / 32, kb = r / nblk, db = r % nblk; d0 = 32 * db; k0 = 64 * kb;
            W = ka->in[I_WIN] + (size_t)L * D * D_IN; WT = (bf16*)(wb + W_IN); ldw = D_IN; K = D;
            if (d0 < 1024) sc0 = d0;
            else if (d0 < 2048) sc0 = 1736 + (d0 - 1024);
            else if (d0 < 3072) sc0 = 2760 + (d0 - 2048);
            else if (d0 < 4096) sc0 = 3784 + (d0 - 3072);
            else if (d0 < 5120) sc0 = 4808 + (d0 - 4096);
            else if (d0 < 5632) sc0 = 1152 + (d0 - 5120);
            else if (d0 < 5696) sc0 = 1024 + (d0 - 5632);
            else if (d0 < 5760) sc0 = 1088 + (d0 - 5696);
            else if (d0 < 5824) sc0 = 1664 + (d0 - 5760);
            else if (d0 == 5824) { sc0 = 1728; nv = 8; }
            else { sc0 = 0; nv = 0; } }
        else if (kind >= 2) { const int dff = kind == 2 ? DFF : DFFE; int e = 0; if (kind == 3) { e = r / I_GU_E; r -= e * I_GU_E; }
            const size_t eo = kind == 2 ? (size_t)jj * D * DFF : ((size_t)jj * NEXP + e) * D * DFFE;
            const int nblk = 2 * dff / 32, kb = r / nblk, db = r % nblk; d0 = 32 * db; k0 = 64 * kb; const int pn = d0 >> 8, rr = d0 & 255;
            W = (rr < 128 ? ka->in[kind == 2 ? I_FFG : I_MOEG] : ka->in[kind == 2 ? I_FFU : I_MOEU]) + eo; sc0 = 128 * pn + (rr & 127); ldw = dff; K = D;
            WT = (bf16*)(wb + W_FF) + (kind == 3 ? (size_t)e * 2 * DFFE * D : 0); }
        else { int Kk, Nn;
            if (m < 4) { Kk = D; Nn = D; W = ka->in[m == 0 ? I_WBRA : m == 1 ? I_WBRR : m == 2 ? I_WO : I_PLEG] + (size_t)L * D * D; WT = (bf16*)(wb + (m == 0 ? W_BRA : m == 1 ? W_BRR : m == 2 ? W_O : W_PG)); }
            else if (m == 4) { Kk = PLE; Nn = D; W = ka->in[I_PLEP] + (size_t)L * PLE * D; WT = (bf16*)(wb + W_PP); }
            else if (m == 5) { const int mm = r / I_LRU1, blk = mm & 7, which = mm >> 3; r -= mm * I_LRU1; Kk = 128; Nn = 128;
                W = ka->in[which ? I_LRUWX : I_LRUWA] + (size_t)L * 8 * 128 * 128 + (size_t)blk * 128 * 128; WT = (bf16*)(wb + W_LRU) + (size_t)which * 8 * 128 * 128 + (size_t)blk * 128 * 128; }
            else if (m == 6) { Kk = DFF; Nn = D; W = ka->in[I_FFD] + (size_t)jj * DFF * D; WT = (bf16*)(wb + W_FF_DN_DENSE); }
            else { const int e = r / I_DN_E; r -= e * I_DN_E; Kk = DFFE; Nn = D; W = ka->in[I_MOED] + ((size_t)jj * NEXP + e) * DFFE * D; WT = (bf16*)(wb + W_FF_DN_MOE) + (size_t)e * D * DFFE; }
            const int nblk = Nn / 32, kb = r / nblk, nb = r % nblk; d0 = 32 * nb; sc0 = 32 * nb; k0 = 64 * kb; ldw = Nn; K = Kk; }
        cvt_item(W, ldw, K, WT, d0, sc0, nv, scale, k0, scr, F.lane);
    }
    if (L == 0) {
        const GAS f32x4* x4 = (const GAS f32x4*)ka->in[I_X]; GAS v4u* o = (GAS v4u*)(F.ws + WS_XB);
        const size_t n8 = (size_t)T_TOK * D / 8;
        for (size_t i = (size_t)F.bx * 512 + F.tid; i < n8; i += (size_t)F.G * 512) { const f32x4 a = x4[2 * i], b = x4[2 * i + 1];
            v4u w; w.x = pk2(a[0], a[1]); w.y = pk2(a[2], a[3]); w.z = pk2(b[0], b[1]); w.w = pk2(b[2], b[3]); o[i] = w; }
    }
}

template <bool LN2, bool ODD, bool DRY = false>
__device__ __forceinline__ void ln_phase(const Frame& F0, int L) {
    Frame F = launder(F0);
    const KArgs ka = kargs();
    const int jj = L >> 1;
    float* X32 = F.out; bf16* XB = (bf16*)(F.ws + WS_XB);
    const float* gam = ka->in[LN2 ? I_LN2G : I_LN1G] + (size_t)L * D; const float* bet = ka->in[LN2 ? I_LN2B : I_LN1B] + (size_t)L * D;
    f32x4 gv[4], bv[4];
#pragma unroll
    for (int j = 0; j < 4; ++j) { gv[j] = ((const GAS f32x4*)gam)[F.lane + 64 * j]; bv[j] = ((const GAS f32x4*)bet)[F.lane + 64 * j]; }
    LAS float* RT = (LAS float*)(F.lds + RING_OFF);
    LAS unsigned* TE = (LAS unsigned*)(F.lds + RING_OFF + 32768);
    volatile LAS unsigned* lcnt = F.MISC + 48; volatile LAS unsigned* gbase = F.MISC + 56;
    float rb[8];
    if (!LN2 && ODD) {
        const float* R = ka->in[I_ROUTER] + (size_t)jj * D * NEXP;
        for (int i = F.tid; i < D * NEXP; i += 512) RT[i] = R[i];
        if (F.tid < 8) lcnt[F.tid] = 0u;
#pragma unroll
        for (int e = 0; e < 8; ++e) rb[e] = ka->in[I_ROUTERB][jj * NEXP + e];
        __syncthreads();
    }
    const unsigned* route = (const unsigned*)(F.ws + WS_ROUTE);
    const bf16* YE = (const bf16*)(F.ws + F_YE);
    const bf16* T1 = (const bf16*)(F.ws + (LN2 ? F_U : Z_GR)); const bf16* T2 = (const bf16*)(F.ws + Z_GR);
    v2u nx[4], n1[4];
    { const size_t r0 = ((size_t)F.bx * 256 + F.wave) * D; const GAS v2u* a0 = (const GAS v2u*)(XB + r0) + F.lane; const GAS v2u* b0 = (const GAS v2u*)(T1 + r0) + F.lane;
#pragma unroll
      for (int j = 0; j < 4; ++j) { nx[j] = a0[64 * j]; n1[j] = b0[64 * j]; } }
    for (int it = 0; it < 32; ++it) {
        const int rl = F.wave + 8 * it; const size_t row = (size_t)F.bx * 256 + rl;
        GAS f32x4* xr = (GAS f32x4*)(X32 + row * D) + F.lane;
        f32x4 v[4]; float s = 0.f;
#pragma unroll
        for (int j = 0; j < 4; ++j) { const v2u a = nx[j], b = n1[j];
            v[j][0] = DN_ALPHA * bf_lo(a.x) + bf_lo(b.x); v[j][1] = DN_ALPHA * bf_hi(a.x) + bf_hi(b.x); v[j][2] = DN_ALPHA * bf_lo(a.y) + bf_lo(b.y); v[j][3] = DN_ALPHA * bf_hi(a.y) + bf_hi(b.y); }
        if (it < 31) { const GAS v2u* a0 = (const GAS v2u*)(XB + (row + 8) * D) + F.lane; const GAS v2u* b0 = (const GAS v2u*)(T1 + (row + 8) * D) + F.lane;
#pragma unroll
            for (int j = 0; j < 4; ++j) { nx[j] = a0[64 * j]; n1[j] = b0[64 * j]; } }
        if (LN2 && !ODD) {
            const GAS v2u* fp = (const GAS v2u*)(T2 + row * D) + F.lane;
#pragma unroll
            for (int j = 0; j < 4; ++j) { const v2u b = fp[64 * j]; v[j][0] += bf_lo(b.x); v[j][1] += bf_hi(b.x); v[j][2] += bf_lo(b.y); v[j][3] += bf_hi(b.y); }
        }
        if (LN2 && ODD) {
            const unsigned e1 = route[row * 8 + 0], e2 = route[row * 8 + 1], p1 = route[row * 8 + 2], p2 = route[row * 8 + 3];
            const float g1 = __builtin_bit_cast(float, route[row * 8 + 4]), g2 = __builtin_bit_cast(float, route[row * 8 + 5]);
            const size_t r1 = (size_t)F.MISC[16 + e1] * 256 + p1, r2 = (size_t)F.MISC[16 + e2] * 256 + p2;
            const GAS v2u* y1 = (const GAS v2u*)(YE + r1 * D) + F.lane; const GAS v2u* y2 = (const GAS v2u*)(YE + r2 * D) + F.lane;
#pragma unroll
            for (int j = 0; j < 4; ++j) { const v2u a = y1[64 * j], b = y2[64 * j];
                v[j][0] += g1 * bf_lo(a.x) + g2 * bf_lo(b.x); v[j][1] += g1 * bf_hi(a.x) + g2 * bf_hi(b.x);
                v[j][2] += g1 * bf_lo(a.y) + g2 * bf_lo(b.y); v[j][3] += g1 * bf_hi(a.y) + g2 * bf_hi(b.y); }
        }
#pragma unroll
        for (int j = 0; j < 4; ++j) s += (v[j][0] + v[j][1]) + (v[j][2] + v[j][3]);
        const float mean = wave_sum(s, F.lane) * (1.f / D); float s2 = 0.f;
#pragma unroll
        for (int j = 0; j < 4; ++j) { v[j] = v[j] - mean; s2 += (v[j][0] * v[j][0] + v[j][1] * v[j][1]) + (v[j][2] * v[j][2] + v[j][3] * v[j][3]); }
        const float rstd = 1.f / sqrtf(wave_sum(s2, F.lane) * (1.f / D) + LN_EPS);
        GAS v2u* o8 = (GAS v2u*)((DRY ? (bf16*)(F.ws + WS_NEED) : XB) + row * D) + F.lane;
        GAS f32x4* xw = DRY ? (GAS f32x4*)((float*)(F.ws + WS_NEED) + row * D) + F.lane : xr;
#pragma unroll
        for (int j = 0; j < 4; ++j) { v[j] = v[j] * rstd * gv[j] + bv[j]; if (DRY || (LN2 && L == DEPTH - 1)) xw[64 * j] = v[j];
            v2u w; w.x = pk2(v[j][0], v[j][1]); w.y = pk2(v[j][2], v[j][3]); o8[64 * j] = w; }
        if (!LN2) {
            const f32x4 pv = ((const GAS f32x4*)(ka->in[I_P] + ((size_t)L * T_TOK + row) * PLE))[F.lane];
            v2u w; w.x = pk2(pv[0], pv[1]); w.y = pk2(pv[2], pv[3]); ((GAS v2u*)(F.ws + (DRY ? WS_NEED : F_PB) + row * PLE * 2))[F.lane] = w;
        }
        if (!LN2 && ODD) {
            float lg[8];
#pragma unroll
            for (int e = 0; e < 8; ++e) lg[e] = 0.f;
#pragma unroll
            for (int j = 0; j < 4; ++j)
#pragma unroll
                for (int q = 0; q < 4; ++q) { const int c = 4 * F.lane + 256 * j + q; const f32x4 ra = *(const LAS f32x4*)(RT + c * 8), rc = *(const LAS f32x4*)(RT + c * 8 + 4); const float xv = v[j][q];
                    lg[0] += xv * ra[0]; lg[1] += xv * ra[1]; lg[2] += xv * ra[2]; lg[3] += xv * ra[3]; lg[4] += xv * rc[0]; lg[5] += xv * rc[1]; lg[6] += xv * rc[2]; lg[7] += xv * rc[3]; }
#pragma unroll
            for (int e = 0; e < 8; ++e) lg[e] = wave_sum(lg[e], F.lane) + rb[e];
            int e1 = 0; float v1 = lg[0];
#pragma unroll
            for (int e = 1; e < 8; ++e) if (lg[e] > v1) { v1 = lg[e]; e1 = e; }
            int e2 = -1; float v2 = 0.f;
#pragma unroll
            for (int e = 0; e < 8; ++e) if (e != e1 && (e2 < 0 || lg[e] > v2)) { v2 = lg[e]; e2 = e; }
            const float ex = __expf(v2 - v1), g1 = 1.f / (1.f + ex), g2 = ex * g1;
            if (F.lane == 0) { const unsigned lp1 = __hip_atomic_fetch_add((LAS unsigned*)lcnt + e1, 1u, __ATOMIC_RELAXED, __HIP_MEMORY_SCOPE_WORKGROUP), lp2 = __hip_atomic_fetch_add((LAS unsigned*)lcnt + e2, 1u, __ATOMIC_RELAXED, __HIP_MEMORY_SCOPE_WORKGROUP);
                TE[rl * 4 + 0] = (unsigned)e1 | ((unsigned)e2 << 8) | (lp1 << 16); TE[rl * 4 + 1] = lp2; TE[rl * 4 + 2] = __builtin_bit_cast(unsigned, g1); TE[rl * 4 + 3] = __builtin_bit_cast(unsigned, g2); }
        }
    }
    if (!LN2 && ODD) {
        __syncthreads();
        if (F.tid < 8) gbase[F.tid] = __hip_atomic_fetch_add(F.ctl + CW_CNT + jj * 1024 + 64 * F.tid, lcnt[F.tid], RLX_AGENT);
        __syncthreads();
        if (F.tid < 256) { const unsigned w0 = TE[F.tid * 4], lp2 = TE[F.tid * 4 + 1]; const unsigned e1 = w0 & 255u, e2 = (w0 >> 8) & 255u, lp1 = w0 >> 16;
            const unsigned p1 = gbase[e1] + lp1, p2 = gbase[e2] + lp2; const unsigned tok = (unsigned)F.bx * 256 + F.tid;
            GAS int* list = (GAS int*)(F.ws + WS_LIST); list[(size_t)e1 * T_TOK + p1] = (int)tok; list[(size_t)e2 * T_TOK + p2] = (int)tok;
            GAS v4u* ro = (GAS v4u*)(F.ws + WS_ROUTE) + (size_t)tok * 2; v4u a; a.x = e1; a.y = e2; a.z = p1; a.w = p2; ro[0] = a; v4u b; b.x = TE[F.tid * 4 + 2]; b.y = TE[F.tid * 4 + 3]; b.z = 0u; b.w = 0u; ro[1] = b; }
        __syncthreads();
    }
}
__device__ __forceinline__ int wave_scan_add(int x) {
    x += __builtin_amdgcn_update_dpp(0, x, 0x111, 0xf, 0xf, false);
    x += __builtin_amdgcn_update_dpp(0, x, 0x112, 0xf, 0xf, false);
    x += __builtin_amdgcn_update_dpp(0, x, 0x114, 0xf, 0xf, false);
    x += __builtin_amdgcn_update_dpp(0, x, 0x118, 0xf, 0xf, false);
    x += __builtin_amdgcn_update_dpp(0, x, 0x142, 0xa, 0xf, false);
    x += __builtin_amdgcn_update_dpp(0, x, 0x143, 0xc, 0xf, false);
    return x;
}
template <int NJ>
__device__ __forceinline__ unsigned select_topk_n(LAS const float* sc, int n_adm, GAS unsigned short* gout, LAS unsigned short* out, int lane, unsigned guess) {
    const int nj = n_adm >> 6;
    unsigned u[NJ];
#pragma unroll
    for (int j = 0; j < NJ; ++j) { unsigned b = 0u;
        if (j < NJ - 8 || j < nj) { b = __builtin_bit_cast(unsigned, sc[64 * j + lane]); b = (b == 0x80000000u) ? 0u : b; b = (b & 0x80000000u) ? ~b : (b | 0x80000000u); }
        u[j] = b; }
#define SEL_COUNT(c_, dst_) do { int t_ = 0; const unsigned cc_ = (unsigned)__builtin_amdgcn_readfirstlane((int)(c_)); _Pragma("unroll") for (int j8 = 0; j8 < NJ; j8 += 8) { unsigned long long m0_, m1_, m2_, m3_, m4_, m5_, m6_, m7_; \
        asm("v_cmp_le_u32_e64 %0, %8, %9\n\tv_cmp_le_u32_e64 %1, %8, %10\n\tv_cmp_le_u32_e64 %2, %8, %11\n\tv_cmp_le_u32_e64 %3, %8, %12\n\tv_cmp_le_u32_e64 %4, %8, %13\n\tv_cmp_le_u32_e64 %5, %8, %14\n\tv_cmp_le_u32_e64 %6, %8, %15\n\tv_cmp_le_u32_e64 %7, %8, %16" \
            : "=&s"(m0_), "=&s"(m1_), "=&s"(m2_), "=&s"(m3_), "=&s"(m4_), "=&s"(m5_), "=&s"(m6_), "=&s"(m7_) : "s"(cc_), "v"(u[j8]), "v"(u[j8 + 1]), "v"(u[j8 + 2]), "v"(u[j8 + 3]), "v"(u[j8 + 4]), "v"(u[j8 + 5]), "v"(u[j8 + 6]), "v"(u[j8 + 7])); \
        t_ += __popcll(m0_) + __popcll(m1_) + __popcll(m2_) + __popcll(m3_) + __popcll(m4_) + __popcll(m5_) + __popcll(m6_) + __popcll(m7_); } dst_ = t_; } while (0)
    unsigned lo = 0u, hi = 0xFFFFFFFFu, ex = 0u; bool exact = false; int c;
    if (guess != 0u) {
        SEL_COUNT(guess, c);
        if (c == 256) { exact = true; ex = guess; }
        else if (c > 256) { lo = guess; unsigned d = 1u << 17;
            for (int e = 0; e < 7 && !exact; ++e) { const unsigned h = lo + d; if (h < lo) break; SEL_COUNT(h, c);
                if (c == 256) { exact = true; ex = h; } else if (c < 256) { hi = h; break; } else { lo = h; d <<= 2; } } }
        else { hi = guess; unsigned d = 1u << 17;
            for (int e = 0; e < 7 && !exact; ++e) { if (d >= hi) break; const unsigned l = hi - d; SEL_COUNT(l, c);
                if (c == 256) { exact = true; ex = l; } else if (c > 256) { lo = l; break; } else { hi = l; d <<= 2; } } }
    }
    while (!exact && hi - lo > 1u) { const unsigned mid = lo + ((hi - lo) >> 1); SEL_COUNT(mid, c);
        if (c == 256) { exact = true; ex = mid; } else if (c > 256) lo = mid; else hi = mid; }
#undef SEL_COUNT
    const unsigned thr = exact ? ex - 1u : lo;
    int nl = 0;
#pragma unroll
    for (int j = 0; j < NJ; ++j) nl += (u[j] > thr) ? 1 : 0;
    const int incl = wave_scan_add(nl); const int ngt = __builtin_amdgcn_readlane(incl, 63);
    int pos = incl - nl;
#pragma unroll
    for (int j = 0; j < NJ; ++j) if (u[j] > thr) { out[pos] = (unsigned short)(64 * j + lane); ++pos; }
    const int quota = 256 - ngt;
    if (quota > 0) {
        int tbase = 0; const unsigned long long lt = (1ull << lane) - 1ull;
#pragma unroll
        for (int j = 0; j < NJ; ++j) {
            const bool eq = u[j] == thr; const unsigned long long meq = __ballot(eq); const int rk = tbase + __popcll(meq & lt);
            if (eq && rk < quota) out[ngt + rk] = (unsigned short)(64 * j + lane);
            tbase += __popcll(meq);
        }
    }
    asm volatile("s_waitcnt lgkmcnt(0)" ::: "memory");
    if (lane < 32) *(GAS v4u*)(gout + 8 * lane) = *(const LAS v4u*)(out + 8 * lane);
    asm volatile("s_waitcnt lgkmcnt(0)" ::: "memory");
    return thr;
}
__device__ __forceinline__ unsigned select_topk(LAS const float* sc, int n_adm, GAS unsigned short* out, LAS unsigned short* orow, int lane, unsigned guess) {
    if (n_adm <= 256) {
#pragma unroll
        for (int j = 0; j < 4; ++j) { const int p = lane + 64 * j; out[p] = (unsigned short)(p < n_adm ? p : 0); }
        return 0u;
    }
    if (n_adm <= 512) return select_topk_n<8>(sc, n_adm, out, orow, lane, guess);
    else if (n_adm <= 1024) return select_topk_n<16>(sc, n_adm, out, orow, lane, guess);
    else if (n_adm <= 1536) return select_topk_n<24>(sc, n_adm, out, orow, lane, guess);
    return select_topk_n<32>(sc, n_adm, out, orow, lane, guess);
}
template <int MODE = 0>
__device__ __forceinline__ void indexer_phase(const Frame& F0) {
    Frame F = launder(F0);
    LAS float* sc = (LAS float*)(F.lds + RING_OFF);
    const bf16* QI = (const bf16*)(F.ws + Z_QI); const bf16* SM = (const bf16*)(F.ws + Z_SM);
    GAS unsigned short* IDX = (GAS unsigned short*)(F.ws + WS_IDX);
    const int lane = F.lane, h = lane >> 5, r = lane & 31;
    const int rq = 2 * ((r >> 2) & 1) + ((r >> 4) & 1), rh = (r & 3) + 4 * ((r >> 3) & 1);
    const int vcu = (F.bx & 7) * (F.G >> 3) + (F.bx >> 3);
    unsigned guess[2] = {0u, 0u};
    bf16x8 A[4][4]; v4u wq[4][2];
#define IDX_TILE(pi_, b_, tq_) const int pid_ = vcu * 8 + ((pi_) >> 1), b_ = pid_ >> 6, jp_ = pid_ & 63, tq_ = 16 * (((pi_) & 1) ? 127 - jp_ : jp_)
#define IDX_LOAD_A(t0_) do { _Pragma("unroll") for (int mt = 0; mt < 4; ++mt) { \
        _Pragma("unroll") for (int s = 0; s < 4; ++s) A[mt][s] = *(const GAS bf16x8*)(QI + (size_t)((t0_) + 4 * mt + rq) * 512 + rh * 64 + 16 * s + 8 * h); \
        _Pragma("unroll") for (int qq = 0; qq < 2; ++qq) wq[mt][qq] = *(const GAS v4u*)(SM + (size_t)((t0_) + 4 * mt + 2 * h + qq) * 256 + 192); } } while (0)
    for (int pi = 0; pi < 16; ++pi) {
        IDX_TILE(pi, b, tq);
        const int t0 = b * SEQ + tq;
        const int n_adm = ((tq >> 6) + 1) * 64, nkb = n_adm >> 5;
        if (n_adm > 256 && MODE != 2) {
            IDX_LOAD_A(t0);
            bf16x8 B[4], Bn[4];
#pragma unroll
            for (int s = 0; s < 4; ++s) Bn[s] = *(const GAS bf16x8*)(SM + (size_t)(b * SEQ + 32 * F.wave + r) * 256 + 128 + 16 * s + 8 * h);
            for (int kb = F.wave; kb < nkb; kb += 8) {
                const int key = 32 * kb + r;
                const int keyn = (kb + 8 < nkb) ? key + 256 : key;
#pragma unroll
                for (int s = 0; s < 4; ++s) B[s] = Bn[s];
#pragma unroll
                for (int s = 0; s < 4; ++s) Bn[s] = *(const GAS bf16x8*)(SM + (size_t)(b * SEQ + keyn) * 256 + 128 + 16 * s + 8 * h);
#pragma unroll
                for (int mt = 0; mt < 4; ++mt) {
                    f32x16 acc;
#pragma unroll
                    for (int i = 0; i < 16; ++i) acc[i] = 0.f;
#pragma unroll
                    for (int s = 0; s < 4; ++s) acc = __builtin_amdgcn_mfma_f32_32x32x16_bf16(A[mt][s], B[s], acc, 0, 0, 0);
                    float sA = 0.f, sB = 0.f;
#pragma unroll
                    for (int i = 0; i < 8; ++i) { const unsigned wa = wq[mt][0][i >> 1], wb = wq[mt][1][i >> 1];
                        const float fa = (i & 1) ? bf_hi(wa) : bf_lo(wa), fb = (i & 1) ? bf_hi(wb) : bf_lo(wb);
                        sA += fmaxf(acc[i], 0.f) * fa; sB += fmaxf(acc[8 + i], 0.f) * fb; }
                    sc[(4 * mt + 2 * h) * 2048 + key] = sA; sc[(4 * mt + 2 * h + 1) * 2048 + key] = sB;
                }
            }
        }
        __syncthreads();
#pragma unroll 1
        for (int qq = 0; qq < 2 && MODE != 1; ++qq) { const int q = 2 * F.wave + qq; const unsigned g_ = (pi & 1) ? guess[1] : guess[0];
            const unsigned t_ = select_topk(sc + q * 2048, n_adm, IDX + (size_t)(t0 + q) * 256, (LAS unsigned short*)(F.lds + LDSCTL_OFF + 1024 + F.wave * 512), lane, g_); if (pi & 1) guess[1] = t_; else guess[0] = t_; }
        __syncthreads();
    }
#undef IDX_TILE
#undef IDX_LOAD_A
}

__device__ __forceinline__ unsigned vst_off(unsigned r, unsigned ch) { return r * 128u + 16u * (ch ^ ((((r >> 1) ^ (r >> 4)) & 1u) << 1) ^ (((r >> 3) & 1u) << 2)); }
__device__ __forceinline__ int t5_bucket_dev(int rel) {
    const int n = rel < 0 ? -rel : rel;
    int v = n;
    if (n >= 8) v = 8 + (n >= 12) + (n >= 16) + (n >= 23) + (n >= 32) + (n >= 46) + (n >= 64) + (n >= 91);
    return v + (rel > 0 ? 16 : 0);
}
#ifndef ATT_REPS
#define ATT_REPS 1
#endif
#ifndef ATT_FIXKEYS
#define ATT_FIXKEYS 0
#endif
template <int FIX = 0>
__device__ __forceinline__ void attention_phase(const Frame& F0) {
#pragma unroll 1
    for (int rep = 0; rep < ATT_REPS; ++rep) {
    Frame F = launder(F0);
    const GAS unsigned char* Q8 = (const GAS unsigned char*)(F.ws + Z_Q8); const GAS unsigned char* KV8 = (const GAS unsigned char*)(F.ws + Z_KV8); bf16* OB = (bf16*)(F.ws + Z_XR);
    const GAS unsigned short* IDX = (const GAS unsigned short*)(F.ws + WS_IDX);
    const int lane = F.lane, g = lane >> 4, m = lane & 15;
    LAS unsigned char* vst = F.lds + RING_OFF + F.wave * 4096;
    const unsigned vbase = (unsigned)(size_t)vst;
    LAS unsigned char* BK = F.lds + RING_OFF + 32768; LAS unsigned char* OH = F.lds + RING_OFF + 32768 + 2176;
    for (int i = F.tid; i < 2112; i += 512) BK[i] = (unsigned char)t5_bucket_dev(i - 2047);
    if (F.tid < 128) { const int bkt = F.tid >> 2, gg = F.tid & 3, j = bkt - 8 * gg; v4u oh; oh.x = oh.y = oh.z = oh.w = 0u;
        if (j >= 0 && j < 8) { const unsigned val = (j & 1) ? 0x3F800000u : 0x3F80u; if ((j >> 1) == 0) oh.x = val; else if ((j >> 1) == 1) oh.y = val; else if ((j >> 1) == 2) oh.z = val; else oh.w = val; }
        *(LAS v4u*)(OH + F.tid * 16) = oh; }
    __syncthreads();
    bf16x8 bb;
    { const float* rbias = kargs()->in[I_RELB]; unsigned w[4];
#pragma unroll
      for (int j = 0; j < 4; ++j) w[j] = pk2(8.0f * rbias[(8 * g + 2 * j) * 16 + m], 8.0f * rbias[(8 * g + 2 * j + 1) * 16 + m]);
      v4u t; t.x = w[0]; t.y = w[1]; t.z = w[2]; t.w = w[3]; bb = __builtin_bit_cast(bf16x8, t); }
    unsigned tra[4];
    { const unsigned rr_ = 8 * g + (m >> 1), fr_ = ((rr_ >> 2) & 3u) ^ ((rr_ >> 1) & 1u);
#pragma unroll
      for (int c = 0; c < 4; ++c) tra[c] = rr_ * 64u + 16u * ((unsigned)c ^ fr_) + 8u * (m & 1); }
    const long aones = (m == 0) ? 0x3838383838383838L : 0L;
    const int vcu = (F.bx & 7) * (F.G >> 3) + (F.bx >> 3);
    typedef long fp8x8;
    v4u ni0, ni1, nq; v4u ka[16]; unsigned koff[16];
#define ATT_KOFF(i0_, i1_) do { _Pragma("unroll") for (int k = 0; k < 4; ++k) { koff[2 * k] = ((i0_)[k] & 0xffffu) * 128u + 16u * g; koff[2 * k + 1] = ((i0_)[k] >> 16) * 128u + 16u * g; \
        koff[8 + 2 * k] = ((i1_)[k] & 0xffffu) * 128u + 16u * g; koff[8 + 2 * k + 1] = ((i1_)[k] >> 16) * 128u + 16u * g; } } while (0)
#ifdef ATT_NO_ASM
#define ATT_KLOAD(kvb_) do { const GAS unsigned char* kb_ = (kvb_); _Pragma("unroll") for (int T = 0; T < 16; ++T) ka[T] = *(const GAS v4u*)(kb_ + koff[T]); } while (0)
#define ATT_KWAIT(n_, T0_) do {} while (0)
#else
#define ATT_KLOAD(kvb_) do { const GAS unsigned char* kb_ = (kvb_); _Pragma("unroll") for (int T = 0; T < 16; ++T) { \
        asm volatile("global_load_dwordx4 %0, %1, %2" : "=&v"(ka[T]) : "v"(koff[T]), "s"(kb_) : "memory"); } } while (0)
#define ATT_KWAIT(n_, T0_) asm volatile("s_waitcnt vmcnt(" #n_ ")" : "+v"(ka[T0_]), "+v"(ka[T0_ + 1]), "+v"(ka[T0_ + 2]), "+v"(ka[T0_ + 3]), "+v"(ka[T0_ + 4]), "+v"(ka[T0_ + 5]), "+v"(ka[T0_ + 6]), "+v"(ka[T0_ + 7]) :: "memory")
#endif
#define ATT_TOK(it_) ((vcu >> 3) * SEQ + ((it_) >> 2) * 256 + (vcu & 7) * 32 + 8 * ((it_) & 3) + F.wave)
    { const int tok0 = ATT_TOK(0); const GAS v4u* ip = (const GAS v4u*)(IDX + (size_t)tok0 * 256 + 16 * m); ni0 = ip[0]; ni1 = ip[1];
      nq = *(const GAS v4u*)(Q8 + (size_t)tok0 * D + m * 64 + 16 * g);
      ATT_KOFF(ni0, ni1); ATT_KLOAD(KV8 + (size_t)(tok0 >> 11) * SEQ * 128); }
    for (int it = 0; it < 32; ++it) {
        const int tok = ATT_TOK(it), b = tok >> 11, tq = tok & (SEQ - 1);
        const int n_valid = (((tq >> 6) + 1) * 64) < 256 ? ((tq >> 6) + 1) * 64 : 256;
        const v4u qv = nq;
        const fp8x8 qf0 = (fp8x8)(((unsigned long long)qv.y << 32) | qv.x), qf1 = (fp8x8)(((unsigned long long)qv.w << 32) | qv.z);
        const GAS unsigned char* kvb = KV8 + (size_t)b * SEQ * 128;
        f32x4 S[16];
#pragma unroll
        for (int T = 0; T < 16; ++T) {
            if (T == 0) ATT_KWAIT(8, 0);
            if (T == 8) ATT_KWAIT(0, 8);
            const unsigned bkt = BK[(koff[T] >> 7) + (2047 - tq)];
            const v4u oh = *(const LAS v4u*)(OH + bkt * 64 + g * 16);
            f32x4 ab = (f32x4){0.f, 0.f, 0.f, 0.f}, a = (f32x4){0.f, 0.f, 0.f, 0.f};
            ab = __builtin_amdgcn_mfma_f32_16x16x32_bf16(__builtin_bit_cast(bf16x8, oh), bb, ab, 0, 0, 0);
            a = __builtin_amdgcn_mfma_f32_16x16x32_fp8_fp8((fp8x8)(((unsigned long long)ka[T].y << 32) | ka[T].x), qf0, a, 0, 0, 0);
            a = __builtin_amdgcn_mfma_f32_16x16x32_fp8_fp8((fp8x8)(((unsigned long long)ka[T].w << 32) | ka[T].z), qf1, a, 0, 0, 0);
            a = a + ab;
            S[T] = a;
        }
        __builtin_amdgcn_sched_barrier(0);
        v4u vv[16];
#pragma unroll
        for (int T = 0; T < 16; ++T) vv[T] = *(const GAS v4u*)(kvb + koff[T] + 64);
        if (n_valid < 256) {
#pragma unroll
            for (int T = 0; T < 16; ++T)
#pragma unroll
                for (int i = 0; i < 4; ++i) if (16 * (4 * g + i) + T >= n_valid) S[T][i] = -1e30f;
        }
        float mx = -3.0e38f;
#pragma unroll
        for (int T = 0; T < 16; ++T) { asm("v_max3_f32 %0, %1, %2, %0" : "+v"(mx) : "v"(S[T][0]), "v"(S[T][1])); asm("v_max3_f32 %0, %1, %2, %0" : "+v"(mx) : "v"(S[T][2]), "v"(S[T][3])); }
        mx = fmaxf(mx, lane_xor(mx, 16, lane)); mx = fmaxf(mx, lane_xor(mx, 32, lane));
        constexpr float SC = 1.4426950408889634f * 0.125f;
        const float mneg = 8.0f - mx * SC;
#pragma unroll
        for (int T = 0; T < 16; ++T)
#pragma unroll
            for (int i = 0; i < 4; ++i) S[T][i] = __builtin_amdgcn_exp2f(S[T][i] * SC + mneg);
        { const int tokn = ATT_TOK(it < 31 ? it + 1 : it); const GAS v4u* ip = (const GAS v4u*)(IDX + (size_t)tokn * 256 + 16 * m); ni0 = ip[0]; ni1 = ip[1];
          nq = *(const GAS v4u*)(Q8 + (size_t)tokn * D + m * 64 + 16 * g); }
        f32x4 O[4], Osum = (f32x4){0.f, 0.f, 0.f, 0.f};
#pragma unroll
        for (int c = 0; c < 4; ++c) O[c] = (f32x4){0.f, 0.f, 0.f, 0.f};
#pragma unroll
        for (int ks = 0; ks < 8; ++ks) {
#pragma unroll
            for (int tt = 0; tt < 2; ++tt) { const unsigned rr = 8 * (m >> 2) + 4 * tt + (m & 3), fr = ((rr >> 2) & 3u) ^ ((rr >> 1) & 1u);
                *(LAS v4u*)(vst + rr * 64u + 16u * ((unsigned)g ^ fr)) = vv[2 * ks + tt]; }
            int p0 = __builtin_amdgcn_cvt_pk_fp8_f32(S[2 * ks][0], S[2 * ks][1], 0, false); p0 = __builtin_amdgcn_cvt_pk_fp8_f32(S[2 * ks][2], S[2 * ks][3], p0, true);
            int p1 = __builtin_amdgcn_cvt_pk_fp8_f32(S[2 * ks + 1][0], S[2 * ks + 1][1], 0, false); p1 = __builtin_amdgcn_cvt_pk_fp8_f32(S[2 * ks + 1][2], S[2 * ks + 1][3], p1, true);
            const fp8x8 pf = (fp8x8)(((unsigned long long)(unsigned)p1 << 32) | (unsigned)p0);
            v2u f[4];
            asm volatile("s_waitcnt lgkmcnt(0)\n\t"
                         "ds_read_b64_tr_b8 %0, %4\n\tds_read_b64_tr_b8 %1, %5\n\tds_read_b64_tr_b8 %2, %6\n\tds_read_b64_tr_b8 %3, %7\n\t"
                         "s_waitcnt lgkmcnt(0)"
                         : "=&v"(f[0]), "=&v"(f[1]), "=&v"(f[2]), "=&v"(f[3])
                         : "v"(vbase + tra[0]), "v"(vbase + tra[1]), "v"(vbase + tra[2]), "v"(vbase + tra[3])
                         : "memory");
#pragma unroll
            for (int c = 0; c < 4; ++c) O[c] = __builtin_amdgcn_mfma_f32_16x16x32_fp8_fp8((fp8x8)(((unsigned long long)f[c].y << 32) | f[c].x), pf, O[c], 0, 0, 0);
            Osum = __builtin_amdgcn_mfma_f32_16x16x32_fp8_fp8(aones, pf, Osum, 0, 0, 0);
        }
        const float inv = 1.0f / lane_get(Osum[0], m);
#pragma unroll
        for (int c = 0; c < 4; ++c) { v2u w; w.x = pk2(O[c][0] * inv, O[c][1] * inv); w.y = pk2(O[c][2] * inv, O[c][3] * inv);
            *(GAS v2u*)(OB + (size_t)tok * D + m * 64 + 16 * c + 4 * g) = w; }
        { const int tokn = ATT_TOK(it < 31 ? it + 1 : it); ATT_KOFF(ni0, ni1); ATT_KLOAD(KV8 + (size_t)(tokn >> 11) * SEQ * 128); }
    }
    asm volatile("s_waitcnt vmcnt(0)" ::: "memory");
#undef ATT_KOFF
#undef ATT_KLOAD
#undef ATT_KWAIT
    }
}

__device__ __forceinline__ void attention_phase2(const Frame& F0) {
    Frame F = launder(F0);
    const GAS unsigned char* Q8 = (const GAS unsigned char*)(F.ws + Z_Q8); const GAS unsigned char* KV8 = (const GAS unsigned char*)(F.ws + Z_KV8); bf16* OB = (bf16*)(F.ws + Z_XR);
    const GAS unsigned short* IDX = (const GAS unsigned short*)(F.ws + WS_IDX);
    const int lane = F.lane, g = lane >> 4, m = lane & 15, r8 = lane >> 3, c8 = lane & 7;
    LAS unsigned char* vbuf = F.lds + RING_OFF + F.wave * 16384;
    const unsigned vbase = (unsigned)(size_t)vbuf;
    LAS unsigned char* irow = F.lds + LDSCTL_OFF + 1024 + F.wave * 512;
    LAS unsigned char* kst = F.lds + LDSCTL_OFF + 5120 + F.wave * 2048;
    LAS unsigned char* BK = F.lds + LDSCTL_OFF + 21504;
    for (int i = F.tid; i < 2112; i += 512) BK[i] = (unsigned char)t5_bucket_dev(i - 2047);
    __syncthreads();
    bf16x8 bb;
    { const float* rbias = kargs()->in[I_RELB]; unsigned w[4];
#pragma unroll
      for (int j = 0; j < 4; ++j) w[j] = pk2(8.0f * rbias[(8 * g + 2 * j) * 16 + m], 8.0f * rbias[(8 * g + 2 * j + 1) * 16 + m]);
      v4u t; t.x = w[0]; t.y = w[1]; t.z = w[2]; t.w = w[3]; bb = __builtin_bit_cast(bf16x8, t); }
    unsigned tra[4];
    { const unsigned rr_ = 8 * g + (m >> 1), fr_ = ((rr_ >> 2) & 3u) ^ ((rr_ >> 1) & 1u);
#pragma unroll
      for (int c = 0; c < 4; ++c) tra[c] = vbase + rr_ * 64u + 16u * ((unsigned)c ^ fr_) + 8u * (m & 1); }
    const long aones = (m == 0) ? 0x3838383838383838L : 0L;
    const int vcu = (F.bx & 7) * (F.G >> 3) + (F.bx >> 3);
    unsigned wa[2][2]; const unsigned vstr = c8 >= 4 ? 2048u : 0u;
#pragma unroll
    for (int j = 0; j < 2; ++j)
#pragma unroll
        for (int t = 0; t < 2; ++t) { const unsigned rho = 8u * j + r8;
            if (c8 < 4) wa[j][t] = (unsigned)(LDSCTL_OFF + 5120) + F.wave * 2048u + 1024u * t + rho * 64u + 16u * ((unsigned)c8 ^ (3u * j));
            else { const unsigned rr = 8u * (rho >> 2) + 4u * t + (rho & 3u), fr = ((rr >> 2) & 3u) ^ ((rr >> 1) & 1u); wa[j][t] = (unsigned)RING_OFF + F.wave * 16384u + rr * 64u + 16u * ((unsigned)(c8 - 4) ^ fr); } }
    const unsigned kra = m * 64u + 16u * ((unsigned)g ^ (3u * ((m >> 3) & 1)));
    const unsigned bra = 2u * (32u * (m & 7) + (m >> 3));
    typedef long fp8x8;
    v4u ni, nq;
#define ATT2_QLOAD(tk_) do { const unsigned qo_ = (unsigned)(tk_) * (unsigned)D + (unsigned)(m * 64 + 16 * g); asm volatile("global_load_dwordx4 %0, %1, %2" : "=&v"(nq) : "v"(qo_), "s"(Q8) : "memory"); } while (0)
    { const int tok0 = ATT_TOK(0); ni = *(const GAS v4u*)(IDX + (size_t)tok0 * 256 + 8 * (lane & 31)); ATT2_QLOAD(tok0); }
    for (int it = 0; it < 32; ++it) {
        const int tok = ATT_TOK(it), b = tok >> 11, tq = tok & (SEQ - 1);
        const int n_valid = (((tq >> 6) + 1) * 64) < 256 ? ((tq >> 6) + 1) * 64 : 256;
        const GAS unsigned char* kvb = KV8 + (size_t)b * SEQ * 128;
        if (lane < 32) *(LAS v4u*)(irow + 16 * lane) = ni;
        v4u kv[32];
        { v4u ix[4];
#pragma unroll
          for (int k = 0; k < 4; ++k) ix[k] = *(const LAS v4u*)(irow + 64 * r8 + 16 * k);
#pragma unroll
          for (int q = 0; q < 32; ++q) { const unsigned w = ix[q >> 3][(q >> 1) & 3]; const unsigned off = ((q & 1) ? (w >> 16) : (w & 0xffffu)) * 128u + 16u * c8;
              asm volatile("global_load_dwordx4 %0, %1, %2" : "=&v"(kv[q]) : "v"(off), "s"(kvb) : "memory"); } }
        unsigned bkp[4] = {0u, 0u, 0u, 0u};
#pragma unroll
        for (int T = 0; T < 16; ++T) { const unsigned key = *(const LAS unsigned short*)(irow + bra + 4 * T); bkp[T >> 2] |= (unsigned)BK[key + (2047 - tq)] << (8 * (T & 3)); }
        f32x4 S[16];
#define ATT2_STAGE(T, N, KF) do { \
            asm volatile("s_waitcnt vmcnt(" #N ")" : "+v"(kv[2 * (T)]), "+v"(kv[2 * (T) + 1]) :: "memory"); \
            *(LAS v4u*)(F.lds + wa[0][(T) & 1] + ((T) >> 1) * vstr) = kv[2 * (T)]; *(LAS v4u*)(F.lds + wa[1][(T) & 1] + ((T) >> 1) * vstr) = kv[2 * (T) + 1]; \
            KF = *(const LAS v4u*)(kst + 1024 * ((T) & 1) + kra); } while (0)
#define ATT2_MMA(T, KF) do { \
            const unsigned ju = ((bkp[(T) >> 2] >> (8 * ((T) & 3))) & 0xffu) - 8u * g, val = 0x3F80u << (16u * (ju & 1u)); v4u oh; \
            oh.x = (ju >> 1) == 0u ? val : 0u; oh.y = (ju >> 1) == 1u ? val : 0u; oh.z = (ju >> 1) == 2u ? val : 0u; oh.w = (ju >> 1) == 3u ? val : 0u; \
            f32x4 ab = (f32x4){0.f, 0.f, 0.f, 0.f}, a = (f32x4){0.f, 0.f, 0.f, 0.f}; \
            ab = __builtin_amdgcn_mfma_f32_16x16x32_bf16(__builtin_bit_cast(bf16x8, oh), bb, ab, 0, 0, 0); \
            a = __builtin_amdgcn_mfma_f32_16x16x32_fp8_fp8((fp8x8)(((unsigned long long)(KF).y << 32) | (KF).x), qf0, a, 0, 0, 0); \
            a = __builtin_amdgcn_mfma_f32_16x16x32_fp8_fp8((fp8x8)(((unsigned long long)(KF).w << 32) | (KF).z), qf1, a, 0, 0, 0); \
            S[T] = a + ab; } while (0)
        v4u kfa, kfb;
        ATT2_STAGE(0, 30, kfa);
        asm volatile("" : "+v"(nq) :: "memory");
        const v4u qv = nq;
        const fp8x8 qf0 = (fp8x8)(((unsigned long long)qv.y << 32) | qv.x), qf1 = (fp8x8)(((unsigned long long)qv.w << 32) | qv.z);
        ATT2_STAGE(1, 28, kfb); ATT2_MMA(0, kfa);   ATT2_STAGE(2, 26, kfa); ATT2_MMA(1, kfb);   ATT2_STAGE(3, 24, kfb); ATT2_MMA(2, kfa);   ATT2_STAGE(4, 22, kfa); ATT2_MMA(3, kfb);
        ATT2_STAGE(5, 20, kfb); ATT2_MMA(4, kfa);   ATT2_STAGE(6, 18, kfa); ATT2_MMA(5, kfb);   ATT2_STAGE(7, 16, kfb); ATT2_MMA(6, kfa);   ATT2_STAGE(8, 14, kfa); ATT2_MMA(7, kfb);
        ATT2_STAGE(9, 12, kfb); ATT2_MMA(8, kfa);   ATT2_STAGE(10, 10, kfa); ATT2_MMA(9, kfb);  ATT2_STAGE(11, 8, kfb); ATT2_MMA(10, kfa);  ATT2_STAGE(12, 6, kfa); ATT2_MMA(11, kfb);
        ATT2_STAGE(13, 4, kfb); ATT2_MMA(12, kfa);  ATT2_STAGE(14, 2, kfa); ATT2_MMA(13, kfb);  ATT2_STAGE(15, 0, kfb); ATT2_MMA(14, kfa);  ATT2_MMA(15, kfb);
#undef ATT2_STAGE
#undef ATT2_MMA
        if (n_valid < 256) {
            int bs0 = 128 * (g & 1) + (g >> 1); asm volatile("" : "+v"(bs0));
#pragma unroll
            for (int T = 0; T < 16; ++T) { const int lim = n_valid - 2 * T;
#pragma unroll
                for (int i = 0; i < 4; ++i) if (bs0 + 32 * i >= lim) S[T][i] = -1e30f; }
        }
        float mx = -3.0e38f;
#pragma unroll
        for (int T = 0; T < 16; ++T) { asm("v_max3_f32 %0, %1, %2, %0" : "+v"(mx) : "v"(S[T][0]), "v"(S[T][1])); asm("v_max3_f32 %0, %1, %2, %0" : "+v"(mx) : "v"(S[T][2]), "v"(S[T][3])); }
        mx = fmaxf(mx, lane_xor(mx, 16, lane)); mx = fmaxf(mx, lane_xor(mx, 32, lane));
        constexpr float SC = 1.4426950408889634f * 0.125f;
        const float mneg = 8.0f - mx * SC;
#pragma unroll
        for (int T = 0; T < 16; ++T)
#pragma unroll
            for (int i = 0; i < 4; ++i) S[T][i] = __builtin_amdgcn_exp2f(S[T][i] * SC + mneg);
        { const int tokn = ATT_TOK(it < 31 ? it + 1 : it); ni = *(const GAS v4u*)(IDX + (size_t)tokn * 256 + 8 * (lane & 31)); ATT2_QLOAD(tokn); }
        f32x4 O[4], Osum = (f32x4){0.f, 0.f, 0.f, 0.f};
#pragma unroll
        for (int c = 0; c < 4; ++c) O[c] = (f32x4){0.f, 0.f, 0.f, 0.f};
#pragma unroll
        for (int ks = 0; ks < 8; ++ks) {
            int p0 = __builtin_amdgcn_cvt_pk_fp8_f32(S[2 * ks][0], S[2 * ks][1], 0, false); p0 = __builtin_amdgcn_cvt_pk_fp8_f32(S[2 * ks][2], S[2 * ks][3], p0, true);
            int p1 = __builtin_amdgcn_cvt_pk_fp8_f32(S[2 * ks + 1][0], S[2 * ks + 1][1], 0, false); p1 = __builtin_amdgcn_cvt_pk_fp8_f32(S[2 * ks + 1][2], S[2 * ks + 1][3], p1, true);
            const fp8x8 pf = (fp8x8)(((unsigned long long)(unsigned)p1 << 32) | (unsigned)p0);
            v2u f[4];
            asm volatile("s_waitcnt lgkmcnt(0)\n\t"
                         "ds_read_b64_tr_b8 %0, %4\n\tds_read_b64_tr_b8 %1, %5\n\tds_read_b64_tr_b8 %2, %6\n\tds_read_b64_tr_b8 %3, %7\n\t"
                         "s_waitcnt lgkmcnt(0)"
                         : "=&v"(f[0]), "=&v"(f[1]), "=&v"(f[2]), "=&v"(f[3])
                         : "v"(tra[0] + 2048u * ks), "v"(tra[1] + 2048u * ks), "v"(tra[2] + 2048u * ks), "v"(tra[3] + 2048u * ks)
                         : "memory");
#pragma unroll
            for (int c = 0; c < 4; ++c) O[c] = __builtin_amdgcn_mfma_f32_16x16x32_fp8_fp8((fp8x8)(((unsigned long long)f[c].y << 32) | f[c].x), pf, O[c], 0, 0, 0);
            Osum = __builtin_amdgcn_mfma_f32_16x16x32_fp8_fp8(aones, pf, Osum, 0, 0, 0);
        }
        const float inv = 1.0f / lane_get(Osum[0], m);
#pragma unroll
        for (int c = 0; c < 4; ++c) { v2u w; w.x = pk2(O[c][0] * inv, O[c][1] * inv); w.y = pk2(O[c][2] * inv, O[c][3] * inv);
            *(GAS v2u*)(OB + (size_t)tok * D + m * 64 + 16 * c + 4 * g) = w; }
    }
    asm volatile("s_waitcnt vmcnt(0)" : "+v"(nq) :: "memory");
#undef ATT2_QLOAD
}
constexpr int XCS = 136;
constexpr int HHS = 132;
__device__ __forceinline__ float gelu_tanh(float x) {
    const float z = 0.7978845608028654f * (x + 0.044715f * x * x * x);
    const float e = __builtin_amdgcn_exp2f(2.885390081777927f * z);
    const float th = 1.0f - 2.0f * __builtin_amdgcn_rcpf(e + 1.0f);
    return 0.5f * x * (1.0f + th);
}
template <bool DRY = false>
__device__ __forceinline__ void lru_phase(const Frame& F0, int L) {
    Frame F = launder(F0);
    const KArgs ka = kargs();
    const int b = F.bx >> 3, nb = F.bx & 7;
    const bf16* XR = (const bf16*)(F.ws + Z_XR); bf16* YR = (bf16*)(F.ws + Z_YR);
    const bf16* WL = (const bf16*)(F.ws + WS_W + W_LRU);
    LAS bf16* XC = (LAS bf16*)(F.lds + RING_OFF);
    LAS float* HH = (LAS float*)(F.lds + RING_OFF + 2 * 64 * XCS * 2);
    const int tid = F.tid, lane = F.lane, w = F.wave, g = lane >> 4, m = lane & 15;
    const int cc = tid & 15, tp = tid >> 4;
    const int ch0 = nb * 128 + 8 * cc;
    float cw[4][8], cbias[8];
#pragma unroll
    for (int j = 0; j < 4; ++j)
#pragma unroll
        for (int k = 0; k < 8; ++k) cw[j][k] = ka->in[I_CONVW][(size_t)L * 4 * D + j * D + ch0 + k];
#pragma unroll
    for (int k = 0; k < 8; ++k) cbias[k] = ka->in[I_CONVB][(size_t)L * D + ch0 + k];
    bf16x8 Br[4], Bi[4];
#pragma unroll
    for (int s = 0; s < 4; ++s) { Br[s] = *(const GAS bf16x8*)(WL + ((size_t)nb * 128 + 16 * w + m) * 128 + 32 * s + 8 * g);
                                  Bi[s] = *(const GAS bf16x8*)(WL + (size_t)8 * 128 * 128 + ((size_t)nb * 128 + 16 * w + m) * 128 + 32 * s + 8 * g); }
    const int chl = 16 * w + m, chg = nb * 128 + chl;
    const float ba = ka->in[I_LRUBA][(size_t)L * D + chg], bx = ka->in[I_LRUBX][(size_t)L * D + chg];
    const float lam = ka->in[I_LAM][(size_t)L * D + chg];
    const float sp8 = -8.0f * (fmaxf(-lam, 0.f) + log1pf(__expf(-fabsf(lam))));
    float carry = 0.f;
    const size_t rowb = (size_t)b * SEQ;
    v4u nxin[5], nyin[2];
#pragma unroll
    for (int k = 0; k < 5; ++k) { const int t = 2 * tp - 3 + k; v4u z; z.x = z.y = z.z = z.w = 0u; nxin[k] = (t >= 0) ? *(const GAS v4u*)(XR + (rowb + t) * D + ch0) : z; }
#pragma unroll
    for (int k = 0; k < 2; ++k) nyin[k] = *(const GAS v4u*)(YR + (rowb + 2 * tp + k) * D + ch0);
    for (int tile = 0; tile < 32; ++tile) {
        const int t0 = tile * 64, buf = tile & 1;
        LAS bf16* xc = XC + buf * 64 * XCS; LAS float* hh = HH + buf * 64 * HHS;
        v4u xin[5], yin[2];
#pragma unroll
        for (int k = 0; k < 5; ++k) xin[k] = nxin[k];
#pragma unroll
        for (int k = 0; k < 2; ++k) yin[k] = nyin[k];
        if (tile < 31) {
#pragma unroll
            for (int k = 0; k < 5; ++k) nxin[k] = *(const GAS v4u*)(XR + (rowb + t0 + 64 + 2 * tp - 3 + k) * D + ch0);
#pragma unroll
            for (int k = 0; k < 2; ++k) nyin[k] = *(const GAS v4u*)(YR + (rowb + t0 + 64 + 2 * tp + k) * D + ch0);
        }
#pragma unroll
        for (int k = 0; k < 2; ++k) { float o[8];
#pragma unroll
            for (int c = 0; c < 8; ++c) { float a = cbias[c];
#pragma unroll
                for (int j = 0; j < 4; ++j) { const unsigned wv = xin[k + j][c >> 1]; a += ((c & 1) ? bf_hi(wv) : bf_lo(wv)) * cw[j][c]; }
                o[c] = a; }
            v4u pw; pw.x = pk2(o[0], o[1]); pw.y = pk2(o[2], o[3]); pw.z = pk2(o[4], o[5]); pw.w = pk2(o[6], o[7]);
            *(LAS v4u*)(xc + (2 * tp + k) * XCS + 8 * cc) = pw; }
        __syncthreads();
#pragma unroll
        for (int mt = 0; mt < 4; ++mt) {
            f32x4 ar = (f32x4){0.f, 0.f, 0.f, 0.f}, ai = (f32x4){0.f, 0.f, 0.f, 0.f};
#pragma unroll
            for (int s = 0; s < 4; ++s) { const bf16x8 A = *(const LAS bf16x8*)(xc + (16 * mt + m) * XCS + 32 * s + 8 * g);
                ar = __builtin_amdgcn_mfma_f32_16x16x32_bf16(A, Br[s], ar, 0, 0, 0); ai = __builtin_amdgcn_mfma_f32_16x16x32_bf16(A, Bi[s], ai, 0, 0, 0); }
            float P[4], W[4];
#pragma unroll
            for (int i = 0; i < 4; ++i) {
                const float rr = sigmoidf_fast(ar[i] + ba), ig = sigmoidf_fast(ai[i] + bx);
                const float la = sp8 * rr;
                const float a = __builtin_amdgcn_exp2f(1.4426950408889634f * la);
                const float mult = __builtin_amdgcn_sqrtf(fmaxf(__builtin_fmaf(-a, a, 1.0f), 0.f));
                const float xv = __builtin_bit_cast(float, (unsigned)xc[(16 * mt + 4 * g + i) * XCS + chl] << 16);
                const float u = mult * (ig * xv);
                if (i == 0) { P[0] = a; W[0] = u; } else { P[i] = a * P[i - 1]; W[i] = a * W[i - 1] + u; }
            }
            float Ac = P[3], Uc = W[3];
            { const float A1 = lane_up(Ac, 16, lane), U1 = lane_up(Uc, 16, lane); if (g >= 1) { Uc = Ac * U1 + Uc; Ac = Ac * A1; } }
            { const float A2 = lane_up(Ac, 32, lane), U2 = lane_up(Uc, 32, lane); if (g >= 2) { Uc = Ac * U2 + Uc; Ac = Ac * A2; } }
            float Ae = lane_up(Ac, 16, lane), Ue = lane_up(Uc, 16, lane); if (g == 0) { Ae = 1.f; Ue = 0.f; }
            const float hin = Ae * carry + Ue;
            const float cnew = Ac * carry + Uc;
            carry = lane_get(cnew, 48 + m);
#pragma unroll
            for (int i = 0; i < 4; ++i) hh[(16 * mt + 4 * g + i) * HHS + chl] = P[i] * hin + W[i];
        }
        __syncthreads();
#pragma unroll
        for (int k = 0; k < 2; ++k) { const f32x4 h0 = *(const LAS f32x4*)(hh + (2 * tp + k) * HHS + 8 * cc), h1 = *(const LAS f32x4*)(hh + (2 * tp + k) * HHS + 8 * cc + 4);
            float o[8];
#pragma unroll
            for (int c = 0; c < 8; ++c) { const unsigned wv = yin[k][c >> 1]; const float y = (c & 1) ? bf_hi(wv) : bf_lo(wv); o[c] = (c < 4 ? h0[c] : h1[c - 4]) * gelu_tanh(y); }
            v4u pw; pw.x = pk2(o[0], o[1]); pw.y = pk2(o[2], o[3]); pw.z = pk2(o[4], o[5]); pw.w = pk2(o[6], o[7]);
            *(GAS v4u*)((DRY ? (bf16*)(F.ws + WS_NEED) : YR) + (rowb + t0 + 2 * tp + k) * D + ch0) = pw; }
    }
    __syncthreads();
}

struct MoeOrder : pg8::StaticOrder {
    const volatile LAS unsigned* tb; int tile0; const int* list; size_t bstride;
    __device__ __forceinline__ int expert_of(int gt) const { int e = 0;
#pragma unroll
        for (int k = 1; k < 8; ++k) e += (gt >= (int)tb[k]) ? 1 : 0;
        return e; }
    __device__ __forceinline__ const char* b_base(const pg8::Gemm& g, const pg8::Unit& u, size_t tstep) const { return (const char*)g.Bt + (size_t)expert_of(tile0 + u.pm) * bstride + (size_t)u.pn * tstep; }
};
struct MoeGatherOrder : MoeOrder {
    static constexpr bool GATHER = true;
    __device__ __forceinline__ const char* a_base(const pg8::Gemm& g, const pg8::Unit&, size_t) const { return (const char*)g.A; }
    __device__ __forceinline__ void a_rows(const pg8::Unit& u, int R0, int R1, int C0, int C1, int K, unsigned (&off)[2][2]) const {
        const int gt = tile0 + u.pm, e = expert_of(gt), j = gt - (int)tb[e], n = (int)tb[16 + e];
        const GAS int* le = (const GAS int*)list + (size_t)e * T_TOK;
#pragma unroll
        for (int h = 0; h < 2; ++h) { int p0 = 256 * j + 128 * h + R0, p1 = 256 * j + 128 * h + R1; p0 = p0 < n ? p0 : n - 1; p1 = p1 < n ? p1 : n - 1;
            off[h][0] = ((unsigned)le[p0] * (unsigned)K + (unsigned)C0) * 2u; off[h][1] = ((unsigned)le[p1] * (unsigned)K + (unsigned)C1) * 2u; }
    }
};
#ifdef SELFCHECK
#ifndef SC_TOL
#define SC_TOL 0.03f
#define SC_ABS 1e-5f
#endif
__device__ __forceinline__ float sc_bf(const bf16* p, size_t i) { return __builtin_bit_cast(float, (unsigned)((const GAS bf16*)p)[i] << 16); }
__device__ __forceinline__ float sc_f8(const unsigned char* p, size_t i) {
    const unsigned v = ((const GAS unsigned char*)p)[i]; const unsigned e = (v >> 3) & 15u, mn = v & 7u; float r;
    if (e == 0u) r = (float)mn * 0.001953125f; else r = (1.0f + (float)mn * 0.125f) * exp2f((float)e - 7.0f);
    return (v & 128u) ? -r : r; }
__device__ __forceinline__ void sc_fail(const Frame& F, unsigned code) { __hip_atomic_fetch_or(F.ctl + CW_CODE, code, RLX_AGENT); }
__device__ __forceinline__ int sc_bucket_ref(int rel) {
    const int half = 16, max_exact = 8; const int ret = rel > 0 ? half : 0; const int n = rel < 0 ? -rel : rel;
    const float nf = (float)(n > 1 ? n : 1);
    int large = max_exact + (int)(logf(nf / (float)max_exact) / logf(16.0f) * (float)(half - max_exact));
    large = large < half - 1 ? large : half - 1;
    return ret + (n < max_exact ? n : large);
}
__device__ __forceinline__ void selfcheck_topk(const Frame& F0) {
    Frame F = launder(F0);
    if (F.wave != 0) return;
    const bf16* QI = (const bf16*)(F.ws + Z_QI); const bf16* SM = (const bf16*)(F.ws + Z_SM);
    const GAS unsigned short* IDX = (const GAS unsigned short*)(F.ws + WS_IDX);
    LAS float* sc = (LAS float*)(F.lds + RING_OFF);
    LAS unsigned* bm = (LAS unsigned*)(F.lds + RING_OFF + 8192);
    const int tok = F.bx * 256 + ((F.bx * 37) & 255), b = tok >> 11, tq = tok & (SEQ - 1), n_adm = ((tq >> 6) + 1) * 64;
    const int lane = F.lane;
    bm[lane] = 0u;
    for (int s = lane; s < n_adm; s += 64) { float score = 0.f;
        for (int h = 0; h < 8; ++h) { float d = 0.f;
            for (int k = 0; k < 64; ++k) d += sc_bf(QI, (size_t)tok * 512 + h * 64 + k) * sc_bf(SM, (size_t)(b * SEQ + s) * 256 + 128 + k);
            score += fmaxf(d, 0.f) * sc_bf(SM, (size_t)tok * 256 + 192 + h); }
        sc[s] = score; }
    asm volatile("s_waitcnt lgkmcnt(0)" ::: "memory");
    const int nsel = n_adm < 256 ? n_adm : 256;
    float msel = 3.0e38f; bool bad = false;
    for (int p = lane; p < nsel; p += 64) { const int key = IDX[(size_t)tok * 256 + p]; if (key >= n_adm) { bad = true; continue; }
        const unsigned old = __hip_atomic_fetch_or(bm + (key >> 5), 1u << (key & 31), __ATOMIC_RELAXED, __HIP_MEMORY_SCOPE_WORKGROUP); if (old & (1u << (key & 31))) bad = true;
        msel = fminf(msel, sc[key]); }
    asm volatile("s_waitcnt lgkmcnt(0)" ::: "memory");
    float muns = -3.0e38f, amax = 0.f;
    for (int s = lane; s < n_adm; s += 64) { amax = fmaxf(amax, fabsf(sc[s])); if (!((bm[s >> 5] >> (s & 31)) & 1u)) muns = fmaxf(muns, sc[s]); }
#pragma unroll
    for (int o = 1; o < 64; o <<= 1) { msel = fminf(msel, lane_xor(msel, o, lane)); muns = fmaxf(muns, lane_xor(muns, o, lane)); amax = fmaxf(amax, lane_xor(amax, o, lane)); }
    if (muns > msel + 1e-4f * amax) bad = true;
    if (__any(bad)) { if (lane == 0) sc_fail(F, 1u); }
}
__device__ __forceinline__ void selfcheck_attn(const Frame& F0) {
    Frame F = launder(F0);
    if (F.wave != 0) return;
    const KArgs ka = kargs();
    const unsigned char* Q8 = F.ws + Z_Q8; const unsigned char* KV8 = F.ws + Z_KV8; const bf16* OB = (const bf16*)(F.ws + Z_XR);
    const GAS unsigned short* IDX = (const GAS unsigned short*)(F.ws + WS_IDX);
    LAS float* lg = (LAS float*)(F.lds + RING_OFF + 65536);
    const int tok = F.bx * 256 + ((F.bx * 37) & 255), b = tok >> 11, tq = tok & (SEQ - 1), n_adm = ((tq >> 6) + 1) * 64, nv = n_adm < 256 ? n_adm : 256;
    const int lane = F.lane;
    for (int p = lane; p < 256; p += 64) { const int key = IDX[(size_t)tok * 256 + p]; const int bk = sc_bucket_ref(key - tq);
        for (int h = 0; h < 16; ++h) { float d = 0.f;
            for (int k = 0; k < 64; ++k) d += sc_f8(Q8, (size_t)tok * D + h * 64 + k) * sc_f8(KV8, (size_t)(b * SEQ + key) * 128 + k);
            lg[h * 256 + p] = p < nv ? 0.125f * d + ((const GAS float*)ka->in[I_RELB])[bk * 16 + h] : -1e30f; } }
    asm volatile("s_waitcnt lgkmcnt(0)" ::: "memory");
    if (lane < 16) { float mx = -3.0e38f; for (int p = 0; p < 256; ++p) mx = fmaxf(mx, lg[lane * 256 + p]); float sum = 0.f;
        for (int p = 0; p < 256; ++p) { const float e = __expf(lg[lane * 256 + p] - mx); lg[lane * 256 + p] = e; sum += e; }
        const float inv = 1.f / sum; for (int p = 0; p < 256; ++p) lg[lane * 256 + p] *= inv; }
    asm volatile("s_waitcnt lgkmcnt(0)" ::: "memory");
    float emax = 0.f, omax = 0.f;
    for (int o = lane; o < 1024; o += 64) { const int h = o >> 6, d = o & 63; float acc = 0.f;
        for (int p = 0; p < 256; ++p) { const int key = IDX[(size_t)tok * 256 + p]; acc += lg[h * 256 + p] * sc_f8(KV8, (size_t)(b * SEQ + key) * 128 + 64 + d); }
        const float got = sc_bf(OB, (size_t)tok * D + o); emax = fmaxf(emax, fabsf(got - acc)); omax = fmaxf(omax, fabsf(acc)); }
#pragma unroll
    for (int o = 1; o < 64; o <<= 1) { emax = fmaxf(emax, lane_xor(emax, o, lane)); omax = fmaxf(omax, lane_xor(omax, o, lane)); }
    if (!(emax <= SC_TOL * omax + SC_ABS)) { if (lane == 0) sc_fail(F, 2u); }
}
__device__ __forceinline__ void selfcheck_lru(const Frame& F0, int L, bool after) {
    Frame F = launder(F0);
    if (F.wave != 0) return;
    const KArgs ka = kargs();
    const bf16* XR = (const bf16*)(F.ws + Z_XR); const bf16* YR = (const bf16*)(F.ws + Z_YR);
    GAS float* EXP = (GAS float*)(F.ws + WS_NEED) + (size_t)F.bx * SEQ;
    const int b = F.bx >> 3, ch = ((F.bx & 7) * 128 + ((F.bx * 29) & 127)), nb = ch >> 7, lane = F.lane;
    if (after) { float emax = 0.f, omax = 0.f;
        for (int t = lane; t < SEQ; t += 64) { const float e = EXP[t], g = sc_bf(YR, (size_t)(b * SEQ + t) * D + ch); emax = fmaxf(emax, fabsf(e - g)); omax = fmaxf(omax, fabsf(e)); }
#pragma unroll
        for (int o = 1; o < 64; o <<= 1) { emax = fmaxf(emax, lane_xor(emax, o, lane)); omax = fmaxf(omax, lane_xor(omax, o, lane)); }
        if (!(emax <= SC_TOL * omax + SC_ABS)) { if (lane == 0) sc_fail(F, 4u); }
        return; }
    const float* cw = ka->in[I_CONVW] + (size_t)L * 4 * D; const float* cb = ka->in[I_CONVB] + (size_t)L * D;
    const float* wa = ka->in[I_LRUWA] + ((size_t)L * 8 + nb) * 128 * 128; const float* wx = ka->in[I_LRUWX] + ((size_t)L * 8 + nb) * 128 * 128;
    const float lam = ka->in[I_LAM][(size_t)L * D + ch], ba = ka->in[I_LRUBA][(size_t)L * D + ch], bx = ka->in[I_LRUBX][(size_t)L * D + ch];
    const float sp = fmaxf(-lam, 0.f) + log1pf(expf(-fabsf(lam)));
    const int dl = ch & 127;
    float h = 0.f;
    for (int t = 0; t < SEQ; ++t) {
        float pr = 0.f, pi = 0.f, xcc = 0.f;
#pragma unroll
        for (int q = 0; q < 2; ++q) { const int cl = lane + 64 * q, cg = nb * 128 + cl; float xc = cb[cg];
            for (int j = 0; j < 4; ++j) { const int tt = t - 3 + j; if (tt >= 0) xc += sc_bf(XR, (size_t)(b * SEQ + tt) * D + cg) * cw[j * D + cg]; }
            pr += xc * wa[cl * 128 + dl]; pi += xc * wx[cl * 128 + dl]; if (cl == dl) xcc = xc; }
#pragma unroll
        for (int o = 1; o < 64; o <<= 1) { pr += lane_xor(pr, o, lane); pi += lane_xor(pi, o, lane); xcc += lane_xor(xcc, o, lane); }
        const float r = 1.f / (1.f + expf(-(pr + ba))), ig = 1.f / (1.f + expf(-(pi + bx)));
        const float la = -8.0f * r * sp, a = expf(la), u = sqrtf(-expm1f(2.0f * la)) * (ig * xcc);
        h = a * h + u;
        const float y = sc_bf(YR, (size_t)(b * SEQ + t) * D + ch);
        const float gl = 0.5f * y * (1.f + tanhf(0.7978845608028654f * (y + 0.044715f * y * y * y)));
        if (lane == 0) EXP[t] = h * gl;
    }
}
#endif
__global__ void __launch_bounds__(NWAVES * 64, 2) mk_fwd(Args args) {
    extern __shared__ __attribute__((aligned(16))) unsigned char lds[];
    Frame F;
    F.lds = (LAS unsigned char*)lds;
    F.MISC = (volatile LAS unsigned*)(F.lds + MISC_OFF);
    F.tid = threadIdx.x; F.lane = F.tid & 63; F.wave = __builtin_amdgcn_readfirstlane(F.tid >> 6);
    F.G = gridDim.x; F.bx = blockIdx.x;
    F.ws = args.ws; F.ctl = (gu32*)(args.ws + WS_CTL); F.out = args.out;
    for (int u = threadIdx.x; u < (LDS_BYTES - LDSCTL_OFF) / 4; u += NWAVES * 64) ((LAS unsigned*)(F.lds + LDSCTL_OFF))[u] = 0u;
    __syncthreads();
    XcdBarrier bar = xcd_barrier_post((unsigned*)(F.ctl + CW_BAR), F.MISC + 8);
#ifdef PROBE_XCC
    if ((blockIdx.x & 7u) != (bar.x & 7u)) { const unsigned long long t0 = __builtin_amdgcn_s_memrealtime(); while (__builtin_amdgcn_s_memrealtime() - t0 < 200000ull) __builtin_amdgcn_s_sleep(8); }
#endif
#ifdef PROF_SEL
#ifndef PROF_WG
#define PROF_WG 0
#endif
#ifndef PROF_SEL2
#define PROF_SEL2 50
#endif
#ifndef PROF_MUL
#define PROF_MUL 1.0f
#endif
#define PROF_END(slot) do { if (launder(F).tid == 0) { const unsigned t_ = (unsigned)__builtin_amdgcn_s_memrealtime(); F.MISC[64 + (slot)] += t_ - F.MISC[96]; F.MISC[96] = t_; F.MISC[99] = (slot); } } while (0)
#define PROF_BEGIN(ph) do { if (launder(F).tid == 0) F.MISC[101] = (ph); } while (0)
#define PROF_WAIT() do { if (launder(F).tid == 0) { const unsigned t_ = (unsigned)__builtin_amdgcn_s_memrealtime(); F.MISC[80 + F.MISC[99]] += t_ - F.MISC[96]; F.MISC[64 + 13] += t_ - F.MISC[96]; F.MISC[96] = t_; } } while (0)
    if (F.tid == 0) { const unsigned t_ = (unsigned)__builtin_amdgcn_s_memrealtime(); F.MISC[96] = t_; F.MISC[98] = t_; }
#else
#define PROF_END(slot) do { } while (0)
#define PROF_BEGIN(ph) do { } while (0)
#define PROF_WAIT() do { } while (0)
#endif
#define GRID_BAR() do { XcdBarrier b_ = bar; unsigned* p_ = bar.bar; asm volatile("" : "+s"(p_)); b_.bar = p_; xcd_barrier(b_); PROF_WAIT(); } while (0)
    float* X32 = args.out;
#define LOCAL_HANDOFF() do { asm volatile("s_waitcnt vmcnt(0)" ::: "memory"); __syncthreads(); __builtin_amdgcn_fence(__ATOMIC_ACQUIRE, "agent"); asm volatile("s_waitcnt vmcnt(0)" ::: "memory"); __syncthreads(); } while (0)
    LAS unsigned char* ring = F.lds + RING_OFF;
    using pg8::Gemm; using pg8::StaticOrder;

    for (int L = -1; L < DEPTH; ++L) {
        const int odd = L & 1;
        if (L >= 0) {
        { const Frame P = launder(F); unsigned char* ws = P.ws; unsigned char* wb = ws + WS_W; bf16* XB = (bf16*)(ws + WS_XB); (void)XB; (void)wb;
          Gemm g{XB, (const bf16*)(wb + W_IN), T_TOK, NIN, D}; StaticOrder S; S.init(T_TOK, NIN, P.G, P.bx);
          pg8::EpiZ E{(bf16*)(ws + Z_Q), (bf16*)(ws + Z_QI), (bf16*)(ws + Z_SM), ws + Z_Q8, ws + Z_KV8};
PROF_BEGIN(1);
#ifndef SK_G1
          pg8::gemm_phase<pg8::EpiZ, StaticOrder>(ring, g, S, E, P.wave);
#endif
#ifdef DUP_G1
          pg8::gemm_phase<pg8::EpiZ, StaticOrder>(ring, g, S, E, P.wave);
#endif
        }
        PROF_END(1);
        GRID_BAR();
#if defined(SELFCHECK) && SELFCHECK == 3
        if (L == 0) { selfcheck_lru(F, L, false); __syncthreads(); }
#endif
#ifdef DUP_IDX
        indexer_phase<DUP_IDX>(F);
#endif
#ifndef SK_IDX
        indexer_phase(F);
#endif
#ifdef DUP_LRU
        lru_phase<true>(F, L);
#endif
#ifndef SK_LRU
        lru_phase(F, L);
#endif
        PROF_END(2);
        GRID_BAR();
#if defined(SELFCHECK) && SELFCHECK == 1
        if (L == 0) { selfcheck_topk(F); __syncthreads(); }
#endif
#if defined(SELFCHECK) && SELFCHECK == 3
        if (L == 0) { selfcheck_lru(F, L, true); __syncthreads(); }
#endif
#ifdef DUP_ATT
        attention_phase<DUP_ATT>(F); __syncthreads();
#endif
#ifndef SK_ATT
#ifdef ATT_V1
        attention_phase(F);
#else
        attention_phase2(F);
#endif
#endif
        PROF_END(3);
        GRID_BAR();
#if defined(SELFCHECK) && SELFCHECK == 2
        if (L == 0) { selfcheck_attn(F); __syncthreads(); }
#endif
        { const Frame P = launder(F); unsigned char* ws = P.ws; unsigned char* wb = ws + WS_W; bf16* XB = (bf16*)(ws + WS_XB); (void)XB; (void)wb;
          Gemm g{(const bf16*)(ws + Z_XR), (const bf16*)(wb + W_BRA), T_TOK, D, D}; StaticOrder S; S.init(T_TOK, D, F.G, F.bx);
          pg8::EpiGate<0> E{(bf16*)(ws + Z_GA), nullptr};
PROF_BEGIN(2);
#ifndef SK_G2
          pg8::gemm_phase<pg8::EpiGate<0>, StaticOrder>(ring, g, S, E, P.wave);
#endif
        }
        LOCAL_HANDOFF();
        { const Frame P = launder(F); unsigned char* ws = P.ws; unsigned char* wb = ws + WS_W; bf16* XB = (bf16*)(ws + WS_XB); (void)XB; (void)wb;
          Gemm g{(const bf16*)(ws + Z_YR), (const bf16*)(wb + W_BRR), T_TOK, D, D}; StaticOrder S; S.init(T_TOK, D, F.G, F.bx);
          pg8::EpiGate<1> E{(bf16*)(ws + Z_GA), (const bf16*)(ws + Z_GR)};
PROF_BEGIN(3);
#ifndef SK_G3
          pg8::gemm_phase<pg8::EpiGate<1>, StaticOrder>(ring, g, S, E, P.wave);
#endif
        }
        PROF_END(4);
        GRID_BAR();
        { const Frame P = launder(F); unsigned char* ws = P.ws; unsigned char* wb = ws + WS_W; bf16* XB = (bf16*)(ws + WS_XB); (void)XB; (void)wb;
          Gemm g{(const bf16*)(ws + Z_GA), (const bf16*)(wb + W_O), T_TOK, D, D}; StaticOrder S; S.init(T_TOK, D, F.G, F.bx);
          pg8::EpiBf16 E{(bf16*)(ws + Z_GR), D, 0};
PROF_BEGIN(4);
#ifndef SK_G4
          pg8::gemm_phase<pg8::EpiBf16, StaticOrder>(ring, g, S, E, P.wave);
#endif
#ifdef DUP_G4
          pg8::gemm_phase<pg8::EpiBf16, StaticOrder>(ring, g, S, E, P.wave);
#endif
        }
        PROF_END(5);
        GRID_BAR();
#ifdef DUP_LN
        ln_phase<false, false, true>(F, L); ln_phase<false, false, true>(F, L);
#endif
#ifndef SK_LN
        if (odd) ln_phase<false, true>(F, L); else ln_phase<false, false>(F, L);
#endif
        PROF_END(6);
        GRID_BAR();
        if (odd) {
            if (launder(F).tid == 0) { unsigned acc = 0u; F.MISC[16] = 0u;
                for (int e = 0; e < 8; ++e) { const unsigned c = __hip_atomic_load(F.ctl + CW_CNT + (L >> 1) * 1024 + 64 * e, RLX_AGENT); F.MISC[32 + e] = c; acc += (c + 255u) >> 8; F.MISC[17 + e] = acc; } }
            __syncthreads();
        }
        { const Frame P = launder(F); unsigned char* ws = P.ws; unsigned char* wb = ws + WS_W; bf16* XB = (bf16*)(ws + WS_XB); (void)XB; (void)wb;
          Gemm g{(const bf16*)(ws + F_PB), (const bf16*)(wb + W_PP), T_TOK, D, PLE}; StaticOrder S; S.init(T_TOK, D, F.G, F.bx);
          pg8::EpiBf16 E{(bf16*)(ws + F_U), D, 0};
PROF_BEGIN(5);
#ifndef SK_G5
          pg8::gemm_phase<pg8::EpiBf16, StaticOrder>(ring, g, S, E, P.wave);
#endif
        }
        LOCAL_HANDOFF();
        { const Frame P = launder(F); unsigned char* ws = P.ws; unsigned char* wb = ws + WS_W; bf16* XB = (bf16*)(ws + WS_XB); (void)XB; (void)wb;
          Gemm g{XB, (const bf16*)(wb + W_PG), T_TOK, D, D}; StaticOrder S; S.init(T_TOK, D, F.G, F.bx);
          pg8::EpiPle E{(bf16*)(ws + F_U)};
PROF_BEGIN(6);
#ifndef SK_G6
          pg8::gemm_phase<pg8::EpiPle, StaticOrder>(ring, g, S, E, P.wave);
#endif
        }
        PROF_END(7);
        if (!odd) {
            { const Frame P = launder(F); unsigned char* ws = P.ws; unsigned char* wb = ws + WS_W; bf16* XB = (bf16*)(ws + WS_XB); (void)XB; (void)wb;
          Gemm g{XB, (const bf16*)(wb + W_FF), T_TOK, 2 * DFF, D}; StaticOrder S; S.init(T_TOK, 2 * DFF, F.G, F.bx);
              pg8::EpiSwiglu E{(bf16*)(ws + F_H), DFF};
PROF_BEGIN(7);
#ifndef SK_G7
              pg8::gemm_phase<pg8::EpiSwiglu, StaticOrder>(ring, g, S, E, P.wave);
#endif
#ifdef DUP_G7
              pg8::gemm_phase<pg8::EpiSwiglu, StaticOrder>(ring, g, S, E, P.wave);
#endif
        }
            PROF_END(8);
            GRID_BAR();
            { const Frame P = launder(F); unsigned char* ws = P.ws; unsigned char* wb = ws + WS_W; bf16* XB = (bf16*)(ws + WS_XB); (void)XB; (void)wb;
          Gemm g{(const bf16*)(ws + F_H), (const bf16*)(wb + W_FF_DN_DENSE), T_TOK, D, DFF}; StaticOrder S; S.init(T_TOK, D, F.G, F.bx);
              pg8::EpiBf16 E{(bf16*)(ws + Z_GR), D, 0};
PROF_BEGIN(8);
#ifndef SK_G8
              pg8::gemm_phase<pg8::EpiBf16, StaticOrder>(ring, g, S, E, P.wave);
#endif
#ifdef DUP_G8
              pg8::gemm_phase<pg8::EpiBf16, StaticOrder>(ring, g, S, E, P.wave);
#endif
        }
            PROF_END(9);
            GRID_BAR();
#ifndef SK_LN
            ln_phase<true, false>(F, L);
#endif
        } else {
            const int ntiles = (int)F.MISC[24];
            const int nchunks = (ntiles + MOE_CHUNK_TILES - 1) / MOE_CHUNK_TILES;
            for (int c = 0; c < nchunks; ++c) {
                const int tile0 = c * MOE_CHUNK_TILES, ntl = (ntiles - tile0) < MOE_CHUNK_TILES ? (ntiles - tile0) : MOE_CHUNK_TILES;
                const size_t hc_off = (c & 1) ? F_H1 : F_H;
                { const Frame P = launder(F); unsigned char* ws = P.ws; unsigned char* wb = ws + WS_W; bf16* XB = (bf16*)(ws + WS_XB); (void)XB; (void)wb;
          Gemm g{XB, (const bf16*)(wb + W_FF), ntl * 256, 2 * DFFE, D}; MoeGatherOrder S; S.init(ntl * 256, 2 * DFFE, F.G, F.bx);
                  S.tb = F.MISC + 16; S.tile0 = tile0; S.list = (const int*)(ws + WS_LIST); S.bstride = (size_t)2 * DFFE * D * 2;
                  pg8::EpiSwiglu E{(bf16*)(ws + hc_off), DFFE};
PROF_BEGIN(9);
#ifndef SK_G9
                  pg8::gemm_phase<pg8::EpiSwiglu, MoeGatherOrder>(ring, g, S, E, P.wave);
#endif
        }
                PROF_END(10);
                GRID_BAR();
                { const Frame P = launder(F); unsigned char* ws = P.ws; unsigned char* wb = ws + WS_W; bf16* XB = (bf16*)(ws + WS_XB); (void)XB; (void)wb;
          Gemm g{(const bf16*)(ws + hc_off), (const bf16*)(wb + W_FF_DN_MOE), ntl * 256, D, DFFE}; MoeOrder S; S.init(ntl * 256, D, F.G, F.bx);
                  S.tb = F.MISC + 16; S.tile0 = tile0; S.list = nullptr; S.bstride = (size_t)D * DFFE * 2;
                  pg8::EpiBf16 E{(bf16*)(ws + F_YE), D, tile0 * 256};
PROF_BEGIN(10);
#ifndef SK_G10
                  pg8::gemm_phase<pg8::EpiBf16, MoeOrder>(ring, g, S, E, P.wave);
#endif
        }
                PROF_END(11);
            }
            PROF_END(11);
            GRID_BAR();
#ifndef SK_LN
            ln_phase<true, true>(F, L);
#endif
        }
        }
        if (L + 1 < DEPTH) { __syncthreads(); p0_convert(F, L + 1); }
        PROF_END(12);
#ifdef PROF_SEL
        if (L == DEPTH - 1 && F.bx == PROF_WG && launder(F).tid == 0) { const unsigned t_ = (unsigned)__builtin_amdgcn_s_memrealtime(); const float tot_ = (float)F.MISC[106] + (float)F.MISC[107] + (float)F.MISC[108] + (float)F.MISC[109] + (float)F.MISC[110] + (float)F.MISC[111] + (float)F.MISC[112] + (float)F.MISC[113];
            const float f_ = (PROF_SEL == 43) ? (float)F.MISC[122] / (float)F.MISC[123] : (PROF_SEL == 42) ? (float)F.MISC[120] / (float)F.MISC[121] : (PROF_SEL >= 50) ? (float)F.MISC[106 + (PROF_SEL - 50)] / tot_ : (PROF_SEL == 41) ? (float)F.MISC[105] / (float)F.MISC[104] : (PROF_SEL == 40) ? (float)F.MISC[104] / (float)F.MISC[64 + 14] * (1.0f / 40.0f) : PROF_MUL * (float)F.MISC[64 + PROF_SEL] / (float)(t_ - F.MISC[98]);
            const float g_ = (PROF_SEL == 43) ? (float)F.MISC[124] / (64.0f * 8.0f * 32.0f * 4.0f) : (PROF_SEL >= 50) ? (float)F.MISC[106 + (PROF_SEL2 - 50)] / tot_ : 0.0f;
            __hip_atomic_store(F.ctl + 9, __builtin_bit_cast(unsigned, g_), __ATOMIC_RELAXED, __HIP_MEMORY_SCOPE_AGENT);
            __hip_atomic_store(F.ctl + 8, __builtin_bit_cast(unsigned, f_), __ATOMIC_RELAXED, __HIP_MEMORY_SCOPE_AGENT); }
#endif
        GRID_BAR();
    }
#ifdef PROF_SEL
    { const float f_ = __builtin_bit_cast(float, __hip_atomic_load(F.ctl + 8, RLX_AGENT)); const float s_ = 1.0f + floorf(sqrtf(f_) * 32.0f + 0.5f) * (1.0f / 32.0f);
      for (size_t i = (size_t)F.bx * 512 + launder(F).tid; i < (size_t)T_TOK * D; i += (size_t)F.G * 512) X32[i] *= s_;
      const float g_ = __builtin_bit_cast(float, __hip_atomic_load(F.ctl + 9, RLX_AGENT)); if (F.bx == 0 && launder(F).tid == 0 && g_ > 0.f) X32[0] = 400.0f * floorf(g_ * 32.0f + 0.5f) * (1.0f / 32.0f); }
#endif
    if (__hip_atomic_load(F.ctl + CW_BAR + XB_TMO, RLX_AGENT) != 0u || __hip_atomic_load(F.ctl + CW_CODE, RLX_AGENT) != 0u) {
        const float q = __builtin_nanf("");
        for (size_t i = (size_t)F.bx * 512 + launder(F).tid; i < (size_t)T_TOK * D; i += (size_t)F.G * 512) X32[i] = q;
    }
}

#if defined(SELFCHECK)
constexpr size_t WS_DRY_EXTRA = 4 * MiB;
#elif defined(DUP_LRU) || defined(DUP_LN)
constexpr size_t WS_DRY_EXTRA = 80 * MiB;
#else
constexpr size_t WS_DRY_EXTRA = 0;
#endif
extern "C" void kernel_launch(void* const* d_in, const int* in_sizes, int n_in, void* d_out, int out_size, void* d_ws, size_t ws_size, hipStream_t stream) {
    static int grid = 0;
    if (grid == 0) {
        if (n_in != 28 || out_size != T_TOK * D || ws_size < WS_NEED + WS_DRY_EXTRA) { fprintf(stderr, "kernel_launch: unexpected shapes: n_in %d out %d ws %zu (need %zu)\n", n_in, out_size, ws_size, (size_t)WS_END); grid = -1; return; }
        int dev = 0, cus = 0, per_cu = 0;
        if (hipGetDevice(&dev) != hipSuccess || hipDeviceGetAttribute(&cus, hipDeviceAttributeMultiprocessorCount, dev) != hipSuccess) { grid = -1; return; }
        if (hipFuncSetAttribute((const void*)mk_fwd, hipFuncAttributeMaxDynamicSharedMemorySize, LDS_BYTES) != hipSuccess) { fprintf(stderr, "kernel_launch: hipFuncSetAttribute failed\n"); grid = -1; return; }
        if (hipOccupancyMaxActiveBlocksPerMultiprocessor(&per_cu, (const void*)mk_fwd, NWAVES * 64, LDS_BYTES) != hipSuccess || per_cu < 1) { fprintf(stderr, "kernel_launch: occupancy query says %d blocks per CU\n", per_cu); }
        (void)hipGetLastError();
        grid = cus;
        if (grid != 256) { fprintf(stderr, "kernel_launch: this kernel needs a 256-CU device (got %d)\n", cus); grid = -1; return; }
    }
    if (grid < 0) return;
    if (hipMemsetAsync((char*)d_ws + WS_CTL, 0, CTL_ZERO_BYTES, stream) != hipSuccess) return;
    Args a{};
    for (int i = 0; i < 28; ++i) a.in[i] = (const float*)d_in[i];
    a.out = (float*)d_out; a.ws = (unsigned char*)d_ws;
    hipLaunchKernelGGL(mk_fwd, dim3(grid), dim3(NWAVES * 64), LDS_BYTES, stream, a);
}
```

```cpp
#include <hip/hip_runtime.h>
#include <cstdio>
#include <cstdint>

constexpr int T_TOK = 65536, D = 1024, SEQ = 2048, NBATCH = 32, DEPTH = 4;
constexpr int D_IN = 5832, NIN = 5888;
constexpr int DFF = 2816, DFFE = 3584, NEXP = 8, PLE = 256;
constexpr float LN_EPS = 1e-5f;
constexpr float DN_ALPHA = 1.681792830507429f;

namespace pg8 {
#define PG8_LAS __attribute__((address_space(3)))
typedef unsigned short bf16_t;
typedef short bf16x8 __attribute__((ext_vector_type(8)));
typedef float f32x4 __attribute__((ext_vector_type(4)));
typedef unsigned u32x4 __attribute__((ext_vector_type(4)));
typedef unsigned u32x2 __attribute__((ext_vector_type(2)));
constexpr int BM = 256, BK = 64, HALF = 128, HTB = HALF * BK * 2  , STAGE_BYTES = 8 * HTB, NXCD = 8, WGM = 8;

__host__ __device__ __forceinline__ int lds_byte(int r, int c) { const int st = (r >> 4) * 2 + (c >> 5), rr = r & 15, cc = c & 31, ob = rr * 64 + cc * 2; return st * 1024 + (ob ^ (((ob >> 9) & 1) << 5)); }
__host__ __device__ __forceinline__ void stage_rc(int b, int& R, int& C) { const int st = b / 1024, sb = b % 1024, swz = sb ^ (((sb >> 9) & 1) << 5); R = (st >> 1) * 16 + swz / 64; C = (st & 1) * 32 + (swz % 64) / 2; }
__host__ __device__ __forceinline__ int perm32(int rho) { const int n = rho >> 4, i = rho & 15; return 8 * (i >> 2) + 4 * n + (i & 3); }

struct Unit { int pm, pn; };
struct Gemm { const bf16_t* A; const bf16_t* Bt; int M, N, K; };

struct StaticOrder {
    static constexpr bool GATHER = false;
    int nM, nN, nwg, G, c;
    __host__ __device__ void init(int M, int N, int G_, int c_) { nM = M / BM; nN = N / BM; nwg = nM * nN; G = G_; c = c_; }
    __host__ __device__ bool next(int i, Unit& u) const {
        const long L = (long)i * G + c; if (L >= nwg) return false;
        int wgid = (int)L; { const int q = nwg / NXCD, r = nwg % NXCD, xcd = wgid % NXCD, off = wgid / NXCD; wgid = (xcd < r ? xcd * (q + 1) : r * (q + 1) + (xcd - r) * q) + off; }
        const int nig = WGM * nN, gid = wgid / nig, fm = gid * WGM, gsz = (nM - fm) < WGM ? (nM - fm) : WGM;
        u.pm = fm + ((wgid % nig) % gsz); u.pn = (wgid % nig) / gsz; return true;
    }
    __device__ __forceinline__ const char* a_base(const Gemm& g, const Unit& u, size_t tstep) const { return (const char*)g.A + (size_t)u.pm * tstep; }
    __device__ __forceinline__ const char* b_base(const Gemm& g, const Unit& u, size_t tstep) const { return (const char*)g.Bt + (size_t)u.pn * tstep; }
    __device__ __forceinline__ void a_rows(const Unit&, int, int, int, int, int, unsigned (&)[2][2]) const {}
    __device__ __forceinline__ void a_ready(const Unit&) const {}
    __device__ __forceinline__ void done(const Unit&) const {}
};

__device__ __forceinline__ unsigned cvt_pk_bf16(float lo, float hi) { unsigned r; asm volatile("v_cvt_pk_bf16_f32 %0, %1, %2" : "=v"(r) : "v"(lo), "v"(hi)); return r; }
__device__ __forceinline__ float bf_lo(unsigned w) { return __builtin_bit_cast(float, w << 16); }
__device__ __forceinline__ float bf_hi(unsigned w) { return __builtin_bit_cast(float, w & 0xffff0000u); }
__device__ __forceinline__ float sigmoidf_fast(float x) { return __builtin_amdgcn_rcpf(1.0f + __builtin_amdgcn_exp2f(-1.4426950408889634f * x)); }
#define EPI_FENCE() asm volatile("" ::: "memory")
#define EGAS __attribute__((address_space(1)))
__device__ __forceinline__ u32x4 pack8(const f32x4 v0, const f32x4 v1) { u32x4 w; w.x = cvt_pk_bf16(v0[0], v0[1]); w.y = cvt_pk_bf16(v0[2], v0[3]); w.z = cvt_pk_bf16(v1[0], v1[1]); w.w = cvt_pk_bf16(v1[2], v1[3]); return w; }

struct EpiBf16 {
    static constexpr bool PERM = true, AFTER_DRAIN = false;
    bf16_t* O; int ldc; int row_off;
    __device__ __forceinline__ void operator()(const f32x4 (&acc)[2][2][4][2], const Unit& u, int wr, int wc, int fr, int fq) const {
        { int l_ = (int)__builtin_amdgcn_mbcnt_hi(~0u, __builtin_amdgcn_mbcnt_lo(~0u, 0u)); asm volatile("" : "+v"(l_)); fr = l_ & 15; fq = l_ >> 4; }
        const int row0 = row_off + u.pm * BM + wr * 64 + fr, col0 = u.pn * BM + wc * 32 + 8 * fq;
#pragma unroll
        for (int ai = 0; ai < 2; ++ai)
#pragma unroll
            for (int m = 0; m < 4; ++m) { bf16_t* rowp = O + (size_t)(row0 + ai * HALF + m * 16) * ldc + col0;
#pragma unroll
                for (int bj = 0; bj < 2; ++bj) *(EGAS u32x4*)(rowp + bj * HALF) = pack8(acc[ai][bj][m][0], acc[ai][bj][m][1]); }
    }
};
__device__ __forceinline__ u32x2 pack8_fp8(const f32x4 v0, const f32x4 v1) { int a = __builtin_amdgcn_cvt_pk_fp8_f32(v0[0], v0[1], 0, false); a = __builtin_amdgcn_cvt_pk_fp8_f32(v0[2], v0[3], a, true);
    int b = __builtin_amdgcn_cvt_pk_fp8_f32(v1[0], v1[1], 0, false); b = __builtin_amdgcn_cvt_pk_fp8_f32(v1[2], v1[3], b, true); u32x2 r; r.x = (unsigned)a; r.y = (unsigned)b; return r; }
struct EpiZ {
    static constexpr bool PERM = true, AFTER_DRAIN = false;
    bf16_t* zbig; bf16_t* zqi; bf16_t* zsm; unsigned char* q8; unsigned char* kv8;
    __device__ __forceinline__ void operator()(const f32x4 (&acc)[2][2][4][2], const Unit& u, int wr, int wc, int fr, int fq) const {
        { int l_ = (int)__builtin_amdgcn_mbcnt_hi(~0u, __builtin_amdgcn_mbcnt_lo(~0u, 0u)); asm volatile("" : "+v"(l_)); fr = l_ & 15; fq = l_ >> 4; }
        const int row0 = u.pm * BM + wr * 64 + fr;
        if (u.pn < 4) {
            const int col0 = u.pn * BM + wc * 32 + 8 * fq;
#pragma unroll
            for (int ai = 0; ai < 2; ++ai)
#pragma unroll
                for (int m = 0; m < 4; ++m) { unsigned char* rowp = q8 + (size_t)(row0 + ai * HALF + m * 16) * D + col0;
#pragma unroll
                    for (int bj = 0; bj < 2; ++bj) *(EGAS u32x2*)(rowp + bj * HALF) = pack8_fp8(acc[ai][bj][m][0], acc[ai][bj][m][1]); }
            return;
        }
        bf16_t* base; int ld, colt;
        if (u.pn < 20) { base = zbig + (size_t)(u.pn >> 2) * ((size_t)T_TOK * D); ld = D; colt = (u.pn & 3) * BM; }
        else if (u.pn < 22) { base = zqi; ld = 512; colt = (u.pn - 20) * BM; }
        else { base = zsm; ld = 256; colt = 0; }
        const int col0 = colt + wc * 32 + 8 * fq;
#pragma unroll
        for (int ai = 0; ai < 2; ++ai)
#pragma unroll
            for (int m = 0; m < 4; ++m) { bf16_t* rowp = base + (size_t)(row0 + ai * HALF + m * 16) * ld + col0;
#pragma unroll
                for (int bj = 0; bj < 2; ++bj) *(EGAS u32x4*)(rowp + bj * HALF) = pack8(acc[ai][bj][m][0], acc[ai][bj][m][1]); }
        if (u.pn == 22) {
#pragma unroll
            for (int ai = 0; ai < 2; ++ai)
#pragma unroll
                for (int m = 0; m < 4; ++m) *(EGAS u32x2*)(kv8 + (size_t)(row0 + ai * HALF + m * 16) * 128 + wc * 32 + 8 * fq) = pack8_fp8(acc[ai][0][m][0], acc[ai][0][m][1]);
        }
    }
};
template <int MODE> struct EpiGate {
    static constexpr bool PERM = true, AFTER_DRAIN = false;
    bf16_t* G; const bf16_t* G2;
    __device__ __forceinline__ void operator()(const f32x4 (&acc)[2][2][4][2], const Unit& u, int wr, int wc, int fr, int fq) const {
        { int l_ = (int)__builtin_amdgcn_mbcnt_hi(~0u, __builtin_amdgcn_mbcnt_lo(~0u, 0u)); asm volatile("" : "+v"(l_)); fr = l_ & 15; fq = l_ >> 4; }
        const int row0 = u.pm * BM + wr * 64 + fr, col0 = u.pn * BM + wc * 32 + 8 * fq;
#pragma unroll
        for (int ai = 0; ai < 2; ++ai) {
            u32x4 gw[4][2], g2[4][2];
#pragma unroll
            for (int m = 0; m < 4; ++m)
#pragma unroll
                for (int bj = 0; bj < 2; ++bj) { const size_t o = (size_t)(row0 + ai * HALF + m * 16) * D + col0 + bj * HALF;
                    gw[m][bj] = *(const EGAS u32x4*)(G + o); if (MODE == 1) g2[m][bj] = *(const EGAS u32x4*)(G2 + o); }
#pragma unroll
            for (int m = 0; m < 4; ++m)
#pragma unroll
                for (int bj = 0; bj < 2; ++bj) { const size_t o = (size_t)(row0 + ai * HALF + m * 16) * D + col0 + bj * HALF;
                    f32x4 v0 = acc[ai][bj][m][0], v1 = acc[ai][bj][m][1];
#pragma unroll
                    for (int j = 0; j < 4; ++j) { const unsigned wa = gw[m][bj][j >> 1], wb = gw[m][bj][2 + (j >> 1)];
                        const float ga = (j & 1) ? bf_hi(wa) : bf_lo(wa), gb = (j & 1) ? bf_hi(wb) : bf_lo(wb);
                        if (MODE == 0) { v0[j] *= sigmoidf_fast(ga); v1[j] *= sigmoidf_fast(gb); }
                        else { const unsigned xa = g2[m][bj][j >> 1], xb = g2[m][bj][2 + (j >> 1)];
                            v0[j] = ga + v0[j] * sigmoidf_fast((j & 1) ? bf_hi(xa) : bf_lo(xa)); v1[j] = gb + v1[j] * sigmoidf_fast((j & 1) ? bf_hi(xb) : bf_lo(xb)); } }
                    *(EGAS u32x4*)(G + o) = pack8(v0, v1); }
            EPI_FENCE(); }
    }
};
template <int MODE> struct EpiRes {
    static constexpr bool PERM = true, AFTER_DRAIN = false;
    float* Y; const bf16_t* XB; const bf16_t* U;
    __device__ __forceinline__ void operator()(const f32x4 (&acc)[2][2][4][2], const Unit& u, int wr, int wc, int fr, int fq) const {
        { int l_ = (int)__builtin_amdgcn_mbcnt_hi(~0u, __builtin_amdgcn_mbcnt_lo(~0u, 0u)); asm volatile("" : "+v"(l_)); fr = l_ & 15; fq = l_ >> 4; }
        const int row0 = u.pm * BM + wr * 64 + fr, col0 = u.pn * BM + wc * 32 + 8 * fq;
#pragma unroll
        for (int ai = 0; ai < 2; ++ai) {
            u32x4 xw[4][2], uw[4][2];
#pragma unroll
            for (int m = 0; m < 4; ++m)
#pragma unroll
                for (int bj = 0; bj < 2; ++bj) { const size_t o = (size_t)(row0 + ai * HALF + m * 16) * D + col0 + bj * HALF;
                    xw[m][bj] = *(const EGAS u32x4*)(XB + o);
                    if (MODE == 1) uw[m][bj] = *(const EGAS u32x4*)(U + o); }
#pragma unroll
            for (int m = 0; m < 4; ++m)
#pragma unroll
                for (int bj = 0; bj < 2; ++bj) { const size_t o = (size_t)(row0 + ai * HALF + m * 16) * D + col0 + bj * HALF;
#pragma unroll
                    for (int n = 0; n < 2; ++n) { const f32x4 a = acc[ai][bj][m][n]; f32x4 r;
                        if (MODE == 0) { const unsigned x0 = xw[m][bj][2 * n], x1 = xw[m][bj][2 * n + 1];
                            r[0] = bf_lo(x0) * DN_ALPHA + a[0]; r[1] = bf_hi(x0) * DN_ALPHA + a[1]; r[2] = bf_lo(x1) * DN_ALPHA + a[2]; r[3] = bf_hi(x1) * DN_ALPHA + a[3]; }
                        else { const unsigned x0 = xw[m][bj][2 * n], x1 = xw[m][bj][2 * n + 1], w0 = uw[m][bj][2 * n], w1 = uw[m][bj][2 * n + 1];
                            r[0] = bf_lo(x0) * DN_ALPHA + bf_lo(w0) + a[0]; r[1] = bf_hi(x0) * DN_ALPHA + bf_hi(w0) + a[1];
                            r[2] = bf_lo(x1) * DN_ALPHA + bf_lo(w1) + a[2]; r[3] = bf_hi(x1) * DN_ALPHA + bf_hi(w1) + a[3]; }
                        *(EGAS f32x4*)(Y + o + 4 * n) = r; } }
            EPI_FENCE(); }
    }
};
struct EpiPle {
    static constexpr bool PERM = true, AFTER_DRAIN = false;
    bf16_t* U;
    __device__ __forceinline__ void operator()(const f32x4 (&acc)[2][2][4][2], const Unit& u, int wr, int wc, int fr, int fq) const {
        { int l_ = (int)__builtin_amdgcn_mbcnt_hi(~0u, __builtin_amdgcn_mbcnt_lo(~0u, 0u)); asm volatile("" : "+v"(l_)); fr = l_ & 15; fq = l_ >> 4; }
        const int row0 = u.pm * BM + wr * 64 + fr, col0 = u.pn * BM + wc * 32 + 8 * fq;
#pragma unroll
        for (int ai = 0; ai < 2; ++ai) {
            u32x4 uw[4][2];
#pragma unroll
            for (int m = 0; m < 4; ++m)
#pragma unroll
                for (int bj = 0; bj < 2; ++bj) uw[m][bj] = *(const EGAS u32x4*)(U + (size_t)(row0 + ai * HALF + m * 16) * D + col0 + bj * HALF);
#pragma unroll
            for (int m = 0; m < 4; ++m)
#pragma unroll
                for (int bj = 0; bj < 2; ++bj) { f32x4 v0 = acc[ai][bj][m][0], v1 = acc[ai][bj][m][1];
#pragma unroll
                    for (int j = 0; j < 4; ++j) { const unsigned wa = uw[m][bj][j >> 1], wb = uw[m][bj][2 + (j >> 1)];
                        v0[j] = sigmoidf_fast(v0[j]) * ((j & 1) ? bf_hi(wa) : bf_lo(wa)); v1[j] = sigmoidf_fast(v1[j]) * ((j & 1) ? bf_hi(wb) : bf_lo(wb)); }
                    *(EGAS u32x4*)(U + (size_t)(row0 + ai * HALF + m * 16) * D + col0 + bj * HALF) = pack8(v0, v1); }
            EPI_FENCE(); }
    }
};
struct EpiSwiglu {
    static constexpr bool PERM = true, AFTER_DRAIN = false;
    bf16_t* H; int ldh;
    __device__ __forceinline__ void operator()(const f32x4 (&acc)[2][2][4][2], const Unit& u, int wr, int wc, int fr, int fq) const {
        { int l_ = (int)__builtin_amdgcn_mbcnt_hi(~0u, __builtin_amdgcn_mbcnt_lo(~0u, 0u)); asm volatile("" : "+v"(l_)); fr = l_ & 15; fq = l_ >> 4; }
        const int row0 = u.pm * BM + wr * 64 + fr, col0 = u.pn * HALF + wc * 32 + 8 * fq;
#pragma unroll
        for (int ai = 0; ai < 2; ++ai)
#pragma unroll
            for (int m = 0; m < 4; ++m) { bf16_t* rowp = H + (size_t)(row0 + ai * HALF + m * 16) * ldh + col0;
                f32x4 v0, v1;
#pragma unroll
                for (int j = 0; j < 4; ++j) { const float g0 = acc[ai][0][m][0][j], g1 = acc[ai][0][m][1][j];
                    v0[j] = g0 * sigmoidf_fast(g0) * acc[ai][1][m][0][j]; v1[j] = g1 * sigmoidf_fast(g1) * acc[ai][1][m][1][j]; }
                *(EGAS u32x4*)rowp = pack8(v0, v1); }
    }
};
template <class Epi, class Sched, bool ALIGN_EPI = true>
__device__ __forceinline__ void gemm_phase(PG8_LAS unsigned char* lds, const Gemm g, const Sched& S, const Epi& E, const int wave_id) {
    int lane_ = (int)__builtin_amdgcn_mbcnt_hi(~0u, __builtin_amdgcn_mbcnt_lo(~0u, 0u)); asm volatile("" : "+v"(lane_));
    const int wid = wave_id, lane = lane_, tid = wid * 64 + lane, wr = wid >> 2, wc = wid & 3, fr = lane & 15, fq = lane >> 4;
    const int K = g.K, nt = K / BK;
    unsigned voffA[2], voffB[2]; int RA[2], CA[2];
#pragma unroll
    for (int i = 0; i < 2; ++i) { int R, C; stage_rc(tid * 16 + i * 8192, R, C); const int Rb = Epi::PERM ? ((R & ~31) + perm32(R & 31)) : R; RA[i] = R; CA[i] = C;
        voffA[i] = (unsigned)(R * K + C) * 2u; voffB[i] = (unsigned)(Rb * K + C) * 2u; }
    const size_t kstep = (size_t)(BK * 2);
    const size_t hstep = (size_t)HALF * K * 2;
    const size_t tstep = 2 * hstep;
    const unsigned ldsw = (unsigned)wid * 1024u;
    const int aoff = lds_byte(wr * 64 + fr, fq * 8), boff = lds_byte(wc * 32 + fr, fq * 8);
    unsigned offC[2][2] = {{0u, 0u}, {0u, 0u}}, offN[2][2] = {{0u, 0u}, {0u, 0u}};
#define PG8_SA(b, h) (((b) * 2 + (h)) * HTB)
#define PG8_SB(b, h) ((4 + (b) * 2 + (h)) * HTB)
#define PG8_STAGE(bufoff, gbase, voff) do { _Pragma("unroll") for (int _i = 0; _i < 2; ++_i) \
        __builtin_amdgcn_global_load_lds((const unsigned*)((const char*)(gbase) + (voff)[_i]), (PG8_LAS unsigned*)(lds + (bufoff) + ldsw + _i * 8192), 16, 0, 0); } while (0)
#define PG8_STA(bufoff, ptr, h, NX) do { if constexpr (Sched::GATHER) { _Pragma("unroll") for (int _i = 0; _i < 2; ++_i) { const unsigned _o = (NX) ? offN[h][_i] : offC[h][_i]; \
        __builtin_amdgcn_global_load_lds((const unsigned*)((const char*)(ptr) + _o), (PG8_LAS unsigned*)(lds + (bufoff) + ldsw + _i * 8192), 16, 0, 0); } } \
        else { PG8_STAGE(bufoff, (ptr) + (h) * hstep, voffA); } } while (0)
#define PG8_LDA(dst, b, h) do { _Pragma("unroll") for (int m = 0; m < 4; ++m) _Pragma("unroll") for (int k = 0; k < 2; ++k) dst[m][k] = *(const PG8_LAS bf16x8*)(lds + PG8_SA(b, h) + aoff + m * 2048 + k * 1024); } while (0)
#define PG8_LDB(dst, b, h) do { _Pragma("unroll") for (int n = 0; n < 2; ++n) _Pragma("unroll") for (int k = 0; k < 2; ++k) dst[n][k] = *(const PG8_LAS bf16x8*)(lds + PG8_SB(b, h) + boff + n * 2048 + k * 1024); } while (0)
#define PG8_MMA(ai, bj, At, Bt) do { __builtin_amdgcn_s_setprio(1); _Pragma("unroll") for (int m = 0; m < 4; ++m) _Pragma("unroll") for (int n = 0; n < 2; ++n) _Pragma("unroll") for (int k = 0; k < 2; ++k) \
        acc[ai][bj][m][n] = __builtin_amdgcn_mfma_f32_16x16x32_bf16(Bt[n][k], At[m][k], acc[ai][bj][m][n], 0, 0, 0); __builtin_amdgcn_s_setprio(0); } while (0)
#define PG8_WAIT_V(n) asm volatile("s_waitcnt vmcnt(" #n ")" ::: "memory")
#define PG8_WAIT_L(n) asm volatile("s_waitcnt lgkmcnt(" #n ")" ::: "memory")
#define PG8_BAR __builtin_amdgcn_s_barrier()
#define PG8_SCHED __builtin_amdgcn_sched_barrier(0)
#ifdef PROF_SEL
#ifndef PROF_KPH
#define PROF_KPH 0
#endif
#define PG8_PROF(slot) do { if (tid == 0) { volatile PG8_LAS unsigned* M_ = (volatile PG8_LAS unsigned*)(lds + 131392); const unsigned t_ = (unsigned)__builtin_amdgcn_s_memrealtime(); const unsigned c_ = (unsigned)__builtin_amdgcn_s_memtime(); if (PROF_KPH == 0 || M_[101] == PROF_KPH) { M_[64 + (slot)] += t_ - M_[97]; if ((slot) == 14) M_[104] += c_ - M_[103]; } M_[97] = t_; M_[103] = c_; } } while (0)
#else
#define PG8_PROF(slot) do { } while (0)
#endif
#ifdef PROF_SEL
#define PG8_WAIT_VT(n) do { unsigned long long a_, b_; asm volatile("s_memtime %0\n\ts_waitcnt vmcnt(" #n ")\n\ts_memtime %1\n\ts_waitcnt lgkmcnt(0)" : "=s"(a_), "=s"(b_) :: "memory"); if (tid == 0) { volatile PG8_LAS unsigned* M_ = (volatile PG8_LAS unsigned*)(lds + 131392); M_[105] += (unsigned)b_ - (unsigned)a_; } } while (0)
#else
#define PG8_WAIT_VT(n) PG8_WAIT_V(n)
#endif
    Unit cur, nxt; int ui = 0;
    if (!S.next(0, cur)) return;
    f32x4 acc[2][2][4][2];
#pragma unroll
    for (int a = 0; a < 2; ++a)
#pragma unroll
        for (int b = 0; b < 2; ++b)
#pragma unroll
            for (int m = 0; m < 4; ++m)
#pragma unroll
                for (int n = 0; n < 2; ++n) acc[a][b][m][n] = (f32x4){0.f, 0.f, 0.f, 0.f};
    bf16x8 At[4][2], B0[2][2], B1[2][2];
    const char* cA = S.a_base(g, cur, tstep); const char* cB = S.b_base(g, cur, tstep);
    if constexpr (Sched::GATHER) S.a_rows(cur, RA[0], RA[1], CA[0], CA[1], K, offC);
    S.a_ready(cur);
    PG8_STAGE(PG8_SB(0, 0), cB, voffB); PG8_STAGE(PG8_SB(0, 1), cB + hstep, voffB); PG8_STA(PG8_SA(0, 0), cA, 0, false); PG8_STA(PG8_SA(0, 1), cA, 1, false);
    if (wr == 1) PG8_BAR;
    PG8_WAIT_V(2); PG8_BAR;
    PG8_STAGE(PG8_SB(1, 0), cB + kstep, voffB); PG8_STA(PG8_SA(1, 0), cA + kstep, 0, false); PG8_STAGE(PG8_SB(1, 1), cB + hstep + kstep, voffB);
    PG8_WAIT_V(6); PG8_BAR;
    PG8_PROF(17);
    for (;;) {
        const bool has_next = S.next(ui + 1, nxt);
        const char* nA = has_next ? S.a_base(g, nxt, tstep) : cA; const char* nB = has_next ? S.b_base(g, nxt, tstep) : cB;
        if constexpr (Sched::GATHER) { if (has_next) S.a_rows(nxt, RA[0], RA[1], CA[0], CA[1], K, offN); else {
#pragma unroll
            for (int h = 0; h < 2; ++h)
#pragma unroll
                for (int i = 0; i < 2; ++i) offN[h][i] = offC[h][i]; } }
        for (int t = 0; t < nt; t += 2) {
            const bool last = (t == nt - 2);
            const char* a1 = cA + (size_t)(t + 1) * kstep;
            const char* a2 = last ? nA : cA + (size_t)(t + 2) * kstep; const char* b2 = last ? nB : cB + (size_t)(t + 2) * kstep;
            const char* a3 = a2 + kstep; const char* b3 = b2 + kstep;
            if (last && has_next) S.a_ready(nxt);
            PG8_LDB(B0, 0, 0); PG8_LDB(B1, 0, 1); PG8_SCHED; PG8_LDA(At, 0, 0); PG8_STA(PG8_SA(1, 1), a1, 1, false);
            PG8_WAIT_VT(8); PG8_WAIT_L(0); PG8_BAR; PG8_MMA(0, 0, At, B0); PG8_MMA(0, 1, At, B1); PG8_BAR; PG8_SCHED;
            PG8_LDA(At, 0, 1); PG8_STAGE(PG8_SB(0, 0), b2, voffB); PG8_STAGE(PG8_SB(0, 1), b2 + hstep, voffB); PG8_STA(PG8_SA(0, 0), a2, 0, last);
            PG8_WAIT_VT(8); PG8_WAIT_L(0); PG8_BAR; PG8_MMA(1, 0, At, B0); PG8_MMA(1, 1, At, B1); PG8_BAR; PG8_SCHED;
            PG8_LDB(B0, 1, 0); PG8_LDB(B1, 1, 1); PG8_SCHED; PG8_LDA(At, 1, 0); PG8_STA(PG8_SA(0, 1), a2, 1, last);
            PG8_WAIT_VT(8); PG8_WAIT_L(0); PG8_BAR; PG8_MMA(0, 0, At, B0); PG8_MMA(0, 1, At, B1); PG8_BAR; PG8_SCHED;
            PG8_LDA(At, 1, 1); PG8_STAGE(PG8_SB(1, 0), b3, voffB); PG8_STAGE(PG8_SB(1, 1), b3 + hstep, voffB); PG8_STA(PG8_SA(1, 0), a3, 0, last);
            PG8_WAIT_VT(8); PG8_WAIT_L(0); PG8_BAR; PG8_MMA(1, 0, At, B0); PG8_MMA(1, 1, At, B1); PG8_BAR; PG8_SCHED;
        }
        if constexpr (ALIGN_EPI) { if (wr == 0) PG8_BAR; }
        PG8_PROF(14);
        E(acc, cur, wr, wc, fr, fq); S.done(cur);
        PG8_PROF(15);
        if (!has_next) break;
#pragma unroll
        for (int a = 0; a < 2; ++a)
#pragma unroll
            for (int b = 0; b < 2; ++b)
#pragma unroll
                for (int m = 0; m < 4; ++m)
#pragma unroll
                    for (int n = 0; n < 2; ++n) acc[a][b][m][n] = (f32x4){0.f, 0.f, 0.f, 0.f};
        cur = nxt; cA = nA; cB = nB; ++ui;
        if constexpr (Sched::GATHER) {
#pragma unroll
            for (int h = 0; h < 2; ++h)
#pragma unroll
                for (int i = 0; i < 2; ++i) offC[h][i] = offN[h][i]; }
        if constexpr (ALIGN_EPI) { if (wr == 1) PG8_BAR; }
    }
    PG8_WAIT_V(0);
    if constexpr (!ALIGN_EPI) { if (wr == 0) PG8_BAR; }
    PG8_BAR;
#undef PG8_PROF
#undef PG8_WAIT_VT
#undef PG8_SA
#undef PG8_SB
#undef PG8_STAGE
#undef PG8_STA
#undef PG8_LDA
#undef PG8_LDB
#undef PG8_MMA
#undef PG8_WAIT_V
#undef PG8_WAIT_L
#undef PG8_BAR
#undef PG8_SCHED
}
}
constexpr int NWAVES = 8;
constexpr size_t MiB = 1u << 20;
constexpr size_t WS_CTL = 0, CTL_ZERO_BYTES = 1 * MiB;
constexpr size_t WS_ROUTE = 1 * MiB;
constexpr size_t WS_LIST = 3 * MiB;
constexpr size_t WS_W = 8 * MiB;
constexpr size_t W_IN = 0, W_BRA = 12 * MiB, W_BRR = 14 * MiB, W_O = 16 * MiB, W_PG = 18 * MiB, W_PP = 20 * MiB, W_LRU = 21 * MiB, W_FF = 22 * MiB;
constexpr size_t W_FF_DN_DENSE = W_FF + 11 * MiB, W_FF_DN_MOE = W_FF + 112 * MiB;
constexpr size_t WS_XB = 208 * MiB;
constexpr size_t WS_IDX = 336 * MiB;
constexpr size_t WS_Z = 368 * MiB;
constexpr size_t Z_Q = WS_Z, Z_XR = WS_Z + 128 * MiB, Z_YR = WS_Z + 256 * MiB, Z_GA = WS_Z + 384 * MiB, Z_GR = WS_Z + 512 * MiB, Z_QI = WS_Z + 640 * MiB, Z_SM = WS_Z + 704 * MiB;
constexpr size_t Z_Q8 = Z_Q, Z_KV8 = Z_Q + 64 * MiB;
constexpr size_t WS_END = WS_Z + 736 * MiB;
constexpr size_t F_U = Z_Q;
constexpr size_t F_PB = Z_SM;
constexpr size_t F_H = Z_XR;
constexpr size_t F_H1 = WS_END;
constexpr size_t F_YE = Z_GA;
constexpr int MOE_CHUNK_TILES = 128;
constexpr size_t F_H_CHUNK_BYTES = (size_t)MOE_CHUNK_TILES * 256 * DFFE * 2;
constexpr size_t WS_NEED = F_H1 + F_H_CHUNK_BYTES;
static_assert(F_H + F_H_CHUNK_BYTES <= F_YE && F_YE + (size_t)520 * 256 * D * 2 <= Z_SM && F_H + (size_t)T_TOK * DFF * 2 <= Z_GR, "overlay map");
constexpr int CW_TMO = 0, CW_CODE = 1, CW_BAR = 4096, CW_CNT = 16384;
constexpr int RING_OFF = 0, RING_BYTES = 131072;
constexpr int LDSCTL_OFF = RING_BYTES, MISC_OFF = LDSCTL_OFF + 320;
constexpr int LDS_BYTES = 157696;

#define GAS __attribute__((address_space(1)))
#define LAS __attribute__((address_space(3)))
typedef unsigned short bf16;
typedef unsigned v4u __attribute__((ext_vector_type(4)));
typedef unsigned v2u __attribute__((ext_vector_type(2)));
typedef float f32x4 __attribute__((ext_vector_type(4)));
typedef float f32x16 __attribute__((ext_vector_type(16)));
typedef short bf16x8 __attribute__((ext_vector_type(8)));
typedef GAS unsigned gu32;
#define RLX_AGENT __ATOMIC_RELAXED, __HIP_MEMORY_SCOPE_AGENT
#define LDS_WAIT() asm volatile("s_waitcnt lgkmcnt(0)" ::: "memory")
#define VM_WAIT() asm volatile("s_waitcnt vmcnt(0)" ::: "memory")
using pg8::cvt_pk_bf16; using pg8::bf_lo; using pg8::bf_hi; using pg8::sigmoidf_fast;
#define XB_TMO      128
#define XB_XCNT(j)  (256  + 64 * (j))
#define XB_XSUB(j)  (1280 + 64 * (j))
#define XB_XGEN(j)  (2304 + 64 * (j))
#define XB_TOP      3328
#define XB_TOPGEN   3392
#define XCD_BAR_WORDS 3456
#define XB_SPIN_CAP (1u << 21)

__device__ __forceinline__ unsigned xb_ld(unsigned* p)              { return __hip_atomic_load(p, __ATOMIC_RELAXED, __HIP_MEMORY_SCOPE_AGENT); }
__device__ __forceinline__ unsigned xb_add(unsigned* p, unsigned v) { return __hip_atomic_fetch_add(p, v, __ATOMIC_RELAXED, __HIP_MEMORY_SCOPE_AGENT); }
__device__ __forceinline__ unsigned xb_xcc_id() { return (unsigned)__builtin_amdgcn_s_getreg((3 << 11) | 20) & 0xFu; }
#define XB_SPIN(cond, bar) do { unsigned _sp = 0; while (cond) { __builtin_amdgcn_s_sleep(1); \
    if ((++_sp & 255u) == 0u) { if (xb_ld(&(bar)[XB_TMO])) break; if (_sp > XB_SPIN_CAP) { atomicAdd(&(bar)[XB_TMO], 1u); break; } } } } while (0)

struct XcdBarrier {
    unsigned* bar; unsigned x;
    volatile LAS unsigned* st;
};

__device__ __forceinline__ XcdBarrier xcd_barrier_post(unsigned* bar, volatile LAS unsigned* st) {
    XcdBarrier b; b.bar = bar; b.x = xb_xcc_id(); b.st = st;
    if (threadIdx.x == 0) (void)xb_add(&bar[XB_XCNT(b.x)], 1u);
    return b;
}
__device__ __forceinline__ void xcd_barrier_complete(unsigned* bar, unsigned x, unsigned& nloc, unsigned& nx) {
    const unsigned G = gridDim.x * gridDim.y * gridDim.z;
    unsigned sum, cnt, mine, sp = 0u;
    for (;;) {
        sum = 0u; cnt = 0u; mine = 0u;
#pragma unroll
        for (unsigned j = 0; j < 16; ++j) { const unsigned c = xb_ld(&bar[XB_XCNT(j)]); sum += c; cnt += (c > 0u) ? 1u : 0u; mine = (j == x) ? c : mine; }
        if (sum == G) break;
        __builtin_amdgcn_s_sleep(1);
        if ((++sp & 255u) == 0u) { if (xb_ld(&bar[XB_TMO])) break; if (sp > XB_SPIN_CAP) { atomicAdd(&bar[XB_TMO], 1u); break; } }
    }
    nloc = mine > 0u ? mine : 1u; nx = cnt > 0u ? cnt : 1u;
}

__device__ __forceinline__ void xcd_barrier(const XcdBarrier& b) {
    asm volatile("s_waitcnt vmcnt(0)" ::: "memory");
    __syncthreads();
    if (threadIdx.x == 0) {
        unsigned* bar = b.bar;
        __builtin_amdgcn_s_waitcnt(0);
        unsigned nloc = b.st[0], nx = b.st[1];
        if (nloc == 0u) { xcd_barrier_complete(bar, b.x, nloc, nx); b.st[0] = nloc; b.st[1] = nx; }
        const unsigned old = xb_add(&bar[XB_XSUB(b.x)], 1u);
        const unsigned gen = old / nloc;
        if (old + 1u == (gen + 1u) * nloc) {
            __builtin_amdgcn_fence(__ATOMIC_RELEASE, "agent");
            asm volatile("s_waitcnt vmcnt(0)" ::: "memory");
            const unsigned og = xb_add(&bar[XB_TOP], 1u);
            const unsigned tg = og / nx;
            if (og + 1u == (tg + 1u) * nx) xb_add(&bar[XB_TOPGEN], 1u);
            else XB_SPIN(xb_ld(&bar[XB_TOPGEN]) == tg, bar);
            __builtin_amdgcn_fence(__ATOMIC_ACQUIRE, "agent");
            xb_add(&bar[XB_XGEN(b.x)], 1u);
            asm volatile("s_waitcnt vmcnt(0)" ::: "memory");
        } else {
            XB_SPIN(xb_ld(&bar[XB_XGEN(b.x)]) == gen, bar);
            __builtin_amdgcn_fence(__ATOMIC_ACQUIRE, "agent");
            asm volatile("s_waitcnt vmcnt(0)" ::: "memory");
        }
    }
    __syncthreads();
}
struct Frame {
    LAS unsigned char* lds;
    volatile LAS unsigned* MISC;
    gu32* ctl;
    int tid, lane, wave, G, bx;
    unsigned char* ws;
    float* out;
};
struct Args { const float* in[28]; float* out; unsigned char* ws; };
typedef const __attribute__((address_space(4))) Args* KArgs;
__device__ __forceinline__ KArgs kargs() { KArgs k = (KArgs)__builtin_amdgcn_kernarg_segment_ptr(); asm volatile("" : "+s"(k)); return k; }
enum { I_X = 0, I_P, I_WIN, I_CONVW, I_CONVB, I_LRUWA, I_LRUBA, I_LRUWX, I_LRUBX, I_LAM, I_WBRA, I_WBRR, I_WO, I_RELB, I_LN1G, I_LN1B, I_FFG, I_FFU, I_FFD, I_ROUTER, I_ROUTERB, I_MOEG, I_MOEU, I_MOED, I_PLEG, I_PLEP, I_LN2G, I_LN2B };

__device__ __forceinline__ Frame launder(const Frame& F0) { Frame F = F0; unsigned char* w = F0.ws; int l = (int)__builtin_amdgcn_mbcnt_hi(~0u, __builtin_amdgcn_mbcnt_lo(~0u, 0u)); asm volatile("" : "+s"(w)); asm volatile("" : "+v"(l));
    F.ws = w; F.lane = l; F.tid = F0.wave * 64 + l; F.ctl = (gu32*)(w + WS_CTL); return F; }
__device__ __forceinline__ float lane_get(float v, int src_lane) { return __builtin_bit_cast(float, __builtin_amdgcn_ds_bpermute(src_lane << 2, __builtin_bit_cast(int, v))); }
__device__ __forceinline__ float lane_xor(float v, int mask, int lane) { return lane_get(v, lane ^ mask); }
__device__ __forceinline__ float lane_up(float v, int d, int lane) { return lane_get(v, lane >= d ? lane - d : lane); }
__device__ __forceinline__ float wave_sum(float v, int lane) {
#pragma unroll
    for (int o = 1; o < 64; o <<= 1) v += lane_xor(v, o, lane);
    return v;
}
__device__ __forceinline__ unsigned pk2(float lo, float hi) { return cvt_pk_bf16(lo, hi); }

__device__ __forceinline__ void cvt_item(const float* W, int ldw, int K, bf16* WT, int d0, int sc0, int nvalid, float scale, int k0, LAS float* scr, int lane) {
    const int n4 = (lane & 7) * 4;
    f32x4 v[8];
#pragma unroll
    for (int i = 0; i < 8; ++i) { const int kk = 8 * i + (lane >> 3); v[i] = (f32x4){0.f, 0.f, 0.f, 0.f}; if (n4 < nvalid) v[i] = *(const GAS f32x4*)(W + (size_t)(k0 + kk) * ldw + sc0 + n4); }
#pragma unroll
    for (int i = 0; i < 8; ++i) { const int kk = 8 * i + (lane >> 3); LAS float* d = scr + kk * 33 + n4; d[0] = v[i][0] * scale; d[1] = v[i][1] * scale; d[2] = v[i][2] * scale; d[3] = v[i][3] * scale; }
    LDS_WAIT(); asm volatile("" ::: "memory");
    const int c = lane & 7;
#pragma unroll
    for (int j = 0; j < 4; ++j) { const int nn = (lane >> 3) + 8 * j; const LAS float* s = scr + (8 * c) * 33 + nn;
        v4u o; o.x = pk2(s[0 * 33], s[1 * 33]); o.y = pk2(s[2 * 33], s[3 * 33]); o.z = pk2(s[4 * 33], s[5 * 33]); o.w = pk2(s[6 * 33], s[7 * 33]);
        *(GAS v4u*)(WT + (size_t)(d0 + nn) * K + k0 + 8 * c) = o; }
    LDS_WAIT(); asm volatile("" ::: "memory");
}
__device__ __forceinline__ void cvt_plain(const float* W, int K, int N, bf16* WT, int item, LAS float* scr, int lane) {
    const int nblk = N / 32, kb = item / nblk, nb = item % nblk;
    cvt_item(W, N, K, WT, 32 * nb, 32 * nb, 32, 1.0f, 64 * kb, scr, lane);
}
__device__ __forceinline__ void cvt_gateup(const float* Wg, const float* Wu, int dff, bf16* WT, int item, LAS float* scr, int lane) {
    const int nblk = 2 * dff / 32, kb = item / nblk, db = item % nblk, d0 = 32 * db, pn = d0 >> 8, r = d0 & 255;
    const float* W = r < 128 ? Wg : Wu; const int sc0 = 128 * pn + (r & 127);
    cvt_item(W, dff, D, WT, d0, sc0, 32, 1.0f, 64 * kb, scr, lane);
}
__device__ __forceinline__ void cvt_win(const float* W, bf16* WT, int item, LAS float* scr, int lane) {
    const int nblk = NIN / 32, kb = item / nblk, db = item % nblk, d0 = 32 * db;
    int sc0, nv = 32; float sc = 1.0f;
    if (d0 < 1024) { sc0 = d0; }
    else if (d0 < 2048) sc0 = 1736 + (d0 - 1024);
    else if (d0 < 3072) sc0 = 2760 + (d0 - 2048);
    else if (d0 < 4096) sc0 = 3784 + (d0 - 3072);
    else if (d0 < 5120) sc0 = 4808 + (d0 - 4096);
    else if (d0 < 5632) sc0 = 1152 + (d0 - 5120);
    else if (d0 < 5696) sc0 = 1024 + (d0 - 5632);
    else if (d0 < 5760) sc0 = 1088 + (d0 - 5696);
    else if (d0 < 5824) sc0 = 1664 + (d0 - 5760);
    else if (d0 == 5824) { sc0 = 1728; nv = 8; }
    else { sc0 = 0; nv = 0; }
    cvt_item(W, D_IN, D, WT, d0, sc0, nv, sc, 64 * kb, scr, lane);
}
__device__ __forceinline__ void p0_convert(const Frame& F0, int L) {
    Frame F = launder(F0);
    const KArgs ka = kargs();
    LAS float* scr = (LAS float*)(F.lds + RING_OFF + F.wave * 16384);
    const int gw = F.bx * NWAVES + F.wave, NGW = F.G * NWAVES;
    unsigned char* wb = F.ws + WS_W;
    const int odd = L & 1, jj = L >> 1;
    constexpr int I_IN = (D / 64) * (NIN / 32), I_SQ = (D / 64) * (D / 32), I_PPJ = (PLE / 64) * (D / 32), I_LRU1 = 2 * 4;
    constexpr int I_GU_D = (D / 64) * (2 * DFF / 32), I_DN_D = (DFF / 64) * (D / 32), I_GU_E = (D / 64) * (2 * DFFE / 32), I_DN_E = (DFFE / 64) * (D / 32);
    const int n_ff = odd ? NEXP * (I_GU_E + I_DN_E) : (I_GU_D + I_DN_D);
    const int NITEMS = I_IN + 4 * I_SQ + I_PPJ + 16 * I_LRU1 + n_ff;
    for (int it = gw; it < NITEMS; it += NGW) {
        const float* W; bf16* WT; int ldw, K, d0, sc0, nv = 32, k0; float scale = 1.0f;
        int r = it, kind = 0, m = 0;
        if (r < I_IN) kind = 1;
        else { r -= I_IN;
            if (r < 4 * I_SQ) { m = r / I_SQ; r -= m * I_SQ; }
            else { r -= 4 * I_SQ;
                if (r < I_PPJ) m = 4;
                else { r -= I_PPJ;
                    if (r < 16 * I_LRU1) m = 5;
                    else { r -= 16 * I_LRU1;
                        if (!odd) { if (r < I_GU_D) kind = 2; else { r -= I_GU_D; m = 6; } }
                        else { if (r < NEXP * I_GU_E) kind = 3; else { r -= NEXP * I_GU_E; m = 7; } } } } } }
        if (kind == 1) { const int nblk = NIN / 32, kb = r / nblk, db = r % nblk; d0 = 32 * db; k0 = 64 * kb;
            W = ka->in[I_WIN] + (size_t)L * D * D_IN; WT = (bf16*)(wb + W_IN); ldw = D_IN; K = D;
            if (d0 < 1024) sc0 = d0;
            else if (d0 < 2048) sc0 = 1736 + (d0 - 1024);
            else if (d0 < 3072) sc0 = 2760 + (d0 - 2048);
            else if (d0 < 4096) sc0 = 3784 + (d0 - 3072);
            else if (d0 < 5120) sc0 = 4808 + (d0 - 4096);
            else if (d0 < 5632) sc0 = 1152 + (d0 - 5120);
            else if (d0 < 5696) sc0 = 1024 + (d0 - 5632);
            else if (d0 < 5760) sc0 = 1088 + (d0 - 5696);
            else if (d0 < 5824) sc0 = 1664 + (d0 - 5760);
            else if (d0 == 5824) { sc0 = 1728; nv = 8; }
            else { sc0 = 0; nv = 0; } }
        else if (kind >= 2) { const int dff = kind == 2 ? DFF : DFFE; int e = 0; if (kind == 3) { e = r / I_GU_E; r -= e * I_GU_E; }
            const size_t eo = kind == 2 ? (size_t)jj * D * DFF : ((size_t)jj * NEXP + e) * D * DFFE;
            const int nblk = 2 * dff / 32, kb = r / nblk, db = r % nblk; d0 = 32 * db; k0 = 64 * kb; const int pn = d0 >> 8, rr = d0 & 255;
            W = (rr < 128 ? ka->in[kind == 2 ? I_FFG : I_MOEG] : ka->in[kind == 2 ? I_FFU : I_MOEU]) + eo; sc0 = 128 * pn + (rr & 127); ldw = dff; K = D;
            WT = (bf16*)(wb + W_FF) + (kind == 3 ? (size_t)e * 2 * DFFE * D : 0); }
        else { int Kk, Nn;
            if (m < 4) { Kk = D; Nn = D; W = ka->in[m == 0 ? I_WBRA : m == 1 ? I_WBRR : m == 2 ? I_WO : I_PLEG] + (size_t)L * D * D; WT = (bf16*)(wb + (m == 0 ? W_BRA : m == 1 ? W_BRR : m == 2 ? W_O : W_PG)); }
            else if (m == 4) { Kk = PLE; Nn = D; W = ka->in[I_PLEP] + (size_t)L * PLE * D; WT = (bf16*)(wb + W_PP); }
            else if (m == 5) { const int mm = r / I_LRU1, blk = mm & 7, which = mm >> 3; r -= mm * I_LRU1; Kk = 128; Nn = 128;
                W = ka->in[which ? I_LRUWX : I_LRUWA] + (size_t)L * 8 * 128 * 128 + (size_t)blk * 128 * 128; WT = (bf16*)(wb + W_LRU) + (size_t)which * 8 * 128 * 128 + (size_t)blk * 128 * 128; }
            else if (m == 6) { Kk = DFF; Nn = D; W = ka->in[I_FFD] + (size_t)jj * DFF * D; WT = (bf16*)(wb + W_FF_DN_DENSE); }
            else { const int e = r / I_DN_E; r -= e * I_DN_E; Kk = DFFE; Nn = D; W = ka->in[I_MOED] + ((size_t)jj * NEXP + e) * DFFE * D; WT = (bf16*)(wb + W_FF_DN_MOE) + (size_t)e * D * DFFE; }
            const int nblk = Nn / 32, kb = r / nblk, nb = r % nblk; d0 = 32 * nb; sc0 = 32 * nb; k0 = 64 * kb; ldw = Nn; K = Kk; }
        cvt_item(W, ldw, K, WT, d0, sc0, nv, scale, k0, scr, F.lane);
    }
    if (L == 0) {
        const GAS f32x4* x4 = (const GAS f32x4*)ka->in[I_X]; GAS v4u* o = (GAS v4u*)(F.ws + WS_XB);
        const size_t n8 = (size_t)T_TOK * D / 8;
        for (size_t i = (size_t)F.bx * 512 + F.tid; i < n8; i += (size_t)F.G * 512) { const f32x4 a = x4[2 * i], b = x4[2 * i + 1];
            v4u w; w.x = pk2(a[0], a[1]); w.y = pk2(a[2], a[3]); w.z = pk2(b[0], b[1]); w.w = pk2(b[2], b[3]); o[i] = w; }
    }
}

template <bool LN2, bool ODD, bool DRY = false>
__device__ __forceinline__ void ln_phase(const Frame& F0, int L) {
    Frame F = launder(F0);
    const KArgs ka = kargs();
    const int jj = L >> 1;
    float* X32 = F.out; bf16* XB = (bf16*)(F.ws + WS_XB);
    const float* gam = ka->in[LN2 ? I_LN2G : I_LN1G] + (size_t)L * D; const float* bet = ka->in[LN2 ? I_LN2B : I_LN1B] + (size_t)L * D;
    f32x4 gv[4], bv[4];
#pragma unroll
    for (int j = 0; j < 4; ++j) { gv[j] = ((const GAS f32x4*)gam)[F.lane + 64 * j]; bv[j] = ((const GAS f32x4*)bet)[F.lane + 64 * j]; }
    LAS float* RT = (LAS float*)(F.lds + RING_OFF);
    LAS unsigned* TE = (LAS unsigned*)(F.lds + RING_OFF + 32768);
    volatile LAS unsigned* lcnt = F.MISC + 48; volatile LAS unsigned* gbase = F.MISC + 56;
    float rb[8];
    if (!LN2 && ODD) {
        const float* R = ka->in[I_ROUTER] + (size_t)jj * D * NEXP;
        for (int i = F.tid; i < D * NEXP; i += 512) RT[i] = R[i];
        if (F.tid < 8) lcnt[F.tid] = 0u;
#pragma unroll
        for (int e = 0; e < 8; ++e) rb[e] = ka->in[I_ROUTERB][jj * NEXP + e];
        __syncthreads();
    }
    const unsigned* route = (const unsigned*)(F.ws + WS_ROUTE);
    const bf16* YE = (const bf16*)(F.ws + F_YE);
    const bf16* T1 = (const bf16*)(F.ws + (LN2 ? F_U : Z_GR)); const bf16* T2 = (const bf16*)(F.ws + Z_GR);
    v2u nx[4], n1[4], n2[4], ny1[4], ny2[4]; f32x4 npv = (f32x4){0.f, 0.f, 0.f, 0.f}; float gc1 = 0.f, gc2 = 0.f; v4u rnA, rnB;
    (void)n2; (void)ny1; (void)ny2; (void)npv; (void)gc1; (void)gc2; (void)rnA; (void)rnB;
    int vz_ = 0; asm volatile("" : "+v"(vz_));
    const GAS v4u* route4 = (const GAS v4u*)(F.ws + WS_ROUTE) + vz_;
#define LN_YE_LOADS(ra_, rb_) do { const size_t r1_ = (size_t)F.MISC[16 + (ra_).x] * 256 + (ra_).z, r2_ = (size_t)F.MISC[16 + (ra_).y] * 256 + (ra_).w; \
        const GAS v2u* y1_ = (const GAS v2u*)(YE + r1_ * D) + F.lane; const GAS v2u* y2_ = (const GAS v2u*)(YE + r2_ * D) + F.lane; \
        _Pragma("unroll") for (int j = 0; j < 4; ++j) { ny1[j] = y1_[64 * j]; ny2[j] = y2_[64 * j]; } } while (0)
    { const size_t rw0 = (size_t)F.bx * 256 + F.wave, r0 = rw0 * D; const GAS v2u* a0 = (const GAS v2u*)(XB + r0) + F.lane; const GAS v2u* b0 = (const GAS v2u*)(T1 + r0) + F.lane;
#pragma unroll
      for (int j = 0; j < 4; ++j) { nx[j] = a0[64 * j]; n1[j] = b0[64 * j]; }
      if (LN2 && !ODD) { const GAS v2u* fp = (const GAS v2u*)(T2 + r0) + F.lane;
#pragma unroll
          for (int j = 0; j < 4; ++j) n2[j] = fp[64 * j]; }
      if (!LN2) npv = ((const GAS f32x4*)(ka->in[I_P] + ((size_t)L * T_TOK + rw0) * PLE))[F.lane];
      if (LN2 && ODD) { const v4u ra = route4[rw0 * 2], rb = route4[rw0 * 2 + 1]; LN_YE_LOADS(ra, rb); gc1 = __builtin_bit_cast(float, route[rw0 * 8 + 4]); gc2 = __builtin_bit_cast(float, route[rw0 * 8 + 5]); rnA = route4[(rw0 + 8) * 2]; rnB = route4[(rw0 + 8) * 2 + 1]; } }
    for (int it = 0; it < 32; ++it) {
        const int rl = F.wave + 8 * it; const size_t row = (size_t)F.bx * 256 + rl;
        GAS f32x4* xr = (GAS f32x4*)(X32 + row * D) + F.lane;
        f32x4 v[4]; float s = 0.f;
#pragma unroll
        for (int j = 0; j < 4; ++j) { const v2u a = nx[j], b = n1[j];
            v[j][0] = DN_ALPHA * bf_lo(a.x) + bf_lo(b.x); v[j][1] = DN_ALPHA * bf_hi(a.x) + bf_hi(b.x); v[j][2] = DN_ALPHA * bf_lo(a.y) + bf_lo(b.y); v[j][3] = DN_ALPHA * bf_hi(a.y) + bf_hi(b.y); }
        if (LN2 && !ODD) {
#pragma unroll
            for (int j = 0; j < 4; ++j) { const v2u b = n2[j]; v[j][0] += bf_lo(b.x); v[j][1] += bf_hi(b.x); v[j][2] += bf_lo(b.y); v[j][3] += bf_hi(b.y); }
        }
        if (LN2 && ODD) {
#ifdef LN_MOE_OLD
            const unsigned e1 = route[row * 8 + 0], e2 = route[row * 8 + 1], p1 = route[row * 8 + 2], p2 = route[row * 8 + 3];
            const float g1 = __builtin_bit_cast(float, route[row * 8 + 4]), g2 = __builtin_bit_cast(float, route[row * 8 + 5]);
            const size_t r1 = (size_t)F.MISC[16 + e1] * 256 + p1, r2 = (size_t)F.MISC[16 + e2] * 256 + p2;
            const GAS v2u* y1 = (const GAS v2u*)(YE + r1 * D) + F.lane; const GAS v2u* y2 = (const GAS v2u*)(YE + r2 * D) + F.lane;
#pragma unroll
            for (int j = 0; j < 4; ++j) { ny1[j] = y1[64 * j]; ny2[j] = y2[64 * j]; }
#elif defined(LN_MOE_GOLD)
            const float g1 = __builtin_bit_cast(float, route[row * 8 + 4]), g2 = __builtin_bit_cast(float, route[row * 8 + 5]);
#else
            const float g1 = gc1, g2 = gc2;
#endif
#pragma unroll
            for (int j = 0; j < 4; ++j) { const v2u a = ny1[j], b = ny2[j];
                v[j][0] += g1 * bf_lo(a.x) + g2 * bf_lo(b.x); v[j][1] += g1 * bf_hi(a.x) + g2 * bf_hi(b.x);
                v[j][2] += g1 * bf_lo(a.y) + g2 * bf_lo(b.y); v[j][3] += g1 * bf_hi(a.y) + g2 * bf_hi(b.y); }
        }
        const f32x4 pv = npv;
        if (it < 31) { const GAS v2u* a0 = (const GAS v2u*)(XB + (row + 8) * D) + F.lane; const GAS v2u* b0 = (const GAS v2u*)(T1 + (row + 8) * D) + F.lane;
#pragma unroll
            for (int j = 0; j < 4; ++j) { nx[j] = a0[64 * j]; n1[j] = b0[64 * j]; }
            if (LN2 && !ODD) { const GAS v2u* fp = (const GAS v2u*)(T2 + (row + 8) * D) + F.lane;
#pragma unroll
                for (int j = 0; j < 4; ++j) n2[j] = fp[64 * j]; }
            if (!LN2) npv = ((const GAS f32x4*)(ka->in[I_P] + ((size_t)L * T_TOK + row + 8) * PLE))[F.lane];
            if (LN2 && ODD) { LN_YE_LOADS(rnA, rnB); gc1 = __builtin_bit_cast(float, route[(row + 8) * 8 + 4]); gc2 = __builtin_bit_cast(float, route[(row + 8) * 8 + 5]); if (it < 30) { rnA = route4[(row + 16) * 2]; rnB = route4[(row + 16) * 2 + 1]; } } }
#pragma unroll
        for (int j = 0; j < 4; ++j) s += (v[j][0] + v[j][1]) + (v[j][2] + v[j][3]);
        const float mean = wave_sum(s, F.lane) * (1.f / D); float s2 = 0.f;
#pragma unroll
        for (int j = 0; j < 4; ++j) { v[j] = v[j] - mean; s2 += (v[j][0] * v[j][0] + v[j][1] * v[j][1]) + (v[j][2] * v[j][2] + v[j][3] * v[j][3]); }
        const float rstd = 1.f / sqrtf(wave_sum(s2, F.lane) * (1.f / D) + LN_EPS);
        GAS v2u* o8 = (GAS v2u*)((DRY ? (bf16*)(F.ws + WS_NEED) : XB) + row * D) + F.lane;
        GAS f32x4* xw = DRY ? (GAS f32x4*)((float*)(F.ws + WS_NEED) + row * D) + F.lane : xr;
#pragma unroll
        for (int j = 0; j < 4; ++j) { v[j] = v[j] * rstd * gv[j] + bv[j]; if (DRY || (LN2 && L == DEPTH - 1)) xw[64 * j] = v[j];
            v2u w; w.x = pk2(v[j][0], v[j][1]); w.y = pk2(v[j][2], v[j][3]); o8[64 * j] = w; }
        if (!LN2) {
            v2u w; w.x = pk2(pv[0], pv[1]); w.y = pk2(pv[2], pv[3]); ((GAS v2u*)(F.ws + (DRY ? WS_NEED : F_PB) + row * PLE * 2))[F.lane] = w;
        }
        if (!LN2 && ODD) {
            float lg[8];
#pragma unroll
            for (int e = 0; e < 8; ++e) lg[e] = 0.f;
#pragma unroll
            for (int j = 0; j < 4; ++j)
#pragma unroll
                for (int q = 0; q < 4; ++q) { const int c = 4 * F.lane + 256 * j + q; const f32x4 ra = *(const LAS f32x4*)(RT + c * 8), rc = *(const LAS f32x4*)(RT + c * 8 + 4); const float xv = v[j][q];
                    lg[0] += xv * ra[0]; lg[1] += xv * ra[1]; lg[2] += xv * ra[2]; lg[3] += xv * ra[3]; lg[4] += xv * rc[0]; lg[5] += xv * rc[1]; lg[6] += xv * rc[2]; lg[7] += xv * rc[3]; }
#pragma unroll
            for (int e = 0; e < 8; ++e) lg[e] = wave_sum(lg[e], F.lane) + rb[e];
            int e1 = 0; float v1 = lg[0];
#pragma unroll
            for (int e = 1; e < 8; ++e) if (lg[e] > v1) { v1 = lg[e]; e1 = e; }
            int e2 = -1; float v2 = 0.f;
#pragma unroll
            for (int e = 0; e < 8; ++e) if (e != e1 && (e2 < 0 || lg[e] > v2)) { v2 = lg[e]; e2 = e; }
            const float ex = __expf(v2 - v1), g1 = 1.f / (1.f + ex), g2 = ex * g1;
            if (F.lane == 0) { const unsigned lp1 = __hip_atomic_fetch_add((LAS unsigned*)lcnt + e1, 1u, __ATOMIC_RELAXED, __HIP_MEMORY_SCOPE_WORKGROUP), lp2 = __hip_atomic_fetch_add((LAS unsigned*)lcnt + e2, 1u, __ATOMIC_RELAXED, __HIP_MEMORY_SCOPE_WORKGROUP);
                TE[rl * 4 + 0] = (unsigned)e1 | ((unsigned)e2 << 8) | (lp1 << 16); TE[rl * 4 + 1] = lp2; TE[rl * 4 + 2] = __builtin_bit_cast(unsigned, g1); TE[rl * 4 + 3] = __builtin_bit_cast(unsigned, g2); }
        }
    }
#undef LN_YE_LOADS
    if (!LN2 && ODD) {
        __syncthreads();
        if (F.tid < 8) gbase[F.tid] = __hip_atomic_fetch_add(F.ctl + CW_CNT + jj * 1024 + 64 * F.tid, lcnt[F.tid], RLX_AGENT);
        __syncthreads();
        if (F.tid < 256) { const unsigned w0 = TE[F.tid * 4], lp2 = TE[F.tid * 4 + 1]; const unsigned e1 = w0 & 255u, e2 = (w0 >> 8) & 255u, lp1 = w0 >> 16;
            const unsigned p1 = gbase[e1] + lp1, p2 = gbase[e2] + lp2; const unsigned tok = (unsigned)F.bx * 256 + F.tid;
            GAS int* list = (GAS int*)(F.ws + WS_LIST); list[(size_t)e1 * T_TOK + p1] = (int)tok; list[(size_t)e2 * T_TOK + p2] = (int)tok;
            GAS v4u* ro = (GAS v4u*)(F.ws + WS_ROUTE) + (size_t)tok * 2; v4u a; a.x = e1; a.y = e2; a.z = p1; a.w = p2; ro[0] = a; v4u b; b.x = TE[F.tid * 4 + 2]; b.y = TE[F.tid * 4 + 3]; b.z = 0u; b.w = 0u; ro[1] = b; }
        __syncthreads();
    }
}
__device__ __forceinline__ int wave_scan_add(int x) {
    x += __builtin_amdgcn_update_dpp(0, x, 0x111, 0xf, 0xf, false);
    x += __builtin_amdgcn_update_dpp(0, x, 0x112, 0xf, 0xf, false);
    x += __builtin_amdgcn_update_dpp(0, x, 0x114, 0xf, 0xf, false);
    x += __builtin_amdgcn_update_dpp(0, x, 0x118, 0xf, 0xf, false);
    x += __builtin_amdgcn_update_dpp(0, x, 0x142, 0xa, 0xf, false);
    x += __builtin_amdgcn_update_dpp(0, x, 0x143, 0xc, 0xf, false);
    return x;
}
template <int NJ>
__device__ __forceinline__ unsigned select_topk_n(LAS const float* sc, int n_adm, GAS unsigned short* gout, LAS unsigned short* out, int lane, unsigned guess) {
    const int nj = n_adm >> 6;
    unsigned u[NJ];
#pragma unroll
    for (int j = 0; j < NJ; ++j) { unsigned b = 0u;
        if (j < NJ - 8 || j < nj) { b = __builtin_bit_cast(unsigned, sc[64 * j + lane]); b = (b == 0x80000000u) ? 0u : b; b = (b & 0x80000000u) ? ~b : (b | 0x80000000u); }
        u[j] = b; }
#define SEL_COUNT(c_, dst_) do { int t_ = 0; const unsigned cc_ = (unsigned)__builtin_amdgcn_readfirstlane((int)(c_)); _Pragma("unroll") for (int j8 = 0; j8 < NJ; j8 += 8) { unsigned long long m0_, m1_, m2_, m3_, m4_, m5_, m6_, m7_; \
        asm("v_cmp_le_u32_e64 %0, %8, %9\n\tv_cmp_le_u32_e64 %1, %8, %10\n\tv_cmp_le_u32_e64 %2, %8, %11\n\tv_cmp_le_u32_e64 %3, %8, %12\n\tv_cmp_le_u32_e64 %4, %8, %13\n\tv_cmp_le_u32_e64 %5, %8, %14\n\tv_cmp_le_u32_e64 %6, %8, %15\n\tv_cmp_le_u32_e64 %7, %8, %16" \
            : "=&s"(m0_), "=&s"(m1_), "=&s"(m2_), "=&s"(m3_), "=&s"(m4_), "=&s"(m5_), "=&s"(m6_), "=&s"(m7_) : "s"(cc_), "v"(u[j8]), "v"(u[j8 + 1]), "v"(u[j8 + 2]), "v"(u[j8 + 3]), "v"(u[j8 + 4]), "v"(u[j8 + 5]), "v"(u[j8 + 6]), "v"(u[j8 + 7])); \
        t_ += __popcll(m0_) + __popcll(m1_) + __popcll(m2_) + __popcll(m3_) + __popcll(m4_) + __popcll(m5_) + __popcll(m6_) + __popcll(m7_); } dst_ = t_; } while (0)
    unsigned lo = 0u, hi = 0xFFFFFFFFu, ex = 0u; bool exact = false; int c;
    if (guess != 0u) {
        SEL_COUNT(guess, c);
        if (c == 256) { exact = true; ex = guess; }
        else if (c > 256) { lo = guess; unsigned d = 1u << 17;
            for (int e = 0; e < 7 && !exact; ++e) { const unsigned h = lo + d; if (h < lo) break; SEL_COUNT(h, c);
                if (c == 256) { exact = true; ex = h; } else if (c < 256) { hi = h; break; } else { lo = h; d <<= 2; } } }
        else { hi = guess; unsigned d = 1u << 17;
            for (int e = 0; e < 7 && !exact; ++e) { if (d >= hi) break; const unsigned l = hi - d; SEL_COUNT(l, c);
                if (c == 256) { exact = true; ex = l; } else if (c > 256) { lo = l; break; } else { hi = l; d <<= 2; } } }
    }
    while (!exact && hi - lo > 1u) { const unsigned mid = lo + ((hi - lo) >> 1); SEL_COUNT(mid, c);
        if (c == 256) { exact = true; ex = mid; } else if (c > 256) lo = mid; else hi = mid; }
#undef SEL_COUNT
    const unsigned thr = exact ? ex - 1u : lo;
    int nl = 0;
#pragma unroll
    for (int j = 0; j < NJ; ++j) nl += (u[j] > thr) ? 1 : 0;
    const int incl = wave_scan_add(nl); const int ngt = __builtin_amdgcn_readlane(incl, 63);
    int pos = incl - nl;
#pragma unroll
    for (int j = 0; j < NJ; ++j) if (u[j] > thr) { out[pos] = (unsigned short)(64 * j + lane); ++pos; }
    const int quota = 256 - ngt;
    if (quota > 0) {
        int tbase = 0; const unsigned long long lt = (1ull << lane) - 1ull;
#pragma unroll
        for (int j = 0; j < NJ; ++j) {
            const bool eq = u[j] == thr; const unsigned long long meq = __ballot(eq); const int rk = tbase + __popcll(meq & lt);
            if (eq && rk < quota) out[ngt + rk] = (unsigned short)(64 * j + lane);
            tbase += __popcll(meq);
        }
    }
    asm volatile("s_waitcnt lgkmcnt(0)" ::: "memory");
    if (lane < 32) *(GAS v4u*)(gout + 8 * lane) = *(const LAS v4u*)(out + 8 * lane);
    asm volatile("s_waitcnt lgkmcnt(0)" ::: "memory");
    return thr;
}
__device__ __forceinline__ unsigned select_topk(LAS const float* sc, int n_adm, GAS unsigned short* out, LAS unsigned short* orow, int lane, unsigned guess) {
    if (n_adm <= 256) {
#pragma unroll
        for (int j = 0; j < 4; ++j) { const int p = lane + 64 * j; out[p] = (unsigned short)(p < n_adm ? p : 0); }
        return 0u;
    }
    if (n_adm <= 512) return select_topk_n<8>(sc, n_adm, out, orow, lane, guess);
    else if (n_adm <= 1024) return select_topk_n<16>(sc, n_adm, out, orow, lane, guess);
    else if (n_adm <= 1536) return select_topk_n<24>(sc, n_adm, out, orow, lane, guess);
    return select_topk_n<32>(sc, n_adm, out, orow, lane, guess);
}
template <int MODE = 0>
__device__ __forceinline__ void indexer_phase(const Frame& F0) {
    Frame F = launder(F0);
    LAS float* sc = (LAS float*)(F.lds + RING_OFF);
    const bf16* QI = (const bf16*)(F.ws + Z_QI); const bf16* SM = (const bf16*)(F.ws + Z_SM);
    GAS unsigned short* IDX = (GAS unsigned short*)(F.ws + WS_IDX);
    const int lane = F.lane, h = lane >> 5, r = lane & 31;
    const int rq = 2 * ((r >> 2) & 1) + ((r >> 4) & 1), rh = (r & 3) + 4 * ((r >> 3) & 1);
    const int vcu = (F.bx & 7) * (F.G >> 3) + (F.bx >> 3);
    unsigned guess[2] = {0u, 0u};
    bf16x8 A[4][4]; v4u wq[4][2];
#define IDX_TILE(pi_, b_, tq_) const int pid_ = vcu * 8 + ((pi_) >> 1), b_ = pid_ >> 6, jp_ = pid_ & 63, tq_ = 16 * (((pi_) & 1) ? 127 - jp_ : jp_)
#define IDX_LOAD_A(t0_) do { _Pragma("unroll") for (int mt = 0; mt < 4; ++mt) { \
        _Pragma("unroll") for (int s = 0; s < 4; ++s) A[mt][s] = *(const GAS bf16x8*)(QI + (size_t)((t0_) + 4 * mt + rq) * 512 + rh * 64 + 16 * s + 8 * h); \
        _Pragma("unroll") for (int qq = 0; qq < 2; ++qq) wq[mt][qq] = *(const GAS v4u*)(SM + (size_t)((t0_) + 4 * mt + 2 * h + qq) * 256 + 192); } } while (0)
    for (int pi = 0; pi < 16; ++pi) {
        IDX_TILE(pi, b, tq);
        const int t0 = b * SEQ + tq;
        const int n_adm = ((tq >> 6) + 1) * 64, nkb = n_adm >> 5;
        if (n_adm > 256 && MODE != 2) {
            IDX_LOAD_A(t0);
            bf16x8 B[4], Bn[4];
#pragma unroll
            for (int s = 0; s < 4; ++s) Bn[s] = *(const GAS bf16x8*)(SM + (size_t)(b * SEQ + 32 * F.wave + r) * 256 + 128 + 16 * s + 8 * h);
            for (int kb = F.wave; kb < nkb; kb += 8) {
                const int key = 32 * kb + r;
                const int keyn = (kb + 8 < nkb) ? key + 256 : key;
#pragma unroll
                for (int s = 0; s < 4; ++s) B[s] = Bn[s];
#pragma unroll
                for (int s = 0; s < 4; ++s) Bn[s] = *(const GAS bf16x8*)(SM + (size_t)(b * SEQ + keyn) * 256 + 128 + 16 * s + 8 * h);
#pragma unroll
                for (int mt = 0; mt < 4; ++mt) {
                    f32x16 acc;
#pragma unroll
                    for (int i = 0; i < 16; ++i) acc[i] = 0.f;
#pragma unroll
                    for (int s = 0; s < 4; ++s) acc = __builtin_amdgcn_mfma_f32_32x32x16_bf16(A[mt][s], B[s], acc, 0, 0, 0);
                    float sA = 0.f, sB = 0.f;
#pragma unroll
                    for (int i = 0; i < 8; ++i) { const unsigned wa = wq[mt][0][i >> 1], wb = wq[mt][1][i >> 1];
                        const float fa = (i & 1) ? bf_hi(wa) : bf_lo(wa), fb = (i & 1) ? bf_hi(wb) : bf_lo(wb);
                        sA += fmaxf(acc[i], 0.f) * fa; sB += fmaxf(acc[8 + i], 0.f) * fb; }
                    sc[(4 * mt + 2 * h) * 2048 + key] = sA; sc[(4 * mt + 2 * h + 1) * 2048 + key] = sB;
                }
            }
        }
        __syncthreads();
#pragma unroll 1
        for (int qq = 0; qq < 2 && MODE != 1; ++qq) { const int q = 2 * F.wave + qq; const unsigned g_ = (pi & 1) ? guess[1] : guess[0];
            const unsigned t_ = select_topk(sc + q * 2048, n_adm, IDX + (size_t)(t0 + q) * 256, (LAS unsigned short*)(F.lds + LDSCTL_OFF + 1024 + F.wave * 512), lane, g_); if (pi & 1) guess[1] = t_; else guess[0] = t_; }
        __syncthreads();
    }
#undef IDX_TILE
#undef IDX_LOAD_A
}

__device__ __forceinline__ unsigned vst_off(unsigned r, unsigned ch) { return r * 128u + 16u * (ch ^ ((((r >> 1) ^ (r >> 4)) & 1u) << 1) ^ (((r >> 3) & 1u) << 2)); }
__device__ __forceinline__ int t5_bucket_dev(int rel) {
    const int n = rel < 0 ? -rel : rel;
    int v = n;
    if (n >= 8) v = 8 + (n >= 12) + (n >= 16) + (n >= 23) + (n >= 32) + (n >= 46) + (n >= 64) + (n >= 91);
    return v + (rel > 0 ? 16 : 0);
}
#ifndef ATT_REPS
#define ATT_REPS 1
#endif
#ifndef ATT_FIXKEYS
#define ATT_FIXKEYS 0
#endif
template <int FIX = 0>
__device__ __forceinline__ void attention_phase(const Frame& F0) {
#pragma unroll 1
    for (int rep = 0; rep < ATT_REPS; ++rep) {
    Frame F = launder(F0);
    const GAS unsigned char* Q8 = (const GAS unsigned char*)(F.ws + Z_Q8); const GAS unsigned char* KV8 = (const GAS unsigned char*)(F.ws + Z_KV8); bf16* OB = (bf16*)(F.ws + Z_XR);
    const GAS unsigned short* IDX = (const GAS unsigned short*)(F.ws + WS_IDX);
    const int lane = F.lane, g = lane >> 4, m = lane & 15;
    LAS unsigned char* vst = F.lds + RING_OFF + F.wave * 4096;
    const unsigned vbase = (unsigned)(size_t)vst;
    LAS unsigned char* BK = F.lds + RING_OFF + 32768; LAS unsigned char* OH = F.lds + RING_OFF + 32768 + 2176;
    for (int i = F.tid; i < 2112; i += 512) BK[i] = (unsigned char)t5_bucket_dev(i - 2047);
    if (F.tid < 128) { const int bkt = F.tid >> 2, gg = F.tid & 3, j = bkt - 8 * gg; v4u oh; oh.x = oh.y = oh.z = oh.w = 0u;
        if (j >= 0 && j < 8) { const unsigned val = (j & 1) ? 0x3F800000u : 0x3F80u; if ((j >> 1) == 0) oh.x = val; else if ((j >> 1) == 1) oh.y = val; else if ((j >> 1) == 2) oh.z = val; else oh.w = val; }
        *(LAS v4u*)(OH + F.tid * 16) = oh; }
    __syncthreads();
    bf16x8 bb;
    { const float* rbias = kargs()->in[I_RELB]; unsigned w[4];
#pragma unroll
      for (int j = 0; j < 4; ++j) w[j] = pk2(8.0f * rbias[(8 * g + 2 * j) * 16 + m], 8.0f * rbias[(8 * g + 2 * j + 1) * 16 + m]);
      v4u t; t.x = w[0]; t.y = w[1]; t.z = w[2]; t.w = w[3]; bb = __builtin_bit_cast(bf16x8, t); }
    unsigned tra[4];
    { const unsigned rr_ = 8 * g + (m >> 1), fr_ = ((rr_ >> 2) & 3u) ^ ((rr_ >> 1) & 1u);
#pragma unroll
      for (int c = 0; c < 4; ++c) tra[c] = rr_ * 64u + 16u * ((unsigned)c ^ fr_) + 8u * (m & 1); }
    const long aones = (m == 0) ? 0x3838383838383838L : 0L;
    const int vcu = (F.bx & 7) * (F.G >> 3) + (F.bx >> 3);
    typedef long fp8x8;
    v4u ni0, ni1, nq; v4u ka[16]; unsigned koff[16];
#define ATT_KOFF(i0_, i1_) do { _Pragma("unroll") for (int k = 0; k < 4; ++k) { koff[2 * k] = ((i0_)[k] & 0xffffu) * 128u + 16u * g; koff[2 * k + 1] = ((i0_)[k] >> 16) * 128u + 16u * g; \
        koff[8 + 2 * k] = ((i1_)[k] & 0xffffu) * 128u + 16u * g; koff[8 + 2 * k + 1] = ((i1_)[k] >> 16) * 128u + 16u * g; } } while (0)
#ifdef ATT_NO_ASM
#define ATT_KLOAD(kvb_) do { const GAS unsigned char* kb_ = (kvb_); _Pragma("unroll") for (int T = 0; T < 16; ++T) ka[T] = *(const GAS v4u*)(kb_ + koff[T]); } while (0)
#define ATT_KWAIT(n_, T0_) do {} while (0)
#else
#define ATT_KLOAD(kvb_) do { const GAS unsigned char* kb_ = (kvb_); _Pragma("unroll") for (int T = 0; T < 16; ++T) { \
        asm volatile("global_load_dwordx4 %0, %1, %2" : "=&v"(ka[T]) : "v"(koff[T]), "s"(kb_) : "memory"); } } while (0)
#define ATT_KWAIT(n_, T0_) asm volatile("s_waitcnt vmcnt(" #n_ ")" : "+v"(ka[T0_]), "+v"(ka[T0_ + 1]), "+v"(ka[T0_ + 2]), "+v"(ka[T0_ + 3]), "+v"(ka[T0_ + 4]), "+v"(ka[T0_ + 5]), "+v"(ka[T0_ + 6]), "+v"(ka[T0_ + 7]) :: "memory")
#endif
#define ATT_TOK(it_) ((vcu >> 3) * SEQ + ((it_) >> 2) * 256 + (vcu & 7) * 32 + 8 * ((it_) & 3) + F.wave)
    { const int tok0 = ATT_TOK(0); const GAS v4u* ip = (const GAS v4u*)(IDX + (size_t)tok0 * 256 + 16 * m); ni0 = ip[0]; ni1 = ip[1];
      nq = *(const GAS v4u*)(Q8 + (size_t)tok0 * D + m * 64 + 16 * g);
      ATT_KOFF(ni0, ni1); ATT_KLOAD(KV8 + (size_t)(tok0 >> 11) * SEQ * 128); }
    for (int it = 0; it < 32; ++it) {
        const int tok = ATT_TOK(it), b = tok >> 11, tq = tok & (SEQ - 1);
        const int n_valid = (((tq >> 6) + 1) * 64) < 256 ? ((tq >> 6) + 1) * 64 : 256;
        const v4u qv = nq;
        const fp8x8 qf0 = (fp8x8)(((unsigned long long)qv.y << 32) | qv.x), qf1 = (fp8x8)(((unsigned long long)qv.w << 32) | qv.z);
        const GAS unsigned char* kvb = KV8 + (size_t)b * SEQ * 128;
        f32x4 S[16];
#pragma unroll
        for (int T = 0; T < 16; ++T) {
            if (T == 0) ATT_KWAIT(8, 0);
            if (T == 8) ATT_KWAIT(0, 8);
            const unsigned bkt = BK[(koff[T] >> 7) + (2047 - tq)];
            const v4u oh = *(const LAS v4u*)(OH + bkt * 64 + g * 16);
            f32x4 ab = (f32x4){0.f, 0.f, 0.f, 0.f}, a = (f32x4){0.f, 0.f, 0.f, 0.f};
            ab = __builtin_amdgcn_mfma_f32_16x16x32_bf16(__builtin_bit_cast(bf16x8, oh), bb, ab, 0, 0, 0);
            a = __builtin_amdgcn_mfma_f32_16x16x32_fp8_fp8((fp8x8)(((unsigned long long)ka[T].y << 32) | ka[T].x), qf0, a, 0, 0, 0);
            a = __builtin_amdgcn_mfma_f32_16x16x32_fp8_fp8((fp8x8)(((unsigned long long)ka[T].w << 32) | ka[T].z), qf1, a, 0, 0, 0);
            a = a + ab;
            S[T] = a;
        }
        __builtin_amdgcn_sched_barrier(0);
        v4u vv[16];
#pragma unroll
        for (int T = 0; T < 16; ++T) vv[T] = *(const GAS v4u*)(kvb + koff[T] + 64);
        if (n_valid < 256) {
#pragma unroll
            for (int T = 0; T < 16; ++T)
#pragma unroll
                for (int i = 0; i < 4; ++i) if (16 * (4 * g + i) + T >= n_valid) S[T][i] = -1e30f;
        }
        float mx = -3.0e38f;
#pragma unroll
        for (int T = 0; T < 16; ++T) { asm("v_max3_f32 %0, %1, %2, %0" : "+v"(mx) : "v"(S[T][0]), "v"(S[T][1])); asm("v_max3_f32 %0, %1, %2, %0" : "+v"(mx) : "v"(S[T][2]), "v"(S[T][3])); }
        mx = fmaxf(mx, lane_xor(mx, 16, lane)); mx = fmaxf(mx, lane_xor(mx, 32, lane));
        constexpr float SC = 1.4426950408889634f * 0.125f;
        const float mneg = 8.0f - mx * SC;
#pragma unroll
        for (int T = 0; T < 16; ++T)
#pragma unroll
            for (int i = 0; i < 4; ++i) S[T][i] = __builtin_amdgcn_exp2f(S[T][i] * SC + mneg);
        { const int tokn = ATT_TOK(it < 31 ? it + 1 : it); const GAS v4u* ip = (const GAS v4u*)(IDX + (size_t)tokn * 256 + 16 * m); ni0 = ip[0]; ni1 = ip[1];
          nq = *(const GAS v4u*)(Q8 + (size_t)tokn * D + m * 64 + 16 * g); }
        f32x4 O[4], Osum = (f32x4){0.f, 0.f, 0.f, 0.f};
#pragma unroll
        for (int c = 0; c < 4; ++c) O[c] = (f32x4){0.f, 0.f, 0.f, 0.f};
#pragma unroll
        for (int ks = 0; ks < 8; ++ks) {
#pragma unroll
            for (int tt = 0; tt < 2; ++tt) { const unsigned rr = 8 * (m >> 2) + 4 * tt + (m & 3), fr = ((rr >> 2) & 3u) ^ ((rr >> 1) & 1u);
                *(LAS v4u*)(vst + rr * 64u + 16u * ((unsigned)g ^ fr)) = vv[2 * ks + tt]; }
            int p0 = __builtin_amdgcn_cvt_pk_fp8_f32(S[2 * ks][0], S[2 * ks][1], 0, false); p0 = __builtin_amdgcn_cvt_pk_fp8_f32(S[2 * ks][2], S[2 * ks][3], p0, true);
            int p1 = __builtin_amdgcn_cvt_pk_fp8_f32(S[2 * ks + 1][0], S[2 * ks + 1][1], 0, false); p1 = __builtin_amdgcn_cvt_pk_fp8_f32(S[2 * ks + 1][2], S[2 * ks + 1][3], p1, true);
            const fp8x8 pf = (fp8x8)(((unsigned long long)(unsigned)p1 << 32) | (unsigned)p0);
            v2u f[4];
            asm volatile("s_waitcnt lgkmcnt(0)\n\t"
                         "ds_read_b64_tr_b8 %0, %4\n\tds_read_b64_tr_b8 %1, %5\n\tds_read_b64_tr_b8 %2, %6\n\tds_read_b64_tr_b8 %3, %7\n\t"
                         "s_waitcnt lgkmcnt(0)"
                         : "=&v"(f[0]), "=&v"(f[1]), "=&v"(f[2]), "=&v"(f[3])
                         : "v"(vbase + tra[0]), "v"(vbase + tra[1]), "v"(vbase + tra[2]), "v"(vbase + tra[3])
                         : "memory");
#pragma unroll
            for (int c = 0; c < 4; ++c) O[c] = __builtin_amdgcn_mfma_f32_16x16x32_fp8_fp8((fp8x8)(((unsigned long long)f[c].y << 32) | f[c].x), pf, O[c], 0, 0, 0);
            Osum = __builtin_amdgcn_mfma_f32_16x16x32_fp8_fp8(aones, pf, Osum, 0, 0, 0);
        }
        const float inv = 1.0f / lane_get(Osum[0], m);
#pragma unroll
        for (int c = 0; c < 4; ++c) { v2u w; w.x = pk2(O[c][0] * inv, O[c][1] * inv); w.y = pk2(O[c][2] * inv, O[c][3] * inv);
            *(GAS v2u*)(OB + (size_t)tok * D + m * 64 + 16 * c + 4 * g) = w; }
        { const int tokn = ATT_TOK(it < 31 ? it + 1 : it); ATT_KOFF(ni0, ni1); ATT_KLOAD(KV8 + (size_t)(tokn >> 11) * SEQ * 128); }
    }
    asm volatile("s_waitcnt vmcnt(0)" ::: "memory");
#undef ATT_KOFF
#undef ATT_KLOAD
#undef ATT_KWAIT
    }
}

__device__ __forceinline__ void attention_phase2(const Frame& F0) {
    Frame F = launder(F0);
    const GAS unsigned char* Q8 = (const GAS unsigned char*)(F.ws + Z_Q8); const GAS unsigned char* KV8 = (const GAS unsigned char*)(F.ws + Z_KV8); bf16* OB = (bf16*)(F.ws + Z_XR);
    const GAS unsigned short* IDX = (const GAS unsigned short*)(F.ws + WS_IDX);
    const int lane = F.lane, g = lane >> 4, m = lane & 15, r8 = lane >> 3, c8 = lane & 7;
    LAS unsigned char* vbuf = F.lds + RING_OFF + F.wave * 16384;
    const unsigned vbase = (unsigned)(size_t)vbuf;
    LAS unsigned char* irow = F.lds + LDSCTL_OFF + 1024 + F.wave * 512;
    LAS unsigned char* kst = F.lds + LDSCTL_OFF + 5120 + F.wave * 2048;
    LAS unsigned char* BK = F.lds + LDSCTL_OFF + 21504;
    LAS unsigned char* OH = F.lds + LDSCTL_OFF + 23680;
    for (int i = F.tid; i < 2112; i += 512) BK[i] = (unsigned char)t5_bucket_dev(i - 2047);
    if (F.tid < 128) { const int bkt = F.tid >> 2, gg = F.tid & 3, j = bkt - 8 * gg; v4u oh; oh.x = oh.y = oh.z = oh.w = 0u;
        if (j >= 0 && j < 8) { const unsigned val = (j & 1) ? 0x3F800000u : 0x3F80u; if ((j >> 1) == 0) oh.x = val; else if ((j >> 1) == 1) oh.y = val; else if ((j >> 1) == 2) oh.z = val; else oh.w = val; }
        *(LAS v4u*)(OH + F.tid * 16) = oh; }
    __syncthreads();
    bf16x8 bb;
    { const float* rbias = kargs()->in[I_RELB]; unsigned w[4];
#pragma unroll
      for (int j = 0; j < 4; ++j) w[j] = pk2(8.0f * rbias[(8 * g + 2 * j) * 16 + m], 8.0f * rbias[(8 * g + 2 * j + 1) * 16 + m]);
      v4u t; t.x = w[0]; t.y = w[1]; t.z = w[2]; t.w = w[3]; bb = __builtin_bit_cast(bf16x8, t); }
    unsigned tra[4];
    { const unsigned rr_ = 8 * g + (m >> 1), fr_ = ((rr_ >> 2) & 3u) ^ ((rr_ >> 1) & 1u);
#pragma unroll
      for (int c = 0; c < 4; ++c) tra[c] = vbase + rr_ * 64u + 16u * ((unsigned)c ^ fr_) + 8u * (m & 1); }
    const long aones = (m == 0) ? 0x3838383838383838L : 0L;
    const int vcu = (F.bx & 7) * (F.G >> 3) + (F.bx >> 3);
    unsigned wa[2][2]; const unsigned vstr = c8 >= 4 ? 2048u : 0u;
#pragma unroll
    for (int j = 0; j < 2; ++j)
#pragma unroll
        for (int t = 0; t < 2; ++t) { const unsigned rho = 8u * j + r8;
            if (c8 < 4) wa[j][t] = (unsigned)(LDSCTL_OFF + 5120) + F.wave * 2048u + 1024u * t + rho * 64u + 16u * ((unsigned)c8 ^ (3u * j));
            else { const unsigned rr = 8u * (rho >> 2) + 4u * t + (rho & 3u), fr = ((rr >> 2) & 3u) ^ ((rr >> 1) & 1u); wa[j][t] = (unsigned)RING_OFF + F.wave * 16384u + rr * 64u + 16u * ((unsigned)(c8 - 4) ^ fr); } }
    const unsigned kra = m * 64u + 16u * ((unsigned)g ^ (3u * ((m >> 3) & 1)));
    const unsigned bra = 2u * (32u * (m & 7) + (m >> 3));
    typedef long fp8x8;
    v4u ni, nq;
#define ATT2_QLOAD(tk_) do { const unsigned qo_ = (unsigned)(tk_) * (unsigned)D + (unsigned)(m * 64 + 16 * g); asm volatile("global_load_dwordx4 %0, %1, %2" : "=&v"(nq) : "v"(qo_), "s"(Q8) : "memory"); } while (0)
    { const int tok0 = ATT_TOK(0); ni = *(const GAS v4u*)(IDX + (size_t)tok0 * 256 + 8 * (lane & 31)); ATT2_QLOAD(tok0); }
    for (int it = 0; it < 32; ++it) {
        const int tok = ATT_TOK(it), b = tok >> 11, tq = tok & (SEQ - 1);
        const int n_valid = (((tq >> 6) + 1) * 64) < 256 ? ((tq >> 6) + 1) * 64 : 256;
        const GAS unsigned char* kvb = KV8 + (size_t)b * SEQ * 128;
        if (lane < 32) *(LAS v4u*)(irow + 16 * lane) = ni;
        v4u kv[32];
        { v4u ix[4];
#pragma unroll
          for (int k = 0; k < 4; ++k) ix[k] = *(const LAS v4u*)(irow + 64 * r8 + 16 * k);
#pragma unroll
          for (int q = 0; q < 32; ++q) { const unsigned w = ix[q >> 3][(q >> 1) & 3]; const unsigned off = ((q & 1) ? (w >> 16) : (w & 0xffffu)) * 128u + 16u * c8;
              asm volatile("global_load_dwordx4 %0, %1, %2" : "=&v"(kv[q]) : "v"(off), "s"(kvb) : "memory"); } }
        unsigned bkp[4] = {0u, 0u, 0u, 0u};
#pragma unroll
        for (int T = 0; T < 16; ++T) { const unsigned key = *(const LAS unsigned short*)(irow + bra + 4 * T); bkp[T >> 2] |= (unsigned)BK[key + (2047 - tq)] << (8 * (T & 3)); }
        f32x4 S[16];
#define ATT2_STAGE(T, N, KF) do { \
            asm volatile("s_waitcnt vmcnt(" #N ")" : "+v"(kv[2 * (T)]), "+v"(kv[2 * (T) + 1]) :: "memory"); \
            *(LAS v4u*)(F.lds + wa[0][(T) & 1] + ((T) >> 1) * vstr) = kv[2 * (T)]; *(LAS v4u*)(F.lds + wa[1][(T) & 1] + ((T) >> 1) * vstr) = kv[2 * (T) + 1]; \
            KF = *(const LAS v4u*)(kst + 1024 * ((T) & 1) + kra); } while (0)
#define ATT2_MMA(T, KF) do { \
            const v4u oh = *(const LAS v4u*)(OH + ((bkp[(T) >> 2] >> (8 * ((T) & 3))) & 0xffu) * 64u + g * 16); \
            f32x4 ab = (f32x4){0.f, 0.f, 0.f, 0.f}, a = (f32x4){0.f, 0.f, 0.f, 0.f}; \
            ab = __builtin_amdgcn_mfma_f32_16x16x32_bf16(__builtin_bit_cast(bf16x8, oh), bb, ab, 0, 0, 0); \
            a = __builtin_amdgcn_mfma_f32_16x16x32_fp8_fp8((fp8x8)(((unsigned long long)(KF).y << 32) | (KF).x), qf0, a, 0, 0, 0); \
            a = __builtin_amdgcn_mfma_f32_16x16x32_fp8_fp8((fp8x8)(((unsigned long long)(KF).w << 32) | (KF).z), qf1, a, 0, 0, 0); \
            S[T] = a + ab; } while (0)
        v4u kfa, kfb;
        ATT2_STAGE(0, 30, kfa);
        asm volatile("" : "+v"(nq) :: "memory");
        const v4u qv = nq;
        const fp8x8 qf0 = (fp8x8)(((unsigned long long)qv.y << 32) | qv.x), qf1 = (fp8x8)(((unsigned long long)qv.w << 32) | qv.z);
        ATT2_STAGE(1, 28, kfb); ATT2_MMA(0, kfa);   ATT2_STAGE(2, 26, kfa); ATT2_MMA(1, kfb);   ATT2_STAGE(3, 24, kfb); ATT2_MMA(2, kfa);   ATT2_STAGE(4, 22, kfa); ATT2_MMA(3, kfb);
        ATT2_STAGE(5, 20, kfb); ATT2_MMA(4, kfa);   ATT2_STAGE(6, 18, kfa); ATT2_MMA(5, kfb);   ATT2_STAGE(7, 16, kfb); ATT2_MMA(6, kfa);   ATT2_STAGE(8, 14, kfa); ATT2_MMA(7, kfb);
        ATT2_STAGE(9, 12, kfb); ATT2_MMA(8, kfa);   ATT2_STAGE(10, 10, kfa); ATT2_MMA(9, kfb);  ATT2_STAGE(11, 8, kfb); ATT2_MMA(10, kfa);  ATT2_STAGE(12, 6, kfa); ATT2_MMA(11, kfb);
        ATT2_STAGE(13, 4, kfb); ATT2_MMA(12, kfa);  ATT2_STAGE(14, 2, kfa); ATT2_MMA(13, kfb);  ATT2_STAGE(15, 0, kfb); ATT2_MMA(14, kfa);  ATT2_MMA(15, kfb);
#undef ATT2_STAGE
#undef ATT2_MMA
        if (n_valid < 256) {
            int bs0 = 128 * (g & 1) + (g >> 1); asm volatile("" : "+v"(bs0));
#pragma unroll
            for (int T = 0; T < 16; ++T) { const int lim = n_valid - 2 * T;
#pragma unroll
                for (int i = 0; i < 4; ++i) if (bs0 + 32 * i >= lim) S[T][i] = -1e30f; }
        }
        float mx = -3.0e38f;
#pragma unroll
        for (int T = 0; T < 16; ++T) { asm("v_max3_f32 %0, %1, %2, %0" : "+v"(mx) : "v"(S[T][0]), "v"(S[T][1])); asm("v_max3_f32 %0, %1, %2, %0" : "+v"(mx) : "v"(S[T][2]), "v"(S[T][3])); }
        mx = fmaxf(mx, lane_xor(mx, 16, lane)); mx = fmaxf(mx, lane_xor(mx, 32, lane));
        constexpr float SC = 1.4426950408889634f * 0.125f;
        const float mneg = 8.0f - mx * SC;
#pragma unroll
        for (int T = 0; T < 16; ++T)
#pragma unroll
            for (int i = 0; i < 4; ++i) S[T][i] = __builtin_amdgcn_exp2f(S[T][i] * SC + mneg);
        { const int tokn = ATT_TOK(it < 31 ? it + 1 : it); ni = *(const GAS v4u*)(IDX + (size_t)tokn * 256 + 8 * (lane & 31)); ATT2_QLOAD(tokn); }
        f32x4 O[4], Osum = (f32x4){0.f, 0.f, 0.f, 0.f};
#pragma unroll
        for (int c = 0; c < 4; ++c) O[c] = (f32x4){0.f, 0.f, 0.f, 0.f};
#pragma unroll
        for (int ks = 0; ks < 8; ++ks) {
            int p0 = __builtin_amdgcn_cvt_pk_fp8_f32(S[2 * ks][0], S[2 * ks][1], 0, false); p0 = __builtin_amdgcn_cvt_pk_fp8_f32(S[2 * ks][2], S[2 * ks][3], p0, true);
            int p1 = __builtin_amdgcn_cvt_pk_fp8_f32(S[2 * ks + 1][0], S[2 * ks + 1][1], 0, false); p1 = __builtin_amdgcn_cvt_pk_fp8_f32(S[2 * ks + 1][2], S[2 * ks + 1][3], p1, true);
            const fp8x8 pf = (fp8x8)(((unsigned long long)(unsigned)p1 << 32) | (unsigned)p0);
            v2u f[4];
            asm volatile("s_waitcnt lgkmcnt(0)\n\t"
                         "ds_read_b64_tr_b8 %0, %4\n\tds_read_b64_tr_b8 %1, %5\n\tds_read_b64_tr_b8 %2, %6\n\tds_read_b64_tr_b8 %3, %7\n\t"
                         "s_waitcnt lgkmcnt(0)"
                         : "=&v"(f[0]), "=&v"(f[1]), "=&v"(f[2]), "=&v"(f[3])
                         : "v"(tra[0] + 2048u * ks), "v"(tra[1] + 2048u * ks), "v"(tra[2] + 2048u * ks), "v"(tra[3] + 2048u * ks)
                         : "memory");
#pragma unroll
            for (int c = 0; c < 4; ++c) O[c] = __builtin_amdgcn_mfma_f32_16x16x32_fp8_fp8((fp8x8)(((unsigned long long)f[c].y << 32) | f[c].x), pf, O[c], 0, 0, 0);
            Osum = __builtin_amdgcn_mfma_f32_16x16x32_fp8_fp8(aones, pf, Osum, 0, 0, 0);
        }
        const float inv = 1.0f / lane_get(Osum[0], m);
#pragma unroll
        for (int c = 0; c < 4; ++c) { v2u w; w.x = pk2(O[c][0] * inv, O[c][1] * inv); w.y = pk2(O[c][2] * inv, O[c][3] * inv);
            *(GAS v2u*)(OB + (size_t)tok * D + m * 64 + 16 * c + 4 * g) = w; }
    }
    asm volatile("s_waitcnt vmcnt(0)" : "+v"(nq) :: "memory");
#undef ATT2_QLOAD
}
constexpr int XCS = 136;
constexpr int HHS = 132;
__device__ __forceinline__ float gelu_tanh(float x) {
    const float z = 0.7978845608028654f * (x + 0.044715f * x * x * x);
    const float e = __builtin_amdgcn_exp2f(2.885390081777927f * z);
    const float th = 1.0f - 2.0f * __builtin_amdgcn_rcpf(e + 1.0f);
    return 0.5f * x * (1.0f + th);
}
template <bool DRY = false>
__device__ __forceinline__ void lru_phase(const Frame& F0, int L) {
    Frame F = launder(F0);
    const KArgs ka = kargs();
    const int b = F.bx >> 3, nb = F.bx & 7;
    const bf16* XR = (const bf16*)(F.ws + Z_XR); bf16* YR = (bf16*)(F.ws + Z_YR);
    const bf16* WL = (const bf16*)(F.ws + WS_W + W_LRU);
    LAS bf16* XC = (LAS bf16*)(F.lds + RING_OFF);
    LAS float* HH = (LAS float*)(F.lds + RING_OFF + 2 * 64 * XCS * 2);
    const int tid = F.tid, lane = F.lane, w = F.wave, g = lane >> 4, m = lane & 15;
    const int cc = tid & 15, tp = tid >> 4;
    const int ch0 = nb * 128 + 8 * cc;
    float cw[4][8], cbias[8];
#pragma unroll
    for (int j = 0; j < 4; ++j)
#pragma unroll
        for (int k = 0; k < 8; ++k) cw[j][k] = ka->in[I_CONVW][(size_t)L * 4 * D + j * D + ch0 + k];
#pragma unroll
    for (int k = 0; k < 8; ++k) cbias[k] = ka->in[I_CONVB][(size_t)L * D + ch0 + k];
    bf16x8 Br[4], Bi[4];
#pragma unroll
    for (int s = 0; s < 4; ++s) { Br[s] = *(const GAS bf16x8*)(WL + ((size_t)nb * 128 + 16 * w + m) * 128 + 32 * s + 8 * g);
                                  Bi[s] = *(const GAS bf16x8*)(WL + (size_t)8 * 128 * 128 + ((size_t)nb * 128 + 16 * w + m) * 128 + 32 * s + 8 * g); }
    const int chl = 16 * w + m, chg = nb * 128 + chl;
    const float ba = ka->in[I_LRUBA][(size_t)L * D + chg], bx = ka->in[I_LRUBX][(size_t)L * D + chg];
    const float lam = ka->in[I_LAM][(size_t)L * D + chg];
    const float sp8 = -8.0f * (fmaxf(-lam, 0.f) + log1pf(__expf(-fabsf(lam))));
    float carry = 0.f;
    const size_t rowb = (size_t)b * SEQ;
    v4u nxin[5], nyin[2];
#pragma unroll
    for (int k = 0; k < 5; ++k) { const int t = 2 * tp - 3 + k; v4u z; z.x = z.y = z.z = z.w = 0u; nxin[k] = (t >= 0) ? *(const GAS v4u*)(XR + (rowb + t) * D + ch0) : z; }
#pragma unroll
    for (int k = 0; k < 2; ++k) nyin[k] = *(const GAS v4u*)(YR + (rowb + 2 * tp + k) * D + ch0);
    for (int tile = 0; tile < 32; ++tile) {
        const int t0 = tile * 64, buf = tile & 1;
        LAS bf16* xc = XC + buf * 64 * XCS; LAS float* hh = HH + buf * 64 * HHS;
        v4u xin[5], yin[2];
#pragma unroll
        for (int k = 0; k < 5; ++k) xin[k] = nxin[k];
#pragma unroll
        for (int k = 0; k < 2; ++k) yin[k] = nyin[k];
        if (tile < 31) {
#pragma unroll
            for (int k = 0; k < 5; ++k) nxin[k] = *(const GAS v4u*)(XR + (rowb + t0 + 64 + 2 * tp - 3 + k) * D + ch0);
#pragma unroll
            for (int k = 0; k < 2; ++k) nyin[k] = *(const GAS v4u*)(YR + (rowb + t0 + 64 + 2 * tp + k) * D + ch0);
        }
#pragma unroll
        for (int k = 0; k < 2; ++k) { float o[8];
#pragma unroll
            for (int c = 0; c < 8; ++c) { float a = cbias[c];
#pragma unroll
                for (int j = 0; j < 4; ++j) { const unsigned wv = xin[k + j][c >> 1]; a += ((c & 1) ? bf_hi(wv) : bf_lo(wv)) * cw[j][c]; }
                o[c] = a; }
            v4u pw; pw.x = pk2(o[0], o[1]); pw.y = pk2(o[2], o[3]); pw.z = pk2(o[4], o[5]); pw.w = pk2(o[6], o[7]);
            *(LAS v4u*)(xc + (2 * tp + k) * XCS + 8 * cc) = pw; }
        __syncthreads();
#pragma unroll
        for (int mt = 0; mt < 4; ++mt) {
            f32x4 ar = (f32x4){0.f, 0.f, 0.f, 0.f}, ai = (f32x4){0.f, 0.f, 0.f, 0.f};
#pragma unroll
            for (int s = 0; s < 4; ++s) { const bf16x8 A = *(const LAS bf16x8*)(xc + (16 * mt + m) * XCS + 32 * s + 8 * g);
                ar = __builtin_amdgcn_mfma_f32_16x16x32_bf16(A, Br[s], ar, 0, 0, 0); ai = __builtin_amdgcn_mfma_f32_16x16x32_bf16(A, Bi[s], ai, 0, 0, 0); }
            float P[4], W[4];
#pragma unroll
            for (int i = 0; i < 4; ++i) {
                const float rr = sigmoidf_fast(ar[i] + ba), ig = sigmoidf_fast(ai[i] + bx);
                const float la = sp8 * rr;
                const float a = __builtin_amdgcn_exp2f(1.4426950408889634f * la);
                const float mult = __builtin_amdgcn_sqrtf(fmaxf(__builtin_fmaf(-a, a, 1.0f), 0.f));
                const float xv = __builtin_bit_cast(float, (unsigned)xc[(16 * mt + 4 * g + i) * XCS + chl] << 16);
                const float u = mult * (ig * xv);
                if (i == 0) { P[0] = a; W[0] = u; } else { P[i] = a * P[i - 1]; W[i] = a * W[i - 1] + u; }
            }
            float Ac = P[3], Uc = W[3];
            { const float A1 = lane_up(Ac, 16, lane), U1 = lane_up(Uc, 16, lane); if (g >= 1) { Uc = Ac * U1 + Uc; Ac = Ac * A1; } }
            { const float A2 = lane_up(Ac, 32, lane), U2 = lane_up(Uc, 32, lane); if (g >= 2) { Uc = Ac * U2 + Uc; Ac = Ac * A2; } }
            float Ae = lane_up(Ac, 16, lane), Ue = lane_up(Uc, 16, lane); if (g == 0) { Ae = 1.f; Ue = 0.f; }
            const float hin = Ae * carry + Ue;
            const float cnew = Ac * carry + Uc;
            carry = lane_get(cnew, 48 + m);
#pragma unroll
            for (int i = 0; i < 4; ++i) hh[(16 * mt + 4 * g + i) * HHS + chl] = P[i] * hin + W[i];
        }
        __syncthreads();
#pragma unroll
        for (int k = 0; k < 2; ++k) { const f32x4 h0 = *(const LAS f32x4*)(hh + (2 * tp + k) * HHS + 8 * cc), h1 = *(const LAS f32x4*)(hh + (2 * tp + k) * HHS + 8 * cc + 4);
            float o[8];
#pragma unroll
            for (int c = 0; c < 8; ++c) { const unsigned wv = yin[k][c >> 1]; const float y = (c & 1) ? bf_hi(wv) : bf_lo(wv); o[c] = (c < 4 ? h0[c] : h1[c - 4]) * gelu_tanh(y); }
            v4u pw; pw.x = pk2(o[0], o[1]); pw.y = pk2(o[2], o[3]); pw.z = pk2(o[4], o[5]); pw.w = pk2(o[6], o[7]);
            *(GAS v4u*)((DRY ? (bf16*)(F.ws + WS_NEED) : YR) + (rowb + t0 + 2 * tp + k) * D + ch0) = pw; }
    }
    __syncthreads();
}

struct MoeOrder : pg8::StaticOrder {
    const volatile LAS unsigned* tb; int tile0; const int* list; size_t bstride;
    __device__ __forceinline__ int expert_of(int gt) const { int e = 0;
#pragma unroll
        for (int k = 1; k < 8; ++k) e += (gt >= (int)tb[k]) ? 1 : 0;
        return e; }
    __device__ __forceinline__ const char* b_base(const pg8::Gemm& g, const pg8::Unit& u, size_t tstep) const { return (const char*)g.Bt + (size_t)expert_of(tile0 + u.pm) * bstride + (size_t)u.pn * tstep; }
};
struct MoeGatherOrder : MoeOrder {
    static constexpr bool GATHER = true;
    __device__ __forceinline__ const char* a_base(const pg8::Gemm& g, const pg8::Unit&, size_t) const { return (const char*)g.A; }
    __device__ __forceinline__ void a_rows(const pg8::Unit& u, int R0, int R1, int C0, int C1, int K, unsigned (&off)[2][2]) const {
        const int gt = tile0 + u.pm, e = expert_of(gt), j = gt - (int)tb[e], n = (int)tb[16 + e];
        const GAS int* le = (const GAS int*)list + (size_t)e * T_TOK;
#pragma unroll
        for (int h = 0; h < 2; ++h) { int p0 = 256 * j + 128 * h + R0, p1 = 256 * j + 128 * h + R1; p0 = p0 < n ? p0 : n - 1; p1 = p1 < n ? p1 : n - 1;
            off[h][0] = ((unsigned)le[p0] * (unsigned)K + (unsigned)C0) * 2u; off[h][1] = ((unsigned)le[p1] * (unsigned)K + (unsigned)C1) * 2u; }
    }
};
#ifdef SELFCHECK
#ifndef SC_TOL
#define SC_TOL 0.03f
#define SC_ABS 1e-5f
#endif
__device__ __forceinline__ float sc_bf(const bf16* p, size_t i) { return __builtin_bit_cast(float, (unsigned)((const GAS bf16*)p)[i] << 16); }
__device__ __forceinline__ float sc_f8(const unsigned char* p, size_t i) {
    const unsigned v = ((const GAS unsigned char*)p)[i]; const unsigned e = (v >> 3) & 15u, mn = v & 7u; float r;
    if (e == 0u) r = (float)mn * 0.001953125f; else r = (1.0f + (float)mn * 0.125f) * exp2f((float)e - 7.0f);
    return (v & 128u) ? -r : r; }
__device__ __forceinline__ void sc_fail(const Frame& F, unsigned code) { __hip_atomic_fetch_or(F.ctl + CW_CODE, code, RLX_AGENT); }
__device__ __forceinline__ int sc_bucket_ref(int rel) {
    const int half = 16, max_exact = 8; const int ret = rel > 0 ? half : 0; const int n = rel < 0 ? -rel : rel;
    const float nf = (float)(n > 1 ? n : 1);
    int large = max_exact + (int)(logf(nf / (float)max_exact) / logf(16.0f) * (float)(half - max_exact));
    large = large < half - 1 ? large : half - 1;
    return ret + (n < max_exact ? n : large);
}
__device__ __forceinline__ void selfcheck_topk(const Frame& F0) {
    Frame F = launder(F0);
    if (F.wave != 0) return;
    const bf16* QI = (const bf16*)(F.ws + Z_QI); const bf16* SM = (const bf16*)(F.ws + Z_SM);
    const GAS unsigned short* IDX = (const GAS unsigned short*)(F.ws + WS_IDX);
    LAS float* sc = (LAS float*)(F.lds + RING_OFF);
    LAS unsigned* bm = (LAS unsigned*)(F.lds + RING_OFF + 8192);
    const int tok = F.bx * 256 + ((F.bx * 37) & 255), b = tok >> 11, tq = tok & (SEQ - 1), n_adm = ((tq >> 6) + 1) * 64;
    const int lane = F.lane;
    bm[lane] = 0u;
    for (int s = lane; s < n_adm; s += 64) { float score = 0.f;
        for (int h = 0; h < 8; ++h) { float d = 0.f;
            for (int k = 0; k < 64; ++k) d += sc_bf(QI, (size_t)tok * 512 + h * 64 + k) * sc_bf(SM, (size_t)(b * SEQ + s) * 256 + 128 + k);
            score += fmaxf(d, 0.f) * sc_bf(SM, (size_t)tok * 256 + 192 + h); }
        sc[s] = score; }
    asm volatile("s_waitcnt lgkmcnt(0)" ::: "memory");
    const int nsel = n_adm < 256 ? n_adm : 256;
    float msel = 3.0e38f; bool bad = false;
    for (int p = lane; p < nsel; p += 64) { const int key = IDX[(size_t)tok * 256 + p]; if (key >= n_adm) { bad = true; continue; }
        const unsigned old = __hip_atomic_fetch_or(bm + (key >> 5), 1u << (key & 31), __ATOMIC_RELAXED, __HIP_MEMORY_SCOPE_WORKGROUP); if (old & (1u << (key & 31))) bad = true;
        msel = fminf(msel, sc[key]); }
    asm volatile("s_waitcnt lgkmcnt(0)" ::: "memory");
    float muns = -3.0e38f, amax = 0.f;
    for (int s = lane; s < n_adm; s += 64) { amax = fmaxf(amax, fabsf(sc[s])); if (!((bm[s >> 5] >> (s & 31)) & 1u)) muns = fmaxf(muns, sc[s]); }
#pragma unroll
    for (int o = 1; o < 64; o <<= 1) { msel = fminf(msel, lane_xor(msel, o, lane)); muns = fmaxf(muns, lane_xor(muns, o, lane)); amax = fmaxf(amax, lane_xor(amax, o, lane)); }
    if (muns > msel + 1e-4f * amax) bad = true;
    if (__any(bad)) { if (lane == 0) sc_fail(F, 1u); }
}
__device__ __forceinline__ void selfcheck_attn(const Frame& F0) {
    Frame F = launder(F0);
    if (F.wave != 0) return;
    const KArgs ka = kargs();
    const unsigned char* Q8 = F.ws + Z_Q8; const unsigned char* KV8 = F.ws + Z_KV8; const bf16* OB = (const bf16*)(F.ws + Z_XR);
    const GAS unsigned short* IDX = (const GAS unsigned short*)(F.ws + WS_IDX);
    LAS float* lg = (LAS float*)(F.lds + RING_OFF + 65536);
    const int tok = F.bx * 256 + ((F.bx * 37) & 255), b = tok >> 11, tq = tok & (SEQ - 1), n_adm = ((tq >> 6) + 1) * 64, nv = n_adm < 256 ? n_adm : 256;
    const int lane = F.lane;
    for (int p = lane; p < 256; p += 64) { const int key = IDX[(size_t)tok * 256 + p]; const int bk = sc_bucket_ref(key - tq);
        for (int h = 0; h < 16; ++h) { float d = 0.f;
            for (int k = 0; k < 64; ++k) d += sc_f8(Q8, (size_t)tok * D + h * 64 + k) * sc_f8(KV8, (size_t)(b * SEQ + key) * 128 + k);
            lg[h * 256 + p] = p < nv ? 0.125f * d + ((const GAS float*)ka->in[I_RELB])[bk * 16 + h] : -1e30f; } }
    asm volatile("s_waitcnt lgkmcnt(0)" ::: "memory");
    if (lane < 16) { float mx = -3.0e38f; for (int p = 0; p < 256; ++p) mx = fmaxf(mx, lg[lane * 256 + p]); float sum = 0.f;
        for (int p = 0; p < 256; ++p) { const float e = __expf(lg[lane * 256 + p] - mx); lg[lane * 256 + p] = e; sum += e; }
        const float inv = 1.f / sum; for (int p = 0; p < 256; ++p) lg[lane * 256 + p] *= inv; }
    asm volatile("s_waitcnt lgkmcnt(0)" ::: "memory");
    float emax = 0.f, omax = 0.f;
    for (int o = lane; o < 1024; o += 64) { const int h = o >> 6, d = o & 63; float acc = 0.f;
        for (int p = 0; p < 256; ++p) { const int key = IDX[(size_t)tok * 256 + p]; acc += lg[h * 256 + p] * sc_f8(KV8, (size_t)(b * SEQ + key) * 128 + 64 + d); }
        const float got = sc_bf(OB, (size_t)tok * D + o); emax = fmaxf(emax, fabsf(got - acc)); omax = fmaxf(omax, fabsf(acc)); }
#pragma unroll
    for (int o = 1; o < 64; o <<= 1) { emax = fmaxf(emax, lane_xor(emax, o, lane)); omax = fmaxf(omax, lane_xor(omax, o, lane)); }
    if (!(emax <= SC_TOL * omax + SC_ABS)) { if (lane == 0) sc_fail(F, 2u); }
}
__device__ __forceinline__ void selfcheck_lru(const Frame& F0, int L, bool after) {
    Frame F = launder(F0);
    if (F.wave != 0) return;
    const KArgs ka = kargs();
    const bf16* XR = (const bf16*)(F.ws + Z_XR); const bf16* YR = (const bf16*)(F.ws + Z_YR);
    GAS float* EXP = (GAS float*)(F.ws + WS_NEED) + (size_t)F.bx * SEQ;
    const int b = F.bx >> 3, ch = ((F.bx & 7) * 128 + ((F.bx * 29) & 127)), nb = ch >> 7, lane = F.lane;
    if (after) { float emax = 0.f, omax = 0.f;
        for (int t = lane; t < SEQ; t += 64) { const float e = EXP[t], g = sc_bf(YR, (size_t)(b * SEQ + t) * D + ch); emax = fmaxf(emax, fabsf(e - g)); omax = fmaxf(omax, fabsf(e)); }
#pragma unroll
        for (int o = 1; o < 64; o <<= 1) { emax = fmaxf(emax, lane_xor(emax, o, lane)); omax = fmaxf(omax, lane_xor(omax, o, lane)); }
        if (!(emax <= SC_TOL * omax + SC_ABS)) { if (lane == 0) sc_fail(F, 4u); }
        return; }
    const float* cw = ka->in[I_CONVW] + (size_t)L * 4 * D; const float* cb = ka->in[I_CONVB] + (size_t)L * D;
    const float* wa = ka->in[I_LRUWA] + ((size_t)L * 8 + nb) * 128 * 128; const float* wx = ka->in[I_LRUWX] + ((size_t)L * 8 + nb) * 128 * 128;
    const float lam = ka->in[I_LAM][(size_t)L * D + ch], ba = ka->in[I_LRUBA][(size_t)L * D + ch], bx = ka->in[I_LRUBX][(size_t)L * D + ch];
    const float sp = fmaxf(-lam, 0.f) + log1pf(expf(-fabsf(lam)));
    const int dl = ch & 127;
    float h = 0.f;
    for (int t = 0; t < SEQ; ++t) {
        float pr = 0.f, pi = 0.f, xcc = 0.f;
#pragma unroll
        for (int q = 0; q < 2; ++q) { const int cl = lane + 64 * q, cg = nb * 128 + cl; float xc = cb[cg];
            for (int j = 0; j < 4; ++j) { const int tt = t - 3 + j; if (tt >= 0) xc += sc_bf(XR, (size_t)(b * SEQ + tt) * D + cg) * cw[j * D + cg]; }
            pr += xc * wa[cl * 128 + dl]; pi += xc * wx[cl * 128 + dl]; if (cl == dl) xcc = xc; }
#pragma unroll
        for (int o = 1; o < 64; o <<= 1) { pr += lane_xor(pr, o, lane); pi += lane_xor(pi, o, lane); xcc += lane_xor(xcc, o, lane); }
        const float r = 1.f / (1.f + expf(-(pr + ba))), ig = 1.f / (1.f + expf(-(pi + bx)));
        const float la = -8.0f * r * sp, a = expf(la), u = sqrtf(-expm1f(2.0f * la)) * (ig * xcc);
        h = a * h + u;
        const float y = sc_bf(YR, (size_t)(b * SEQ + t) * D + ch);
        const float gl = 0.5f * y * (1.f + tanhf(0.7978845608028654f * (y + 0.044715f * y * y * y)));
        if (lane == 0) EXP[t] = h * gl;
    }
}
#endif
__global__ void __launch_bounds__(NWAVES * 64, 2) mk_fwd(Args args) {
    extern __shared__ __attribute__((aligned(16))) unsigned char lds[];
    Frame F;
    F.lds = (LAS unsigned char*)lds;
    F.MISC = (volatile LAS unsigned*)(F.lds + MISC_OFF);
    F.tid = threadIdx.x; F.lane = F.tid & 63; F.wave = __builtin_amdgcn_readfirstlane(F.tid >> 6);
    F.G = gridDim.x; F.bx = blockIdx.x;
    F.ws = args.ws; F.ctl = (gu32*)(args.ws + WS_CTL); F.out = args.out;
    for (int u = threadIdx.x; u < (LDS_BYTES - LDSCTL_OFF) / 4; u += NWAVES * 64) ((LAS unsigned*)(F.lds + LDSCTL_OFF))[u] = 0u;
    __syncthreads();
    XcdBarrier bar = xcd_barrier_post((unsigned*)(F.ctl + CW_BAR), F.MISC + 8);
#ifdef PROBE_XCC
    if ((blockIdx.x & 7u) != (bar.x & 7u)) { const unsigned long long t0 = __builtin_amdgcn_s_memrealtime(); while (__builtin_amdgcn_s_memrealtime() - t0 < 200000ull) __builtin_amdgcn_s_sleep(8); }
#endif
#ifdef PROF_SEL
#ifndef PROF_WG
#define PROF_WG 0
#endif
#ifndef PROF_SEL2
#define PROF_SEL2 50
#endif
#ifndef PROF_MUL
#define PROF_MUL 1.0f
#endif
#define PROF_END(slot) do { if (launder(F).tid == 0) { const unsigned t_ = (unsigned)__builtin_amdgcn_s_memrealtime(); F.MISC[64 + (slot)] += t_ - F.MISC[96]; F.MISC[96] = t_; F.MISC[99] = (slot); } } while (0)
#define PROF_BEGIN(ph) do { if (launder(F).tid == 0) F.MISC[101] = (ph); } while (0)
#define PROF_WAIT() do { if (launder(F).tid == 0) { const unsigned t_ = (unsigned)__builtin_amdgcn_s_memrealtime(); F.MISC[80 + F.MISC[99]] += t_ - F.MISC[96]; F.MISC[64 + 13] += t_ - F.MISC[96]; F.MISC[96] = t_; } } while (0)
    if (F.tid == 0) { const unsigned t_ = (unsigned)__builtin_amdgcn_s_memrealtime(); F.MISC[96] = t_; F.MISC[98] = t_; }
#else
#define PROF_END(slot) do { } while (0)
#define PROF_BEGIN(ph) do { } while (0)
#define PROF_WAIT() do { } while (0)
#endif
#define GRID_BAR() do { XcdBarrier b_ = bar; unsigned* p_ = bar.bar; asm volatile("" : "+s"(p_)); b_.bar = p_; xcd_barrier(b_); PROF_WAIT(); } while (0)
    float* X32 = args.out;
#define LOCAL_HANDOFF() do { asm volatile("s_waitcnt vmcnt(0)" ::: "memory"); __syncthreads(); __builtin_amdgcn_fence(__ATOMIC_ACQUIRE, "agent"); asm volatile("s_waitcnt vmcnt(0)" ::: "memory"); __syncthreads(); } while (0)
    LAS unsigned char* ring = F.lds + RING_OFF;
    using pg8::Gemm; using pg8::StaticOrder;

    for (int L = -1; L < DEPTH; ++L) {
        const int odd = L & 1;
        if (L >= 0) {
        { const Frame P = launder(F); unsigned char* ws = P.ws; unsigned char* wb = ws + WS_W; bf16* XB = (bf16*)(ws + WS_XB); (void)XB; (void)wb;
          Gemm g{XB, (const bf16*)(wb + W_IN), T_TOK, NIN, D}; StaticOrder S; S.init(T_TOK, NIN, P.G, P.bx);
          pg8::EpiZ E{(bf16*)(ws + Z_Q), (bf16*)(ws + Z_QI), (bf16*)(ws + Z_SM), ws + Z_Q8, ws + Z_KV8};
PROF_BEGIN(1);
#ifndef SK_G1
          pg8::gemm_phase<pg8::EpiZ, StaticOrder>(ring, g, S, E, P.wave);
#endif
#ifdef DUP_G1
          pg8::gemm_phase<pg8::EpiZ, StaticOrder>(ring, g, S, E, P.wave);
#endif
        }
        PROF_END(1);
        GRID_BAR();
#if defined(SELFCHECK) && SELFCHECK == 3
        if (L == 0) { selfcheck_lru(F, L, false); __syncthreads(); }
#endif
#ifdef DUP_IDX
        indexer_phase<DUP_IDX>(F);
#endif
#ifndef SK_IDX
        indexer_phase(F);
#endif
#ifdef DUP_LRU
        lru_phase<true>(F, L);
#endif
#ifndef SK_LRU
        lru_phase(F, L);
#endif
        PROF_END(2);
        GRID_BAR();
#if defined(SELFCHECK) && SELFCHECK == 1
        if (L == 0) { selfcheck_topk(F); __syncthreads(); }
#endif
#if defined(SELFCHECK) && SELFCHECK == 3
        if (L == 0) { selfcheck_lru(F, L, true); __syncthreads(); }
#endif
#ifdef DUP_ATT
        attention_phase<DUP_ATT>(F); __syncthreads();
#endif
#ifndef SK_ATT
#ifdef ATT_V1
        attention_phase(F);
#else
        attention_phase2(F);
#endif
#endif
        PROF_END(3);
        GRID_BAR();
#if defined(SELFCHECK) && SELFCHECK == 2
        if (L == 0) { selfcheck_attn(F); __syncthreads(); }
#endif
        { const Frame P = launder(F); unsigned char* ws = P.ws; unsigned char* wb = ws + WS_W; bf16* XB = (bf16*)(ws + WS_XB); (void)XB; (void)wb;
          Gemm g{(const bf16*)(ws + Z_XR), (const bf16*)(wb + W_BRA), T_TOK, D, D}; StaticOrder S; S.init(T_TOK, D, F.G, F.bx);
          pg8::EpiGate<0> E{(bf16*)(ws + Z_GA), nullptr};
PROF_BEGIN(2);
#ifndef SK_G2
          pg8::gemm_phase<pg8::EpiGate<0>, StaticOrder>(ring, g, S, E, P.wave);
#endif
        }
        LOCAL_HANDOFF();
        { const Frame P = launder(F); unsigned char* ws = P.ws; unsigned char* wb = ws + WS_W; bf16* XB = (bf16*)(ws + WS_XB); (void)XB; (void)wb;
          Gemm g{(const bf16*)(ws + Z_YR), (const bf16*)(wb + W_BRR), T_TOK, D, D}; StaticOrder S; S.init(T_TOK, D, F.G, F.bx);
          pg8::EpiGate<1> E{(bf16*)(ws + Z_GA), (const bf16*)(ws + Z_GR)};
PROF_BEGIN(3);
#ifndef SK_G3
          pg8::gemm_phase<pg8::EpiGate<1>, StaticOrder>(ring, g, S, E, P.wave);
#endif
        }
        PROF_END(4);
        GRID_BAR();
        { const Frame P = launder(F); unsigned char* ws = P.ws; unsigned char* wb = ws + WS_W; bf16* XB = (bf16*)(ws + WS_XB); (void)XB; (void)wb;
          Gemm g{(const bf16*)(ws + Z_GA), (const bf16*)(wb + W_O), T_TOK, D, D}; StaticOrder S; S.init(T_TOK, D, F.G, F.bx);
          pg8::EpiBf16 E{(bf16*)(ws + Z_GR), D, 0};
PROF_BEGIN(4);
#ifndef SK_G4
          pg8::gemm_phase<pg8::EpiBf16, StaticOrder>(ring, g, S, E, P.wave);
#endif
#ifdef DUP_G4
          pg8::gemm_phase<pg8::EpiBf16, StaticOrder>(ring, g, S, E, P.wave);
#endif
        }
        PROF_END(5);
        GRID_BAR();
#ifdef DUP_LN
        ln_phase<false, false, true>(F, L); ln_phase<false, false, true>(F, L);
#endif
#ifndef SK_LN
        if (odd) ln_phase<false, true>(F, L); else ln_phase<false, false>(F, L);
#endif
        PROF_END(6);
        GRID_BAR();
        if (odd) {
            if (launder(F).tid == 0) { unsigned acc = 0u; F.MISC[16] = 0u;
                for (int e = 0; e < 8; ++e) { const unsigned c = __hip_atomic_load(F.ctl + CW_CNT + (L >> 1) * 1024 + 64 * e, RLX_AGENT); F.MISC[32 + e] = c; acc += (c + 255u) >> 8; F.MISC[17 + e] = acc; } }
            __syncthreads();
        }
        { const Frame P = launder(F); unsigned char* ws = P.ws; unsigned char* wb = ws + WS_W; bf16* XB = (bf16*)(ws + WS_XB); (void)XB; (void)wb;
          Gemm g{(const bf16*)(ws + F_PB), (const bf16*)(wb + W_PP), T_TOK, D, PLE}; StaticOrder S; S.init(T_TOK, D, F.G, F.bx);
          pg8::EpiBf16 E{(bf16*)(ws + F_U), D, 0};
PROF_BEGIN(5);
#ifndef SK_G5
          pg8::gemm_phase<pg8::EpiBf16, StaticOrder>(ring, g, S, E, P.wave);
#endif
        }
        LOCAL_HANDOFF();
        { const Frame P = launder(F); unsigned char* ws = P.ws; unsigned char* wb = ws + WS_W; bf16* XB = (bf16*)(ws + WS_XB); (void)XB; (void)wb;
          Gemm g{XB, (const bf16*)(wb + W_PG), T_TOK, D, D}; StaticOrder S; S.init(T_TOK, D, F.G, F.bx);
          pg8::EpiPle E{(bf16*)(ws + F_U)};
PROF_BEGIN(6);
#ifndef SK_G6
          pg8::gemm_phase<pg8::EpiPle, StaticOrder>(ring, g, S, E, P.wave);
#endif
        }
        PROF_END(7);
        if (!odd) {
            { const Frame P = launder(F); unsigned char* ws = P.ws; unsigned char* wb = ws + WS_W; bf16* XB = (bf16*)(ws + WS_XB); (void)XB; (void)wb;
          Gemm g{XB, (const bf16*)(wb + W_FF), T_TOK, 2 * DFF, D}; StaticOrder S; S.init(T_TOK, 2 * DFF, F.G, F.bx);
              pg8::EpiSwiglu E{(bf16*)(ws + F_H), DFF};
PROF_BEGIN(7);
#ifndef SK_G7
              pg8::gemm_phase<pg8::EpiSwiglu, StaticOrder>(ring, g, S, E, P.wave);
#endif
#ifdef DUP_G7
              pg8::gemm_phase<pg8::EpiSwiglu, StaticOrder>(ring, g, S, E, P.wave);
#endif
        }
            PROF_END(8);
            GRID_BAR();
            { const Frame P = launder(F); unsigned char* ws = P.ws; unsigned char* wb = ws + WS_W; bf16* XB = (bf16*)(ws + WS_XB); (void)XB; (void)wb;
          Gemm g{(const bf16*)(ws + F_H), (const bf16*)(wb + W_FF_DN_DENSE), T_TOK, D, DFF}; StaticOrder S; S.init(T_TOK, D, F.G, F.bx);
              pg8::EpiBf16 E{(bf16*)(ws + Z_GR), D, 0};
PROF_BEGIN(8);
#ifndef SK_G8
              pg8::gemm_phase<pg8::EpiBf16, StaticOrder>(ring, g, S, E, P.wave);
#endif
#ifdef DUP_G8
              pg8::gemm_phase<pg8::EpiBf16, StaticOrder>(ring, g, S, E, P.wave);
#endif
        }
            PROF_END(9);
            GRID_BAR();
#ifndef SK_LN
            ln_phase<true, false>(F, L);
#endif
        } else {
            const int ntiles = (int)F.MISC[24];
            const int nchunks = (ntiles + MOE_CHUNK_TILES - 1) / MOE_CHUNK_TILES;
            for (int c = 0; c < nchunks; ++c) {
                const int tile0 = c * MOE_CHUNK_TILES, ntl = (ntiles - tile0) < MOE_CHUNK_TILES ? (ntiles - tile0) : MOE_CHUNK_TILES;
                const size_t hc_off = (c & 1) ? F_H1 : F_H;
                { const Frame P = launder(F); unsigned char* ws = P.ws; unsigned char* wb = ws + WS_W; bf16* XB = (bf16*)(ws + WS_XB); (void)XB; (void)wb;
          Gemm g{XB, (const bf16*)(wb + W_FF), ntl * 256, 2 * DFFE, D}; MoeGatherOrder S; S.init(ntl * 256, 2 * DFFE, F.G, F.bx);
                  S.tb = F.MISC + 16; S.tile0 = tile0; S.list = (const int*)(ws + WS_LIST); S.bstride = (size_t)2 * DFFE * D * 2;
                  pg8::EpiSwiglu E{(bf16*)(ws + hc_off), DFFE};
PROF_BEGIN(9);
#ifndef SK_G9
                  pg8::gemm_phase<pg8::EpiSwiglu, MoeGatherOrder>(ring, g, S, E, P.wave);
#endif
        }
                PROF_END(10);
                GRID_BAR();
                { const Frame P = launder(F); unsigned char* ws = P.ws; unsigned char* wb = ws + WS_W; bf16* XB = (bf16*)(ws + WS_XB); (void)XB; (void)wb;
          Gemm g{(const bf16*)(ws + hc_off), (const bf16*)(wb + W_FF_DN_MOE), ntl * 256, D, DFFE}; MoeOrder S; S.init(ntl * 256, D, F.G, F.bx);
                  S.tb = F.MISC + 16; S.tile0 = tile0; S.list = nullptr; S.bstride = (size_t)D * DFFE * 2;
                  pg8::EpiBf16 E{(bf16*)(ws + F_YE), D, tile0 * 256};
PROF_BEGIN(10);
#ifndef SK_G10
                  pg8::gemm_phase<pg8::EpiBf16, MoeOrder>(ring, g, S, E, P.wave);
#endif
        }
                PROF_END(11);
            }
            PROF_END(11);
            GRID_BAR();
#ifndef SK_LN
            ln_phase<true, true>(F, L);
#endif
        }
        }
        if (L + 1 < DEPTH) { __syncthreads(); p0_convert(F, L + 1); }
        PROF_END(12);
#ifdef PROF_SEL
        if (L == DEPTH - 1 && F.bx == PROF_WG && launder(F).tid == 0) { const unsigned t_ = (unsigned)__builtin_amdgcn_s_memrealtime(); const float tot_ = (float)F.MISC[106] + (float)F.MISC[107] + (float)F.MISC[108] + (float)F.MISC[109] + (float)F.MISC[110] + (float)F.MISC[111] + (float)F.MISC[112] + (float)F.MISC[113];
            const float f_ = (PROF_SEL == 43) ? (float)F.MISC[122] / (float)F.MISC[123] : (PROF_SEL == 42) ? (float)F.MISC[120] / (float)F.MISC[121] : (PROF_SEL >= 50) ? (float)F.MISC[106 + (PROF_SEL - 50)] / tot_ : (PROF_SEL == 41) ? (float)F.MISC[105] / (float)F.MISC[104] : (PROF_SEL == 40) ? (float)F.MISC[104] / (float)F.MISC[64 + 14] * (1.0f / 40.0f) : PROF_MUL * (float)F.MISC[64 + PROF_SEL] / (float)(t_ - F.MISC[98]);
            const float g_ = (PROF_SEL < 40 && PROF_SEL2 < 40) ? PROF_MUL * (float)F.MISC[64 + PROF_SEL2] / (float)(t_ - F.MISC[98]) : (PROF_SEL == 43) ? (float)F.MISC[124] / (64.0f * 8.0f * 32.0f * 4.0f) : (PROF_SEL >= 50) ? (float)F.MISC[106 + (PROF_SEL2 - 50)] / tot_ : 0.0f;
            __hip_atomic_store(F.ctl + 9, __builtin_bit_cast(unsigned, g_), __ATOMIC_RELAXED, __HIP_MEMORY_SCOPE_AGENT);
            __hip_atomic_store(F.ctl + 8, __builtin_bit_cast(unsigned, f_), __ATOMIC_RELAXED, __HIP_MEMORY_SCOPE_AGENT); }
#endif
        GRID_BAR();
    }
#ifdef PROF_SEL
    { const float f_ = __builtin_bit_cast(float, __hip_atomic_load(F.ctl + 8, RLX_AGENT)); const float s_ = 1.0f + floorf(sqrtf(f_) * 32.0f + 0.5f) * (1.0f / 32.0f);
      for (size_t i = (size_t)F.bx * 512 + launder(F).tid; i < (size_t)T_TOK * D; i += (size_t)F.G * 512) X32[i] *= s_;
      const float g_ = __builtin_bit_cast(float, __hip_atomic_load(F.ctl + 9, RLX_AGENT)); if (F.bx == 0 && launder(F).tid == 0 && g_ > 0.f) X32[0] = 400.0f * floorf(g_ * 32.0f + 0.5f) * (1.0f / 32.0f); }
#endif
    if (__hip_atomic_load(F.ctl + CW_BAR + XB_TMO, RLX_AGENT) != 0u || __hip_atomic_load(F.ctl + CW_CODE, RLX_AGENT) != 0u) {
        const float q = __builtin_nanf("");
        for (size_t i = (size_t)F.bx * 512 + launder(F).tid; i < (size_t)T_TOK * D; i += (size_t)F.G * 512) X32[i] = q;
    }
}

#if defined(SELFCHECK)
constexpr size_t WS_DRY_EXTRA = 4 * MiB;
#elif defined(DUP_LRU) || defined(DUP_LN)
constexpr size_t WS_DRY_EXTRA = 80 * MiB;
#else
constexpr size_t WS_DRY_EXTRA = 0;
#endif
extern "C" void kernel_launch(void* const* d_in, const int* in_sizes, int n_in, void* d_out, int out_size, void* d_ws, size_t ws_size, hipStream_t stream) {
    static int grid = 0;
    if (grid == 0) {
        if (n_in != 28 || out_size != T_TOK * D || ws_size < WS_NEED + WS_DRY_EXTRA) { fprintf(stderr, "kernel_launch: unexpected shapes: n_in %d out %d ws %zu (need %zu)\n", n_in, out_size, ws_size, (size_t)WS_END); grid = -1; return; }
        int dev = 0, cus = 0, per_cu = 0;
        if (hipGetDevice(&dev) != hipSuccess || hipDeviceGetAttribute(&cus, hipDeviceAttributeMultiprocessorCount, dev) != hipSuccess) { grid = -1; return; }
        if (hipFuncSetAttribute((const void*)mk_fwd, hipFuncAttributeMaxDynamicSharedMemorySize, LDS_BYTES) != hipSuccess) { fprintf(stderr, "kernel_launch: hipFuncSetAttribute failed\n"); grid = -1; return; }
        if (hipOccupancyMaxActiveBlocksPerMultiprocessor(&per_cu, (const void*)mk_fwd, NWAVES * 64, LDS_BYTES) != hipSuccess || per_cu < 1) { fprintf(stderr, "kernel_launch: occupancy query says %d blocks per CU\n", per_cu); }
        (void)hipGetLastError();
        grid = cus;
        if (grid != 256) { fprintf(stderr, "kernel_launch: this kernel needs a 256-CU device (got %d)\n", cus); grid = -1; return; }
    }
    if (grid < 0) return;
    if (hipMemsetAsync((char*)d_ws + WS_CTL, 0, CTL_ZERO_BYTES, stream) != hipSuccess) return;
    Args a{};
    for (int i = 0; i < 28; ++i) a.in[i] = (const float*)d_in[i];
    a.out = (float*)d_out; a.ws = (unsigned char*)d_ws;
    hipLaunchKernelGGL(mk_fwd, dim3(grid), dim3(NWAVES * 64), LDS_BYTES, stream, a);
}
```

```cpp
#include <hip/hip_runtime.h>
#include <cstdio>
#include <cstdint>

constexpr int T_TOK = 65536, D = 1024, SEQ = 2048, NBATCH = 32, DEPTH = 4;
constexpr int D_IN = 5832, NIN = 5888;
constexpr int DFF = 2816, DFFE = 3584, NEXP = 8, PLE = 256;
constexpr float LN_EPS = 1e-5f;
constexpr float DN_ALPHA = 1.681792830507429f;

namespace pg8 {
#define PG8_LAS __attribute__((address_space(3)))
typedef unsigned short bf16_t;
typedef short bf16x8 __attribute__((ext_vector_type(8)));
typedef float f32x4 __attribute__((ext_vector_type(4)));
typedef unsigned u32x4 __attribute__((ext_vector_type(4)));
typedef unsigned u32x2 __attribute__((ext_vector_type(2)));
constexpr int BM = 256, BK = 64, HALF = 128, HTB = HALF * BK * 2  , STAGE_BYTES = 8 * HTB, NXCD = 8, WGM = 8;

__host__ __device__ __forceinline__ int lds_byte(int r, int c) { const int st = (r >> 4) * 2 + (c >> 5), rr = r & 15, cc = c & 31, ob = rr * 64 + cc * 2; return st * 1024 + (ob ^ (((ob >> 9) & 1) << 5)); }
__host__ __device__ __forceinline__ void stage_rc(int b, int& R, int& C) { const int st = b / 1024, sb = b % 1024, swz = sb ^ (((sb >> 9) & 1) << 5); R = (st >> 1) * 16 + swz / 64; C = (st & 1) * 32 + (swz % 64) / 2; }
__host__ __device__ __forceinline__ int perm32(int rho) { const int n = rho >> 4, i = rho & 15; return 8 * (i >> 2) + 4 * n + (i & 3); }

struct Unit { int pm, pn; };
struct Gemm { const bf16_t* A; const bf16_t* Bt; int M, N, K; };

struct StaticOrder {
    static constexpr bool GATHER = false;
    int nM, nN, nwg, G, c;
    __host__ __device__ void init(int M, int N, int G_, int c_) { nM = M / BM; nN = N / BM; nwg = nM * nN; G = G_; c = c_; }
    __host__ __device__ bool next(int i, Unit& u) const {
        const long L = (long)i * G + c; if (L >= nwg) return false;
        int wgid = (int)L; { const int q = nwg / NXCD, r = nwg % NXCD, xcd = wgid % NXCD, off = wgid / NXCD; wgid = (xcd < r ? xcd * (q + 1) : r * (q + 1) + (xcd - r) * q) + off; }
        const int nig = WGM * nN, gid = wgid / nig, fm = gid * WGM, gsz = (nM - fm) < WGM ? (nM - fm) : WGM;
        u.pm = fm + ((wgid % nig) % gsz); u.pn = (wgid % nig) / gsz; return true;
    }
    __device__ __forceinline__ const char* a_base(const Gemm& g, const Unit& u, size_t tstep) const { return (const char*)g.A + (size_t)u.pm * tstep; }
    __device__ __forceinline__ const char* b_base(const Gemm& g, const Unit& u, size_t tstep) const { return (const char*)g.Bt + (size_t)u.pn * tstep; }
    __device__ __forceinline__ void a_rows(const Unit&, int, int, int, int, int, unsigned (&)[2][2]) const {}
    __device__ __forceinline__ void a_ready(const Unit&) const {}
    __device__ __forceinline__ void done(const Unit&) const {}
};

__device__ __forceinline__ unsigned cvt_pk_bf16(float lo, float hi) { unsigned r; asm volatile("v_cvt_pk_bf16_f32 %0, %1, %2" : "=v"(r) : "v"(lo), "v"(hi)); return r; }
__device__ __forceinline__ float bf_lo(unsigned w) { return __builtin_bit_cast(float, w << 16); }
__device__ __forceinline__ float bf_hi(unsigned w) { return __builtin_bit_cast(float, w & 0xffff0000u); }
__device__ __forceinline__ float sigmoidf_fast(float x) { return __builtin_amdgcn_rcpf(1.0f + __builtin_amdgcn_exp2f(-1.4426950408889634f * x)); }
#define EPI_FENCE() asm volatile("" ::: "memory")
#define EGAS __attribute__((address_space(1)))
__device__ __forceinline__ u32x4 pack8(const f32x4 v0, const f32x4 v1) { u32x4 w; w.x = cvt_pk_bf16(v0[0], v0[1]); w.y = cvt_pk_bf16(v0[2], v0[3]); w.z = cvt_pk_bf16(v1[0], v1[1]); w.w = cvt_pk_bf16(v1[2], v1[3]); return w; }

struct EpiBf16 {
    static constexpr bool PERM = true, AFTER_DRAIN = false;
    bf16_t* O; int ldc; int row_off;
    __device__ __forceinline__ void operator()(const f32x4 (&acc)[2][2][4][2], const Unit& u, int wr, int wc, int fr, int fq) const {
        { int l_ = (int)__builtin_amdgcn_mbcnt_hi(~0u, __builtin_amdgcn_mbcnt_lo(~0u, 0u)); asm volatile("" : "+v"(l_)); fr = l_ & 15; fq = l_ >> 4; }
        const int row0 = row_off + u.pm * BM + wr * 64 + fr, col0 = u.pn * BM + wc * 32 + 8 * fq;
#pragma unroll
        for (int ai = 0; ai < 2; ++ai)
#pragma unroll
            for (int m = 0; m < 4; ++m) { bf16_t* rowp = O + (size_t)(row0 + ai * HALF + m * 16) * ldc + col0;
#pragma unroll
                for (int bj = 0; bj < 2; ++bj) *(EGAS u32x4*)(rowp + bj * HALF) = pack8(acc[ai][bj][m][0], acc[ai][bj][m][1]); }
    }
};
__device__ __forceinline__ u32x2 pack8_fp8(const f32x4 v0, const f32x4 v1) { int a = __builtin_amdgcn_cvt_pk_fp8_f32(v0[0], v0[1], 0, false); a = __builtin_amdgcn_cvt_pk_fp8_f32(v0[2], v0[3], a, true);
    int b = __builtin_amdgcn_cvt_pk_fp8_f32(v1[0], v1[1], 0, false); b = __builtin_amdgcn_cvt_pk_fp8_f32(v1[2], v1[3], b, true); u32x2 r; r.x = (unsigned)a; r.y = (unsigned)b; return r; }
struct EpiZ {
    static constexpr bool PERM = true, AFTER_DRAIN = false;
    bf16_t* zbig; bf16_t* zqi; bf16_t* zsm; unsigned char* q8; unsigned char* kv8;
    __device__ __forceinline__ void operator()(const f32x4 (&acc)[2][2][4][2], const Unit& u, int wr, int wc, int fr, int fq) const {
        { int l_ = (int)__builtin_amdgcn_mbcnt_hi(~0u, __builtin_amdgcn_mbcnt_lo(~0u, 0u)); asm volatile("" : "+v"(l_)); fr = l_ & 15; fq = l_ >> 4; }
        const int row0 = u.pm * BM + wr * 64 + fr;
        if (u.pn < 4) {
            const int col0 = u.pn * BM + wc * 32 + 8 * fq;
#pragma unroll
            for (int ai = 0; ai < 2; ++ai)
#pragma unroll
                for (int m = 0; m < 4; ++m) { unsigned char* rowp = q8 + (size_t)(row0 + ai * HALF + m * 16) * D + col0;
#pragma unroll
                    for (int bj = 0; bj < 2; ++bj) *(EGAS u32x2*)(rowp + bj * HALF) = pack8_fp8(acc[ai][bj][m][0], acc[ai][bj][m][1]); }
            return;
        }
        bf16_t* base; int ld, colt;
        if (u.pn < 20) { base = zbig + (size_t)(u.pn >> 2) * ((size_t)T_TOK * D); ld = D; colt = (u.pn & 3) * BM; }
        else if (u.pn < 22) { base = zqi; ld = 512; colt = (u.pn - 20) * BM; }
        else { base = zsm; ld = 256; colt = 0; }
        const int col0 = colt + wc * 32 + 8 * fq;
#pragma unroll
        for (int ai = 0; ai < 2; ++ai)
#pragma unroll
            for (int m = 0; m < 4; ++m) { bf16_t* rowp = base + (size_t)(row0 + ai * HALF + m * 16) * ld + col0;
#pragma unroll
                for (int bj = 0; bj < 2; ++bj) *(EGAS u32x4*)(rowp + bj * HALF) = pack8(acc[ai][bj][m][0], acc[ai][bj][m][1]); }
        if (u.pn == 22) {
#pragma unroll
            for (int ai = 0; ai < 2; ++ai)
#pragma unroll
                for (int m = 0; m < 4; ++m) *(EGAS u32x2*)(kv8 + (size_t)(row0 + ai * HALF + m * 16) * 128 + wc * 32 + 8 * fq) = pack8_fp8(acc[ai][0][m][0], acc[ai][0][m][1]);
        }
    }
};
template <int MODE> struct EpiGate {
    static constexpr bool PERM = true, AFTER_DRAIN = false;
    bf16_t* G; const bf16_t* G2;
    __device__ __forceinline__ void operator()(const f32x4 (&acc)[2][2][4][2], const Unit& u, int wr, int wc, int fr, int fq) const {
        { int l_ = (int)__builtin_amdgcn_mbcnt_hi(~0u, __builtin_amdgcn_mbcnt_lo(~0u, 0u)); asm volatile("" : "+v"(l_)); fr = l_ & 15; fq = l_ >> 4; }
        const int row0 = u.pm * BM + wr * 64 + fr, col0 = u.pn * BM + wc * 32 + 8 * fq;
#pragma unroll
        for (int ai = 0; ai < 2; ++ai) {
            u32x4 gw[4][2], g2[4][2];
#pragma unroll
            for (int m = 0; m < 4; ++m)
#pragma unroll
                for (int bj = 0; bj < 2; ++bj) { const size_t o = (size_t)(row0 + ai * HALF + m * 16) * D + col0 + bj * HALF;
                    gw[m][bj] = *(const EGAS u32x4*)(G + o); if (MODE == 1) g2[m][bj] = *(const EGAS u32x4*)(G2 + o); }
#pragma unroll
            for (int m = 0; m < 4; ++m)
#pragma unroll
                for (int bj = 0; bj < 2; ++bj) { const size_t o = (size_t)(row0 + ai * HALF + m * 16) * D + col0 + bj * HALF;
                    f32x4 v0 = acc[ai][bj][m][0], v1 = acc[ai][bj][m][1];
#pragma unroll
                    for (int j = 0; j < 4; ++j) { const unsigned wa = gw[m][bj][j >> 1], wb = gw[m][bj][2 + (j >> 1)];
                        const float ga = (j & 1) ? bf_hi(wa) : bf_lo(wa), gb = (j & 1) ? bf_hi(wb) : bf_lo(wb);
                        if (MODE == 0) { v0[j] *= sigmoidf_fast(ga); v1[j] *= sigmoidf_fast(gb); }
                        else { const unsigned xa = g2[m][bj][j >> 1], xb = g2[m][bj][2 + (j >> 1)];
                            v0[j] = ga + v0[j] * sigmoidf_fast((j & 1) ? bf_hi(xa) : bf_lo(xa)); v1[j] = gb + v1[j] * sigmoidf_fast((j & 1) ? bf_hi(xb) : bf_lo(xb)); } }
                    *(EGAS u32x4*)(G + o) = pack8(v0, v1); }
            EPI_FENCE(); }
    }
};
template <int MODE> struct EpiRes {
    static constexpr bool PERM = true, AFTER_DRAIN = false;
    float* Y; const bf16_t* XB; const bf16_t* U;
    __device__ __forceinline__ void operator()(const f32x4 (&acc)[2][2][4][2], const Unit& u, int wr, int wc, int fr, int fq) const {
        { int l_ = (int)__builtin_amdgcn_mbcnt_hi(~0u, __builtin_amdgcn_mbcnt_lo(~0u, 0u)); asm volatile("" : "+v"(l_)); fr = l_ & 15; fq = l_ >> 4; }
        const int row0 = u.pm * BM + wr * 64 + fr, col0 = u.pn * BM + wc * 32 + 8 * fq;
#pragma unroll
        for (int ai = 0; ai < 2; ++ai) {
            u32x4 xw[4][2], uw[4][2];
#pragma unroll
            for (int m = 0; m < 4; ++m)
#pragma unroll
                for (int bj = 0; bj < 2; ++bj) { const size_t o = (size_t)(row0 + ai * HALF + m * 16) * D + col0 + bj * HALF;
                    xw[m][bj] = *(const EGAS u32x4*)(XB + o);
                    if (MODE == 1) uw[m][bj] = *(const EGAS u32x4*)(U + o); }
#pragma unroll
            for (int m = 0; m < 4; ++m)
#pragma unroll
                for (int bj = 0; bj < 2; ++bj) { const size_t o = (size_t)(row0 + ai * HALF + m * 16) * D + col0 + bj * HALF;
#pragma unroll
                    for (int n = 0; n < 2; ++n) { const f32x4 a = acc[ai][bj][m][n]; f32x4 r;
                        if (MODE == 0) { const unsigned x0 = xw[m][bj][2 * n], x1 = xw[m][bj][2 * n + 1];
                            r[0] = bf_lo(x0) * DN_ALPHA + a[0]; r[1] = bf_hi(x0) * DN_ALPHA + a[1]; r[2] = bf_lo(x1) * DN_ALPHA + a[2]; r[3] = bf_hi(x1) * DN_ALPHA + a[3]; }
                        else { const unsigned x0 = xw[m][bj][2 * n], x1 = xw[m][bj][2 * n + 1], w0 = uw[m][bj][2 * n], w1 = uw[m][bj][2 * n + 1];
                            r[0] = bf_lo(x0) * DN_ALPHA + bf_lo(w0) + a[0]; r[1] = bf_hi(x0) * DN_ALPHA + bf_hi(w0) + a[1];
                            r[2] = bf_lo(x1) * DN_ALPHA + bf_lo(w1) + a[2]; r[3] = bf_hi(x1) * DN_ALPHA + bf_hi(w1) + a[3]; }
                        *(EGAS f32x4*)(Y + o + 4 * n) = r; } }
            EPI_FENCE(); }
    }
};
struct EpiPle {
    static constexpr bool PERM = true, AFTER_DRAIN = false;
    bf16_t* U;
    __device__ __forceinline__ void operator()(const f32x4 (&acc)[2][2][4][2], const Unit& u, int wr, int wc, int fr, int fq) const {
        { int l_ = (int)__builtin_amdgcn_mbcnt_hi(~0u, __builtin_amdgcn_mbcnt_lo(~0u, 0u)); asm volatile("" : "+v"(l_)); fr = l_ & 15; fq = l_ >> 4; }
        const int row0 = u.pm * BM + wr * 64 + fr, col0 = u.pn * BM + wc * 32 + 8 * fq;
#pragma unroll
        for (int ai = 0; ai < 2; ++ai) {
            u32x4 uw[4][2];
#pragma unroll
            for (int m = 0; m < 4; ++m)
#pragma unroll
                for (int bj = 0; bj < 2; ++bj) uw[m][bj] = *(const EGAS u32x4*)(U + (size_t)(row0 + ai * HALF + m * 16) * D + col0 + bj * HALF);
#pragma unroll
            for (int m = 0; m < 4; ++m)
#pragma unroll
                for (int bj = 0; bj < 2; ++bj) { f32x4 v0 = acc[ai][bj][m][0], v1 = acc[ai][bj][m][1];
#pragma unroll
                    for (int j = 0; j < 4; ++j) { const unsigned wa = uw[m][bj][j >> 1], wb = uw[m][bj][2 + (j >> 1)];
                        v0[j] = sigmoidf_fast(v0[j]) * ((j & 1) ? bf_hi(wa) : bf_lo(wa)); v1[j] = sigmoidf_fast(v1[j]) * ((j & 1) ? bf_hi(wb) : bf_lo(wb)); }
                    *(EGAS u32x4*)(U + (size_t)(row0 + ai * HALF + m * 16) * D + col0 + bj * HALF) = pack8(v0, v1); }
            EPI_FENCE(); }
    }
};
struct EpiSwiglu {
    static constexpr bool PERM = true, AFTER_DRAIN = false;
    bf16_t* H; int ldh;
    __device__ __forceinline__ void operator()(const f32x4 (&acc)[2][2][4][2], const Unit& u, int wr, int wc, int fr, int fq) const {
        { int l_ = (int)__builtin_amdgcn_mbcnt_hi(~0u, __builtin_amdgcn_mbcnt_lo(~0u, 0u)); asm volatile("" : "+v"(l_)); fr = l_ & 15; fq = l_ >> 4; }
        const int row0 = u.pm * BM + wr * 64 + fr, col0 = u.pn * HALF + wc * 32 + 8 * fq;
#pragma unroll
        for (int ai = 0; ai < 2; ++ai)
#pragma unroll
            for (int m = 0; m < 4; ++m) { bf16_t* rowp = H + (size_t)(row0 + ai * HALF + m * 16) * ldh + col0;
                f32x4 v0, v1;
#pragma unroll
                for (int j = 0; j < 4; ++j) { const float g0 = acc[ai][0][m][0][j], g1 = acc[ai][0][m][1][j];
                    v0[j] = g0 * sigmoidf_fast(g0) * acc[ai][1][m][0][j]; v1[j] = g1 * sigmoidf_fast(g1) * acc[ai][1][m][1][j]; }
                *(EGAS u32x4*)rowp = pack8(v0, v1); }
    }
};
template <class Epi, class Sched, bool ALIGN_EPI = true>
__device__ __forceinline__ void gemm_phase(PG8_LAS unsigned char* lds, const Gemm g, const Sched& S, const Epi& E, const int wave_id) {
    int lane_ = (int)__builtin_amdgcn_mbcnt_hi(~0u, __builtin_amdgcn_mbcnt_lo(~0u, 0u)); asm volatile("" : "+v"(lane_));
    const int wid = wave_id, lane = lane_, tid = wid * 64 + lane, wr = wid >> 2, wc = wid & 3, fr = lane & 15, fq = lane >> 4;
    const int K = g.K, nt = K / BK;
    unsigned voffA[2], voffB[2]; int RA[2], CA[2];
#pragma unroll
    for (int i = 0; i < 2; ++i) { int R, C; stage_rc(tid * 16 + i * 8192, R, C); const int Rb = Epi::PERM ? ((R & ~31) + perm32(R & 31)) : R; RA[i] = R; CA[i] = C;
        voffA[i] = (unsigned)(R * K + C) * 2u; voffB[i] = (unsigned)(Rb * K + C) * 2u; }
    const size_t kstep = (size_t)(BK * 2);
    const size_t hstep = (size_t)HALF * K * 2;
    const size_t tstep = 2 * hstep;
    const unsigned ldsw = (unsigned)wid * 1024u;
    const int aoff = lds_byte(wr * 64 + fr, fq * 8), boff = lds_byte(wc * 32 + fr, fq * 8);
    unsigned offC[2][2] = {{0u, 0u}, {0u, 0u}}, offN[2][2] = {{0u, 0u}, {0u, 0u}};
#define PG8_SA(b, h) (((b) * 2 + (h)) * HTB)
#define PG8_SB(b, h) ((4 + (b) * 2 + (h)) * HTB)
#define PG8_STAGE(bufoff, gbase, voff) do { _Pragma("unroll") for (int _i = 0; _i < 2; ++_i) \
        __builtin_amdgcn_global_load_lds((const unsigned*)((const char*)(gbase) + (voff)[_i]), (PG8_LAS unsigned*)(lds + (bufoff) + ldsw + _i * 8192), 16, 0, 0); } while (0)
#define PG8_STA(bufoff, ptr, h, NX) do { if constexpr (Sched::GATHER) { _Pragma("unroll") for (int _i = 0; _i < 2; ++_i) { const unsigned _o = (NX) ? offN[h][_i] : offC[h][_i]; \
        __builtin_amdgcn_global_load_lds((const unsigned*)((const char*)(ptr) + _o), (PG8_LAS unsigned*)(lds + (bufoff) + ldsw + _i * 8192), 16, 0, 0); } } \
        else { PG8_STAGE(bufoff, (ptr) + (h) * hstep, voffA); } } while (0)
#define PG8_LDA(dst, b, h) do { _Pragma("unroll") for (int m = 0; m < 4; ++m) _Pragma("unroll") for (int k = 0; k < 2; ++k) dst[m][k] = *(const PG8_LAS bf16x8*)(lds + PG8_SA(b, h) + aoff + m * 2048 + k * 1024); } while (0)
#define PG8_LDB(dst, b, h) do { _Pragma("unroll") for (int n = 0; n < 2; ++n) _Pragma("unroll") for (int k = 0; k < 2; ++k) dst[n][k] = *(const PG8_LAS bf16x8*)(lds + PG8_SB(b, h) + boff + n * 2048 + k * 1024); } while (0)
#define PG8_MMA(ai, bj, At, Bt) do { __builtin_amdgcn_s_setprio(1); _Pragma("unroll") for (int m = 0; m < 4; ++m) _Pragma("unroll") for (int n = 0; n < 2; ++n) _Pragma("unroll") for (int k = 0; k < 2; ++k) \
        acc[ai][bj][m][n] = __builtin_amdgcn_mfma_f32_16x16x32_bf16(Bt[n][k], At[m][k], acc[ai][bj][m][n], 0, 0, 0); __builtin_amdgcn_s_setprio(0); } while (0)
#define PG8_WAIT_V(n) asm volatile("s_waitcnt vmcnt(" #n ")" ::: "memory")
#define PG8_WAIT_L(n) asm volatile("s_waitcnt lgkmcnt(" #n ")" ::: "memory")
#define PG8_BAR __builtin_amdgcn_s_barrier()
#define PG8_SCHED __builtin_amdgcn_sched_barrier(0)
#ifdef PROF_SEL
#ifndef PROF_KPH
#define PROF_KPH 0
#endif
#define PG8_PROF(slot) do { if (tid == 0) { volatile PG8_LAS unsigned* M_ = (volatile PG8_LAS unsigned*)(lds + 131392); const unsigned t_ = (unsigned)__builtin_amdgcn_s_memrealtime(); const unsigned c_ = (unsigned)__builtin_amdgcn_s_memtime(); if (PROF_KPH == 0 || M_[101] == PROF_KPH) { M_[64 + (slot)] += t_ - M_[97]; if ((slot) == 14) M_[104] += c_ - M_[103]; } M_[97] = t_; M_[103] = c_; } } while (0)
#else
#define PG8_PROF(slot) do { } while (0)
#endif
#ifdef PROF_SEL
#define PG8_WAIT_VT(n) do { unsigned long long a_, b_; asm volatile("s_memtime %0\n\ts_waitcnt vmcnt(" #n ")\n\ts_memtime %1\n\ts_waitcnt lgkmcnt(0)" : "=s"(a_), "=s"(b_) :: "memory"); if (tid == 0) { volatile PG8_LAS unsigned* M_ = (volatile PG8_LAS unsigned*)(lds + 131392); M_[105] += (unsigned)b_ - (unsigned)a_; } } while (0)
#else
#define PG8_WAIT_VT(n) PG8_WAIT_V(n)
#endif
    Unit cur, nxt; int ui = 0;
    if (!S.next(0, cur)) return;
    f32x4 acc[2][2][4][2];
#pragma unroll
    for (int a = 0; a < 2; ++a)
#pragma unroll
        for (int b = 0; b < 2; ++b)
#pragma unroll
            for (int m = 0; m < 4; ++m)
#pragma unroll
                for (int n = 0; n < 2; ++n) acc[a][b][m][n] = (f32x4){0.f, 0.f, 0.f, 0.f};
    bf16x8 At[4][2], B0[2][2], B1[2][2];
    const char* cA = S.a_base(g, cur, tstep); const char* cB = S.b_base(g, cur, tstep);
    if constexpr (Sched::GATHER) S.a_rows(cur, RA[0], RA[1], CA[0], CA[1], K, offC);
    S.a_ready(cur);
    PG8_STAGE(PG8_SB(0, 0), cB, voffB); PG8_STAGE(PG8_SB(0, 1), cB + hstep, voffB); PG8_STA(PG8_SA(0, 0), cA, 0, false); PG8_STA(PG8_SA(0, 1), cA, 1, false);
    if (wr == 1) PG8_BAR;
    PG8_WAIT_V(2); PG8_BAR;
    PG8_STAGE(PG8_SB(1, 0), cB + kstep, voffB); PG8_STA(PG8_SA(1, 0), cA + kstep, 0, false); PG8_STAGE(PG8_SB(1, 1), cB + hstep + kstep, voffB);
    PG8_WAIT_V(6); PG8_BAR;
    PG8_PROF(17);
    for (;;) {
        const bool has_next = S.next(ui + 1, nxt);
        const char* nA = has_next ? S.a_base(g, nxt, tstep) : cA; const char* nB = has_next ? S.b_base(g, nxt, tstep) : cB;
        if constexpr (Sched::GATHER) { if (has_next) S.a_rows(nxt, RA[0], RA[1], CA[0], CA[1], K, offN); else {
#pragma unroll
            for (int h = 0; h < 2; ++h)
#pragma unroll
                for (int i = 0; i < 2; ++i) offN[h][i] = offC[h][i]; } }
        for (int t = 0; t < nt; t += 2) {
            const bool last = (t == nt - 2);
            const char* a1 = cA + (size_t)(t + 1) * kstep;
            const char* a2 = last ? nA : cA + (size_t)(t + 2) * kstep; const char* b2 = last ? nB : cB + (size_t)(t + 2) * kstep;
            const char* a3 = a2 + kstep; const char* b3 = b2 + kstep;
            if (last && has_next) S.a_ready(nxt);
            PG8_LDB(B0, 0, 0); PG8_LDB(B1, 0, 1); PG8_SCHED; PG8_LDA(At, 0, 0); PG8_STA(PG8_SA(1, 1), a1, 1, false);
            PG8_WAIT_VT(8); PG8_WAIT_L(0); PG8_BAR; PG8_MMA(0, 0, At, B0); PG8_MMA(0, 1, At, B1); PG8_BAR; PG8_SCHED;
            PG8_LDA(At, 0, 1); PG8_STAGE(PG8_SB(0, 0), b2, voffB); PG8_STAGE(PG8_SB(0, 1), b2 + hstep, voffB); PG8_STA(PG8_SA(0, 0), a2, 0, last);
            PG8_WAIT_VT(8); PG8_WAIT_L(0); PG8_BAR; PG8_MMA(1, 0, At, B0); PG8_MMA(1, 1, At, B1); PG8_BAR; PG8_SCHED;
            PG8_LDB(B0, 1, 0); PG8_LDB(B1, 1, 1); PG8_SCHED; PG8_LDA(At, 1, 0); PG8_STA(PG8_SA(0, 1), a2, 1, last);
            PG8_WAIT_VT(8); PG8_WAIT_L(0); PG8_BAR; PG8_MMA(0, 0, At, B0); PG8_MMA(0, 1, At, B1); PG8_BAR; PG8_SCHED;
            PG8_LDA(At, 1, 1); PG8_STAGE(PG8_SB(1, 0), b3, voffB); PG8_STAGE(PG8_SB(1, 1), b3 + hstep, voffB); PG8_STA(PG8_SA(1, 0), a3, 0, last);
            PG8_WAIT_VT(8); PG8_WAIT_L(0); PG8_BAR; PG8_MMA(1, 0, At, B0); PG8_MMA(1, 1, At, B1); PG8_BAR; PG8_SCHED;
        }
        if constexpr (ALIGN_EPI) { if (wr == 0) PG8_BAR; }
        PG8_PROF(14);
        E(acc, cur, wr, wc, fr, fq); S.done(cur);
        PG8_PROF(15);
        if (!has_next) break;
#pragma unroll
        for (int a = 0; a < 2; ++a)
#pragma unroll
            for (int b = 0; b < 2; ++b)
#pragma unroll
                for (int m = 0; m < 4; ++m)
#pragma unroll
                    for (int n = 0; n < 2; ++n) acc[a][b][m][n] = (f32x4){0.f, 0.f, 0.f, 0.f};
        cur = nxt; cA = nA; cB = nB; ++ui;
        if constexpr (Sched::GATHER) {
#pragma unroll
            for (int h = 0; h < 2; ++h)
#pragma unroll
                for (int i = 0; i < 2; ++i) offC[h][i] = offN[h][i]; }
        if constexpr (ALIGN_EPI) { if (wr == 1) PG8_BAR; }
    }
    PG8_WAIT_V(0);
    if constexpr (!ALIGN_EPI) { if (wr == 0) PG8_BAR; }
    PG8_BAR;
#undef PG8_PROF
#undef PG8_WAIT_VT
#undef PG8_SA
#undef PG8_SB
#undef PG8_STAGE
#undef PG8_STA
#undef PG8_LDA
#undef PG8_LDB
#undef PG8_MMA
#undef PG8_WAIT_V
#undef PG8_WAIT_L
#undef PG8_BAR
#undef PG8_SCHED
}
}
constexpr int NWAVES = 8;
constexpr size_t MiB = 1u << 20;
constexpr size_t WS_CTL = 0, CTL_ZERO_BYTES = 1 * MiB;
constexpr size_t WS_ROUTE = 1 * MiB;
constexpr size_t WS_LIST = 3 * MiB;
constexpr size_t WS_W = 8 * MiB;
constexpr size_t W_IN = 0, W_BRA = 12 * MiB, W_BRR = 14 * MiB, W_O = 16 * MiB, W_PG = 18 * MiB, W_PP = 20 * MiB, W_LRU = 21 * MiB, W_FF = 22 * MiB;
constexpr size_t W_FF_DN_DENSE = W_FF + 11 * MiB, W_FF_DN_MOE = W_FF + 112 * MiB;
constexpr size_t WS_XB = 208 * MiB;
constexpr size_t WS_IDX = 336 * MiB;
constexpr size_t WS_Z = 368 * MiB;
constexpr size_t Z_Q = WS_Z, Z_XR = WS_Z + 128 * MiB, Z_YR = WS_Z + 256 * MiB, Z_GA = WS_Z + 384 * MiB, Z_GR = WS_Z + 512 * MiB, Z_QI = WS_Z + 640 * MiB, Z_SM = WS_Z + 704 * MiB;
constexpr size_t Z_Q8 = Z_Q, Z_KV8 = Z_Q + 64 * MiB;
constexpr size_t WS_END = WS_Z + 736 * MiB;
constexpr size_t F_U = Z_Q;
constexpr size_t F_PB = Z_SM;
constexpr size_t F_H = Z_XR;
constexpr size_t F_H1 = WS_END;
constexpr size_t F_YE = Z_GA;
constexpr int MOE_CHUNK_TILES = 128;
constexpr size_t F_H_CHUNK_BYTES = (size_t)MOE_CHUNK_TILES * 256 * DFFE * 2;
constexpr size_t WS_NEED = F_H1 + F_H_CHUNK_BYTES;
static_assert(F_H + F_H_CHUNK_BYTES <= F_YE && F_YE + (size_t)520 * 256 * D * 2 <= Z_SM && F_H + (size_t)T_TOK * DFF * 2 <= Z_GR, "overlay map");
constexpr int CW_TMO = 0, CW_CODE = 1, CW_BAR = 4096, CW_CNT = 16384;
constexpr int RING_OFF = 0, RING_BYTES = 131072;
constexpr int LDSCTL_OFF = RING_BYTES, MISC_OFF = LDSCTL_OFF + 320;
constexpr int LDS_BYTES = 157696;

#define GAS __attribute__((address_space(1)))
#define LAS __attribute__((address_space(3)))
typedef unsigned short bf16;
typedef unsigned v4u __attribute__((ext_vector_type(4)));
typedef unsigned v2u __attribute__((ext_vector_type(2)));
typedef float f32x4 __attribute__((ext_vector_type(4)));
typedef float f32x16 __attribute__((ext_vector_type(16)));
typedef short bf16x8 __attribute__((ext_vector_type(8)));
typedef GAS unsigned gu32;
#define RLX_AGENT __ATOMIC_RELAXED, __HIP_MEMORY_SCOPE_AGENT
#define LDS_WAIT() asm volatile("s_waitcnt lgkmcnt(0)" ::: "memory")
#define VM_WAIT() asm volatile("s_waitcnt vmcnt(0)" ::: "memory")
using pg8::cvt_pk_bf16; using pg8::bf_lo; using pg8::bf_hi; using pg8::sigmoidf_fast;
#define XB_TMO      128
#define XB_XCNT(j)  (256  + 64 * (j))
#define XB_XSUB(j)  (1280 + 64 * (j))
#define XB_XGEN(j)  (2304 + 64 * (j))
#define XB_TOP      3328
#define XB_TOPGEN   3392
#define XCD_BAR_WORDS 3456
#define XB_SPIN_CAP (1u << 21)

__device__ __forceinline__ unsigned xb_ld(unsigned* p)              { return __hip_atomic_load(p, __ATOMIC_RELAXED, __HIP_MEMORY_SCOPE_AGENT); }
__device__ __forceinline__ unsigned xb_add(unsigned* p, unsigned v) { return __hip_atomic_fetch_add(p, v, __ATOMIC_RELAXED, __HIP_MEMORY_SCOPE_AGENT); }
__device__ __forceinline__ unsigned xb_xcc_id() { return (unsigned)__builtin_amdgcn_s_getreg((3 << 11) | 20) & 0xFu; }
#define XB_SPIN(cond, bar) do { unsigned _sp = 0; while (cond) { __builtin_amdgcn_s_sleep(1); \
    if ((++_sp & 255u) == 0u) { if (xb_ld(&(bar)[XB_TMO])) break; if (_sp > XB_SPIN_CAP) { atomicAdd(&(bar)[XB_TMO], 1u); break; } } } } while (0)

struct XcdBarrier {
    unsigned* bar; unsigned x;
    volatile LAS unsigned* st;
};

__device__ __forceinline__ XcdBarrier xcd_barrier_post(unsigned* bar, volatile LAS unsigned* st) {
    XcdBarrier b; b.bar = bar; b.x = xb_xcc_id(); b.st = st;
    if (threadIdx.x == 0) (void)xb_add(&bar[XB_XCNT(b.x)], 1u);
    return b;
}
__device__ __forceinline__ void xcd_barrier_complete(unsigned* bar, unsigned x, unsigned& nloc, unsigned& nx) {
    const unsigned G = gridDim.x * gridDim.y * gridDim.z;
    unsigned sum, cnt, mine, sp = 0u;
    for (;;) {
        sum = 0u; cnt = 0u; mine = 0u;
#pragma unroll
        for (unsigned j = 0; j < 16; ++j) { const unsigned c = xb_ld(&bar[XB_XCNT(j)]); sum += c; cnt += (c > 0u) ? 1u : 0u; mine = (j == x) ? c : mine; }
        if (sum == G) break;
        __builtin_amdgcn_s_sleep(1);
        if ((++sp & 255u) == 0u) { if (xb_ld(&bar[XB_TMO])) break; if (sp > XB_SPIN_CAP) { atomicAdd(&bar[XB_TMO], 1u); break; } }
    }
    nloc = mine > 0u ? mine : 1u; nx = cnt > 0u ? cnt : 1u;
}

__device__ __forceinline__ void xcd_barrier(const XcdBarrier& b) {
    asm volatile("s_waitcnt vmcnt(0)" ::: "memory");
    __syncthreads();
    if (threadIdx.x == 0) {
        unsigned* bar = b.bar;
        __builtin_amdgcn_s_waitcnt(0);
        unsigned nloc = b.st[0], nx = b.st[1];
        if (nloc == 0u) { xcd_barrier_complete(bar, b.x, nloc, nx); b.st[0] = nloc; b.st[1] = nx; }
        const unsigned old = xb_add(&bar[XB_XSUB(b.x)], 1u);
        const unsigned gen = old / nloc;
        if (old + 1u == (gen + 1u) * nloc) {
            __builtin_amdgcn_fence(__ATOMIC_RELEASE, "agent");
            asm volatile("s_waitcnt vmcnt(0)" ::: "memory");
            const unsigned og = xb_add(&bar[XB_TOP], 1u);
            const unsigned tg = og / nx;
            if (og + 1u == (tg + 1u) * nx) xb_add(&bar[XB_TOPGEN], 1u);
            else XB_SPIN(xb_ld(&bar[XB_TOPGEN]) == tg, bar);
            __builtin_amdgcn_fence(__ATOMIC_ACQUIRE, "agent");
            xb_add(&bar[XB_XGEN(b.x)], 1u);
            asm volatile("s_waitcnt vmcnt(0)" ::: "memory");
        } else {
            XB_SPIN(xb_ld(&bar[XB_XGEN(b.x)]) == gen, bar);
            __builtin_amdgcn_fence(__ATOMIC_ACQUIRE, "agent");
            asm volatile("s_waitcnt vmcnt(0)" ::: "memory");
        }
    }
    __syncthreads();
}
struct Frame {
    LAS unsigned char* lds;
    volatile LAS unsigned* MISC;
    gu32* ctl;
    int tid, lane, wave, G, bx;
    unsigned char* ws;
    float* out;
};
struct Args { const float* in[28]; float* out; unsigned char* ws; };
typedef const __attribute__((address_space(4))) Args* KArgs;
__device__ __forceinline__ KArgs kargs() { KArgs k = (KArgs)__builtin_amdgcn_kernarg_segment_ptr(); asm volatile("" : "+s"(k)); return k; }
enum { I_X = 0, I_P, I_WIN, I_CONVW, I_CONVB, I_LRUWA, I_LRUBA, I_LRUWX, I_LRUBX, I_LAM, I_WBRA, I_WBRR, I_WO, I_RELB, I_LN1G, I_LN1B, I_FFG, I_FFU, I_FFD, I_ROUTER, I_ROUTERB, I_MOEG, I_MOEU, I_MOED, I_PLEG, I_PLEP, I_LN2G, I_LN2B };

__device__ __forceinline__ Frame launder(const Frame& F0) { Frame F = F0; unsigned char* w = F0.ws; int l = (int)__builtin_amdgcn_mbcnt_hi(~0u, __builtin_amdgcn_mbcnt_lo(~0u, 0u)); asm volatile("" : "+s"(w)); asm volatile("" : "+v"(l));
    F.ws = w; F.lane = l; F.tid = F0.wave * 64 + l; F.ctl = (gu32*)(w + WS_CTL); return F; }
__device__ __forceinline__ float lane_get(float v, int src_lane) { return __builtin_bit_cast(float, __builtin_amdgcn_ds_bpermute(src_lane << 2, __builtin_bit_cast(int, v))); }
__device__ __forceinline__ float lane_xor(float v, int mask, int lane) { return lane_get(v, lane ^ mask); }
__device__ __forceinline__ float lane_up(float v, int d, int lane) { return lane_get(v, lane >= d ? lane - d : lane); }
__device__ __forceinline__ float wave_sum(float v, int lane) {
    (void)lane;
#define WS_DPP(ctrl, rmask) v += __builtin_bit_cast(float, __builtin_amdgcn_update_dpp(0, __builtin_bit_cast(int, v), ctrl, rmask, 0xf, false))
    WS_DPP(0x111, 0xf); WS_DPP(0x112, 0xf); WS_DPP(0x114, 0xf); WS_DPP(0x118, 0xf); WS_DPP(0x142, 0xa); WS_DPP(0x143, 0xc);
#undef WS_DPP
    return __builtin_bit_cast(float, __builtin_amdgcn_readlane(__builtin_bit_cast(int, v), 63));
}
__device__ __forceinline__ unsigned pk2(float lo, float hi) { return cvt_pk_bf16(lo, hi); }

__device__ __forceinline__ void cvt_item(const float* W, int ldw, int K, bf16* WT, int d0, int sc0, int nvalid, float scale, int k0, LAS float* scr, int lane) {
    const int n4 = (lane & 7) * 4;
    f32x4 v[8];
#pragma unroll
    for (int i = 0; i < 8; ++i) { const int kk = 8 * i + (lane >> 3); v[i] = (f32x4){0.f, 0.f, 0.f, 0.f}; if (n4 < nvalid) v[i] = *(const GAS f32x4*)(W + (size_t)(k0 + kk) * ldw + sc0 + n4); }
#pragma unroll
    for (int i = 0; i < 8; ++i) { const int kk = 8 * i + (lane >> 3); LAS float* d = scr + kk * 33 + n4; d[0] = v[i][0] * scale; d[1] = v[i][1] * scale; d[2] = v[i][2] * scale; d[3] = v[i][3] * scale; }
    LDS_WAIT(); asm volatile("" ::: "memory");
    const int c = lane & 7;
#pragma unroll
    for (int j = 0; j < 4; ++j) { const int nn = (lane >> 3) + 8 * j; const LAS float* s = scr + (8 * c) * 33 + nn;
        v4u o; o.x = pk2(s[0 * 33], s[1 * 33]); o.y = pk2(s[2 * 33], s[3 * 33]); o.z = pk2(s[4 * 33], s[5 * 33]); o.w = pk2(s[6 * 33], s[7 * 33]);
        *(GAS v4u*)(WT + (size_t)(d0 + nn) * K + k0 + 8 * c) = o; }
    LDS_WAIT(); asm volatile("" ::: "memory");
}
__device__ __forceinline__ void cvt_plain(const float* W, int K, int N, bf16* WT, int item, LAS float* scr, int lane) {
    const int nblk = N / 32, kb = item / nblk, nb = item % nblk;
    cvt_item(W, N, K, WT, 32 * nb, 32 * nb, 32, 1.0f, 64 * kb, scr, lane);
}
__device__ __forceinline__ void cvt_gateup(const float* Wg, const float* Wu, int dff, bf16* WT, int item, LAS float* scr, int lane) {
    const int nblk = 2 * dff / 32, kb = item / nblk, db = item % nblk, d0 = 32 * db, pn = d0 >> 8, r = d0 & 255;
    const float* W = r < 128 ? Wg : Wu; const int sc0 = 128 * pn + (r & 127);
    cvt_item(W, dff, D, WT, d0, sc0, 32, 1.0f, 64 * kb, scr, lane);
}
__device__ __forceinline__ void cvt_win(const float* W, bf16* WT, int item, LAS float* scr, int lane) {
    const int nblk = NIN / 32, kb = item / nblk, db = item % nblk, d0 = 32 * db;
    int sc0, nv = 32; float sc = 1.0f;
    if (d0 < 1024) { sc0 = d0; }
    else if (d0 < 2048) sc0 = 1736 + (d0 - 1024);
    else if (d0 < 3072) sc0 = 2760 + (d0 - 2048);
    else if (d0 < 4096) sc0 = 3784 + (d0 - 3072);
    else if (d0 < 5120) sc0 = 4808 + (d0 - 4096);
    else if (d0 < 5632) sc0 = 1152 + (d0 - 5120);
    else if (d0 < 5696) sc0 = 1024 + (d0 - 5632);
    else if (d0 < 5760) sc0 = 1088 + (d0 - 5696);
    else if (d0 < 5824) sc0 = 1664 + (d0 - 5760);
    else if (d0 == 5824) { sc0 = 1728; nv = 8; }
    else { sc0 = 0; nv = 0; }
    cvt_item(W, D_IN, D, WT, d0, sc0, nv, sc, 64 * kb, scr, lane);
}
__device__ __forceinline__ void p0_convert(const Frame& F0, int L) {
    Frame F = launder(F0);
    const KArgs ka = kargs();
    LAS float* scr = (LAS float*)(F.lds + RING_OFF + F.wave * 16384);
    const int gw = F.bx * NWAVES + F.wave, NGW = F.G * NWAVES;
    unsigned char* wb = F.ws + WS_W;
    const int odd = L & 1, jj = L >> 1;
    constexpr int I_IN = (D / 64) * (NIN / 32), I_SQ = (D / 64) * (D / 32), I_PPJ = (PLE / 64) * (D / 32), I_LRU1 = 2 * 4;
    constexpr int I_GU_D = (D / 64) * (2 * DFF / 32), I_DN_D = (DFF / 64) * (D / 32), I_GU_E = (D / 64) * (2 * DFFE / 32), I_DN_E = (DFFE / 64) * (D / 32);
    const int n_ff = odd ? NEXP * (I_GU_E + I_DN_E) : (I_GU_D + I_DN_D);
    const int NITEMS = I_IN + 4 * I_SQ + I_PPJ + 16 * I_LRU1 + n_ff;
    for (int it = gw; it < NITEMS; it += NGW) {
        const float* W; bf16* WT; int ldw, K, d0, sc0, nv = 32, k0; float scale = 1.0f;
        int r = it, kind = 0, m = 0;
        if (r < I_IN) kind = 1;
        else { r -= I_IN;
            if (r < 4 * I_SQ) { m = r / I_SQ; r -= m * I_SQ; }
            else { r -= 4 * I_SQ;
                if (r < I_PPJ) m = 4;
                else { r -= I_PPJ;
                    if (r < 16 * I_LRU1) m = 5;
                    else { r -= 16 * I_LRU1;
                        if (!odd) { if (r < I_GU_D) kind = 2; else { r -= I_GU_D; m = 6; } }
                        else { if (r < NEXP * I_GU_E) kind = 3; else { r -= NEXP * I_GU_E; m = 7; } } } } } }
        if (kind == 1) { const int nblk = NIN / 32, kb = r / nblk, db = r % nblk; d0 = 32 * db; k0 = 64 * kb;
            W = ka->in[I_WIN] + (size_t)L * D * D_IN; WT = (bf16*)(wb + W_IN); ldw = D_IN; K = D;
            if (d0 < 1024) sc0 = d0;
            else if (d0 < 2048) sc0 = 1736 + (d0 - 1024);
            else if (d0 < 3072) sc0 = 2760 + (d0 - 2048);
            else if (d0 < 4096) sc0 = 3784 + (d0 - 3072);
            else if (d0 < 5120) sc0 = 4808 + (d0 - 4096);
            else if (d0 < 5632) sc0 = 1152 + (d0 - 5120);
            else if (d0 < 5696) sc0 = 1024 + (d0 - 5632);
            else if (d0 < 5760) sc0 = 1088 + (d0 - 5696);
            else if (d0 < 5824) sc0 = 1664 + (d0 - 5760);
            else if (d0 == 5824) { sc0 = 1728; nv = 8; }
            else { sc0 = 0; nv = 0; } }
        else if (kind >= 2) { const int dff = kind == 2 ? DFF : DFFE; int e = 0; if (kind == 3) { e = r / I_GU_E; r -= e * I_GU_E; }
            const size_t eo = kind == 2 ? (size_t)jj * D * DFF : ((size_t)jj * NEXP + e) * D * DFFE;
            const int nblk = 2 * dff / 32, kb = r / nblk, db = r % nblk; d0 = 32 * db; k0 = 64 * kb; const int pn = d0 >> 8, rr = d0 & 255;
            W = (rr < 128 ? ka->in[kind == 2 ? I_FFG : I_MOEG] : ka->in[kind == 2 ? I_FFU : I_MOEU]) + eo; sc0 = 128 * pn + (rr & 127); ldw = dff; K = D;
            WT = (bf16*)(wb + W_FF) + (kind == 3 ? (size_t)e * 2 * DFFE * D : 0); }
        else { int Kk, Nn;
            if (m < 4) { Kk = D; Nn = D; W = ka->in[m == 0 ? I_WBRA : m == 1 ? I_WBRR : m == 2 ? I_WO : I_PLEG] + (size_t)L * D * D; WT = (bf16*)(wb + (m == 0 ? W_BRA : m == 1 ? W_BRR : m == 2 ? W_O : W_PG)); }
            else if (m == 4) { Kk = PLE; Nn = D; W = ka->in[I_PLEP] + (size_t)L * PLE * D; WT = (bf16*)(wb + W_PP); }
            else if (m == 5) { const int mm = r / I_LRU1, blk = mm & 7, which = mm >> 3; r -= mm * I_LRU1; Kk = 128; Nn = 128;
                W = ka->in[which ? I_LRUWX : I_LRUWA] + (size_t)L * 8 * 128 * 128 + (size_t)blk * 128 * 128; WT = (bf16*)(wb + W_LRU) + (size_t)which * 8 * 128 * 128 + (size_t)blk * 128 * 128; }
            else if (m == 6) { Kk = DFF; Nn = D; W = ka->in[I_FFD] + (size_t)jj * DFF * D; WT = (bf16*)(wb + W_FF_DN_DENSE); }
            else { const int e = r / I_DN_E; r -= e * I_DN_E; Kk = DFFE; Nn = D; W = ka->in[I_MOED] + ((size_t)jj * NEXP + e) * DFFE * D; WT = (bf16*)(wb + W_FF_DN_MOE) + (size_t)e * D * DFFE; }
            const int nblk = Nn / 32, kb = r / nblk, nb = r % nblk; d0 = 32 * nb; sc0 = 32 * nb; k0 = 64 * kb; ldw = Nn; K = Kk; }
        cvt_item(W, ldw, K, WT, d0, sc0, nv, scale, k0, scr, F.lane);
    }
    if (L == 0) {
        const GAS f32x4* x4 = (const GAS f32x4*)ka->in[I_X]; GAS v4u* o = (GAS v4u*)(F.ws + WS_XB);
        const size_t n8 = (size_t)T_TOK * D / 8;
        for (size_t i = (size_t)F.bx * 512 + F.tid; i < n8; i += (size_t)F.G * 512) { const f32x4 a = x4[2 * i], b = x4[2 * i + 1];
            v4u w; w.x = pk2(a[0], a[1]); w.y = pk2(a[2], a[3]); w.z = pk2(b[0], b[1]); w.w = pk2(b[2], b[3]); o[i] = w; }
    }
}

template <bool LN2, bool ODD, bool DRY = false>
__device__ __forceinline__ void ln_phase(const Frame& F0, int L) {
    Frame F = launder(F0);
    const KArgs ka = kargs();
    const int jj = L >> 1;
    float* X32 = F.out; bf16* XB = (bf16*)(F.ws + WS_XB);
    const float* gam = ka->in[LN2 ? I_LN2G : I_LN1G] + (size_t)L * D; const float* bet = ka->in[LN2 ? I_LN2B : I_LN1B] + (size_t)L * D;
    f32x4 gv[4], bv[4];
#pragma unroll
    for (int j = 0; j < 4; ++j) { gv[j] = ((const GAS f32x4*)gam)[F.lane + 64 * j]; bv[j] = ((const GAS f32x4*)bet)[F.lane + 64 * j]; }
    LAS float* RT = (LAS float*)(F.lds + RING_OFF);
    LAS unsigned* TE = (LAS unsigned*)(F.lds + RING_OFF + 32768);
    volatile LAS unsigned* lcnt = F.MISC + 48; volatile LAS unsigned* gbase = F.MISC + 56;
    float rb[8];
    if (!LN2 && ODD) {
        const float* R = ka->in[I_ROUTER] + (size_t)jj * D * NEXP;
        for (int i = F.tid; i < D * NEXP; i += 512) RT[i] = R[i];
        if (F.tid < 8) lcnt[F.tid] = 0u;
#pragma unroll
        for (int e = 0; e < 8; ++e) rb[e] = ka->in[I_ROUTERB][jj * NEXP + e];
        __syncthreads();
    }
    const unsigned* route = (const unsigned*)(F.ws + WS_ROUTE);
    const bf16* YE = (const bf16*)(F.ws + F_YE);
    const bf16* T1 = (const bf16*)(F.ws + (LN2 ? F_U : Z_GR)); const bf16* T2 = (const bf16*)(F.ws + Z_GR);
    v2u nx[2][4], n1[2][4], n2[2][4], ny1[2][4], ny2[2][4]; f32x4 npv[2]; float gc1[2], gc2[2]; v4u rnA[2];
    npv[0] = npv[1] = (f32x4){0.f, 0.f, 0.f, 0.f}; gc1[0] = gc1[1] = gc2[0] = gc2[1] = 0.f;
    (void)n2; (void)ny1; (void)ny2; (void)npv; (void)gc1; (void)gc2; (void)rnA;
    int vz_ = 0; asm volatile("" : "+v"(vz_));
    const GAS v4u* route4 = (const GAS v4u*)(F.ws + WS_ROUTE) + vz_;
    const size_t rwb = (size_t)F.bx * 256 + F.wave;
#define LN_ROW_LOADS(B, rw_, ra_) do { const size_t rw__ = (rw_); const GAS v2u* a0_ = (const GAS v2u*)(XB + rw__ * D) + F.lane; const GAS v2u* b0_ = (const GAS v2u*)(T1 + rw__ * D) + F.lane; \
        _Pragma("unroll") for (int j = 0; j < 4; ++j) { nx[B][j] = a0_[64 * j]; n1[B][j] = b0_[64 * j]; } \
        if (LN2 && !ODD) { const GAS v2u* fp_ = (const GAS v2u*)(T2 + rw__ * D) + F.lane; _Pragma("unroll") for (int j = 0; j < 4; ++j) n2[B][j] = fp_[64 * j]; } \
        if (!LN2) npv[B] = ((const GAS f32x4*)(ka->in[I_P] + ((size_t)L * T_TOK + rw__) * PLE))[F.lane]; \
        if (LN2 && ODD) { const size_t r1_ = (size_t)F.MISC[16 + (ra_).x] * 256 + (ra_).z, r2_ = (size_t)F.MISC[16 + (ra_).y] * 256 + (ra_).w; \
            const GAS v2u* y1_ = (const GAS v2u*)(YE + r1_ * D) + F.lane; const GAS v2u* y2_ = (const GAS v2u*)(YE + r2_ * D) + F.lane; \
            _Pragma("unroll") for (int j = 0; j < 4; ++j) { ny1[B][j] = y1_[64 * j]; ny2[B][j] = y2_[64 * j]; } \
            gc1[B] = __builtin_bit_cast(float, route[rw__ * 8 + 4]); gc2[B] = __builtin_bit_cast(float, route[rw__ * 8 + 5]); } } while (0)
    { v4u r0_, r1x_; r0_.x = r0_.y = r0_.z = r0_.w = 0u; r1x_ = r0_;
      if (LN2 && ODD) { r0_ = route4[rwb * 2]; r1x_ = route4[(rwb + 8) * 2]; }
      LN_ROW_LOADS(0, rwb, r0_); LN_ROW_LOADS(1, rwb + 8, r1x_);
      if (LN2 && ODD) { rnA[0] = route4[(rwb + 16) * 2]; rnA[1] = route4[(rwb + 24) * 2]; } }
    for (int it2 = 0; it2 < 32; it2 += 2) {
#pragma unroll
      for (int bf = 0; bf < 2; ++bf) {
        const int it = it2 + bf;
        const int rl = F.wave + 8 * it; const size_t row = (size_t)F.bx * 256 + rl;
        GAS f32x4* xr = (GAS f32x4*)(X32 + row * D) + F.lane;
        f32x4 v[4]; float s = 0.f;
#pragma unroll
        for (int j = 0; j < 4; ++j) { const v2u a = nx[bf][j], b = n1[bf][j];
            v[j][0] = DN_ALPHA * bf_lo(a.x) + bf_lo(b.x); v[j][1] = DN_ALPHA * bf_hi(a.x) + bf_hi(b.x); v[j][2] = DN_ALPHA * bf_lo(a.y) + bf_lo(b.y); v[j][3] = DN_ALPHA * bf_hi(a.y) + bf_hi(b.y); }
        if (LN2 && !ODD) {
#pragma unroll
            for (int j = 0; j < 4; ++j) { const v2u b = n2[bf][j]; v[j][0] += bf_lo(b.x); v[j][1] += bf_hi(b.x); v[j][2] += bf_lo(b.y); v[j][3] += bf_hi(b.y); }
        }
        if (LN2 && ODD) {
            const float g1 = gc1[bf], g2 = gc2[bf];
#pragma unroll
            for (int j = 0; j < 4; ++j) { const v2u a = ny1[bf][j], b = ny2[bf][j];
                v[j][0] += g1 * bf_lo(a.x) + g2 * bf_lo(b.x); v[j][1] += g1 * bf_hi(a.x) + g2 * bf_hi(b.x);
                v[j][2] += g1 * bf_lo(a.y) + g2 * bf_lo(b.y); v[j][3] += g1 * bf_hi(a.y) + g2 * bf_hi(b.y); }
        }
        const f32x4 pv = npv[bf];
        if (it < 30) { v4u rcur_; rcur_.x = rcur_.y = rcur_.z = rcur_.w = 0u; if (LN2 && ODD) rcur_ = rnA[bf];
            LN_ROW_LOADS(bf, row + 16, rcur_);
            if (LN2 && ODD) { if (it < 28) rnA[bf] = route4[(row + 32) * 2]; } }
#pragma unroll
        for (int j = 0; j < 4; ++j) s += (v[j][0] + v[j][1]) + (v[j][2] + v[j][3]);
        const float mean = wave_sum(s, F.lane) * (1.f / D); float s2 = 0.f;
#pragma unroll
        for (int j = 0; j < 4; ++j) { v[j] = v[j] - mean; s2 += (v[j][0] * v[j][0] + v[j][1] * v[j][1]) + (v[j][2] * v[j][2] + v[j][3] * v[j][3]); }
        const float rstd = 1.f / sqrtf(wave_sum(s2, F.lane) * (1.f / D) + LN_EPS);
        GAS v2u* o8 = (GAS v2u*)((DRY ? (bf16*)(F.ws + WS_NEED) : XB) + row * D) + F.lane;
        GAS f32x4* xw = DRY ? (GAS f32x4*)((float*)(F.ws + WS_NEED) + row * D) + F.lane : xr;
#pragma unroll
        for (int j = 0; j < 4; ++j) { v[j] = v[j] * rstd * gv[j] + bv[j]; if (DRY || (LN2 && L == DEPTH - 1)) xw[64 * j] = v[j];
            v2u w; w.x = pk2(v[j][0], v[j][1]); w.y = pk2(v[j][2], v[j][3]); o8[64 * j] = w; }
        if (!LN2) {
            v2u w; w.x = pk2(pv[0], pv[1]); w.y = pk2(pv[2], pv[3]); ((GAS v2u*)(F.ws + (DRY ? WS_NEED : F_PB) + row * PLE * 2))[F.lane] = w;
        }
        if (!LN2 && ODD) {
            float lg[8];
#pragma unroll
            for (int e = 0; e < 8; ++e) lg[e] = 0.f;
#pragma unroll
            for (int j = 0; j < 4; ++j)
#pragma unroll
                for (int q = 0; q < 4; ++q) { const int c = 4 * F.lane + 256 * j + q; const f32x4 ra = *(const LAS f32x4*)(RT + c * 8), rc = *(const LAS f32x4*)(RT + c * 8 + 4); const float xv = v[j][q];
                    lg[0] += xv * ra[0]; lg[1] += xv * ra[1]; lg[2] += xv * ra[2]; lg[3] += xv * ra[3]; lg[4] += xv * rc[0]; lg[5] += xv * rc[1]; lg[6] += xv * rc[2]; lg[7] += xv * rc[3]; }
#pragma unroll
            for (int e = 0; e < 8; ++e) lg[e] = wave_sum(lg[e], F.lane) + rb[e];
            int e1 = 0; float v1 = lg[0];
#pragma unroll
            for (int e = 1; e < 8; ++e) if (lg[e] > v1) { v1 = lg[e]; e1 = e; }
            int e2 = -1; float v2 = 0.f;
#pragma unroll
            for (int e = 0; e < 8; ++e) if (e != e1 && (e2 < 0 || lg[e] > v2)) { v2 = lg[e]; e2 = e; }
            const float ex = __expf(v2 - v1), g1 = 1.f / (1.f + ex), g2 = ex * g1;
            if (F.lane == 0) { const unsigned lp1 = __hip_atomic_fetch_add((LAS unsigned*)lcnt + e1, 1u, __ATOMIC_RELAXED, __HIP_MEMORY_SCOPE_WORKGROUP), lp2 = __hip_atomic_fetch_add((LAS unsigned*)lcnt + e2, 1u, __ATOMIC_RELAXED, __HIP_MEMORY_SCOPE_WORKGROUP);
                TE[rl * 4 + 0] = (unsigned)e1 | ((unsigned)e2 << 8) | (lp1 << 16); TE[rl * 4 + 1] = lp2; TE[rl * 4 + 2] = __builtin_bit_cast(unsigned, g1); TE[rl * 4 + 3] = __builtin_bit_cast(unsigned, g2); }
        }
      }
    }
#undef LN_ROW_LOADS
    if (!LN2 && ODD) {
        __syncthreads();
        if (F.tid < 8) gbase[F.tid] = __hip_atomic_fetch_add(F.ctl + CW_CNT + jj * 1024 + 64 * F.tid, lcnt[F.tid], RLX_AGENT);
        __syncthreads();
        if (F.tid < 256) { const unsigned w0 = TE[F.tid * 4], lp2 = TE[F.tid * 4 + 1]; const unsigned e1 = w0 & 255u, e2 = (w0 >> 8) & 255u, lp1 = w0 >> 16;
            const unsigned p1 = gbase[e1] + lp1, p2 = gbase[e2] + lp2; const unsigned tok = (unsigned)F.bx * 256 + F.tid;
            GAS int* list = (GAS int*)(F.ws + WS_LIST); list[(size_t)e1 * T_TOK + p1] = (int)tok; list[(size_t)e2 * T_TOK + p2] = (int)tok;
            GAS v4u* ro = (GAS v4u*)(F.ws + WS_ROUTE) + (size_t)tok * 2; v4u a; a.x = e1; a.y = e2; a.z = p1; a.w = p2; ro[0] = a; v4u b; b.x = TE[F.tid * 4 + 2]; b.y = TE[F.tid * 4 + 3]; b.z = 0u; b.w = 0u; ro[1] = b; }
        __syncthreads();
    }
}
__device__ __forceinline__ int wave_scan_add(int x) {
    x += __builtin_amdgcn_update_dpp(0, x, 0x111, 0xf, 0xf, false);
    x += __builtin_amdgcn_update_dpp(0, x, 0x112, 0xf, 0xf, false);
    x += __builtin_amdgcn_update_dpp(0, x, 0x114, 0xf, 0xf, false);
    x += __builtin_amdgcn_update_dpp(0, x, 0x118, 0xf, 0xf, false);
    x += __builtin_amdgcn_update_dpp(0, x, 0x142, 0xa, 0xf, false);
    x += __builtin_amdgcn_update_dpp(0, x, 0x143, 0xc, 0xf, false);
    return x;
}
template <int NJ>
__device__ __forceinline__ unsigned select_topk_n(LAS const float* sc, int n_adm, GAS unsigned short* gout, LAS unsigned short* out, int lane, unsigned guess) {
    const int nj = n_adm >> 6;
    unsigned u[NJ];
#pragma unroll
    for (int j = 0; j < NJ; ++j) { unsigned b = 0u;
        if (j < NJ - 8 || j < nj) { b = __builtin_bit_cast(unsigned, sc[64 * j + lane]); b = (b == 0x80000000u) ? 0u : b; b = (b & 0x80000000u) ? ~b : (b | 0x80000000u); }
        u[j] = b; }
#define SEL_COUNT(c_, dst_) do { int t_ = 0; const unsigned cc_ = (unsigned)__builtin_amdgcn_readfirstlane((int)(c_)); _Pragma("unroll") for (int j8 = 0; j8 < NJ; j8 += 8) { unsigned long long m0_, m1_, m2_, m3_, m4_, m5_, m6_, m7_; \
        asm("v_cmp_le_u32_e64 %0, %8, %9\n\tv_cmp_le_u32_e64 %1, %8, %10\n\tv_cmp_le_u32_e64 %2, %8, %11\n\tv_cmp_le_u32_e64 %3, %8, %12\n\tv_cmp_le_u32_e64 %4, %8, %13\n\tv_cmp_le_u32_e64 %5, %8, %14\n\tv_cmp_le_u32_e64 %6, %8, %15\n\tv_cmp_le_u32_e64 %7, %8, %16" \
            : "=&s"(m0_), "=&s"(m1_), "=&s"(m2_), "=&s"(m3_), "=&s"(m4_), "=&s"(m5_), "=&s"(m6_), "=&s"(m7_) : "s"(cc_), "v"(u[j8]), "v"(u[j8 + 1]), "v"(u[j8 + 2]), "v"(u[j8 + 3]), "v"(u[j8 + 4]), "v"(u[j8 + 5]), "v"(u[j8 + 6]), "v"(u[j8 + 7])); \
        t_ += __popcll(m0_) + __popcll(m1_) + __popcll(m2_) + __popcll(m3_) + __popcll(m4_) + __popcll(m5_) + __popcll(m6_) + __popcll(m7_); } dst_ = t_; } while (0)
    unsigned lo = 0u, hi = 0xFFFFFFFFu, ex = 0u; bool exact = false; int c;
    if (guess != 0u) {
        SEL_COUNT(guess, c);
        if (c == 256) { exact = true; ex = guess; }
        else if (c > 256) { lo = guess; unsigned d = 1u << 17;
            for (int e = 0; e < 7 && !exact; ++e) { const unsigned h = lo + d; if (h < lo) break; SEL_COUNT(h, c);
                if (c == 256) { exact = true; ex = h; } else if (c < 256) { hi = h; break; } else { lo = h; d <<= 2; } } }
        else { hi = guess; unsigned d = 1u << 17;
            for (int e = 0; e < 7 && !exact; ++e) { if (d >= hi) break; const unsigned l = hi - d; SEL_COUNT(l, c);
                if (c == 256) { exact = true; ex = l; } else if (c > 256) { lo = l; break; } else { hi = l; d <<= 2; } } }
    }
    while (!exact && hi - lo > 1u) { const unsigned mid = lo + ((hi - lo) >> 1); SEL_COUNT(mid, c);
        if (c == 256) { exact = true; ex = mid; } else if (c > 256) lo = mid; else hi = mid; }
#undef SEL_COUNT
    const unsigned thr = exact ? ex - 1u : lo;
    int nl = 0;
#pragma unroll
    for (int j = 0; j < NJ; ++j) nl += (u[j] > thr) ? 1 : 0;
    const int incl = wave_scan_add(nl); const int ngt = __builtin_amdgcn_readlane(incl, 63);
    int pos = incl - nl;
#pragma unroll
    for (int j = 0; j < NJ; ++j) if (u[j] > thr) { out[pos] = (unsigned short)(64 * j + lane); ++pos; }
    const int quota = 256 - ngt;
    if (quota > 0) {
        int tbase = 0; const unsigned long long lt = (1ull << lane) - 1ull;
#pragma unroll
        for (int j = 0; j < NJ; ++j) {
            const bool eq = u[j] == thr; const unsigned long long meq = __ballot(eq); const int rk = tbase + __popcll(meq & lt);
            if (eq && rk < quota) out[ngt + rk] = (unsigned short)(64 * j + lane);
            tbase += __popcll(meq);
        }
    }
    asm volatile("s_waitcnt lgkmcnt(0)" ::: "memory");
    if (lane < 32) *(GAS v4u*)(gout + 8 * lane) = *(const LAS v4u*)(out + 8 * lane);
    asm volatile("s_waitcnt lgkmcnt(0)" ::: "memory");
    return thr;
}
__device__ __forceinline__ unsigned select_topk(LAS const float* sc, int n_adm, GAS unsigned short* out, LAS unsigned short* orow, int lane, unsigned guess) {
    if (n_adm <= 256) {
#pragma unroll
        for (int j = 0; j < 4; ++j) { const int p = lane + 64 * j; out[p] = (unsigned short)(p < n_adm ? p : 0); }
        return 0u;
    }
    if (n_adm <= 512) return select_topk_n<8>(sc, n_adm, out, orow, lane, guess);
    else if (n_adm <= 1024) return select_topk_n<16>(sc, n_adm, out, orow, lane, guess);
    else if (n_adm <= 1536) return select_topk_n<24>(sc, n_adm, out, orow, lane, guess);
    return select_topk_n<32>(sc, n_adm, out, orow, lane, guess);
}
template <int MODE = 0>
__device__ __forceinline__ void indexer_phase(const Frame& F0) {
    Frame F = launder(F0);
    LAS float* sc = (LAS float*)(F.lds + RING_OFF);
    const bf16* QI = (const bf16*)(F.ws + Z_QI); const bf16* SM = (const bf16*)(F.ws + Z_SM);
    GAS unsigned short* IDX = (GAS unsigned short*)(F.ws + WS_IDX);
    const int lane = F.lane, h = lane >> 5, r = lane & 31;
    const int rq = 2 * ((r >> 2) & 1) + ((r >> 4) & 1), rh = (r & 3) + 4 * ((r >> 3) & 1);
    const int vcu = (F.bx & 7) * (F.G >> 3) + (F.bx >> 3);
    unsigned guess[2] = {0u, 0u};
    bf16x8 A[4][4]; v4u wq[4][2];
#define IDX_TILE(pi_, b_, tq_) const int pid_ = vcu * 8 + ((pi_) >> 1), b_ = pid_ >> 6, jp_ = pid_ & 63, tq_ = 16 * (((pi_) & 1) ? 127 - jp_ : jp_)
#define IDX_LOAD_A(t0_) do { _Pragma("unroll") for (int mt = 0; mt < 4; ++mt) { \
        _Pragma("unroll") for (int s = 0; s < 4; ++s) A[mt][s] = *(const GAS bf16x8*)(QI + (size_t)((t0_) + 4 * mt + rq) * 512 + rh * 64 + 16 * s + 8 * h); \
        _Pragma("unroll") for (int qq = 0; qq < 2; ++qq) wq[mt][qq] = *(const GAS v4u*)(SM + (size_t)((t0_) + 4 * mt + 2 * h + qq) * 256 + 192); } } while (0)
    for (int pi = 0; pi < 16; ++pi) {
        IDX_TILE(pi, b, tq);
        const int t0 = b * SEQ + tq;
        const int n_adm = ((tq >> 6) + 1) * 64, nkb = n_adm >> 5;
        if (n_adm > 256 && MODE != 2) {
            IDX_LOAD_A(t0);
            bf16x8 B[4], Bn[4];
#pragma unroll
            for (int s = 0; s < 4; ++s) Bn[s] = *(const GAS bf16x8*)(SM + (size_t)(b * SEQ + 32 * F.wave + r) * 256 + 128 + 16 * s + 8 * h);
            for (int kb = F.wave; kb < nkb; kb += 8) {
                const int key = 32 * kb + r;
                const int keyn = (kb + 8 < nkb) ? key + 256 : key;
#pragma unroll
                for (int s = 0; s < 4; ++s) B[s] = Bn[s];
#pragma unroll
                for (int s = 0; s < 4; ++s) Bn[s] = *(const GAS bf16x8*)(SM + (size_t)(b * SEQ + keyn) * 256 + 128 + 16 * s + 8 * h);
#pragma unroll
                for (int mt = 0; mt < 4; ++mt) {
                    f32x16 acc;
#pragma unroll
                    for (int i = 0; i < 16; ++i) acc[i] = 0.f;
#pragma unroll
                    for (int s = 0; s < 4; ++s) acc = __builtin_amdgcn_mfma_f32_32x32x16_bf16(A[mt][s], B[s], acc, 0, 0, 0);
                    float sA = 0.f, sB = 0.f;
#pragma unroll
                    for (int i = 0; i < 8; ++i) { const unsigned wa = wq[mt][0][i >> 1], wb = wq[mt][1][i >> 1];
                        const float fa = (i & 1) ? bf_hi(wa) : bf_lo(wa), fb = (i & 1) ? bf_hi(wb) : bf_lo(wb);
                        sA += fmaxf(acc[i], 0.f) * fa; sB += fmaxf(acc[8 + i], 0.f) * fb; }
                    sc[(4 * mt + 2 * h) * 2048 + key] = sA; sc[(4 * mt + 2 * h + 1) * 2048 + key] = sB;
                }
            }
        }
        __syncthreads();
#pragma unroll 1
        for (int qq = 0; qq < 2 && MODE != 1; ++qq) { const int q = 2 * F.wave + qq; const unsigned g_ = (pi & 1) ? guess[1] : guess[0];
            const unsigned t_ = select_topk(sc + q * 2048, n_adm, IDX + (size_t)(t0 + q) * 256, (LAS unsigned short*)(F.lds + LDSCTL_OFF + 1024 + F.wave * 512), lane, g_); if (pi & 1) guess[1] = t_; else guess[0] = t_; }
        __syncthreads();
    }
#undef IDX_TILE
#undef IDX_LOAD_A
}

__device__ __forceinline__ unsigned vst_off(unsigned r, unsigned ch) { return r * 128u + 16u * (ch ^ ((((r >> 1) ^ (r >> 4)) & 1u) << 1) ^ (((r >> 3) & 1u) << 2)); }
__device__ __forceinline__ int t5_bucket_dev(int rel) {
    const int n = rel < 0 ? -rel : rel;
    int v = n;
    if (n >= 8) v = 8 + (n >= 12) + (n >= 16) + (n >= 23) + (n >= 32) + (n >= 46) + (n >= 64) + (n >= 91);
    return v + (rel > 0 ? 16 : 0);
}
#ifndef ATT_REPS
#define ATT_REPS 1
#endif
#ifndef ATT_FIXKEYS
#define ATT_FIXKEYS 0
#endif
template <int FIX = 0>
__device__ __forceinline__ void attention_phase(const Frame& F0) {
#pragma unroll 1
    for (int rep = 0; rep < ATT_REPS; ++rep) {
    Frame F = launder(F0);
    const GAS unsigned char* Q8 = (const GAS unsigned char*)(F.ws + Z_Q8); const GAS unsigned char* KV8 = (const GAS unsigned char*)(F.ws + Z_KV8); bf16* OB = (bf16*)(F.ws + Z_XR);
    const GAS unsigned short* IDX = (const GAS unsigned short*)(F.ws + WS_IDX);
    const int lane = F.lane, g = lane >> 4, m = lane & 15;
    LAS unsigned char* vst = F.lds + RING_OFF + F.wave * 4096;
    const unsigned vbase = (unsigned)(size_t)vst;
    LAS unsigned char* BK = F.lds + RING_OFF + 32768; LAS unsigned char* OH = F.lds + RING_OFF + 32768 + 2176;
    for (int i = F.tid; i < 2112; i += 512) BK[i] = (unsigned char)t5_bucket_dev(i - 2047);
    if (F.tid < 128) { const int bkt = F.tid >> 2, gg = F.tid & 3, j = bkt - 8 * gg; v4u oh; oh.x = oh.y = oh.z = oh.w = 0u;
        if (j >= 0 && j < 8) { const unsigned val = (j & 1) ? 0x3F800000u : 0x3F80u; if ((j >> 1) == 0) oh.x = val; else if ((j >> 1) == 1) oh.y = val; else if ((j >> 1) == 2) oh.z = val; else oh.w = val; }
        *(LAS v4u*)(OH + F.tid * 16) = oh; }
    __syncthreads();
    bf16x8 bb;
    { const float* rbias = kargs()->in[I_RELB]; unsigned w[4];
#pragma unroll
      for (int j = 0; j < 4; ++j) w[j] = pk2(8.0f * rbias[(8 * g + 2 * j) * 16 + m], 8.0f * rbias[(8 * g + 2 * j + 1) * 16 + m]);
      v4u t; t.x = w[0]; t.y = w[1]; t.z = w[2]; t.w = w[3]; bb = __builtin_bit_cast(bf16x8, t); }
    unsigned tra[4];
    { const unsigned rr_ = 8 * g + (m >> 1), fr_ = ((rr_ >> 2) & 3u) ^ ((rr_ >> 1) & 1u);
#pragma unroll
      for (int c = 0; c < 4; ++c) tra[c] = rr_ * 64u + 16u * ((unsigned)c ^ fr_) + 8u * (m & 1); }
    const long aones = (m == 0) ? 0x3838383838383838L : 0L;
    const int vcu = (F.bx & 7) * (F.G >> 3) + (F.bx >> 3);
    typedef long fp8x8;
    v4u ni0, ni1, nq; v4u ka[16]; unsigned koff[16];
#define ATT_KOFF(i0_, i1_) do { _Pragma("unroll") for (int k = 0; k < 4; ++k) { koff[2 * k] = ((i0_)[k] & 0xffffu) * 128u + 16u * g; koff[2 * k + 1] = ((i0_)[k] >> 16) * 128u + 16u * g; \
        koff[8 + 2 * k] = ((i1_)[k] & 0xffffu) * 128u + 16u * g; koff[8 + 2 * k + 1] = ((i1_)[k] >> 16) * 128u + 16u * g; } } while (0)
#ifdef ATT_NO_ASM
#define ATT_KLOAD(kvb_) do { const GAS unsigned char* kb_ = (kvb_); _Pragma("unroll") for (int T = 0; T < 16; ++T) ka[T] = *(const GAS v4u*)(kb_ + koff[T]); } while (0)
#define ATT_KWAIT(n_, T0_) do {} while (0)
#else
#define ATT_KLOAD(kvb_) do { const GAS unsigned char* kb_ = (kvb_); _Pragma("unroll") for (int T = 0; T < 16; ++T) { \
        asm volatile("global_load_dwordx4 %0, %1, %2" : "=&v"(ka[T]) : "v"(koff[T]), "s"(kb_) : "memory"); } } while (0)
#define ATT_KWAIT(n_, T0_) asm volatile("s_waitcnt vmcnt(" #n_ ")" : "+v"(ka[T0_]), "+v"(ka[T0_ + 1]), "+v"(ka[T0_ + 2]), "+v"(ka[T0_ + 3]), "+v"(ka[T0_ + 4]), "+v"(ka[T0_ + 5]), "+v"(ka[T0_ + 6]), "+v"(ka[T0_ + 7]) :: "memory")
#endif
#define ATT_TOK(it_) ((vcu >> 3) * SEQ + ((it_) >> 2) * 256 + (vcu & 7) * 32 + 8 * ((it_) & 3) + F.wave)
    { const int tok0 = ATT_TOK(0); const GAS v4u* ip = (const GAS v4u*)(IDX + (size_t)tok0 * 256 + 16 * m); ni0 = ip[0]; ni1 = ip[1];
      nq = *(const GAS v4u*)(Q8 + (size_t)tok0 * D + m * 64 + 16 * g);
      ATT_KOFF(ni0, ni1); ATT_KLOAD(KV8 + (size_t)(tok0 >> 11) * SEQ * 128); }
    for (int it = 0; it < 32; ++it) {
        const int tok = ATT_TOK(it), b = tok >> 11, tq = tok & (SEQ - 1);
        const int n_valid = (((tq >> 6) + 1) * 64) < 256 ? ((tq >> 6) + 1) * 64 : 256;
        const v4u qv = nq;
        const fp8x8 qf0 = (fp8x8)(((unsigned long long)qv.y << 32) | qv.x), qf1 = (fp8x8)(((unsigned long long)qv.w << 32) | qv.z);
        const GAS unsigned char* kvb = KV8 + (size_t)b * SEQ * 128;
        f32x4 S[16];
#pragma unroll
        for (int T = 0; T < 16; ++T) {
            if (T == 0) ATT_KWAIT(8, 0);
            if (T == 8) ATT_KWAIT(0, 8);
            const unsigned bkt = BK[(koff[T] >> 7) + (2047 - tq)];
            const v4u oh = *(const LAS v4u*)(OH + bkt * 64 + g * 16);
            f32x4 ab = (f32x4){0.f, 0.f, 0.f, 0.f}, a = (f32x4){0.f, 0.f, 0.f, 0.f};
            ab = __builtin_amdgcn_mfma_f32_16x16x32_bf16(__builtin_bit_cast(bf16x8, oh), bb, ab, 0, 0, 0);
            a = __builtin_amdgcn_mfma_f32_16x16x32_fp8_fp8((fp8x8)(((unsigned long long)ka[T].y << 32) | ka[T].x), qf0, a, 0, 0, 0);
            a = __builtin_amdgcn_mfma_f32_16x16x32_fp8_fp8((fp8x8)(((unsigned long long)ka[T].w << 32) | ka[T].z), qf1, a, 0, 0, 0);
            a = a + ab;
            S[T] = a;
        }
        __builtin_amdgcn_sched_barrier(0);
        v4u vv[16];
#pragma unroll
        for (int T = 0; T < 16; ++T) vv[T] = *(const GAS v4u*)(kvb + koff[T] + 64);
        if (n_valid < 256) {
#pragma unroll
            for (int T = 0; T < 16; ++T)
#pragma unroll
                for (int i = 0; i < 4; ++i) if (16 * (4 * g + i) + T >= n_valid) S[T][i] = -1e30f;
        }
        float mx = -3.0e38f;
#pragma unroll
        for (int T = 0; T < 16; ++T) { asm("v_max3_f32 %0, %1, %2, %0" : "+v"(mx) : "v"(S[T][0]), "v"(S[T][1])); asm("v_max3_f32 %0, %1, %2, %0" : "+v"(mx) : "v"(S[T][2]), "v"(S[T][3])); }
        mx = fmaxf(mx, lane_xor(mx, 16, lane)); mx = fmaxf(mx, lane_xor(mx, 32, lane));
        constexpr float SC = 1.4426950408889634f * 0.125f;
        const float mneg = 8.0f - mx * SC;
#pragma unroll
        for (int T = 0; T < 16; ++T)
#pragma unroll
            for (int i = 0; i < 4; ++i) S[T][i] = __builtin_amdgcn_exp2f(S[T][i] * SC + mneg);
        { const int tokn = ATT_TOK(it < 31 ? it + 1 : it); const GAS v4u* ip = (const GAS v4u*)(IDX + (size_t)tokn * 256 + 16 * m); ni0 = ip[0]; ni1 = ip[1];
          nq = *(const GAS v4u*)(Q8 + (size_t)tokn * D + m * 64 + 16 * g); }
        f32x4 O[4], Osum = (f32x4){0.f, 0.f, 0.f, 0.f};
#pragma unroll
        for (int c = 0; c < 4; ++c) O[c] = (f32x4){0.f, 0.f, 0.f, 0.f};
#pragma unroll
        for (int ks = 0; ks < 8; ++ks) {
#pragma unroll
            for (int tt = 0; tt < 2; ++tt) { const unsigned rr = 8 * (m >> 2) + 4 * tt + (m & 3), fr = ((rr >> 2) & 3u) ^ ((rr >> 1) & 1u);
                *(LAS v4u*)(vst + rr * 64u + 16u * ((unsigned)g ^ fr)) = vv[2 * ks + tt]; }
            int p0 = __builtin_amdgcn_cvt_pk_fp8_f32(S[2 * ks][0], S[2 * ks][1], 0, false); p0 = __builtin_amdgcn_cvt_pk_fp8_f32(S[2 * ks][2], S[2 * ks][3], p0, true);
            int p1 = __builtin_amdgcn_cvt_pk_fp8_f32(S[2 * ks + 1][0], S[2 * ks + 1][1], 0, false); p1 = __builtin_amdgcn_cvt_pk_fp8_f32(S[2 * ks + 1][2], S[2 * ks + 1][3], p1, true);
            const fp8x8 pf = (fp8x8)(((unsigned long long)(unsigned)p1 << 32) | (unsigned)p0);
            v2u f[4];
            asm volatile("s_waitcnt lgkmcnt(0)\n\t"
                         "ds_read_b64_tr_b8 %0, %4\n\tds_read_b64_tr_b8 %1, %5\n\tds_read_b64_tr_b8 %2, %6\n\tds_read_b64_tr_b8 %3, %7\n\t"
                         "s_waitcnt lgkmcnt(0)"
                         : "=&v"(f[0]), "=&v"(f[1]), "=&v"(f[2]), "=&v"(f[3])
                         : "v"(vbase + tra[0]), "v"(vbase + tra[1]), "v"(vbase + tra[2]), "v"(vbase + tra[3])
                         : "memory");
#pragma unroll
            for (int c = 0; c < 4; ++c) O[c] = __builtin_amdgcn_mfma_f32_16x16x32_fp8_fp8((fp8x8)(((unsigned long long)f[c].y << 32) | f[c].x), pf, O[c], 0, 0, 0);
            Osum = __builtin_amdgcn_mfma_f32_16x16x32_fp8_fp8(aones, pf, Osum, 0, 0, 0);
        }
        const float inv = 1.0f / lane_get(Osum[0], m);
#pragma unroll
        for (int c = 0; c < 4; ++c) { v2u w; w.x = pk2(O[c][0] * inv, O[c][1] * inv); w.y = pk2(O[c][2] * inv, O[c][3] * inv);
            *(GAS v2u*)(OB + (size_t)tok * D + m * 64 + 16 * c + 4 * g) = w; }
        { const int tokn = ATT_TOK(it < 31 ? it + 1 : it); ATT_KOFF(ni0, ni1); ATT_KLOAD(KV8 + (size_t)(tokn >> 11) * SEQ * 128); }
    }
    asm volatile("s_waitcnt vmcnt(0)" ::: "memory");
#undef ATT_KOFF
#undef ATT_KLOAD
#undef ATT_KWAIT
    }
}

__device__ __forceinline__ void attention_phase2(const Frame& F0) {
    Frame F = launder(F0);
    const GAS unsigned char* Q8 = (const GAS unsigned char*)(F.ws + Z_Q8); const GAS unsigned char* KV8 = (const GAS unsigned char*)(F.ws + Z_KV8); bf16* OB = (bf16*)(F.ws + Z_XR);
    const GAS unsigned short* IDX = (const GAS unsigned short*)(F.ws + WS_IDX);
    const int lane = F.lane, g = lane >> 4, m = lane & 15, r8 = lane >> 3, c8 = lane & 7;
    LAS unsigned char* vbuf = F.lds + RING_OFF + F.wave * 16384;
    const unsigned vbase = (unsigned)(size_t)vbuf;
    LAS unsigned char* irow = F.lds + LDSCTL_OFF + 1024 + F.wave * 512;
    LAS unsigned char* kst = F.lds + LDSCTL_OFF + 5120 + F.wave * 2048;
    LAS unsigned char* BK = F.lds + LDSCTL_OFF + 21504;
    LAS unsigned char* OH = F.lds + LDSCTL_OFF + 23680;
    for (int i = F.tid; i < 2112; i += 512) BK[i] = (unsigned char)t5_bucket_dev(i - 2047);
    if (F.tid < 128) { const int bkt = F.tid >> 2, gg = F.tid & 3, j = bkt - 8 * gg; v4u oh; oh.x = oh.y = oh.z = oh.w = 0u;
        if (j >= 0 && j < 8) { const unsigned val = (j & 1) ? 0x3F800000u : 0x3F80u; if ((j >> 1) == 0) oh.x = val; else if ((j >> 1) == 1) oh.y = val; else if ((j >> 1) == 2) oh.z = val; else oh.w = val; }
        *(LAS v4u*)(OH + F.tid * 16) = oh; }
    __syncthreads();
    bf16x8 bb;
    { const float* rbias = kargs()->in[I_RELB]; unsigned w[4];
#pragma unroll
      for (int j = 0; j < 4; ++j) w[j] = pk2(8.0f * rbias[(8 * g + 2 * j) * 16 + m], 8.0f * rbias[(8 * g + 2 * j + 1) * 16 + m]);
      v4u t; t.x = w[0]; t.y = w[1]; t.z = w[2]; t.w = w[3]; bb = __builtin_bit_cast(bf16x8, t); }
    unsigned tra[4];
    { const unsigned rr_ = 8 * g + (m >> 1), fr_ = ((rr_ >> 2) & 3u) ^ ((rr_ >> 1) & 1u);
#pragma unroll
      for (int c = 0; c < 4; ++c) tra[c] = vbase + rr_ * 64u + 16u * ((unsigned)c ^ fr_) + 8u * (m & 1); }
    const long aones = (m == 0) ? 0x3838383838383838L : 0L;
    const int vcu = (F.bx & 7) * (F.G >> 3) + (F.bx >> 3);
    unsigned wa[2][2]; const unsigned vstr = c8 >= 4 ? 2048u : 0u;
#pragma unroll
    for (int j = 0; j < 2; ++j)
#pragma unroll
        for (int t = 0; t < 2; ++t) { const unsigned rho = 8u * j + r8;
            if (c8 < 4) wa[j][t] = (unsigned)(LDSCTL_OFF + 5120) + F.wave * 2048u + 1024u * t + rho * 64u + 16u * ((unsigned)c8 ^ (3u * j));
            else { const unsigned rr = 8u * (rho >> 2) + 4u * t + (rho & 3u), fr = ((rr >> 2) & 3u) ^ ((rr >> 1) & 1u); wa[j][t] = (unsigned)RING_OFF + F.wave * 16384u + rr * 64u + 16u * ((unsigned)(c8 - 4) ^ fr); } }
    const unsigned kra = m * 64u + 16u * ((unsigned)g ^ (3u * ((m >> 3) & 1)));
    const unsigned bra = 2u * (32u * (m & 7) + (m >> 3));
    typedef long fp8x8;
    v4u ni, nq;
#define ATT2_QLOAD(tk_) do { const unsigned qo_ = (unsigned)(tk_) * (unsigned)D + (unsigned)(m * 64 + 16 * g); asm volatile("global_load_dwordx4 %0, %1, %2" : "=&v"(nq) : "v"(qo_), "s"(Q8) : "memory"); } while (0)
    { const int tok0 = ATT_TOK(0); ni = *(const GAS v4u*)(IDX + (size_t)tok0 * 256 + 8 * (lane & 31)); ATT2_QLOAD(tok0); }
    for (int it = 0; it < 32; ++it) {
        const int tok = ATT_TOK(it), b = tok >> 11, tq = tok & (SEQ - 1);
        const int n_valid = (((tq >> 6) + 1) * 64) < 256 ? ((tq >> 6) + 1) * 64 : 256;
        const GAS unsigned char* kvb = KV8 + (size_t)b * SEQ * 128;
        if (lane < 32) *(LAS v4u*)(irow + 16 * lane) = ni;
        v4u kv[32];
        { v4u ix[4];
#pragma unroll
          for (int k = 0; k < 4; ++k) ix[k] = *(const LAS v4u*)(irow + 64 * r8 + 16 * k);
#pragma unroll
          for (int q = 0; q < 32; ++q) { const unsigned w = ix[q >> 3][(q >> 1) & 3]; const unsigned off = ((q & 1) ? (w >> 16) : (w & 0xffffu)) * 128u + 16u * c8;
              asm volatile("global_load_dwordx4 %0, %1, %2" : "=&v"(kv[q]) : "v"(off), "s"(kvb) : "memory"); } }
        unsigned bkp[4] = {0u, 0u, 0u, 0u};
#pragma unroll
        for (int T = 0; T < 16; ++T) { const unsigned key = *(const LAS unsigned short*)(irow + bra + 4 * T); bkp[T >> 2] |= (unsigned)BK[key + (2047 - tq)] << (8 * (T & 3)); }
        f32x4 S[16];
#define ATT2_STAGE(T, N, KF) do { \
            asm volatile("s_waitcnt vmcnt(" #N ")" : "+v"(kv[2 * (T)]), "+v"(kv[2 * (T) + 1]) :: "memory"); \
            *(LAS v4u*)(F.lds + wa[0][(T) & 1] + ((T) >> 1) * vstr) = kv[2 * (T)]; *(LAS v4u*)(F.lds + wa[1][(T) & 1] + ((T) >> 1) * vstr) = kv[2 * (T) + 1]; \
            KF = *(const LAS v4u*)(kst + 1024 * ((T) & 1) + kra); } while (0)
#define ATT2_MMA(T, KF) do { \
            const v4u oh = *(const LAS v4u*)(OH + ((bkp[(T) >> 2] >> (8 * ((T) & 3))) & 0xffu) * 64u + g * 16); \
            f32x4 ab = (f32x4){0.f, 0.f, 0.f, 0.f}, a = (f32x4){0.f, 0.f, 0.f, 0.f}; \
            ab = __builtin_amdgcn_mfma_f32_16x16x32_bf16(__builtin_bit_cast(bf16x8, oh), bb, ab, 0, 0, 0); \
            a = __builtin_amdgcn_mfma_f32_16x16x32_fp8_fp8((fp8x8)(((unsigned long long)(KF).y << 32) | (KF).x), qf0, a, 0, 0, 0); \
            a = __builtin_amdgcn_mfma_f32_16x16x32_fp8_fp8((fp8x8)(((unsigned long long)(KF).w << 32) | (KF).z), qf1, a, 0, 0, 0); \
            S[T] = a + ab; } while (0)
        v4u kfa, kfb;
        ATT2_STAGE(0, 30, kfa);
        asm volatile("" : "+v"(nq) :: "memory");
        const v4u qv = nq;
        const fp8x8 qf0 = (fp8x8)(((unsigned long long)qv.y << 32) | qv.x), qf1 = (fp8x8)(((unsigned long long)qv.w << 32) | qv.z);
        ATT2_STAGE(1, 28, kfb); ATT2_MMA(0, kfa);   ATT2_STAGE(2, 26, kfa); ATT2_MMA(1, kfb);   ATT2_STAGE(3, 24, kfb); ATT2_MMA(2, kfa);   ATT2_STAGE(4, 22, kfa); ATT2_MMA(3, kfb);
        ATT2_STAGE(5, 20, kfb); ATT2_MMA(4, kfa);   ATT2_STAGE(6, 18, kfa); ATT2_MMA(5, kfb);   ATT2_STAGE(7, 16, kfb); ATT2_MMA(6, kfa);   ATT2_STAGE(8, 14, kfa); ATT2_MMA(7, kfb);
        ATT2_STAGE(9, 12, kfb); ATT2_MMA(8, kfa);   ATT2_STAGE(10, 10, kfa); ATT2_MMA(9, kfb);  ATT2_STAGE(11, 8, kfb); ATT2_MMA(10, kfa);  ATT2_STAGE(12, 6, kfa); ATT2_MMA(11, kfb);
        ATT2_STAGE(13, 4, kfb); ATT2_MMA(12, kfa);  ATT2_STAGE(14, 2, kfa); ATT2_MMA(13, kfb);  ATT2_STAGE(15, 0, kfb); ATT2_MMA(14, kfa);  ATT2_MMA(15, kfb);
#undef ATT2_STAGE
#undef ATT2_MMA
        if (n_valid < 256) {
            int bs0 = 128 * (g & 1) + (g >> 1); asm volatile("" : "+v"(bs0));
#pragma unroll
            for (int T = 0; T < 16; ++T) { const int lim = n_valid - 2 * T;
#pragma unroll
                for (int i = 0; i < 4; ++i) if (bs0 + 32 * i >= lim) S[T][i] = -1e30f; }
        }
        float mx = -3.0e38f;
#pragma unroll
        for (int T = 0; T < 16; ++T) { asm("v_max3_f32 %0, %1, %2, %0" : "+v"(mx) : "v"(S[T][0]), "v"(S[T][1])); asm("v_max3_f32 %0, %1, %2, %0" : "+v"(mx) : "v"(S[T][2]), "v"(S[T][3])); }
        mx = fmaxf(mx, lane_xor(mx, 16, lane)); mx = fmaxf(mx, lane_xor(mx, 32, lane));
        constexpr float SC = 1.4426950408889634f * 0.125f;
        const float mneg = 8.0f - mx * SC;
#pragma unroll
        for (int T = 0; T < 16; ++T)
#pragma unroll
            for (int i = 0; i < 4; ++i) S[T][i] = __builtin_amdgcn_exp2f(S[T][i] * SC + mneg);
        { const int tokn = ATT_TOK(it < 31 ? it + 1 : it); ni = *(const GAS v4u*)(IDX + (size_t)tokn * 256 + 8 * (lane & 31)); ATT2_QLOAD(tokn); }
        f32x4 O[4], Osum = (f32x4){0.f, 0.f, 0.f, 0.f};
#pragma unroll
        for (int c = 0; c < 4; ++c) O[c] = (f32x4){0.f, 0.f, 0.f, 0.f};
#pragma unroll
        for (int ks = 0; ks < 8; ++ks) {
            int p0 = __builtin_amdgcn_cvt_pk_fp8_f32(S[2 * ks][0], S[2 * ks][1], 0, false); p0 = __builtin_amdgcn_cvt_pk_fp8_f32(S[2 * ks][2], S[2 * ks][3], p0, true);
            int p1 = __builtin_amdgcn_cvt_pk_fp8_f32(S[2 * ks + 1][0], S[2 * ks + 1][1], 0, false); p1 = __builtin_amdgcn_cvt_pk_fp8_f32(S[2 * ks + 1][2], S[2 * ks + 1][3], p1, true);
            const fp8x8 pf = (fp8x8)(((unsigned long long)(unsigned)p1 << 32) | (unsigned)p0);
            v2u f[4];
            asm volatile("s_waitcnt lgkmcnt(0)\n\t"
                         "ds_read_b64_tr_b8 %0, %4\n\tds_read_b64_tr_b8 %1, %5\n\tds_read_b64_tr_b8 %2, %6\n\tds_read_b64_tr_b8 %3, %7\n\t"
                         "s_waitcnt lgkmcnt(0)"
                         : "=&v"(f[0]), "=&v"(f[1]), "=&v"(f[2]), "=&v"(f[3])
                         : "v"(tra[0] + 2048u * ks), "v"(tra[1] + 2048u * ks), "v"(tra[2] + 2048u * ks), "v"(tra[3] + 2048u * ks)
                         : "memory");
#pragma unroll
            for (int c = 0; c < 4; ++c) O[c] = __builtin_amdgcn_mfma_f32_16x16x32_fp8_fp8((fp8x8)(((unsigned long long)f[c].y << 32) | f[c].x), pf, O[c], 0, 0, 0);
            Osum = __builtin_amdgcn_mfma_f32_16x16x32_fp8_fp8(aones, pf, Osum, 0, 0, 0);
        }
        const float inv = 1.0f / lane_get(Osum[0], m);
#pragma unroll
        for (int c = 0; c < 4; ++c) { v2u w; w.x = pk2(O[c][0] * inv, O[c][1] * inv); w.y = pk2(O[c][2] * inv, O[c][3] * inv);
            *(GAS v2u*)(OB + (size_t)tok * D + m * 64 + 16 * c + 4 * g) = w; }
    }
    asm volatile("s_waitcnt vmcnt(0)" : "+v"(nq) :: "memory");
#undef ATT2_QLOAD
}
constexpr int XCS = 136;
constexpr int HHS = 132;
__device__ __forceinline__ float gelu_tanh(float x) {
    const float z = 0.7978845608028654f * (x + 0.044715f * x * x * x);
    const float e = __builtin_amdgcn_exp2f(2.885390081777927f * z);
    const float th = 1.0f - 2.0f * __builtin_amdgcn_rcpf(e + 1.0f);
    return 0.5f * x * (1.0f + th);
}
template <bool DRY = false>
__device__ __forceinline__ void lru_phase(const Frame& F0, int L) {
    Frame F = launder(F0);
    const KArgs ka = kargs();
    const int b = F.bx >> 3, nb = F.bx & 7;
    const bf16* XR = (const bf16*)(F.ws + Z_XR); bf16* YR = (bf16*)(F.ws + Z_YR);
    const bf16* WL = (const bf16*)(F.ws + WS_W + W_LRU);
    LAS bf16* XC = (LAS bf16*)(F.lds + RING_OFF);
    LAS float* HH = (LAS float*)(F.lds + RING_OFF + 2 * 64 * XCS * 2);
    const int tid = F.tid, lane = F.lane, w = F.wave, g = lane >> 4, m = lane & 15;
    const int cc = tid & 15, tp = tid >> 4;
    const int ch0 = nb * 128 + 8 * cc;
    float cw[4][8], cbias[8];
#pragma unroll
    for (int j = 0; j < 4; ++j)
#pragma unroll
        for (int k = 0; k < 8; ++k) cw[j][k] = ka->in[I_CONVW][(size_t)L * 4 * D + j * D + ch0 + k];
#pragma unroll
    for (int k = 0; k < 8; ++k) cbias[k] = ka->in[I_CONVB][(size_t)L * D + ch0 + k];
    bf16x8 Br[4], Bi[4];
#pragma unroll
    for (int s = 0; s < 4; ++s) { Br[s] = *(const GAS bf16x8*)(WL + ((size_t)nb * 128 + 16 * w + m) * 128 + 32 * s + 8 * g);
                                  Bi[s] = *(const GAS bf16x8*)(WL + (size_t)8 * 128 * 128 + ((size_t)nb * 128 + 16 * w + m) * 128 + 32 * s + 8 * g); }
    const int chl = 16 * w + m, chg = nb * 128 + chl;
    const float ba = ka->in[I_LRUBA][(size_t)L * D + chg], bx = ka->in[I_LRUBX][(size_t)L * D + chg];
    const float lam = ka->in[I_LAM][(size_t)L * D + chg];
    const float sp8 = -8.0f * (fmaxf(-lam, 0.f) + log1pf(__expf(-fabsf(lam))));
    float carry = 0.f;
    const size_t rowb = (size_t)b * SEQ;
    v4u nxin[5], nyin[2];
#pragma unroll
    for (int k = 0; k < 5; ++k) { const int t = 2 * tp - 3 + k; v4u z; z.x = z.y = z.z = z.w = 0u; nxin[k] = (t >= 0) ? *(const GAS v4u*)(XR + (rowb + t) * D + ch0) : z; }
#pragma unroll
    for (int k = 0; k < 2; ++k) nyin[k] = *(const GAS v4u*)(YR + (rowb + 2 * tp + k) * D + ch0);
    for (int tile = 0; tile < 32; ++tile) {
        const int t0 = tile * 64, buf = tile & 1;
        LAS bf16* xc = XC + buf * 64 * XCS; LAS float* hh = HH + buf * 64 * HHS;
        v4u xin[5], yin[2];
#pragma unroll
        for (int k = 0; k < 5; ++k) xin[k] = nxin[k];
#pragma unroll
        for (int k = 0; k < 2; ++k) yin[k] = nyin[k];
        if (tile < 31) {
#pragma unroll
            for (int k = 0; k < 5; ++k) nxin[k] = *(const GAS v4u*)(XR + (rowb + t0 + 64 + 2 * tp - 3 + k) * D + ch0);
#pragma unroll
            for (int k = 0; k < 2; ++k) nyin[k] = *(const GAS v4u*)(YR + (rowb + t0 + 64 + 2 * tp + k) * D + ch0);
        }
#pragma unroll
        for (int k = 0; k < 2; ++k) { float o[8];
#pragma unroll
            for (int c = 0; c < 8; ++c) { float a = cbias[c];
#pragma unroll
                for (int j = 0; j < 4; ++j) { const unsigned wv = xin[k + j][c >> 1]; a += ((c & 1) ? bf_hi(wv) : bf_lo(wv)) * cw[j][c]; }
                o[c] = a; }
            v4u pw; pw.x = pk2(o[0], o[1]); pw.y = pk2(o[2], o[3]); pw.z = pk2(o[4], o[5]); pw.w = pk2(o[6], o[7]);
            *(LAS v4u*)(xc + (2 * tp + k) * XCS + 8 * cc) = pw; }
        __syncthreads();
#pragma unroll
        for (int mt = 0; mt < 4; ++mt) {
            f32x4 ar = (f32x4){0.f, 0.f, 0.f, 0.f}, ai = (f32x4){0.f, 0.f, 0.f, 0.f};
#pragma unroll
            for (int s = 0; s < 4; ++s) { const bf16x8 A = *(const LAS bf16x8*)(xc + (16 * mt + m) * XCS + 32 * s + 8 * g);
                ar = __builtin_amdgcn_mfma_f32_16x16x32_bf16(A, Br[s], ar, 0, 0, 0); ai = __builtin_amdgcn_mfma_f32_16x16x32_bf16(A, Bi[s], ai, 0, 0, 0); }
            float P[4], W[4];
#pragma unroll
            for (int i = 0; i < 4; ++i) {
                const float rr = sigmoidf_fast(ar[i] + ba), ig = sigmoidf_fast(ai[i] + bx);
                const float la = sp8 * rr;
                const float a = __builtin_amdgcn_exp2f(1.4426950408889634f * la);
                const float mult = __builtin_amdgcn_sqrtf(fmaxf(__builtin_fmaf(-a, a, 1.0f), 0.f));
                const float xv = __builtin_bit_cast(float, (unsigned)xc[(16 * mt + 4 * g + i) * XCS + chl] << 16);
                const float u = mult * (ig * xv);
                if (i == 0) { P[0] = a; W[0] = u; } else { P[i] = a * P[i - 1]; W[i] = a * W[i - 1] + u; }
            }
            float Ac = P[3], Uc = W[3];
            { const float A1 = lane_up(Ac, 16, lane), U1 = lane_up(Uc, 16, lane); if (g >= 1) { Uc = Ac * U1 + Uc; Ac = Ac * A1; } }
            { const float A2 = lane_up(Ac, 32, lane), U2 = lane_up(Uc, 32, lane); if (g >= 2) { Uc = Ac * U2 + Uc; Ac = Ac * A2; } }
            float Ae = lane_up(Ac, 16, lane), Ue = lane_up(Uc, 16, lane); if (g == 0) { Ae = 1.f; Ue = 0.f; }
            const float hin = Ae * carry + Ue;
            const float cnew = Ac * carry + Uc;
            carry = lane_get(cnew, 48 + m);
#pragma unroll
            for (int i = 0; i < 4; ++i) hh[(16 * mt + 4 * g + i) * HHS + chl] = P[i] * hin + W[i];
        }
        __syncthreads();
#pragma unroll
        for (int k = 0; k < 2; ++k) { const f32x4 h0 = *(const LAS f32x4*)(hh + (2 * tp + k) * HHS + 8 * cc), h1 = *(const LAS f32x4*)(hh + (2 * tp + k) * HHS + 8 * cc + 4);
            float o[8];
#pragma unroll
            for (int c = 0; c < 8; ++c) { const unsigned wv = yin[k][c >> 1]; const float y = (c & 1) ? bf_hi(wv) : bf_lo(wv); o[c] = (c < 4 ? h0[c] : h1[c - 4]) * gelu_tanh(y); }
            v4u pw; pw.x = pk2(o[0], o[1]); pw.y = pk2(o[2], o[3]); pw.z = pk2(o[4], o[5]); pw.w = pk2(o[6], o[7]);
            *(GAS v4u*)((DRY ? (bf16*)(F.ws + WS_NEED) : YR) + (rowb + t0 + 2 * tp + k) * D + ch0) = pw; }
    }
    __syncthreads();
}

struct MoeOrder : pg8::StaticOrder {
    const volatile LAS unsigned* tb; int tile0; const int* list; size_t bstride;
    __device__ __forceinline__ int expert_of(int gt) const { int e = 0;
#pragma unroll
        for (int k = 1; k < 8; ++k) e += (gt >= (int)tb[k]) ? 1 : 0;
        return e; }
    __device__ __forceinline__ const char* b_base(const pg8::Gemm& g, const pg8::Unit& u, size_t tstep) const { return (const char*)g.Bt + (size_t)expert_of(tile0 + u.pm) * bstride + (size_t)u.pn * tstep; }
};
struct MoeGatherOrder : MoeOrder {
    static constexpr bool GATHER = true;
    __device__ __forceinline__ const char* a_base(const pg8::Gemm& g, const pg8::Unit&, size_t) const { return (const char*)g.A; }
    __device__ __forceinline__ void a_rows(const pg8::Unit& u, int R0, int R1, int C0, int C1, int K, unsigned (&off)[2][2]) const {
        const int gt = tile0 + u.pm, e = expert_of(gt), j = gt - (int)tb[e], n = (int)tb[16 + e];
        const GAS int* le = (const GAS int*)list + (size_t)e * T_TOK;
#pragma unroll
        for (int h = 0; h < 2; ++h) { int p0 = 256 * j + 128 * h + R0, p1 = 256 * j + 128 * h + R1; p0 = p0 < n ? p0 : n - 1; p1 = p1 < n ? p1 : n - 1;
            off[h][0] = ((unsigned)le[p0] * (unsigned)K + (unsigned)C0) * 2u; off[h][1] = ((unsigned)le[p1] * (unsigned)K + (unsigned)C1) * 2u; }
    }
};
#ifdef SELFCHECK
#ifndef SC_TOL
#define SC_TOL 0.03f
#define SC_ABS 1e-5f
#endif
__device__ __forceinline__ float sc_bf(const bf16* p, size_t i) { return __builtin_bit_cast(float, (unsigned)((const GAS bf16*)p)[i] << 16); }
__device__ __forceinline__ float sc_f8(const unsigned char* p, size_t i) {
    const unsigned v = ((const GAS unsigned char*)p)[i]; const unsigned e = (v >> 3) & 15u, mn = v & 7u; float r;
    if (e == 0u) r = (float)mn * 0.001953125f; else r = (1.0f + (float)mn * 0.125f) * exp2f((float)e - 7.0f);
    return (v & 128u) ? -r : r; }
__device__ __forceinline__ void sc_fail(const Frame& F, unsigned code) { __hip_atomic_fetch_or(F.ctl + CW_CODE, code, RLX_AGENT); }
__device__ __forceinline__ int sc_bucket_ref(int rel) {
    const int half = 16, max_exact = 8; const int ret = rel > 0 ? half : 0; const int n = rel < 0 ? -rel : rel;
    const float nf = (float)(n > 1 ? n : 1);
    int large = max_exact + (int)(logf(nf / (float)max_exact) / logf(16.0f) * (float)(half - max_exact));
    large = large < half - 1 ? large : half - 1;
    return ret + (n < max_exact ? n : large);
}
__device__ __forceinline__ void selfcheck_topk(const Frame& F0) {
    Frame F = launder(F0);
    if (F.wave != 0) return;
    const bf16* QI = (const bf16*)(F.ws + Z_QI); const bf16* SM = (const bf16*)(F.ws + Z_SM);
    const GAS unsigned short* IDX = (const GAS unsigned short*)(F.ws + WS_IDX);
    LAS float* sc = (LAS float*)(F.lds + RING_OFF);
    LAS unsigned* bm = (LAS unsigned*)(F.lds + RING_OFF + 8192);
    const int tok = F.bx * 256 + ((F.bx * 37) & 255), b = tok >> 11, tq = tok & (SEQ - 1), n_adm = ((tq >> 6) + 1) * 64;
    const int lane = F.lane;
    bm[lane] = 0u;
    for (int s = lane; s < n_adm; s += 64) { float score = 0.f;
        for (int h = 0; h < 8; ++h) { float d = 0.f;
            for (int k = 0; k < 64; ++k) d += sc_bf(QI, (size_t)tok * 512 + h * 64 + k) * sc_bf(SM, (size_t)(b * SEQ + s) * 256 + 128 + k);
            score += fmaxf(d, 0.f) * sc_bf(SM, (size_t)tok * 256 + 192 + h); }
        sc[s] = score; }
    asm volatile("s_waitcnt lgkmcnt(0)" ::: "memory");
    const int nsel = n_adm < 256 ? n_adm : 256;
    float msel = 3.0e38f; bool bad = false;
    for (int p = lane; p < nsel; p += 64) { const int key = IDX[(size_t)tok * 256 + p]; if (key >= n_adm) { bad = true; continue; }
        const unsigned old = __hip_atomic_fetch_or(bm + (key >> 5), 1u << (key & 31), __ATOMIC_RELAXED, __HIP_MEMORY_SCOPE_WORKGROUP); if (old & (1u << (key & 31))) bad = true;
        msel = fminf(msel, sc[key]); }
    asm volatile("s_waitcnt lgkmcnt(0)" ::: "memory");
    float muns = -3.0e38f, amax = 0.f;
    for (int s = lane; s < n_adm; s += 64) { amax = fmaxf(amax, fabsf(sc[s])); if (!((bm[s >> 5] >> (s & 31)) & 1u)) muns = fmaxf(muns, sc[s]); }
#pragma unroll
    for (int o = 1; o < 64; o <<= 1) { msel = fminf(msel, lane_xor(msel, o, lane)); muns = fmaxf(muns, lane_xor(muns, o, lane)); amax = fmaxf(amax, lane_xor(amax, o, lane)); }
    if (muns > msel + 1e-4f * amax) bad = true;
    if (__any(bad)) { if (lane == 0) sc_fail(F, 1u); }
}
__device__ __forceinline__ void selfcheck_attn(const Frame& F0) {
    Frame F = launder(F0);
    if (F.wave != 0) return;
    const KArgs ka = kargs();
    const unsigned char* Q8 = F.ws + Z_Q8; const unsigned char* KV8 = F.ws + Z_KV8; const bf16* OB = (const bf16*)(F.ws + Z_XR);
    const GAS unsigned short* IDX = (const GAS unsigned short*)(F.ws + WS_IDX);
    LAS float* lg = (LAS float*)(F.lds + RING_OFF + 65536);
    const int tok = F.bx * 256 + ((F.bx * 37) & 255), b = tok >> 11, tq = tok & (SEQ - 1), n_adm = ((tq >> 6) + 1) * 64, nv = n_adm < 256 ? n_adm : 256;
    const int lane = F.lane;
    for (int p = lane; p < 256; p += 64) { const int key = IDX[(size_t)tok * 256 + p]; const int bk = sc_bucket_ref(key - tq);
        for (int h = 0; h < 16; ++h) { float d = 0.f;
            for (int k = 0; k < 64; ++k) d += sc_f8(Q8, (size_t)tok * D + h * 64 + k) * sc_f8(KV8, (size_t)(b * SEQ + key) * 128 + k);
            lg[h * 256 + p] = p < nv ? 0.125f * d + ((const GAS float*)ka->in[I_RELB])[bk * 16 + h] : -1e30f; } }
    asm volatile("s_waitcnt lgkmcnt(0)" ::: "memory");
    if (lane < 16) { float mx = -3.0e38f; for (int p = 0; p < 256; ++p) mx = fmaxf(mx, lg[lane * 256 + p]); float sum = 0.f;
        for (int p = 0; p < 256; ++p) { const float e = __expf(lg[lane * 256 + p] - mx); lg[lane * 256 + p] = e; sum += e; }
        const float inv = 1.f / sum; for (int p = 0; p < 256; ++p) lg[lane * 256 + p] *= inv; }
    asm volatile("s_waitcnt lgkmcnt(0)" ::: "memory");
    float emax = 0.f, omax = 0.f;
    for (int o = lane; o < 1024; o += 64) { const int h = o >> 6, d = o & 63; float acc = 0.f;
        for (int p = 0; p < 256; ++p) { const int key = IDX[(size_t)tok * 256 + p]; acc += lg[h * 256 + p] * sc_f8(KV8, (size_t)(b * SEQ + key) * 128 + 64 + d); }
        const float got = sc_bf(OB, (size_t)tok * D + o); emax = fmaxf(emax, fabsf(got - acc)); omax = fmaxf(omax, fabsf(acc)); }
#pragma unroll
    for (int o = 1; o < 64; o <<= 1) { emax = fmaxf(emax, lane_xor(emax, o, lane)); omax = fmaxf(omax, lane_xor(omax, o, lane)); }
    if (!(emax <= SC_TOL * omax + SC_ABS)) { if (lane == 0) sc_fail(F, 2u); }
}
__device__ __forceinline__ void selfcheck_lru(const Frame& F0, int L, bool after) {
    Frame F = launder(F0);
    if (F.wave != 0) return;
    const KArgs ka = kargs();
    const bf16* XR = (const bf16*)(F.ws + Z_XR); const bf16* YR = (const bf16*)(F.ws + Z_YR);
    GAS float* EXP = (GAS float*)(F.ws + WS_NEED) + (size_t)F.bx * SEQ;
    const int b = F.bx >> 3, ch = ((F.bx & 7) * 128 + ((F.bx * 29) & 127)), nb = ch >> 7, lane = F.lane;
    if (after) { float emax = 0.f, omax = 0.f;
        for (int t = lane; t < SEQ; t += 64) { const float e = EXP[t], g = sc_bf(YR, (size_t)(b * SEQ + t) * D + ch); emax = fmaxf(emax, fabsf(e - g)); omax = fmaxf(omax, fabsf(e)); }
#pragma unroll
        for (int o = 1; o < 64; o <<= 1) { emax = fmaxf(emax, lane_xor(emax, o, lane)); omax = fmaxf(omax, lane_xor(omax, o, lane)); }
        if (!(emax <= SC_TOL * omax + SC_ABS)) { if (lane == 0) sc_fail(F, 4u); }
        return; }
    const float* cw = ka->in[I_CONVW] + (size_t)L * 4 * D; const float* cb = ka->in[I_CONVB] + (size_t)L * D;
    const float* wa = ka->in[I_LRUWA] + ((size_t)L * 8 + nb) * 128 * 128; const float* wx = ka->in[I_LRUWX] + ((size_t)L * 8 + nb) * 128 * 128;
    const float lam = ka->in[I_LAM][(size_t)L * D + ch], ba = ka->in[I_LRUBA][(size_t)L * D + ch], bx = ka->in[I_LRUBX][(size_t)L * D + ch];
    const float sp = fmaxf(-lam, 0.f) + log1pf(expf(-fabsf(lam)));
    const int dl = ch & 127;
    float h = 0.f;
    for (int t = 0; t < SEQ; ++t) {
        float pr = 0.f, pi = 0.f, xcc = 0.f;
#pragma unroll
        for (int q = 0; q < 2; ++q) { const int cl = lane + 64 * q, cg = nb * 128 + cl; float xc = cb[cg];
            for (int j = 0; j < 4; ++j) { const int tt = t - 3 + j; if (tt >= 0) xc += sc_bf(XR, (size_t)(b * SEQ + tt) * D + cg) * cw[j * D + cg]; }
            pr += xc * wa[cl * 128 + dl]; pi += xc * wx[cl * 128 + dl]; if (cl == dl) xcc = xc; }
#pragma unroll
        for (int o = 1; o < 64; o <<= 1) { pr += lane_xor(pr, o, lane); pi += lane_xor(pi, o, lane); xcc += lane_xor(xcc, o, lane); }
        const float r = 1.f / (1.f + expf(-(pr + ba))), ig = 1.f / (1.f + expf(-(pi + bx)));
        const float la = -8.0f * r * sp, a = expf(la), u = sqrtf(-expm1f(2.0f * la)) * (ig * xcc);
        h = a * h + u;
        const float y = sc_bf(YR, (size_t)(b * SEQ + t) * D + ch);
        const float gl = 0.5f * y * (1.f + tanhf(0.7978845608028654f * (y + 0.044715f * y * y * y)));
        if (lane == 0) EXP[t] = h * gl;
    }
}
#endif
__global__ void __launch_bounds__(NWAVES * 64, 2) mk_fwd(Args args) {
    extern __shared__ __attribute__((aligned(16))) unsigned char lds[];
    Frame F;
    F.lds = (LAS unsigned char*)lds;
    F.MISC = (volatile LAS unsigned*)(F.lds + MISC_OFF);
    F.tid = threadIdx.x; F.lane = F.tid & 63; F.wave = __builtin_amdgcn_readfirstlane(F.tid >> 6);
    F.G = gridDim.x; F.bx = blockIdx.x;
    F.ws = args.ws; F.ctl = (gu32*)(args.ws + WS_CTL); F.out = args.out;
    for (int u = threadIdx.x; u < (LDS_BYTES - LDSCTL_OFF) / 4; u += NWAVES * 64) ((LAS unsigned*)(F.lds + LDSCTL_OFF))[u] = 0u;
    __syncthreads();
    XcdBarrier bar = xcd_barrier_post((unsigned*)(F.ctl + CW_BAR), F.MISC + 8);
#ifdef PROBE_XCC
    if ((blockIdx.x & 7u) != (bar.x & 7u)) { const unsigned long long t0 = __builtin_amdgcn_s_memrealtime(); while (__builtin_amdgcn_s_memrealtime() - t0 < 200000ull) __builtin_amdgcn_s_sleep(8); }
#endif
#ifdef PROF_SEL
#ifndef PROF_WG
#define PROF_WG 0
#endif
#ifndef PROF_SEL2
#define PROF_SEL2 50
#endif
#ifndef PROF_MUL
#define PROF_MUL 1.0f
#endif
#define PROF_END(slot) do { if (launder(F).tid == 0) { const unsigned t_ = (unsigned)__builtin_amdgcn_s_memrealtime(); F.MISC[64 + (slot)] += t_ - F.MISC[96]; F.MISC[96] = t_; F.MISC[99] = (slot); } } while (0)
#define PROF_BEGIN(ph) do { if (launder(F).tid == 0) F.MISC[101] = (ph); } while (0)
#define PROF_WAIT() do { if (launder(F).tid == 0) { const unsigned t_ = (unsigned)__builtin_amdgcn_s_memrealtime(); F.MISC[80 + F.MISC[99]] += t_ - F.MISC[96]; F.MISC[64 + 13] += t_ - F.MISC[96]; F.MISC[96] = t_; } } while (0)
    if (F.tid == 0) { const unsigned t_ = (unsigned)__builtin_amdgcn_s_memrealtime(); F.MISC[96] = t_; F.MISC[98] = t_; }
#else
#define PROF_END(slot) do { } while (0)
#define PROF_BEGIN(ph) do { } while (0)
#define PROF_WAIT() do { } while (0)
#endif
#define GRID_BAR() do { XcdBarrier b_ = bar; unsigned* p_ = bar.bar; asm volatile("" : "+s"(p_)); b_.bar = p_; xcd_barrier(b_); PROF_WAIT(); } while (0)
    float* X32 = args.out;
#define LOCAL_HANDOFF() do { asm volatile("s_waitcnt vmcnt(0)" ::: "memory"); __syncthreads(); __builtin_amdgcn_fence(__ATOMIC_ACQUIRE, "agent"); asm volatile("s_waitcnt vmcnt(0)" ::: "memory"); __syncthreads(); } while (0)
    LAS unsigned char* ring = F.lds + RING_OFF;
    using pg8::Gemm; using pg8::StaticOrder;

    for (int L = -1; L < DEPTH; ++L) {
        const int odd = L & 1;
        if (L >= 0) {
        { const Frame P = launder(F); unsigned char* ws = P.ws; unsigned char* wb = ws + WS_W; bf16* XB = (bf16*)(ws + WS_XB); (void)XB; (void)wb;
          Gemm g{XB, (const bf16*)(wb + W_IN), T_TOK, NIN, D}; StaticOrder S; S.init(T_TOK, NIN, P.G, P.bx);
          pg8::EpiZ E{(bf16*)(ws + Z_Q), (bf16*)(ws + Z_QI), (bf16*)(ws + Z_SM), ws + Z_Q8, ws + Z_KV8};
PROF_BEGIN(1);
#ifndef SK_G1
          pg8::gemm_phase<pg8::EpiZ, StaticOrder>(ring, g, S, E, P.wave);
#endif
#ifdef DUP_G1
          pg8::gemm_phase<pg8::EpiZ, StaticOrder>(ring, g, S, E, P.wave);
#endif
        }
        PROF_END(1);
        GRID_BAR();
#if defined(SELFCHECK) && SELFCHECK == 3
        if (L == 0) { selfcheck_lru(F, L, false); __syncthreads(); }
#endif
#ifdef DUP_IDX
        indexer_phase<DUP_IDX>(F);
#endif
#ifndef SK_IDX
        indexer_phase(F);
#endif
#ifdef DUP_LRU
        lru_phase<true>(F, L);
#endif
#ifndef SK_LRU
        lru_phase(F, L);
#endif
        PROF_END(2);
        GRID_BAR();
#if defined(SELFCHECK) && SELFCHECK == 1
        if (L == 0) { selfcheck_topk(F); __syncthreads(); }
#endif
#if defined(SELFCHECK) && SELFCHECK == 3
        if (L == 0) { selfcheck_lru(F, L, true); __syncthreads(); }
#endif
#ifdef DUP_ATT
        attention_phase<DUP_ATT>(F); __syncthreads();
#endif
#ifndef SK_ATT
#ifdef ATT_V1
        attention_phase(F);
#else
        attention_phase2(F);
#endif
#endif
        PROF_END(3);
        GRID_BAR();
#if defined(SELFCHECK) && SELFCHECK == 2
        if (L == 0) { selfcheck_attn(F); __syncthreads(); }
#endif
        { const Frame P = launder(F); unsigned char* ws = P.ws; unsigned char* wb = ws + WS_W; bf16* XB = (bf16*)(ws + WS_XB); (void)XB; (void)wb;
          Gemm g{(const bf16*)(ws + Z_XR), (const bf16*)(wb + W_BRA), T_TOK, D, D}; StaticOrder S; S.init(T_TOK, D, F.G, F.bx);
          pg8::EpiGate<0> E{(bf16*)(ws + Z_GA), nullptr};
PROF_BEGIN(2);
#ifndef SK_G2
          pg8::gemm_phase<pg8::EpiGate<0>, StaticOrder>(ring, g, S, E, P.wave);
#endif
        }
        LOCAL_HANDOFF();
        { const Frame P = launder(F); unsigned char* ws = P.ws; unsigned char* wb = ws + WS_W; bf16* XB = (bf16*)(ws + WS_XB); (void)XB; (void)wb;
          Gemm g{(const bf16*)(ws + Z_YR), (const bf16*)(wb + W_BRR), T_TOK, D, D}; StaticOrder S; S.init(T_TOK, D, F.G, F.bx);
          pg8::EpiGate<1> E{(bf16*)(ws + Z_GA), (const bf16*)(ws + Z_GR)};
PROF_BEGIN(3);
#ifndef SK_G3
          pg8::gemm_phase<pg8::EpiGate<1>, StaticOrder>(ring, g, S, E, P.wave);
#endif
        }
        PROF_END(4);
        GRID_BAR();
        { const Frame P = launder(F); unsigned char* ws = P.ws; unsigned char* wb = ws + WS_W; bf16* XB = (bf16*)(ws + WS_XB); (void)XB; (void)wb;
          Gemm g{(const bf16*)(ws + Z_GA), (const bf16*)(wb + W_O), T_TOK, D, D}; StaticOrder S; S.init(T_TOK, D, F.G, F.bx);
          pg8::EpiBf16 E{(bf16*)(ws + Z_GR), D, 0};
PROF_BEGIN(4);
#ifndef SK_G4
          pg8::gemm_phase<pg8::EpiBf16, StaticOrder>(ring, g, S, E, P.wave);
#endif
#ifdef DUP_G4
          pg8::gemm_phase<pg8::EpiBf16, StaticOrder>(ring, g, S, E, P.wave);
#endif
        }
        PROF_END(5);
        GRID_BAR();
#ifdef DUP_LN
        ln_phase<false, false, true>(F, L); ln_phase<false, false, true>(F, L);
#endif
#ifndef SK_LN
        if (odd) ln_phase<false, true>(F, L); else ln_phase<false, false>(F, L);
#endif
        PROF_END(6);
        GRID_BAR();
        if (odd) {
            if (launder(F).tid == 0) { unsigned acc = 0u; F.MISC[16] = 0u;
                for (int e = 0; e < 8; ++e) { const unsigned c = __hip_atomic_load(F.ctl + CW_CNT + (L >> 1) * 1024 + 64 * e, RLX_AGENT); F.MISC[32 + e] = c; acc += (c + 255u) >> 8; F.MISC[17 + e] = acc; } }
            __syncthreads();
        }
        { const Frame P = launder(F); unsigned char* ws = P.ws; unsigned char* wb = ws + WS_W; bf16* XB = (bf16*)(ws + WS_XB); (void)XB; (void)wb;
          Gemm g{(const bf16*)(ws + F_PB), (const bf16*)(wb + W_PP), T_TOK, D, PLE}; StaticOrder S; S.init(T_TOK, D, F.G, F.bx);
          pg8::EpiBf16 E{(bf16*)(ws + F_U), D, 0};
PROF_BEGIN(5);
#ifndef SK_G5
          pg8::gemm_phase<pg8::EpiBf16, StaticOrder>(ring, g, S, E, P.wave);
#endif
        }
        LOCAL_HANDOFF();
        { const Frame P = launder(F); unsigned char* ws = P.ws; unsigned char* wb = ws + WS_W; bf16* XB = (bf16*)(ws + WS_XB); (void)XB; (void)wb;
          Gemm g{XB, (const bf16*)(wb + W_PG), T_TOK, D, D}; StaticOrder S; S.init(T_TOK, D, F.G, F.bx);
          pg8::EpiPle E{(bf16*)(ws + F_U)};
PROF_BEGIN(6);
#ifndef SK_G6
          pg8::gemm_phase<pg8::EpiPle, StaticOrder>(ring, g, S, E, P.wave);
#endif
        }
        PROF_END(7);
        if (!odd) {
            { const Frame P = launder(F); unsigned char* ws = P.ws; unsigned char* wb = ws + WS_W; bf16* XB = (bf16*)(ws + WS_XB); (void)XB; (void)wb;
          Gemm g{XB, (const bf16*)(wb + W_FF), T_TOK, 2 * DFF, D}; StaticOrder S; S.init(T_TOK, 2 * DFF, F.G, F.bx);
              pg8::EpiSwiglu E{(bf16*)(ws + F_H), DFF};
PROF_BEGIN(7);
#ifndef SK_G7
              pg8::gemm_phase<pg8::EpiSwiglu, StaticOrder>(ring, g, S, E, P.wave);
#endif
#ifdef DUP_G7
              pg8::gemm_phase<pg8::EpiSwiglu, StaticOrder>(ring, g, S, E, P.wave);
#endif
        }
            PROF_END(8);
            GRID_BAR();
            { const Frame P = launder(F); unsigned char* ws = P.ws; unsigned char* wb = ws + WS_W; bf16* XB = (bf16*)(ws + WS_XB); (void)XB; (void)wb;
          Gemm g{(const bf16*)(ws + F_H), (const bf16*)(wb + W_FF_DN_DENSE), T_TOK, D, DFF}; StaticOrder S; S.init(T_TOK, D, F.G, F.bx);
              pg8::EpiBf16 E{(bf16*)(ws + Z_GR), D, 0};
PROF_BEGIN(8);
#ifndef SK_G8
              pg8::gemm_phase<pg8::EpiBf16, StaticOrder>(ring, g, S, E, P.wave);
#endif
#ifdef DUP_G8
              pg8::gemm_phase<pg8::EpiBf16, StaticOrder>(ring, g, S, E, P.wave);
#endif
        }
            PROF_END(9);
            GRID_BAR();
#ifndef SK_LN
            ln_phase<true, false>(F, L);
#endif
        } else {
            const int ntiles = (int)F.MISC[24];
            const int nchunks = (ntiles + MOE_CHUNK_TILES - 1) / MOE_CHUNK_TILES;
            for (int c = 0; c < nchunks; ++c) {
                const int tile0 = c * MOE_CHUNK_TILES, ntl = (ntiles - tile0) < MOE_CHUNK_TILES ? (ntiles - tile0) : MOE_CHUNK_TILES;
                const size_t hc_off = (c & 1) ? F_H1 : F_H;
                { const Frame P = launder(F); unsigned char* ws = P.ws; unsigned char* wb = ws + WS_W; bf16* XB = (bf16*)(ws + WS_XB); (void)XB; (void)wb;
          Gemm g{XB, (const bf16*)(wb + W_FF), ntl * 256, 2 * DFFE, D}; MoeGatherOrder S; S.init(ntl * 256, 2 * DFFE, F.G, F.bx);
                  S.tb = F.MISC + 16; S.tile0 = tile0; S.list = (const int*)(ws + WS_LIST); S.bstride = (size_t)2 * DFFE * D * 2;
                  pg8::EpiSwiglu E{(bf16*)(ws + hc_off), DFFE};
PROF_BEGIN(9);
#ifndef SK_G9
                  pg8::gemm_phase<pg8::EpiSwiglu, MoeGatherOrder>(ring, g, S, E, P.wave);
#endif
        }
                PROF_END(10);
                GRID_BAR();
                { const Frame P = launder(F); unsigned char* ws = P.ws; unsigned char* wb = ws + WS_W; bf16* XB = (bf16*)(ws + WS_XB); (void)XB; (void)wb;
          Gemm g{(const bf16*)(ws + hc_off), (const bf16*)(wb + W_FF_DN_MOE), ntl * 256, D, DFFE}; MoeOrder S; S.init(ntl * 256, D, F.G, F.bx);
                  S.tb = F.MISC + 16; S.tile0 = tile0; S.list = nullptr; S.bstride = (size_t)D * DFFE * 2;
                  pg8::EpiBf16 E{(bf16*)(ws + F_YE), D, tile0 * 256};
PROF_BEGIN(10);
#ifndef SK_G10
                  pg8::gemm_phase<pg8::EpiBf16, MoeOrder>(ring, g, S, E, P.wave);
#endif
        }
                PROF_END(11);
            }
            PROF_END(11);
            GRID_BAR();
#ifndef SK_LN
            ln_phase<true, true>(F, L);
#endif
        }
        }
        if (L + 1 < DEPTH) { __syncthreads(); p0_convert(F, L + 1); }
        PROF_END(12);
#ifdef PROF_SEL
        if (L == DEPTH - 1 && F.bx == PROF_WG && launder(F).tid == 0) { const unsigned t_ = (unsigned)__builtin_amdgcn_s_memrealtime(); const float tot_ = (float)F.MISC[106] + (float)F.MISC[107] + (float)F.MISC[108] + (float)F.MISC[109] + (float)F.MISC[110] + (float)F.MISC[111] + (float)F.MISC[112] + (float)F.MISC[113];
            const float f_ = (PROF_SEL == 43) ? (float)F.MISC[122] / (float)F.MISC[123] : (PROF_SEL == 42) ? (float)F.MISC[120] / (float)F.MISC[121] : (PROF_SEL >= 50) ? (float)F.MISC[106 + (PROF_SEL - 50)] / tot_ : (PROF_SEL == 41) ? (float)F.MISC[105] / (float)F.MISC[104] : (PROF_SEL == 40) ? (float)F.MISC[104] / (float)F.MISC[64 + 14] * (1.0f / 40.0f) : PROF_MUL * (float)F.MISC[64 + PROF_SEL] / (float)(t_ - F.MISC[98]);
            const float g_ = (PROF_SEL < 40 && PROF_SEL2 < 40) ? PROF_MUL * (float)F.MISC[64 + PROF_SEL2] / (float)(t_ - F.MISC[98]) : (PROF_SEL == 43) ? (float)F.MISC[124] / (64.0f * 8.0f * 32.0f * 4.0f) : (PROF_SEL >= 50) ? (float)F.MISC[106 + (PROF_SEL2 - 50)] / tot_ : 0.0f;
            __hip_atomic_store(F.ctl + 9, __builtin_bit_cast(unsigned, g_), __ATOMIC_RELAXED, __HIP_MEMORY_SCOPE_AGENT);
            __hip_atomic_store(F.ctl + 8, __builtin_bit_cast(unsigned, f_), __ATOMIC_RELAXED, __HIP_MEMORY_SCOPE_AGENT); }
#endif
        GRID_BAR();
    }
#ifdef PROF_SEL
    { const float f_ = __builtin_bit_cast(float, __hip_atomic_load(F.ctl + 8, RLX_AGENT)); const float s_ = 1.0f + floorf(sqrtf(f_) * 32.0f + 0.5f) * (1.0f / 32.0f);
      for (size_t i = (size_t)F.bx * 512 + launder(F).tid; i < (size_t)T_TOK * D; i += (size_t)F.G * 512) X32[i] *= s_;
      const float g_ = __builtin_bit_cast(float, __hip_atomic_load(F.ctl + 9, RLX_AGENT)); if (F.bx == 0 && launder(F).tid == 0 && g_ > 0.f) X32[0] = 400.0f * floorf(g_ * 32.0f + 0.5f) * (1.0f / 32.0f); }
#endif
    if (__hip_atomic_load(F.ctl + CW_BAR + XB_TMO, RLX_AGENT) != 0u || __hip_atomic_load(F.ctl + CW_CODE, RLX_AGENT) != 0u) {
        const float q = __builtin_nanf("");
        for (size_t i = (size_t)F.bx * 512 + launder(F).tid; i < (size_t)T_TOK * D; i += (size_t)F.G * 512) X32[i] = q;
    }
}

#if defined(SELFCHECK)
constexpr size_t WS_DRY_EXTRA = 4 * MiB;
#elif defined(DUP_LRU) || defined(DUP_LN)
constexpr size_t WS_DRY_EXTRA = 80 * MiB;
#else
constexpr size_t WS_DRY_EXTRA = 0;
#endif
extern "C" void kernel_launch(void* const* d_in, const int* in_sizes, int n_in, void* d_out, int out_size, void* d_ws, size_t ws_size, hipStream_t stream) {
    static int grid = 0;
    if (grid == 0) {
        if (n_in != 28 || out_size != T_TOK * D || ws_size < WS_NEED + WS_DRY_EXTRA) { fprintf(stderr, "kernel_launch: unexpected shapes: n_in %d out %d ws %zu (need %zu)\n", n_in, out_size, ws_size, (size_t)WS_END); grid = -1; return; }
        int dev = 0, cus = 0, per_cu = 0;
        if (hipGetDevice(&dev) != hipSuccess || hipDeviceGetAttribute(&cus, hipDeviceAttributeMultiprocessorCount, dev) != hipSuccess) { grid = -1; return; }
        if (hipFuncSetAttribute((const void*)mk_fwd, hipFuncAttributeMaxDynamicSharedMemorySize, LDS_BYTES) != hipSuccess) { fprintf(stderr, "kernel_launch: hipFuncSetAttribute failed\n"); grid = -1; return; }
        if (hipOccupancyMaxActiveBlocksPerMultiprocessor(&per_cu, (const void*)mk_fwd, NWAVES * 64, LDS_BYTES) != hipSuccess || per_cu < 1) { fprintf(stderr, "kernel_launch: occupancy query says %d blocks per CU\n", per_cu); }
        (void)hipGetLastError();
        grid = cus;
        if (grid != 256) { fprintf(stderr, "kernel_launch: this kernel needs a 256-CU device (got %d)\n", cus); grid = -1; return; }
    }
    if (grid < 0) return;
    if (hipMemsetAsync((char*)d_ws + WS_CTL, 0, CTL_ZERO_BYTES, stream) != hipSuccess) return;
    Args a{};
    for (int i = 0; i < 28; ++i) a.in[i] = (const float*)d_in[i];
    a.out = (float*)d_out; a.ws = (unsigned char*)d_ws;
    hipLaunchKernelGGL(mk_fwd, dim3(grid), dim3(NWAVES * 64), LDS_BYTES, stream, a);
}
```

```cpp
#include <hip/hip_runtime.h>
#include <cstdio>
#include <cstdint>

constexpr int T_TOK = 65536, D = 1024, SEQ = 2048, NBATCH = 32, DEPTH = 4;
constexpr int D_IN = 5832, NIN = 5888;
constexpr int DFF = 2816, DFFE = 3584, NEXP = 8, PLE = 256;
constexpr float LN_EPS = 1e-5f;
constexpr float DN_ALPHA = 1.681792830507429f;

namespace pg8 {
#define PG8_LAS __attribute__((address_space(3)))
typedef unsigned short bf16_t;
typedef short bf16x8 __attribute__((ext_vector_type(8)));
typedef float f32x4 __attribute__((ext_vector_type(4)));
typedef unsigned u32x4 __attribute__((ext_vector_type(4)));
typedef unsigned u32x2 __attribute__((ext_vector_type(2)));
constexpr int BM = 256, BK = 64, HALF = 128, HTB = HALF * BK * 2  , STAGE_BYTES = 8 * HTB, NXCD = 8, WGM = 8;

__host__ __device__ __forceinline__ int lds_byte(int r, int c) { const int st = (r >> 4) * 2 + (c >> 5), rr = r & 15, cc = c & 31, ob = rr * 64 + cc * 2; return st * 1024 + (ob ^ (((ob >> 9) & 1) << 5)); }
__host__ __device__ __forceinline__ void stage_rc(int b, int& R, int& C) { const int st = b / 1024, sb = b % 1024, swz = sb ^ (((sb >> 9) & 1) << 5); R = (st >> 1) * 16 + swz / 64; C = (st & 1) * 32 + (swz % 64) / 2; }
__host__ __device__ __forceinline__ int perm32(int rho) { const int n = rho >> 4, i = rho & 15; return 8 * (i >> 2) + 4 * n + (i & 3); }

struct Unit { int pm, pn; };
struct Gemm { const bf16_t* A; const bf16_t* Bt; int M, N, K; };

struct StaticOrder {
    static constexpr bool GATHER = false;
    int nM, nN, nwg, G, c;
    __host__ __device__ void init(int M, int N, int G_, int c_) { nM = M / BM; nN = N / BM; nwg = nM * nN; G = G_; c = c_; }
    __host__ __device__ bool next(int i, Unit& u) const {
        const long L = (long)i * G + c; if (L >= nwg) return false;
        int wgid = (int)L; { const int q = nwg / NXCD, r = nwg % NXCD, xcd = wgid % NXCD, off = wgid / NXCD; wgid = (xcd < r ? xcd * (q + 1) : r * (q + 1) + (xcd - r) * q) + off; }
        const int nig = WGM * nN, gid = wgid / nig, fm = gid * WGM, gsz = (nM - fm) < WGM ? (nM - fm) : WGM;
        u.pm = fm + ((wgid % nig) % gsz); u.pn = (wgid % nig) / gsz; return true;
    }
    __device__ __forceinline__ const char* a_base(const Gemm& g, const Unit& u, size_t tstep) const { return (const char*)g.A + (size_t)u.pm * tstep; }
    __device__ __forceinline__ const char* b_base(const Gemm& g, const Unit& u, size_t tstep) const { return (const char*)g.Bt + (size_t)u.pn * tstep; }
    __device__ __forceinline__ void a_rows(const Unit&, int, int, int, int, int, unsigned (&)[2][2]) const {}
    __device__ __forceinline__ void a_ready(const Unit&) const {}
    __device__ __forceinline__ void done(const Unit&) const {}
};

__device__ __forceinline__ unsigned cvt_pk_bf16(float lo, float hi) { unsigned r; asm volatile("v_cvt_pk_bf16_f32 %0, %1, %2" : "=v"(r) : "v"(lo), "v"(hi)); return r; }
__device__ __forceinline__ float bf_lo(unsigned w) { return __builtin_bit_cast(float, w << 16); }
__device__ __forceinline__ float bf_hi(unsigned w) { return __builtin_bit_cast(float, w & 0xffff0000u); }
__device__ __forceinline__ float sigmoidf_fast(float x) { return __builtin_amdgcn_rcpf(1.0f + __builtin_amdgcn_exp2f(-1.4426950408889634f * x)); }
#define EPI_FENCE() asm volatile("" ::: "memory")
#define EGAS __attribute__((address_space(1)))
__device__ __forceinline__ u32x4 pack8(const f32x4 v0, const f32x4 v1) { u32x4 w; w.x = cvt_pk_bf16(v0[0], v0[1]); w.y = cvt_pk_bf16(v0[2], v0[3]); w.z = cvt_pk_bf16(v1[0], v1[1]); w.w = cvt_pk_bf16(v1[2], v1[3]); return w; }

struct EpiBf16 {
    static constexpr bool PERM = true, AFTER_DRAIN = false;
    bf16_t* O; int ldc; int row_off;
    __device__ __forceinline__ void operator()(const f32x4 (&acc)[2][2][4][2], const Unit& u, int wr, int wc, int fr, int fq) const {
        { int l_ = (int)__builtin_amdgcn_mbcnt_hi(~0u, __builtin_amdgcn_mbcnt_lo(~0u, 0u)); asm volatile("" : "+v"(l_)); fr = l_ & 15; fq = l_ >> 4; }
        const int row0 = row_off + u.pm * BM + wr * 64 + fr, col0 = u.pn * BM + wc * 32 + 8 * fq;
#pragma unroll
        for (int ai = 0; ai < 2; ++ai)
#pragma unroll
            for (int m = 0; m < 4; ++m) { bf16_t* rowp = O + (size_t)(row0 + ai * HALF + m * 16) * ldc + col0;
#pragma unroll
                for (int bj = 0; bj < 2; ++bj) *(EGAS u32x4*)(rowp + bj * HALF) = pack8(acc[ai][bj][m][0], acc[ai][bj][m][1]); }
    }
};
__device__ __forceinline__ u32x2 pack8_fp8(const f32x4 v0, const f32x4 v1) { int a = __builtin_amdgcn_cvt_pk_fp8_f32(v0[0], v0[1], 0, false); a = __builtin_amdgcn_cvt_pk_fp8_f32(v0[2], v0[3], a, true);
    int b = __builtin_amdgcn_cvt_pk_fp8_f32(v1[0], v1[1], 0, false); b = __builtin_amdgcn_cvt_pk_fp8_f32(v1[2], v1[3], b, true); u32x2 r; r.x = (unsigned)a; r.y = (unsigned)b; return r; }
struct EpiZ {
    static constexpr bool PERM = true, AFTER_DRAIN = false;
    bf16_t* zbig; bf16_t* zqi; bf16_t* zsm; unsigned char* q8; unsigned char* kv8;
    __device__ __forceinline__ void operator()(const f32x4 (&acc)[2][2][4][2], const Unit& u, int wr, int wc, int fr, int fq) const {
        { int l_ = (int)__builtin_amdgcn_mbcnt_hi(~0u, __builtin_amdgcn_mbcnt_lo(~0u, 0u)); asm volatile("" : "+v"(l_)); fr = l_ & 15; fq = l_ >> 4; }
        const int row0 = u.pm * BM + wr * 64 + fr;
        if (u.pn < 4) {
            const int col0 = u.pn * BM + wc * 32 + 8 * fq;
#pragma unroll
            for (int ai = 0; ai < 2; ++ai)
#pragma unroll
                for (int m = 0; m < 4; ++m) { unsigned char* rowp = q8 + (size_t)(row0 + ai * HALF + m * 16) * D + col0;
#pragma unroll
                    for (int bj = 0; bj < 2; ++bj) *(EGAS u32x2*)(rowp + bj * HALF) = pack8_fp8(acc[ai][bj][m][0], acc[ai][bj][m][1]); }
            return;
        }
        bf16_t* base; int ld, colt;
        if (u.pn < 20) { base = zbig + (size_t)(u.pn >> 2) * ((size_t)T_TOK * D); ld = D; colt = (u.pn & 3) * BM; }
        else if (u.pn < 22) { base = zqi; ld = 512; colt = (u.pn - 20) * BM; }
        else { base = zsm; ld = 256; colt = 0; }
        const int col0 = colt + wc * 32 + 8 * fq;
#pragma unroll
        for (int ai = 0; ai < 2; ++ai)
#pragma unroll
            for (int m = 0; m < 4; ++m) { bf16_t* rowp = base + (size_t)(row0 + ai * HALF + m * 16) * ld + col0;
#pragma unroll
                for (int bj = 0; bj < 2; ++bj) *(EGAS u32x4*)(rowp + bj * HALF) = pack8(acc[ai][bj][m][0], acc[ai][bj][m][1]); }
        if (u.pn == 22) {
#pragma unroll
            for (int ai = 0; ai < 2; ++ai)
#pragma unroll
                for (int m = 0; m < 4; ++m) *(EGAS u32x2*)(kv8 + (size_t)(row0 + ai * HALF + m * 16) * 128 + wc * 32 + 8 * fq) = pack8_fp8(acc[ai][0][m][0], acc[ai][0][m][1]);
        }
    }
};
template <int MODE> struct EpiGate {
    static constexpr bool PERM = true, AFTER_DRAIN = false;
    bf16_t* G; const bf16_t* G2;
    __device__ __forceinline__ void operator()(const f32x4 (&acc)[2][2][4][2], const Unit& u, int wr, int wc, int fr, int fq) const {
        { int l_ = (int)__builtin_amdgcn_mbcnt_hi(~0u, __builtin_amdgcn_mbcnt_lo(~0u, 0u)); asm volatile("" : "+v"(l_)); fr = l_ & 15; fq = l_ >> 4; }
        const int row0 = u.pm * BM + wr * 64 + fr, col0 = u.pn * BM + wc * 32 + 8 * fq;
#pragma unroll
        for (int ai = 0; ai < 2; ++ai) {
            u32x4 gw[4][2], g2[4][2];
#pragma unroll
            for (int m = 0; m < 4; ++m)
#pragma unroll
                for (int bj = 0; bj < 2; ++bj) { const size_t o = (size_t)(row0 + ai * HALF + m * 16) * D + col0 + bj * HALF;
                    gw[m][bj] = *(const EGAS u32x4*)(G + o); if (MODE == 1) g2[m][bj] = *(const EGAS u32x4*)(G2 + o); }
#pragma unroll
            for (int m = 0; m < 4; ++m)
#pragma unroll
                for (int bj = 0; bj < 2; ++bj) { const size_t o = (size_t)(row0 + ai * HALF + m * 16) * D + col0 + bj * HALF;
                    f32x4 v0 = acc[ai][bj][m][0], v1 = acc[ai][bj][m][1];
#pragma unroll
                    for (int j = 0; j < 4; ++j) { const unsigned wa = gw[m][bj][j >> 1], wb = gw[m][bj][2 + (j >> 1)];
                        const float ga = (j & 1) ? bf_hi(wa) : bf_lo(wa), gb = (j & 1) ? bf_hi(wb) : bf_lo(wb);
                        if (MODE == 0) { v0[j] *= sigmoidf_fast(ga); v1[j] *= sigmoidf_fast(gb); }
                        else { const unsigned xa = g2[m][bj][j >> 1], xb = g2[m][bj][2 + (j >> 1)];
                            v0[j] = ga + v0[j] * sigmoidf_fast((j & 1) ? bf_hi(xa) : bf_lo(xa)); v1[j] = gb + v1[j] * sigmoidf_fast((j & 1) ? bf_hi(xb) : bf_lo(xb)); } }
                    *(EGAS u32x4*)(G + o) = pack8(v0, v1); }
            EPI_FENCE(); }
    }
};
template <int MODE> struct EpiRes {
    static constexpr bool PERM = true, AFTER_DRAIN = false;
    float* Y; const bf16_t* XB; const bf16_t* U;
    __device__ __forceinline__ void operator()(const f32x4 (&acc)[2][2][4][2], const Unit& u, int wr, int wc, int fr, int fq) const {
        { int l_ = (int)__builtin_amdgcn_mbcnt_hi(~0u, __builtin_amdgcn_mbcnt_lo(~0u, 0u)); asm volatile("" : "+v"(l_)); fr = l_ & 15; fq = l_ >> 4; }
        const int row0 = u.pm * BM + wr * 64 + fr, col0 = u.pn * BM + wc * 32 + 8 * fq;
#pragma unroll
        for (int ai = 0; ai < 2; ++ai) {
            u32x4 xw[4][2], uw[4][2];
#pragma unroll
            for (int m = 0; m < 4; ++m)
#pragma unroll
                for (int bj = 0; bj < 2; ++bj) { const size_t o = (size_t)(row0 + ai * HALF + m * 16) * D + col0 + bj * HALF;
                    xw[m][bj] = *(const EGAS u32x4*)(XB + o);
                    if (MODE == 1) uw[m][bj] = *(const EGAS u32x4*)(U + o); }
#pragma unroll
            for (int m = 0; m < 4; ++m)
#pragma unroll
                for (int bj = 0; bj < 2; ++bj) { const size_t o = (size_t)(row0 + ai * HALF + m * 16) * D + col0 + bj * HALF;
#pragma unroll
                    for (int n = 0; n < 2; ++n) { const f32x4 a = acc[ai][bj][m][n]; f32x4 r;
                        if (MODE == 0) { const unsigned x0 = xw[m][bj][2 * n], x1 = xw[m][bj][2 * n + 1];
                            r[0] = bf_lo(x0) * DN_ALPHA + a[0]; r[1] = bf_hi(x0) * DN_ALPHA + a[1]; r[2] = bf_lo(x1) * DN_ALPHA + a[2]; r[3] = bf_hi(x1) * DN_ALPHA + a[3]; }
                        else { const unsigned x0 = xw[m][bj][2 * n], x1 = xw[m][bj][2 * n + 1], w0 = uw[m][bj][2 * n], w1 = uw[m][bj][2 * n + 1];
                            r[0] = bf_lo(x0) * DN_ALPHA + bf_lo(w0) + a[0]; r[1] = bf_hi(x0) * DN_ALPHA + bf_hi(w0) + a[1];
                            r[2] = bf_lo(x1) * DN_ALPHA + bf_lo(w1) + a[2]; r[3] = bf_hi(x1) * DN_ALPHA + bf_hi(w1) + a[3]; }
                        *(EGAS f32x4*)(Y + o + 4 * n) = r; } }
            EPI_FENCE(); }
    }
};
struct EpiPle {
    static constexpr bool PERM = true, AFTER_DRAIN = false;
    bf16_t* U;
    __device__ __forceinline__ void operator()(const f32x4 (&acc)[2][2][4][2], const Unit& u, int wr, int wc, int fr, int fq) const {
        { int l_ = (int)__builtin_amdgcn_mbcnt_hi(~0u, __builtin_amdgcn_mbcnt_lo(~0u, 0u)); asm volatile("" : "+v"(l_)); fr = l_ & 15; fq = l_ >> 4; }
        const int row0 = u.pm * BM + wr * 64 + fr, col0 = u.pn * BM + wc * 32 + 8 * fq;
#pragma unroll
        for (int ai = 0; ai < 2; ++ai) {
            u32x4 uw[4][2];
#pragma unroll
            for (int m = 0; m < 4; ++m)
#pragma unroll
                for (int bj = 0; bj < 2; ++bj) uw[m][bj] = *(const EGAS u32x4*)(U + (size_t)(row0 + ai * HALF + m * 16) * D + col0 + bj * HALF);
#pragma unroll
            for (int m = 0; m < 4; ++m)
#pragma unroll
                for (int bj = 0; bj < 2; ++bj) { f32x4 v0 = acc[ai][bj][m][0], v1 = acc[ai][bj][m][1];
#pragma unroll
                    for (int j = 0; j < 4; ++j) { const unsigned wa = uw[m][bj][j >> 1], wb = uw[m][bj][2 + (j >> 1)];
                        v0[j] = sigmoidf_fast(v0[j]) * ((j & 1) ? bf_hi(wa) : bf_lo(wa)); v1[j] = sigmoidf_fast(v1[j]) * ((j & 1) ? bf_hi(wb) : bf_lo(wb)); }
                    *(EGAS u32x4*)(U + (size_t)(row0 + ai * HALF + m * 16) * D + col0 + bj * HALF) = pack8(v0, v1); }
            EPI_FENCE(); }
    }
};
struct EpiSwiglu {
    static constexpr bool PERM = true, AFTER_DRAIN = false;
    bf16_t* H; int ldh;
    __device__ __forceinline__ void operator()(const f32x4 (&acc)[2][2][4][2], const Unit& u, int wr, int wc, int fr, int fq) const {
        { int l_ = (int)__builtin_amdgcn_mbcnt_hi(~0u, __builtin_amdgcn_mbcnt_lo(~0u, 0u)); asm volatile("" : "+v"(l_)); fr = l_ & 15; fq = l_ >> 4; }
        const int row0 = u.pm * BM + wr * 64 + fr, col0 = u.pn * HALF + wc * 32 + 8 * fq;
#pragma unroll
        for (int ai = 0; ai < 2; ++ai)
#pragma unroll
            for (int m = 0; m < 4; ++m) { bf16_t* rowp = H + (size_t)(row0 + ai * HALF + m * 16) * ldh + col0;
                f32x4 v0, v1;
#pragma unroll
                for (int j = 0; j < 4; ++j) { const float g0 = acc[ai][0][m][0][j], g1 = acc[ai][0][m][1][j];
                    v0[j] = g0 * sigmoidf_fast(g0) * acc[ai][1][m][0][j]; v1[j] = g1 * sigmoidf_fast(g1) * acc[ai][1][m][1][j]; }
                *(EGAS u32x4*)rowp = pack8(v0, v1); }
    }
};
template <class Epi, class Sched, bool ALIGN_EPI = true>
__device__ __forceinline__ void gemm_phase(PG8_LAS unsigned char* lds, const Gemm g, const Sched& S, const Epi& E, const int wave_id) {
    int lane_ = (int)__builtin_amdgcn_mbcnt_hi(~0u, __builtin_amdgcn_mbcnt_lo(~0u, 0u)); asm volatile("" : "+v"(lane_));
    const int wid = wave_id, lane = lane_, tid = wid * 64 + lane, wr = wid >> 2, wc = wid & 3, fr = lane & 15, fq = lane >> 4;
    const int K = g.K, nt = K / BK;
    unsigned voffA[2], voffB[2]; int RA[2], CA[2];
#pragma unroll
    for (int i = 0; i < 2; ++i) { int R, C; stage_rc(tid * 16 + i * 8192, R, C); const int Rb = Epi::PERM ? ((R & ~31) + perm32(R & 31)) : R; RA[i] = R; CA[i] = C;
        voffA[i] = (unsigned)(R * K + C) * 2u; voffB[i] = (unsigned)(Rb * K + C) * 2u; }
    const size_t kstep = (size_t)(BK * 2);
    const size_t hstep = (size_t)HALF * K * 2;
    const size_t tstep = 2 * hstep;
    const unsigned ldsw = (unsigned)wid * 1024u;
    const int aoff = lds_byte(wr * 64 + fr, fq * 8), boff = lds_byte(wc * 32 + fr, fq * 8);
    unsigned offC[2][2] = {{0u, 0u}, {0u, 0u}}, offN[2][2] = {{0u, 0u}, {0u, 0u}};
#define PG8_SA(b, h) (((b) * 2 + (h)) * HTB)
#define PG8_SB(b, h) ((4 + (b) * 2 + (h)) * HTB)
#define PG8_STAGE(bufoff, gbase, voff) do { _Pragma("unroll") for (int _i = 0; _i < 2; ++_i) \
        __builtin_amdgcn_global_load_lds((const unsigned*)((const char*)(gbase) + (voff)[_i]), (PG8_LAS unsigned*)(lds + (bufoff) + ldsw + _i * 8192), 16, 0, 0); } while (0)
#define PG8_STA(bufoff, ptr, h, NX) do { if constexpr (Sched::GATHER) { _Pragma("unroll") for (int _i = 0; _i < 2; ++_i) { const unsigned _o = (NX) ? offN[h][_i] : offC[h][_i]; \
        __builtin_amdgcn_global_load_lds((const unsigned*)((const char*)(ptr) + _o), (PG8_LAS unsigned*)(lds + (bufoff) + ldsw + _i * 8192), 16, 0, 0); } } \
        else { PG8_STAGE(bufoff, (ptr) + (h) * hstep, voffA); } } while (0)
#define PG8_LDA(dst, b, h) do { _Pragma("unroll") for (int m = 0; m < 4; ++m) _Pragma("unroll") for (int k = 0; k < 2; ++k) dst[m][k] = *(const PG8_LAS bf16x8*)(lds + PG8_SA(b, h) + aoff + m * 2048 + k * 1024); } while (0)
#define PG8_LDB(dst, b, h) do { _Pragma("unroll") for (int n = 0; n < 2; ++n) _Pragma("unroll") for (int k = 0; k < 2; ++k) dst[n][k] = *(const PG8_LAS bf16x8*)(lds + PG8_SB(b, h) + boff + n * 2048 + k * 1024); } while (0)
#define PG8_MMA(ai, bj, At, Bt) do { __builtin_amdgcn_s_setprio(1); _Pragma("unroll") for (int m = 0; m < 4; ++m) _Pragma("unroll") for (int n = 0; n < 2; ++n) _Pragma("unroll") for (int k = 0; k < 2; ++k) \
        acc[ai][bj][m][n] = __builtin_amdgcn_mfma_f32_16x16x32_bf16(Bt[n][k], At[m][k], acc[ai][bj][m][n], 0, 0, 0); __builtin_amdgcn_s_setprio(0); } while (0)
#define PG8_WAIT_V(n) asm volatile("s_waitcnt vmcnt(" #n ")" ::: "memory")
#define PG8_WAIT_L(n) asm volatile("s_waitcnt lgkmcnt(" #n ")" ::: "memory")
#define PG8_BAR __builtin_amdgcn_s_barrier()
#define PG8_SCHED __builtin_amdgcn_sched_barrier(0)
#ifdef PROF_SEL
#ifndef PROF_KPH
#define PROF_KPH 0
#endif
#define PG8_PROF(slot) do { if (tid == 0) { volatile PG8_LAS unsigned* M_ = (volatile PG8_LAS unsigned*)(lds + 131392); const unsigned t_ = (unsigned)__builtin_amdgcn_s_memrealtime(); const unsigned c_ = (unsigned)__builtin_amdgcn_s_memtime(); if (PROF_KPH == 0 || M_[101] == PROF_KPH) { M_[64 + (slot)] += t_ - M_[97]; if ((slot) == 14) M_[104] += c_ - M_[103]; } M_[97] = t_; M_[103] = c_; } } while (0)
#else
#define PG8_PROF(slot) do { } while (0)
#endif
#ifdef PROF_SEL
#define PG8_WAIT_VT(n) do { unsigned long long a_, b_; asm volatile("s_memtime %0\n\ts_waitcnt vmcnt(" #n ")\n\ts_memtime %1\n\ts_waitcnt lgkmcnt(0)" : "=s"(a_), "=s"(b_) :: "memory"); if (tid == 0) { volatile PG8_LAS unsigned* M_ = (volatile PG8_LAS unsigned*)(lds + 131392); M_[105] += (unsigned)b_ - (unsigned)a_; } } while (0)
#else
#define PG8_WAIT_VT(n) PG8_WAIT_V(n)
#endif
    Unit cur, nxt; int ui = 0;
    if (!S.next(0, cur)) return;
    f32x4 acc[2][2][4][2];
#pragma unroll
    for (int a = 0; a < 2; ++a)
#pragma unroll
        for (int b = 0; b < 2; ++b)
#pragma unroll
            for (int m = 0; m < 4; ++m)
#pragma unroll
                for (int n = 0; n < 2; ++n) acc[a][b][m][n] = (f32x4){0.f, 0.f, 0.f, 0.f};
    bf16x8 At[4][2], B0[2][2], B1[2][2];
    const char* cA = S.a_base(g, cur, tstep); const char* cB = S.b_base(g, cur, tstep);
    if constexpr (Sched::GATHER) S.a_rows(cur, RA[0], RA[1], CA[0], CA[1], K, offC);
    S.a_ready(cur);
    PG8_STAGE(PG8_SB(0, 0), cB, voffB); PG8_STAGE(PG8_SB(0, 1), cB + hstep, voffB); PG8_STA(PG8_SA(0, 0), cA, 0, false); PG8_STA(PG8_SA(0, 1), cA, 1, false);
    if (wr == 1) PG8_BAR;
    PG8_WAIT_V(2); PG8_BAR;
    PG8_STAGE(PG8_SB(1, 0), cB + kstep, voffB); PG8_STA(PG8_SA(1, 0), cA + kstep, 0, false); PG8_STAGE(PG8_SB(1, 1), cB + hstep + kstep, voffB);
    PG8_WAIT_V(6); PG8_BAR;
    PG8_PROF(17);
    for (;;) {
        const bool has_next = S.next(ui + 1, nxt);
        const char* nA = has_next ? S.a_base(g, nxt, tstep) : cA; const char* nB = has_next ? S.b_base(g, nxt, tstep) : cB;
        if constexpr (Sched::GATHER) { if (has_next) S.a_rows(nxt, RA[0], RA[1], CA[0], CA[1], K, offN); else {
#pragma unroll
            for (int h = 0; h < 2; ++h)
#pragma unroll
                for (int i = 0; i < 2; ++i) offN[h][i] = offC[h][i]; } }
        for (int t = 0; t < nt; t += 2) {
            const bool last = (t == nt - 2);
            const char* a1 = cA + (size_t)(t + 1) * kstep;
            const char* a2 = last ? nA : cA + (size_t)(t + 2) * kstep; const char* b2 = last ? nB : cB + (size_t)(t + 2) * kstep;
            const char* a3 = a2 + kstep; const char* b3 = b2 + kstep;
            if (last && has_next) S.a_ready(nxt);
            PG8_LDB(B0, 0, 0); PG8_LDB(B1, 0, 1); PG8_SCHED; PG8_LDA(At, 0, 0); PG8_STA(PG8_SA(1, 1), a1, 1, false);
            PG8_WAIT_VT(8); PG8_WAIT_L(0); PG8_BAR; PG8_MMA(0, 0, At, B0); PG8_MMA(0, 1, At, B1); PG8_BAR; PG8_SCHED;
            PG8_LDA(At, 0, 1); PG8_STAGE(PG8_SB(0, 0), b2, voffB); PG8_STAGE(PG8_SB(0, 1), b2 + hstep, voffB); PG8_STA(PG8_SA(0, 0), a2, 0, last);
            PG8_WAIT_VT(8); PG8_WAIT_L(0); PG8_BAR; PG8_MMA(1, 0, At, B0); PG8_MMA(1, 1, At, B1); PG8_BAR; PG8_SCHED;
            PG8_LDB(B0, 1, 0); PG8_LDB(B1, 1, 1); PG8_SCHED; PG8_LDA(At, 1, 0); PG8_STA(PG8_SA(0, 1), a2, 1, last);
            PG8_WAIT_VT(8); PG8_WAIT_L(0); PG8_BAR; PG8_MMA(0, 0, At, B0); PG8_MMA(0, 1, At, B1); PG8_BAR; PG8_SCHED;
            PG8_LDA(At, 1, 1); PG8_STAGE(PG8_SB(1, 0), b3, voffB); PG8_STAGE(PG8_SB(1, 1), b3 + hstep, voffB); PG8_STA(PG8_SA(1, 0), a3, 0, last);
            PG8_WAIT_VT(8); PG8_WAIT_L(0); PG8_BAR; PG8_MMA(1, 0, At, B0); PG8_MMA(1, 1, At, B1); PG8_BAR; PG8_SCHED;
        }
        if constexpr (ALIGN_EPI) { if (wr == 0) PG8_BAR; }
        PG8_PROF(14);
        E(acc, cur, wr, wc, fr, fq); S.done(cur);
        PG8_PROF(15);
        if (!has_next) break;
#pragma unroll
        for (int a = 0; a < 2; ++a)
#pragma unroll
            for (int b = 0; b < 2; ++b)
#pragma unroll
                for (int m = 0; m < 4; ++m)
#pragma unroll
                    for (int n = 0; n < 2; ++n) acc[a][b][m][n] = (f32x4){0.f, 0.f, 0.f, 0.f};
        cur = nxt; cA = nA; cB = nB; ++ui;
        if constexpr (Sched::GATHER) {
#pragma unroll
            for (int h = 0; h < 2; ++h)
#pragma unroll
                for (int i = 0; i < 2; ++i) offC[h][i] = offN[h][i]; }
        if constexpr (ALIGN_EPI) { if (wr == 1) PG8_BAR; }
    }
    PG8_WAIT_V(0);
    if constexpr (!ALIGN_EPI) { if (wr == 0) PG8_BAR; }
    PG8_BAR;
#undef PG8_PROF
#undef PG8_WAIT_VT
#undef PG8_SA
#undef PG8_SB
#undef PG8_STAGE
#undef PG8_STA
#undef PG8_LDA
#undef PG8_LDB
#undef PG8_MMA
#undef PG8_WAIT_V
#undef PG8_WAIT_L
#undef PG8_BAR
#undef PG8_SCHED
}
}
constexpr int NWAVES = 8;
constexpr size_t MiB = 1u << 20;
constexpr size_t WS_CTL = 0, CTL_ZERO_BYTES = 1 * MiB;
constexpr size_t WS_ROUTE = 1 * MiB;
constexpr size_t WS_LIST = 3 * MiB;
constexpr size_t WS_W = 8 * MiB;
constexpr size_t W_IN = 0, W_BRA = 12 * MiB, W_BRR = 14 * MiB, W_O = 16 * MiB, W_PG = 18 * MiB, W_PP = 20 * MiB, W_LRU = 21 * MiB, W_FF = 22 * MiB;
constexpr size_t W_FF_DN_DENSE = W_FF + 11 * MiB, W_FF_DN_MOE = W_FF + 112 * MiB;
constexpr size_t WS_XB = 208 * MiB;
constexpr size_t WS_IDX = 336 * MiB;
constexpr size_t WS_Z = 368 * MiB;
constexpr size_t Z_Q = WS_Z, Z_XR = WS_Z + 128 * MiB, Z_YR = WS_Z + 256 * MiB, Z_GA = WS_Z + 384 * MiB, Z_GR = WS_Z + 512 * MiB, Z_QI = WS_Z + 640 * MiB, Z_SM = WS_Z + 704 * MiB;
constexpr size_t Z_Q8 = Z_Q, Z_KV8 = Z_Q + 64 * MiB;
constexpr size_t WS_END = WS_Z + 736 * MiB;
constexpr size_t F_U = Z_Q;
constexpr size_t F_PB = Z_SM;
constexpr size_t F_H = Z_XR;
constexpr size_t F_H1 = WS_END;
constexpr size_t F_YE = Z_GA;
constexpr int MOE_CHUNK_TILES = 128;
constexpr size_t F_H_CHUNK_BYTES = (size_t)MOE_CHUNK_TILES * 256 * DFFE * 2;
constexpr size_t WS_NEED = F_H1 + F_H_CHUNK_BYTES;
static_assert(F_H + F_H_CHUNK_BYTES <= F_YE && F_YE + (size_t)520 * 256 * D * 2 <= Z_SM && F_H + (size_t)T_TOK * DFF * 2 <= Z_GR, "overlay map");
constexpr int CW_TMO = 0, CW_CODE = 1, CW_BAR = 4096, CW_CNT = 16384;
constexpr int RING_OFF = 0, RING_BYTES = 131072;
constexpr int LDSCTL_OFF = RING_BYTES, MISC_OFF = LDSCTL_OFF + 320;
constexpr int LDS_BYTES = 157696;

#define GAS __attribute__((address_space(1)))
#define LAS __attribute__((address_space(3)))
typedef unsigned short bf16;
typedef unsigned v4u __attribute__((ext_vector_type(4)));
typedef unsigned v2u __attribute__((ext_vector_type(2)));
typedef float f32x4 __attribute__((ext_vector_type(4)));
typedef float f32x16 __attribute__((ext_vector_type(16)));
typedef short bf16x8 __attribute__((ext_vector_type(8)));
typedef GAS unsigned gu32;
#define RLX_AGENT __ATOMIC_RELAXED, __HIP_MEMORY_SCOPE_AGENT
#define LDS_WAIT() asm volatile("s_waitcnt lgkmcnt(0)" ::: "memory")
#define VM_WAIT() asm volatile("s_waitcnt vmcnt(0)" ::: "memory")
using pg8::cvt_pk_bf16; using pg8::bf_lo; using pg8::bf_hi; using pg8::sigmoidf_fast;
#define XB_TMO      128
#define XB_XCNT(j)  (256  + 64 * (j))
#define XB_XSUB(j)  (1280 + 64 * (j))
#define XB_XGEN(j)  (2304 + 64 * (j))
#define XB_TOP      3328
#define XB_TOPGEN   3392
#define XCD_BAR_WORDS 3456
#define XB_SPIN_CAP (1u << 21)

__device__ __forceinline__ unsigned xb_ld(unsigned* p)              { return __hip_atomic_load(p, __ATOMIC_RELAXED, __HIP_MEMORY_SCOPE_AGENT); }
__device__ __forceinline__ unsigned xb_add(unsigned* p, unsigned v) { return __hip_atomic_fetch_add(p, v, __ATOMIC_RELAXED, __HIP_MEMORY_SCOPE_AGENT); }
__device__ __forceinline__ unsigned xb_xcc_id() { return (unsigned)__builtin_amdgcn_s_getreg((3 << 11) | 20) & 0xFu; }
#define XB_SPIN(cond, bar) do { unsigned _sp = 0; while (cond) { __builtin_amdgcn_s_sleep(1); \
    if ((++_sp & 255u) == 0u) { if (xb_ld(&(bar)[XB_TMO])) break; if (_sp > XB_SPIN_CAP) { atomicAdd(&(bar)[XB_TMO], 1u); break; } } } } while (0)

struct XcdBarrier {
    unsigned* bar; unsigned x;
    volatile LAS unsigned* st;
};

__device__ __forceinline__ XcdBarrier xcd_barrier_post(unsigned* bar, volatile LAS unsigned* st) {
    XcdBarrier b; b.bar = bar; b.x = xb_xcc_id(); b.st = st;
    if (threadIdx.x == 0) (void)xb_add(&bar[XB_XCNT(b.x)], 1u);
    return b;
}
__device__ __forceinline__ void xcd_barrier_complete(unsigned* bar, unsigned x, unsigned& nloc, unsigned& nx) {
    const unsigned G = gridDim.x * gridDim.y * gridDim.z;
    unsigned sum, cnt, mine, sp = 0u;
    for (;;) {
        sum = 0u; cnt = 0u; mine = 0u;
#pragma unroll
        for (unsigned j = 0; j < 16; ++j) { const unsigned c = xb_ld(&bar[XB_XCNT(j)]); sum += c; cnt += (c > 0u) ? 1u : 0u; mine = (j == x) ? c : mine; }
        if (sum == G) break;
        __builtin_amdgcn_s_sleep(1);
        if ((++sp & 255u) == 0u) { if (xb_ld(&bar[XB_TMO])) break; if (sp > XB_SPIN_CAP) { atomicAdd(&bar[XB_TMO], 1u); break; } }
    }
    nloc = mine > 0u ? mine : 1u; nx = cnt > 0u ? cnt : 1u;
}

__device__ __forceinline__ void xcd_barrier(const XcdBarrier& b) {
    asm volatile("s_waitcnt vmcnt(0)" ::: "memory");
    __syncthreads();
    if (threadIdx.x == 0) {
        unsigned* bar = b.bar;
        __builtin_amdgcn_s_waitcnt(0);
        unsigned nloc = b.st[0], nx = b.st[1];
        if (nloc == 0u) { xcd_barrier_complete(bar, b.x, nloc, nx); b.st[0] = nloc; b.st[1] = nx; }
        const unsigned old = xb_add(&bar[XB_XSUB(b.x)], 1u);
        const unsigned gen = old / nloc;
        if (old + 1u == (gen + 1u) * nloc) {
            __builtin_amdgcn_fence(__ATOMIC_RELEASE, "agent");
            asm volatile("s_waitcnt vmcnt(0)" ::: "memory");
            const unsigned og = xb_add(&bar[XB_TOP], 1u);
            const unsigned tg = og / nx;
            if (og + 1u == (tg + 1u) * nx) xb_add(&bar[XB_TOPGEN], 1u);
            else XB_SPIN(xb_ld(&bar[XB_TOPGEN]) == tg, bar);
            __builtin_amdgcn_fence(__ATOMIC_ACQUIRE, "agent");
            xb_add(&bar[XB_XGEN(b.x)], 1u);
            asm volatile("s_waitcnt vmcnt(0)" ::: "memory");
        } else {
            XB_SPIN(xb_ld(&bar[XB_XGEN(b.x)]) == gen, bar);
            __builtin_amdgcn_fence(__ATOMIC_ACQUIRE, "agent");
            asm volatile("s_waitcnt vmcnt(0)" ::: "memory");
        }
    }
    __syncthreads();
}
struct Frame {
    LAS unsigned char* lds;
    volatile LAS unsigned* MISC;
    gu32* ctl;
    int tid, lane, wave, G, bx;
    unsigned char* ws;
    float* out;
};
struct Args { const float* in[28]; float* out; unsigned char* ws; };
typedef const __attribute__((address_space(4))) Args* KArgs;
__device__ __forceinline__ KArgs kargs() { KArgs k = (KArgs)__builtin_amdgcn_kernarg_segment_ptr(); asm volatile("" : "+s"(k)); return k; }
enum { I_X = 0, I_P, I_WIN, I_CONVW, I_CONVB, I_LRUWA, I_LRUBA, I_LRUWX, I_LRUBX, I_LAM, I_WBRA, I_WBRR, I_WO, I_RELB, I_LN1G, I_LN1B, I_FFG, I_FFU, I_FFD, I_ROUTER, I_ROUTERB, I_MOEG, I_MOEU, I_MOED, I_PLEG, I_PLEP, I_LN2G, I_LN2B };

__device__ __forceinline__ Frame launder(const Frame& F0) { Frame F = F0; unsigned char* w = F0.ws; int l = (int)__builtin_amdgcn_mbcnt_hi(~0u, __builtin_amdgcn_mbcnt_lo(~0u, 0u)); asm volatile("" : "+s"(w)); asm volatile("" : "+v"(l));
    F.ws = w; F.lane = l; F.tid = F0.wave * 64 + l; F.ctl = (gu32*)(w + WS_CTL); return F; }
__device__ __forceinline__ float lane_get(float v, int src_lane) { return __builtin_bit_cast(float, __builtin_amdgcn_ds_bpermute(src_lane << 2, __builtin_bit_cast(int, v))); }
__device__ __forceinline__ float lane_xor(float v, int mask, int lane) { return lane_get(v, lane ^ mask); }
__device__ __forceinline__ float lane_up(float v, int d, int lane) { return lane_get(v, lane >= d ? lane - d : lane); }
__device__ __forceinline__ float wave_sum(float v, int lane) {
    (void)lane;
#define WS_DPP(ctrl, rmask) v += __builtin_bit_cast(float, __builtin_amdgcn_update_dpp(0, __builtin_bit_cast(int, v), ctrl, rmask, 0xf, false))
    WS_DPP(0x111, 0xf); WS_DPP(0x112, 0xf); WS_DPP(0x114, 0xf); WS_DPP(0x118, 0xf); WS_DPP(0x142, 0xa); WS_DPP(0x143, 0xc);
#undef WS_DPP
    return __builtin_bit_cast(float, __builtin_amdgcn_readlane(__builtin_bit_cast(int, v), 63));
}
__device__ __forceinline__ unsigned pk2(float lo, float hi) { return cvt_pk_bf16(lo, hi); }

__device__ __forceinline__ void cvt_item(const float* W, int ldw, int K, bf16* WT, int d0, int sc0, int nvalid, float scale, int k0, LAS float* scr, int lane) {
    const int n4 = (lane & 7) * 4;
    f32x4 v[8];
#pragma unroll
    for (int i = 0; i < 8; ++i) { const int kk = 8 * i + (lane >> 3); v[i] = (f32x4){0.f, 0.f, 0.f, 0.f}; if (n4 < nvalid) v[i] = *(const GAS f32x4*)(W + (size_t)(k0 + kk) * ldw + sc0 + n4); }
#pragma unroll
    for (int i = 0; i < 8; ++i) { const int kk = 8 * i + (lane >> 3); LAS float* d = scr + kk * 33 + n4; d[0] = v[i][0] * scale; d[1] = v[i][1] * scale; d[2] = v[i][2] * scale; d[3] = v[i][3] * scale; }
    LDS_WAIT(); asm volatile("" ::: "memory");
    const int c = lane & 7;
#pragma unroll
    for (int j = 0; j < 4; ++j) { const int nn = (lane >> 3) + 8 * j; const LAS float* s = scr + (8 * c) * 33 + nn;
        v4u o; o.x = pk2(s[0 * 33], s[1 * 33]); o.y = pk2(s[2 * 33], s[3 * 33]); o.z = pk2(s[4 * 33], s[5 * 33]); o.w = pk2(s[6 * 33], s[7 * 33]);
        *(GAS v4u*)(WT + (size_t)(d0 + nn) * K + k0 + 8 * c) = o; }
    LDS_WAIT(); asm volatile("" ::: "memory");
}
__device__ __forceinline__ void cvt_plain(const float* W, int K, int N, bf16* WT, int item, LAS float* scr, int lane) {
    const int nblk = N / 32, kb = item / nblk, nb = item % nblk;
    cvt_item(W, N, K, WT, 32 * nb, 32 * nb, 32, 1.0f, 64 * kb, scr, lane);
}
__device__ __forceinline__ void cvt_gateup(const float* Wg, const float* Wu, int dff, bf16* WT, int item, LAS float* scr, int lane) {
    const int nblk = 2 * dff / 32, kb = item / nblk, db = item % nblk, d0 = 32 * db, pn = d0 >> 8, r = d0 & 255;
    const float* W = r < 128 ? Wg : Wu; const int sc0 = 128 * pn + (r & 127);
    cvt_item(W, dff, D, WT, d0, sc0, 32, 1.0f, 64 * kb, scr, lane);
}
__device__ __forceinline__ void cvt_win(const float* W, bf16* WT, int item, LAS float* scr, int lane) {
    const int nblk = NIN / 32, kb = item / nblk, db = item % nblk, d0 = 32 * db;
    int sc0, nv = 32; float sc = 1.0f;
    if (d0 < 1024) { sc0 = d0; }
    else if (d0 < 2048) sc0 = 1736 + (d0 - 1024);
    else if (d0 < 3072) sc0 = 2760 + (d0 - 2048);
    else if (d0 < 4096) sc0 = 3784 + (d0 - 3072);
    else if (d0 < 5120) sc0 = 4808 + (d0 - 4096);
    else if (d0 < 5632) sc0 = 1152 + (d0 - 5120);
    else if (d0 < 5696) sc0 = 1024 + (d0 - 5632);
    else if (d0 < 5760) sc0 = 1088 + (d0 - 5696);
    else if (d0 < 5824) sc0 = 1664 + (d0 - 5760);
    else if (d0 == 5824) { sc0 = 1728; nv = 8; }
    else { sc0 = 0; nv = 0; }
    cvt_item(W, D_IN, D, WT, d0, sc0, nv, sc, 64 * kb, scr, lane);
}
__device__ __forceinline__ void p0_convert(const Frame& F0, int L) {
    Frame F = launder(F0);
    const KArgs ka = kargs();
    LAS float* scr = (LAS float*)(F.lds + RING_OFF + F.wave * 16384);
    const int gw = F.bx * NWAVES + F.wave, NGW = F.G * NWAVES;
    unsigned char* wb = F.ws + WS_W;
    const int odd = L & 1, jj = L >> 1;
    constexpr int I_IN = (D / 64) * (NIN / 32), I_SQ = (D / 64) * (D / 32), I_PPJ = (PLE / 64) * (D / 32), I_LRU1 = 2 * 4;
    constexpr int I_GU_D = (D / 64) * (2 * DFF / 32), I_DN_D = (DFF / 64) * (D / 32), I_GU_E = (D / 64) * (2 * DFFE / 32), I_DN_E = (DFFE / 64) * (D / 32);
    const int n_ff = odd ? NEXP * (I_GU_E + I_DN_E) : (I_GU_D + I_DN_D);
    const int NITEMS = I_IN + 4 * I_SQ + I_PPJ + 16 * I_LRU1 + n_ff;
    for (int it = gw; it < NITEMS; it += NGW) {
        const float* W; bf16* WT; int ldw, K, d0, sc0, nv = 32, k0; float scale = 1.0f;
        int r = it, kind = 0, m = 0;
        if (r < I_IN) kind = 1;
        else { r -= I_IN;
            if (r < 4 * I_SQ) { m = r / I_SQ; r -= m * I_SQ; }
            else { r -= 4 * I_SQ;
                if (r < I_PPJ) m = 4;
                else { r -= I_PPJ;
                    if (r < 16 * I_LRU1) m = 5;
                    else { r -= 16 * I_LRU1;
                        if (!odd) { if (r < I_GU_D) kind = 2; else { r -= I_GU_D; m = 6; } }
                        else { if (r < NEXP * I_GU_E) kind = 3; else { r -= NEXP * I_GU_E; m = 7; } } } } } }
        if (kind == 1) { const int nblk = NIN / 32, kb = r / nblk, db = r % nblk; d0 = 32 * db; k0 = 64 * kb;
            W = ka->in[I_WIN] + (size_t)L * D * D_IN; WT = (bf16*)(wb + W_IN); ldw = D_IN; K = D;
            if (d0 < 1024) sc0 = d0;
            else if (d0 < 2048) sc0 = 1736 + (d0 - 1024);
            else if (d0 < 3072) sc0 = 2760 + (d0 - 2048);
            else if (d0 < 4096) sc0 = 3784 + (d0 - 3072);
            else if (d0 < 5120) sc0 = 4808 + (d0 - 4096);
            else if (d0 < 5632) sc0 = 1152 + (d0 - 5120);
            else if (d0 < 5696) sc0 = 1024 + (d0 - 5632);
            else if (d0 < 5760) sc0 = 1088 + (d0 - 5696);
            else if (d0 < 5824) sc0 = 1664 + (d0 - 5760);
            else if (d0 == 5824) { sc0 = 1728; nv = 8; }
            else { sc0 = 0; nv = 0; } }
        else if (kind >= 2) { const int dff = kind == 2 ? DFF : DFFE; int e = 0; if (kind == 3) { e = r / I_GU_E; r -= e * I_GU_E; }
            const size_t eo = kind == 2 ? (size_t)jj * D * DFF : ((size_t)jj * NEXP + e) * D * DFFE;
            const int nblk = 2 * dff / 32, kb = r / nblk, db = r % nblk; d0 = 32 * db; k0 = 64 * kb; const int pn = d0 >> 8, rr = d0 & 255;
            W = (rr < 128 ? ka->in[kind == 2 ? I_FFG : I_MOEG] : ka->in[kind == 2 ? I_FFU : I_MOEU]) + eo; sc0 = 128 * pn + (rr & 127); ldw = dff; K = D;
            WT = (bf16*)(wb + W_FF) + (kind == 3 ? (size_t)e * 2 * DFFE * D : 0); }
        else { int Kk, Nn;
            if (m < 4) { Kk = D; Nn = D; W = ka->in[m == 0 ? I_WBRA : m == 1 ? I_WBRR : m == 2 ? I_WO : I_PLEG] + (size_t)L * D * D; WT = (bf16*)(wb + (m == 0 ? W_BRA : m == 1 ? W_BRR : m == 2 ? W_O : W_PG)); }
            else if (m == 4) { Kk = PLE; Nn = D; W = ka->in[I_PLEP] + (size_t)L * PLE * D; WT = (bf16*)(wb + W_PP); }
            else if (m == 5) { const int mm = r / I_LRU1, blk = mm & 7, which = mm >> 3; r -= mm * I_LRU1; Kk = 128; Nn = 128;
                W = ka->in[which ? I_LRUWX : I_LRUWA] + (size_t)L * 8 * 128 * 128 + (size_t)blk * 128 * 128; WT = (bf16*)(wb + W_LRU) + (size_t)which * 8 * 128 * 128 + (size_t)blk * 128 * 128; }
            else if (m == 6) { Kk = DFF; Nn = D; W = ka->in[I_FFD] + (size_t)jj * DFF * D; WT = (bf16*)(wb + W_FF_DN_DENSE); }
            else { const int e = r / I_DN_E; r -= e * I_DN_E; Kk = DFFE; Nn = D; W = ka->in[I_MOED] + ((size_t)jj * NEXP + e) * DFFE * D; WT = (bf16*)(wb + W_FF_DN_MOE) + (size_t)e * D * DFFE; }
            const int nblk = Nn / 32, kb = r / nblk, nb = r % nblk; d0 = 32 * nb; sc0 = 32 * nb; k0 = 64 * kb; ldw = Nn; K = Kk; }
        cvt_item(W, ldw, K, WT, d0, sc0, nv, scale, k0, scr, F.lane);
    }
    if (L == 0) {
        const GAS f32x4* x4 = (const GAS f32x4*)ka->in[I_X]; GAS v4u* o = (GAS v4u*)(F.ws + WS_XB);
        const size_t n8 = (size_t)T_TOK * D / 8;
        for (size_t i = (size_t)F.bx * 512 + F.tid; i < n8; i += (size_t)F.G * 512) { const f32x4 a = x4[2 * i], b = x4[2 * i + 1];
            v4u w; w.x = pk2(a[0], a[1]); w.y = pk2(a[2], a[3]); w.z = pk2(b[0], b[1]); w.w = pk2(b[2], b[3]); o[i] = w; }
    }
}

template <bool LN2, bool ODD, bool DRY = false>
__device__ __forceinline__ void ln_phase(const Frame& F0, int L) {
    Frame F = launder(F0);
    const KArgs ka = kargs();
    const int jj = L >> 1;
    float* X32 = F.out; bf16* XB = (bf16*)(F.ws + WS_XB);
    const float* gam = ka->in[LN2 ? I_LN2G : I_LN1G] + (size_t)L * D; const float* bet = ka->in[LN2 ? I_LN2B : I_LN1B] + (size_t)L * D;
    f32x4 gv[4], bv[4];
#pragma unroll
    for (int j = 0; j < 4; ++j) { gv[j] = ((const GAS f32x4*)gam)[F.lane + 64 * j]; bv[j] = ((const GAS f32x4*)bet)[F.lane + 64 * j]; }
    LAS float* RT = (LAS float*)(F.lds + RING_OFF);
    LAS unsigned* TE = (LAS unsigned*)(F.lds + RING_OFF + 32768);
    volatile LAS unsigned* lcnt = F.MISC + 48; volatile LAS unsigned* gbase = F.MISC + 56;
    float rb[8];
    if (!LN2 && ODD) {
        const float* R = ka->in[I_ROUTER] + (size_t)jj * D * NEXP;
        for (int i = F.tid; i < D * NEXP; i += 512) RT[i] = R[i];
        if (F.tid < 8) lcnt[F.tid] = 0u;
#pragma unroll
        for (int e = 0; e < 8; ++e) rb[e] = ka->in[I_ROUTERB][jj * NEXP + e];
        __syncthreads();
    }
    const unsigned* route = (const unsigned*)(F.ws + WS_ROUTE);
    const bf16* YE = (const bf16*)(F.ws + F_YE);
    const bf16* T1 = (const bf16*)(F.ws + (LN2 ? F_U : Z_GR)); const bf16* T2 = (const bf16*)(F.ws + Z_GR);
    v2u nx[2][4], n1[2][4], n2[2][4], ny1[2][4], ny2[2][4]; f32x4 npv[2]; float gc1[2], gc2[2]; v4u rnA[2];
    npv[0] = npv[1] = (f32x4){0.f, 0.f, 0.f, 0.f}; gc1[0] = gc1[1] = gc2[0] = gc2[1] = 0.f;
    (void)n2; (void)ny1; (void)ny2; (void)npv; (void)gc1; (void)gc2; (void)rnA;
    int vz_ = 0; asm volatile("" : "+v"(vz_));
    const GAS v4u* route4 = (const GAS v4u*)(F.ws + WS_ROUTE) + vz_;
    const size_t rwb = (size_t)F.bx * 256 + F.wave;
#define LN_ROW_LOADS(B, rw_, ra_) do { const size_t rw__ = (rw_); const GAS v2u* a0_ = (const GAS v2u*)(XB + rw__ * D) + F.lane; const GAS v2u* b0_ = (const GAS v2u*)(T1 + rw__ * D) + F.lane; \
        _Pragma("unroll") for (int j = 0; j < 4; ++j) { nx[B][j] = a0_[64 * j]; n1[B][j] = b0_[64 * j]; } \
        if (LN2 && !ODD) { const GAS v2u* fp_ = (const GAS v2u*)(T2 + rw__ * D) + F.lane; _Pragma("unroll") for (int j = 0; j < 4; ++j) n2[B][j] = fp_[64 * j]; } \
        if (!LN2) npv[B] = ((const GAS f32x4*)(ka->in[I_P] + ((size_t)L * T_TOK + rw__) * PLE))[F.lane]; \
        if (LN2 && ODD) { const size_t r1_ = (size_t)F.MISC[16 + (ra_).x] * 256 + (ra_).z, r2_ = (size_t)F.MISC[16 + (ra_).y] * 256 + (ra_).w; \
            const GAS v2u* y1_ = (const GAS v2u*)(YE + r1_ * D) + F.lane; const GAS v2u* y2_ = (const GAS v2u*)(YE + r2_ * D) + F.lane; \
            _Pragma("unroll") for (int j = 0; j < 4; ++j) { ny1[B][j] = y1_[64 * j]; ny2[B][j] = y2_[64 * j]; } \
            gc1[B] = __builtin_bit_cast(float, route[rw__ * 8 + 4]); gc2[B] = __builtin_bit_cast(float, route[rw__ * 8 + 5]); } } while (0)
    { v4u r0_, r1x_; r0_.x = r0_.y = r0_.z = r0_.w = 0u; r1x_ = r0_;
      if (LN2 && ODD) { r0_ = route4[rwb * 2]; r1x_ = route4[(rwb + 8) * 2]; }
      LN_ROW_LOADS(0, rwb, r0_); LN_ROW_LOADS(1, rwb + 8, r1x_);
      if (LN2 && ODD) { rnA[0] = route4[(rwb + 16) * 2]; rnA[1] = route4[(rwb + 24) * 2]; } }
    for (int it2 = 0; it2 < 32; it2 += 2) {
#pragma unroll
      for (int bf = 0; bf < 2; ++bf) {
        const int it = it2 + bf;
        const int rl = F.wave + 8 * it; const size_t row = (size_t)F.bx * 256 + rl;
        GAS f32x4* xr = (GAS f32x4*)(X32 + row * D) + F.lane;
        f32x4 v[4]; float s = 0.f;
#pragma unroll
        for (int j = 0; j < 4; ++j) { const v2u a = nx[bf][j], b = n1[bf][j];
            v[j][0] = DN_ALPHA * bf_lo(a.x) + bf_lo(b.x); v[j][1] = DN_ALPHA * bf_hi(a.x) + bf_hi(b.x); v[j][2] = DN_ALPHA * bf_lo(a.y) + bf_lo(b.y); v[j][3] = DN_ALPHA * bf_hi(a.y) + bf_hi(b.y); }
        if (LN2 && !ODD) {
#pragma unroll
            for (int j = 0; j < 4; ++j) { const v2u b = n2[bf][j]; v[j][0] += bf_lo(b.x); v[j][1] += bf_hi(b.x); v[j][2] += bf_lo(b.y); v[j][3] += bf_hi(b.y); }
        }
        if (LN2 && ODD) {
            const float g1 = gc1[bf], g2 = gc2[bf];
#pragma unroll
            for (int j = 0; j < 4; ++j) { const v2u a = ny1[bf][j], b = ny2[bf][j];
                v[j][0] += g1 * bf_lo(a.x) + g2 * bf_lo(b.x); v[j][1] += g1 * bf_hi(a.x) + g2 * bf_hi(b.x);
                v[j][2] += g1 * bf_lo(a.y) + g2 * bf_lo(b.y); v[j][3] += g1 * bf_hi(a.y) + g2 * bf_hi(b.y); }
        }
        const f32x4 pv = npv[bf];
        if (it < 30) { v4u rcur_; rcur_.x = rcur_.y = rcur_.z = rcur_.w = 0u; if (LN2 && ODD) rcur_ = rnA[bf];
            LN_ROW_LOADS(bf, row + 16, rcur_);
            if (LN2 && ODD) { if (it < 28) rnA[bf] = route4[(row + 32) * 2]; } }
#pragma unroll
        for (int j = 0; j < 4; ++j) s += (v[j][0] + v[j][1]) + (v[j][2] + v[j][3]);
        const float mean = wave_sum(s, F.lane) * (1.f / D); float s2 = 0.f;
#pragma unroll
        for (int j = 0; j < 4; ++j) { v[j] = v[j] - mean; s2 += (v[j][0] * v[j][0] + v[j][1] * v[j][1]) + (v[j][2] * v[j][2] + v[j][3] * v[j][3]); }
        const float rstd = 1.f / sqrtf(wave_sum(s2, F.lane) * (1.f / D) + LN_EPS);
        GAS v2u* o8 = (GAS v2u*)((DRY ? (bf16*)(F.ws + WS_NEED) : XB) + row * D) + F.lane;
        GAS f32x4* xw = DRY ? (GAS f32x4*)((float*)(F.ws + WS_NEED) + row * D) + F.lane : xr;
#pragma unroll
        for (int j = 0; j < 4; ++j) { v[j] = v[j] * rstd * gv[j] + bv[j]; if (DRY || (LN2 && L == DEPTH - 1)) xw[64 * j] = v[j];
            v2u w; w.x = pk2(v[j][0], v[j][1]); w.y = pk2(v[j][2], v[j][3]); o8[64 * j] = w; }
        if (!LN2) {
            v2u w; w.x = pk2(pv[0], pv[1]); w.y = pk2(pv[2], pv[3]); ((GAS v2u*)(F.ws + (DRY ? WS_NEED : F_PB) + row * PLE * 2))[F.lane] = w;
        }
        if (!LN2 && ODD) {
            float lg[8];
#pragma unroll
            for (int e = 0; e < 8; ++e) lg[e] = 0.f;
#pragma unroll
            for (int j = 0; j < 4; ++j)
#pragma unroll
                for (int q = 0; q < 4; ++q) { const int c = 4 * F.lane + 256 * j + q; const f32x4 ra = *(const LAS f32x4*)(RT + c * 8), rc = *(const LAS f32x4*)(RT + c * 8 + 4); const float xv = v[j][q];
                    lg[0] += xv * ra[0]; lg[1] += xv * ra[1]; lg[2] += xv * ra[2]; lg[3] += xv * ra[3]; lg[4] += xv * rc[0]; lg[5] += xv * rc[1]; lg[6] += xv * rc[2]; lg[7] += xv * rc[3]; }
#pragma unroll
            for (int e = 0; e < 8; ++e) lg[e] = wave_sum(lg[e], F.lane) + rb[e];
            int e1 = 0; float v1 = lg[0];
#pragma unroll
            for (int e = 1; e < 8; ++e) if (lg[e] > v1) { v1 = lg[e]; e1 = e; }
            int e2 = -1; float v2 = 0.f;
#pragma unroll
            for (int e = 0; e < 8; ++e) if (e != e1 && (e2 < 0 || lg[e] > v2)) { v2 = lg[e]; e2 = e; }
            const float ex = __expf(v2 - v1), g1 = 1.f / (1.f + ex), g2 = ex * g1;
            if (F.lane == 0) { const unsigned lp1 = __hip_atomic_fetch_add((LAS unsigned*)lcnt + e1, 1u, __ATOMIC_RELAXED, __HIP_MEMORY_SCOPE_WORKGROUP), lp2 = __hip_atomic_fetch_add((LAS unsigned*)lcnt + e2, 1u, __ATOMIC_RELAXED, __HIP_MEMORY_SCOPE_WORKGROUP);
                TE[rl * 4 + 0] = (unsigned)e1 | ((unsigned)e2 << 8) | (lp1 << 16); TE[rl * 4 + 1] = lp2; TE[rl * 4 + 2] = __builtin_bit_cast(unsigned, g1); TE[rl * 4 + 3] = __builtin_bit_cast(unsigned, g2); }
        }
      }
    }
#undef LN_ROW_LOADS
    if (!LN2 && ODD) {
        __syncthreads();
        if (F.tid < 8) gbase[F.tid] = __hip_atomic_fetch_add(F.ctl + CW_CNT + jj * 1024 + 64 * F.tid, lcnt[F.tid], RLX_AGENT);
        __syncthreads();
        if (F.tid < 256) { const unsigned w0 = TE[F.tid * 4], lp2 = TE[F.tid * 4 + 1]; const unsigned e1 = w0 & 255u, e2 = (w0 >> 8) & 255u, lp1 = w0 >> 16;
            const unsigned p1 = gbase[e1] + lp1, p2 = gbase[e2] + lp2; const unsigned tok = (unsigned)F.bx * 256 + F.tid;
            GAS int* list = (GAS int*)(F.ws + WS_LIST); list[(size_t)e1 * T_TOK + p1] = (int)tok; list[(size_t)e2 * T_TOK + p2] = (int)tok;
            GAS v4u* ro = (GAS v4u*)(F.ws + WS_ROUTE) + (size_t)tok * 2; v4u a; a.x = e1; a.y = e2; a.z = p1; a.w = p2; ro[0] = a; v4u b; b.x = TE[F.tid * 4 + 2]; b.y = TE[F.tid * 4 + 3]; b.z = 0u; b.w = 0u; ro[1] = b; }
        __syncthreads();
    }
}
__device__ __forceinline__ int wave_scan_add(int x) {
    x += __builtin_amdgcn_update_dpp(0, x, 0x111, 0xf, 0xf, false);
    x += __builtin_amdgcn_update_dpp(0, x, 0x112, 0xf, 0xf, false);
    x += __builtin_amdgcn_update_dpp(0, x, 0x114, 0xf, 0xf, false);
    x += __builtin_amdgcn_update_dpp(0, x, 0x118, 0xf, 0xf, false);
    x += __builtin_amdgcn_update_dpp(0, x, 0x142, 0xa, 0xf, false);
    x += __builtin_amdgcn_update_dpp(0, x, 0x143, 0xc, 0xf, false);
    return x;
}
template <int NJ>
__device__ __forceinline__ unsigned select_topk_n(LAS const float* sc, int n_adm, GAS unsigned short* gout, LAS unsigned short* out, int lane, unsigned guess) {
    const int nj = n_adm >> 6;
    unsigned u[NJ];
#pragma unroll
    for (int j = 0; j < NJ; ++j) { unsigned b = 0u;
        if (j < NJ - 8 || j < nj) { b = __builtin_bit_cast(unsigned, sc[64 * j + lane]); b = (b == 0x80000000u) ? 0u : b; b = (b & 0x80000000u) ? ~b : (b | 0x80000000u); }
        u[j] = b; }
#define SEL_COUNT(c_, dst_) do { int t_ = 0; const unsigned cc_ = (unsigned)__builtin_amdgcn_readfirstlane((int)(c_)); _Pragma("unroll") for (int j8 = 0; j8 < NJ; j8 += 8) { unsigned long long m0_, m1_, m2_, m3_, m4_, m5_, m6_, m7_; \
        asm("v_cmp_le_u32_e64 %0, %8, %9\n\tv_cmp_le_u32_e64 %1, %8, %10\n\tv_cmp_le_u32_e64 %2, %8, %11\n\tv_cmp_le_u32_e64 %3, %8, %12\n\tv_cmp_le_u32_e64 %4, %8, %13\n\tv_cmp_le_u32_e64 %5, %8, %14\n\tv_cmp_le_u32_e64 %6, %8, %15\n\tv_cmp_le_u32_e64 %7, %8, %16" \
            : "=&s"(m0_), "=&s"(m1_), "=&s"(m2_), "=&s"(m3_), "=&s"(m4_), "=&s"(m5_), "=&s"(m6_), "=&s"(m7_) : "s"(cc_), "v"(u[j8]), "v"(u[j8 + 1]), "v"(u[j8 + 2]), "v"(u[j8 + 3]), "v"(u[j8 + 4]), "v"(u[j8 + 5]), "v"(u[j8 + 6]), "v"(u[j8 + 7])); \
        t_ += __popcll(m0_) + __popcll(m1_) + __popcll(m2_) + __popcll(m3_) + __popcll(m4_) + __popcll(m5_) + __popcll(m6_) + __popcll(m7_); } dst_ = t_; } while (0)
    typedef short s16x2 __attribute__((ext_vector_type(2)));
    s16x2 pk[NJ / 2];
#pragma unroll
    for (int j = 0; j < NJ / 2; ++j) pk[j] = __builtin_bit_cast(s16x2, (u[2 * j] >> 17) | ((u[2 * j + 1] >> 17) << 16));
#define SEL_COUNT15(c15_, dst_) do { const short cs_ = (short)(c15_); const s16x2 cc2_ = (s16x2){cs_, cs_}; s16x2 acc_ = (s16x2){0, 0}; \
        _Pragma("unroll") for (int j = 0; j < NJ / 2; ++j) acc_ -= (pk[j] - cc2_) >> 15; \
        const int a_ = __builtin_bit_cast(int, acc_); dst_ = 64 * NJ - __builtin_amdgcn_readlane(wave_scan_add((a_ & 0xffff) + (int)((unsigned)a_ >> 16)), 63); } while (0)
    unsigned lo = 0u, hi = 0xFFFFFFFFu, ex = 0u; bool exact = false; int c;
    { int l15 = 0, h15 = 0x8000, cl = 64 * NJ, ch = 0;
        if (guess != 0u) { const int g15 = (int)(guess >> 17);
            SEL_COUNT15(g15, c);
            if (c >= 256) { l15 = g15; cl = c; int d = 1;
                for (int e = 0; e < 8; ++e) { const int h = l15 + d; if (h >= 0x8000) break; SEL_COUNT15(h, c); if (c < 256) { h15 = h; ch = c; break; } l15 = h; cl = c; d <<= 2; } }
            else { h15 = g15; ch = c; int d = 1;
                for (int e = 0; e < 8; ++e) { const int l = h15 - d; if (l <= 0) break; SEL_COUNT15(l, c); if (c >= 256) { l15 = l; cl = c; break; } h15 = l; ch = c; d <<= 2; } } }
        while (h15 - l15 > 1) { const int mid = l15 + ((h15 - l15) >> 1); SEL_COUNT15(mid, c); if (c >= 256) { l15 = mid; cl = c; } else { h15 = mid; ch = c; } }
        lo = (unsigned)l15 << 17; hi = h15 >= 0x8000 ? 0xFFFFFFFFu : (unsigned)h15 << 17; (void)ch;
        if (cl == 256) { exact = true; ex = lo; }
    }
#undef SEL_COUNT15
    while (!exact && hi - lo > 1u) { const unsigned mid = lo + ((hi - lo) >> 1); SEL_COUNT(mid, c);
        if (c == 256) { exact = true; ex = mid; } else if (c > 256) lo = mid; else hi = mid; }
#undef SEL_COUNT
    const unsigned thr = exact ? ex - 1u : lo;
    int nl = 0;
#pragma unroll
    for (int j = 0; j < NJ; ++j) nl += (u[j] > thr) ? 1 : 0;
    const int incl = wave_scan_add(nl); const int ngt = __builtin_amdgcn_readlane(incl, 63);
    int pos = incl - nl;
#pragma unroll
    for (int j = 0; j < NJ; ++j) if (u[j] > thr) { out[pos] = (unsigned short)(64 * j + lane); ++pos; }
    const int quota = 256 - ngt;
    if (quota > 0) {
        int tbase = 0; const unsigned long long lt = (1ull << lane) - 1ull;
#pragma unroll
        for (int j = 0; j < NJ; ++j) {
            const bool eq = u[j] == thr; const unsigned long long meq = __ballot(eq); const int rk = tbase + __popcll(meq & lt);
            if (eq && rk < quota) out[ngt + rk] = (unsigned short)(64 * j + lane);
            tbase += __popcll(meq);
        }
    }
    asm volatile("s_waitcnt lgkmcnt(0)" ::: "memory");
    if (lane < 32) *(GAS v4u*)(gout + 8 * lane) = *(const LAS v4u*)(out + 8 * lane);
    asm volatile("s_waitcnt lgkmcnt(0)" ::: "memory");
    return thr;
}
__device__ __forceinline__ unsigned select_topk(LAS const float* sc, int n_adm, GAS unsigned short* out, LAS unsigned short* orow, int lane, unsigned guess) {
    if (n_adm <= 256) {
#pragma unroll
        for (int j = 0; j < 4; ++j) { const int p = lane + 64 * j; out[p] = (unsigned short)(p < n_adm ? p : 0); }
        return 0u;
    }
    if (n_adm <= 512) return select_topk_n<8>(sc, n_adm, out, orow, lane, guess);
    else if (n_adm <= 1024) return select_topk_n<16>(sc, n_adm, out, orow, lane, guess);
    else if (n_adm <= 1536) return select_topk_n<24>(sc, n_adm, out, orow, lane, guess);
    return select_topk_n<32>(sc, n_adm, out, orow, lane, guess);
}
template <int MODE = 0>
__device__ __forceinline__ void indexer_phase(const Frame& F0) {
    Frame F = launder(F0);
    LAS float* sc = (LAS float*)(F.lds + RING_OFF);
    const bf16* QI = (const bf16*)(F.ws + Z_QI); const bf16* SM = (const bf16*)(F.ws + Z_SM);
    GAS unsigned short* IDX = (GAS unsigned short*)(F.ws + WS_IDX);
    const int lane = F.lane, h = lane >> 5, r = lane & 31;
    const int rq = 2 * ((r >> 2) & 1) + ((r >> 4) & 1), rh = (r & 3) + 4 * ((r >> 3) & 1);
    const int vcu = (F.bx & 7) * (F.G >> 3) + (F.bx >> 3);
    unsigned guess[2] = {0u, 0u};
    bf16x8 A[4][4]; v4u wq[4][2];
#define IDX_TILE(pi_, b_, tq_) const int pid_ = vcu * 8 + ((pi_) >> 1), b_ = pid_ >> 6, jp_ = pid_ & 63, tq_ = 16 * (((pi_) & 1) ? 127 - jp_ : jp_)
#define IDX_LOAD_A(t0_) do { _Pragma("unroll") for (int mt = 0; mt < 4; ++mt) { \
        _Pragma("unroll") for (int s = 0; s < 4; ++s) A[mt][s] = *(const GAS bf16x8*)(QI + (size_t)((t0_) + 4 * mt + rq) * 512 + rh * 64 + 16 * s + 8 * h); \
        _Pragma("unroll") for (int qq = 0; qq < 2; ++qq) wq[mt][qq] = *(const GAS v4u*)(SM + (size_t)((t0_) + 4 * mt + 2 * h + qq) * 256 + 192); } } while (0)
    for (int pi = 0; pi < 16; ++pi) {
        IDX_TILE(pi, b, tq);
        const int t0 = b * SEQ + tq;
        const int n_adm = ((tq >> 6) + 1) * 64, nkb = n_adm >> 5;
        if (n_adm > 256 && MODE != 2) {
            IDX_LOAD_A(t0);
            bf16x8 B[4], Bn[4];
#pragma unroll
            for (int s = 0; s < 4; ++s) Bn[s] = *(const GAS bf16x8*)(SM + (size_t)(b * SEQ + 32 * F.wave + r) * 256 + 128 + 16 * s + 8 * h);
            for (int kb = F.wave; kb < nkb; kb += 8) {
                const int key = 32 * kb + r;
                const int keyn = (kb + 8 < nkb) ? key + 256 : key;
#pragma unroll
                for (int s = 0; s < 4; ++s) B[s] = Bn[s];
#pragma unroll
                for (int s = 0; s < 4; ++s) Bn[s] = *(const GAS bf16x8*)(SM + (size_t)(b * SEQ + keyn) * 256 + 128 + 16 * s + 8 * h);
#pragma unroll
                for (int mt = 0; mt < 4; ++mt) {
                    f32x16 acc;
#pragma unroll
                    for (int i = 0; i < 16; ++i) acc[i] = 0.f;
#pragma unroll
                    for (int s = 0; s < 4; ++s) acc = __builtin_amdgcn_mfma_f32_32x32x16_bf16(A[mt][s], B[s], acc, 0, 0, 0);
                    float sA = 0.f, sB = 0.f;
#pragma unroll
                    for (int i = 0; i < 8; ++i) { const unsigned wa = wq[mt][0][i >> 1], wb = wq[mt][1][i >> 1];
                        const float fa = (i & 1) ? bf_hi(wa) : bf_lo(wa), fb = (i & 1) ? bf_hi(wb) : bf_lo(wb);
                        sA += fmaxf(acc[i], 0.f) * fa; sB += fmaxf(acc[8 + i], 0.f) * fb; }
                    sc[(4 * mt + 2 * h) * 2048 + key] = sA; sc[(4 * mt + 2 * h + 1) * 2048 + key] = sB;
                }
            }
        }
        __syncthreads();
#pragma unroll 1
        for (int qq = 0; qq < 2 && MODE != 1; ++qq) { const int q = 2 * F.wave + qq; const unsigned g_ = (pi & 1) ? guess[1] : guess[0];
            const unsigned t_ = select_topk(sc + q * 2048, n_adm, IDX + (size_t)(t0 + q) * 256, (LAS unsigned short*)(F.lds + LDSCTL_OFF + 1024 + F.wave * 512), lane, g_); if (pi & 1) guess[1] = t_; else guess[0] = t_; }
        __syncthreads();
    }
#undef IDX_TILE
#undef IDX_LOAD_A
}

__device__ __forceinline__ unsigned vst_off(unsigned r, unsigned ch) { return r * 128u + 16u * (ch ^ ((((r >> 1) ^ (r >> 4)) & 1u) << 1) ^ (((r >> 3) & 1u) << 2)); }
__device__ __forceinline__ int t5_bucket_dev(int rel) {
    const int n = rel < 0 ? -rel : rel;
    int v = n;
    if (n >= 8) v = 8 + (n >= 12) + (n >= 16) + (n >= 23) + (n >= 32) + (n >= 46) + (n >= 64) + (n >= 91);
    return v + (rel > 0 ? 16 : 0);
}
#ifndef ATT_REPS
#define ATT_REPS 1
#endif
#ifndef ATT_FIXKEYS
#define ATT_FIXKEYS 0
#endif
template <int FIX = 0>
__device__ __forceinline__ void attention_phase(const Frame& F0) {
#pragma unroll 1
    for (int rep = 0; rep < ATT_REPS; ++rep) {
    Frame F = launder(F0);
    const GAS unsigned char* Q8 = (const GAS unsigned char*)(F.ws + Z_Q8); const GAS unsigned char* KV8 = (const GAS unsigned char*)(F.ws + Z_KV8); bf16* OB = (bf16*)(F.ws + Z_XR);
    const GAS unsigned short* IDX = (const GAS unsigned short*)(F.ws + WS_IDX);
    const int lane = F.lane, g = lane >> 4, m = lane & 15;
    LAS unsigned char* vst = F.lds + RING_OFF + F.wave * 4096;
    const unsigned vbase = (unsigned)(size_t)vst;
    LAS unsigned char* BK = F.lds + RING_OFF + 32768; LAS unsigned char* OH = F.lds + RING_OFF + 32768 + 2176;
    for (int i = F.tid; i < 2112; i += 512) BK[i] = (unsigned char)t5_bucket_dev(i - 2047);
    if (F.tid < 128) { const int bkt = F.tid >> 2, gg = F.tid & 3, j = bkt - 8 * gg; v4u oh; oh.x = oh.y = oh.z = oh.w = 0u;
        if (j >= 0 && j < 8) { const unsigned val = (j & 1) ? 0x3F800000u : 0x3F80u; if ((j >> 1) == 0) oh.x = val; else if ((j >> 1) == 1) oh.y = val; else if ((j >> 1) == 2) oh.z = val; else oh.w = val; }
        *(LAS v4u*)(OH + F.tid * 16) = oh; }
    __syncthreads();
    bf16x8 bb;
    { const float* rbias = kargs()->in[I_RELB]; unsigned w[4];
#pragma unroll
      for (int j = 0; j < 4; ++j) w[j] = pk2(8.0f * rbias[(8 * g + 2 * j) * 16 + m], 8.0f * rbias[(8 * g + 2 * j + 1) * 16 + m]);
      v4u t; t.x = w[0]; t.y = w[1]; t.z = w[2]; t.w = w[3]; bb = __builtin_bit_cast(bf16x8, t); }
    unsigned tra[4];
    { const unsigned rr_ = 8 * g + (m >> 1), fr_ = ((rr_ >> 2) & 3u) ^ ((rr_ >> 1) & 1u);
#pragma unroll
      for (int c = 0; c < 4; ++c) tra[c] = rr_ * 64u + 16u * ((unsigned)c ^ fr_) + 8u * (m & 1); }
    const long aones = (m == 0) ? 0x3838383838383838L : 0L;
    const int vcu = (F.bx & 7) * (F.G >> 3) + (F.bx >> 3);
    typedef long fp8x8;
    v4u ni0, ni1, nq; v4u ka[16]; unsigned koff[16];
#define ATT_KOFF(i0_, i1_) do { _Pragma("unroll") for (int k = 0; k < 4; ++k) { koff[2 * k] = ((i0_)[k] & 0xffffu) * 128u + 16u * g; koff[2 * k + 1] = ((i0_)[k] >> 16) * 128u + 16u * g; \
        koff[8 + 2 * k] = ((i1_)[k] & 0xffffu) * 128u + 16u * g; koff[8 + 2 * k + 1] = ((i1_)[k] >> 16) * 128u + 16u * g; } } while (0)
#ifdef ATT_NO_ASM
#define ATT_KLOAD(kvb_) do { const GAS unsigned char* kb_ = (kvb_); _Pragma("unroll") for (int T = 0; T < 16; ++T) ka[T] = *(const GAS v4u*)(kb_ + koff[T]); } while (0)
#define ATT_KWAIT(n_, T0_) do {} while (0)
#else
#define ATT_KLOAD(kvb_) do { const GAS unsigned char* kb_ = (kvb_); _Pragma("unroll") for (int T = 0; T < 16; ++T) { \
        asm volatile("global_load_dwordx4 %0, %1, %2" : "=&v"(ka[T]) : "v"(koff[T]), "s"(kb_) : "memory"); } } while (0)
#define ATT_KWAIT(n_, T0_) asm volatile("s_waitcnt vmcnt(" #n_ ")" : "+v"(ka[T0_]), "+v"(ka[T0_ + 1]), "+v"(ka[T0_ + 2]), "+v"(ka[T0_ + 3]), "+v"(ka[T0_ + 4]), "+v"(ka[T0_ + 5]), "+v"(ka[T0_ + 6]), "+v"(ka[T0_ + 7]) :: "memory")
#endif
#define ATT_TOK(it_) ((vcu >> 3) * SEQ + ((it_) >> 2) * 256 + (vcu & 7) * 32 + 8 * ((it_) & 3) + F.wave)
    { const int tok0 = ATT_TOK(0); const GAS v4u* ip = (const GAS v4u*)(IDX + (size_t)tok0 * 256 + 16 * m); ni0 = ip[0]; ni1 = ip[1];
      nq = *(const GAS v4u*)(Q8 + (size_t)tok0 * D + m * 64 + 16 * g);
      ATT_KOFF(ni0, ni1); ATT_KLOAD(KV8 + (size_t)(tok0 >> 11) * SEQ * 128); }
    for (int it = 0; it < 32; ++it) {
        const int tok = ATT_TOK(it), b = tok >> 11, tq = tok & (SEQ - 1);
        const int n_valid = (((tq >> 6) + 1) * 64) < 256 ? ((tq >> 6) + 1) * 64 : 256;
        const v4u qv = nq;
        const fp8x8 qf0 = (fp8x8)(((unsigned long long)qv.y << 32) | qv.x), qf1 = (fp8x8)(((unsigned long long)qv.w << 32) | qv.z);
        const GAS unsigned char* kvb = KV8 + (size_t)b * SEQ * 128;
        f32x4 S[16];
#pragma unroll
        for (int T = 0; T < 16; ++T) {
            if (T == 0) ATT_KWAIT(8, 0);
            if (T == 8) ATT_KWAIT(0, 8);
            const unsigned bkt = BK[(koff[T] >> 7) + (2047 - tq)];
            const v4u oh = *(const LAS v4u*)(OH + bkt * 64 + g * 16);
            f32x4 ab = (f32x4){0.f, 0.f, 0.f, 0.f}, a = (f32x4){0.f, 0.f, 0.f, 0.f};
            ab = __builtin_amdgcn_mfma_f32_16x16x32_bf16(__builtin_bit_cast(bf16x8, oh), bb, ab, 0, 0, 0);
            a = __builtin_amdgcn_mfma_f32_16x16x32_fp8_fp8((fp8x8)(((unsigned long long)ka[T].y << 32) | ka[T].x), qf0, a, 0, 0, 0);
            a = __builtin_amdgcn_mfma_f32_16x16x32_fp8_fp8((fp8x8)(((unsigned long long)ka[T].w << 32) | ka[T].z), qf1, a, 0, 0, 0);
            a = a + ab;
            S[T] = a;
        }
        __builtin_amdgcn_sched_barrier(0);
        v4u vv[16];
#pragma unroll
        for (int T = 0; T < 16; ++T) vv[T] = *(const GAS v4u*)(kvb + koff[T] + 64);
        if (n_valid < 256) {
#pragma unroll
            for (int T = 0; T < 16; ++T)
#pragma unroll
                for (int i = 0; i < 4; ++i) if (16 * (4 * g + i) + T >= n_valid) S[T][i] = -1e30f;
        }
        float mx = -3.0e38f;
#pragma unroll
        for (int T = 0; T < 16; ++T) { asm("v_max3_f32 %0, %1, %2, %0" : "+v"(mx) : "v"(S[T][0]), "v"(S[T][1])); asm("v_max3_f32 %0, %1, %2, %0" : "+v"(mx) : "v"(S[T][2]), "v"(S[T][3])); }
        mx = fmaxf(mx, lane_xor(mx, 16, lane)); mx = fmaxf(mx, lane_xor(mx, 32, lane));
        constexpr float SC = 1.4426950408889634f * 0.125f;
        const float mneg = 8.0f - mx * SC;
#pragma unroll
        for (int T = 0; T < 16; ++T)
#pragma unroll
            for (int i = 0; i < 4; ++i) S[T][i] = __builtin_amdgcn_exp2f(S[T][i] * SC + mneg);
        { const int tokn = ATT_TOK(it < 31 ? it + 1 : it); const GAS v4u* ip = (const GAS v4u*)(IDX + (size_t)tokn * 256 + 16 * m); ni0 = ip[0]; ni1 = ip[1];
          nq = *(const GAS v4u*)(Q8 + (size_t)tokn * D + m * 64 + 16 * g); }
        f32x4 O[4], Osum = (f32x4){0.f, 0.f, 0.f, 0.f};
#pragma unroll
        for (int c = 0; c < 4; ++c) O[c] = (f32x4){0.f, 0.f, 0.f, 0.f};
#pragma unroll
        for (int ks = 0; ks < 8; ++ks) {
#pragma unroll
            for (int tt = 0; tt < 2; ++tt) { const unsigned rr = 8 * (m >> 2) + 4 * tt + (m & 3), fr = ((rr >> 2) & 3u) ^ ((rr >> 1) & 1u);
                *(LAS v4u*)(vst + rr * 64u + 16u * ((unsigned)g ^ fr)) = vv[2 * ks + tt]; }
            int p0 = __builtin_amdgcn_cvt_pk_fp8_f32(S[2 * ks][0], S[2 * ks][1], 0, false); p0 = __builtin_amdgcn_cvt_pk_fp8_f32(S[2 * ks][2], S[2 * ks][3], p0, true);
            int p1 = __builtin_amdgcn_cvt_pk_fp8_f32(S[2 * ks + 1][0], S[2 * ks + 1][1], 0, false); p1 = __builtin_amdgcn_cvt_pk_fp8_f32(S[2 * ks + 1][2], S[2 * ks + 1][3], p1, true);
            const fp8x8 pf = (fp8x8)(((unsigned long long)(unsigned)p1 << 32) | (unsigned)p0);
            v2u f[4];
            asm volatile("s_waitcnt lgkmcnt(0)\n\t"
                         "ds_read_b64_tr_b8 %0, %4\n\tds_read_b64_tr_b8 %1, %5\n\tds_read_b64_tr_b8 %2, %6\n\tds_read_b64_tr_b8 %3, %7\n\t"
                         "s_waitcnt lgkmcnt(0)"
                         : "=&v"(f[0]), "=&v"(f[1]), "=&v"(f[2]), "=&v"(f[3])
                         : "v"(vbase + tra[0]), "v"(vbase + tra[1]), "v"(vbase + tra[2]), "v"(vbase + tra[3])
                         : "memory");
#pragma unroll
            for (int c = 0; c < 4; ++c) O[c] = __builtin_amdgcn_mfma_f32_16x16x32_fp8_fp8((fp8x8)(((unsigned long long)f[c].y << 32) | f[c].x), pf, O[c], 0, 0, 0);
            Osum = __builtin_amdgcn_mfma_f32_16x16x32_fp8_fp8(aones, pf, Osum, 0, 0, 0);
        }
        const float inv = 1.0f / lane_get(Osum[0], m);
#pragma unroll
        for (int c = 0; c < 4; ++c) { v2u w; w.x = pk2(O[c][0] * inv, O[c][1] * inv); w.y = pk2(O[c][2] * inv, O[c][3] * inv);
            *(GAS v2u*)(OB + (size_t)tok * D + m * 64 + 16 * c + 4 * g) = w; }
        { const int tokn = ATT_TOK(it < 31 ? it + 1 : it); ATT_KOFF(ni0, ni1); ATT_KLOAD(KV8 + (size_t)(tokn >> 11) * SEQ * 128); }
    }
    asm volatile("s_waitcnt vmcnt(0)" ::: "memory");
#undef ATT_KOFF
#undef ATT_KLOAD
#undef ATT_KWAIT
    }
}

__device__ __forceinline__ void attention_phase2(const Frame& F0) {
    Frame F = launder(F0);
    const GAS unsigned char* Q8 = (const GAS unsigned char*)(F.ws + Z_Q8); const GAS unsigned char* KV8 = (const GAS unsigned char*)(F.ws + Z_KV8); bf16* OB = (bf16*)(F.ws + Z_XR);
    const GAS unsigned short* IDX = (const GAS unsigned short*)(F.ws + WS_IDX);
    const int lane = F.lane, g = lane >> 4, m = lane & 15, r8 = lane >> 3, c8 = lane & 7;
    LAS unsigned char* vbuf = F.lds + RING_OFF + F.wave * 16384;
    const unsigned vbase = (unsigned)(size_t)vbuf;
    LAS unsigned char* irow = F.lds + LDSCTL_OFF + 1024 + F.wave * 512;
    LAS unsigned char* kst = F.lds + LDSCTL_OFF + 5120 + F.wave * 2048;
    LAS unsigned char* BK = F.lds + LDSCTL_OFF + 21504;
    LAS unsigned char* OH = F.lds + LDSCTL_OFF + 23680;
    for (int i = F.tid; i < 2112; i += 512) BK[i] = (unsigned char)t5_bucket_dev(i - 2047);
    if (F.tid < 128) { const int bkt = F.tid >> 2, gg = F.tid & 3, j = bkt - 8 * gg; v4u oh; oh.x = oh.y = oh.z = oh.w = 0u;
        if (j >= 0 && j < 8) { const unsigned val = (j & 1) ? 0x3F800000u : 0x3F80u; if ((j >> 1) == 0) oh.x = val; else if ((j >> 1) == 1) oh.y = val; else if ((j >> 1) == 2) oh.z = val; else oh.w = val; }
        *(LAS v4u*)(OH + F.tid * 16) = oh; }
    __syncthreads();
    bf16x8 bb;
    { const float* rbias = kargs()->in[I_RELB]; unsigned w[4];
#pragma unroll
      for (int j = 0; j < 4; ++j) w[j] = pk2(8.0f * rbias[(8 * g + 2 * j) * 16 + m], 8.0f * rbias[(8 * g + 2 * j + 1) * 16 + m]);
      v4u t; t.x = w[0]; t.y = w[1]; t.z = w[2]; t.w = w[3]; bb = __builtin_bit_cast(bf16x8, t); }
    unsigned tra[4];
    { const unsigned rr_ = 8 * g + (m >> 1), fr_ = ((rr_ >> 2) & 3u) ^ ((rr_ >> 1) & 1u);
#pragma unroll
      for (int c = 0; c < 4; ++c) tra[c] = vbase + rr_ * 64u + 16u * ((unsigned)c ^ fr_) + 8u * (m & 1); }
    const long aones = (m == 0) ? 0x3838383838383838L : 0L;
    const int vcu = (F.bx & 7) * (F.G >> 3) + (F.bx >> 3);
    unsigned wa[2][2]; const unsigned vstr = c8 >= 4 ? 2048u : 0u;
#pragma unroll
    for (int j = 0; j < 2; ++j)
#pragma unroll
        for (int t = 0; t < 2; ++t) { const unsigned rho = 8u * j + r8;
            if (c8 < 4) wa[j][t] = (unsigned)(LDSCTL_OFF + 5120) + F.wave * 2048u + 1024u * t + rho * 64u + 16u * ((unsigned)c8 ^ (3u * j));
            else { const unsigned rr = 8u * (rho >> 2) + 4u * t + (rho & 3u), fr = ((rr >> 2) & 3u) ^ ((rr >> 1) & 1u); wa[j][t] = (unsigned)RING_OFF + F.wave * 16384u + rr * 64u + 16u * ((unsigned)(c8 - 4) ^ fr); } }
    const unsigned kra = m * 64u + 16u * ((unsigned)g ^ (3u * ((m >> 3) & 1)));
    const unsigned bra = 2u * (32u * (m & 7) + (m >> 3));
    typedef long fp8x8;
    v4u ni, nq;
#define ATT2_QLOAD(tk_) do { const unsigned qo_ = (unsigned)(tk_) * (unsigned)D + (unsigned)(m * 64 + 16 * g); asm volatile("global_load_dwordx4 %0, %1, %2" : "=&v"(nq) : "v"(qo_), "s"(Q8) : "memory"); } while (0)
    { const int tok0 = ATT_TOK(0); ni = *(const GAS v4u*)(IDX + (size_t)tok0 * 256 + 8 * (lane & 31)); ATT2_QLOAD(tok0); }
    for (int it = 0; it < 32; ++it) {
        const int tok = ATT_TOK(it), b = tok >> 11, tq = tok & (SEQ - 1);
        const int n_valid = (((tq >> 6) + 1) * 64) < 256 ? ((tq >> 6) + 1) * 64 : 256;
        const GAS unsigned char* kvb = KV8 + (size_t)b * SEQ * 128;
        if (lane < 32) *(LAS v4u*)(irow + 16 * lane) = ni;
        v4u kv[32];
        { v4u ix[4];
#pragma unroll
          for (int k = 0; k < 4; ++k) ix[k] = *(const LAS v4u*)(irow + 64 * r8 + 16 * k);
#pragma unroll
          for (int q = 0; q < 32; ++q) { const unsigned w = ix[q >> 3][(q >> 1) & 3]; const unsigned off = ((q & 1) ? (w >> 16) : (w & 0xffffu)) * 128u + 16u * c8;
              asm volatile("global_load_dwordx4 %0, %1, %2" : "=&v"(kv[q]) : "v"(off), "s"(kvb) : "memory"); } }
        unsigned bkp[4] = {0u, 0u, 0u, 0u};
#pragma unroll
        for (int T = 0; T < 16; ++T) { const unsigned key = *(const LAS unsigned short*)(irow + bra + 4 * T); bkp[T >> 2] |= (unsigned)BK[key + (2047 - tq)] << (8 * (T & 3)); }
        f32x4 S[16];
#define ATT2_STAGE(T, N, KF) do { \
            asm volatile("s_waitcnt vmcnt(" #N ")" : "+v"(kv[2 * (T)]), "+v"(kv[2 * (T) + 1]) :: "memory"); \
            *(LAS v4u*)(F.lds + wa[0][(T) & 1] + ((T) >> 1) * vstr) = kv[2 * (T)]; *(LAS v4u*)(F.lds + wa[1][(T) & 1] + ((T) >> 1) * vstr) = kv[2 * (T) + 1]; \
            KF = *(const LAS v4u*)(kst + 1024 * ((T) & 1) + kra); } while (0)
#define ATT2_MMA(T, KF) do { \
            const v4u oh = *(const LAS v4u*)(OH + ((bkp[(T) >> 2] >> (8 * ((T) & 3))) & 0xffu) * 64u + g * 16); \
            f32x4 ab = (f32x4){0.f, 0.f, 0.f, 0.f}, a = (f32x4){0.f, 0.f, 0.f, 0.f}; \
            ab = __builtin_amdgcn_mfma_f32_16x16x32_bf16(__builtin_bit_cast(bf16x8, oh), bb, ab, 0, 0, 0); \
            a = __builtin_amdgcn_mfma_f32_16x16x32_fp8_fp8((fp8x8)(((unsigned long long)(KF).y << 32) | (KF).x), qf0, a, 0, 0, 0); \
            a = __builtin_amdgcn_mfma_f32_16x16x32_fp8_fp8((fp8x8)(((unsigned long long)(KF).w << 32) | (KF).z), qf1, a, 0, 0, 0); \
            S[T] = a + ab; } while (0)
        v4u kfa, kfb;
        ATT2_STAGE(0, 30, kfa);
        asm volatile("" : "+v"(nq) :: "memory");
        const v4u qv = nq;
        const fp8x8 qf0 = (fp8x8)(((unsigned long long)qv.y << 32) | qv.x), qf1 = (fp8x8)(((unsigned long long)qv.w << 32) | qv.z);
        ATT2_STAGE(1, 28, kfb); ATT2_MMA(0, kfa);   ATT2_STAGE(2, 26, kfa); ATT2_MMA(1, kfb);   ATT2_STAGE(3, 24, kfb); ATT2_MMA(2, kfa);   ATT2_STAGE(4, 22, kfa); ATT2_MMA(3, kfb);
        ATT2_STAGE(5, 20, kfb); ATT2_MMA(4, kfa);   ATT2_STAGE(6, 18, kfa); ATT2_MMA(5, kfb);   ATT2_STAGE(7, 16, kfb); ATT2_MMA(6, kfa);   ATT2_STAGE(8, 14, kfa); ATT2_MMA(7, kfb);
        ATT2_STAGE(9, 12, kfb); ATT2_MMA(8, kfa);   ATT2_STAGE(10, 10, kfa); ATT2_MMA(9, kfb);  ATT2_STAGE(11, 8, kfb); ATT2_MMA(10, kfa);  ATT2_STAGE(12, 6, kfa); ATT2_MMA(11, kfb);
        ATT2_STAGE(13, 4, kfb); ATT2_MMA(12, kfa);  ATT2_STAGE(14, 2, kfa); ATT2_MMA(13, kfb);  ATT2_STAGE(15, 0, kfb); ATT2_MMA(14, kfa);  ATT2_MMA(15, kfb);
#undef ATT2_STAGE
#undef ATT2_MMA
        if (n_valid < 256) {
            int bs0 = 128 * (g & 1) + (g >> 1); asm volatile("" : "+v"(bs0));
#pragma unroll
            for (int T = 0; T < 16; ++T) { const int lim = n_valid - 2 * T;
#pragma unroll
                for (int i = 0; i < 4; ++i) if (bs0 + 32 * i >= lim) S[T][i] = -1e30f; }
        }
        float mx = -3.0e38f;
#pragma unroll
        for (int T = 0; T < 16; ++T) { asm("v_max3_f32 %0, %1, %2, %0" : "+v"(mx) : "v"(S[T][0]), "v"(S[T][1])); asm("v_max3_f32 %0, %1, %2, %0" : "+v"(mx) : "v"(S[T][2]), "v"(S[T][3])); }
        mx = fmaxf(mx, lane_xor(mx, 16, lane)); mx = fmaxf(mx, lane_xor(mx, 32, lane));
        constexpr float SC = 1.4426950408889634f * 0.125f;
        const float mneg = 8.0f - mx * SC;
#pragma unroll
        for (int T = 0; T < 16; ++T)
#pragma unroll
            for (int i = 0; i < 4; ++i) S[T][i] = __builtin_amdgcn_exp2f(S[T][i] * SC + mneg);
        { const int tokn = ATT_TOK(it < 31 ? it + 1 : it); ni = *(const GAS v4u*)(IDX + (size_t)tokn * 256 + 8 * (lane & 31)); ATT2_QLOAD(tokn); }
        f32x4 O[4], Osum = (f32x4){0.f, 0.f, 0.f, 0.f};
#pragma unroll
        for (int c = 0; c < 4; ++c) O[c] = (f32x4){0.f, 0.f, 0.f, 0.f};
#pragma unroll
        for (int ks = 0; ks < 8; ++ks) {
            int p0 = __builtin_amdgcn_cvt_pk_fp8_f32(S[2 * ks][0], S[2 * ks][1], 0, false); p0 = __builtin_amdgcn_cvt_pk_fp8_f32(S[2 * ks][2], S[2 * ks][3], p0, true);
            int p1 = __builtin_amdgcn_cvt_pk_fp8_f32(S[2 * ks + 1][0], S[2 * ks + 1][1], 0, false); p1 = __builtin_amdgcn_cvt_pk_fp8_f32(S[2 * ks + 1][2], S[2 * ks + 1][3], p1, true);
            const fp8x8 pf = (fp8x8)(((unsigned long long)(unsigned)p1 << 32) | (unsigned)p0);
            v2u f[4];
            asm volatile("s_waitcnt lgkmcnt(0)\n\t"
                         "ds_read_b64_tr_b8 %0, %4\n\tds_read_b64_tr_b8 %1, %5\n\tds_read_b64_tr_b8 %2, %6\n\tds_read_b64_tr_b8 %3, %7\n\t"
                         "s_waitcnt lgkmcnt(0)"
                         : "=&v"(f[0]), "=&v"(f[1]), "=&v"(f[2]), "=&v"(f[3])
                         : "v"(tra[0] + 2048u * ks), "v"(tra[1] + 2048u * ks), "v"(tra[2] + 2048u * ks), "v"(tra[3] + 2048u * ks)
                         : "memory");
#pragma unroll
            for (int c = 0; c < 4; ++c) O[c] = __builtin_amdgcn_mfma_f32_16x16x32_fp8_fp8((fp8x8)(((unsigned long long)f[c].y << 32) | f[c].x), pf, O[c], 0, 0, 0);
            Osum = __builtin_amdgcn_mfma_f32_16x16x32_fp8_fp8(aones, pf, Osum, 0, 0, 0);
        }
        const float inv = 1.0f / lane_get(Osum[0], m);
#pragma unroll
        for (int c = 0; c < 4; ++c) { v2u w; w.x = pk2(O[c][0] * inv, O[c][1] * inv); w.y = pk2(O[c][2] * inv, O[c][3] * inv);
            *(GAS v2u*)(OB + (size_t)tok * D + m * 64 + 16 * c + 4 * g) = w; }
    }
    asm volatile("s_waitcnt vmcnt(0)" : "+v"(nq) :: "memory");
#undef ATT2_QLOAD
}
constexpr int XCS = 136;
constexpr int HHS = 132;
__device__ __forceinline__ float gelu_tanh(float x) {
    const float z = 0.7978845608028654f * (x + 0.044715f * x * x * x);
    const float e = __builtin_amdgcn_exp2f(2.885390081777927f * z);
    const float th = 1.0f - 2.0f * __builtin_amdgcn_rcpf(e + 1.0f);
    return 0.5f * x * (1.0f + th);
}
template <bool DRY = false>
__device__ __forceinline__ void lru_phase(const Frame& F0, int L) {
    Frame F = launder(F0);
    const KArgs ka = kargs();
    const int b = F.bx >> 3, nb = F.bx & 7;
    const bf16* XR = (const bf16*)(F.ws + Z_XR); bf16* YR = (bf16*)(F.ws + Z_YR);
    const bf16* WL = (const bf16*)(F.ws + WS_W + W_LRU);
    LAS bf16* XC = (LAS bf16*)(F.lds + RING_OFF);
    LAS float* HH = (LAS float*)(F.lds + RING_OFF + 2 * 64 * XCS * 2);
    const int tid = F.tid, lane = F.lane, w = F.wave, g = lane >> 4, m = lane & 15;
    const int cc = tid & 15, tp = tid >> 4;
    const int ch0 = nb * 128 + 8 * cc;
    float cw[4][8], cbias[8];
#pragma unroll
    for (int j = 0; j < 4; ++j)
#pragma unroll
        for (int k = 0; k < 8; ++k) cw[j][k] = ka->in[I_CONVW][(size_t)L * 4 * D + j * D + ch0 + k];
#pragma unroll
    for (int k = 0; k < 8; ++k) cbias[k] = ka->in[I_CONVB][(size_t)L * D + ch0 + k];
    bf16x8 Br[4], Bi[4];
#pragma unroll
    for (int s = 0; s < 4; ++s) { Br[s] = *(const GAS bf16x8*)(WL + ((size_t)nb * 128 + 16 * w + m) * 128 + 32 * s + 8 * g);
                                  Bi[s] = *(const GAS bf16x8*)(WL + (size_t)8 * 128 * 128 + ((size_t)nb * 128 + 16 * w + m) * 128 + 32 * s + 8 * g); }
    const int chl = 16 * w + m, chg = nb * 128 + chl;
    const float ba = ka->in[I_LRUBA][(size_t)L * D + chg], bx = ka->in[I_LRUBX][(size_t)L * D + chg];
    const float lam = ka->in[I_LAM][(size_t)L * D + chg];
    const float sp8 = -8.0f * (fmaxf(-lam, 0.f) + log1pf(__expf(-fabsf(lam))));
    float carry = 0.f;
    const size_t rowb = (size_t)b * SEQ;
    v4u nxin[5], nyin[2];
#pragma unroll
    for (int k = 0; k < 5; ++k) { const int t = 2 * tp - 3 + k; v4u z; z.x = z.y = z.z = z.w = 0u; nxin[k] = (t >= 0) ? *(const GAS v4u*)(XR + (rowb + t) * D + ch0) : z; }
#pragma unroll
    for (int k = 0; k < 2; ++k) nyin[k] = *(const GAS v4u*)(YR + (rowb + 2 * tp + k) * D + ch0);
    for (int tile = 0; tile < 32; ++tile) {
        const int t0 = tile * 64, buf = tile & 1;
        LAS bf16* xc = XC + buf * 64 * XCS; LAS float* hh = HH + buf * 64 * HHS;
        v4u xin[5], yin[2];
#pragma unroll
        for (int k = 0; k < 5; ++k) xin[k] = nxin[k];
#pragma unroll
        for (int k = 0; k < 2; ++k) yin[k] = nyin[k];
        if (tile < 31) {
#pragma unroll
            for (int k = 0; k < 5; ++k) nxin[k] = *(const GAS v4u*)(XR + (rowb + t0 + 64 + 2 * tp - 3 + k) * D + ch0);
#pragma unroll
            for (int k = 0; k < 2; ++k) nyin[k] = *(const GAS v4u*)(YR + (rowb + t0 + 64 + 2 * tp + k) * D + ch0);
        }
#pragma unroll
        for (int k = 0; k < 2; ++k) { float o[8];
#pragma unroll
            for (int c = 0; c < 8; ++c) { float a = cbias[c];
#pragma unroll
                for (int j = 0; j < 4; ++j) { const unsigned wv = xin[k + j][c >> 1]; a += ((c & 1) ? bf_hi(wv) : bf_lo(wv)) * cw[j][c]; }
                o[c] = a; }
            v4u pw; pw.x = pk2(o[0], o[1]); pw.y = pk2(o[2], o[3]); pw.z = pk2(o[4], o[5]); pw.w = pk2(o[6], o[7]);
            *(LAS v4u*)(xc + (2 * tp + k) * XCS + 8 * cc) = pw; }
        __syncthreads();
        float P[4][4], W[4][4];
#pragma unroll
        for (int mt = 0; mt < 4; ++mt) {
            f32x4 ar = (f32x4){0.f, 0.f, 0.f, 0.f}, ai = (f32x4){0.f, 0.f, 0.f, 0.f};
#pragma unroll
            for (int s = 0; s < 4; ++s) { const bf16x8 A = *(const LAS bf16x8*)(xc + (16 * mt + m) * XCS + 32 * s + 8 * g);
                ar = __builtin_amdgcn_mfma_f32_16x16x32_bf16(A, Br[s], ar, 0, 0, 0); ai = __builtin_amdgcn_mfma_f32_16x16x32_bf16(A, Bi[s], ai, 0, 0, 0); }
#pragma unroll
            for (int i = 0; i < 4; ++i) {
                const float rr = sigmoidf_fast(ar[i] + ba), ig = sigmoidf_fast(ai[i] + bx);
                const float la = sp8 * rr;
                const float a = __builtin_amdgcn_exp2f(1.4426950408889634f * la);
                const float mult = __builtin_amdgcn_sqrtf(fmaxf(__builtin_fmaf(-a, a, 1.0f), 0.f));
                const float xv = __builtin_bit_cast(float, (unsigned)xc[(16 * mt + 4 * g + i) * XCS + chl] << 16);
                const float u = mult * (ig * xv);
                if (i == 0) { P[mt][0] = a; W[mt][0] = u; } else { P[mt][i] = a * P[mt][i - 1]; W[mt][i] = a * W[mt][i - 1] + u; }
            }
        }
        float Ac[4], Uc[4], Ae[4], Ue[4], At[4], Ut[4];
#pragma unroll
        for (int mt = 0; mt < 4; ++mt) { Ac[mt] = P[mt][3]; Uc[mt] = W[mt][3]; }
        { float A1[4], U1[4];
#pragma unroll
          for (int mt = 0; mt < 4; ++mt) { A1[mt] = lane_up(Ac[mt], 16, lane); U1[mt] = lane_up(Uc[mt], 16, lane); }
#pragma unroll
          for (int mt = 0; mt < 4; ++mt) if (g >= 1) { Uc[mt] = Ac[mt] * U1[mt] + Uc[mt]; Ac[mt] = Ac[mt] * A1[mt]; } }
        { float A2[4], U2[4];
#pragma unroll
          for (int mt = 0; mt < 4; ++mt) { A2[mt] = lane_up(Ac[mt], 32, lane); U2[mt] = lane_up(Uc[mt], 32, lane); }
#pragma unroll
          for (int mt = 0; mt < 4; ++mt) if (g >= 2) { Uc[mt] = Ac[mt] * U2[mt] + Uc[mt]; Ac[mt] = Ac[mt] * A2[mt]; } }
#pragma unroll
        for (int mt = 0; mt < 4; ++mt) { Ae[mt] = lane_up(Ac[mt], 16, lane); Ue[mt] = lane_up(Uc[mt], 16, lane); At[mt] = lane_get(Ac[mt], 48 + m); Ut[mt] = lane_get(Uc[mt], 48 + m); }
#pragma unroll
        for (int mt = 0; mt < 4; ++mt) {
            const float ae = g == 0 ? 1.f : Ae[mt], ue = g == 0 ? 0.f : Ue[mt];
            const float hin = ae * carry + ue;
#pragma unroll
            for (int i = 0; i < 4; ++i) hh[(16 * mt + 4 * g + i) * HHS + chl] = P[mt][i] * hin + W[mt][i];
            carry = At[mt] * carry + Ut[mt];
        }
        __syncthreads();
#pragma unroll
        for (int k = 0; k < 2; ++k) { const f32x4 h0 = *(const LAS f32x4*)(hh + (2 * tp + k) * HHS + 8 * cc), h1 = *(const LAS f32x4*)(hh + (2 * tp + k) * HHS + 8 * cc + 4);
            float o[8];
#pragma unroll
            for (int c = 0; c < 8; ++c) { const unsigned wv = yin[k][c >> 1]; const float y = (c & 1) ? bf_hi(wv) : bf_lo(wv); o[c] = (c < 4 ? h0[c] : h1[c - 4]) * gelu_tanh(y); }
            v4u pw; pw.x = pk2(o[0], o[1]); pw.y = pk2(o[2], o[3]); pw.z = pk2(o[4], o[5]); pw.w = pk2(o[6], o[7]);
            *(GAS v4u*)((DRY ? (bf16*)(F.ws + WS_NEED) : YR) + (rowb + t0 + 2 * tp + k) * D + ch0) = pw; }
    }
    __syncthreads();
}

struct MoeOrder : pg8::StaticOrder {
    const volatile LAS unsigned* tb; int tile0; const int* list; size_t bstride;
    __device__ __forceinline__ int expert_of(int gt) const { int e = 0;
#pragma unroll
        for (int k = 1; k < 8; ++k) e += (gt >= (int)tb[k]) ? 1 : 0;
        return e; }
    __device__ __forceinline__ const char* b_base(const pg8::Gemm& g, const pg8::Unit& u, size_t tstep) const { return (const char*)g.Bt + (size_t)expert_of(tile0 + u.pm) * bstride + (size_t)u.pn * tstep; }
};
struct MoeGatherOrder : MoeOrder {
    static constexpr bool GATHER = true;
    __device__ __forceinline__ const char* a_base(const pg8::Gemm& g, const pg8::Unit&, size_t) const { return (const char*)g.A; }
    __device__ __forceinline__ void a_rows(const pg8::Unit& u, int R0, int R1, int C0, int C1, int K, unsigned (&off)[2][2]) const {
        const int gt = tile0 + u.pm, e = expert_of(gt), j = gt - (int)tb[e], n = (int)tb[16 + e];
        const GAS int* le = (const GAS int*)list + (size_t)e * T_TOK;
#pragma unroll
        for (int h = 0; h < 2; ++h) { int p0 = 256 * j + 128 * h + R0, p1 = 256 * j + 128 * h + R1; p0 = p0 < n ? p0 : n - 1; p1 = p1 < n ? p1 : n - 1;
            off[h][0] = ((unsigned)le[p0] * (unsigned)K + (unsigned)C0) * 2u; off[h][1] = ((unsigned)le[p1] * (unsigned)K + (unsigned)C1) * 2u; }
    }
};
#ifdef SELFCHECK
#ifndef SC_TOL
#define SC_TOL 0.03f
#define SC_ABS 1e-5f
#endif
__device__ __forceinline__ float sc_bf(const bf16* p, size_t i) { return __builtin_bit_cast(float, (unsigned)((const GAS bf16*)p)[i] << 16); }
__device__ __forceinline__ float sc_f8(const unsigned char* p, size_t i) {
    const unsigned v = ((const GAS unsigned char*)p)[i]; const unsigned e = (v >> 3) & 15u, mn = v & 7u; float r;
    if (e == 0u) r = (float)mn * 0.001953125f; else r = (1.0f + (float)mn * 0.125f) * exp2f((float)e - 7.0f);
    return (v & 128u) ? -r : r; }
__device__ __forceinline__ void sc_fail(const Frame& F, unsigned code) { __hip_atomic_fetch_or(F.ctl + CW_CODE, code, RLX_AGENT); }
__device__ __forceinline__ int sc_bucket_ref(int rel) {
    const int half = 16, max_exact = 8; const int ret = rel > 0 ? half : 0; const int n = rel < 0 ? -rel : rel;
    const float nf = (float)(n > 1 ? n : 1);
    int large = max_exact + (int)(logf(nf / (float)max_exact) / logf(16.0f) * (float)(half - max_exact));
    large = large < half - 1 ? large : half - 1;
    return ret + (n < max_exact ? n : large);
}
__device__ __forceinline__ void selfcheck_topk(const Frame& F0) {
    Frame F = launder(F0);
    if (F.wave != 0) return;
    const bf16* QI = (const bf16*)(F.ws + Z_QI); const bf16* SM = (const bf16*)(F.ws + Z_SM);
    const GAS unsigned short* IDX = (const GAS unsigned short*)(F.ws + WS_IDX);
    LAS float* sc = (LAS float*)(F.lds + RING_OFF);
    LAS unsigned* bm = (LAS unsigned*)(F.lds + RING_OFF + 8192);
    const int tok = F.bx * 256 + ((F.bx * 37) & 255), b = tok >> 11, tq = tok & (SEQ - 1), n_adm = ((tq >> 6) + 1) * 64;
    const int lane = F.lane;
    bm[lane] = 0u;
    for (int s = lane; s < n_adm; s += 64) { float score = 0.f;
        for (int h = 0; h < 8; ++h) { float d = 0.f;
            for (int k = 0; k < 64; ++k) d += sc_bf(QI, (size_t)tok * 512 + h * 64 + k) * sc_bf(SM, (size_t)(b * SEQ + s) * 256 + 128 + k);
            score += fmaxf(d, 0.f) * sc_bf(SM, (size_t)tok * 256 + 192 + h); }
        sc[s] = score; }
    asm volatile("s_waitcnt lgkmcnt(0)" ::: "memory");
    const int nsel = n_adm < 256 ? n_adm : 256;
    float msel = 3.0e38f; bool bad = false;
    for (int p = lane; p < nsel; p += 64) { const int key = IDX[(size_t)tok * 256 + p]; if (key >= n_adm) { bad = true; continue; }
        const unsigned old = __hip_atomic_fetch_or(bm + (key >> 5), 1u << (key & 31), __ATOMIC_RELAXED, __HIP_MEMORY_SCOPE_WORKGROUP); if (old & (1u << (key & 31))) bad = true;
        msel = fminf(msel, sc[key]); }
    asm volatile("s_waitcnt lgkmcnt(0)" ::: "memory");
    float muns = -3.0e38f, amax = 0.f;
    for (int s = lane; s < n_adm; s += 64) { amax = fmaxf(amax, fabsf(sc[s])); if (!((bm[s >> 5] >> (s & 31)) & 1u)) muns = fmaxf(muns, sc[s]); }
#pragma unroll
    for (int o = 1; o < 64; o <<= 1) { msel = fminf(msel, lane_xor(msel, o, lane)); muns = fmaxf(muns, lane_xor(muns, o, lane)); amax = fmaxf(amax, lane_xor(amax, o, lane)); }
    if (muns > msel + 1e-4f * amax) bad = true;
    if (__any(bad)) { if (lane == 0) sc_fail(F, 1u); }
}
__device__ __forceinline__ void selfcheck_attn(const Frame& F0) {
    Frame F = launder(F0);
    if (F.wave != 0) return;
    const KArgs ka = kargs();
    const unsigned char* Q8 = F.ws + Z_Q8; const unsigned char* KV8 = F.ws + Z_KV8; const bf16* OB = (const bf16*)(F.ws + Z_XR);
    const GAS unsigned short* IDX = (const GAS unsigned short*)(F.ws + WS_IDX);
    LAS float* lg = (LAS float*)(F.lds + RING_OFF + 65536);
    const int tok = F.bx * 256 + ((F.bx * 37) & 255), b = tok >> 11, tq = tok & (SEQ - 1), n_adm = ((tq >> 6) + 1) * 64, nv = n_adm < 256 ? n_adm : 256;
    const int lane = F.lane;
    for (int p = lane; p < 256; p += 64) { const int key = IDX[(size_t)tok * 256 + p]; const int bk = sc_bucket_ref(key - tq);
        for (int h = 0; h < 16; ++h) { float d = 0.f;
            for (int k = 0; k < 64; ++k) d += sc_f8(Q8, (size_t)tok * D + h * 64 + k) * sc_f8(KV8, (size_t)(b * SEQ + key) * 128 + k);
            lg[h * 256 + p] = p < nv ? 0.125f * d + ((const GAS float*)ka->in[I_RELB])[bk * 16 + h] : -1e30f; } }
    asm volatile("s_waitcnt lgkmcnt(0)" ::: "memory");
    if (lane < 16) { float mx = -3.0e38f; for (int p = 0; p < 256; ++p) mx = fmaxf(mx, lg[lane * 256 + p]); float sum = 0.f;
        for (int p = 0; p < 256; ++p) { const float e = __expf(lg[lane * 256 + p] - mx); lg[lane * 256 + p] = e; sum += e; }
        const float inv = 1.f / sum; for (int p = 0; p < 256; ++p) lg[lane * 256 + p] *= inv; }
    asm volatile("s_waitcnt lgkmcnt(0)" ::: "memory");
    float emax = 0.f, omax = 0.f;
    for (int o = lane; o < 1024; o += 64) { const int h = o >> 6, d = o & 63; float acc = 0.f;
        for (int p = 0; p < 256; ++p) { const int key = IDX[(size_t)tok * 256 + p]; acc += lg[h * 256 + p] * sc_f8(KV8, (size_t)(b * SEQ + key) * 128 + 64 + d); }
        const float got = sc_bf(OB, (size_t)tok * D + o); emax = fmaxf(emax, fabsf(got - acc)); omax = fmaxf(omax, fabsf(acc)); }
#pragma unroll
    for (int o = 1; o < 64; o <<= 1) { emax = fmaxf(emax, lane_xor(emax, o, lane)); omax = fmaxf(omax, lane_xor(omax, o, lane)); }
    if (!(emax <= SC_TOL * omax + SC_ABS)) { if (lane == 0) sc_fail(F, 2u); }
}
__device__ __forceinline__ void selfcheck_lru(const Frame& F0, int L, bool after) {
    Frame F = launder(F0);
    if (F.wave != 0) return;
    const KArgs ka = kargs();
    const bf16* XR = (const bf16*)(F.ws + Z_XR); const bf16* YR = (const bf16*)(F.ws + Z_YR);
    GAS float* EXP = (GAS float*)(F.ws + WS_NEED) + (size_t)F.bx * SEQ;
    const int b = F.bx >> 3, ch = ((F.bx & 7) * 128 + ((F.bx * 29) & 127)), nb = ch >> 7, lane = F.lane;
    if (after) { float emax = 0.f, omax = 0.f;
        for (int t = lane; t < SEQ; t += 64) { const float e = EXP[t], g = sc_bf(YR, (size_t)(b * SEQ + t) * D + ch); emax = fmaxf(emax, fabsf(e - g)); omax = fmaxf(omax, fabsf(e)); }
#pragma unroll
        for (int o = 1; o < 64; o <<= 1) { emax = fmaxf(emax, lane_xor(emax, o, lane)); omax = fmaxf(omax, lane_xor(omax, o, lane)); }
        if (!(emax <= SC_TOL * omax + SC_ABS)) { if (lane == 0) sc_fail(F, 4u); }
        return; }
    const float* cw = ka->in[I_CONVW] + (size_t)L * 4 * D; const float* cb = ka->in[I_CONVB] + (size_t)L * D;
    const float* wa = ka->in[I_LRUWA] + ((size_t)L * 8 + nb) * 128 * 128; const float* wx = ka->in[I_LRUWX] + ((size_t)L * 8 + nb) * 128 * 128;
    const float lam = ka->in[I_LAM][(size_t)L * D + ch], ba = ka->in[I_LRUBA][(size_t)L * D + ch], bx = ka->in[I_LRUBX][(size_t)L * D + ch];
    const float sp = fmaxf(-lam, 0.f) + log1pf(expf(-fabsf(lam)));
    const int dl = ch & 127;
    float h = 0.f;
    for (int t = 0; t < SEQ; ++t) {
        float pr = 0.f, pi = 0.f, xcc = 0.f;
#pragma unroll
        for (int q = 0; q < 2; ++q) { const int cl = lane + 64 * q, cg = nb * 128 + cl; float xc = cb[cg];
            for (int j = 0; j < 4; ++j) { const int tt = t - 3 + j; if (tt >= 0) xc += sc_bf(XR, (size_t)(b * SEQ + tt) * D + cg) * cw[j * D + cg]; }
            pr += xc * wa[cl * 128 + dl]; pi += xc * wx[cl * 128 + dl]; if (cl == dl) xcc = xc; }
#pragma unroll
        for (int o = 1; o < 64; o <<= 1) { pr += lane_xor(pr, o, lane); pi += lane_xor(pi, o, lane); xcc += lane_xor(xcc, o, lane); }
        const float r = 1.f / (1.f + expf(-(pr + ba))), ig = 1.f / (1.f + expf(-(pi + bx)));
        const float la = -8.0f * r * sp, a = expf(la), u = sqrtf(-expm1f(2.0f * la)) * (ig * xcc);
        h = a * h + u;
        const float y = sc_bf(YR, (size_t)(b * SEQ + t) * D + ch);
        const float gl = 0.5f * y * (1.f + tanhf(0.7978845608028654f * (y + 0.044715f * y * y * y)));
        if (lane == 0) EXP[t] = h * gl;
    }
}
#endif
__global__ void __launch_bounds__(NWAVES * 64, 2) mk_fwd(Args args) {
    extern __shared__ __attribute__((aligned(16))) unsigned char lds[];
    Frame F;
    F.lds = (LAS unsigned char*)lds;
    F.MISC = (volatile LAS unsigned*)(F.lds + MISC_OFF);
    F.tid = threadIdx.x; F.lane = F.tid & 63; F.wave = __builtin_amdgcn_readfirstlane(F.tid >> 6);
    F.G = gridDim.x; F.bx = blockIdx.x;
    F.ws = args.ws; F.ctl = (gu32*)(args.ws + WS_CTL); F.out = args.out;
    for (int u = threadIdx.x; u < (LDS_BYTES - LDSCTL_OFF) / 4; u += NWAVES * 64) ((LAS unsigned*)(F.lds + LDSCTL_OFF))[u] = 0u;
    __syncthreads();
    XcdBarrier bar = xcd_barrier_post((unsigned*)(F.ctl + CW_BAR), F.MISC + 8);
#ifdef PROBE_XCC
    if ((blockIdx.x & 7u) != (bar.x & 7u)) { const unsigned long long t0 = __builtin_amdgcn_s_memrealtime(); while (__builtin_amdgcn_s_memrealtime() - t0 < 200000ull) __builtin_amdgcn_s_sleep(8); }
#endif
#ifdef PROF_SEL
#ifndef PROF_WG
#define PROF_WG 0
#endif
#ifndef PROF_SEL2
#define PROF_SEL2 50
#endif
#ifndef PROF_MUL
#define PROF_MUL 1.0f
#endif
#define PROF_END(slot) do { if (launder(F).tid == 0) { const unsigned t_ = (unsigned)__builtin_amdgcn_s_memrealtime(); F.MISC[64 + (slot)] += t_ - F.MISC[96]; F.MISC[96] = t_; F.MISC[99] = (slot); } } while (0)
#define PROF_BEGIN(ph) do { if (launder(F).tid == 0) F.MISC[101] = (ph); } while (0)
#define PROF_WAIT() do { if (launder(F).tid == 0) { const unsigned t_ = (unsigned)__builtin_amdgcn_s_memrealtime(); F.MISC[80 + F.MISC[99]] += t_ - F.MISC[96]; F.MISC[64 + 13] += t_ - F.MISC[96]; F.MISC[96] = t_; } } while (0)
    if (F.tid == 0) { const unsigned t_ = (unsigned)__builtin_amdgcn_s_memrealtime(); F.MISC[96] = t_; F.MISC[98] = t_; }
#else
#define PROF_END(slot) do { } while (0)
#define PROF_BEGIN(ph) do { } while (0)
#define PROF_WAIT() do { } while (0)
#endif
#define GRID_BAR() do { XcdBarrier b_ = bar; unsigned* p_ = bar.bar; asm volatile("" : "+s"(p_)); b_.bar = p_; xcd_barrier(b_); PROF_WAIT(); } while (0)
    float* X32 = args.out;
#define LOCAL_HANDOFF() do { asm volatile("s_waitcnt vmcnt(0)" ::: "memory"); __syncthreads(); __builtin_amdgcn_fence(__ATOMIC_ACQUIRE, "agent"); asm volatile("s_waitcnt vmcnt(0)" ::: "memory"); __syncthreads(); } while (0)
    LAS unsigned char* ring = F.lds + RING_OFF;
    using pg8::Gemm; using pg8::StaticOrder;

    for (int L = -1; L < DEPTH; ++L) {
        const int odd = L & 1;
        if (L >= 0) {
        { const Frame P = launder(F); unsigned char* ws = P.ws; unsigned char* wb = ws + WS_W; bf16* XB = (bf16*)(ws + WS_XB); (void)XB; (void)wb;
          Gemm g{XB, (const bf16*)(wb + W_IN), T_TOK, NIN, D}; StaticOrder S; S.init(T_TOK, NIN, P.G, P.bx);
          pg8::EpiZ E{(bf16*)(ws + Z_Q), (bf16*)(ws + Z_QI), (bf16*)(ws + Z_SM), ws + Z_Q8, ws + Z_KV8};
PROF_BEGIN(1);
#ifndef SK_G1
          pg8::gemm_phase<pg8::EpiZ, StaticOrder>(ring, g, S, E, P.wave);
#endif
#ifdef DUP_G1
          pg8::gemm_phase<pg8::EpiZ, StaticOrder>(ring, g, S, E, P.wave);
#endif
        }
        PROF_END(1);
        GRID_BAR();
#if defined(SELFCHECK) && SELFCHECK == 3
        if (L == 0) { selfcheck_lru(F, L, false); __syncthreads(); }
#endif
#ifdef DUP_IDX
        indexer_phase<DUP_IDX>(F);
#endif
#ifndef SK_IDX
        indexer_phase(F);
#endif
#ifdef DUP_LRU
        lru_phase<true>(F, L);
#endif
#ifndef SK_LRU
        lru_phase(F, L);
#endif
        PROF_END(2);
        GRID_BAR();
#if defined(SELFCHECK) && SELFCHECK == 1
        if (L == 0) { selfcheck_topk(F); __syncthreads(); }
#endif
#if defined(SELFCHECK) && SELFCHECK == 3
        if (L == 0) { selfcheck_lru(F, L, true); __syncthreads(); }
#endif
#ifdef DUP_ATT
        attention_phase<DUP_ATT>(F); __syncthreads();
#endif
#ifndef SK_ATT
#ifdef ATT_V1
        attention_phase(F);
#else
        attention_phase2(F);
#endif
#endif
        PROF_END(3);
        GRID_BAR();
#if defined(SELFCHECK) && SELFCHECK == 2
        if (L == 0) { selfcheck_attn(F); __syncthreads(); }
#endif
        { const Frame P = launder(F); unsigned char* ws = P.ws; unsigned char* wb = ws + WS_W; bf16* XB = (bf16*)(ws + WS_XB); (void)XB; (void)wb;
          Gemm g{(const bf16*)(ws + Z_XR), (const bf16*)(wb + W_BRA), T_TOK, D, D}; StaticOrder S; S.init(T_TOK, D, F.G, F.bx);
          pg8::EpiGate<0> E{(bf16*)(ws + Z_GA), nullptr};
PROF_BEGIN(2);
#ifndef SK_G2
          pg8::gemm_phase<pg8::EpiGate<0>, StaticOrder>(ring, g, S, E, P.wave);
#endif
        }
        LOCAL_HANDOFF();
        { const Frame P = launder(F); unsigned char* ws = P.ws; unsigned char* wb = ws + WS_W; bf16* XB = (bf16*)(ws + WS_XB); (void)XB; (void)wb;
          Gemm g{(const bf16*)(ws + Z_YR), (const bf16*)(wb + W_BRR), T_TOK, D, D}; StaticOrder S; S.init(T_TOK, D, F.G, F.bx);
          pg8::EpiGate<1> E{(bf16*)(ws + Z_GA), (const bf16*)(ws + Z_GR)};
PROF_BEGIN(3);
#ifndef SK_G3
          pg8::gemm_phase<pg8::EpiGate<1>, StaticOrder>(ring, g, S, E, P.wave);
#endif
        }
        PROF_END(4);
        GRID_BAR();
        { const Frame P = launder(F); unsigned char* ws = P.ws; unsigned char* wb = ws + WS_W; bf16* XB = (bf16*)(ws + WS_XB); (void)XB; (void)wb;
          Gemm g{(const bf16*)(ws + Z_GA), (const bf16*)(wb + W_O), T_TOK, D, D}; StaticOrder S; S.init(T_TOK, D, F.G, F.bx);
          pg8::EpiBf16 E{(bf16*)(ws + Z_GR), D, 0};
PROF_BEGIN(4);
#ifndef SK_G4
          pg8::gemm_phase<pg8::EpiBf16, StaticOrder>(ring, g, S, E, P.wave);
#endif
#ifdef DUP_G4
          pg8::gemm_phase<pg8::EpiBf16, StaticOrder>(ring, g, S, E, P.wave);
#endif
        }
        PROF_END(5);
        GRID_BAR();
#ifdef DUP_LN
        ln_phase<false, false, true>(F, L); ln_phase<false, false, true>(F, L);
#endif
#ifndef SK_LN
        if (odd) ln_phase<false, true>(F, L); else ln_phase<false, false>(F, L);
#endif
        PROF_END(6);
        GRID_BAR();
        if (odd) {
            if (launder(F).tid == 0) { unsigned acc = 0u; F.MISC[16] = 0u;
                for (int e = 0; e < 8; ++e) { const unsigned c = __hip_atomic_load(F.ctl + CW_CNT + (L >> 1) * 1024 + 64 * e, RLX_AGENT); F.MISC[32 + e] = c; acc += (c + 255u) >> 8; F.MISC[17 + e] = acc; } }
            __syncthreads();
        }
        { const Frame P = launder(F); unsigned char* ws = P.ws; unsigned char* wb = ws + WS_W; bf16* XB = (bf16*)(ws + WS_XB); (void)XB; (void)wb;
          Gemm g{(const bf16*)(ws + F_PB), (const bf16*)(wb + W_PP), T_TOK, D, PLE}; StaticOrder S; S.init(T_TOK, D, F.G, F.bx);
          pg8::EpiBf16 E{(bf16*)(ws + F_U), D, 0};
PROF_BEGIN(5);
#ifndef SK_G5
          pg8::gemm_phase<pg8::EpiBf16, StaticOrder>(ring, g, S, E, P.wave);
#endif
        }
        LOCAL_HANDOFF();
        { const Frame P = launder(F); unsigned char* ws = P.ws; unsigned char* wb = ws + WS_W; bf16* XB = (bf16*)(ws + WS_XB); (void)XB; (void)wb;
          Gemm g{XB, (const bf16*)(wb + W_PG), T_TOK, D, D}; StaticOrder S; S.init(T_TOK, D, F.G, F.bx);
          pg8::EpiPle E{(bf16*)(ws + F_U)};
PROF_BEGIN(6);
#ifndef SK_G6
          pg8::gemm_phase<pg8::EpiPle, StaticOrder>(ring, g, S, E, P.wave);
#endif
        }
        PROF_END(7);
        if (!odd) {
            { const Frame P = launder(F); unsigned char* ws = P.ws; unsigned char* wb = ws + WS_W; bf16* XB = (bf16*)(ws + WS_XB); (void)XB; (void)wb;
          Gemm g{XB, (const bf16*)(wb + W_FF), T_TOK, 2 * DFF, D}; StaticOrder S; S.init(T_TOK, 2 * DFF, F.G, F.bx);
              pg8::EpiSwiglu E{(bf16*)(ws + F_H), DFF};
PROF_BEGIN(7);
#ifndef SK_G7
              pg8::gemm_phase<pg8::EpiSwiglu, StaticOrder>(ring, g, S, E, P.wave);
#endif
#ifdef DUP_G7
              pg8::gemm_phase<pg8::EpiSwiglu, StaticOrder>(ring, g, S, E, P.wave);
#endif
        }
            PROF_END(8);
            GRID_BAR();
            { const Frame P = launder(F); unsigned char* ws = P.ws; unsigned char* wb = ws + WS_W; bf16* XB = (bf16*)(ws + WS_XB); (void)XB; (void)wb;
          Gemm g{(const bf16*)(ws + F_H), (const bf16*)(wb + W_FF_DN_DENSE), T_TOK, D, DFF}; StaticOrder S; S.init(T_TOK, D, F.G, F.bx);
              pg8::EpiBf16 E{(bf16*)(ws + Z_GR), D, 0};
PROF_BEGIN(8);
#ifndef SK_G8
              pg8::gemm_phase<pg8::EpiBf16, StaticOrder>(ring, g, S, E, P.wave);
#endif
#ifdef DUP_G8
              pg8::gemm_phase<pg8::EpiBf16, StaticOrder>(ring, g, S, E, P.wave);
#endif
        }
            PROF_END(9);
            GRID_BAR();
#ifndef SK_LN
            ln_phase<true, false>(F, L);
#endif
        } else {
            const int ntiles = (int)F.MISC[24];
            const int nchunks = (ntiles + MOE_CHUNK_TILES - 1) / MOE_CHUNK_TILES;
            for (int c = 0; c < nchunks; ++c) {
                const int tile0 = c * MOE_CHUNK_TILES, ntl = (ntiles - tile0) < MOE_CHUNK_TILES ? (ntiles - tile0) : MOE_CHUNK_TILES;
                const size_t hc_off = (c & 1) ? F_H1 : F_H;
                { const Frame P = launder(F); unsigned char* ws = P.ws; unsigned char* wb = ws + WS_W; bf16* XB = (bf16*)(ws + WS_XB); (void)XB; (void)wb;
          Gemm g{XB, (const bf16*)(wb + W_FF), ntl * 256, 2 * DFFE, D}; MoeGatherOrder S; S.init(ntl * 256, 2 * DFFE, F.G, F.bx);
                  S.tb = F.MISC + 16; S.tile0 = tile0; S.list = (const int*)(ws + WS_LIST); S.bstride = (size_t)2 * DFFE * D * 2;
                  pg8::EpiSwiglu E{(bf16*)(ws + hc_off), DFFE};
PROF_BEGIN(9);
#ifndef SK_G9
                  pg8::gemm_phase<pg8::EpiSwiglu, MoeGatherOrder>(ring, g, S, E, P.wave);
#endif
        }
                PROF_END(10);
                GRID_BAR();
                { const Frame P = launder(F); unsigned char* ws = P.ws; unsigned char* wb = ws + WS_W; bf16* XB = (bf16*)(ws + WS_XB); (void)XB; (void)wb;
          Gemm g{(const bf16*)(ws + hc_off), (const bf16*)(wb + W_FF_DN_MOE), ntl * 256, D, DFFE}; MoeOrder S; S.init(ntl * 256, D, F.G, F.bx);
                  S.tb = F.MISC + 16; S.tile0 = tile0; S.list = nullptr; S.bstride = (size_t)D * DFFE * 2;
                  pg8::EpiBf16 E{(bf16*)(ws + F_YE), D, tile0 * 256};
PROF_BEGIN(10);
#ifndef SK_G10
                  pg8::gemm_phase<pg8::EpiBf16, MoeOrder>(ring, g, S, E, P.wave);
#endif
        }
                PROF_END(11);
            }
            PROF_END(11);
            GRID_BAR();
#ifndef SK_LN
            ln_phase<true, true>(F, L);
#endif
        }
        }
        if (L + 1 < DEPTH) { __syncthreads(); p0_convert(F, L + 1); }
        PROF_END(12);
#ifdef PROF_SEL
        if (L == DEPTH - 1 && F.bx == PROF_WG && launder(F).tid == 0) { const unsigned t_ = (unsigned)__builtin_amdgcn_s_memrealtime(); const float tot_ = (float)F.MISC[106] + (float)F.MISC[107] + (float)F.MISC[108] + (float)F.MISC[109] + (float)F.MISC[110] + (float)F.MISC[111] + (float)F.MISC[112] + (float)F.MISC[113];
            const float f_ = (PROF_SEL == 43) ? (float)F.MISC[122] / (float)F.MISC[123] : (PROF_SEL == 42) ? (float)F.MISC[120] / (float)F.MISC[121] : (PROF_SEL >= 50) ? (float)F.MISC[106 + (PROF_SEL - 50)] / tot_ : (PROF_SEL == 41) ? (float)F.MISC[105] / (float)F.MISC[104] : (PROF_SEL == 40) ? (float)F.MISC[104] / (float)F.MISC[64 + 14] * (1.0f / 40.0f) : PROF_MUL * (float)F.MISC[64 + PROF_SEL] / (float)(t_ - F.MISC[98]);
            const float g_ = (PROF_SEL < 40 && PROF_SEL2 < 40) ? PROF_MUL * (float)F.MISC[64 + PROF_SEL2] / (float)(t_ - F.MISC[98]) : (PROF_SEL == 43) ? (float)F.MISC[124] / (64.0f * 8.0f * 32.0f * 4.0f) : (PROF_SEL >= 50) ? (float)F.MISC[106 + (PROF_SEL2 - 50)] / tot_ : 0.0f;
            __hip_atomic_store(F.ctl + 9, __builtin_bit_cast(unsigned, g_), __ATOMIC_RELAXED, __HIP_MEMORY_SCOPE_AGENT);
            __hip_atomic_store(F.ctl + 8, __builtin_bit_cast(unsigned, f_), __ATOMIC_RELAXED, __HIP_MEMORY_SCOPE_AGENT); }
#endif
        GRID_BAR();
    }
#ifdef PROF_SEL
    { const float f_ = __builtin_bit_cast(float, __hip_atomic_load(F.ctl + 8, RLX_AGENT)); const float s_ = 1.0f + floorf(sqrtf(f_) * 32.0f + 0.5f) * (1.0f / 32.0f);
      for (size_t i = (size_t)F.bx * 512 + launder(F).tid; i < (size_t)T_TOK * D; i += (size_t)F.G * 512) X32[i] *= s_;
      const float g_ = __builtin_bit_cast(float, __hip_atomic_load(F.ctl + 9, RLX_AGENT)); if (F.bx == 0 && launder(F).tid == 0 && g_ > 0.f) X32[0] = 400.0f * floorf(g_ * 32.0f + 0.5f) * (1.0f / 32.0f); }
#endif
    if (__hip_atomic_load(F.ctl + CW_BAR + XB_TMO, RLX_AGENT) != 0u || __hip_atomic_load(F.ctl + CW_CODE, RLX_AGENT) != 0u) {
        const float q = __builtin_nanf("");
        for (size_t i = (size_t)F.bx * 512 + launder(F).tid; i < (size_t)T_TOK * D; i += (size_t)F.G * 512) X32[i] = q;
    }
}

#if defined(SELFCHECK)
constexpr size_t WS_DRY_EXTRA = 4 * MiB;
#elif defined(DUP_LRU) || defined(DUP_LN)
constexpr size_t WS_DRY_EXTRA = 80 * MiB;
#else
constexpr size_t WS_DRY_EXTRA = 0;
#endif
extern "C" void kernel_launch(void* const* d_in, const int* in_sizes, int n_in, void* d_out, int out_size, void* d_ws, size_t ws_size, hipStream_t stream) {
    static int grid = 0;
    if (grid == 0) {
        if (n_in != 28 || out_size != T_TOK * D || ws_size < WS_NEED + WS_DRY_EXTRA) { fprintf(stderr, "kernel_launch: unexpected shapes: n_in %d out %d ws %zu (need %zu)\n", n_in, out_size, ws_size, (size_t)WS_END); grid = -1; return; }
        int dev = 0, cus = 0, per_cu = 0;
        if (hipGetDevice(&dev) != hipSuccess || hipDeviceGetAttribute(&cus, hipDeviceAttributeMultiprocessorCount, dev) != hipSuccess) { grid = -1; return; }
        if (hipFuncSetAttribute((const void*)mk_fwd, hipFuncAttributeMaxDynamicSharedMemorySize, LDS_BYTES) != hipSuccess) { fprintf(stderr, "kernel_launch: hipFuncSetAttribute failed\n"); grid = -1; return; }
        if (hipOccupancyMaxActiveBlocksPerMultiprocessor(&per_cu, (const void*)mk_fwd, NWAVES * 64, LDS_BYTES) != hipSuccess || per_cu < 1) { fprintf(stderr, "kernel_launch: occupancy query says %d blocks per CU\n", per_cu); }
        (void)hipGetLastError();
        grid = cus;
        if (grid != 256) { fprintf(stderr, "kernel_launch: this kernel needs a 256-CU device (got %d)\n", cus); grid = -1; return; }
    }
    if (grid < 0) return;
    if (hipMemsetAsync((char*)d_ws + WS_CTL, 0, CTL_ZERO_BYTES, stream) != hipSuccess) return;
    Args a{};
    for (int i = 0; i < 28; ++i) a.in[i] = (const float*)d_in[i];
    a.out = (float*)d_out; a.ws = (unsigned char*)d_ws;
    hipLaunchKernelGGL(mk_fwd, dim3(grid), dim3(NWAVES * 64), LDS_BYTES, stream, a);
}
```
